# Optimizing an MI355X kernel written in HIP

```python
import jax, jax.numpy as jnp
from jax import lax
import numpy as np

D_MODEL = 1024
BATCH = 2
SEQ = 8192
DEPTH = 1

FOURIER_GROUPS = 4
FOURIER_GROUP_DIM = 128
D_FOURIER = FOURIER_GROUPS * FOURIER_GROUP_DIM
D_CONV = D_MODEL
CONV_WIDTH = 3
N_BRANCHES = 2
D_IN_PROJ = D_FOURIER + 3 * D_CONV + N_BRANCHES * D_MODEL
N_EXPERTS = 16
EC_CAPACITY = 2
D_EXPERT = 2048
N_MOD = 6
RMS_EPS = 1e-6

kernel_name = "hybrid_fourier_shortconv_ecmoe_block"


def rms_norm(x, g):
    xf = x.astype(jnp.float32)
    y = xf * lax.rsqrt(jnp.mean(xf * xf, axis=-1, keepdims=True) + RMS_EPS)
    return (y * g.astype(jnp.float32)).astype(x.dtype)


def modulate(h, shift, scale):
    return h * (1 + scale[:, None, :]) + shift[:, None, :]


def fourier_mix(u):
    b, s, _ = u.shape
    ug = u.reshape(b, s, FOURIER_GROUPS, FOURIER_GROUP_DIM).astype(jnp.float32)
    f = jnp.fft.fftn(ug, axes=(1, 3), norm="ortho")
    return jnp.real(f).reshape(b, s, D_FOURIER).astype(u.dtype)


def centred_conv3(u, w):
    s = u.shape[1]
    up = jnp.pad(u, ((0, 0), (1, 1), (0, 0)))
    return up[:, 0:s] * w[0] + up[:, 1:s + 1] * w[1] + up[:, 2:s + 2] * w[2]


def expert_choice_moe(h, w_router, b_router, w_gate_e, w_up_e, w_down_e):
    b, s, d = h.shape
    cap = EC_CAPACITY * s // N_EXPERTS
    logits = jnp.einsum('bsd,de->bse', h, w_router).astype(jnp.float32) + b_router.astype(jnp.float32)
    probs = jax.nn.softmax(logits, axis=-1)
    vals, idx = lax.top_k(jnp.swapaxes(probs, 1, 2), cap)
    xe = jax.vmap(lambda hb, ib: hb[ib])(h, idx)
    a = jnp.einsum('becd,edf->becf', xe, w_gate_e)
    u = jnp.einsum('becd,edf->becf', xe, w_up_e)
    y = jnp.einsum('becf,efd->becd', jax.nn.silu(a) * u, w_down_e)
    y = y * vals[..., None].astype(y.dtype)
    return jax.vmap(lambda yb, ib: jnp.zeros((s, d), yb.dtype).at[ib.reshape(-1)].add(yb.reshape(-1, d)))(y, idx)


def setup_inputs(seed: int = 0) -> dict:
    key = jax.random.key(seed)
    ks = jax.random.split(key, 20)
    f32 = jnp.float32
    nrm = lambda k, shape, scale: (jax.random.normal(k, shape, f32) * scale).astype(f32)
    D = D_MODEL
    return {
        "x": nrm(ks[0], (BATCH, SEQ, D), 1.0),
        "c": nrm(ks[1], (BATCH, D), 1.0),
        "w_ada": nrm(ks[2], (DEPTH, D, N_MOD * D), 0.5 * D ** -0.5),
        "b_ada": nrm(ks[3], (DEPTH, N_MOD * D), 0.02),
        "g_norm_mix": 1.0 + nrm(ks[4], (DEPTH, D), 0.02),
        "w_in": nrm(ks[5], (DEPTH, D, D_IN_PROJ), D ** -0.5),
        "b_gate": nrm(ks[6], (DEPTH, N_BRANCHES * D), 0.02),
        "w_fourier": nrm(ks[7], (DEPTH, D_FOURIER, D), D_FOURIER ** -0.5),
        "w_conv": nrm(ks[8], (DEPTH, CONV_WIDTH, D_CONV), CONV_WIDTH ** -0.5),
        "w_conv_out": nrm(ks[9], (DEPTH, D_CONV, D), D_CONV ** -0.5),
        "w_o": nrm(ks[10], (DEPTH, D, D), D ** -0.5),
        "g_norm_moe": 1.0 + nrm(ks[11], (DEPTH, D), 0.02),
        "w_router": nrm(ks[12], (DEPTH, D, N_EXPERTS), D ** -0.5),
        "b_router": nrm(ks[13], (DEPTH, N_EXPERTS), 0.01),
        "w_gate_e": nrm(ks[14], (DEPTH, N_EXPERTS, D, D_EXPERT), D ** -0.5),
        "w_up_e": nrm(ks[15], (DEPTH, N_EXPERTS, D, D_EXPERT), D ** -0.5),
        "w_down_e": nrm(ks[16], (DEPTH, N_EXPERTS, D_EXPERT, D), D_EXPERT ** -0.5),
        "g_final": 1.0 + nrm(ks[17], (D,), 0.02),
    }


def reference(x, c, w_ada, b_ada, g_norm_mix, w_in, b_gate, w_fourier, w_conv, w_conv_out, w_o,
              g_norm_moe, w_router, b_router, w_gate_e, w_up_e, w_down_e, g_final):
    D = D_MODEL
    c_act = jax.nn.silu(c)
    for l in range(DEPTH):
        mod = jnp.einsum('bd,dm->bm', c_act, w_ada[l]) + b_ada[l]
        shift_m, scale_m, gate_m, shift_f, scale_f, gate_f = jnp.split(mod, N_MOD, axis=-1)

        h = modulate(rms_norm(x, g_norm_mix[l]), shift_m, scale_m)
        p = jnp.einsum('bsd,dk->bsk', h, w_in[l])
        o1 = D_FOURIER
        o2 = o1 + D_CONV
        o3 = o2 + D_CONV
        o4 = o3 + D_CONV
        u_f = p[..., :o1]
        v, b_g, c_g = p[..., o1:o2], p[..., o2:o3], p[..., o3:o4]
        g_logits = p[..., o4:] + b_gate[l]
        gate_a = jax.nn.sigmoid(g_logits[..., :D])
        gate_b = jax.nn.sigmoid(g_logits[..., D:])
        y_a = jnp.einsum('bsk,kd->bsd', fourier_mix(u_f), w_fourier[l])
        y_b = jnp.einsum('bsk,kd->bsd', b_g * centred_conv3(c_g * v, w_conv[l]), w_conv_out[l])
        z = gate_a * y_a + gate_b * y_b
        mix_out = jnp.einsum('bsd,de->bse', z, w_o[l])
        x = x + gate_m[:, None, :] * mix_out

        h2 = modulate(rms_norm(x, g_norm_moe[l]), shift_f, scale_f)
        moe_out = expert_choice_moe(h2, w_router[l], b_router[l], w_gate_e[l], w_up_e[l], w_down_e[l])
        x = x + gate_f[:, None, :] * moe_out
    return rms_norm(x, g_final)
```

```cpp
#include <hip/hip_runtime.h>
#include <cstdio>
#include <cstdint>
namespace nv {
constexpr int B_ = 2, S_ = 8192, D_ = 1024, M_ = B_ * S_, DF = 512, DIN = 5632, NE = 16, CAP = 1024, DE = 2048;
__device__ __forceinline__ float silu_f(float v) { return v / (1.f + __expf(-v)); }
__device__ __forceinline__ float sigm_f(float v) { return 1.f / (1.f + __expf(-v)); }

__global__ void k_mod(const float* c, const float* w_ada, const float* b_ada, float* mod) {
    const int j = blockIdx.x * blockDim.x + threadIdx.x, b = blockIdx.y;
    if (j >= 6 * D_) return;
    float s = 0.f;
    for (int d = 0; d < D_; ++d) s += silu_f(c[b * D_ + d]) * w_ada[(size_t)d * 6 * D_ + j];
    mod[b * 6 * D_ + j] = s + b_ada[j];
}
__global__ void k_norm_mod(const float* x, const float* g, const float* shift, const float* scale, float* out) {
    const int m = blockIdx.x, b = m / S_, t = threadIdx.x;
    __shared__ float red[4];
    const float4 v = ((const float4*)(x + (size_t)m * D_))[t];
    float s = v.x * v.x + v.y * v.y + v.z * v.z + v.w * v.w;
    for (int o = 32; o >= 1; o >>= 1) s += __shfl_xor(s, o);
    if ((t & 63) == 0) red[t >> 6] = s;
    __syncthreads();
    const float tot = red[0] + red[1] + red[2] + red[3];
    const float r = rsqrtf(tot * (1.f / D_) + 1e-6f);
    float o[4] = {v.x, v.y, v.z, v.w};
#pragma unroll
    for (int i = 0; i < 4; ++i) { const int d = 4 * t + i; float y = o[i] * r * g[d]; if (scale) y = y * (1.f + scale[b * 6 * D_ + d]) + shift[b * 6 * D_ + d]; out[(size_t)m * D_ + d] = y; }
}
template <class LA, class EP>
__global__ void __launch_bounds__(256) k_gemm(LA la, const float* __restrict__ Bm, int ldb, int K, EP ep) {
    __shared__ float As[16][65]; __shared__ float Bs[16][64];
    const int tx = threadIdx.x & 15, ty = threadIdx.x >> 4, m0 = blockIdx.y * 64, n0 = blockIdx.x * 64;
    float acc[4][4];
#pragma unroll
    for (int i = 0; i < 4; ++i)
#pragma unroll
        for (int j = 0; j < 4; ++j) acc[i][j] = 0.f;
    for (int k0 = 0; k0 < K; k0 += 16) {
#pragma unroll
        for (int i = 0; i < 4; ++i) { const int e = threadIdx.x + i * 256, mm = e >> 4, kk = e & 15; As[kk][mm] = la(m0 + mm, k0 + kk); }
#pragma unroll
        for (int i = 0; i < 4; ++i) { const int e = threadIdx.x + i * 256, kk = e >> 6, nn = e & 63; Bs[kk][nn] = Bm[(size_t)(k0 + kk) * ldb + n0 + nn]; }
        __syncthreads();
#pragma unroll
        for (int kk = 0; kk < 16; ++kk) {
            float a0 = As[kk][ty * 4 + 0], a1 = As[kk][ty * 4 + 1], a2 = As[kk][ty * 4 + 2], a3 = As[kk][ty * 4 + 3];
            const float4 bv = *(const float4*)&Bs[kk][tx * 4];
            acc[0][0] += a0 * bv.x; acc[0][1] += a0 * bv.y; acc[0][2] += a0 * bv.z; acc[0][3] += a0 * bv.w;
            acc[1][0] += a1 * bv.x; acc[1][1] += a1 * bv.y; acc[1][2] += a1 * bv.z; acc[1][3] += a1 * bv.w;
            acc[2][0] += a2 * bv.x; acc[2][1] += a2 * bv.y; acc[2][2] += a2 * bv.z; acc[2][3] += a2 * bv.w;
            acc[3][0] += a3 * bv.x; acc[3][1] += a3 * bv.y; acc[3][2] += a3 * bv.z; acc[3][3] += a3 * bv.w;
        }
        __syncthreads();
    }
#pragma unroll
    for (int i = 0; i < 4; ++i)
#pragma unroll
        for (int j = 0; j < 4; ++j) ep(m0 + ty * 4 + i, n0 + tx * 4 + j, acc[i][j]);
}
struct LdRow { const float* A; int lda; __device__ __forceinline__ float operator()(int m, int k) const { return A[(size_t)m * lda + k]; } };
struct LdGather { const float* A; int lda; const int* idx; __device__ __forceinline__ float operator()(int m, int k) const { return A[(size_t)idx[m] * lda + k]; } };
struct LdDft { const float* tab; int mode; __device__ __forceinline__ float operator()(int k, int s) const { const int t = (k * s) & (S_ - 1); return mode == 0 ? tab[t] : -tab[S_ + t]; } };
struct EpStore { float* C; int ldc; __device__ __forceinline__ void operator()(int m, int n, float v) const { C[(size_t)m * ldc + n] = v; } };
struct EpInProj { float *uf, *v, *bg, *cg, *ga, *gb; const float* b_gate;
    __device__ __forceinline__ void operator()(int m, int n, float a) const {
        if (n < 512) uf[(size_t)m * 512 + n] = a;
        else if (n < 1536) v[(size_t)m * 1024 + n - 512] = a;
        else if (n < 2560) bg[(size_t)m * 1024 + n - 1536] = a;
        else if (n < 3584) cg[(size_t)m * 1024 + n - 2560] = a;
        else if (n < 4608) ga[(size_t)m * 1024 + n - 3584] = sigm_f(a + b_gate[n - 3584]);
        else gb[(size_t)m * 1024 + n - 4608] = sigm_f(a + b_gate[n - 3584]);
    } };
struct EpMulInto { float* Z; const float* G; int mode;
    __device__ __forceinline__ void operator()(int m, int n, float a) const { const size_t i = (size_t)m * D_ + n; if (mode == 0) Z[i] = G[i] * a; else Z[i] += G[i] * a; } };
struct EpResid { const float* x; const float* gate; float* out;
    __device__ __forceinline__ void operator()(int m, int n, float a) const { const int b = m / S_; out[(size_t)m * D_ + n] = x[(size_t)m * D_ + n] + gate[b * 6 * D_ + n] * a; } };
struct EpSiluMul { float* U;
    __device__ __forceinline__ void operator()(int m, int n, float a) const { const size_t i = (size_t)m * DE + n; U[i] = silu_f(a) * U[i]; } };
struct EpScaleRow { float* Y; const float* val; __device__ __forceinline__ void operator()(int m, int n, float a) const { Y[(size_t)m * D_ + n] = a * val[m]; } };

__global__ void k_trig(float* tab) { const int i = blockIdx.x * blockDim.x + threadIdx.x; if (i < S_) { float s, c; sincospif(2.0f * (float)i / (float)S_, &s, &c); tab[i] = c; tab[S_ + i] = s; } }
__global__ void k_chan_dft(const float* WR, const float* WI, const float* tab, float* Af) {
    const int n = threadIdx.x + blockIdx.x * blockDim.x, m = blockIdx.y; if (n >= DF) return;
    const int g = n >> 7, mm = n & 127; float s = 0.f;
    for (int j = 0; j < 128; ++j) { const int t = ((mm * j) & 127) * (S_ / 128); s += WR[(size_t)m * DF + g * 128 + j] * tab[t] + WI[(size_t)m * DF + g * 128 + j] * tab[S_ + t]; }
    Af[(size_t)m * DF + n] = s * (1.0f / 1024.0f);
}
__global__ void k_conv(const float* v, const float* bg, const float* cg, const float* wc, float* ab) {
    const int k = threadIdx.x + blockIdx.x * blockDim.x, m = blockIdx.y, s = m % S_; const size_t i = (size_t)m * D_ + k;
    float a = cg[i] * v[i] * wc[D_ + k];
    if (s > 0) a += cg[i - D_] * v[i - D_] * wc[k];
    if (s < S_ - 1) a += cg[i + D_] * v[i + D_] * wc[2 * D_ + k];
    ab[i] = bg[i] * a;
}
__global__ void k_router(const float* h2, const float* wr, const float* br, float* probs) {
    const int m = blockIdx.x * 4 + (threadIdx.x >> 6), lane = threadIdx.x & 63;
    float acc[NE];
#pragma unroll
    for (int e = 0; e < NE; ++e) acc[e] = 0.f;
    for (int d = lane; d < D_; d += 64) { const float hv = h2[(size_t)m * D_ + d];
#pragma unroll
        for (int e = 0; e < NE; ++e) acc[e] += hv * wr[d * NE + e]; }
    float mx = -1e30f;
#pragma unroll
    for (int e = 0; e < NE; ++e) { for (int o = 32; o >= 1; o >>= 1) acc[e] += __shfl_xor(acc[e], o); acc[e] += br[e]; mx = fmaxf(mx, acc[e]); }
    float sum = 0.f;
#pragma unroll
    for (int e = 0; e < NE; ++e) { acc[e] = expf(acc[e] - mx); sum += acc[e]; }
#pragma unroll
    for (int e = 0; e < NE; ++e) if (lane == e) probs[(size_t)m * NE + e] = acc[e] / sum;
}
__global__ void k_topk(const float* probs, int* idx, float* val, int* slot) {
    const int s = blockIdx.x * 256 + threadIdx.x, e = blockIdx.y, b = blockIdx.z;
    const float* col = probs + (size_t)b * S_ * NE + e; const float p = col[(size_t)s * NE]; int rank = 0;
    for (int t = 0; t < S_; ++t) { const float q = col[(size_t)t * NE]; rank += (q > p || (q == p && t < s)) ? 1 : 0; }
    if (rank < CAP) { idx[(b * NE + e) * CAP + rank] = b * S_ + s; val[(b * NE + e) * CAP + rank] = p; slot[(size_t)(b * S_ + s) * NE + e] = rank; }
    else slot[(size_t)(b * S_ + s) * NE + e] = -1;
}
__global__ void k_final(const float* x1, const float* Y, const int* slot, const float* gate, const float* g, float* out) {
    const int m = blockIdx.x, b = m / S_, t = threadIdx.x; __shared__ float red[4];
    float4 acc = make_float4(0.f, 0.f, 0.f, 0.f);
    for (int e = 0; e < NE; ++e) { const int sl = slot[(size_t)m * NE + e]; if (sl >= 0) { const float4 y = ((const float4*)(Y + ((size_t)(b * NE + e) * CAP + sl) * D_))[t]; acc.x += y.x; acc.y += y.y; acc.z += y.z; acc.w += y.w; } }
    const float4 xv = ((const float4*)(x1 + (size_t)m * D_))[t]; const float4 gv = ((const float4*)(gate + b * 6 * D_))[t];
    float o[4] = {xv.x + gv.x * acc.x, xv.y + gv.y * acc.y, xv.z + gv.z * acc.z, xv.w + gv.w * acc.w};
    float s = o[0] * o[0] + o[1] * o[1] + o[2] * o[2] + o[3] * o[3];
    for (int q = 32; q >= 1; q >>= 1) s += __shfl_xor(s, q);
    if ((t & 63) == 0) red[t >> 6] = s;
    __syncthreads();
    const float r = rsqrtf((red[0] + red[1] + red[2] + red[3]) * (1.f / D_) + 1e-6f);
#pragma unroll
    for (int i = 0; i < 4; ++i) out[(size_t)m * D_ + 4 * t + i] = o[i] * r * g[4 * t + i];
}

static void forward(void* const* d_in, float* out, float* ws, hipStream_t st) {
    const float *x = (const float*)d_in[0], *c = (const float*)d_in[1], *w_ada = (const float*)d_in[2], *b_ada = (const float*)d_in[3], *g_mix = (const float*)d_in[4], *w_in = (const float*)d_in[5],
                *b_gate = (const float*)d_in[6], *w_f = (const float*)d_in[7], *w_conv = (const float*)d_in[8], *w_co = (const float*)d_in[9], *w_o = (const float*)d_in[10], *g_moe = (const float*)d_in[11],
                *w_r = (const float*)d_in[12], *b_r = (const float*)d_in[13], *w_g = (const float*)d_in[14], *w_u = (const float*)d_in[15], *w_d = (const float*)d_in[16], *g_fin = (const float*)d_in[17];
    const size_t MD = (size_t)M_ * D_;
    float* mod = ws;
    float* tab = ws + 16384;
    float* probs = ws + 32768;
    float* val = probs + (size_t)M_ * NE;
    int* idx = (int*)(val + 32768);
    int* slot = idx + 32768;
    float* R0 = ws + (1u << 20);
    float* h = R0;
    float* uf = h + MD;
    float* v = uf + MD / 2;
    float* bg = v + MD;
    float* cg = bg + MD;
    float* ga = cg + MD;
    float* gb = ga + MD;
    k_mod<<<dim3(6 * D_ / 256, B_), 256, 0, st>>>(c, w_ada, b_ada, mod);
    k_trig<<<S_ / 256, 256, 0, st>>>(tab);
    k_norm_mod<<<M_, 256, 0, st>>>(x, g_mix, mod, mod + D_, h);
    k_gemm<<<dim3(DIN / 64, M_ / 64), 256, 0, st>>>(LdRow{h, D_}, w_in, DIN, D_, EpInProj{uf, v, bg, cg, ga, gb, b_gate});
    float* ab = h;
    k_conv<<<dim3(D_ / 256, M_), 256, 0, st>>>(v, bg, cg, w_conv, ab);
    float *WR = bg, *WI = bg + MD / 2, *Af = cg;
    for (int b = 0; b < B_; ++b) {
        k_gemm<<<dim3(DF / 64, S_ / 64), 256, 0, st>>>(LdDft{tab, 0}, uf + (size_t)b * S_ * DF, DF, S_, EpStore{WR + (size_t)b * S_ * DF, DF});
        k_gemm<<<dim3(DF / 64, S_ / 64), 256, 0, st>>>(LdDft{tab, 1}, uf + (size_t)b * S_ * DF, DF, S_, EpStore{WI + (size_t)b * S_ * DF, DF});
    }
    k_chan_dft<<<dim3(DF / 256, M_), 256, 0, st>>>(WR, WI, tab, Af);
    k_gemm<<<dim3(D_ / 64, M_ / 64), 256, 0, st>>>(LdRow{Af, DF}, w_f, D_, DF, EpMulInto{ga, ga, 0});
    k_gemm<<<dim3(D_ / 64, M_ / 64), 256, 0, st>>>(LdRow{ab, D_}, w_co, D_, D_, EpMulInto{ga, gb, 1});
    float* x1 = out;
    k_gemm<<<dim3(D_ / 64, M_ / 64), 256, 0, st>>>(LdRow{ga, D_}, w_o, D_, D_, EpResid{x, mod + 2 * D_, x1});
    float* h2 = h;
    k_norm_mod<<<M_, 256, 0, st>>>(x1, g_moe, mod + 3 * D_, mod + 4 * D_, h2);
    k_router<<<M_ / 4, 256, 0, st>>>(h2, w_r, b_r, probs);
    k_topk<<<dim3(S_ / 256, NE, B_), 256, 0, st>>>(probs, idx, val, slot);
    float* U = uf;
    float* Y = U + 4 * MD;
    for (int be = 0; be < B_ * NE; ++be) {
        const int e = be % NE; const int* ix = idx + be * CAP;
        k_gemm<<<dim3(DE / 64, CAP / 64), 256, 0, st>>>(LdGather{h2, D_, ix}, w_u + (size_t)e * D_ * DE, DE, D_, EpStore{U + (size_t)be * CAP * DE, DE});
        k_gemm<<<dim3(DE / 64, CAP / 64), 256, 0, st>>>(LdGather{h2, D_, ix}, w_g + (size_t)e * D_ * DE, DE, D_, EpSiluMul{U + (size_t)be * CAP * DE});
        k_gemm<<<dim3(D_ / 64, CAP / 64), 256, 0, st>>>(LdRow{U + (size_t)be * CAP * DE, DE}, w_d + (size_t)e * DE * D_, D_, DE, EpScaleRow{Y + (size_t)be * CAP * D_, val + be * CAP});
    }
    k_final<<<M_, 256, 0, st>>>(x1, Y, slot, mod + 5 * D_, g_fin, out);
}
}

extern "C" void kernel_launch(void* const* d_in, const int* in_sizes, int n_in, void* d_out, int out_size, void* d_ws, size_t ws_size, hipStream_t stream) {
    (void)in_sizes; (void)n_in; (void)out_size; (void)ws_size;
    nv::forward(d_in, (float*)d_out, (float*)d_ws, stream);
}
```

```cpp
#include <hip/hip_runtime.h>
#include <cstdio>
#include <cstdint>
#define MK_PER_PHASE 0
#define STOP_AFTER 11
#define DUMP_WHICH -1
#define GALIGN true
#define GSP2 true
#define DBG_PLAIN 0
#define DBG_NOBIAS 0
#define DBG_NOSIG 0
namespace pg8 {
#define PG8_LAS __attribute__((address_space(3)))
typedef unsigned short bf16_t;
typedef short bf16x8 __attribute__((ext_vector_type(8)));
typedef float f32x4 __attribute__((ext_vector_type(4)));
typedef unsigned u32x4 __attribute__((ext_vector_type(4)));
typedef unsigned u32x2 __attribute__((ext_vector_type(2)));
constexpr int BM = 256, BK = 64, HALF = 128, HTB = HALF * BK * 2  , STAGE_BYTES = 8 * HTB, NXCD = 8, WGM = 8;

__host__ __device__ __forceinline__ int lds_byte(int r, int c) { const int st = (r >> 4) * 2 + (c >> 5), rr = r & 15, cc = c & 31, ob = rr * 64 + cc * 2; return st * 1024 + (ob ^ (((ob >> 9) & 1) << 5)); }
__host__ __device__ __forceinline__ void stage_rc(int b, int& R, int& C) { const int st = b / 1024, sb = b % 1024, swz = sb ^ (((sb >> 9) & 1) << 5); R = (st >> 1) * 16 + swz / 64; C = (st & 1) * 32 + (swz % 64) / 2; }
__host__ __device__ __forceinline__ int perm32(int rho) { const int n = rho >> 4, i = rho & 15; return 8 * (i >> 2) + 4 * n + (i & 3); }

struct Unit { int pm, pn; };
struct Gemm { const bf16_t* A; const bf16_t* Bt; int M, N, K; int bgrp; size_t bstride; };

struct StaticOrder {
    int nM, nN, nwg, G, c;
    __host__ __device__ void init(int M, int N, int G_, int c_) { nM = M / BM; nN = N / BM; nwg = nM * nN; G = G_; c = c_; }
    __host__ __device__ bool next(int i, Unit& u) const {
        const long L = (long)i * G + c; if (L >= nwg) return false;
        int wgid = (int)L; { const int q = nwg / NXCD, r = nwg % NXCD, xcd = wgid % NXCD, off = wgid / NXCD; wgid = (xcd < r ? xcd * (q + 1) : r * (q + 1) + (xcd - r) * q) + off; }
        const int nig = WGM * nN, gid = wgid / nig, fm = gid * WGM, gsz = (nM - fm) < WGM ? (nM - fm) : WGM;
        u.pm = fm + ((wgid % nig) % gsz); u.pn = (wgid % nig) / gsz; return true;
    }
    __device__ __forceinline__ void a_ready(const Unit&) const {}
    __device__ __forceinline__ void done(const Unit&) const {}
};

typedef __bf16 bf16x2_t __attribute__((ext_vector_type(2)));
typedef float f32x2_t __attribute__((ext_vector_type(2)));
__device__ __forceinline__ unsigned cvt_pk_bf16(float lo, float hi) { const f32x2_t v = {lo, hi}; const bf16x2_t b = __builtin_convertvector(v, bf16x2_t); return __builtin_bit_cast(unsigned, b); }
__device__ __forceinline__ float bf_lo(unsigned w) { return __uint_as_float(w << 16); }
__device__ __forceinline__ float bf_hi(unsigned w) { return __uint_as_float(w & 0xffff0000u); }
__device__ __forceinline__ float sigm(float v) { return __builtin_amdgcn_rcpf(1.0f + __expf(-v)); }


template <class Epi, class Sched, int AMODE, bool ALIGN_EPI, bool SP2>
__device__ __forceinline__ void gemm_phase(PG8_LAS unsigned char* lds, const Gemm g, const Sched& S, const Epi& E) {
    const int tid = threadIdx.x, wid = __builtin_amdgcn_readfirstlane(tid >> 6), lane = tid & 63, wr = wid >> 2, wc = wid & 3, fr = lane & 15, fq = lane >> 4;
    const int K = g.K, nt = K / BK;
    unsigned voffA0[2], voffA1[2], voffB[2];
#pragma unroll
    for (int i = 0; i < 2; ++i) { int R, C; stage_rc(tid * 16 + i * 8192, R, C); const int Rb = Epi::PERM ? ((R & ~31) + perm32(R & 31)) : R;
        voffB[i] = (unsigned)(Rb * K + C) * 2u;
        if (AMODE == 0) { voffA0[i] = (unsigned)(R * K + C) * 2u; voffA1[i] = (unsigned)((R + HALF) * K + C) * 2u; }
        else { voffA0[i] = (unsigned)((C >> 3) * 8192 + R) * 16u; voffA1[i] = voffA0[i] + (unsigned)HALF * 16u; } }
    const size_t kstepB = (size_t)(BK * 2);
    const size_t kstepA = (AMODE == 0) ? (size_t)(BK * 2) : (size_t)8 * 8192 * 16;
    const size_t hstepB = (size_t)HALF * K * 2;
    const size_t tstepB = 2 * hstepB;
    const unsigned ldsw = (unsigned)wid * 1024u;
    const int aoff = lds_byte(wr * 64 + fr, fq * 8), boff = lds_byte(wc * 32 + fr, fq * 8);
#define PG8_ABASE(u) ((const char*)g.A + ((AMODE == 0) ? (size_t)(u).pm * (size_t)BM * K * 2 : (size_t)((u).pm >> 5) * ((size_t)(K >> 3) * 8192 * 16) + (size_t)((u).pm & 31) * (BM * 16)))
#define PG8_BBASE(u) ((const char*)g.Bt + (g.bgrp ? (size_t)((u).pm / g.bgrp) * g.bstride * 2 : (size_t)0) + (size_t)(u).pn * tstepB)
#define PG8_SA(b, h) (((b) * 2 + (h)) * HTB)
#define PG8_SB(b, h) ((4 + (b) * 2 + (h)) * HTB)
#define PG8_STAGE(bufoff, gbase, voff) do { _Pragma("unroll") for (int _i = 0; _i < 2; ++_i) \
        __builtin_amdgcn_global_load_lds((const unsigned*)((const char*)(gbase) + (voff)[_i]), (PG8_LAS unsigned*)(lds + (bufoff) + ldsw + _i * 8192), 16, 0, 0); } while (0)
#define PG8_LDA(dst, b, h) do { _Pragma("unroll") for (int m = 0; m < 4; ++m) _Pragma("unroll") for (int k = 0; k < 2; ++k) dst[m][k] = *(const PG8_LAS bf16x8*)(lds + PG8_SA(b, h) + aoff + m * 2048 + k * 1024); } while (0)
#define PG8_LDB(dst, b, h) do { _Pragma("unroll") for (int n = 0; n < 2; ++n) _Pragma("unroll") for (int k = 0; k < 2; ++k) dst[n][k] = *(const PG8_LAS bf16x8*)(lds + PG8_SB(b, h) + boff + n * 2048 + k * 1024); } while (0)
#define PG8_MMA(ai, bj, At, Bt) do { __builtin_amdgcn_s_setprio(1); _Pragma("unroll") for (int m = 0; m < 4; ++m) _Pragma("unroll") for (int n = 0; n < 2; ++n) _Pragma("unroll") for (int k = 0; k < 2; ++k) \
        acc[ai][bj][m][n] = __builtin_amdgcn_mfma_f32_16x16x32_bf16(Bt[n][k], At[m][k], acc[ai][bj][m][n], 0, 0, 0); __builtin_amdgcn_s_setprio(0); } while (0)
#define PG8_WAIT_V(n) asm volatile("s_waitcnt vmcnt(" #n ")" ::: "memory")
#define PG8_WAIT_L(n) asm volatile("s_waitcnt lgkmcnt(" #n ")" ::: "memory")
#define PG8_BAR __builtin_amdgcn_s_barrier()
#define PG8_SCHED __builtin_amdgcn_sched_barrier(0)
    Unit cur, nxt; int ui = 0;
    if (!S.next(0, cur)) return;
    f32x4 acc[2][2][4][2];
#pragma unroll
    for (int a = 0; a < 2; ++a)
#pragma unroll
        for (int b = 0; b < 2; ++b)
#pragma unroll
            for (int m = 0; m < 4; ++m)
#pragma unroll
                for (int n = 0; n < 2; ++n) acc[a][b][m][n] = (f32x4){0.f, 0.f, 0.f, 0.f};
    bf16x8 At[4][2], B0[2][2], B1[2][2];
    const char* cA = PG8_ABASE(cur); const char* cB = PG8_BBASE(cur);
    S.a_ready(cur);
    if constexpr (SP2) {
        PG8_STAGE(PG8_SB(0, 0), cB, voffB); PG8_STAGE(PG8_SB(0, 1), cB + hstepB, voffB); PG8_STAGE(PG8_SA(0, 0), cA, voffA0); PG8_STAGE(PG8_SA(0, 1), cA, voffA1);
        if (wr == 1) PG8_BAR;
        PG8_WAIT_V(2); PG8_BAR;
        PG8_STAGE(PG8_SB(1, 0), cB + kstepB, voffB); PG8_STAGE(PG8_SA(1, 0), cA + kstepA, voffA0); PG8_STAGE(PG8_SB(1, 1), cB + hstepB + kstepB, voffB);
        PG8_WAIT_V(6); PG8_BAR;
    } else {
        PG8_STAGE(PG8_SB(0, 0), cB, voffB); PG8_STAGE(PG8_SA(0, 0), cA, voffA0); PG8_STAGE(PG8_SB(0, 1), cB + hstepB, voffB); PG8_STAGE(PG8_SA(0, 1), cA, voffA1);
        if (wr == 1) PG8_BAR;
        PG8_WAIT_V(4); PG8_BAR;
        PG8_STAGE(PG8_SB(1, 0), cB + kstepB, voffB); PG8_STAGE(PG8_SA(1, 0), cA + kstepA, voffA0); PG8_STAGE(PG8_SB(1, 1), cB + hstepB + kstepB, voffB);
        PG8_WAIT_V(6); PG8_BAR;
    }
    for (;;) {
        const bool has_next = S.next(ui + 1, nxt);
        const char* nA = has_next ? PG8_ABASE(nxt) : cA; const char* nB = has_next ? PG8_BBASE(nxt) : cB;
        for (int t = 0; t < nt; t += 2) {
            const bool last = (t == nt - 2);
            const char* a1 = cA + (size_t)(t + 1) * kstepA;
            const char* a2 = last ? nA : cA + (size_t)(t + 2) * kstepA; const char* b2 = last ? nB : cB + (size_t)(t + 2) * kstepB;
            const char* a3 = a2 + kstepA; const char* b3 = b2 + kstepB;
            if (last && has_next) S.a_ready(nxt);
            if constexpr (SP2) {
            PG8_LDB(B0, 0, 0); PG8_LDB(B1, 0, 1); PG8_SCHED; PG8_LDA(At, 0, 0); PG8_STAGE(PG8_SA(1, 1), a1, voffA1);
            PG8_WAIT_V(8); PG8_WAIT_L(0); PG8_BAR; PG8_MMA(0, 0, At, B0); PG8_MMA(0, 1, At, B1); PG8_BAR; PG8_SCHED;
            PG8_LDA(At, 0, 1); PG8_STAGE(PG8_SB(0, 0), b2, voffB); PG8_STAGE(PG8_SB(0, 1), b2 + hstepB, voffB); PG8_STAGE(PG8_SA(0, 0), a2, voffA0);
            PG8_WAIT_V(8); PG8_WAIT_L(0); PG8_BAR; PG8_MMA(1, 0, At, B0); PG8_MMA(1, 1, At, B1); PG8_BAR; PG8_SCHED;
            PG8_LDB(B0, 1, 0); PG8_LDB(B1, 1, 1); PG8_SCHED; PG8_LDA(At, 1, 0); PG8_STAGE(PG8_SA(0, 1), a2, voffA1);
            PG8_WAIT_V(8); PG8_WAIT_L(0); PG8_BAR; PG8_MMA(0, 0, At, B0); PG8_MMA(0, 1, At, B1); PG8_BAR; PG8_SCHED;
            PG8_LDA(At, 1, 1); PG8_STAGE(PG8_SB(1, 0), b3, voffB); PG8_STAGE(PG8_SB(1, 1), b3 + hstepB, voffB); PG8_STAGE(PG8_SA(1, 0), a3, voffA0);
            PG8_WAIT_V(8); PG8_WAIT_L(0); PG8_BAR; PG8_MMA(1, 0, At, B0); PG8_MMA(1, 1, At, B1); PG8_BAR; PG8_SCHED;
            } else {
            PG8_LDB(B0, 0, 0); PG8_SCHED; PG8_LDA(At, 0, 0); PG8_STAGE(PG8_SA(1, 1), a1, voffA1);
            PG8_WAIT_L(8); PG8_BAR; PG8_WAIT_L(0); PG8_MMA(0, 0, At, B0); PG8_BAR; PG8_SCHED;
            PG8_LDB(B1, 0, 1); PG8_STAGE(PG8_SB(0, 0), b2, voffB);
            PG8_BAR; PG8_WAIT_L(0); PG8_MMA(0, 1, At, B1); PG8_BAR;
            PG8_LDA(At, 0, 1); PG8_STAGE(PG8_SA(0, 0), a2, voffA0);
            PG8_BAR; PG8_WAIT_L(0); PG8_MMA(1, 0, At, B0); PG8_BAR; PG8_SCHED;
            PG8_STAGE(PG8_SB(0, 1), b2 + hstepB, voffB);
            PG8_WAIT_V(6); PG8_BAR; PG8_MMA(1, 1, At, B1); PG8_BAR;
            PG8_LDB(B0, 1, 0); PG8_SCHED; PG8_LDA(At, 1, 0); PG8_STAGE(PG8_SA(0, 1), a2, voffA1);
            PG8_WAIT_L(8); PG8_BAR; PG8_WAIT_L(0); PG8_MMA(0, 0, At, B0); PG8_BAR; PG8_SCHED;
            PG8_LDB(B1, 1, 1); PG8_STAGE(PG8_SB(1, 0), b3, voffB);
            PG8_BAR; PG8_WAIT_L(0); PG8_MMA(0, 1, At, B1); PG8_BAR;
            PG8_LDA(At, 1, 1); PG8_STAGE(PG8_SA(1, 0), a3, voffA0);
            PG8_BAR; PG8_WAIT_L(0); PG8_MMA(1, 0, At, B0); PG8_BAR; PG8_SCHED;
            PG8_STAGE(PG8_SB(1, 1), b3 + hstepB, voffB);
            PG8_WAIT_V(6); PG8_BAR; PG8_MMA(1, 1, At, B1); PG8_BAR;
            }
        }
        if constexpr (ALIGN_EPI) { if (wr == 0) PG8_BAR; }
        E(acc, cur, wr, wc, fr, fq); S.done(cur);
        if (!has_next) break;
#pragma unroll
        for (int a = 0; a < 2; ++a)
#pragma unroll
            for (int b = 0; b < 2; ++b)
#pragma unroll
                for (int m = 0; m < 4; ++m)
#pragma unroll
                    for (int n = 0; n < 2; ++n) acc[a][b][m][n] = (f32x4){0.f, 0.f, 0.f, 0.f};
        cur = nxt; cA = nA; cB = nB; ++ui;
        if constexpr (ALIGN_EPI) { if (wr == 1) PG8_BAR; }
    }
    PG8_WAIT_V(0);
    if constexpr (!ALIGN_EPI) { if (wr == 0) PG8_BAR; }
    PG8_BAR;
#undef PG8_ABASE
#undef PG8_BBASE
#undef PG8_SA
#undef PG8_SB
#undef PG8_STAGE
#undef PG8_LDA
#undef PG8_LDB
#undef PG8_MMA
#undef PG8_WAIT_V
#undef PG8_WAIT_L
#undef PG8_BAR
#undef PG8_SCHED
}
}
constexpr int NWAVES = 8;
constexpr int BATCH = 2, SEQ = 8192, D = 1024, M = BATCH * SEQ, DF = 512, DIN = 5632, NE = 16, CAP = 1024, DE = 2048, MR = BATCH * NE * CAP  ;
constexpr float RMS_EPS = 1e-6f;
constexpr size_t MiB = 1u << 20;
constexpr size_t WS_CTL = 0, CTL_ZERO_BYTES = 1 * MiB;
constexpr size_t WS_MODP = 1 * MiB, WS_MOD = 1 * MiB + 256 * 1024, WS_FC1 = 1 * MiB + 512 * 1024, WS_FC2 = 1 * MiB + 576 * 1024;
constexpr size_t WS_PROBS = 2 * MiB, WS_SLOT = 3 * MiB, WS_IDX = 4 * MiB, WS_VAL = 4 * MiB + 128 * 1024;
constexpr size_t WS_WIN = 8 * MiB, WS_WF = 20 * MiB, WS_WCO = 22 * MiB, WS_WO = 24 * MiB, WS_WGU = 32 * MiB, WS_WD = 160 * MiB;
constexpr size_t WS_H1 = 224 * MiB, WS_AB = 224 * MiB, WS_UF = 256 * MiB, WS_CV = 272 * MiB, WS_BG = 304 * MiB, WS_GA = 336 * MiB, WS_GB = 368 * MiB, WS_ZF = 400 * MiB, WS_TZ = 432 * MiB, WS_H2 = 464 * MiB;
constexpr size_t WS_HM = 224 * MiB, WS_Y = 352 * MiB, WS_XE = 400 * MiB, WS_END = 496 * MiB;
constexpr int CW_BAR = 4096;
constexpr int RING_BYTES = 131072, MISC_OFF = 143360, LDS_BYTES = 147456;
constexpr int FFT_TOFF = 65536, FFT_TPITCH = 528;

#define GAS __attribute__((address_space(1)))
#define LAS __attribute__((address_space(3)))
typedef unsigned short bf16;
typedef unsigned v4u __attribute__((ext_vector_type(4)));
typedef unsigned v2u __attribute__((ext_vector_type(2)));
typedef float f32x4 __attribute__((ext_vector_type(4)));
typedef short bf16x8 __attribute__((ext_vector_type(8)));
#define LDS_WAIT() asm volatile("s_waitcnt lgkmcnt(0)" ::: "memory")
#define VM_WAIT() asm volatile("s_waitcnt vmcnt(0)" ::: "memory")
using pg8::cvt_pk_bf16; using pg8::bf_lo; using pg8::bf_hi; using pg8::sigm;
__device__ __forceinline__ float wave_sum(float v) {
#pragma unroll
    for (int o = 1; o < 64; o <<= 1) v += __shfl_xor(v, o);
    return v;
}
__device__ __forceinline__ float silu(float v) { return v * sigm(v); }
#ifndef DBG_NOBIAS
#define DBG_NOBIAS 0
#endif
#ifndef DBG_NOSIG
#define DBG_NOSIG 0
#endif
__device__ __forceinline__ float sigx(float v) { return DBG_NOSIG ? v : sigm(v); }

#define XB_TMO      128
#define XB_XCNT(j)  (256  + 64 * (j))
#define XB_XSUB(j)  (1280 + 64 * (j))
#define XB_XGEN(j)  (2304 + 64 * (j))
#define XB_TOP      3328
#define XB_TOPGEN   3392
#define XCD_BAR_WORDS 3456
#define XB_SPIN_CAP (1u << 18)
__device__ __forceinline__ unsigned xb_ld(unsigned* p)              { return __hip_atomic_load(p, __ATOMIC_RELAXED, __HIP_MEMORY_SCOPE_AGENT); }
__device__ __forceinline__ unsigned xb_add(unsigned* p, unsigned v) { return __hip_atomic_fetch_add(p, v, __ATOMIC_RELAXED, __HIP_MEMORY_SCOPE_AGENT); }
__device__ __forceinline__ unsigned xb_xcc_id() { return (unsigned)__builtin_amdgcn_s_getreg((3 << 11) | 20) & 0xFu; }
#define XB_SPIN(cond, bar) do { unsigned _sp = 0; while (cond) { __builtin_amdgcn_s_sleep(1); \
    if ((++_sp & 255u) == 0u) { if (xb_ld(&(bar)[XB_TMO])) break; if (_sp > XB_SPIN_CAP) { atomicAdd(&(bar)[XB_TMO], 1u); break; } } } } while (0)
struct XcdBarrier { unsigned* bar; unsigned x; volatile LAS unsigned* st; };
__device__ __forceinline__ XcdBarrier xcd_barrier_post(unsigned* bar, volatile LAS unsigned* st) {
    XcdBarrier b; b.bar = bar; b.x = xb_xcc_id(); b.st = st;
    if (threadIdx.x == 0) (void)xb_add(&bar[XB_XCNT(b.x)], 1u);
    return b;
}
__device__ __forceinline__ void xcd_barrier_complete(unsigned* bar, unsigned x, unsigned& nloc, unsigned& nx) {
    const unsigned G = gridDim.x * gridDim.y * gridDim.z;
    unsigned sum, cnt, mine, sp = 0u;
    for (;;) {
        sum = 0u; cnt = 0u; mine = 0u;
#pragma unroll
        for (unsigned j = 0; j < 16; ++j) { const unsigned c = xb_ld(&bar[XB_XCNT(j)]); sum += c; cnt += (c > 0u) ? 1u : 0u; mine = (j == x) ? c : mine; }
        if (sum == G) break;
        __builtin_amdgcn_s_sleep(1);
        if ((++sp & 255u) == 0u) { if (xb_ld(&bar[XB_TMO])) break; if (sp > XB_SPIN_CAP) { atomicAdd(&bar[XB_TMO], 1u); break; } }
    }
    nloc = mine > 0u ? mine : 1u; nx = cnt > 0u ? cnt : 1u;
}
__device__ __forceinline__ void xcd_barrier(const XcdBarrier& b) {
    asm volatile("s_waitcnt vmcnt(0)" ::: "memory");
    __syncthreads();
    if (threadIdx.x == 0) {
        unsigned* bar = b.bar;
        __builtin_amdgcn_s_waitcnt(0);
        unsigned nloc = b.st[0], nx = b.st[1];
        if (nloc == 0u) { xcd_barrier_complete(bar, b.x, nloc, nx); b.st[0] = nloc; b.st[1] = nx; }
        const unsigned old = xb_add(&bar[XB_XSUB(b.x)], 1u);
        const unsigned gen = old / nloc;
        if (old + 1u == (gen + 1u) * nloc) {
            __builtin_amdgcn_fence(__ATOMIC_RELEASE, "agent");
            asm volatile("s_waitcnt vmcnt(0)" ::: "memory");
            const unsigned og = xb_add(&bar[XB_TOP], 1u);
            const unsigned tg = og / nx;
            if (og + 1u == (tg + 1u) * nx) xb_add(&bar[XB_TOPGEN], 1u);
            else XB_SPIN(xb_ld(&bar[XB_TOPGEN]) == tg, bar);
            __builtin_amdgcn_fence(__ATOMIC_ACQUIRE, "agent");
            xb_add(&bar[XB_XGEN(b.x)], 1u);
            asm volatile("s_waitcnt vmcnt(0)" ::: "memory");
        } else {
            XB_SPIN(xb_ld(&bar[XB_XGEN(b.x)]) == gen, bar);
            __builtin_amdgcn_fence(__ATOMIC_ACQUIRE, "agent");
            asm volatile("s_waitcnt vmcnt(0)" ::: "memory");
        }
    }
    __syncthreads();
}

using pg8::Unit; using pg8::u32x4; using pg8::u32x2;
struct EpiInProj {
    static constexpr bool PERM = true;
    bf16 *UF, *CV, *BG, *GA, *GB; const float* b_gate;
    __device__ __forceinline__ void operator()(const f32x4 (&acc)[2][2][4][2], const Unit& u, int wr, int wc, int fr, int fq) const {
        const int row0 = u.pm * 256 + wr * 64 + fr;
        if (u.pn < 2) {
            const int b = u.pm >> 5, s0 = (u.pm & 31) * 256 + wr * 64 + fr;
#pragma unroll
            for (int ai = 0; ai < 2; ++ai)
#pragma unroll
                for (int m = 0; m < 4; ++m) { const int s = s0 + ai * 128 + m * 16;
#pragma unroll
                    for (int bj = 0; bj < 2; ++bj) { const int g4 = (u.pn * 256 + bj * 128 + wc * 32 + 8 * fq) >> 2;
#pragma unroll
                        for (int n = 0; n < 2; ++n) { const f32x4 v = acc[ai][bj][m][n]; u32x2 w; w.x = cvt_pk_bf16(v[0], v[1]); w.y = cvt_pk_bf16(v[2], v[3]);
                            *(u32x2*)(UF + ((size_t)(b * 128 + g4 + n) * 8192 + s) * 4) = w; } } }
        } else if (u.pn < 10) {
#pragma unroll
            for (int ai = 0; ai < 2; ++ai)
#pragma unroll
                for (int m = 0; m < 4; ++m) { bf16* rowp = CV + (size_t)(row0 + ai * 128 + m * 16) * D + (u.pn - 2) * 128 + wc * 16 + 4 * fq;
#pragma unroll
                    for (int bj = 0; bj < 2; ++bj) { const f32x4 v = acc[ai][bj][m][0] * acc[ai][bj][m][1]; u32x2 w; w.x = cvt_pk_bf16(v[0], v[1]); w.y = cvt_pk_bf16(v[2], v[3]);
                        *(u32x2*)(rowp + bj * 64) = w; } }
        } else if (u.pn < 14) {
#pragma unroll
            for (int ai = 0; ai < 2; ++ai)
#pragma unroll
                for (int m = 0; m < 4; ++m) { bf16* rowp = BG + (size_t)(row0 + ai * 128 + m * 16) * D + (u.pn - 10) * 256 + wc * 32 + 8 * fq;
#pragma unroll
                    for (int bj = 0; bj < 2; ++bj) { const f32x4 v0 = acc[ai][bj][m][0], v1 = acc[ai][bj][m][1]; u32x4 w; w.x = cvt_pk_bf16(v0[0], v0[1]); w.y = cvt_pk_bf16(v0[2], v0[3]); w.z = cvt_pk_bf16(v1[0], v1[1]); w.w = cvt_pk_bf16(v1[2], v1[3]);
                        *(u32x4*)(rowp + bj * 128) = w; } }
        } else {
            const int colg = (u.pn - 14) * 256 + wc * 32 + 8 * fq;
            bf16* O = (u.pn < 18) ? GA : GB;
            f32x4 bv[2][2];
#pragma unroll
            for (int bj = 0; bj < 2; ++bj)
#pragma unroll
                for (int n = 0; n < 2; ++n) bv[bj][n] = DBG_NOBIAS ? (f32x4){0.f, 0.f, 0.f, 0.f} : *(const f32x4*)(b_gate + colg + bj * 128 + 4 * n);
#pragma unroll
            for (int ai = 0; ai < 2; ++ai)
#pragma unroll
                for (int m = 0; m < 4; ++m) { bf16* rowp = O + (size_t)(row0 + ai * 128 + m * 16) * D + (colg & 1023);
#pragma unroll
                    for (int bj = 0; bj < 2; ++bj) { const f32x4 v0 = acc[ai][bj][m][0] + bv[bj][0], v1 = acc[ai][bj][m][1] + bv[bj][1]; u32x4 w;
                        w.x = cvt_pk_bf16(sigx(v0[0]), sigx(v0[1])); w.y = cvt_pk_bf16(sigx(v0[2]), sigx(v0[3])); w.z = cvt_pk_bf16(sigx(v1[0]), sigx(v1[1])); w.w = cvt_pk_bf16(sigx(v1[2]), sigx(v1[3]));
                        *(u32x4*)(rowp + bj * 128) = w; } }
        }
    }
};
template <int MODE> struct EpiGateMul {
    static constexpr bool PERM = true;
    bf16* O; const bf16* G;
    __device__ __forceinline__ void operator()(const f32x4 (&acc)[2][2][4][2], const Unit& u, int wr, int wc, int fr, int fq) const {
        const int row0 = u.pm * 256 + wr * 64 + fr, col0 = u.pn * 256 + wc * 32 + 8 * fq;
#pragma unroll
        for (int ai = 0; ai < 2; ++ai)
#pragma unroll
            for (int m = 0; m < 4; ++m) { const size_t off = (size_t)(row0 + ai * 128 + m * 16) * D + col0;
#pragma unroll
                for (int bj = 0; bj < 2; ++bj) { const u32x4 gw = *(const u32x4*)(G + off + bj * 128); const f32x4 v0 = acc[ai][bj][m][0], v1 = acc[ai][bj][m][1];
                    float r[8] = {bf_lo(gw.x) * v0[0], bf_hi(gw.x) * v0[1], bf_lo(gw.y) * v0[2], bf_hi(gw.y) * v0[3], bf_lo(gw.z) * v1[0], bf_hi(gw.z) * v1[1], bf_lo(gw.w) * v1[2], bf_hi(gw.w) * v1[3]};
                    if (MODE == 1) { const u32x4 ow = *(const u32x4*)(O + off + bj * 128);
                        r[0] += bf_lo(ow.x); r[1] += bf_hi(ow.x); r[2] += bf_lo(ow.y); r[3] += bf_hi(ow.y); r[4] += bf_lo(ow.z); r[5] += bf_hi(ow.z); r[6] += bf_lo(ow.w); r[7] += bf_hi(ow.w); }
                    u32x4 w; w.x = cvt_pk_bf16(r[0], r[1]); w.y = cvt_pk_bf16(r[2], r[3]); w.z = cvt_pk_bf16(r[4], r[5]); w.w = cvt_pk_bf16(r[6], r[7]);
                    *(u32x4*)(O + off + bj * 128) = w; } }
    }
};
struct EpiResid {
    static constexpr bool PERM = false;
    const float* x; float* out; const float* gate;
    __device__ __forceinline__ void operator()(const f32x4 (&acc)[2][2][4][2], const Unit& u, int wr, int wc, int fr, int fq) const {
        const int row0 = u.pm * 256 + wr * 64 + fr, col0 = u.pn * 256 + wc * 32 + 4 * fq, b = u.pm >> 5;
        f32x4 gv[2][2];
#pragma unroll
        for (int bj = 0; bj < 2; ++bj)
#pragma unroll
            for (int n = 0; n < 2; ++n) gv[bj][n] = *(const f32x4*)(gate + b * 6 * D + col0 + bj * 128 + n * 16);
#pragma unroll
        for (int ai = 0; ai < 2; ++ai)
#pragma unroll
            for (int m = 0; m < 4; ++m) { const size_t off = (size_t)(row0 + ai * 128 + m * 16) * D + col0;
#pragma unroll
                for (int bj = 0; bj < 2; ++bj)
#pragma unroll
                    for (int n = 0; n < 2; ++n) { const f32x4 xv = *(const f32x4*)(x + off + bj * 128 + n * 16); *(f32x4*)(out + off + bj * 128 + n * 16) = xv + gv[bj][n] * acc[ai][bj][m][n]; }
                asm volatile("" ::: "memory"); }
    }
};
struct EpiSwiGLU {
    static constexpr bool PERM = true;
    bf16* HM;
    __device__ __forceinline__ void operator()(const f32x4 (&acc)[2][2][4][2], const Unit& u, int wr, int wc, int fr, int fq) const {
        const int row0 = u.pm * 256 + wr * 64 + fr, col0 = u.pn * 128 + wc * 32 + 8 * fq;
#pragma unroll
        for (int ai = 0; ai < 2; ++ai)
#pragma unroll
            for (int m = 0; m < 4; ++m) { const f32x4 g0 = acc[ai][0][m][0], g1 = acc[ai][0][m][1], u0 = acc[ai][1][m][0], u1 = acc[ai][1][m][1]; u32x4 w;
                w.x = cvt_pk_bf16(silu(g0[0]) * u0[0], silu(g0[1]) * u0[1]); w.y = cvt_pk_bf16(silu(g0[2]) * u0[2], silu(g0[3]) * u0[3]);
                w.z = cvt_pk_bf16(silu(g1[0]) * u1[0], silu(g1[1]) * u1[1]); w.w = cvt_pk_bf16(silu(g1[2]) * u1[2], silu(g1[3]) * u1[3]);
                *(u32x4*)(HM + (size_t)(row0 + ai * 128 + m * 16) * DE + col0) = w; }
    }
};
struct EpiRowScale {
    static constexpr bool PERM = true;
    bf16* Y; const float* val;
    __device__ __forceinline__ void operator()(const f32x4 (&acc)[2][2][4][2], const Unit& u, int wr, int wc, int fr, int fq) const {
        const int row0 = u.pm * 256 + wr * 64 + fr, col0 = u.pn * 256 + wc * 32 + 8 * fq;
#pragma unroll
        for (int ai = 0; ai < 2; ++ai)
#pragma unroll
            for (int m = 0; m < 4; ++m) { const int row = row0 + ai * 128 + m * 16; const float sv = val[row];
#pragma unroll
                for (int bj = 0; bj < 2; ++bj) { const f32x4 v0 = acc[ai][bj][m][0] * sv, v1 = acc[ai][bj][m][1] * sv; u32x4 w; w.x = cvt_pk_bf16(v0[0], v0[1]); w.y = cvt_pk_bf16(v0[2], v0[3]); w.z = cvt_pk_bf16(v1[0], v1[1]); w.w = cvt_pk_bf16(v1[2], v1[3]);
                    *(u32x4*)(Y + (size_t)row * D + col0 + bj * 128) = w; } }
    }
};

struct EpiPlain {
    static constexpr bool PERM = true;
    bf16* O; int ldc;
    __device__ __forceinline__ void operator()(const f32x4 (&acc)[2][2][4][2], const Unit& u, int wr, int wc, int fr, int fq) const {
        const int row0 = u.pm * 256 + wr * 64 + fr, col0 = u.pn * 256 + wc * 32 + 8 * fq;
#pragma unroll
        for (int ai = 0; ai < 2; ++ai)
#pragma unroll
            for (int m = 0; m < 4; ++m) { bf16* rowp = O + (size_t)(row0 + ai * 128 + m * 16) * ldc + col0;
#pragma unroll
                for (int bj = 0; bj < 2; ++bj) { const f32x4 v0 = acc[ai][bj][m][0], v1 = acc[ai][bj][m][1]; u32x4 w; w.x = cvt_pk_bf16(v0[0], v0[1]); w.y = cvt_pk_bf16(v0[2], v0[3]); w.z = cvt_pk_bf16(v1[0], v1[1]); w.w = cvt_pk_bf16(v1[2], v1[3]);
                    *(u32x4*)(rowp + bj * 128) = w; } }
    }
};
__device__ __forceinline__ unsigned f2bf(float f) { unsigned u = __builtin_bit_cast(unsigned, f); return (u + 0x7fffu + ((u >> 16) & 1u)) >> 16; }
__device__ __forceinline__ unsigned pk2(float lo, float hi) { return f2bf(lo) | (f2bf(hi) << 16); }
__device__ __forceinline__ int rowmap_in(int n) {
    if (n < 512) return n;
    if (n < 1536) { const int j = n - 512; return 512 + 8 * (j >> 2) + (j & 3); }
    if (n < 2560) return 2560 + (n - 1536);
    if (n < 3584) { const int j = n - 2560; return 512 + 8 * (j >> 2) + 4 + (j & 3); }
    return n;
}
template <int MAP>
__device__ __forceinline__ void transpose_item(const float* W, int K, int N, bf16* WT, LAS float* scr, int item, int lane) {
    const int nblk = N / 32, kb = item / nblk, nb = item % nblk, k0 = 64 * kb, n0 = 32 * nb;
#pragma unroll 8
    for (int i = 0; i < 32; ++i) { const int kk = 2 * i + (lane >> 5); scr[kk * 33 + (lane & 31)] = W[(size_t)(k0 + kk) * N + n0 + (lane & 31)]; }
    LDS_WAIT(); asm volatile("" ::: "memory");
    const int c = lane & 7;
#pragma unroll
    for (int j = 0; j < 4; ++j) { const int n = (lane >> 3) + 8 * j; const LAS float* s = scr + (8 * c) * 33 + n;
        v4u o; o.x = pk2(s[0 * 33], s[1 * 33]); o.y = pk2(s[2 * 33], s[3 * 33]); o.z = pk2(s[4 * 33], s[5 * 33]); o.w = pk2(s[6 * 33], s[7 * 33]);
        const int ns = n0 + n; int row;
        if (MAP == 0) row = ns; else if (MAP == 1) row = rowmap_in(ns); else if (MAP == 2) row = 256 * (ns >> 7) + (ns & 127); else row = 256 * (ns >> 7) + 128 + (ns & 127);
        *(GAS v4u*)(WT + (size_t)row * K + k0 + 8 * c) = o; }
    LDS_WAIT(); asm volatile("" ::: "memory");
}
__device__ __forceinline__ void wf_item(const float* wf, bf16* WF_T, int item, int lane) {
    const int c = item >> 2, dblk = item & 3, g = c >> 7, j = c & 127, d0 = 256 * dblk + 4 * lane;
    f32x4 ac = {0.f, 0.f, 0.f, 0.f}, as = {0.f, 0.f, 0.f, 0.f};
    for (int m = 0; m < 128; ++m) { const f32x4 wv = *(const GAS f32x4*)(wf + (size_t)(g * 128 + m) * D + d0); const float fr = (float)((m * j) & 127) * (1.0f / 128.0f);
        const float cv = __builtin_amdgcn_cosf(fr), sv = __builtin_amdgcn_sinf(fr); ac += cv * wv; as += sv * wv; }
    const int kv = 8 * (c >> 2) + 2 * (c & 3);
#pragma unroll
    for (int i = 0; i < 4; ++i) *(GAS unsigned*)(WF_T + (size_t)(d0 + i) * D + kv) = pk2(ac[i] * (1.0f / 1024.0f), as[i] * (1.0f / 1024.0f));
}
__device__ __forceinline__ void fc_tables(bf16* Fc1, bf16* Fc2, int gtid, int gthreads) {
    for (int e = gtid; e < 8192 + 65536; e += gthreads) {
        if (e < 8192) { const int j = e & 7, ln = (e >> 3) & 63, kk = (e >> 9) & 1, mt = (e >> 10) & 3, hh = e >> 12, rho = ln & 15;
            const int s1 = 32 * kk + 8 * (ln >> 4) + j, k1 = 32 * hh + 16 * (mt & 1) + 4 * (rho & 3) + (rho >> 2);
            const float fr = (float)((k1 * s1) & 63) * (1.0f / 64.0f); Fc1[e] = (bf16)f2bf((mt >> 1) == 0 ? cospif(2.0f * fr) : -sinpif(2.0f * fr)); }
        else { const int q = e - 8192, j = q & 7, ln = (q >> 3) & 63, kk = (q >> 9) & 7, ro = (q >> 12) & 1, w = q >> 13;
            const int k2 = 16 * w + (ln & 15), kap = 32 * kk + 8 * (ln >> 4) + j, s2 = kap >> 1, ri = kap & 1;
            const float fr = (float)((k2 * s2) & 127) * (1.0f / 128.0f), cv = cospif(2.0f * fr), sv = sinpif(2.0f * fr);
            Fc2[q] = (bf16)f2bf(ro == 0 ? (ri == 0 ? cv : sv) : (ri == 0 ? -sv : cv)); }
    }
}
__device__ __forceinline__ void mod_item(const float* c, const float* w_ada, float* modp, LAS unsigned char* lds, int item, int tid, int wave, int lane) {
    const int cb = item % 24, kq = item / 24, col0 = 256 * cb + 4 * lane;
    f32x4 a0 = {0.f, 0.f, 0.f, 0.f}, a1 = {0.f, 0.f, 0.f, 0.f};
    for (int i = 0; i < 32; ++i) { const int d = 256 * kq + 32 * wave + i; const float c0 = c[d], c1 = c[D + d];
        const f32x4 wv = *(const GAS f32x4*)(w_ada + (size_t)d * 6 * D + col0); a0 += silu(c0) * wv; a1 += silu(c1) * wv; }
    LAS f32x4* red = (LAS f32x4*)lds;
    red[(wave * 2 + 0) * 64 + lane] = a0; red[(wave * 2 + 1) * 64 + lane] = a1;
    __syncthreads();
    { const int b = tid >> 8, cc = tid & 255; const LAS float* rf = (const LAS float*)lds; float s = 0.f;
#pragma unroll
      for (int w = 0; w < 8; ++w) s += rf[((w * 2 + b) * 64) * 4 + cc];
      modp[(size_t)(kq * 2 + b) * 6 * D + 256 * cb + cc] = s; }
    __syncthreads();
}

__device__ __forceinline__ void phase_h(const float* x, const float* g_mix, const float* b_ada, const float* modp, float* mod, bf16* H1, LAS unsigned char* lds, int tid, int wave, int lane, int vcu, int G) {
    LAS float* ga = (LAS float*)lds;
    LAS float* sh = ga + 2 * D;
    for (int i = tid; i < 2 * 2 * D; i += NWAVES * 64) { const int b = i >> 11, j = i & 2047;
        float v = b_ada[j]; for (int q = 0; q < 4; ++q) v += modp[(size_t)(q * 2 + b) * 6 * D + j];
        if (j < D) sh[b * D + j] = v; else ga[b * D + j - D] = g_mix[j - D] * (1.f + v); }
    if (vcu == 0) for (int i = tid; i < 2 * 6 * D; i += NWAVES * 64) { const int b = i / (6 * D), j = i % (6 * D);
        float v = b_ada[j]; for (int q = 0; q < 4; ++q) v += modp[(size_t)(q * 2 + b) * 6 * D + j]; mod[i] = v; }
    __syncthreads();
    const int gw = vcu * NWAVES + wave, NGW = G * NWAVES;
    for (int m = gw; m < M; m += NGW) { const int b = m >> 13;
        const GAS f32x4* xr = (const GAS f32x4*)(x + (size_t)m * D) + lane; f32x4 v[4]; float s = 0.f;
#pragma unroll
        for (int j = 0; j < 4; ++j) { v[j] = xr[64 * j]; s += (v[j].x * v[j].x + v[j].y * v[j].y) + (v[j].z * v[j].z + v[j].w * v[j].w); }
        const float r = rsqrtf(wave_sum(s) * (1.f / D) + RMS_EPS);
        GAS v2u* o8 = (GAS v2u*)(H1 + (size_t)m * D) + lane;
#pragma unroll
        for (int j = 0; j < 4; ++j) { const f32x4 gg = *(const LAS f32x4*)(ga + b * D + 4 * lane + 256 * j), ss = *(const LAS f32x4*)(sh + b * D + 4 * lane + 256 * j); const f32x4 y = v[j] * r * gg + ss;
            v2u w; w.x = cvt_pk_bf16(y.x, y.y); w.y = cvt_pk_bf16(y.z, y.w); o8[64 * j] = w; } }
    __syncthreads();
}
__device__ __forceinline__ void phase_conv(const bf16* CV, const bf16* BG, const float* w_conv, bf16* AB, int wave, int lane, int vcu, int G) {
    const int gw = vcu * NWAVES + wave, NGW = G * NWAVES;
    for (int m = gw; m < M; m += NGW) { const int s = m & (SEQ - 1);
#pragma unroll
        for (int hseg = 0; hseg < 2; ++hseg) { const int ch = hseg * 512 + 8 * lane; const size_t off = (size_t)m * D + ch;
            const v4u c1 = *(const GAS v4u*)(CV + off), bg = *(const GAS v4u*)(BG + off);
            v4u c0 = {0u, 0u, 0u, 0u}, c2 = {0u, 0u, 0u, 0u};
            if (s > 0) c0 = *(const GAS v4u*)(CV + off - D);
            if (s < SEQ - 1) c2 = *(const GAS v4u*)(CV + off + D);
            float w0[8], w1[8], w2[8];
#pragma unroll
            for (int q = 0; q < 2; ++q) { const f32x4 a = *(const GAS f32x4*)(w_conv + ch + 4 * q), b = *(const GAS f32x4*)(w_conv + D + ch + 4 * q), c = *(const GAS f32x4*)(w_conv + 2 * D + ch + 4 * q);
#pragma unroll
                for (int i = 0; i < 4; ++i) { w0[4 * q + i] = a[i]; w1[4 * q + i] = b[i]; w2[4 * q + i] = c[i]; } }
            unsigned ow[4];
#pragma unroll
            for (int q = 0; q < 4; ++q) {
                const float lo = bf_lo(bg[q]) * (w0[2 * q] * bf_lo(c0[q]) + w1[2 * q] * bf_lo(c1[q]) + w2[2 * q] * bf_lo(c2[q]));
                const float hi = bf_hi(bg[q]) * (w0[2 * q + 1] * bf_hi(c0[q]) + w1[2 * q + 1] * bf_hi(c1[q]) + w2[2 * q + 1] * bf_hi(c2[q]));
                ow[q] = cvt_pk_bf16(lo, hi); }
            v4u o; o.x = ow[0]; o.y = ow[1]; o.z = ow[2]; o.w = ow[3];
            *(GAS v4u*)(AB + off) = o; } }
}
__device__ __forceinline__ void phase_h2(const float* x1, const float* g_moe, const float* mod, const float* w_router, const float* b_router, bf16* H2, float* probs,
                                         LAS unsigned char* lds, int tid, int wave, int lane, int vcu, int G) {
    LAS float* wrl = (LAS float*)lds;
    LAS float* ga = wrl + 16384;
    LAS float* sh = ga + 2 * D;
    for (int i = tid; i < D * NE; i += NWAVES * 64) { const int d = i >> 4, e = i & 15, j4 = d >> 8, ln = (d & 255) >> 2, ii = d & 3;
        wrl[((((j4 * 4 + ii) * 4 + (e >> 2)) * 64 + ln) * 4) + (e & 3)] = w_router[i]; }
    for (int i = tid; i < 2 * D; i += NWAVES * 64) { const int b = i >> 10, j = i & 1023; sh[i] = mod[b * 6 * D + 3 * D + j]; ga[i] = g_moe[j] * (1.f + mod[b * 6 * D + 4 * D + j]); }
    __syncthreads();
    float br[NE];
#pragma unroll
    for (int e = 0; e < NE; ++e) br[e] = b_router[e];
    const int gw = vcu * NWAVES + wave, NGW = G * NWAVES;
    for (int m = gw; m < M; m += NGW) { const int b = m >> 13;
        const GAS f32x4* xr = (const GAS f32x4*)(x1 + (size_t)m * D) + lane; f32x4 v[4]; float s = 0.f;
#pragma unroll
        for (int j = 0; j < 4; ++j) { v[j] = xr[64 * j]; s += (v[j].x * v[j].x + v[j].y * v[j].y) + (v[j].z * v[j].z + v[j].w * v[j].w); }
        const float r = rsqrtf(wave_sum(s) * (1.f / D) + RMS_EPS);
        GAS v2u* o8 = (GAS v2u*)(H2 + (size_t)m * D) + lane;
        float lg[NE];
#pragma unroll
        for (int e = 0; e < NE; ++e) lg[e] = 0.f;
#pragma unroll
        for (int j = 0; j < 4; ++j) { const f32x4 gg = *(const LAS f32x4*)(ga + b * D + 4 * lane + 256 * j), ss = *(const LAS f32x4*)(sh + b * D + 4 * lane + 256 * j); const f32x4 y = v[j] * r * gg + ss;
            v2u w; w.x = cvt_pk_bf16(y.x, y.y); w.y = cvt_pk_bf16(y.z, y.w); o8[64 * j] = w;
#pragma unroll
            for (int i = 0; i < 4; ++i)
#pragma unroll
                for (int c = 0; c < 4; ++c) { const f32x4 wv = *(const LAS f32x4*)(wrl + (((j * 4 + i) * 4 + c) * 64 + lane) * 4);
                    lg[4 * c + 0] += y[i] * wv.x; lg[4 * c + 1] += y[i] * wv.y; lg[4 * c + 2] += y[i] * wv.z; lg[4 * c + 3] += y[i] * wv.w; }
            asm volatile("" ::: "memory"); }
        float mx = -3.0e38f;
#pragma unroll
        for (int e = 0; e < NE; ++e) { lg[e] = wave_sum(lg[e]) + br[e]; mx = fmaxf(mx, lg[e]); }
        float sum = 0.f;
#pragma unroll
        for (int e = 0; e < NE; ++e) { lg[e] = expf(lg[e] - mx); sum += lg[e]; }
        const float inv = 1.0f / sum; float mine = 0.f;
#pragma unroll
        for (int e = 0; e < NE; ++e) mine = (lane == e) ? lg[e] * inv : mine;
        if (lane < NE) probs[(size_t)m * NE + lane] = mine; }
    __syncthreads();
}
__device__ __forceinline__ void topk_item(const float* probs, int* idx, float* val, int* slot, LAS unsigned char* lds, int item, int tid, int wave, int lane) {
    const int e = item >> 1, b = item & 1;
    LAS int* red = (LAS int*)lds;
    unsigned p[16];
#pragma unroll
    for (int j = 0; j < 16; ++j) p[j] = __float_as_uint(probs[((size_t)b * SEQ + 16 * tid + j) * NE + e]);
    unsigned prefix = 0u;
    for (int bit = 30; bit >= 0; --bit) { const unsigned cand = prefix | (1u << bit); int cnt = 0;
#pragma unroll
        for (int j = 0; j < 16; ++j) cnt += (p[j] >= cand) ? 1 : 0;
#pragma unroll
        for (int o = 1; o < 64; o <<= 1) cnt += __shfl_xor(cnt, o);
        const int par = bit & 1;
        if (lane == 0) red[par * 8 + wave] = cnt;
        __syncthreads();
        int tot = 0;
#pragma unroll
        for (int w = 0; w < 8; ++w) tot += red[par * 8 + w];
        if (tot >= CAP) prefix = cand; }
    const unsigned T = prefix;
    int cgt = 0, ceq = 0;
#pragma unroll
    for (int j = 0; j < 16; ++j) { cgt += (p[j] > T) ? 1 : 0; ceq += (p[j] == T) ? 1 : 0; }
    int sgt = cgt, seq = ceq;
#pragma unroll
    for (int o = 1; o < 64; o <<= 1) { const int a = __shfl_up(sgt, o), c = __shfl_up(seq, o); if (lane >= o) { sgt += a; seq += c; } }
    __syncthreads();
    if (lane == 63) { red[32 + wave] = sgt; red[48 + wave] = seq; }
    __syncthreads();
    int bgt = 0, beq = 0, totgt = 0;
#pragma unroll
    for (int w = 0; w < 8; ++w) { const int a = red[32 + w], c = red[48 + w]; if (w < wave) { bgt += a; beq += c; } totgt += a; }
    int rgt = bgt + sgt - cgt, req = beq + seq - ceq;
    const int need = CAP - totgt; const int rbase = (e * 2 + b) * CAP;
#pragma unroll
    for (int j = 0; j < 16; ++j) { const int tok = b * SEQ + 16 * tid + j; int sl = -1;
        if (p[j] > T) { sl = rgt; ++rgt; } else if (p[j] == T) { if (req < need) sl = totgt + req; ++req; }
        slot[(size_t)tok * NE + e] = sl;
        if (sl >= 0) { idx[rbase + sl] = tok; val[rbase + sl] = __uint_as_float(p[j]); } }
    __syncthreads();
}
__device__ __forceinline__ void phase_gather(const bf16* H2, const int* idx, bf16* XE, int wave, int lane, int vcu, int G) {
    const int gw = vcu * NWAVES + wave, NGW = G * NWAVES;
    for (int r = gw; r < MR; r += NGW) { const int tok = idx[r];
        const GAS v4u* src = (const GAS v4u*)(H2 + (size_t)tok * D) + lane; GAS v4u* dst = (GAS v4u*)(XE + (size_t)r * D) + lane;
        const v4u a = src[0], b2 = src[64]; dst[0] = a; dst[64] = b2; }
}
__device__ __forceinline__ void phase_final(float* out, const bf16* Y, const int* slot, const float* mod, const float* g_fin, int wave, int lane, int vcu, int G) {
    const int gw = vcu * NWAVES + wave, NGW = G * NWAVES;
    for (int m = gw; m < M; m += NGW) { const int b = m >> 13;
        GAS f32x4* xr = (GAS f32x4*)(out + (size_t)m * D) + lane; f32x4 v[4], a[4];
#pragma unroll
        for (int j = 0; j < 4; ++j) { v[j] = xr[64 * j]; a[j] = (f32x4){0.f, 0.f, 0.f, 0.f}; }
        for (int e = 0; e < NE; ++e) { const int sl = __builtin_amdgcn_readfirstlane(slot[(size_t)m * NE + e]);
            if (sl >= 0) { const GAS v2u* yr = (const GAS v2u*)(Y + ((size_t)(e * 2 + b) * CAP + sl) * D) + lane;
#pragma unroll
                for (int j = 0; j < 4; ++j) { const v2u w = yr[64 * j]; a[j].x += bf_lo(w.x); a[j].y += bf_hi(w.x); a[j].z += bf_lo(w.y); a[j].w += bf_hi(w.y); } } }
        float s = 0.f;
#pragma unroll
        for (int j = 0; j < 4; ++j) { const f32x4 gf = *(const GAS f32x4*)(mod + b * 6 * D + 5 * D + 4 * lane + 256 * j); v[j] = v[j] + gf * a[j]; s += (v[j].x * v[j].x + v[j].y * v[j].y) + (v[j].z * v[j].z + v[j].w * v[j].w); }
        const float r = rsqrtf(wave_sum(s) * (1.f / D) + RMS_EPS);
#pragma unroll
        for (int j = 0; j < 4; ++j) { const f32x4 gg = *(const GAS f32x4*)(g_fin + 4 * lane + 256 * j); xr[64 * j] = v[j] * r * gg; } }
}
__device__ __forceinline__ void fft_item(LAS unsigned char* lds, const bf16* UF, bf16* ZF, const bf16* Fc1, const bf16* Fc2, int item, int wave, int lane) {
    const char* slab = (const char*)UF + (size_t)item * 65536;
    { v4u xv[8];
#pragma unroll
      for (int p = 0; p < 8; ++p) { const int s1 = 8 * p + wave; xv[p] = *(const GAS v4u*)(slab + s1 * 1024 + ((16 * lane - 32 * ((s1 >> 3) & 3)) & 1023)); }
#pragma unroll
      for (int p = 0; p < 8; ++p) *(LAS v4u*)(lds + (8 * p + wave) * 1024 + 16 * lane) = xv[p]; }
    bf16x8 A2[2][8];
#pragma unroll
    for (int ro = 0; ro < 2; ++ro)
#pragma unroll
        for (int kk = 0; kk < 8; ++kk) A2[ro][kk] = *(const GAS bf16x8*)(Fc2 + ((size_t)(((wave * 2 + ro) * 8 + kk) * 64 + lane)) * 8);
    LDS_WAIT(); __syncthreads();
    const int fr = lane & 15, fq = lane >> 4, ch = lane & 3, s2l = (lane & 15) >> 2;
    char* zb = (char*)ZF + (size_t)item * 131072;
    for (int hh = 0; hh < 2; ++hh) {
        { bf16x8 A1[4][2];
#pragma unroll
          for (int mt = 0; mt < 4; ++mt)
#pragma unroll
              for (int kk = 0; kk < 2; ++kk) A1[mt][kk] = *(const GAS bf16x8*)(Fc1 + ((size_t)(((hh * 4 + mt) * 2 + kk) * 64 + lane)) * 8);
          for (int jn = 0; jn < 4; ++jn) { const int nt = wave + 8 * jn, s2 = 4 * nt + s2l;
            bf16x8 Bx[2];
#pragma unroll
            for (int kk = 0; kk < 2; ++kk)
#pragma unroll
                for (int j = 0; j < 8; ++j) { const int s1 = 32 * kk + 8 * fq + j; Bx[kk][j] = *(const LAS short*)(lds + s1 * 1024 + ((s2 * 8 + ch * 2 + 32 * fq) & 1023)); }
            f32x4 acc[4];
#pragma unroll
            for (int mt = 0; mt < 4; ++mt) { acc[mt] = (f32x4){0.f, 0.f, 0.f, 0.f};
#pragma unroll
                for (int kk = 0; kk < 2; ++kk) acc[mt] = __builtin_amdgcn_mfma_f32_16x16x32_bf16(A1[mt][kk], Bx[kk], acc[mt], 0, 0, 0); }
#pragma unroll
            for (int blk = 0; blk < 2; ++blk)
#pragma unroll
                for (int r = 0; r < 4; ++r) { const int k1l = 16 * blk + 4 * r + fq, k1 = 32 * hh + k1l; const float dr = acc[blk][r], di = acc[2 + blk][r];
                    const float frac = (float)((s2 * k1) & 8191) * (1.0f / 8192.0f), c = __builtin_amdgcn_cosf(frac), s = __builtin_amdgcn_sinf(frac);
                    *(LAS unsigned*)(lds + FFT_TOFF + (k1l * 4 + ch) * FFT_TPITCH + s2 * 4) = cvt_pk_bf16(dr * c + di * s, di * c - dr * s); } } }
        LDS_WAIT(); __syncthreads();
        for (int nt2 = 0; nt2 < 8; ++nt2) { f32x4 c0 = {0.f, 0.f, 0.f, 0.f}, c1 = {0.f, 0.f, 0.f, 0.f};
#pragma unroll
            for (int kk = 0; kk < 8; ++kk) { const bf16x8 Bt = *(const LAS bf16x8*)(lds + FFT_TOFF + (16 * nt2 + fr) * FFT_TPITCH + kk * 64 + fq * 16);
                c0 = __builtin_amdgcn_mfma_f32_16x16x32_bf16(A2[0][kk], Bt, c0, 0, 0, 0); c1 = __builtin_amdgcn_mfma_f32_16x16x32_bf16(A2[1][kk], Bt, c1, 0, 0, 0); }
            const int k1 = 32 * hh + 4 * nt2 + s2l;
#pragma unroll
            for (int r = 0; r < 4; ++r) { const int k = k1 + 64 * (16 * wave + 4 * fq + r); *(GAS unsigned*)(zb + (size_t)k * 16 + ch * 4) = cvt_pk_bf16(c0[r], c1[r]); } }
        LDS_WAIT(); __syncthreads();
    }
}
constexpr int NPHASE = 12;
#ifndef DBG_PLAIN
#define DBG_PLAIN 0
#endif
#ifndef GALIGN
#define GALIGN true
#endif
#ifndef GSP2
#define GSP2 true
#endif
struct Args { const float* in[18]; float* out; unsigned char* ws; int ph_lo, ph_hi; };
__global__ void __launch_bounds__(NWAVES * 64, 2) fwd(Args args) {
    extern __shared__ __attribute__((aligned(16))) unsigned char lds_raw[];
    LAS unsigned char* lds = (LAS unsigned char*)lds_raw;
    volatile LAS unsigned* MISC = (volatile LAS unsigned*)(lds + MISC_OFF);
    const int tid = threadIdx.x, lane = tid & 63, wave = __builtin_amdgcn_readfirstlane(tid >> 6);
    const int G = gridDim.x; const int bx = blockIdx.x; const int vcu = (G % 8 == 0) ? (bx % 8) * (G / 8) + bx / 8 : bx;
    unsigned char* ws = args.ws;
    const float *x = args.in[0], *c = args.in[1], *w_ada = args.in[2], *b_ada = args.in[3], *g_mix = args.in[4], *w_in = args.in[5], *b_gate = args.in[6], *w_f = args.in[7], *w_conv = args.in[8],
                *w_co = args.in[9], *w_o = args.in[10], *g_moe = args.in[11], *w_r = args.in[12], *b_r = args.in[13], *w_g = args.in[14], *w_u = args.in[15], *w_d = args.in[16], *g_fin = args.in[17];
    float* out = args.out;
    float *modp = (float*)(ws + WS_MODP), *mod = (float*)(ws + WS_MOD), *probs = (float*)(ws + WS_PROBS), *val = (float*)(ws + WS_VAL);
    int *slot = (int*)(ws + WS_SLOT), *idx = (int*)(ws + WS_IDX);
    bf16 *Fc1 = (bf16*)(ws + WS_FC1), *Fc2 = (bf16*)(ws + WS_FC2), *WIN = (bf16*)(ws + WS_WIN), *WF = (bf16*)(ws + WS_WF), *WCO = (bf16*)(ws + WS_WCO), *WO = (bf16*)(ws + WS_WO), *WGU = (bf16*)(ws + WS_WGU), *WD = (bf16*)(ws + WS_WD);
    bf16 *H1 = (bf16*)(ws + WS_H1), *AB = (bf16*)(ws + WS_AB), *UF = (bf16*)(ws + WS_UF), *CV = (bf16*)(ws + WS_CV), *BG = (bf16*)(ws + WS_BG), *GA = (bf16*)(ws + WS_GA), *GB = (bf16*)(ws + WS_GB), *ZF = (bf16*)(ws + WS_ZF),
         *TZ = (bf16*)(ws + WS_TZ), *H2 = (bf16*)(ws + WS_H2), *HM = (bf16*)(ws + WS_HM), *Y = (bf16*)(ws + WS_Y), *XE = (bf16*)(ws + WS_XE);
    for (int u = tid; u < (LDS_BYTES - MISC_OFF) / 4; u += NWAVES * 64) ((LAS unsigned*)(lds + MISC_OFF))[u] = 0u;
    __syncthreads();
    const int lo = args.ph_lo, hi = args.ph_hi;
    XcdBarrier bar; bar.bar = (unsigned*)(ws + WS_CTL) + CW_BAR; bar.x = 0; bar.st = nullptr;
    if (hi - lo > 1) bar = xcd_barrier_post((unsigned*)(ws + WS_CTL) + CW_BAR, MISC + 8);
#define IN(k) (lo <= (k) && (k) < hi)
#define GRID_BAR(k) do { if (IN(k) && IN((k) + 1)) xcd_barrier(bar); } while (0)
    const int gw = vcu * NWAVES + wave, NGW = G * NWAVES;

    if (IN(0)) {
        if (vcu < 96) mod_item(c, w_ada, modp, lds, vcu, tid, wave, lane);
        fc_tables(Fc1, Fc2, vcu * NWAVES * 64 + tid, G * NWAVES * 64);
        LAS float* scr = (LAS float*)(lds + wave * 16384);
        constexpr int I_WF = 2048, I_IN = 16 * 176, I_SQ = 16 * 32, I_EX = 3072, NITEMS = I_WF + I_IN + 2 * I_SQ + NE * I_EX;
        for (int it = gw; it < NITEMS; it += NGW) {
            int r = it;
            if (r < I_WF) { wf_item(w_f, WF, r, lane); continue; } r -= I_WF;
            if (r < I_IN) { transpose_item<1>(w_in, D, DIN, WIN, scr, r, lane); continue; } r -= I_IN;
            if (r < I_SQ) { transpose_item<0>(w_co, D, D, WCO, scr, r, lane); continue; } r -= I_SQ;
            if (r < I_SQ) { transpose_item<0>(w_o, D, D, WO, scr, r, lane); continue; } r -= I_SQ;
            const int e = r / I_EX, q = r % I_EX;
            if (q < 1024) transpose_item<2>(w_g + (size_t)e * D * DE, D, DE, WGU + (size_t)e * 4096 * D, scr, q, lane);
            else if (q < 2048) transpose_item<3>(w_u + (size_t)e * D * DE, D, DE, WGU + (size_t)e * 4096 * D, scr, q - 1024, lane);
            else transpose_item<0>(w_d + (size_t)e * DE * D, DE, D, WD + (size_t)e * D * DE, scr, q - 2048, lane);
        }
        GRID_BAR(0);
    }
    if (IN(1)) { phase_h(x, g_mix, b_ada, modp, mod, H1, lds, tid, wave, lane, vcu, G); GRID_BAR(1); }
    if (IN(2)) {
        pg8::Gemm g{H1, WIN, M, DIN, D, 0, 0}; pg8::StaticOrder S; S.init(M, DIN, G, bx);
#if DBG_PLAIN
        EpiPlain E{UF, DIN};
        pg8::gemm_phase<EpiPlain, pg8::StaticOrder, 0, GALIGN, GSP2>(lds, g, S, E);
#else
        EpiInProj E{UF, CV, BG, GA, GB, b_gate};
        pg8::gemm_phase<EpiInProj, pg8::StaticOrder, 0, GALIGN, GSP2>(lds, g, S, E);
#endif
        GRID_BAR(2);
    }
    if (IN(3)) {
        for (int it = vcu; it < BATCH * 128; it += G) fft_item(lds, UF, ZF, Fc1, Fc2, it, wave, lane);
        phase_conv(CV, BG, w_conv, AB, wave, lane, vcu, G);
        GRID_BAR(3);
    }
    if (IN(4)) {
        { pg8::Gemm g{ZF, WF, M, D, D, 0, 0}; pg8::StaticOrder S; S.init(M, D, G, bx); EpiGateMul<0> E{TZ, GA};
          pg8::gemm_phase<EpiGateMul<0>, pg8::StaticOrder, 1, true, true>(lds, g, S, E); }
        { pg8::Gemm g{AB, WCO, M, D, D, 0, 0}; pg8::StaticOrder S; S.init(M, D, G, bx); EpiGateMul<1> E{TZ, GB};
          pg8::gemm_phase<EpiGateMul<1>, pg8::StaticOrder, 0, true, true>(lds, g, S, E); }
        GRID_BAR(4);
    }
    if (IN(5)) {
        pg8::Gemm g{TZ, WO, M, D, D, 0, 0}; pg8::StaticOrder S; S.init(M, D, G, bx); EpiResid E{x, out, mod + 2 * D};
        pg8::gemm_phase<EpiResid, pg8::StaticOrder, 0, true, true>(lds, g, S, E);
        GRID_BAR(5);
    }
    if (IN(6)) { phase_h2(out, g_moe, mod, w_r, b_r, H2, probs, lds, tid, wave, lane, vcu, G); GRID_BAR(6); }
    if (IN(7)) { for (int it = vcu; it < NE * BATCH; it += G) topk_item(probs, idx, val, slot, lds, it, tid, wave, lane); GRID_BAR(7); }
    if (IN(8)) { phase_gather(H2, idx, XE, wave, lane, vcu, G); GRID_BAR(8); }
    if (IN(9)) {
        pg8::Gemm g{XE, WGU, MR, 2 * DE, D, 8, (size_t)2 * DE * D}; pg8::StaticOrder S; S.init(MR, 2 * DE, G, bx); EpiSwiGLU E{HM};
        pg8::gemm_phase<EpiSwiGLU, pg8::StaticOrder, 0, true, true>(lds, g, S, E);
        GRID_BAR(9);
    }
    if (IN(10)) {
        pg8::Gemm g{HM, WD, MR, D, DE, 8, (size_t)D * DE}; pg8::StaticOrder S; S.init(MR, D, G, bx); EpiRowScale E{Y, val};
        pg8::gemm_phase<EpiRowScale, pg8::StaticOrder, 0, true, true>(lds, g, S, E);
        GRID_BAR(10);
    }
    if (IN(11)) phase_final(out, Y, slot, mod, g_fin, wave, lane, vcu, G);
#undef IN
#undef GRID_BAR
}


struct DumpArgs { const unsigned short* p[8]; unsigned long long n[8]; int f32[8]; int nb; int pad; };
__global__ void k_dump(float* out, DumpArgs a) {
    const size_t i = (size_t)blockIdx.x * blockDim.x + threadIdx.x; float s = 0.f;
    for (int b = 0; b < a.nb; ++b) for (size_t j = i; j < a.n[b]; j += (size_t)M * D) s += (a.f32[b] ? ((const float*)a.p[b])[j] : __uint_as_float(((unsigned)a.p[b][j]) << 16)) * (float)(b + 1);
    out[i] = s;
}
#ifndef DUMP_WHICH
#define DUMP_WHICH -1
#endif
#ifndef STOP_AFTER
#define STOP_AFTER (NPHASE - 1)
#endif
#ifndef MK_PER_PHASE
#define MK_PER_PHASE 0
#endif
extern "C" void kernel_launch(void* const* d_in, const int* in_sizes, int n_in, void* d_out, int out_size, void* d_ws, size_t ws_size, hipStream_t stream) {
    static int grid = 0;
    if (grid == 0) {
        if (n_in != 18 || in_sizes[0] != M * D || out_size != M * D || ws_size < WS_END) { fprintf(stderr, "kernel_launch: unexpected shapes (n_in %d, in0 %d, out %d, ws %zu); nothing launched\n", n_in, n_in > 0 ? in_sizes[0] : -1, out_size, ws_size); grid = -1; return; }
        int dev = 0, cus = 0, per_cu = 0;
        if (hipGetDevice(&dev) != hipSuccess || hipDeviceGetAttribute(&cus, hipDeviceAttributeMultiprocessorCount, dev) != hipSuccess) { grid = -1; return; }
        if (hipFuncSetAttribute((const void*)fwd, hipFuncAttributeMaxDynamicSharedMemorySize, LDS_BYTES) != hipSuccess) { fprintf(stderr, "kernel_launch: hipFuncSetAttribute failed\n"); grid = -1; return; }
        if (hipOccupancyMaxActiveBlocksPerMultiprocessor(&per_cu, (const void*)fwd, NWAVES * 64, LDS_BYTES) != hipSuccess || per_cu < 1) { fprintf(stderr, "kernel_launch: occupancy query reports %d blocks per CU\n", per_cu); }
        (void)hipGetLastError();
        grid = cus;
    }
    if (grid < 0) return;
    (void)hipMemsetAsync((char*)d_ws + WS_CTL, 0, CTL_ZERO_BYTES, stream);
    Args a{};
    for (int i = 0; i < 18; ++i) a.in[i] = (const float*)d_in[i];
    a.out = (float*)d_out; a.ws = (unsigned char*)d_ws;
#if MK_PER_PHASE
    for (int p = 0; p < STOP_AFTER + 1; ++p) { a.ph_lo = p; a.ph_hi = p + 1; hipLaunchKernelGGL(fwd, dim3(grid), dim3(NWAVES * 64), LDS_BYTES, stream, a); }
#if DUMP_WHICH >= 0
    { DumpArgs da{}; unsigned char* w = (unsigned char*)d_ws; int nb = 0;
      auto add = [&](size_t off, size_t n, int isf = 0) { da.p[nb] = (const unsigned short*)(w + off); da.n[nb] = n; da.f32[nb] = isf; ++nb; };
      if (DUMP_WHICH == 0) { add(WS_WIN, (size_t)DIN * D); add(WS_WF, (size_t)D * D); add(WS_WCO, (size_t)D * D); add(WS_WO, (size_t)D * D); add(WS_WGU, (size_t)NE * 4096 * D); add(WS_WD, (size_t)NE * D * DE); add(WS_FC1, 8192 + 0); add(WS_MODP, 4 * 2 * 6 * D, 1); }
      if (DUMP_WHICH == 1) { add(WS_H1, (size_t)M * D); add(WS_MOD, 2 * 6 * D, 1); add(WS_FC2, 65536); }
      if (DUMP_WHICH == 2) { add(WS_UF, (size_t)M * DF); add(WS_CV, (size_t)M * D); add(WS_BG, (size_t)M * D); add(WS_GA, (size_t)M * D); add(WS_GB, (size_t)M * D); }
      if (DUMP_WHICH == 5) { add(WS_UF, (size_t)M * DIN); }
      if (DUMP_WHICH == 6) { add(WS_UF, (size_t)M * DF); add(WS_CV, (size_t)M * D); }
      if (DUMP_WHICH == 7) { add(WS_BG, (size_t)M * D); }
      if (DUMP_WHICH == 8) { add(WS_GA, (size_t)M * D); add(WS_GB, (size_t)M * D); }
      if (DUMP_WHICH == 9) { add(WS_GA, (size_t)M * D); }
      if (DUMP_WHICH == 10) { add(WS_GB, (size_t)M * D); }
      if (DUMP_WHICH == 3) { add(WS_ZF, (size_t)M * D); add(WS_AB, (size_t)M * D); }
      if (DUMP_WHICH == 4) { add(WS_TZ, (size_t)M * D); }
      da.nb = nb; hipLaunchKernelGGL(k_dump, dim3(M * D / 256), dim3(256), 0, stream, (float*)d_out, da); }
#endif
#else
    a.ph_lo = 0; a.ph_hi = NPHASE; hipLaunchKernelGGL(fwd, dim3(grid), dim3(NWAVES * 64), LDS_BYTES, stream, a);
#endif
}
```

```cpp
#include <hip/hip_runtime.h>
#include <cstdio>
#include <cstdint>
#define MK_PER_PHASE 0
#define STOP_AFTER 11
#define DUMP_WHICH -1
#define GALIGN true
#define GSP2 true
#define DBG_PLAIN 0
#define DBG_NOBIAS 0
#define DBG_NOSIG 0
#define PROBE_I -1
#define PROBE_J -1
#define DOUBLE_PH -1
#define STAGGER_US 0
#define EXTRA_BARS 0
#define DBG_EPI2 0
#ifndef DBG_EPI2
#define DBG_EPI2 0
#endif
namespace pg8 {
#define PG8_LAS __attribute__((address_space(3)))
typedef unsigned short bf16_t;
typedef short bf16x8 __attribute__((ext_vector_type(8)));
typedef float f32x4 __attribute__((ext_vector_type(4)));
typedef unsigned u32x4 __attribute__((ext_vector_type(4)));
typedef unsigned u32x2 __attribute__((ext_vector_type(2)));
typedef int v8i __attribute__((ext_vector_type(8)));
typedef int v4i __attribute__((ext_vector_type(4)));
constexpr int BM = 256, BK = 64, HALF = 128, HTB = HALF * BK * 2  , STAGE_BYTES = 8 * HTB, NXCD = 8, WGM = 8;

__host__ __device__ __forceinline__ int lds_byte(int r, int c) { const int st = (r >> 4) * 2 + (c >> 5), rr = r & 15, cc = c & 31, ob = rr * 64 + cc * 2; return st * 1024 + (ob ^ (((ob >> 9) & 1) << 5)); }
__host__ __device__ __forceinline__ void stage_rc(int b, int& R, int& C) { const int st = b / 1024, sb = b % 1024, swz = sb ^ (((sb >> 9) & 1) << 5); R = (st >> 1) * 16 + swz / 64; C = (st & 1) * 32 + (swz % 64) / 2; }
__host__ __device__ __forceinline__ int perm32(int rho) { const int n = rho >> 4, i = rho & 15; return 8 * (i >> 2) + 4 * n + (i & 3); }

struct Unit { int pm, pn; };
struct Gemm { const bf16_t* A; const bf16_t* Bt; int M, N, K; int bgrp; size_t bstride; const int* gidx; };

struct StaticOrder {
    int nM, nN, nwg, G, c;
    __host__ __device__ void init(int M, int N, int G_, int c_) { nM = M / BM; nN = N / BM; nwg = nM * nN; G = G_; c = c_; }
    __host__ __device__ bool next(int i, Unit& u) const {
        const long L = (long)i * G + c; if (L >= nwg) return false;
        int wgid = (int)L; { const int q = nwg / NXCD, r = nwg % NXCD, xcd = wgid % NXCD, off = wgid / NXCD; wgid = (xcd < r ? xcd * (q + 1) : r * (q + 1) + (xcd - r) * q) + off; }
        const int nig = WGM * nN, gid = wgid / nig, fm = gid * WGM, gsz = (nM - fm) < WGM ? (nM - fm) : WGM;
        u.pm = fm + ((wgid % nig) % gsz); u.pn = (wgid % nig) / gsz; return true;
    }
    __device__ __forceinline__ void a_ready(const Unit&) const {}
    __device__ __forceinline__ void done(const Unit&) const {}
};

typedef __bf16 bf16x2_t __attribute__((ext_vector_type(2)));
typedef float f32x2_t __attribute__((ext_vector_type(2)));
__device__ __forceinline__ unsigned cvt_pk_bf16(float lo, float hi) { const f32x2_t v = {lo, hi}; const bf16x2_t b = __builtin_convertvector(v, bf16x2_t); return __builtin_bit_cast(unsigned, b); }
__device__ __forceinline__ float bf_lo(unsigned w) { return __uint_as_float(w << 16); }
__device__ __forceinline__ float bf_hi(unsigned w) { return __uint_as_float(w & 0xffff0000u); }
__device__ __forceinline__ float sigm(float v) { return __builtin_amdgcn_rcpf(1.0f + __expf(-v)); }


template <class Epi, class Sched, int AMODE, bool ALIGN_EPI, bool SP2, bool F8 = false>
__device__ __forceinline__ void gemm_phase(PG8_LAS unsigned char* lds, const Gemm g, const Sched& S, const Epi& E) {
    const int tid = threadIdx.x, wid = __builtin_amdgcn_readfirstlane(tid >> 6), lane = tid & 63, wr = wid >> 2, wc = wid & 3, fr = lane & 15, fq = lane >> 4;
    const int K = g.K, nt = K / BK;
    unsigned voffA0[2], voffA1[2], voffB[2]; int gR[2], gC2[2];
#pragma unroll
    for (int i = 0; i < 2; ++i) { int R, C; stage_rc(tid * 16 + i * 8192, R, C); const int Rb = Epi::PERM ? ((R & ~31) + perm32(R & 31)) : R;
        voffB[i] = (unsigned)(Rb * K + C) * 2u; gR[i] = R; gC2[i] = C * 2;
        if (AMODE == 0) { voffA0[i] = (unsigned)(R * K + C) * 2u; voffA1[i] = (unsigned)((R + HALF) * K + C) * 2u; }
        else if (AMODE == 1) { voffA0[i] = (unsigned)((C >> 3) * 8192 + R) * 16u; voffA1[i] = voffA0[i] + (unsigned)HALF * 16u; }
        else { voffA0[i] = 0u; voffA1[i] = 0u; } }
    const size_t kstepB = (size_t)(BK * 2);
    const size_t kstepA = (AMODE == 1) ? (size_t)8 * 8192 * 16 : (size_t)(BK * 2);
    int nidx0[2] = {0, 0}, nidx1[2] = {0, 0}; unsigned voffN0[2] = {0u, 0u}, voffN1[2] = {0u, 0u};
#define PG8_GIDX_LOAD(u) do { if (AMODE == 2) { _Pragma("unroll") for (int _i = 0; _i < 2; ++_i) { \
        const int* _p0 = g.gidx + (size_t)(u).pm * BM + gR[_i]; const int* _p1 = _p0 + HALF; \
        asm volatile("global_load_dword %0, %1, off" : "=v"(nidx0[_i]) : "v"(_p0) : "memory"); asm volatile("global_load_dword %0, %1, off" : "=v"(nidx1[_i]) : "v"(_p1) : "memory"); } } } while (0)
#define PG8_GIDX_USE() do { if (AMODE == 2) { _Pragma("unroll") for (int _i = 0; _i < 2; ++_i) { asm volatile("" : "+v"(nidx0[_i]), "+v"(nidx1[_i])); \
        voffN0[_i] = (unsigned)nidx0[_i] * (unsigned)(K * 2) + (unsigned)gC2[_i]; voffN1[_i] = (unsigned)nidx1[_i] * (unsigned)(K * 2) + (unsigned)gC2[_i]; } } } while (0)
    const size_t hstepB = (size_t)HALF * K * 2;
    const size_t tstepB = 2 * hstepB;
    const unsigned ldsw = (unsigned)wid * 1024u;
    const int aoff = lds_byte(wr * 64 + fr, fq * 8), boff = lds_byte(wc * 32 + fr, fq * 8);
    const int aoff8a = lds_byte(wr * 64 + fr, fq * 16), boff8a = lds_byte(wc * 32 + fr, fq * 16);
#define PG8_ABASE(u) ((const char*)g.A + ((AMODE == 2) ? (size_t)0 : (AMODE == 0) ? (size_t)(u).pm * (size_t)BM * K * 2 : (size_t)((u).pm >> 5) * ((size_t)(K >> 3) * 8192 * 16) + (size_t)((u).pm & 31) * (BM * 16)))
#define PG8_BBASE(u) ((const char*)g.Bt + (g.bgrp ? (size_t)((u).pm / g.bgrp) * g.bstride * 2 : (size_t)0) + (size_t)(u).pn * tstepB)
#define PG8_SA(b, h) (((b) * 2 + (h)) * HTB)
#define PG8_SB(b, h) ((4 + (b) * 2 + (h)) * HTB)
#define PG8_STAGE(bufoff, gbase, voff) do { _Pragma("unroll") for (int _i = 0; _i < 2; ++_i) \
        __builtin_amdgcn_global_load_lds((const unsigned*)((const char*)(gbase) + (voff)[_i]), (PG8_LAS unsigned*)(lds + (bufoff) + ldsw + _i * 8192), 16, 0, 0); } while (0)
#define PG8_LDA16(dst, b, h) do { _Pragma("unroll") for (int m = 0; m < 4; ++m) _Pragma("unroll") for (int k = 0; k < 2; ++k) dst[m][k] = *(const PG8_LAS bf16x8*)(lds + PG8_SA(b, h) + aoff + m * 2048 + k * 1024); } while (0)
#define PG8_LDB16(dst, b, h) do { _Pragma("unroll") for (int n = 0; n < 2; ++n) _Pragma("unroll") for (int k = 0; k < 2; ++k) dst[n][k] = *(const PG8_LAS bf16x8*)(lds + PG8_SB(b, h) + boff + n * 2048 + k * 1024); } while (0)
#define PG8_MMA16(ai, bj, At, Bt) do { __builtin_amdgcn_s_setprio(1); _Pragma("unroll") for (int m = 0; m < 4; ++m) _Pragma("unroll") for (int n = 0; n < 2; ++n) _Pragma("unroll") for (int k = 0; k < 2; ++k) \
        acc[ai][bj][m][n] = __builtin_amdgcn_mfma_f32_16x16x32_bf16(Bt[n][k], At[m][k], acc[ai][bj][m][n], 0, 0, 0); __builtin_amdgcn_s_setprio(0); } while (0)
#define PG8_LDA8(dst, b, h) do { _Pragma("unroll") for (int m = 0; m < 4; ++m) { const v4i lo_ = *(const PG8_LAS v4i*)(lds + PG8_SA(b, h) + aoff8a + m * 2048), hi_ = *(const PG8_LAS v4i*)(lds + PG8_SA(b, h) + aoff8a + m * 2048 + 16); \
        dst[m] = (v8i){lo_.x, lo_.y, lo_.z, lo_.w, hi_.x, hi_.y, hi_.z, hi_.w}; } } while (0)
#define PG8_LDB8(dst, b, h) do { _Pragma("unroll") for (int n = 0; n < 2; ++n) { const v4i lo_ = *(const PG8_LAS v4i*)(lds + PG8_SB(b, h) + boff8a + n * 2048), hi_ = *(const PG8_LAS v4i*)(lds + PG8_SB(b, h) + boff8a + n * 2048 + 16); \
        dst[n] = (v8i){lo_.x, lo_.y, lo_.z, lo_.w, hi_.x, hi_.y, hi_.z, hi_.w}; } } while (0)
#define PG8_MMA8(ai, bj, At, Bt) do { __builtin_amdgcn_s_setprio(1); _Pragma("unroll") for (int m = 0; m < 4; ++m) _Pragma("unroll") for (int n = 0; n < 2; ++n) \
        asm volatile("v_mfma_scale_f32_16x16x128_f8f6f4 %0, %1, %2, %0, %3, %3 op_sel:[0,1,0] op_sel_hi:[0,0,0]" : "+v"(acc[ai][bj][m][n]) : "v"(Bt[n]), "v"(At[m]), "v"(f8scale)); __builtin_amdgcn_s_setprio(0); } while (0)
#define PG8_LDA(dst, b, h) do { if constexpr (F8) PG8_LDA8(dst##8, b, h); else PG8_LDA16(dst, b, h); } while (0)
#define PG8_LDB(dst, b, h) do { if constexpr (F8) PG8_LDB8(dst##8, b, h); else PG8_LDB16(dst, b, h); } while (0)
#define PG8_MMA(ai, bj, At, Bt) do { if constexpr (F8) PG8_MMA8(ai, bj, At##8, Bt##8); else PG8_MMA16(ai, bj, At, Bt); } while (0)
#define PG8_WAIT_V(n) asm volatile("s_waitcnt vmcnt(" #n ")" ::: "memory")
#define PG8_WAIT_L(n) asm volatile("s_waitcnt lgkmcnt(" #n ")" ::: "memory")
#define PG8_BAR __builtin_amdgcn_s_barrier()
#define PG8_SCHED __builtin_amdgcn_sched_barrier(0)
    Unit cur, nxt; int ui = 0;
    if (!S.next(0, cur)) return;
    f32x4 acc[2][2][4][2];
#pragma unroll
    for (int a = 0; a < 2; ++a)
#pragma unroll
        for (int b = 0; b < 2; ++b)
#pragma unroll
            for (int m = 0; m < 4; ++m)
#pragma unroll
                for (int n = 0; n < 2; ++n) acc[a][b][m][n] = (f32x4){0.f, 0.f, 0.f, 0.f};
    bf16x8 At[4][2], B0[2][2], B1[2][2]; v8i At8[4], B08[2], B18[2]; int f8scale = 0x7f7f7f78; asm volatile("" : "+v"(f8scale));
    const char* cA = PG8_ABASE(cur); const char* cB = PG8_BBASE(cur);
    S.a_ready(cur);
    if (AMODE == 2) { PG8_GIDX_LOAD(cur); asm volatile("s_waitcnt vmcnt(0)" ::: "memory"); PG8_GIDX_USE();
#pragma unroll
        for (int i = 0; i < 2; ++i) { voffA0[i] = voffN0[i]; voffA1[i] = voffN1[i]; } }
    if constexpr (SP2) {
        PG8_STAGE(PG8_SB(0, 0), cB, voffB); PG8_STAGE(PG8_SB(0, 1), cB + hstepB, voffB); PG8_STAGE(PG8_SA(0, 0), cA, voffA0); PG8_STAGE(PG8_SA(0, 1), cA, voffA1);
        if (wr == 1) PG8_BAR;
        PG8_WAIT_V(2); PG8_BAR;
        PG8_STAGE(PG8_SB(1, 0), cB + kstepB, voffB); PG8_STAGE(PG8_SA(1, 0), cA + kstepA, voffA0); PG8_STAGE(PG8_SB(1, 1), cB + hstepB + kstepB, voffB);
        PG8_WAIT_V(6); PG8_BAR;
    } else {
        PG8_STAGE(PG8_SB(0, 0), cB, voffB); PG8_STAGE(PG8_SA(0, 0), cA, voffA0); PG8_STAGE(PG8_SB(0, 1), cB + hstepB, voffB); PG8_STAGE(PG8_SA(0, 1), cA, voffA1);
        if (wr == 1) PG8_BAR;
        PG8_WAIT_V(4); PG8_BAR;
        PG8_STAGE(PG8_SB(1, 0), cB + kstepB, voffB); PG8_STAGE(PG8_SA(1, 0), cA + kstepA, voffA0); PG8_STAGE(PG8_SB(1, 1), cB + hstepB + kstepB, voffB);
        PG8_WAIT_V(6); PG8_BAR;
    }
    for (;;) {
        const bool has_next = S.next(ui + 1, nxt);
        const char* nA = has_next ? PG8_ABASE(nxt) : cA; const char* nB = has_next ? PG8_BBASE(nxt) : cB;
        if (AMODE == 2) { if (has_next) PG8_GIDX_LOAD(nxt); }
#pragma unroll 1
        for (int t = 0; t < nt; t += 2) {
            const bool last = (t == nt - 2);
            unsigned vS0[2], vS1[2];
            if (AMODE == 2) { if (last) { if (has_next) PG8_GIDX_USE(); else { _Pragma("unroll") for (int i = 0; i < 2; ++i) { voffN0[i] = voffA0[i]; voffN1[i] = voffA1[i]; } } } }
#pragma unroll
            for (int i = 0; i < 2; ++i) { vS0[i] = (AMODE == 2 && last) ? voffN0[i] : voffA0[i]; vS1[i] = (AMODE == 2 && last) ? voffN1[i] : voffA1[i]; }
            const char* a1 = cA + (size_t)(t + 1) * kstepA;
            const char* a2 = last ? nA : cA + (size_t)(t + 2) * kstepA; const char* b2 = last ? nB : cB + (size_t)(t + 2) * kstepB;
            const char* a3 = a2 + kstepA; const char* b3 = b2 + kstepB;
            if (last && has_next) S.a_ready(nxt);
            if constexpr (SP2) {
            PG8_LDB(B0, 0, 0); PG8_LDB(B1, 0, 1); PG8_SCHED; PG8_LDA(At, 0, 0); PG8_STAGE(PG8_SA(1, 1), a1, voffA1);
            PG8_WAIT_V(8); PG8_WAIT_L(0); PG8_BAR; PG8_MMA(0, 0, At, B0); PG8_MMA(0, 1, At, B1); PG8_BAR; PG8_SCHED;
            PG8_LDA(At, 0, 1); PG8_STAGE(PG8_SB(0, 0), b2, voffB); PG8_STAGE(PG8_SB(0, 1), b2 + hstepB, voffB); PG8_STAGE(PG8_SA(0, 0), a2, vS0);
            PG8_WAIT_V(8); PG8_WAIT_L(0); PG8_BAR; PG8_MMA(1, 0, At, B0); PG8_MMA(1, 1, At, B1); PG8_BAR; PG8_SCHED;
            PG8_LDB(B0, 1, 0); PG8_LDB(B1, 1, 1); PG8_SCHED; PG8_LDA(At, 1, 0); PG8_STAGE(PG8_SA(0, 1), a2, vS1);
            PG8_WAIT_V(8); PG8_WAIT_L(0); PG8_BAR; PG8_MMA(0, 0, At, B0); PG8_MMA(0, 1, At, B1); PG8_BAR; PG8_SCHED;
            PG8_LDA(At, 1, 1); PG8_STAGE(PG8_SB(1, 0), b3, voffB); PG8_STAGE(PG8_SB(1, 1), b3 + hstepB, voffB); PG8_STAGE(PG8_SA(1, 0), a3, vS0);
            PG8_WAIT_V(8); PG8_WAIT_L(0); PG8_BAR; PG8_MMA(1, 0, At, B0); PG8_MMA(1, 1, At, B1); PG8_BAR; PG8_SCHED;
            } else {
            PG8_LDB(B0, 0, 0); PG8_SCHED; PG8_LDA(At, 0, 0); PG8_STAGE(PG8_SA(1, 1), a1, voffA1);
            PG8_WAIT_L(8); PG8_BAR; PG8_WAIT_L(0); PG8_MMA(0, 0, At, B0); PG8_BAR; PG8_SCHED;
            PG8_LDB(B1, 0, 1); PG8_STAGE(PG8_SB(0, 0), b2, voffB);
            PG8_BAR; PG8_WAIT_L(0); PG8_MMA(0, 1, At, B1); PG8_BAR;
            PG8_LDA(At, 0, 1); PG8_STAGE(PG8_SA(0, 0), a2, vS0);
            PG8_BAR; PG8_WAIT_L(0); PG8_MMA(1, 0, At, B0); PG8_BAR; PG8_SCHED;
            PG8_STAGE(PG8_SB(0, 1), b2 + hstepB, voffB);
            PG8_WAIT_V(6); PG8_BAR; PG8_MMA(1, 1, At, B1); PG8_BAR;
            PG8_LDB(B0, 1, 0); PG8_SCHED; PG8_LDA(At, 1, 0); PG8_STAGE(PG8_SA(0, 1), a2, vS1);
            PG8_WAIT_L(8); PG8_BAR; PG8_WAIT_L(0); PG8_MMA(0, 0, At, B0); PG8_BAR; PG8_SCHED;
            PG8_LDB(B1, 1, 1); PG8_STAGE(PG8_SB(1, 0), b3, voffB);
            PG8_BAR; PG8_WAIT_L(0); PG8_MMA(0, 1, At, B1); PG8_BAR;
            PG8_LDA(At, 1, 1); PG8_STAGE(PG8_SA(1, 0), a3, vS0);
            PG8_BAR; PG8_WAIT_L(0); PG8_MMA(1, 0, At, B0); PG8_BAR; PG8_SCHED;
            PG8_STAGE(PG8_SB(1, 1), b3 + hstepB, voffB);
            PG8_WAIT_V(6); PG8_BAR; PG8_MMA(1, 1, At, B1); PG8_BAR;
            }
        }
        if constexpr (ALIGN_EPI) { if (wr == 0) PG8_BAR; }
        if constexpr (F8) asm volatile("s_nop 15\n\ts_nop 15\n\ts_nop 7" ::: "memory");
        E(acc, cur, wr, wc, fr, fq); S.done(cur);
#if DBG_EPI2
        if (Epi::EPI2) { asm volatile("" ::: "memory"); E(acc, cur, wr, wc, fr, fq); }
#endif
        if (!has_next) break;
#pragma unroll
        for (int a = 0; a < 2; ++a)
#pragma unroll
            for (int b = 0; b < 2; ++b)
#pragma unroll
                for (int m = 0; m < 4; ++m)
#pragma unroll
                    for (int n = 0; n < 2; ++n) acc[a][b][m][n] = (f32x4){0.f, 0.f, 0.f, 0.f};
        cur = nxt; cA = nA; cB = nB; ++ui;
        if (AMODE == 2) {
#pragma unroll
            for (int i = 0; i < 2; ++i) { voffA0[i] = voffN0[i]; voffA1[i] = voffN1[i]; } }
        if constexpr (ALIGN_EPI) { if (wr == 1) PG8_BAR; }
    }
    PG8_WAIT_V(0);
    if constexpr (!ALIGN_EPI) { if (wr == 0) PG8_BAR; }
    PG8_BAR;
#undef PG8_GIDX_LOAD
#undef PG8_GIDX_USE
#undef PG8_ABASE
#undef PG8_BBASE
#undef PG8_SA
#undef PG8_SB
#undef PG8_STAGE
#undef PG8_LDA
#undef PG8_LDA16
#undef PG8_LDA8
#undef PG8_LDB16
#undef PG8_LDB8
#undef PG8_MMA16
#undef PG8_MMA8
#undef PG8_LDB
#undef PG8_MMA
#undef PG8_WAIT_V
#undef PG8_WAIT_L
#undef PG8_BAR
#undef PG8_SCHED
}
}
constexpr int NWAVES = 8;
constexpr int BATCH = 2, SEQ = 8192, D = 1024, M = BATCH * SEQ, DF = 512, DIN = 5632, NE = 16, CAP = 1024, DE = 2048, MR = BATCH * NE * CAP  ;
constexpr float RMS_EPS = 1e-6f;
constexpr size_t MiB = 1u << 20;
constexpr size_t WS_CTL = 0, CTL_ZERO_BYTES = 1 * MiB;
constexpr size_t WS_MODP = 1 * MiB, WS_MOD = 1 * MiB + 256 * 1024, WS_FC1 = 1 * MiB + 512 * 1024, WS_FC2 = 1 * MiB + 576 * 1024;
constexpr size_t WS_PROBS = 2 * MiB, WS_SLOT = 3 * MiB, WS_IDX = 4 * MiB, WS_VAL = 4 * MiB + 128 * 1024;
constexpr size_t WS_WIN = 8 * MiB, WS_WF = 20 * MiB, WS_WCO = 22 * MiB, WS_WO = 24 * MiB, WS_WGU = 32 * MiB, WS_WD = 160 * MiB;
constexpr size_t WS_H1 = 224 * MiB, WS_AB = 224 * MiB, WS_UF = 256 * MiB, WS_CV = 272 * MiB, WS_BG = 304 * MiB, WS_GA = 336 * MiB, WS_GB = 368 * MiB, WS_ZF = 400 * MiB, WS_TZ = 432 * MiB, WS_H2 = 464 * MiB;
#ifndef MOE_FP8
#define MOE_FP8 1
#endif
constexpr size_t WS_HM = 224 * MiB, WS_Y = 432 * MiB, WS_X1B = 400 * MiB, WS_END = 496 * MiB;
constexpr int CW_BAR = 4096;
constexpr int RING_BYTES = 131072, MISC_OFF = 143360, LDS_BYTES = 147456;
constexpr int FFT_TOFF = 65536, FFT_TPITCH = 528;

#define GAS __attribute__((address_space(1)))
#define LAS __attribute__((address_space(3)))
typedef unsigned short bf16;
typedef unsigned v4u __attribute__((ext_vector_type(4)));
typedef unsigned v2u __attribute__((ext_vector_type(2)));
typedef float f32x4 __attribute__((ext_vector_type(4)));
typedef short bf16x8 __attribute__((ext_vector_type(8)));
#define LDS_WAIT() asm volatile("s_waitcnt lgkmcnt(0)" ::: "memory")
#define VM_WAIT() asm volatile("s_waitcnt vmcnt(0)" ::: "memory")
using pg8::cvt_pk_bf16; using pg8::bf_lo; using pg8::bf_hi; using pg8::sigm;
__device__ __forceinline__ float wave_sum(float v) {
#pragma unroll
    for (int o = 1; o < 64; o <<= 1) v += __shfl_xor(v, o);
    return v;
}
__device__ __forceinline__ float silu(float v) { return v * sigm(v); }
#ifndef DBG_NOBIAS
#define DBG_NOBIAS 0
#endif
#ifndef DBG_NOSIG
#define DBG_NOSIG 0
#endif
__device__ __forceinline__ float sigx(float v) { return DBG_NOSIG ? v : sigm(v); }

#define XB_TMO      128
#define XB_XCNT(j)  (256  + 64 * (j))
#define XB_XSUB(j)  (1280 + 64 * (j))
#define XB_XGEN(j)  (2304 + 64 * (j))
#define XB_TOP      3328
#define XB_TOPGEN   3392
#define XCD_BAR_WORDS 3456
#define XB_SPIN_CAP (1u << 18)
__device__ __forceinline__ unsigned xb_ld(unsigned* p)              { return __hip_atomic_load(p, __ATOMIC_RELAXED, __HIP_MEMORY_SCOPE_AGENT); }
__device__ __forceinline__ unsigned xb_add(unsigned* p, unsigned v) { return __hip_atomic_fetch_add(p, v, __ATOMIC_RELAXED, __HIP_MEMORY_SCOPE_AGENT); }
__device__ __forceinline__ unsigned xb_xcc_id() { return (unsigned)__builtin_amdgcn_s_getreg((3 << 11) | 20) & 0xFu; }
#define XB_SPIN(cond, bar) do { unsigned _sp = 0; while (cond) { __builtin_amdgcn_s_sleep(1); \
    if ((++_sp & 255u) == 0u) { if (xb_ld(&(bar)[XB_TMO])) break; if (_sp > XB_SPIN_CAP) { atomicAdd(&(bar)[XB_TMO], 1u); break; } } } } while (0)
struct XcdBarrier { unsigned* bar; unsigned x; volatile LAS unsigned* st; };
__device__ __forceinline__ XcdBarrier xcd_barrier_post(unsigned* bar, volatile LAS unsigned* st) {
    XcdBarrier b; b.bar = bar; b.x = xb_xcc_id(); b.st = st;
    if (threadIdx.x == 0) (void)xb_add(&bar[XB_XCNT(b.x)], 1u);
    return b;
}
__device__ __forceinline__ void xcd_barrier_complete(unsigned* bar, unsigned x, unsigned& nloc, unsigned& nx) {
    const unsigned G = gridDim.x * gridDim.y * gridDim.z;
    unsigned sum, cnt, mine, sp = 0u;
    for (;;) {
        sum = 0u; cnt = 0u; mine = 0u;
#pragma unroll
        for (unsigned j = 0; j < 16; ++j) { const unsigned c = xb_ld(&bar[XB_XCNT(j)]); sum += c; cnt += (c > 0u) ? 1u : 0u; mine = (j == x) ? c : mine; }
        if (sum == G) break;
        __builtin_amdgcn_s_sleep(1);
        if ((++sp & 255u) == 0u) { if (xb_ld(&bar[XB_TMO])) break; if (sp > XB_SPIN_CAP) { atomicAdd(&bar[XB_TMO], 1u); break; } }
    }
    nloc = mine > 0u ? mine : 1u; nx = cnt > 0u ? cnt : 1u;
}
__device__ __forceinline__ void xcd_barrier(const XcdBarrier& b) {
    asm volatile("s_waitcnt vmcnt(0)" ::: "memory");
    __syncthreads();
    if (threadIdx.x == 0) {
        unsigned* bar = b.bar;
        __builtin_amdgcn_s_waitcnt(0);
        unsigned nloc = b.st[0], nx = b.st[1];
        if (nloc == 0u) { xcd_barrier_complete(bar, b.x, nloc, nx); b.st[0] = nloc; b.st[1] = nx; }
        const unsigned old = xb_add(&bar[XB_XSUB(b.x)], 1u);
        const unsigned gen = old / nloc;
        if (old + 1u == (gen + 1u) * nloc) {
            __builtin_amdgcn_fence(__ATOMIC_RELEASE, "agent");
            asm volatile("s_waitcnt vmcnt(0)" ::: "memory");
            const unsigned og = xb_add(&bar[XB_TOP], 1u);
            const unsigned tg = og / nx;
            if (og + 1u == (tg + 1u) * nx) xb_add(&bar[XB_TOPGEN], 1u);
            else XB_SPIN(xb_ld(&bar[XB_TOPGEN]) == tg, bar);
            __builtin_amdgcn_fence(__ATOMIC_ACQUIRE, "agent");
            xb_add(&bar[XB_XGEN(b.x)], 1u);
            asm volatile("s_waitcnt vmcnt(0)" ::: "memory");
        } else {
            XB_SPIN(xb_ld(&bar[XB_XGEN(b.x)]) == gen, bar);
            __builtin_amdgcn_fence(__ATOMIC_ACQUIRE, "agent");
            asm volatile("s_waitcnt vmcnt(0)" ::: "memory");
        }
    }
    __syncthreads();
}

using pg8::Unit; using pg8::u32x4; using pg8::u32x2;
struct EpiInProj {
    static constexpr bool PERM = true, EPI2 = (DBG_EPI2 == 2);
    bf16 *UF, *CV, *BG, *GA, *GB; const float* b_gate;
    __device__ __forceinline__ void operator()(const f32x4 (&acc)[2][2][4][2], const Unit& u, int wr, int wc, int fr, int fq) const {
        const int row0 = u.pm * 256 + wr * 64 + fr;
        if (u.pn < 2) {
            const int b = u.pm >> 5, s0 = (u.pm & 31) * 256 + wr * 64 + fr;
#pragma unroll
            for (int ai = 0; ai < 2; ++ai)
#pragma unroll
                for (int m = 0; m < 4; ++m) { const int s = s0 + ai * 128 + m * 16;
#pragma unroll
                    for (int bj = 0; bj < 2; ++bj) { const int g4 = (u.pn * 256 + bj * 128 + wc * 32 + 8 * fq) >> 2;
#pragma unroll
                        for (int n = 0; n < 2; ++n) { const f32x4 v = acc[ai][bj][m][n]; u32x2 w; w.x = cvt_pk_bf16(v[0], v[1]); w.y = cvt_pk_bf16(v[2], v[3]);
                            *(u32x2*)(UF + ((size_t)(b * 128 + g4 + n) * 8192 + s) * 4) = w; } } }
        } else if (u.pn < 10) {
#pragma unroll
            for (int ai = 0; ai < 2; ++ai)
#pragma unroll
                for (int m = 0; m < 4; ++m) { bf16* rowp = CV + (size_t)(row0 + ai * 128 + m * 16) * D + (u.pn - 2) * 128 + wc * 16 + 4 * fq;
#pragma unroll
                    for (int bj = 0; bj < 2; ++bj) { const f32x4 v = acc[ai][bj][m][0] * acc[ai][bj][m][1]; u32x2 w; w.x = cvt_pk_bf16(v[0], v[1]); w.y = cvt_pk_bf16(v[2], v[3]);
                        *(u32x2*)(rowp + bj * 64) = w; } }
        } else if (u.pn < 14) {
#pragma unroll
            for (int ai = 0; ai < 2; ++ai)
#pragma unroll
                for (int m = 0; m < 4; ++m) { bf16* rowp = BG + (size_t)(row0 + ai * 128 + m * 16) * D + (u.pn - 10) * 256 + wc * 32 + 8 * fq;
#pragma unroll
                    for (int bj = 0; bj < 2; ++bj) { const f32x4 v0 = acc[ai][bj][m][0], v1 = acc[ai][bj][m][1]; u32x4 w; w.x = cvt_pk_bf16(v0[0], v0[1]); w.y = cvt_pk_bf16(v0[2], v0[3]); w.z = cvt_pk_bf16(v1[0], v1[1]); w.w = cvt_pk_bf16(v1[2], v1[3]);
                        *(u32x4*)(rowp + bj * 128) = w; } }
        } else {
            const int colg = (u.pn - 14) * 256 + wc * 32 + 8 * fq;
            bf16* O = (u.pn < 18) ? GA : GB;
            f32x4 bv[2][2];
#pragma unroll
            for (int bj = 0; bj < 2; ++bj)
#pragma unroll
                for (int n = 0; n < 2; ++n) bv[bj][n] = DBG_NOBIAS ? (f32x4){0.f, 0.f, 0.f, 0.f} : *(const f32x4*)(b_gate + colg + bj * 128 + 4 * n);
#pragma unroll
            for (int ai = 0; ai < 2; ++ai)
#pragma unroll
                for (int m = 0; m < 4; ++m) { bf16* rowp = O + (size_t)(row0 + ai * 128 + m * 16) * D + (colg & 1023);
#pragma unroll
                    for (int bj = 0; bj < 2; ++bj) { const f32x4 v0 = acc[ai][bj][m][0] + bv[bj][0], v1 = acc[ai][bj][m][1] + bv[bj][1]; u32x4 w;
                        w.x = cvt_pk_bf16(sigx(v0[0]), sigx(v0[1])); w.y = cvt_pk_bf16(sigx(v0[2]), sigx(v0[3])); w.z = cvt_pk_bf16(sigx(v1[0]), sigx(v1[1])); w.w = cvt_pk_bf16(sigx(v1[2]), sigx(v1[3]));
                        *(u32x4*)(rowp + bj * 128) = w; } }
        }
    }
};
template <int MODE> struct EpiGateMul {
    static constexpr bool PERM = true, EPI2 = false;
    bf16* O; const bf16* G;
    __device__ __forceinline__ void operator()(const f32x4 (&acc)[2][2][4][2], const Unit& u, int wr, int wc, int fr, int fq) const {
        const int row0 = u.pm * 256 + wr * 64 + fr, col0 = u.pn * 256 + wc * 32 + 8 * fq;
#pragma unroll
        for (int ai = 0; ai < 2; ++ai)
#pragma unroll
            for (int m = 0; m < 4; ++m) { const size_t off = (size_t)(row0 + ai * 128 + m * 16) * D + col0;
#pragma unroll
                for (int bj = 0; bj < 2; ++bj) { const u32x4 gw = *(const u32x4*)(G + off + bj * 128); const f32x4 v0 = acc[ai][bj][m][0], v1 = acc[ai][bj][m][1];
                    float r[8] = {bf_lo(gw.x) * v0[0], bf_hi(gw.x) * v0[1], bf_lo(gw.y) * v0[2], bf_hi(gw.y) * v0[3], bf_lo(gw.z) * v1[0], bf_hi(gw.z) * v1[1], bf_lo(gw.w) * v1[2], bf_hi(gw.w) * v1[3]};
                    if (MODE == 1) { const u32x4 ow = *(const u32x4*)(O + off + bj * 128);
                        r[0] += bf_lo(ow.x); r[1] += bf_hi(ow.x); r[2] += bf_lo(ow.y); r[3] += bf_hi(ow.y); r[4] += bf_lo(ow.z); r[5] += bf_hi(ow.z); r[6] += bf_lo(ow.w); r[7] += bf_hi(ow.w); }
                    u32x4 w; w.x = cvt_pk_bf16(r[0], r[1]); w.y = cvt_pk_bf16(r[2], r[3]); w.z = cvt_pk_bf16(r[4], r[5]); w.w = cvt_pk_bf16(r[6], r[7]);
                    *(u32x4*)(O + off + bj * 128) = w; } }
    }
};
struct EpiResid {
    static constexpr bool PERM = true, EPI2 = (DBG_EPI2 == 5);
    const float* x; bf16* X1B; const float* gate;
    __device__ __forceinline__ void operator()(const f32x4 (&acc)[2][2][4][2], const Unit& u, int wr, int wc, int fr, int fq) const {
        const int row0 = u.pm * 256 + wr * 64 + fr, col0 = u.pn * 256 + wc * 32 + 8 * fq, b = u.pm >> 5;
        f32x4 gv[2][2];
#pragma unroll
        for (int bj = 0; bj < 2; ++bj)
#pragma unroll
            for (int n = 0; n < 2; ++n) gv[bj][n] = *(const f32x4*)(gate + b * 6 * D + col0 + bj * 128 + 4 * n);
#pragma unroll
        for (int ai = 0; ai < 2; ++ai)
#pragma unroll
            for (int m = 0; m < 4; ++m) { const size_t off = (size_t)(row0 + ai * 128 + m * 16) * D + col0;
#pragma unroll
                for (int bj = 0; bj < 2; ++bj) { const f32x4 x0 = *(const f32x4*)(x + off + bj * 128), x1 = *(const f32x4*)(x + off + bj * 128 + 4);
                    const f32x4 v0 = x0 + gv[bj][0] * acc[ai][bj][m][0], v1 = x1 + gv[bj][1] * acc[ai][bj][m][1];
                    u32x4 w; w.x = cvt_pk_bf16(v0[0], v0[1]); w.y = cvt_pk_bf16(v0[2], v0[3]); w.z = cvt_pk_bf16(v1[0], v1[1]); w.w = cvt_pk_bf16(v1[2], v1[3]);
                    *(u32x4*)(X1B + off + bj * 128) = w; }
                asm volatile("" ::: "memory"); }
    }
};
struct EpiSwiGLU {
    static constexpr bool PERM = true, EPI2 = (DBG_EPI2 == 9);
    bf16* HM;
    __device__ __forceinline__ void operator()(const f32x4 (&acc)[2][2][4][2], const Unit& u, int wr, int wc, int fr, int fq) const {
        const int row0 = u.pm * 256 + wr * 64 + fr, col0 = u.pn * 128 + wc * 32 + 8 * fq;
#pragma unroll
        for (int ai = 0; ai < 2; ++ai)
#pragma unroll
            for (int m = 0; m < 4; ++m) { const f32x4 g0 = acc[ai][0][m][0], g1 = acc[ai][0][m][1], u0 = acc[ai][1][m][0], u1 = acc[ai][1][m][1]; u32x4 w;
                w.x = cvt_pk_bf16(silu(g0[0]) * u0[0], silu(g0[1]) * u0[1]); w.y = cvt_pk_bf16(silu(g0[2]) * u0[2], silu(g0[3]) * u0[3]);
                w.z = cvt_pk_bf16(silu(g1[0]) * u1[0], silu(g1[1]) * u1[1]); w.w = cvt_pk_bf16(silu(g1[2]) * u1[2], silu(g1[3]) * u1[3]);
                *(u32x4*)(HM + (size_t)(row0 + ai * 128 + m * 16) * DE + col0) = w; }
    }
};
__device__ __forceinline__ unsigned pk4_fp8(float a, float b2, float c, float d) { unsigned w = 0u; w = __builtin_amdgcn_cvt_pk_fp8_f32(a, b2, w, false); w = __builtin_amdgcn_cvt_pk_fp8_f32(c, d, w, true); return w; }
struct EpiSwiGLU8 {
    static constexpr bool PERM = true, EPI2 = false;
    unsigned char* HM8;
    __device__ __forceinline__ void operator()(const f32x4 (&acc)[2][2][4][2], const Unit& u, int wr, int wc, int fr, int fq) const {
        const int row0 = u.pm * 256 + wr * 64 + fr, col0 = u.pn * 128 + wc * 32 + 8 * fq;
#pragma unroll
        for (int ai = 0; ai < 2; ++ai)
#pragma unroll
            for (int m = 0; m < 4; ++m) { const f32x4 g0 = acc[ai][0][m][0], g1 = acc[ai][0][m][1], u0 = acc[ai][1][m][0], u1 = acc[ai][1][m][1]; u32x2 w;
                w.x = pk4_fp8(silu(g0[0]) * u0[0], silu(g0[1]) * u0[1], silu(g0[2]) * u0[2], silu(g0[3]) * u0[3]);
                w.y = pk4_fp8(silu(g1[0]) * u1[0], silu(g1[1]) * u1[1], silu(g1[2]) * u1[2], silu(g1[3]) * u1[3]);
                *(u32x2*)(HM8 + (size_t)(row0 + ai * 128 + m * 16) * DE + col0) = w; asm volatile("" ::: "memory"); }
    }
};
struct EpiRowScale {
    static constexpr bool PERM = true, EPI2 = (DBG_EPI2 == 10);
    bf16* Y; const float* val;
    __device__ __forceinline__ void operator()(const f32x4 (&acc)[2][2][4][2], const Unit& u, int wr, int wc, int fr, int fq) const {
        const int row0 = u.pm * 256 + wr * 64 + fr, col0 = u.pn * 256 + wc * 32 + 8 * fq;
#pragma unroll
        for (int ai = 0; ai < 2; ++ai)
#pragma unroll
            for (int m = 0; m < 4; ++m) { const int row = row0 + ai * 128 + m * 16; const float sv = val[row];
#pragma unroll
                for (int bj = 0; bj < 2; ++bj) { const f32x4 v0 = acc[ai][bj][m][0] * sv, v1 = acc[ai][bj][m][1] * sv; u32x4 w; w.x = cvt_pk_bf16(v0[0], v0[1]); w.y = cvt_pk_bf16(v0[2], v0[3]); w.z = cvt_pk_bf16(v1[0], v1[1]); w.w = cvt_pk_bf16(v1[2], v1[3]);
                    *(u32x4*)(Y + (size_t)row * D + col0 + bj * 128) = w; } }
    }
};

struct EpiPlain {
    static constexpr bool PERM = true, EPI2 = false;
    bf16* O; int ldc;
    __device__ __forceinline__ void operator()(const f32x4 (&acc)[2][2][4][2], const Unit& u, int wr, int wc, int fr, int fq) const {
        const int row0 = u.pm * 256 + wr * 64 + fr, col0 = u.pn * 256 + wc * 32 + 8 * fq;
#pragma unroll
        for (int ai = 0; ai < 2; ++ai)
#pragma unroll
            for (int m = 0; m < 4; ++m) { bf16* rowp = O + (size_t)(row0 + ai * 128 + m * 16) * ldc + col0;
#pragma unroll
                for (int bj = 0; bj < 2; ++bj) { const f32x4 v0 = acc[ai][bj][m][0], v1 = acc[ai][bj][m][1]; u32x4 w; w.x = cvt_pk_bf16(v0[0], v0[1]); w.y = cvt_pk_bf16(v0[2], v0[3]); w.z = cvt_pk_bf16(v1[0], v1[1]); w.w = cvt_pk_bf16(v1[2], v1[3]);
                    *(u32x4*)(rowp + bj * 128) = w; } }
    }
};
__device__ __forceinline__ unsigned f2bf(float f) { unsigned u = __builtin_bit_cast(unsigned, f); return (u + 0x7fffu + ((u >> 16) & 1u)) >> 16; }
__device__ __forceinline__ unsigned pk2(float lo, float hi) { return f2bf(lo) | (f2bf(hi) << 16); }
__device__ __forceinline__ int rowmap_in(int n) {
    if (n < 512) return n;
    if (n < 1536) { const int j = n - 512; return 512 + 8 * (j >> 2) + (j & 3); }
    if (n < 2560) return 2560 + (n - 1536);
    if (n < 3584) { const int j = n - 2560; return 512 + 8 * (j >> 2) + 4 + (j & 3); }
    return n;
}
template <int MAP>
__device__ __forceinline__ void transpose_item(const float* W, int K, int N, bf16* WT, LAS float* scr, int item, int lane) {
    const int nblk = N / 32, kb = item / nblk, nb = item % nblk, k0 = 64 * kb, n0 = 32 * nb;
#pragma unroll 8
    for (int i = 0; i < 32; ++i) { const int kk = 2 * i + (lane >> 5); scr[kk * 33 + (lane & 31)] = W[(size_t)(k0 + kk) * N + n0 + (lane & 31)]; }
    LDS_WAIT(); asm volatile("" ::: "memory");
    const int c = lane & 7;
#pragma unroll
    for (int j = 0; j < 4; ++j) { const int n = (lane >> 3) + 8 * j; const LAS float* s = scr + (8 * c) * 33 + n;
        v4u o; o.x = pk2(s[0 * 33], s[1 * 33]); o.y = pk2(s[2 * 33], s[3 * 33]); o.z = pk2(s[4 * 33], s[5 * 33]); o.w = pk2(s[6 * 33], s[7 * 33]);
        const int ns = n0 + n; int row;
        if (MAP == 0) row = ns; else if (MAP == 1) row = rowmap_in(ns); else if (MAP == 2) row = 256 * (ns >> 7) + (ns & 127); else row = 256 * (ns >> 7) + 128 + (ns & 127);
        *(GAS v4u*)(WT + (size_t)row * K + k0 + 8 * c) = o; }
    LDS_WAIT(); asm volatile("" ::: "memory");
}
template <int MAP>
__device__ __forceinline__ void transpose_item8(const float* W, int K, int N, unsigned char* WT, LAS float* scr, int item, int lane) {
    const int nblk = N / 32, kb = item / nblk, nb = item % nblk, k0 = 64 * kb, n0 = 32 * nb;
#pragma unroll 8
    for (int i = 0; i < 32; ++i) { const int kk = 2 * i + (lane >> 5); scr[kk * 33 + (lane & 31)] = W[(size_t)(k0 + kk) * N + n0 + (lane & 31)]; }
    LDS_WAIT(); asm volatile("" ::: "memory");
    const int c = lane & 3;
#pragma unroll
    for (int j = 0; j < 2; ++j) { const int n = (lane >> 2) + 16 * j; const LAS float* s = scr + (16 * c) * 33 + n; unsigned o[4];
#pragma unroll
        for (int q = 0; q < 4; ++q) { unsigned w = 0u; w = __builtin_amdgcn_cvt_pk_fp8_f32(s[(4 * q) * 33] * 128.f, s[(4 * q + 1) * 33] * 128.f, w, false); w = __builtin_amdgcn_cvt_pk_fp8_f32(s[(4 * q + 2) * 33] * 128.f, s[(4 * q + 3) * 33] * 128.f, w, true); o[q] = w; }
        const int ns = n0 + n; int row;
        if (MAP == 0) row = ns; else if (MAP == 2) row = 256 * (ns >> 7) + (ns & 127); else row = 256 * (ns >> 7) + 128 + (ns & 127);
        v4u ov; ov.x = o[0]; ov.y = o[1]; ov.z = o[2]; ov.w = o[3];
        *(GAS v4u*)(WT + (size_t)row * K + k0 + 16 * c) = ov; }
    LDS_WAIT(); asm volatile("" ::: "memory");
}
__device__ __forceinline__ void wf_item(const float* wf, bf16* WF_T, int item, int lane) {
    const int c = item >> 2, dblk = item & 3, g = c >> 7, j = c & 127, d0 = 256 * dblk + 4 * lane;
    f32x4 ac = {0.f, 0.f, 0.f, 0.f}, as = {0.f, 0.f, 0.f, 0.f};
    for (int m = 0; m < 128; ++m) { const f32x4 wv = *(const GAS f32x4*)(wf + (size_t)(g * 128 + m) * D + d0); const float fr = (float)((m * j) & 127) * (1.0f / 128.0f);
        const float cv = __builtin_amdgcn_cosf(fr), sv = __builtin_amdgcn_sinf(fr); ac += cv * wv; as += sv * wv; }
    const int kv = 8 * (c >> 2) + 2 * (c & 3);
#pragma unroll
    for (int i = 0; i < 4; ++i) *(GAS unsigned*)(WF_T + (size_t)(d0 + i) * D + kv) = pk2(ac[i] * (1.0f / 1024.0f), as[i] * (1.0f / 1024.0f));
}
__device__ __forceinline__ void fc_tables(bf16* Fc1, bf16* Fc2, int gtid, int gthreads) {
    for (int e = gtid; e < 8192 + 65536; e += gthreads) {
        if (e < 8192) { const int j = e & 7, ln = (e >> 3) & 63, kk = (e >> 9) & 1, mt = (e >> 10) & 3, hh = e >> 12, rho = ln & 15;
            const int s1 = 32 * kk + 8 * (ln >> 4) + j, k1 = 32 * hh + 16 * (mt & 1) + 4 * (rho & 3) + (rho >> 2);
            const float fr = (float)((k1 * s1) & 63) * (1.0f / 64.0f); Fc1[e] = (bf16)f2bf((mt >> 1) == 0 ? cospif(2.0f * fr) : -sinpif(2.0f * fr)); }
        else { const int q = e - 8192, j = q & 7, ln = (q >> 3) & 63, kk = (q >> 9) & 7, ro = (q >> 12) & 1, w = q >> 13;
            const int k2 = 16 * w + (ln & 15), kap = 32 * kk + 8 * (ln >> 4) + j, s2 = kap >> 1, ri = kap & 1;
            const float fr = (float)((k2 * s2) & 127) * (1.0f / 128.0f), cv = cospif(2.0f * fr), sv = sinpif(2.0f * fr);
            Fc2[q] = (bf16)f2bf(ro == 0 ? (ri == 0 ? cv : sv) : (ri == 0 ? -sv : cv)); }
    }
}
__device__ __forceinline__ void mod_item(const float* c, const float* w_ada, float* modp, LAS unsigned char* lds, int item, int tid, int wave, int lane) {
    const int cb = item % 24, kq = item / 24, col0 = 256 * cb + 4 * lane;
    f32x4 a0 = {0.f, 0.f, 0.f, 0.f}, a1 = {0.f, 0.f, 0.f, 0.f};
    for (int i = 0; i < 32; ++i) { const int d = 256 * kq + 32 * wave + i; const float c0 = c[d], c1 = c[D + d];
        const f32x4 wv = *(const GAS f32x4*)(w_ada + (size_t)d * 6 * D + col0); a0 += silu(c0) * wv; a1 += silu(c1) * wv; }
    LAS f32x4* red = (LAS f32x4*)lds;
    red[(wave * 2 + 0) * 64 + lane] = a0; red[(wave * 2 + 1) * 64 + lane] = a1;
    __syncthreads();
    { const int b = tid >> 8, cc = tid & 255; const LAS float* rf = (const LAS float*)lds; float s = 0.f;
#pragma unroll
      for (int w = 0; w < 8; ++w) s += rf[((w * 2 + b) * 64) * 4 + cc];
      modp[(size_t)(kq * 2 + b) * 6 * D + 256 * cb + cc] = s; }
    __syncthreads();
}

__device__ __forceinline__ void phase_h(const float* x, const float* g_mix, const float* b_ada, const float* modp, float* mod, bf16* H1, LAS unsigned char* lds, int tid, int wave, int lane, int vcu, int G) {
    LAS float* ga = (LAS float*)lds;
    LAS float* sh = ga + 2 * D;
    { float v[8];
#pragma unroll
      for (int k = 0; k < 8; ++k) { const int i = tid + 512 * k, j = i & 2047; v[k] = b_ada[j]; }
#pragma unroll
      for (int q = 0; q < 4; ++q)
#pragma unroll
          for (int k = 0; k < 8; ++k) { const int i = tid + 512 * k, b = i >> 11, j = i & 2047; v[k] += modp[(size_t)(q * 2 + b) * 6 * D + j]; }
#pragma unroll
      for (int k = 0; k < 8; ++k) { const int i = tid + 512 * k, b = i >> 11, j = i & 2047; if (j < D) sh[b * D + j] = v[k]; else ga[b * D + j - D] = g_mix[j - D] * (1.f + v[k]); } }
    { const int i = vcu * NWAVES * 64 + tid;
      if (i < 2 * 6 * D) { const int b = i / (6 * D), j = i % (6 * D); float v = b_ada[j];
#pragma unroll
          for (int q = 0; q < 4; ++q) v += modp[(size_t)(q * 2 + b) * 6 * D + j];
          mod[i] = v; } }
    __syncthreads();
    const int gw = vcu * NWAVES + wave, NGW = G * NWAVES;
    for (int m0 = gw * 4; m0 < M; m0 += NGW * 4) { const int b = m0 >> 13;
        f32x4 v[4][4]; float s[4];
#pragma unroll
        for (int r = 0; r < 4; ++r) { const GAS f32x4* xr = (const GAS f32x4*)(x + (size_t)(m0 + r) * D) + lane;
#pragma unroll
            for (int j = 0; j < 4; ++j) v[r][j] = xr[64 * j]; }
#pragma unroll
        for (int r = 0; r < 4; ++r) { s[r] = 0.f;
#pragma unroll
            for (int j = 0; j < 4; ++j) s[r] += (v[r][j].x * v[r][j].x + v[r][j].y * v[r][j].y) + (v[r][j].z * v[r][j].z + v[r][j].w * v[r][j].w); }
#pragma unroll
        for (int o = 1; o < 64; o <<= 1) {
#pragma unroll
            for (int r = 0; r < 4; ++r) s[r] += __shfl_xor(s[r], o); }
#pragma unroll
        for (int r = 0; r < 4; ++r) { const float rr = rsqrtf(s[r] * (1.f / D) + RMS_EPS); GAS v2u* o8 = (GAS v2u*)(H1 + (size_t)(m0 + r) * D) + lane;
#pragma unroll
            for (int j = 0; j < 4; ++j) { const f32x4 gg = *(const LAS f32x4*)(ga + b * D + 4 * lane + 256 * j), ss = *(const LAS f32x4*)(sh + b * D + 4 * lane + 256 * j); const f32x4 y = v[r][j] * rr * gg + ss;
                v2u w; w.x = cvt_pk_bf16(y.x, y.y); w.y = cvt_pk_bf16(y.z, y.w); o8[64 * j] = w; } } }
    __syncthreads();
}
__device__ __forceinline__ void phase_conv(const bf16* CV, const bf16* BG, const float* w_conv, bf16* AB, int wave, int lane, int vcu, int G) {
    const int gw = vcu * NWAVES + wave, NGW = G * NWAVES;
    for (int m = gw; m < M; m += NGW) { const int s = m & (SEQ - 1);
#pragma unroll
        for (int hseg = 0; hseg < 2; ++hseg) { const int ch = hseg * 512 + 8 * lane; const size_t off = (size_t)m * D + ch;
            const v4u c1 = *(const GAS v4u*)(CV + off), bg = *(const GAS v4u*)(BG + off);
            v4u c0 = {0u, 0u, 0u, 0u}, c2 = {0u, 0u, 0u, 0u};
            if (s > 0) c0 = *(const GAS v4u*)(CV + off - D);
            if (s < SEQ - 1) c2 = *(const GAS v4u*)(CV + off + D);
            float w0[8], w1[8], w2[8];
#pragma unroll
            for (int q = 0; q < 2; ++q) { const f32x4 a = *(const GAS f32x4*)(w_conv + ch + 4 * q), b = *(const GAS f32x4*)(w_conv + D + ch + 4 * q), c = *(const GAS f32x4*)(w_conv + 2 * D + ch + 4 * q);
#pragma unroll
                for (int i = 0; i < 4; ++i) { w0[4 * q + i] = a[i]; w1[4 * q + i] = b[i]; w2[4 * q + i] = c[i]; } }
            unsigned ow[4];
#pragma unroll
            for (int q = 0; q < 4; ++q) {
                const float lo = bf_lo(bg[q]) * (w0[2 * q] * bf_lo(c0[q]) + w1[2 * q] * bf_lo(c1[q]) + w2[2 * q] * bf_lo(c2[q]));
                const float hi = bf_hi(bg[q]) * (w0[2 * q + 1] * bf_hi(c0[q]) + w1[2 * q + 1] * bf_hi(c1[q]) + w2[2 * q + 1] * bf_hi(c2[q]));
                ow[q] = cvt_pk_bf16(lo, hi); }
            v4u o; o.x = ow[0]; o.y = ow[1]; o.z = ow[2]; o.w = ow[3];
            *(GAS v4u*)(AB + off) = o; } }
}
__device__ __forceinline__ void phase_h2(const bf16* X1B, const float* g_moe, const float* mod, const float* w_router, const float* b_router, bf16* H2, unsigned char* H2F8, float* probs,
                                         LAS unsigned char* lds, int tid, int wave, int lane, int vcu, int G) {
    LAS bf16* whi = (LAS bf16*)lds;
    LAS bf16* wlo = whi + 16384;
    LAS float* ga = (LAS float*)(lds + 65536);
    LAS float* sh = ga + 2 * D;
    for (int i = tid; i < 16384; i += NWAVES * 64) { const int j = i & 7, ln = (i >> 3) & 63, kk = i >> 9, k = 32 * kk + 8 * (ln >> 4) + j, e = ln & 15;
        const float w = w_router[k * NE + e]; const unsigned h = f2bf(w); const float wh = __uint_as_float(h << 16); whi[i] = (bf16)h; wlo[i] = (bf16)f2bf(w - wh); }
    { float a[4], b2[4], c2[4];
#pragma unroll
      for (int k = 0; k < 4; ++k) { const int i = tid + 512 * k, b = i >> 10, j = i & 1023; a[k] = mod[b * 6 * D + 3 * D + j]; b2[k] = mod[b * 6 * D + 4 * D + j]; c2[k] = g_moe[j]; }
#pragma unroll
      for (int k = 0; k < 4; ++k) { const int i = tid + 512 * k; sh[i] = a[k]; ga[i] = c2[k] * (1.f + b2[k]); } }
    __syncthreads();
    const int n = lane & 15, kq = lane >> 4;
    float br[4];
#pragma unroll
    for (int r = 0; r < 4; ++r) br[r] = b_router[4 * kq + r];
    for (int grp = wave * G + vcu; grp < M / 16; grp += NWAVES * G) { const int m0 = 16 * grp, b = m0 >> 13;
        const GAS v4u* xr = (const GAS v4u*)(X1B + (size_t)(m0 + n) * D + 8 * kq);
        v4u xf[32]; float ssq = 0.f;
#pragma unroll
        for (int kk = 0; kk < 32; ++kk) xf[kk] = xr[4 * kk];
#pragma unroll
        for (int kk = 0; kk < 32; ++kk) { const v4u w = xf[kk]; const float e0 = bf_lo(w.x), e1 = bf_hi(w.x), e2 = bf_lo(w.y), e3 = bf_hi(w.y), e4 = bf_lo(w.z), e5 = bf_hi(w.z), e6 = bf_lo(w.w), e7 = bf_hi(w.w);
            ssq += (e0 * e0 + e1 * e1) + (e2 * e2 + e3 * e3) + (e4 * e4 + e5 * e5) + (e6 * e6 + e7 * e7); }
#pragma unroll
        for (int kk = 0; kk < 32; ++kk) asm volatile("" : "+v"(xf[kk].x), "+v"(xf[kk].y), "+v"(xf[kk].z), "+v"(xf[kk].w));
        ssq += __shfl_xor(ssq, 16); ssq += __shfl_xor(ssq, 32);
        const float rstd = rsqrtf(ssq * (1.f / D) + RMS_EPS);
        f32x4 acc = {0.f, 0.f, 0.f, 0.f};
        GAS v4u* ho = (GAS v4u*)(H2 + (size_t)(m0 + n) * D + 8 * kq);
#pragma unroll
        for (int kk = 0; kk < 32; ++kk) { const v4u w = xf[kk]; const int col = 32 * kk + 8 * kq;
            const f32x4 g0 = *(const LAS f32x4*)(ga + b * D + col), g1 = *(const LAS f32x4*)(ga + b * D + col + 4), s0 = *(const LAS f32x4*)(sh + b * D + col), s1 = *(const LAS f32x4*)(sh + b * D + col + 4);
            float h[8] = {bf_lo(w.x) * rstd * g0.x + s0.x, bf_hi(w.x) * rstd * g0.y + s0.y, bf_lo(w.y) * rstd * g0.z + s0.z, bf_hi(w.y) * rstd * g0.w + s0.w,
                          bf_lo(w.z) * rstd * g1.x + s1.x, bf_hi(w.z) * rstd * g1.y + s1.y, bf_lo(w.w) * rstd * g1.z + s1.z, bf_hi(w.w) * rstd * g1.w + s1.w};
            v4u hh, hl;
            hh.x = cvt_pk_bf16(h[0], h[1]); hh.y = cvt_pk_bf16(h[2], h[3]); hh.z = cvt_pk_bf16(h[4], h[5]); hh.w = cvt_pk_bf16(h[6], h[7]);
            hl.x = cvt_pk_bf16(h[0] - bf_lo(hh.x), h[1] - bf_hi(hh.x)); hl.y = cvt_pk_bf16(h[2] - bf_lo(hh.y), h[3] - bf_hi(hh.y)); hl.z = cvt_pk_bf16(h[4] - bf_lo(hh.z), h[5] - bf_hi(hh.z)); hl.w = cvt_pk_bf16(h[6] - bf_lo(hh.w), h[7] - bf_hi(hh.w));
            if (MOE_FP8) { v2u q8; q8.x = pk4_fp8(h[0], h[1], h[2], h[3]); q8.y = pk4_fp8(h[4], h[5], h[6], h[7]); *(GAS v2u*)(H2F8 + (size_t)(m0 + n) * D + 32 * kk + 8 * kq) = q8; }
            else ho[4 * kk] = hh;
            const bf16x8 ah = *(const LAS bf16x8*)(whi + (kk * 64 + lane) * 8), al = *(const LAS bf16x8*)(wlo + (kk * 64 + lane) * 8);
            const bf16x8 bh = __builtin_bit_cast(bf16x8, hh), bl = __builtin_bit_cast(bf16x8, hl);
            acc = __builtin_amdgcn_mfma_f32_16x16x32_bf16(ah, bh, acc, 0, 0, 0); acc = __builtin_amdgcn_mfma_f32_16x16x32_bf16(al, bh, acc, 0, 0, 0); acc = __builtin_amdgcn_mfma_f32_16x16x32_bf16(ah, bl, acc, 0, 0, 0);
            asm volatile("" ::: "memory"); }
        float lg[4], mx = -3.0e38f;
#pragma unroll
        for (int r = 0; r < 4; ++r) { lg[r] = acc[r] + br[r]; mx = fmaxf(mx, lg[r]); }
        mx = fmaxf(mx, __shfl_xor(mx, 16)); mx = fmaxf(mx, __shfl_xor(mx, 32));
        float sum = 0.f;
#pragma unroll
        for (int r = 0; r < 4; ++r) { lg[r] = __expf(lg[r] - mx); sum += lg[r]; }
        sum += __shfl_xor(sum, 16); sum += __shfl_xor(sum, 32);
        const float inv = 1.0f / sum; const int s = (m0 + n) & (SEQ - 1);
#pragma unroll
        for (int r = 0; r < 4; ++r) probs[((size_t)(b * NE + 4 * kq + r)) * SEQ + s] = lg[r] * inv; }
    __syncthreads();
}
__device__ __forceinline__ void topk_item(const float* probs, int* idx, float* val, int* slot, LAS unsigned char* lds, int item, int tid, int wave, int lane) {
    const int e = item >> 1, b = item & 1;
    LAS int* red = (LAS int*)lds;
    unsigned p[16];
#pragma unroll
    for (int q = 0; q < 4; ++q) { const v4u w = *(const GAS v4u*)(probs + ((size_t)(b * NE + e)) * SEQ + 16 * tid + 4 * q); p[4 * q] = w.x; p[4 * q + 1] = w.y; p[4 * q + 2] = w.z; p[4 * q + 3] = w.w; }
    unsigned prefix = 0u;
    for (int bit = 30; bit >= 0; --bit) { const unsigned cand = prefix | (1u << bit); int cnt = 0;
#pragma unroll
        for (int j = 0; j < 16; ++j) cnt += __popcll(__ballot(p[j] >= cand));
        const int par = bit & 1;
        if (lane == 0) red[par * 8 + wave] = cnt;
        __syncthreads();
        int tot = 0;
#pragma unroll
        for (int w = 0; w < 8; ++w) tot += red[par * 8 + w];
        if (tot >= CAP) prefix = cand; }
    const unsigned T = prefix;
    int cgt = 0, ceq = 0;
#pragma unroll
    for (int j = 0; j < 16; ++j) { cgt += (p[j] > T) ? 1 : 0; ceq += (p[j] == T) ? 1 : 0; }
    int sgt = cgt, seq = ceq;
#pragma unroll
    for (int o = 1; o < 64; o <<= 1) { const int a = __shfl_up(sgt, o), c = __shfl_up(seq, o); if (lane >= o) { sgt += a; seq += c; } }
    __syncthreads();
    if (lane == 63) { red[32 + wave] = sgt; red[48 + wave] = seq; }
    __syncthreads();
    int bgt = 0, beq = 0, totgt = 0;
#pragma unroll
    for (int w = 0; w < 8; ++w) { const int a = red[32 + w], c = red[48 + w]; if (w < wave) { bgt += a; beq += c; } totgt += a; }
    int rgt = bgt + sgt - cgt, req = beq + seq - ceq;
    const int need = CAP - totgt; const int rbase = (e * 2 + b) * CAP;
#pragma unroll
    for (int j = 0; j < 16; ++j) { const int tok = b * SEQ + 16 * tid + j; int sl = -1;
        if (p[j] > T) { sl = rgt; ++rgt; } else if (p[j] == T) { if (req < need) sl = totgt + req; ++req; }
        slot[(size_t)tok * NE + e] = sl;
        if (sl >= 0) { idx[rbase + sl] = tok; val[rbase + sl] = __uint_as_float(p[j]); } }
    __syncthreads();
}
__device__ __forceinline__ void phase_gather(const bf16* H2, const int* idx, bf16* XE, int wave, int lane, int vcu, int G) {
    const int gw = vcu * NWAVES + wave, NGW = G * NWAVES;
    for (int r = gw; r < MR; r += NGW) { const int tok = idx[r];
        const GAS v4u* src = (const GAS v4u*)(H2 + (size_t)tok * D) + lane; GAS v4u* dst = (GAS v4u*)(XE + (size_t)r * D) + lane;
        const v4u a = src[0], b2 = src[64]; dst[0] = a; dst[64] = b2; }
}
__device__ __forceinline__ void phase_final(float* out, const bf16* X1B, const bf16* Y, const int* slot, const float* mod, const float* g_fin, int wave, int lane, int vcu, int G, float pert) {
    const int gw = vcu * NWAVES + wave, NGW = G * NWAVES;
    int slv[2]; v2u xw[2][4];
#define PF_FETCH(mm) do { _Pragma("unroll") for (int r = 0; r < 2; ++r) { slv[r] = slot[(size_t)((mm) + r) * NE + (lane & 15)]; const GAS v2u* xr_ = (const GAS v2u*)(X1B + (size_t)((mm) + r) * D) + lane; \
        _Pragma("unroll") for (int j = 0; j < 4; ++j) xw[r][j] = xr_[64 * j]; } } while (0)
    int m0 = gw * 2;
    if (m0 < M) PF_FETCH(m0);
    for (; m0 < M; m0 += NGW * 2) { const int b = m0 >> 13;
        int cs[2]; f32x4 v[2][4], a[2][4];
#pragma unroll
        for (int r = 0; r < 2; ++r) { cs[r] = slv[r];
#pragma unroll
            for (int j = 0; j < 4; ++j) { const v2u w = xw[r][j]; v[r][j] = (f32x4){bf_lo(w.x), bf_hi(w.x), bf_lo(w.y), bf_hi(w.y)}; a[r][j] = (f32x4){0.f, 0.f, 0.f, 0.f}; } }
        const int mn = m0 + NGW * 2;
        if (mn < M) PF_FETCH(mn);
        unsigned long long mask[2]; bool more = false;
#pragma unroll
        for (int r = 0; r < 2; ++r) mask[r] = __ballot(cs[r] >= 0) & 0xFFFFull;
        do { const GAS v2u* yp[2][4]; bool ok[2][4]; v2u w[2][4][4];
#pragma unroll
            for (int r = 0; r < 2; ++r)
#pragma unroll
                for (int c = 0; c < 4; ++c) { ok[r][c] = (mask[r] != 0ull); const int e = ok[r][c] ? (int)__builtin_ctzll(mask[r]) : 0; mask[r] &= (mask[r] - 1ull);
                    const int sl = __builtin_amdgcn_readlane(cs[r], e); yp[r][c] = (const GAS v2u*)(Y + ((size_t)(e * 2 + b) * CAP + (ok[r][c] ? sl : 0)) * D) + lane; }
#pragma unroll
            for (int r = 0; r < 2; ++r)
#pragma unroll
                for (int c = 0; c < 4; ++c) if (ok[r][c]) {
#pragma unroll
                    for (int j = 0; j < 4; ++j) w[r][c][j] = yp[r][c][64 * j]; }
#pragma unroll
            for (int r = 0; r < 2; ++r)
#pragma unroll
                for (int c = 0; c < 4; ++c) if (ok[r][c]) {
#pragma unroll
                    for (int j = 0; j < 4; ++j) { a[r][j].x += bf_lo(w[r][c][j].x); a[r][j].y += bf_hi(w[r][c][j].x); a[r][j].z += bf_lo(w[r][c][j].y); a[r][j].w += bf_hi(w[r][c][j].y); } }
            more = (mask[0] | mask[1]) != 0ull;
        } while (more);
        float s[2];
#pragma unroll
        for (int r = 0; r < 2; ++r) { s[r] = 0.f;
#pragma unroll
            for (int j = 0; j < 4; ++j) { const f32x4 gf = *(const GAS f32x4*)(mod + b * 6 * D + 5 * D + 4 * lane + 256 * j); v[r][j] = v[r][j] + gf * a[r][j]; s[r] += (v[r][j].x * v[r][j].x + v[r][j].y * v[r][j].y) + (v[r][j].z * v[r][j].z + v[r][j].w * v[r][j].w); } }
#pragma unroll
        for (int o = 1; o < 64; o <<= 1) { s[0] += __shfl_xor(s[0], o); s[1] += __shfl_xor(s[1], o); }
#pragma unroll
        for (int r = 0; r < 2; ++r) { const float rr = rsqrtf(s[r] * (1.f / D) + RMS_EPS); GAS f32x4* xo = (GAS f32x4*)(out + (size_t)(m0 + r) * D) + lane;
#pragma unroll
            for (int j = 0; j < 4; ++j) { const f32x4 gg = *(const GAS f32x4*)(g_fin + 4 * lane + 256 * j); xo[64 * j] = v[r][j] * rr * gg + pert; } } }
#undef PF_FETCH
}
__device__ __forceinline__ void fft_item(LAS unsigned char* lds, const bf16* UF, bf16* ZF, const bf16* Fc1, const bf16* Fc2, int item, int wave, int lane) {
    const char* slab = (const char*)UF + (size_t)item * 65536;
    { v4u xv[8];
#pragma unroll
      for (int p = 0; p < 8; ++p) { const int s1 = 8 * p + wave; xv[p] = *(const GAS v4u*)(slab + s1 * 1024 + ((16 * lane - 32 * ((s1 >> 3) & 3)) & 1023)); }
#pragma unroll
      for (int p = 0; p < 8; ++p) *(LAS v4u*)(lds + (8 * p + wave) * 1024 + 16 * lane) = xv[p]; }
    bf16x8 A2[2][8];
#pragma unroll
    for (int ro = 0; ro < 2; ++ro)
#pragma unroll
        for (int kk = 0; kk < 8; ++kk) A2[ro][kk] = *(const GAS bf16x8*)(Fc2 + ((size_t)(((wave * 2 + ro) * 8 + kk) * 64 + lane)) * 8);
    LDS_WAIT(); __syncthreads();
    const int fr = lane & 15, fq = lane >> 4, ch = lane & 3, s2l = (lane & 15) >> 2;
    char* zb = (char*)ZF + (size_t)item * 131072;
    for (int hh = 0; hh < 2; ++hh) {
        { bf16x8 A1[4][2];
#pragma unroll
          for (int mt = 0; mt < 4; ++mt)
#pragma unroll
              for (int kk = 0; kk < 2; ++kk) A1[mt][kk] = *(const GAS bf16x8*)(Fc1 + ((size_t)(((hh * 4 + mt) * 2 + kk) * 64 + lane)) * 8);
          for (int jn = 0; jn < 4; ++jn) { const int nt = wave + 8 * jn, s2 = 4 * nt + s2l;
            bf16x8 Bx[2];
#pragma unroll
            for (int kk = 0; kk < 2; ++kk)
#pragma unroll
                for (int j = 0; j < 8; ++j) { const int s1 = 32 * kk + 8 * fq + j; Bx[kk][j] = *(const LAS short*)(lds + s1 * 1024 + ((s2 * 8 + ch * 2 + 32 * fq) & 1023)); }
            f32x4 acc[4];
#pragma unroll
            for (int mt = 0; mt < 4; ++mt) { acc[mt] = (f32x4){0.f, 0.f, 0.f, 0.f};
#pragma unroll
                for (int kk = 0; kk < 2; ++kk) acc[mt] = __builtin_amdgcn_mfma_f32_16x16x32_bf16(A1[mt][kk], Bx[kk], acc[mt], 0, 0, 0); }
#pragma unroll
            for (int blk = 0; blk < 2; ++blk)
#pragma unroll
                for (int r = 0; r < 4; ++r) { const int k1l = 16 * blk + 4 * r + fq, k1 = 32 * hh + k1l; const float dr = acc[blk][r], di = acc[2 + blk][r];
                    const float frac = (float)((s2 * k1) & 8191) * (1.0f / 8192.0f), c = __builtin_amdgcn_cosf(frac), s = __builtin_amdgcn_sinf(frac);
                    *(LAS unsigned*)(lds + FFT_TOFF + (k1l * 4 + ch) * FFT_TPITCH + s2 * 4) = cvt_pk_bf16(dr * c + di * s, di * c - dr * s); } } }
        LDS_WAIT(); __syncthreads();
        for (int nt2 = 0; nt2 < 8; ++nt2) { f32x4 c0 = {0.f, 0.f, 0.f, 0.f}, c1 = {0.f, 0.f, 0.f, 0.f};
#pragma unroll
            for (int kk = 0; kk < 8; ++kk) { const bf16x8 Bt = *(const LAS bf16x8*)(lds + FFT_TOFF + (16 * nt2 + fr) * FFT_TPITCH + kk * 64 + fq * 16);
                c0 = __builtin_amdgcn_mfma_f32_16x16x32_bf16(A2[0][kk], Bt, c0, 0, 0, 0); c1 = __builtin_amdgcn_mfma_f32_16x16x32_bf16(A2[1][kk], Bt, c1, 0, 0, 0); }
            const int k1 = 32 * hh + 4 * nt2 + s2l;
#pragma unroll
            for (int r = 0; r < 4; ++r) { const int k = k1 + 64 * (16 * wave + 4 * fq + r); *(GAS unsigned*)(zb + (size_t)k * 16 + ch * 4) = cvt_pk_bf16(c0[r], c1[r]); } }
        LDS_WAIT(); __syncthreads();
    }
}
constexpr int NPHASE = 12;
#ifndef EXTRA_BARS
#define EXTRA_BARS 0
#endif
#ifndef STAGGER_US
#define STAGGER_US 0
#endif
#ifndef DOUBLE_PH
#define DOUBLE_PH -1
#endif
#define REP(k) for (int rep_ = 0; rep_ < ((DOUBLE_PH == (k)) ? 2 : 1); ++rep_)
#define REPBAR(k) do { if (DOUBLE_PH == (k) && rep_ == 0) xcd_barrier(bar); } while (0)
#ifndef PROBE_I
#define PROBE_I -1
#endif
#ifndef PROBE_J
#define PROBE_J -1
#endif
#ifndef DBG_PLAIN
#define DBG_PLAIN 0
#endif
#ifndef GALIGN
#define GALIGN true
#endif
#ifndef GSP2
#define GSP2 true
#endif
struct Args { const float* in[18]; float* out; unsigned char* ws; int ph_lo, ph_hi; };
__global__ void __launch_bounds__(NWAVES * 64, 2) fwd(Args args) {
    extern __shared__ __attribute__((aligned(16))) unsigned char lds_raw[];
    LAS unsigned char* lds = (LAS unsigned char*)lds_raw;
    volatile LAS unsigned* MISC = (volatile LAS unsigned*)(lds + MISC_OFF);
    const int tid = threadIdx.x, lane = tid & 63, wave = __builtin_amdgcn_readfirstlane(tid >> 6);
    const int G = gridDim.x; const int bx = blockIdx.x; const int vcu = (G % 8 == 0) ? (bx % 8) * (G / 8) + bx / 8 : bx;
    unsigned char* ws = args.ws;
    const float *x = args.in[0], *c = args.in[1], *w_ada = args.in[2], *b_ada = args.in[3], *g_mix = args.in[4], *w_in = args.in[5], *b_gate = args.in[6], *w_f = args.in[7], *w_conv = args.in[8],
                *w_co = args.in[9], *w_o = args.in[10], *g_moe = args.in[11], *w_r = args.in[12], *b_r = args.in[13], *w_g = args.in[14], *w_u = args.in[15], *w_d = args.in[16], *g_fin = args.in[17];
    float* out = args.out;
    float *modp = (float*)(ws + WS_MODP), *mod = (float*)(ws + WS_MOD), *probs = (float*)(ws + WS_PROBS), *val = (float*)(ws + WS_VAL);
    int *slot = (int*)(ws + WS_SLOT), *idx = (int*)(ws + WS_IDX);
    bf16 *Fc1 = (bf16*)(ws + WS_FC1), *Fc2 = (bf16*)(ws + WS_FC2), *WIN = (bf16*)(ws + WS_WIN), *WF = (bf16*)(ws + WS_WF), *WCO = (bf16*)(ws + WS_WCO), *WO = (bf16*)(ws + WS_WO), *WGU = (bf16*)(ws + WS_WGU), *WD = (bf16*)(ws + WS_WD);
    bf16 *H1 = (bf16*)(ws + WS_H1), *AB = (bf16*)(ws + WS_AB), *UF = (bf16*)(ws + WS_UF), *CV = (bf16*)(ws + WS_CV), *BG = (bf16*)(ws + WS_BG), *GA = (bf16*)(ws + WS_GA), *GB = (bf16*)(ws + WS_GB), *ZF = (bf16*)(ws + WS_ZF),
         *TZ = (bf16*)(ws + WS_TZ), *H2 = (bf16*)(ws + WS_H2), *HM = (bf16*)(ws + WS_HM), *Y = (bf16*)(ws + WS_Y), *X1B = (bf16*)(ws + WS_X1B);
    unsigned char *WGU8 = ws + WS_WGU, *WD8 = ws + WS_WD, *H2F8 = ws + WS_H2, *HM8 = ws + WS_HM;
    for (int u = tid; u < (LDS_BYTES - MISC_OFF) / 4; u += NWAVES * 64) ((LAS unsigned*)(lds + MISC_OFF))[u] = 0u;
    __syncthreads();
    const int lo = args.ph_lo, hi = args.ph_hi;
    XcdBarrier bar; bar.bar = (unsigned*)(ws + WS_CTL) + CW_BAR; bar.x = 0; bar.st = nullptr;
    if (hi - lo > 1) bar = xcd_barrier_post((unsigned*)(ws + WS_CTL) + CW_BAR, MISC + 8);
#define IN(k) (lo <= (k) && (k) < hi)
#if PROBE_I >= 0
    unsigned long long* tsb = (unsigned long long*)(ws + WS_CTL + 512 * 1024);
    if (bx == 0 && tid == 0) tsb[0] = __builtin_amdgcn_s_memrealtime();
#define GRID_BAR(k) do { if (IN(k) && IN((k) + 1)) xcd_barrier(bar); if (bx == 0 && tid == 0) tsb[(k) + 1] = __builtin_amdgcn_s_memrealtime(); } while (0)
#else
#define GRID_BAR(k) do { if (IN(k) && IN((k) + 1)) xcd_barrier(bar); } while (0)
#endif
    const int gw = vcu * NWAVES + wave, NGW = G * NWAVES;

    if (IN(0)) REP(0) {
        if (vcu < 96) mod_item(c, w_ada, modp, lds, vcu, tid, wave, lane);
        fc_tables(Fc1, Fc2, vcu * NWAVES * 64 + tid, G * NWAVES * 64);
        LAS float* scr = (LAS float*)(lds + wave * 16384);
        constexpr int I_WF = 2048, I_IN = 16 * 176, I_SQ = 16 * 32, I_EX = 3072, NITEMS = I_WF + I_IN + 2 * I_SQ + NE * I_EX;
        for (int it = gw; it < NITEMS; it += NGW) {
            int r = it;
            if (r < I_WF) { wf_item(w_f, WF, r, lane); continue; } r -= I_WF;
            if (r < I_IN) { transpose_item<1>(w_in, D, DIN, WIN, scr, r, lane); continue; } r -= I_IN;
            if (r < I_SQ) { transpose_item<0>(w_co, D, D, WCO, scr, r, lane); continue; } r -= I_SQ;
            if (r < I_SQ) { transpose_item<0>(w_o, D, D, WO, scr, r, lane); continue; } r -= I_SQ;
            const int e = r / I_EX, q = r % I_EX;
#if MOE_FP8
            if (q < 1024) transpose_item8<2>(w_g + (size_t)e * D * DE, D, DE, WGU8 + (size_t)e * 4096 * D, scr, q, lane);
            else if (q < 2048) transpose_item8<3>(w_u + (size_t)e * D * DE, D, DE, WGU8 + (size_t)e * 4096 * D, scr, q - 1024, lane);
            else transpose_item8<0>(w_d + (size_t)e * DE * D, DE, D, WD8 + (size_t)e * D * DE, scr, q - 2048, lane);
#else
            if (q < 1024) transpose_item<2>(w_g + (size_t)e * D * DE, D, DE, WGU + (size_t)e * 4096 * D, scr, q, lane);
            else if (q < 2048) transpose_item<3>(w_u + (size_t)e * D * DE, D, DE, WGU + (size_t)e * 4096 * D, scr, q - 1024, lane);
            else transpose_item<0>(w_d + (size_t)e * DE * D, DE, D, WD + (size_t)e * D * DE, scr, q - 2048, lane);
#endif
        }
        GRID_BAR(0);
    }
    if (IN(1)) REP(1) { phase_h(x, g_mix, b_ada, modp, mod, H1, lds, tid, wave, lane, vcu, G); GRID_BAR(1); }
#if EXTRA_BARS > 0
    if (IN(1) && IN(2)) { for (int eb = 0; eb < EXTRA_BARS; ++eb) xcd_barrier(bar); }
#endif
    if (IN(2)) REP(2) {
#if STAGGER_US > 0
        if (bx >= 128) { const unsigned long long t0 = __builtin_amdgcn_s_memrealtime(); while (__builtin_amdgcn_s_memrealtime() - t0 < (unsigned long long)(STAGGER_US * 100)) __builtin_amdgcn_s_sleep(8); }
#endif
        pg8::Gemm g{H1, WIN, M, DIN, D, 0, 0, nullptr}; pg8::StaticOrder S; S.init(M, DIN, G, bx);
#if DBG_PLAIN
        EpiPlain E{UF, DIN};
        pg8::gemm_phase<EpiPlain, pg8::StaticOrder, 0, GALIGN, GSP2>(lds, g, S, E);
#else
        EpiInProj E{UF, CV, BG, GA, GB, b_gate};
        pg8::gemm_phase<EpiInProj, pg8::StaticOrder, 0, GALIGN, GSP2>(lds, g, S, E);
#endif
        GRID_BAR(2);
    }
    if (IN(3)) REP(3) {
        for (int it = vcu; it < BATCH * 128; it += G) fft_item(lds, UF, ZF, Fc1, Fc2, it, wave, lane);
        phase_conv(CV, BG, w_conv, AB, wave, lane, vcu, G);
        GRID_BAR(3);
    }
    if (IN(4)) REP(4) {
        { pg8::Gemm g{ZF, WF, M, D, D, 0, 0, nullptr}; pg8::StaticOrder S; S.init(M, D, G, bx); EpiGateMul<0> E{TZ, GA};
          pg8::gemm_phase<EpiGateMul<0>, pg8::StaticOrder, 1, true, true>(lds, g, S, E); }
        { pg8::Gemm g{AB, WCO, M, D, D, 0, 0, nullptr}; pg8::StaticOrder S; S.init(M, D, G, bx); EpiGateMul<1> E{TZ, GB};
          pg8::gemm_phase<EpiGateMul<1>, pg8::StaticOrder, 0, true, true>(lds, g, S, E); }
        GRID_BAR(4);
    }
    if (IN(5)) REP(5) {
        pg8::Gemm g{TZ, WO, M, D, D, 0, 0, nullptr}; pg8::StaticOrder S; S.init(M, D, G, bx); EpiResid E{x, X1B, mod + 2 * D};
        pg8::gemm_phase<EpiResid, pg8::StaticOrder, 0, true, true>(lds, g, S, E);
        GRID_BAR(5);
    }
    if (IN(6)) REP(6) { phase_h2(X1B, g_moe, mod, w_r, b_r, H2, H2F8, probs, lds, tid, wave, lane, vcu, G); GRID_BAR(6); }
    if (IN(7)) REP(7) { for (int it = vcu; it < NE * BATCH; it += G) topk_item(probs, idx, val, slot, lds, it, tid, wave, lane); GRID_BAR(7); }
    if (IN(9)) REP(9) {
#if MOE_FP8
        pg8::Gemm g{(const bf16*)H2F8, (const bf16*)WGU8, MR, 2 * DE, D / 2, 8, (size_t)2 * DE * D / 2, idx}; pg8::StaticOrder S; S.init(MR, 2 * DE, G, bx); EpiSwiGLU8 E{HM8};
        pg8::gemm_phase<EpiSwiGLU8, pg8::StaticOrder, 2, true, true, true>(lds, g, S, E);
#else
        pg8::Gemm g{H2, WGU, MR, 2 * DE, D, 8, (size_t)2 * DE * D, idx}; pg8::StaticOrder S; S.init(MR, 2 * DE, G, bx); EpiSwiGLU E{HM};
        pg8::gemm_phase<EpiSwiGLU, pg8::StaticOrder, 2, true, true>(lds, g, S, E);
#endif
        GRID_BAR(9);
    }
    if (IN(10)) REP(10) {
#if MOE_FP8
        pg8::Gemm g{(const bf16*)HM8, (const bf16*)WD8, MR, D, DE / 2, 8, (size_t)D * DE / 2, nullptr}; pg8::StaticOrder S; S.init(MR, D, G, bx); EpiRowScale E{Y, val};
        pg8::gemm_phase<EpiRowScale, pg8::StaticOrder, 0, true, true, true>(lds, g, S, E);
#else
        pg8::Gemm g{HM, WD, MR, D, DE, 8, (size_t)D * DE, nullptr}; pg8::StaticOrder S; S.init(MR, D, G, bx); EpiRowScale E{Y, val};
        pg8::gemm_phase<EpiRowScale, pg8::StaticOrder, 0, true, true>(lds, g, S, E);
#endif
#if PROBE_I >= 0
        if (bx == 0 && tid == 0) tsb[12] = __builtin_amdgcn_s_memrealtime();
#endif
        GRID_BAR(10);
    }
#if PROBE_I >= 0
    float pert = 0.f;
    if (IN(11)) { const unsigned long long a0 = __hip_atomic_load(tsb + (PROBE_I == 100 ? 0 : PROBE_I == 9 ? 8 : PROBE_I), __ATOMIC_RELAXED, __HIP_MEMORY_SCOPE_AGENT), a1 = __hip_atomic_load(tsb + (PROBE_I == 100 ? 12 : PROBE_I == 10 ? 12 : PROBE_I + 1), __ATOMIC_RELAXED, __HIP_MEMORY_SCOPE_AGENT); pert = (float)(a1 - a0) * 0.01f * (PROBE_I == 100 ? (1.0f / 64000.0f) : (1.0f / 16000.0f)); }
    if (PROBE_I == 102) { pert = 0.f; if (bx == 0 && tid == 0) tsb[14] = __builtin_amdgcn_s_memrealtime(); __syncthreads(); }
    if (PROBE_I == 101) { pert = 0.f; if (bx == 0) { const unsigned long long a0 = __hip_atomic_load(tsb + 12, __ATOMIC_RELAXED, __HIP_MEMORY_SCOPE_AGENT); pert = (float)(__builtin_amdgcn_s_memrealtime() - a0) * 0.01f * (1.0f / 250.0f); } }
    if (IN(11)) phase_final(out, X1B, Y, slot, mod, g_fin, wave, lane, vcu, G, pert);
    if (PROBE_I == 102) {
        const unsigned long long t_a = tsb[14];
        xcd_barrier(bar);
        if (bx == 0) { const float pp = (float)(__builtin_amdgcn_s_memrealtime() - t_a) * 0.01f * (1.0f / 250.0f);
            for (int k = 0; k < 4; ++k) for (int r = 0; r < 2; ++r) { float* row = out + (size_t)(2 * (vcu * NWAVES + wave) + r + 4096 * k) * D; for (int cc = lane; cc < D; cc += 64) row[cc] += pp; } } }
#else
    if (IN(11)) REP(11) { phase_final(out, X1B, Y, slot, mod, g_fin, wave, lane, vcu, G, 0.f); if (DOUBLE_PH == 11 && rep_ == 0) xcd_barrier(bar); }
#endif

#undef IN
#undef GRID_BAR
}


struct DumpArgs { const unsigned short* p[8]; unsigned long long n[8]; int f32[8]; int nb; int pad; };
__global__ void k_dump(float* out, DumpArgs a) {
    const size_t i = (size_t)blockIdx.x * blockDim.x + threadIdx.x; float s = 0.f;
    for (int b = 0; b < a.nb; ++b) for (size_t j = i; j < a.n[b]; j += (size_t)M * D) s += (a.f32[b] ? ((const float*)a.p[b])[j] : __uint_as_float(((unsigned)a.p[b][j]) << 16)) * (float)(b + 1);
    out[i] = s;
}
#ifndef DUMP_WHICH
#define DUMP_WHICH -1
#endif
#ifndef STOP_AFTER
#define STOP_AFTER (NPHASE - 1)
#endif
#ifndef MK_PER_PHASE
#define MK_PER_PHASE 0
#endif
extern "C" void kernel_launch(void* const* d_in, const int* in_sizes, int n_in, void* d_out, int out_size, void* d_ws, size_t ws_size, hipStream_t stream) {
    static int grid = 0;
    if (grid == 0) {
        if (n_in != 18 || in_sizes[0] != M * D || out_size != M * D || ws_size < WS_END) { fprintf(stderr, "kernel_launch: unexpected shapes (n_in %d, in0 %d, out %d, ws %zu); nothing launched\n", n_in, n_in > 0 ? in_sizes[0] : -1, out_size, ws_size); grid = -1; return; }
        int dev = 0, cus = 0, per_cu = 0;
        if (hipGetDevice(&dev) != hipSuccess || hipDeviceGetAttribute(&cus, hipDeviceAttributeMultiprocessorCount, dev) != hipSuccess) { grid = -1; return; }
        if (hipFuncSetAttribute((const void*)fwd, hipFuncAttributeMaxDynamicSharedMemorySize, LDS_BYTES) != hipSuccess) { fprintf(stderr, "kernel_launch: hipFuncSetAttribute failed\n"); grid = -1; return; }
        if (hipOccupancyMaxActiveBlocksPerMultiprocessor(&per_cu, (const void*)fwd, NWAVES * 64, LDS_BYTES) != hipSuccess || per_cu < 1) { fprintf(stderr, "kernel_launch: occupancy query reports %d blocks per CU\n", per_cu); }
        (void)hipGetLastError();
        grid = cus;
    }
    if (grid < 0) return;
    (void)hipMemsetAsync((char*)d_ws + WS_CTL, 0, CTL_ZERO_BYTES, stream);
    Args a{};
    for (int i = 0; i < 18; ++i) a.in[i] = (const float*)d_in[i];
    a.out = (float*)d_out; a.ws = (unsigned char*)d_ws;
#if MK_PER_PHASE
    for (int p = 0; p < STOP_AFTER + 1; ++p) { a.ph_lo = p; a.ph_hi = p + 1; hipLaunchKernelGGL(fwd, dim3(grid), dim3(NWAVES * 64), LDS_BYTES, stream, a); }
#if DUMP_WHICH >= 0
    { DumpArgs da{}; unsigned char* w = (unsigned char*)d_ws; int nb = 0;
      auto add = [&](size_t off, size_t n, int isf = 0) { da.p[nb] = (const unsigned short*)(w + off); da.n[nb] = n; da.f32[nb] = isf; ++nb; };
      if (DUMP_WHICH == 0) { add(WS_WIN, (size_t)DIN * D); add(WS_WF, (size_t)D * D); add(WS_WCO, (size_t)D * D); add(WS_WO, (size_t)D * D); add(WS_WGU, (size_t)NE * 4096 * D); add(WS_WD, (size_t)NE * D * DE); add(WS_FC1, 8192 + 0); add(WS_MODP, 4 * 2 * 6 * D, 1); }
      if (DUMP_WHICH == 1) { add(WS_H1, (size_t)M * D); add(WS_MOD, 2 * 6 * D, 1); add(WS_FC2, 65536); }
      if (DUMP_WHICH == 2) { add(WS_UF, (size_t)M * DF); add(WS_CV, (size_t)M * D); add(WS_BG, (size_t)M * D); add(WS_GA, (size_t)M * D); add(WS_GB, (size_t)M * D); }
      if (DUMP_WHICH == 5) { add(WS_UF, (size_t)M * DIN); }
      if (DUMP_WHICH == 6) { add(WS_UF, (size_t)M * DF); add(WS_CV, (size_t)M * D); }
      if (DUMP_WHICH == 7) { add(WS_BG, (size_t)M * D); }
      if (DUMP_WHICH == 8) { add(WS_GA, (size_t)M * D); add(WS_GB, (size_t)M * D); }
      if (DUMP_WHICH == 9) { add(WS_GA, (size_t)M * D); }
      if (DUMP_WHICH == 10) { add(WS_GB, (size_t)M * D); }
      if (DUMP_WHICH == 3) { add(WS_ZF, (size_t)M * D); add(WS_AB, (size_t)M * D); }
      if (DUMP_WHICH == 4) { add(WS_TZ, (size_t)M * D); }
      da.nb = nb; hipLaunchKernelGGL(k_dump, dim3(M * D / 256), dim3(256), 0, stream, (float*)d_out, da); }
#endif
#else
    a.ph_lo = 0; a.ph_hi = NPHASE; hipLaunchKernelGGL(fwd, dim3(grid), dim3(NWAVES * 64), LDS_BYTES, stream, a);
#endif
}
```

```cpp
#include <hip/hip_runtime.h>
#include <cstdio>
#include <cstdint>
#define MK_PER_PHASE 0
#define STOP_AFTER 11
#define DUMP_WHICH -1
#define GALIGN true
#define GSP2 true
#define DBG_PLAIN 0
#define DBG_NOBIAS 0
#define DBG_NOSIG 0
#define PROBE_I -1
#define PROBE_J -1
#define DOUBLE_PH -1
#define STAGGER_US 0
#define EXTRA_BARS 0
#define DBG_EPI2 0
#ifndef DBG_EPI2
#define DBG_EPI2 0
#endif
namespace pg8 {
#define PG8_LAS __attribute__((address_space(3)))
typedef unsigned short bf16_t;
typedef short bf16x8 __attribute__((ext_vector_type(8)));
typedef float f32x4 __attribute__((ext_vector_type(4)));
typedef unsigned u32x4 __attribute__((ext_vector_type(4)));
typedef unsigned u32x2 __attribute__((ext_vector_type(2)));
typedef int v8i __attribute__((ext_vector_type(8)));
typedef int v4i __attribute__((ext_vector_type(4)));
constexpr int BM = 256, BK = 64, HALF = 128, HTB = HALF * BK * 2  , STAGE_BYTES = 8 * HTB, NXCD = 8, WGM = 8;

__host__ __device__ __forceinline__ int lds_byte(int r, int c) { const int st = (r >> 4) * 2 + (c >> 5), rr = r & 15, cc = c & 31, ob = rr * 64 + cc * 2; return st * 1024 + (ob ^ (((ob >> 9) & 1) << 5)); }
__host__ __device__ __forceinline__ void stage_rc(int b, int& R, int& C) { const int st = b / 1024, sb = b % 1024, swz = sb ^ (((sb >> 9) & 1) << 5); R = (st >> 1) * 16 + swz / 64; C = (st & 1) * 32 + (swz % 64) / 2; }
__host__ __device__ __forceinline__ int perm32(int rho) { const int n = rho >> 4, i = rho & 15; return 8 * (i >> 2) + 4 * n + (i & 3); }

struct Unit { int pm, pn; };
struct Gemm { const bf16_t* A; const bf16_t* Bt; int M, N, K; int bgrp; size_t bstride; const int* gidx; };

struct StaticOrder {
    int nM, nN, nwg, G, c;
    __host__ __device__ void init(int M, int N, int G_, int c_) { nM = M / BM; nN = N / BM; nwg = nM * nN; G = G_; c = c_; }
    __host__ __device__ bool next(int i, Unit& u) const {
        const long L = (long)i * G + c; if (L >= nwg) return false;
        int wgid = (int)L; { const int q = nwg / NXCD, r = nwg % NXCD, xcd = wgid % NXCD, off = wgid / NXCD; wgid = (xcd < r ? xcd * (q + 1) : r * (q + 1) + (xcd - r) * q) + off; }
        const int nig = WGM * nN, gid = wgid / nig, fm = gid * WGM, gsz = (nM - fm) < WGM ? (nM - fm) : WGM;
        u.pm = fm + ((wgid % nig) % gsz); u.pn = (wgid % nig) / gsz; return true;
    }
    __device__ __forceinline__ void a_ready(const Unit&) const {}
    __device__ __forceinline__ void done(const Unit&) const {}
};

typedef __bf16 bf16x2_t __attribute__((ext_vector_type(2)));
typedef float f32x2_t __attribute__((ext_vector_type(2)));
__device__ __forceinline__ unsigned cvt_pk_bf16(float lo, float hi) { const f32x2_t v = {lo, hi}; const bf16x2_t b = __builtin_convertvector(v, bf16x2_t); return __builtin_bit_cast(unsigned, b); }
__device__ __forceinline__ float bf_lo(unsigned w) { return __uint_as_float(w << 16); }
__device__ __forceinline__ float bf_hi(unsigned w) { return __uint_as_float(w & 0xffff0000u); }
__device__ __forceinline__ float sigm(float v) { return __builtin_amdgcn_rcpf(1.0f + __expf(-v)); }


template <class Epi, class Sched, int AMODE, bool ALIGN_EPI, bool SP2, bool F8 = false>
__device__ __forceinline__ void gemm_phase(PG8_LAS unsigned char* lds, const Gemm g, const Sched& S, const Epi& E) {
    const int tid = threadIdx.x, wid = __builtin_amdgcn_readfirstlane(tid >> 6), lane = tid & 63, wr = wid >> 2, wc = wid & 3, fr = lane & 15, fq = lane >> 4;
    const int K = g.K, nt = K / BK;
    unsigned voffA0[2], voffA1[2], voffB[2]; int gR[2], gC2[2];
#pragma unroll
    for (int i = 0; i < 2; ++i) { int R, C; stage_rc(tid * 16 + i * 8192, R, C); const int Rb = Epi::PERM ? ((R & ~31) + perm32(R & 31)) : R;
        voffB[i] = (unsigned)(Rb * K + C) * 2u; gR[i] = R; gC2[i] = C * 2;
        if (AMODE == 0) { voffA0[i] = (unsigned)(R * K + C) * 2u; voffA1[i] = (unsigned)((R + HALF) * K + C) * 2u; }
        else if (AMODE == 1) { voffA0[i] = (unsigned)((C >> 3) * 8192 + R) * 16u; voffA1[i] = voffA0[i] + (unsigned)HALF * 16u; }
        else { voffA0[i] = 0u; voffA1[i] = 0u; } }
    const size_t kstepB = (size_t)(BK * 2);
    const size_t kstepA = (AMODE == 1) ? (size_t)8 * 8192 * 16 : (size_t)(BK * 2);
    int nidx0[2] = {0, 0}, nidx1[2] = {0, 0}; unsigned voffN0[2] = {0u, 0u}, voffN1[2] = {0u, 0u};
#define PG8_GIDX_LOAD(u) do { if (AMODE == 2) { _Pragma("unroll") for (int _i = 0; _i < 2; ++_i) { \
        const int* _p0 = g.gidx + (size_t)(u).pm * BM + gR[_i]; const int* _p1 = _p0 + HALF; \
        asm volatile("global_load_dword %0, %1, off" : "=v"(nidx0[_i]) : "v"(_p0) : "memory"); asm volatile("global_load_dword %0, %1, off" : "=v"(nidx1[_i]) : "v"(_p1) : "memory"); } } } while (0)
#define PG8_GIDX_USE() do { if (AMODE == 2) { _Pragma("unroll") for (int _i = 0; _i < 2; ++_i) { asm volatile("" : "+v"(nidx0[_i]), "+v"(nidx1[_i])); \
        voffN0[_i] = (unsigned)nidx0[_i] * (unsigned)(K * 2) + (unsigned)gC2[_i]; voffN1[_i] = (unsigned)nidx1[_i] * (unsigned)(K * 2) + (unsigned)gC2[_i]; } } } while (0)
    const size_t hstepB = (size_t)HALF * K * 2;
    const size_t tstepB = 2 * hstepB;
    const unsigned ldsw = (unsigned)wid * 1024u;
    const int aoff = lds_byte(wr * 64 + fr, fq * 8), boff = lds_byte(wc * 32 + fr, fq * 8);
    const int aoff8a = lds_byte(wr * 64 + fr, fq * 16), boff8a = lds_byte(wc * 32 + fr, fq * 16);
#define PG8_ABASE(u) ((const char*)g.A + ((AMODE == 2) ? (size_t)0 : (AMODE == 0) ? (size_t)(u).pm * (size_t)BM * K * 2 : (size_t)((u).pm >> 5) * ((size_t)(K >> 3) * 8192 * 16) + (size_t)((u).pm & 31) * (BM * 16)))
#define PG8_BBASE(u) ((const char*)g.Bt + (g.bgrp ? (size_t)((u).pm / g.bgrp) * g.bstride * 2 : (size_t)0) + (size_t)(u).pn * tstepB)
#define PG8_SA(b, h) (((b) * 2 + (h)) * HTB)
#define PG8_SB(b, h) ((4 + (b) * 2 + (h)) * HTB)
#define PG8_STAGE(bufoff, gbase, voff) do { _Pragma("unroll") for (int _i = 0; _i < 2; ++_i) \
        __builtin_amdgcn_global_load_lds((const unsigned*)((const char*)(gbase) + (voff)[_i]), (PG8_LAS unsigned*)(lds + (bufoff) + ldsw + _i * 8192), 16, 0, 0); } while (0)
#define PG8_LDA16(dst, b, h) do { _Pragma("unroll") for (int m = 0; m < 4; ++m) _Pragma("unroll") for (int k = 0; k < 2; ++k) dst[m][k] = *(const PG8_LAS bf16x8*)(lds + PG8_SA(b, h) + aoff + m * 2048 + k * 1024); } while (0)
#define PG8_LDB16(dst, b, h) do { _Pragma("unroll") for (int n = 0; n < 2; ++n) _Pragma("unroll") for (int k = 0; k < 2; ++k) dst[n][k] = *(const PG8_LAS bf16x8*)(lds + PG8_SB(b, h) + boff + n * 2048 + k * 1024); } while (0)
#define PG8_MMA16(ai, bj, At, Bt) do { __builtin_amdgcn_s_setprio(1); _Pragma("unroll") for (int m = 0; m < 4; ++m) _Pragma("unroll") for (int n = 0; n < 2; ++n) _Pragma("unroll") for (int k = 0; k < 2; ++k) \
        acc[ai][bj][m][n] = __builtin_amdgcn_mfma_f32_16x16x32_bf16(Bt[n][k], At[m][k], acc[ai][bj][m][n], 0, 0, 0); __builtin_amdgcn_s_setprio(0); } while (0)
#define PG8_LDA8(dst, b, h) do { _Pragma("unroll") for (int m = 0; m < 4; ++m) { const v4i lo_ = *(const PG8_LAS v4i*)(lds + PG8_SA(b, h) + aoff8a + m * 2048), hi_ = *(const PG8_LAS v4i*)(lds + PG8_SA(b, h) + aoff8a + m * 2048 + 16); \
        dst[m] = (v8i){lo_.x, lo_.y, lo_.z, lo_.w, hi_.x, hi_.y, hi_.z, hi_.w}; } } while (0)
#define PG8_LDB8(dst, b, h) do { _Pragma("unroll") for (int n = 0; n < 2; ++n) { const v4i lo_ = *(const PG8_LAS v4i*)(lds + PG8_SB(b, h) + boff8a + n * 2048), hi_ = *(const PG8_LAS v4i*)(lds + PG8_SB(b, h) + boff8a + n * 2048 + 16); \
        dst[n] = (v8i){lo_.x, lo_.y, lo_.z, lo_.w, hi_.x, hi_.y, hi_.z, hi_.w}; } } while (0)
#define PG8_MMA8(ai, bj, At, Bt) do { __builtin_amdgcn_s_setprio(1); _Pragma("unroll") for (int m = 0; m < 4; ++m) _Pragma("unroll") for (int n = 0; n < 2; ++n) \
        asm volatile("v_mfma_scale_f32_16x16x128_f8f6f4 %0, %1, %2, %0, %3, %3 op_sel:[0,1,0] op_sel_hi:[0,0,0]" : "+v"(acc[ai][bj][m][n]) : "v"(Bt[n]), "v"(At[m]), "v"(f8scale)); __builtin_amdgcn_s_setprio(0); } while (0)
#define PG8_LDA(dst, b, h) do { if constexpr (F8) PG8_LDA8(dst##8, b, h); else PG8_LDA16(dst, b, h); } while (0)
#define PG8_LDB(dst, b, h) do { if constexpr (F8) PG8_LDB8(dst##8, b, h); else PG8_LDB16(dst, b, h); } while (0)
#define PG8_MMA(ai, bj, At, Bt) do { if constexpr (F8) PG8_MMA8(ai, bj, At##8, Bt##8); else PG8_MMA16(ai, bj, At, Bt); } while (0)
#define PG8_WAIT_V(n) asm volatile("s_waitcnt vmcnt(" #n ")" ::: "memory")
#define PG8_WAIT_L(n) asm volatile("s_waitcnt lgkmcnt(" #n ")" ::: "memory")
#define PG8_BAR __builtin_amdgcn_s_barrier()
#define PG8_SCHED __builtin_amdgcn_sched_barrier(0)
    Unit cur, nxt; int ui = 0;
    if (!S.next(0, cur)) return;
    f32x4 acc[2][2][4][2];
#pragma unroll
    for (int a = 0; a < 2; ++a)
#pragma unroll
        for (int b = 0; b < 2; ++b)
#pragma unroll
            for (int m = 0; m < 4; ++m)
#pragma unroll
                for (int n = 0; n < 2; ++n) acc[a][b][m][n] = (f32x4){0.f, 0.f, 0.f, 0.f};
    bf16x8 At[4][2], B0[2][2], B1[2][2]; v8i At8[4], B08[2], B18[2]; int f8scale = 0x7f7f7f78; asm volatile("" : "+v"(f8scale));
    const char* cA = PG8_ABASE(cur); const char* cB = PG8_BBASE(cur);
    S.a_ready(cur);
    if (AMODE == 2) { PG8_GIDX_LOAD(cur); asm volatile("s_waitcnt vmcnt(0)" ::: "memory"); PG8_GIDX_USE();
#pragma unroll
        for (int i = 0; i < 2; ++i) { voffA0[i] = voffN0[i]; voffA1[i] = voffN1[i]; } }
    if constexpr (SP2) {
        PG8_STAGE(PG8_SB(0, 0), cB, voffB); PG8_STAGE(PG8_SB(0, 1), cB + hstepB, voffB); PG8_STAGE(PG8_SA(0, 0), cA, voffA0); PG8_STAGE(PG8_SA(0, 1), cA, voffA1);
        if (wr == 1) PG8_BAR;
        PG8_WAIT_V(2); PG8_BAR;
        PG8_STAGE(PG8_SB(1, 0), cB + kstepB, voffB); PG8_STAGE(PG8_SA(1, 0), cA + kstepA, voffA0); PG8_STAGE(PG8_SB(1, 1), cB + hstepB + kstepB, voffB);
        PG8_WAIT_V(6); PG8_BAR;
    } else {
        PG8_STAGE(PG8_SB(0, 0), cB, voffB); PG8_STAGE(PG8_SA(0, 0), cA, voffA0); PG8_STAGE(PG8_SB(0, 1), cB + hstepB, voffB); PG8_STAGE(PG8_SA(0, 1), cA, voffA1);
        if (wr == 1) PG8_BAR;
        PG8_WAIT_V(4); PG8_BAR;
        PG8_STAGE(PG8_SB(1, 0), cB + kstepB, voffB); PG8_STAGE(PG8_SA(1, 0), cA + kstepA, voffA0); PG8_STAGE(PG8_SB(1, 1), cB + hstepB + kstepB, voffB);
        PG8_WAIT_V(6); PG8_BAR;
    }
    for (;;) {
        const bool has_next = S.next(ui + 1, nxt);
        const char* nA = has_next ? PG8_ABASE(nxt) : cA; const char* nB = has_next ? PG8_BBASE(nxt) : cB;
        if (AMODE == 2) { if (has_next) PG8_GIDX_LOAD(nxt); }
#pragma unroll 1
        for (int t = 0; t < nt; t += 2) {
            const bool last = (t == nt - 2);
            unsigned vS0[2], vS1[2];
            if (AMODE == 2) { if (last) { if (has_next) PG8_GIDX_USE(); else { _Pragma("unroll") for (int i = 0; i < 2; ++i) { voffN0[i] = voffA0[i]; voffN1[i] = voffA1[i]; } } } }
#pragma unroll
            for (int i = 0; i < 2; ++i) { vS0[i] = (AMODE == 2 && last) ? voffN0[i] : voffA0[i]; vS1[i] = (AMODE == 2 && last) ? voffN1[i] : voffA1[i]; }
            const char* a1 = cA + (size_t)(t + 1) * kstepA;
            const char* a2 = last ? nA : cA + (size_t)(t + 2) * kstepA; const char* b2 = last ? nB : cB + (size_t)(t + 2) * kstepB;
            const char* a3 = a2 + kstepA; const char* b3 = b2 + kstepB;
            if (last && has_next) S.a_ready(nxt);
            if constexpr (SP2) {
            PG8_LDB(B0, 0, 0); PG8_LDB(B1, 0, 1); PG8_SCHED; PG8_LDA(At, 0, 0); PG8_STAGE(PG8_SA(1, 1), a1, voffA1);
            PG8_WAIT_V(8); PG8_WAIT_L(0); PG8_BAR; PG8_MMA(0, 0, At, B0); PG8_MMA(0, 1, At, B1); PG8_BAR; PG8_SCHED;
            PG8_LDA(At, 0, 1); PG8_STAGE(PG8_SB(0, 0), b2, voffB); PG8_STAGE(PG8_SB(0, 1), b2 + hstepB, voffB); PG8_STAGE(PG8_SA(0, 0), a2, vS0);
            PG8_WAIT_V(8); PG8_WAIT_L(0); PG8_BAR; PG8_MMA(1, 0, At, B0); PG8_MMA(1, 1, At, B1); PG8_BAR; PG8_SCHED;
            PG8_LDB(B0, 1, 0); PG8_LDB(B1, 1, 1); PG8_SCHED; PG8_LDA(At, 1, 0); PG8_STAGE(PG8_SA(0, 1), a2, vS1);
            PG8_WAIT_V(8); PG8_WAIT_L(0); PG8_BAR; PG8_MMA(0, 0, At, B0); PG8_MMA(0, 1, At, B1); PG8_BAR; PG8_SCHED;
            PG8_LDA(At, 1, 1); PG8_STAGE(PG8_SB(1, 0), b3, voffB); PG8_STAGE(PG8_SB(1, 1), b3 + hstepB, voffB); PG8_STAGE(PG8_SA(1, 0), a3, vS0);
            PG8_WAIT_V(8); PG8_WAIT_L(0); PG8_BAR; PG8_MMA(1, 0, At, B0); PG8_MMA(1, 1, At, B1); PG8_BAR; PG8_SCHED;
            } else {
            PG8_LDB(B0, 0, 0); PG8_SCHED; PG8_LDA(At, 0, 0); PG8_STAGE(PG8_SA(1, 1), a1, voffA1);
            PG8_WAIT_L(8); PG8_BAR; PG8_WAIT_L(0); PG8_MMA(0, 0, At, B0); PG8_BAR; PG8_SCHED;
            PG8_LDB(B1, 0, 1); PG8_STAGE(PG8_SB(0, 0), b2, voffB);
            PG8_BAR; PG8_WAIT_L(0); PG8_MMA(0, 1, At, B1); PG8_BAR;
            PG8_LDA(At, 0, 1); PG8_STAGE(PG8_SA(0, 0), a2, vS0);
            PG8_BAR; PG8_WAIT_L(0); PG8_MMA(1, 0, At, B0); PG8_BAR; PG8_SCHED;
            PG8_STAGE(PG8_SB(0, 1), b2 + hstepB, voffB);
            PG8_WAIT_V(6); PG8_BAR; PG8_MMA(1, 1, At, B1); PG8_BAR;
            PG8_LDB(B0, 1, 0); PG8_SCHED; PG8_LDA(At, 1, 0); PG8_STAGE(PG8_SA(0, 1), a2, vS1);
            PG8_WAIT_L(8); PG8_BAR; PG8_WAIT_L(0); PG8_MMA(0, 0, At, B0); PG8_BAR; PG8_SCHED;
            PG8_LDB(B1, 1, 1); PG8_STAGE(PG8_SB(1, 0), b3, voffB);
            PG8_BAR; PG8_WAIT_L(0); PG8_MMA(0, 1, At, B1); PG8_BAR;
            PG8_LDA(At, 1, 1); PG8_STAGE(PG8_SA(1, 0), a3, vS0);
            PG8_BAR; PG8_WAIT_L(0); PG8_MMA(1, 0, At, B0); PG8_BAR; PG8_SCHED;
            PG8_STAGE(PG8_SB(1, 1), b3 + hstepB, voffB);
            PG8_WAIT_V(6); PG8_BAR; PG8_MMA(1, 1, At, B1); PG8_BAR;
            }
        }
        if constexpr (ALIGN_EPI) { if (wr == 0) PG8_BAR; }
        if constexpr (F8) asm volatile("s_nop 15\n\ts_nop 15\n\ts_nop 7" ::: "memory");
        E(acc, cur, wr, wc, fr, fq); S.done(cur);
#if DBG_EPI2
        if (Epi::EPI2) { asm volatile("" ::: "memory"); E(acc, cur, wr, wc, fr, fq); }
#endif
        if (!has_next) break;
#pragma unroll
        for (int a = 0; a < 2; ++a)
#pragma unroll
            for (int b = 0; b < 2; ++b)
#pragma unroll
                for (int m = 0; m < 4; ++m)
#pragma unroll
                    for (int n = 0; n < 2; ++n) acc[a][b][m][n] = (f32x4){0.f, 0.f, 0.f, 0.f};
        cur = nxt; cA = nA; cB = nB; ++ui;
        if (AMODE == 2) {
#pragma unroll
            for (int i = 0; i < 2; ++i) { voffA0[i] = voffN0[i]; voffA1[i] = voffN1[i]; } }
        if constexpr (ALIGN_EPI) { if (wr == 1) PG8_BAR; }
    }
    PG8_WAIT_V(0);
    if constexpr (!ALIGN_EPI) { if (wr == 0) PG8_BAR; }
    PG8_BAR;
#undef PG8_GIDX_LOAD
#undef PG8_GIDX_USE
#undef PG8_ABASE
#undef PG8_BBASE
#undef PG8_SA
#undef PG8_SB
#undef PG8_STAGE
#undef PG8_LDA
#undef PG8_LDA16
#undef PG8_LDA8
#undef PG8_LDB16
#undef PG8_LDB8
#undef PG8_MMA16
#undef PG8_MMA8
#undef PG8_LDB
#undef PG8_MMA
#undef PG8_WAIT_V
#undef PG8_WAIT_L
#undef PG8_BAR
#undef PG8_SCHED
}
}
constexpr int NWAVES = 8;
constexpr int BATCH = 2, SEQ = 8192, D = 1024, M = BATCH * SEQ, DF = 512, DIN = 5632, NE = 16, CAP = 1024, DE = 2048, MR = BATCH * NE * CAP  ;
constexpr float RMS_EPS = 1e-6f;
constexpr size_t MiB = 1u << 20;
constexpr size_t WS_CTL = 0, CTL_ZERO_BYTES = 1 * MiB;
constexpr size_t WS_MODP = 1 * MiB, WS_MOD = 1 * MiB + 256 * 1024, WS_FC1 = 1 * MiB + 512 * 1024, WS_FC2 = 1 * MiB + 576 * 1024;
constexpr size_t WS_PROBS = 2 * MiB, WS_SLOT = 3 * MiB, WS_IDX = 4 * MiB, WS_VAL = 4 * MiB + 128 * 1024;
constexpr size_t WS_WIN = 8 * MiB, WS_WF = 20 * MiB, WS_WCO = 22 * MiB, WS_WO = 24 * MiB, WS_WGU = 32 * MiB, WS_WD = 160 * MiB;
constexpr size_t WS_H1 = 224 * MiB, WS_AB = 224 * MiB, WS_UF = 256 * MiB, WS_CV = 272 * MiB, WS_BG = 304 * MiB, WS_GA = 336 * MiB, WS_GB = 368 * MiB, WS_ZF = 400 * MiB, WS_TZ = 432 * MiB, WS_H2 = 464 * MiB;
#ifndef MOE_FP8
#define MOE_FP8 1
#endif
constexpr size_t WS_HM = 224 * MiB, WS_Y = 432 * MiB, WS_X1B = 400 * MiB, WS_END = 496 * MiB;
constexpr int CW_BAR = 4096;
constexpr int RING_BYTES = 131072, MISC_OFF = 143360, LDS_BYTES = 147456;
constexpr int FFT_TOFF = 65536, FFT_TPITCH = 528;

#define GAS __attribute__((address_space(1)))
#define LAS __attribute__((address_space(3)))
typedef unsigned short bf16;
typedef unsigned v4u __attribute__((ext_vector_type(4)));
typedef unsigned v2u __attribute__((ext_vector_type(2)));
typedef float f32x4 __attribute__((ext_vector_type(4)));
typedef short bf16x8 __attribute__((ext_vector_type(8)));
#define LDS_WAIT() asm volatile("s_waitcnt lgkmcnt(0)" ::: "memory")
#define VM_WAIT() asm volatile("s_waitcnt vmcnt(0)" ::: "memory")
using pg8::cvt_pk_bf16; using pg8::bf_lo; using pg8::bf_hi; using pg8::sigm;
__device__ __forceinline__ float wave_sum(float v) {
#pragma unroll
    for (int o = 1; o < 64; o <<= 1) v += __shfl_xor(v, o);
    return v;
}
__device__ __forceinline__ float silu(float v) { return v * sigm(v); }
#ifndef DBG_NOBIAS
#define DBG_NOBIAS 0
#endif
#ifndef DBG_NOSIG
#define DBG_NOSIG 0
#endif
__device__ __forceinline__ float sigx(float v) { return DBG_NOSIG ? v : sigm(v); }

#define XB_TMO      128
#define XB_XCNT(j)  (256  + 64 * (j))
#define XB_XSUB(j)  (1280 + 64 * (j))
#define XB_XGEN(j)  (2304 + 64 * (j))
#define XB_TOP      3328
#define XB_TOPGEN   3392
#define XCD_BAR_WORDS 3456
#define XB_SPIN_CAP (1u << 18)
__device__ __forceinline__ unsigned xb_ld(unsigned* p)              { return __hip_atomic_load(p, __ATOMIC_RELAXED, __HIP_MEMORY_SCOPE_AGENT); }
__device__ __forceinline__ unsigned xb_add(unsigned* p, unsigned v) { return __hip_atomic_fetch_add(p, v, __ATOMIC_RELAXED, __HIP_MEMORY_SCOPE_AGENT); }
__device__ __forceinline__ unsigned xb_xcc_id() { return (unsigned)__builtin_amdgcn_s_getreg((3 << 11) | 20) & 0xFu; }
#define XB_SPIN(cond, bar) do { unsigned _sp = 0; while (cond) { __builtin_amdgcn_s_sleep(1); \
    if ((++_sp & 255u) == 0u) { if (xb_ld(&(bar)[XB_TMO])) break; if (_sp > XB_SPIN_CAP) { atomicAdd(&(bar)[XB_TMO], 1u); break; } } } } while (0)
struct XcdBarrier { unsigned* bar; unsigned x; volatile LAS unsigned* st; };
__device__ __forceinline__ XcdBarrier xcd_barrier_post(unsigned* bar, volatile LAS unsigned* st) {
    XcdBarrier b; b.bar = bar; b.x = xb_xcc_id(); b.st = st;
    if (threadIdx.x == 0) (void)xb_add(&bar[XB_XCNT(b.x)], 1u);
    return b;
}
__device__ __forceinline__ void xcd_barrier_complete(unsigned* bar, unsigned x, unsigned& nloc, unsigned& nx) {
    const unsigned G = gridDim.x * gridDim.y * gridDim.z;
    unsigned sum, cnt, mine, sp = 0u;
    for (;;) {
        sum = 0u; cnt = 0u; mine = 0u;
#pragma unroll
        for (unsigned j = 0; j < 16; ++j) { const unsigned c = xb_ld(&bar[XB_XCNT(j)]); sum += c; cnt += (c > 0u) ? 1u : 0u; mine = (j == x) ? c : mine; }
        if (sum == G) break;
        __builtin_amdgcn_s_sleep(1);
        if ((++sp & 255u) == 0u) { if (xb_ld(&bar[XB_TMO])) break; if (sp > XB_SPIN_CAP) { atomicAdd(&bar[XB_TMO], 1u); break; } }
    }
    nloc = mine > 0u ? mine : 1u; nx = cnt > 0u ? cnt : 1u;
}
__device__ __forceinline__ void xcd_barrier(const XcdBarrier& b) {
    asm volatile("s_waitcnt vmcnt(0)" ::: "memory");
    __syncthreads();
    if (threadIdx.x == 0) {
        unsigned* bar = b.bar;
        __builtin_amdgcn_s_waitcnt(0);
        unsigned nloc = b.st[0], nx = b.st[1];
        if (nloc == 0u) { xcd_barrier_complete(bar, b.x, nloc, nx); b.st[0] = nloc; b.st[1] = nx; }
        const unsigned old = xb_add(&bar[XB_XSUB(b.x)], 1u);
        const unsigned gen = old / nloc;
        if (old + 1u == (gen + 1u) * nloc) {
            __builtin_amdgcn_fence(__ATOMIC_RELEASE, "agent");
            asm volatile("s_waitcnt vmcnt(0)" ::: "memory");
            const unsigned og = xb_add(&bar[XB_TOP], 1u);
            const unsigned tg = og / nx;
            if (og + 1u == (tg + 1u) * nx) xb_add(&bar[XB_TOPGEN], 1u);
            else XB_SPIN(xb_ld(&bar[XB_TOPGEN]) == tg, bar);
            __builtin_amdgcn_fence(__ATOMIC_ACQUIRE, "agent");
            xb_add(&bar[XB_XGEN(b.x)], 1u);
            asm volatile("s_waitcnt vmcnt(0)" ::: "memory");
        } else {
            XB_SPIN(xb_ld(&bar[XB_XGEN(b.x)]) == gen, bar);
            __builtin_amdgcn_fence(__ATOMIC_ACQUIRE, "agent");
            asm volatile("s_waitcnt vmcnt(0)" ::: "memory");
        }
    }
    __syncthreads();
}

using pg8::Unit; using pg8::u32x4; using pg8::u32x2;
struct EpiInProj {
    static constexpr bool PERM = true, EPI2 = (DBG_EPI2 == 2);
    bf16 *UF, *CV, *BG, *GA, *GB; const float* b_gate;
    __device__ __forceinline__ void operator()(const f32x4 (&acc)[2][2][4][2], const Unit& u, int wr, int wc, int fr, int fq) const {
        const int row0 = u.pm * 256 + wr * 64 + fr;
        if (u.pn < 2) {
            const int b = u.pm >> 5, s0 = (u.pm & 31) * 256 + wr * 64 + fr;
#pragma unroll
            for (int ai = 0; ai < 2; ++ai)
#pragma unroll
                for (int m = 0; m < 4; ++m) { const int s = s0 + ai * 128 + m * 16;
#pragma unroll
                    for (int bj = 0; bj < 2; ++bj) { const int g4 = (u.pn * 256 + bj * 128 + wc * 32 + 8 * fq) >> 2;
#pragma unroll
                        for (int n = 0; n < 2; ++n) { const f32x4 v = acc[ai][bj][m][n]; u32x2 w; w.x = cvt_pk_bf16(v[0], v[1]); w.y = cvt_pk_bf16(v[2], v[3]);
                            *(u32x2*)(UF + ((size_t)(b * 128 + g4 + n) * 8192 + s) * 4) = w; } } }
        } else if (u.pn < 10) {
#pragma unroll
            for (int ai = 0; ai < 2; ++ai)
#pragma unroll
                for (int m = 0; m < 4; ++m) { bf16* rowp = CV + (size_t)(row0 + ai * 128 + m * 16) * D + (u.pn - 2) * 128 + wc * 16 + 4 * fq;
#pragma unroll
                    for (int bj = 0; bj < 2; ++bj) { const f32x4 v = acc[ai][bj][m][0] * acc[ai][bj][m][1]; u32x2 w; w.x = cvt_pk_bf16(v[0], v[1]); w.y = cvt_pk_bf16(v[2], v[3]);
                        *(u32x2*)(rowp + bj * 64) = w; } }
        } else if (u.pn < 14) {
#pragma unroll
            for (int ai = 0; ai < 2; ++ai)
#pragma unroll
                for (int m = 0; m < 4; ++m) { bf16* rowp = BG + (size_t)(row0 + ai * 128 + m * 16) * D + (u.pn - 10) * 256 + wc * 32 + 8 * fq;
#pragma unroll
                    for (int bj = 0; bj < 2; ++bj) { const f32x4 v0 = acc[ai][bj][m][0], v1 = acc[ai][bj][m][1]; u32x4 w; w.x = cvt_pk_bf16(v0[0], v0[1]); w.y = cvt_pk_bf16(v0[2], v0[3]); w.z = cvt_pk_bf16(v1[0], v1[1]); w.w = cvt_pk_bf16(v1[2], v1[3]);
                        *(u32x4*)(rowp + bj * 128) = w; } }
        } else {
            const int colg = (u.pn - 14) * 256 + wc * 32 + 8 * fq;
            bf16* O = (u.pn < 18) ? GA : GB;
            f32x4 bv[2][2];
#pragma unroll
            for (int bj = 0; bj < 2; ++bj)
#pragma unroll
                for (int n = 0; n < 2; ++n) bv[bj][n] = DBG_NOBIAS ? (f32x4){0.f, 0.f, 0.f, 0.f} : *(const f32x4*)(b_gate + colg + bj * 128 + 4 * n);
#pragma unroll
            for (int ai = 0; ai < 2; ++ai)
#pragma unroll
                for (int m = 0; m < 4; ++m) { bf16* rowp = O + (size_t)(row0 + ai * 128 + m * 16) * D + (colg & 1023);
#pragma unroll
                    for (int bj = 0; bj < 2; ++bj) { const f32x4 v0 = acc[ai][bj][m][0] + bv[bj][0], v1 = acc[ai][bj][m][1] + bv[bj][1]; u32x4 w;
                        w.x = cvt_pk_bf16(sigx(v0[0]), sigx(v0[1])); w.y = cvt_pk_bf16(sigx(v0[2]), sigx(v0[3])); w.z = cvt_pk_bf16(sigx(v1[0]), sigx(v1[1])); w.w = cvt_pk_bf16(sigx(v1[2]), sigx(v1[3]));
                        *(u32x4*)(rowp + bj * 128) = w; } }
        }
    }
};
template <int MODE> struct EpiGateMul {
    static constexpr bool PERM = true, EPI2 = false;
    bf16* O; const bf16* G;
    __device__ __forceinline__ void operator()(const f32x4 (&acc)[2][2][4][2], const Unit& u, int wr, int wc, int fr, int fq) const {
        const int row0 = u.pm * 256 + wr * 64 + fr, col0 = u.pn * 256 + wc * 32 + 8 * fq;
#pragma unroll
        for (int ai = 0; ai < 2; ++ai)
#pragma unroll
            for (int m = 0; m < 4; ++m) { const size_t off = (size_t)(row0 + ai * 128 + m * 16) * D + col0;
#pragma unroll
                for (int bj = 0; bj < 2; ++bj) { const u32x4 gw = *(const u32x4*)(G + off + bj * 128); const f32x4 v0 = acc[ai][bj][m][0], v1 = acc[ai][bj][m][1];
                    float r[8] = {bf_lo(gw.x) * v0[0], bf_hi(gw.x) * v0[1], bf_lo(gw.y) * v0[2], bf_hi(gw.y) * v0[3], bf_lo(gw.z) * v1[0], bf_hi(gw.z) * v1[1], bf_lo(gw.w) * v1[2], bf_hi(gw.w) * v1[3]};
                    if (MODE == 1) { const u32x4 ow = *(const u32x4*)(O + off + bj * 128);
                        r[0] += bf_lo(ow.x); r[1] += bf_hi(ow.x); r[2] += bf_lo(ow.y); r[3] += bf_hi(ow.y); r[4] += bf_lo(ow.z); r[5] += bf_hi(ow.z); r[6] += bf_lo(ow.w); r[7] += bf_hi(ow.w); }
                    u32x4 w; w.x = cvt_pk_bf16(r[0], r[1]); w.y = cvt_pk_bf16(r[2], r[3]); w.z = cvt_pk_bf16(r[4], r[5]); w.w = cvt_pk_bf16(r[6], r[7]);
                    *(u32x4*)(O + off + bj * 128) = w; } }
    }
};
struct EpiResid {
    static constexpr bool PERM = true, EPI2 = (DBG_EPI2 == 5);
    const float* x; bf16* X1B; const float* gate;
    __device__ __forceinline__ void operator()(const f32x4 (&acc)[2][2][4][2], const Unit& u, int wr, int wc, int fr, int fq) const {
        const int row0 = u.pm * 256 + wr * 64 + fr, col0 = u.pn * 256 + wc * 32 + 8 * fq, b = u.pm >> 5;
        f32x4 gv[2][2];
#pragma unroll
        for (int bj = 0; bj < 2; ++bj)
#pragma unroll
            for (int n = 0; n < 2; ++n) gv[bj][n] = *(const f32x4*)(gate + b * 6 * D + col0 + bj * 128 + 4 * n);
#pragma unroll
        for (int ai = 0; ai < 2; ++ai)
#pragma unroll
            for (int m = 0; m < 4; ++m) { const size_t off = (size_t)(row0 + ai * 128 + m * 16) * D + col0;
#pragma unroll
                for (int bj = 0; bj < 2; ++bj) { const f32x4 x0 = *(const f32x4*)(x + off + bj * 128), x1 = *(const f32x4*)(x + off + bj * 128 + 4);
                    const f32x4 v0 = x0 + gv[bj][0] * acc[ai][bj][m][0], v1 = x1 + gv[bj][1] * acc[ai][bj][m][1];
                    u32x4 w; w.x = cvt_pk_bf16(v0[0], v0[1]); w.y = cvt_pk_bf16(v0[2], v0[3]); w.z = cvt_pk_bf16(v1[0], v1[1]); w.w = cvt_pk_bf16(v1[2], v1[3]);
                    *(u32x4*)(X1B + off + bj * 128) = w; }
                asm volatile("" ::: "memory"); }
    }
};
struct EpiSwiGLU {
    static constexpr bool PERM = true, EPI2 = (DBG_EPI2 == 9);
    bf16* HM;
    __device__ __forceinline__ void operator()(const f32x4 (&acc)[2][2][4][2], const Unit& u, int wr, int wc, int fr, int fq) const {
        const int row0 = u.pm * 256 + wr * 64 + fr, col0 = u.pn * 128 + wc * 32 + 8 * fq;
#pragma unroll
        for (int ai = 0; ai < 2; ++ai)
#pragma unroll
            for (int m = 0; m < 4; ++m) { const f32x4 g0 = acc[ai][0][m][0], g1 = acc[ai][0][m][1], u0 = acc[ai][1][m][0], u1 = acc[ai][1][m][1]; u32x4 w;
                w.x = cvt_pk_bf16(silu(g0[0]) * u0[0], silu(g0[1]) * u0[1]); w.y = cvt_pk_bf16(silu(g0[2]) * u0[2], silu(g0[3]) * u0[3]);
                w.z = cvt_pk_bf16(silu(g1[0]) * u1[0], silu(g1[1]) * u1[1]); w.w = cvt_pk_bf16(silu(g1[2]) * u1[2], silu(g1[3]) * u1[3]);
                *(u32x4*)(HM + (size_t)(row0 + ai * 128 + m * 16) * DE + col0) = w; }
    }
};
__device__ __forceinline__ unsigned pk4_fp8(float a, float b2, float c, float d) { unsigned w = 0u; w = __builtin_amdgcn_cvt_pk_fp8_f32(a, b2, w, false); w = __builtin_amdgcn_cvt_pk_fp8_f32(c, d, w, true); return w; }
struct EpiSwiGLU8 {
    static constexpr bool PERM = true, EPI2 = false;
    unsigned char* HM8;
    __device__ __forceinline__ void operator()(const f32x4 (&acc)[2][2][4][2], const Unit& u, int wr, int wc, int fr, int fq) const {
        const int row0 = u.pm * 256 + wr * 64 + fr, col0 = u.pn * 128 + wc * 32 + 8 * fq;
#pragma unroll
        for (int ai = 0; ai < 2; ++ai)
#pragma unroll
            for (int m = 0; m < 4; ++m) { const f32x4 g0 = acc[ai][0][m][0], g1 = acc[ai][0][m][1], u0 = acc[ai][1][m][0], u1 = acc[ai][1][m][1]; u32x2 w;
                w.x = pk4_fp8(silu(g0[0]) * u0[0], silu(g0[1]) * u0[1], silu(g0[2]) * u0[2], silu(g0[3]) * u0[3]);
                w.y = pk4_fp8(silu(g1[0]) * u1[0], silu(g1[1]) * u1[1], silu(g1[2]) * u1[2], silu(g1[3]) * u1[3]);
                *(u32x2*)(HM8 + (size_t)(row0 + ai * 128 + m * 16) * DE + col0) = w; asm volatile("" ::: "memory"); }
    }
};
struct EpiRowScale {
    static constexpr bool PERM = true, EPI2 = (DBG_EPI2 == 10);
    bf16* Y; const float* val;
    __device__ __forceinline__ void operator()(const f32x4 (&acc)[2][2][4][2], const Unit& u, int wr, int wc, int fr, int fq) const {
        const int row0 = u.pm * 256 + wr * 64 + fr, col0 = u.pn * 256 + wc * 32 + 8 * fq;
#pragma unroll
        for (int ai = 0; ai < 2; ++ai)
#pragma unroll
            for (int m = 0; m < 4; ++m) { const int row = row0 + ai * 128 + m * 16; const float sv = val[row];
#pragma unroll
                for (int bj = 0; bj < 2; ++bj) { const f32x4 v0 = acc[ai][bj][m][0] * sv, v1 = acc[ai][bj][m][1] * sv; u32x4 w; w.x = cvt_pk_bf16(v0[0], v0[1]); w.y = cvt_pk_bf16(v0[2], v0[3]); w.z = cvt_pk_bf16(v1[0], v1[1]); w.w = cvt_pk_bf16(v1[2], v1[3]);
                    *(u32x4*)(Y + (size_t)row * D + col0 + bj * 128) = w; } }
    }
};

struct EpiPlain {
    static constexpr bool PERM = true, EPI2 = false;
    bf16* O; int ldc;
    __device__ __forceinline__ void operator()(const f32x4 (&acc)[2][2][4][2], const Unit& u, int wr, int wc, int fr, int fq) const {
        const int row0 = u.pm * 256 + wr * 64 + fr, col0 = u.pn * 256 + wc * 32 + 8 * fq;
#pragma unroll
        for (int ai = 0; ai < 2; ++ai)
#pragma unroll
            for (int m = 0; m < 4; ++m) { bf16* rowp = O + (size_t)(row0 + ai * 128 + m * 16) * ldc + col0;
#pragma unroll
                for (int bj = 0; bj < 2; ++bj) { const f32x4 v0 = acc[ai][bj][m][0], v1 = acc[ai][bj][m][1]; u32x4 w; w.x = cvt_pk_bf16(v0[0], v0[1]); w.y = cvt_pk_bf16(v0[2], v0[3]); w.z = cvt_pk_bf16(v1[0], v1[1]); w.w = cvt_pk_bf16(v1[2], v1[3]);
                    *(u32x4*)(rowp + bj * 128) = w; } }
    }
};
__device__ __forceinline__ unsigned f2bf(float f) { unsigned u = __builtin_bit_cast(unsigned, f); return (u + 0x7fffu + ((u >> 16) & 1u)) >> 16; }
__device__ __forceinline__ unsigned pk2(float lo, float hi) { return f2bf(lo) | (f2bf(hi) << 16); }
__device__ __forceinline__ int rowmap_in(int n) {
    if (n < 512) return n;
    if (n < 1536) { const int j = n - 512; return 512 + 8 * (j >> 2) + (j & 3); }
    if (n < 2560) return 2560 + (n - 1536);
    if (n < 3584) { const int j = n - 2560; return 512 + 8 * (j >> 2) + 4 + (j & 3); }
    return n;
}
template <int MAP>
__device__ __forceinline__ void transpose_item(const float* W, int K, int N, bf16* WT, LAS float* scr, int item, int lane) {
    const int nblk = N / 32, kb = item / nblk, nb = item % nblk, k0 = 64 * kb, n0 = 32 * nb;
#pragma unroll 8
    for (int i = 0; i < 32; ++i) { const int kk = 2 * i + (lane >> 5); scr[kk * 33 + (lane & 31)] = W[(size_t)(k0 + kk) * N + n0 + (lane & 31)]; }
    LDS_WAIT(); asm volatile("" ::: "memory");
    const int c = lane & 7;
#pragma unroll
    for (int j = 0; j < 4; ++j) { const int n = (lane >> 3) + 8 * j; const LAS float* s = scr + (8 * c) * 33 + n;
        v4u o; o.x = pk2(s[0 * 33], s[1 * 33]); o.y = pk2(s[2 * 33], s[3 * 33]); o.z = pk2(s[4 * 33], s[5 * 33]); o.w = pk2(s[6 * 33], s[7 * 33]);
        const int ns = n0 + n; int row;
        if (MAP == 0) row = ns; else if (MAP == 1) row = rowmap_in(ns); else if (MAP == 2) row = 256 * (ns >> 7) + (ns & 127); else row = 256 * (ns >> 7) + 128 + (ns & 127);
        *(GAS v4u*)(WT + (size_t)row * K + k0 + 8 * c) = o; }
    LDS_WAIT(); asm volatile("" ::: "memory");
}
template <int MAP>
__device__ __forceinline__ void transpose_item8(const float* W, int K, int N, unsigned char* WT, LAS float* scr, int item, int lane) {
    const int nblk = N / 32, kb = item / nblk, nb = item % nblk, k0 = 64 * kb, n0 = 32 * nb;
#pragma unroll 8
    for (int i = 0; i < 32; ++i) { const int kk = 2 * i + (lane >> 5); scr[kk * 33 + (lane & 31)] = W[(size_t)(k0 + kk) * N + n0 + (lane & 31)]; }
    LDS_WAIT(); asm volatile("" ::: "memory");
    const int c = lane & 3;
#pragma unroll
    for (int j = 0; j < 2; ++j) { const int n = (lane >> 2) + 16 * j; const LAS float* s = scr + (16 * c) * 33 + n; unsigned o[4];
#pragma unroll
        for (int q = 0; q < 4; ++q) { unsigned w = 0u; w = __builtin_amdgcn_cvt_pk_fp8_f32(s[(4 * q) * 33] * 128.f, s[(4 * q + 1) * 33] * 128.f, w, false); w = __builtin_amdgcn_cvt_pk_fp8_f32(s[(4 * q + 2) * 33] * 128.f, s[(4 * q + 3) * 33] * 128.f, w, true); o[q] = w; }
        const int ns = n0 + n; int row;
        if (MAP == 0) row = ns; else if (MAP == 2) row = 256 * (ns >> 7) + (ns & 127); else row = 256 * (ns >> 7) + 128 + (ns & 127);
        v4u ov; ov.x = o[0]; ov.y = o[1]; ov.z = o[2]; ov.w = o[3];
        *(GAS v4u*)(WT + (size_t)row * K + k0 + 16 * c) = ov; }
    LDS_WAIT(); asm volatile("" ::: "memory");
}
__device__ __forceinline__ void wf_item(const float* wf, bf16* WF_T, int item, int lane) {
    const int c = item >> 2, dblk = item & 3, g = c >> 7, j = c & 127, d0 = 256 * dblk + 4 * lane;
    f32x4 ac = {0.f, 0.f, 0.f, 0.f}, as = {0.f, 0.f, 0.f, 0.f};
    for (int m = 0; m < 128; ++m) { const f32x4 wv = *(const GAS f32x4*)(wf + (size_t)(g * 128 + m) * D + d0); const float fr = (float)((m * j) & 127) * (1.0f / 128.0f);
        const float cv = __builtin_amdgcn_cosf(fr), sv = __builtin_amdgcn_sinf(fr); ac += cv * wv; as += sv * wv; }
    const int kv = 8 * (c >> 2) + 2 * (c & 3);
#pragma unroll
    for (int i = 0; i < 4; ++i) *(GAS unsigned*)(WF_T + (size_t)(d0 + i) * D + kv) = pk2(ac[i] * (1.0f / 1024.0f), as[i] * (1.0f / 1024.0f));
}
__device__ __forceinline__ void fc_tables(bf16* Fc1, bf16* Fc2, int gtid, int gthreads) {
    for (int e = gtid; e < 8192 + 65536; e += gthreads) {
        if (e < 8192) { const int j = e & 7, ln = (e >> 3) & 63, kk = (e >> 9) & 1, mt = (e >> 10) & 3, hh = e >> 12, rho = ln & 15;
            const int s1 = 32 * kk + 8 * (ln >> 4) + j, k1 = 32 * hh + 16 * (mt & 1) + 4 * (rho & 3) + (rho >> 2);
            const float fr = (float)((k1 * s1) & 63) * (1.0f / 64.0f); Fc1[e] = (bf16)f2bf((mt >> 1) == 0 ? cospif(2.0f * fr) : -sinpif(2.0f * fr)); }
        else { const int q = e - 8192, j = q & 7, ln = (q >> 3) & 63, kk = (q >> 9) & 7, ro = (q >> 12) & 1, w = q >> 13;
            const int k2 = 16 * w + (ln & 15), kap = 32 * kk + 8 * (ln >> 4) + j, s2 = kap >> 1, ri = kap & 1;
            const float fr = (float)((k2 * s2) & 127) * (1.0f / 128.0f), cv = cospif(2.0f * fr), sv = sinpif(2.0f * fr);
            Fc2[q] = (bf16)f2bf(ro == 0 ? (ri == 0 ? cv : sv) : (ri == 0 ? -sv : cv)); }
    }
}
__device__ __forceinline__ void mod_item(const float* c, const float* w_ada, float* modp, LAS unsigned char* lds, int item, int tid, int wave, int lane) {
    const int cb = item % 24, kq = item / 24, col0 = 256 * cb + 4 * lane;
    f32x4 a0 = {0.f, 0.f, 0.f, 0.f}, a1 = {0.f, 0.f, 0.f, 0.f};
    for (int i = 0; i < 32; ++i) { const int d = 256 * kq + 32 * wave + i; const float c0 = c[d], c1 = c[D + d];
        const f32x4 wv = *(const GAS f32x4*)(w_ada + (size_t)d * 6 * D + col0); a0 += silu(c0) * wv; a1 += silu(c1) * wv; }
    LAS f32x4* red = (LAS f32x4*)lds;
    red[(wave * 2 + 0) * 64 + lane] = a0; red[(wave * 2 + 1) * 64 + lane] = a1;
    __syncthreads();
    { const int b = tid >> 8, cc = tid & 255; const LAS float* rf = (const LAS float*)lds; float s = 0.f;
#pragma unroll
      for (int w = 0; w < 8; ++w) s += rf[((w * 2 + b) * 64) * 4 + cc];
      modp[(size_t)(kq * 2 + b) * 6 * D + 256 * cb + cc] = s; }
    __syncthreads();
}

__device__ __forceinline__ void phase_h(const float* x, const float* g_mix, const float* b_ada, const float* modp, float* mod, bf16* H1, LAS unsigned char* lds, int tid, int wave, int lane, int vcu, int G) {
    LAS float* ga = (LAS float*)lds;
    LAS float* sh = ga + 2 * D;
    { float v[8];
#pragma unroll
      for (int k = 0; k < 8; ++k) { const int i = tid + 512 * k, j = i & 2047; v[k] = b_ada[j]; }
#pragma unroll
      for (int q = 0; q < 4; ++q)
#pragma unroll
          for (int k = 0; k < 8; ++k) { const int i = tid + 512 * k, b = i >> 11, j = i & 2047; v[k] += modp[(size_t)(q * 2 + b) * 6 * D + j]; }
#pragma unroll
      for (int k = 0; k < 8; ++k) { const int i = tid + 512 * k, b = i >> 11, j = i & 2047; if (j < D) sh[b * D + j] = v[k]; else ga[b * D + j - D] = g_mix[j - D] * (1.f + v[k]); } }
    { const int i = vcu * NWAVES * 64 + tid;
      if (i < 2 * 6 * D) { const int b = i / (6 * D), j = i % (6 * D); float v = b_ada[j];
#pragma unroll
          for (int q = 0; q < 4; ++q) v += modp[(size_t)(q * 2 + b) * 6 * D + j];
          mod[i] = v; } }
    __syncthreads();
    const int gw = vcu * NWAVES + wave, NGW = G * NWAVES;
    for (int m0 = gw * 4; m0 < M; m0 += NGW * 4) { const int b = m0 >> 13;
        f32x4 v[4][4]; float s[4];
#pragma unroll
        for (int r = 0; r < 4; ++r) { const GAS f32x4* xr = (const GAS f32x4*)(x + (size_t)(m0 + r) * D) + lane;
#pragma unroll
            for (int j = 0; j < 4; ++j) v[r][j] = xr[64 * j]; }
#pragma unroll
        for (int r = 0; r < 4; ++r) { s[r] = 0.f;
#pragma unroll
            for (int j = 0; j < 4; ++j) s[r] += (v[r][j].x * v[r][j].x + v[r][j].y * v[r][j].y) + (v[r][j].z * v[r][j].z + v[r][j].w * v[r][j].w); }
#pragma unroll
        for (int o = 1; o < 64; o <<= 1) {
#pragma unroll
            for (int r = 0; r < 4; ++r) s[r] += __shfl_xor(s[r], o); }
#pragma unroll
        for (int r = 0; r < 4; ++r) { const float rr = rsqrtf(s[r] * (1.f / D) + RMS_EPS); GAS v2u* o8 = (GAS v2u*)(H1 + (size_t)(m0 + r) * D) + lane;
#pragma unroll
            for (int j = 0; j < 4; ++j) { const f32x4 gg = *(const LAS f32x4*)(ga + b * D + 4 * lane + 256 * j), ss = *(const LAS f32x4*)(sh + b * D + 4 * lane + 256 * j); const f32x4 y = v[r][j] * rr * gg + ss;
                v2u w; w.x = cvt_pk_bf16(y.x, y.y); w.y = cvt_pk_bf16(y.z, y.w); o8[64 * j] = w; } } }
    __syncthreads();
}
__device__ __forceinline__ void phase_conv(const bf16* CV, const bf16* BG, const float* w_conv, bf16* AB, int wave, int lane, int vcu, int G) {
    const int gw = vcu * NWAVES + wave, NGW = G * NWAVES;
    for (int m = gw; m < M; m += NGW) { const int s = m & (SEQ - 1);
#pragma unroll
        for (int hseg = 0; hseg < 2; ++hseg) { const int ch = hseg * 512 + 8 * lane; const size_t off = (size_t)m * D + ch;
            const v4u c1 = *(const GAS v4u*)(CV + off), bg = *(const GAS v4u*)(BG + off);
            v4u c0 = {0u, 0u, 0u, 0u}, c2 = {0u, 0u, 0u, 0u};
            if (s > 0) c0 = *(const GAS v4u*)(CV + off - D);
            if (s < SEQ - 1) c2 = *(const GAS v4u*)(CV + off + D);
            float w0[8], w1[8], w2[8];
#pragma unroll
            for (int q = 0; q < 2; ++q) { const f32x4 a = *(const GAS f32x4*)(w_conv + ch + 4 * q), b = *(const GAS f32x4*)(w_conv + D + ch + 4 * q), c = *(const GAS f32x4*)(w_conv + 2 * D + ch + 4 * q);
#pragma unroll
                for (int i = 0; i < 4; ++i) { w0[4 * q + i] = a[i]; w1[4 * q + i] = b[i]; w2[4 * q + i] = c[i]; } }
            unsigned ow[4];
#pragma unroll
            for (int q = 0; q < 4; ++q) {
                const float lo = bf_lo(bg[q]) * (w0[2 * q] * bf_lo(c0[q]) + w1[2 * q] * bf_lo(c1[q]) + w2[2 * q] * bf_lo(c2[q]));
                const float hi = bf_hi(bg[q]) * (w0[2 * q + 1] * bf_hi(c0[q]) + w1[2 * q + 1] * bf_hi(c1[q]) + w2[2 * q + 1] * bf_hi(c2[q]));
                ow[q] = cvt_pk_bf16(lo, hi); }
            v4u o; o.x = ow[0]; o.y = ow[1]; o.z = ow[2]; o.w = ow[3];
            *(GAS v4u*)(AB + off) = o; } }
}
__device__ __forceinline__ void phase_h2(const bf16* X1B, const float* g_moe, const float* mod, const float* w_router, const float* b_router, bf16* H2, unsigned char* H2F8, float* probs,
                                         LAS unsigned char* lds, int tid, int wave, int lane, int vcu, int G) {
    LAS bf16* whi = (LAS bf16*)lds;
    LAS bf16* wlo = whi + 16384;
    LAS float* ga = (LAS float*)(lds + 65536);
    LAS float* sh = ga + 2 * D;
    for (int i = tid; i < 16384; i += NWAVES * 64) { const int j = i & 7, ln = (i >> 3) & 63, kk = i >> 9, k = 32 * kk + 8 * (ln >> 4) + j, e = ln & 15;
        const float w = w_router[k * NE + e]; const unsigned h = f2bf(w); const float wh = __uint_as_float(h << 16); whi[i] = (bf16)h; wlo[i] = (bf16)f2bf(w - wh); }
    { float a[4], b2[4], c2[4];
#pragma unroll
      for (int k = 0; k < 4; ++k) { const int i = tid + 512 * k, b = i >> 10, j = i & 1023; a[k] = mod[b * 6 * D + 3 * D + j]; b2[k] = mod[b * 6 * D + 4 * D + j]; c2[k] = g_moe[j]; }
#pragma unroll
      for (int k = 0; k < 4; ++k) { const int i = tid + 512 * k; sh[i] = a[k]; ga[i] = c2[k] * (1.f + b2[k]); } }
    __syncthreads();
    const int n = lane & 15, kq = lane >> 4;
    float br[4];
#pragma unroll
    for (int r = 0; r < 4; ++r) br[r] = b_router[4 * kq + r];
    for (int grp = wave * G + vcu; grp < M / 16; grp += NWAVES * G) { const int m0 = 16 * grp, b = m0 >> 13;
        const GAS v4u* xr = (const GAS v4u*)(X1B + (size_t)(m0 + n) * D + 8 * kq);
        v4u xf[32]; float ssq = 0.f;
#pragma unroll
        for (int kk = 0; kk < 32; ++kk) xf[kk] = xr[4 * kk];
#pragma unroll
        for (int kk = 0; kk < 32; ++kk) { const v4u w = xf[kk]; const float e0 = bf_lo(w.x), e1 = bf_hi(w.x), e2 = bf_lo(w.y), e3 = bf_hi(w.y), e4 = bf_lo(w.z), e5 = bf_hi(w.z), e6 = bf_lo(w.w), e7 = bf_hi(w.w);
            ssq += (e0 * e0 + e1 * e1) + (e2 * e2 + e3 * e3) + (e4 * e4 + e5 * e5) + (e6 * e6 + e7 * e7); }
#pragma unroll
        for (int kk = 0; kk < 32; ++kk) asm volatile("" : "+v"(xf[kk].x), "+v"(xf[kk].y), "+v"(xf[kk].z), "+v"(xf[kk].w));
        ssq += __shfl_xor(ssq, 16); ssq += __shfl_xor(ssq, 32);
        const float rstd = rsqrtf(ssq * (1.f / D) + RMS_EPS);
        f32x4 acc = {0.f, 0.f, 0.f, 0.f};
        GAS v4u* ho = (GAS v4u*)(H2 + (size_t)(m0 + n) * D + 8 * kq);
#pragma unroll
        for (int kk = 0; kk < 32; ++kk) { const v4u w = xf[kk]; const int col = 32 * kk + 8 * kq;
            const f32x4 g0 = *(const LAS f32x4*)(ga + b * D + col), g1 = *(const LAS f32x4*)(ga + b * D + col + 4), s0 = *(const LAS f32x4*)(sh + b * D + col), s1 = *(const LAS f32x4*)(sh + b * D + col + 4);
            float h[8] = {bf_lo(w.x) * rstd * g0.x + s0.x, bf_hi(w.x) * rstd * g0.y + s0.y, bf_lo(w.y) * rstd * g0.z + s0.z, bf_hi(w.y) * rstd * g0.w + s0.w,
                          bf_lo(w.z) * rstd * g1.x + s1.x, bf_hi(w.z) * rstd * g1.y + s1.y, bf_lo(w.w) * rstd * g1.z + s1.z, bf_hi(w.w) * rstd * g1.w + s1.w};
            v4u hh, hl;
            hh.x = cvt_pk_bf16(h[0], h[1]); hh.y = cvt_pk_bf16(h[2], h[3]); hh.z = cvt_pk_bf16(h[4], h[5]); hh.w = cvt_pk_bf16(h[6], h[7]);
            hl.x = cvt_pk_bf16(h[0] - bf_lo(hh.x), h[1] - bf_hi(hh.x)); hl.y = cvt_pk_bf16(h[2] - bf_lo(hh.y), h[3] - bf_hi(hh.y)); hl.z = cvt_pk_bf16(h[4] - bf_lo(hh.z), h[5] - bf_hi(hh.z)); hl.w = cvt_pk_bf16(h[6] - bf_lo(hh.w), h[7] - bf_hi(hh.w));
            if (MOE_FP8) { v2u q8; q8.x = pk4_fp8(h[0], h[1], h[2], h[3]); q8.y = pk4_fp8(h[4], h[5], h[6], h[7]); *(GAS v2u*)(H2F8 + (size_t)(m0 + n) * D + 32 * kk + 8 * kq) = q8; }
            else ho[4 * kk] = hh;
            const bf16x8 ah = *(const LAS bf16x8*)(whi + (kk * 64 + lane) * 8), al = *(const LAS bf16x8*)(wlo + (kk * 64 + lane) * 8);
            const bf16x8 bh = __builtin_bit_cast(bf16x8, hh), bl = __builtin_bit_cast(bf16x8, hl);
            acc = __builtin_amdgcn_mfma_f32_16x16x32_bf16(ah, bh, acc, 0, 0, 0); acc = __builtin_amdgcn_mfma_f32_16x16x32_bf16(al, bh, acc, 0, 0, 0); acc = __builtin_amdgcn_mfma_f32_16x16x32_bf16(ah, bl, acc, 0, 0, 0);
            asm volatile("" ::: "memory"); }
        float lg[4], mx = -3.0e38f;
#pragma unroll
        for (int r = 0; r < 4; ++r) { lg[r] = acc[r] + br[r]; mx = fmaxf(mx, lg[r]); }
        mx = fmaxf(mx, __shfl_xor(mx, 16)); mx = fmaxf(mx, __shfl_xor(mx, 32));
        float sum = 0.f;
#pragma unroll
        for (int r = 0; r < 4; ++r) { lg[r] = __expf(lg[r] - mx); sum += lg[r]; }
        sum += __shfl_xor(sum, 16); sum += __shfl_xor(sum, 32);
        const float inv = 1.0f / sum; const int s = (m0 + n) & (SEQ - 1);
#pragma unroll
        for (int r = 0; r < 4; ++r) probs[((size_t)(b * NE + 4 * kq + r)) * SEQ + s] = lg[r] * inv; }
    __syncthreads();
}
__device__ __forceinline__ void topk_item(const float* probs, int* idx, float* val, int* slot, LAS unsigned char* lds, int item, int tid, int wave, int lane) {
    const int e = item >> 1, b = item & 1;
    LAS int* red = (LAS int*)lds;
    unsigned p[16];
#pragma unroll
    for (int q = 0; q < 4; ++q) { const v4u w = *(const GAS v4u*)(probs + ((size_t)(b * NE + e)) * SEQ + 16 * tid + 4 * q); p[4 * q] = w.x; p[4 * q + 1] = w.y; p[4 * q + 2] = w.z; p[4 * q + 3] = w.w; }
    unsigned prefix = 0u;
    for (int bit = 30; bit >= 0; --bit) { const unsigned cand = prefix | (1u << bit); int cnt = 0;
#pragma unroll
        for (int j = 0; j < 16; ++j) cnt += __popcll(__ballot(p[j] >= cand));
        const int par = bit & 1;
        if (lane == 0) red[par * 8 + wave] = cnt;
        __syncthreads();
        int tot = 0;
#pragma unroll
        for (int w = 0; w < 8; ++w) tot += red[par * 8 + w];
        if (tot >= CAP) prefix = cand; }
    const unsigned T = prefix;
    int cgt = 0, ceq = 0;
#pragma unroll
    for (int j = 0; j < 16; ++j) { cgt += (p[j] > T) ? 1 : 0; ceq += (p[j] == T) ? 1 : 0; }
    int sgt = cgt, seq = ceq;
#pragma unroll
    for (int o = 1; o < 64; o <<= 1) { const int a = __shfl_up(sgt, o), c = __shfl_up(seq, o); if (lane >= o) { sgt += a; seq += c; } }
    __syncthreads();
    if (lane == 63) { red[32 + wave] = sgt; red[48 + wave] = seq; }
    __syncthreads();
    int bgt = 0, beq = 0, totgt = 0;
#pragma unroll
    for (int w = 0; w < 8; ++w) { const int a = red[32 + w], c = red[48 + w]; if (w < wave) { bgt += a; beq += c; } totgt += a; }
    int rgt = bgt + sgt - cgt, req = beq + seq - ceq;
    const int need = CAP - totgt; const int rbase = (e * 2 + b) * CAP;
#pragma unroll
    for (int j = 0; j < 16; ++j) { const int tok = b * SEQ + 16 * tid + j; int sl = -1;
        if (p[j] > T) { sl = rgt; ++rgt; } else if (p[j] == T) { if (req < need) sl = totgt + req; ++req; }
        slot[(size_t)tok * NE + e] = sl;
        if (sl >= 0) { idx[rbase + sl] = tok; val[rbase + sl] = __uint_as_float(p[j]); } }
    __syncthreads();
}
__device__ __forceinline__ void phase_gather(const bf16* H2, const int* idx, bf16* XE, int wave, int lane, int vcu, int G) {
    const int gw = vcu * NWAVES + wave, NGW = G * NWAVES;
    for (int r = gw; r < MR; r += NGW) { const int tok = idx[r];
        const GAS v4u* src = (const GAS v4u*)(H2 + (size_t)tok * D) + lane; GAS v4u* dst = (GAS v4u*)(XE + (size_t)r * D) + lane;
        const v4u a = src[0], b2 = src[64]; dst[0] = a; dst[64] = b2; }
}
__device__ __forceinline__ void phase_final(float* out, const bf16* X1B, const bf16* Y, const int* slot, const float* mod, const float* g_fin, int wave, int lane, int vcu, int G, float pert) {
    const int gw = vcu * NWAVES + wave, NGW = G * NWAVES;
    int slv[2]; v2u xw[2][4];
#define PF_FETCH(mm) do { _Pragma("unroll") for (int r = 0; r < 2; ++r) { slv[r] = slot[(size_t)((mm) + r) * NE + (lane & 15)]; const GAS v2u* xr_ = (const GAS v2u*)(X1B + (size_t)((mm) + r) * D) + lane; \
        _Pragma("unroll") for (int j = 0; j < 4; ++j) xw[r][j] = xr_[64 * j]; } } while (0)
    int m0 = gw * 2;
    if (m0 < M) PF_FETCH(m0);
    for (; m0 < M; m0 += NGW * 2) { const int b = m0 >> 13;
        int cs[2]; f32x4 v[2][4], a[2][4];
#pragma unroll
        for (int r = 0; r < 2; ++r) { cs[r] = slv[r];
#pragma unroll
            for (int j = 0; j < 4; ++j) { const v2u w = xw[r][j]; v[r][j] = (f32x4){bf_lo(w.x), bf_hi(w.x), bf_lo(w.y), bf_hi(w.y)}; a[r][j] = (f32x4){0.f, 0.f, 0.f, 0.f}; } }
        const int mn = m0 + NGW * 2;
        if (mn < M) PF_FETCH(mn);
        unsigned long long mask[2]; bool more = false;
#pragma unroll
        for (int r = 0; r < 2; ++r) mask[r] = __ballot(cs[r] >= 0) & 0xFFFFull;
        do { const GAS v2u* yp[2][4]; bool ok[2][4]; v2u w[2][4][4];
#pragma unroll
            for (int r = 0; r < 2; ++r)
#pragma unroll
                for (int c = 0; c < 4; ++c) { ok[r][c] = (mask[r] != 0ull); const int e = ok[r][c] ? (int)__builtin_ctzll(mask[r]) : 0; mask[r] &= (mask[r] - 1ull);
                    const int sl = __builtin_amdgcn_readlane(cs[r], e); yp[r][c] = (const GAS v2u*)(Y + ((size_t)(e * 2 + b) * CAP + (ok[r][c] ? sl : 0)) * D) + lane; }
#pragma unroll
            for (int r = 0; r < 2; ++r)
#pragma unroll
                for (int c = 0; c < 4; ++c) if (ok[r][c]) {
#pragma unroll
                    for (int j = 0; j < 4; ++j) w[r][c][j] = yp[r][c][64 * j]; }
#pragma unroll
            for (int r = 0; r < 2; ++r)
#pragma unroll
                for (int c = 0; c < 4; ++c) if (ok[r][c]) {
#pragma unroll
                    for (int j = 0; j < 4; ++j) { a[r][j].x += bf_lo(w[r][c][j].x); a[r][j].y += bf_hi(w[r][c][j].x); a[r][j].z += bf_lo(w[r][c][j].y); a[r][j].w += bf_hi(w[r][c][j].y); } }
            more = (mask[0] | mask[1]) != 0ull;
        } while (more);
        float s[2];
#pragma unroll
        for (int r = 0; r < 2; ++r) { s[r] = 0.f;
#pragma unroll
            for (int j = 0; j < 4; ++j) { const f32x4 gf = *(const GAS f32x4*)(mod + b * 6 * D + 5 * D + 4 * lane + 256 * j); v[r][j] = v[r][j] + gf * a[r][j]; s[r] += (v[r][j].x * v[r][j].x + v[r][j].y * v[r][j].y) + (v[r][j].z * v[r][j].z + v[r][j].w * v[r][j].w); } }
#pragma unroll
        for (int o = 1; o < 64; o <<= 1) { s[0] += __shfl_xor(s[0], o); s[1] += __shfl_xor(s[1], o); }
#pragma unroll
        for (int r = 0; r < 2; ++r) { const float rr = rsqrtf(s[r] * (1.f / D) + RMS_EPS); GAS f32x4* xo = (GAS f32x4*)(out + (size_t)(m0 + r) * D) + lane;
#pragma unroll
            for (int j = 0; j < 4; ++j) { const f32x4 gg = *(const GAS f32x4*)(g_fin + 4 * lane + 256 * j); xo[64 * j] = v[r][j] * rr * gg + pert; } } }
#undef PF_FETCH
}
__device__ __forceinline__ void fft_item(LAS unsigned char* lds, const bf16* UF, bf16* ZF, const bf16* Fc1, const bf16* Fc2, int item, int wave, int lane) {
    const char* slab = (const char*)UF + (size_t)item * 65536;
    { v4u xv[8];
#pragma unroll
      for (int p = 0; p < 8; ++p) { const int s1 = 8 * p + wave; xv[p] = *(const GAS v4u*)(slab + s1 * 1024 + ((16 * lane - 32 * ((s1 >> 3) & 3)) & 1023)); }
#pragma unroll
      for (int p = 0; p < 8; ++p) *(LAS v4u*)(lds + (8 * p + wave) * 1024 + 16 * lane) = xv[p]; }
    bf16x8 A2[2][8];
#pragma unroll
    for (int ro = 0; ro < 2; ++ro)
#pragma unroll
        for (int kk = 0; kk < 8; ++kk) A2[ro][kk] = *(const GAS bf16x8*)(Fc2 + ((size_t)(((wave * 2 + ro) * 8 + kk) * 64 + lane)) * 8);
    LDS_WAIT(); __syncthreads();
    const int fr = lane & 15, fq = lane >> 4, ch = lane & 3, s2l = (lane & 15) >> 2;
    char* zb = (char*)ZF + (size_t)item * 131072;
    for (int hh = 0; hh < 2; ++hh) {
        { bf16x8 A1[4][2];
#pragma unroll
          for (int mt = 0; mt < 4; ++mt)
#pragma unroll
              for (int kk = 0; kk < 2; ++kk) A1[mt][kk] = *(const GAS bf16x8*)(Fc1 + ((size_t)(((hh * 4 + mt) * 2 + kk) * 64 + lane)) * 8);
          for (int jn = 0; jn < 4; ++jn) { const int nt = wave + 8 * jn, s2 = 4 * nt + s2l;
            bf16x8 Bx[2];
#pragma unroll
            for (int kk = 0; kk < 2; ++kk)
#pragma unroll
                for (int j = 0; j < 8; ++j) { const int s1 = 32 * kk + 8 * fq + j; Bx[kk][j] = *(const LAS short*)(lds + s1 * 1024 + ((s2 * 8 + ch * 2 + 32 * fq) & 1023)); }
            f32x4 acc[4];
#pragma unroll
            for (int mt = 0; mt < 4; ++mt) { acc[mt] = (f32x4){0.f, 0.f, 0.f, 0.f};
#pragma unroll
                for (int kk = 0; kk < 2; ++kk) acc[mt] = __builtin_amdgcn_mfma_f32_16x16x32_bf16(A1[mt][kk], Bx[kk], acc[mt], 0, 0, 0); }
#pragma unroll
            for (int blk = 0; blk < 2; ++blk)
#pragma unroll
                for (int r = 0; r < 4; ++r) { const int k1l = 16 * blk + 4 * r + fq, k1 = 32 * hh + k1l; const float dr = acc[blk][r], di = acc[2 + blk][r];
                    const float frac = (float)((s2 * k1) & 8191) * (1.0f / 8192.0f), c = __builtin_amdgcn_cosf(frac), s = __builtin_amdgcn_sinf(frac);
                    *(LAS unsigned*)(lds + FFT_TOFF + (k1l * 4 + ch) * FFT_TPITCH + s2 * 4) = cvt_pk_bf16(dr * c + di * s, di * c - dr * s); } } }
        LDS_WAIT(); __syncthreads();
        for (int nt2 = 0; nt2 < 8; ++nt2) { f32x4 c0 = {0.f, 0.f, 0.f, 0.f}, c1 = {0.f, 0.f, 0.f, 0.f};
#pragma unroll
            for (int kk = 0; kk < 8; ++kk) { const bf16x8 Bt = *(const LAS bf16x8*)(lds + FFT_TOFF + (16 * nt2 + fr) * FFT_TPITCH + kk * 64 + fq * 16);
                c0 = __builtin_amdgcn_mfma_f32_16x16x32_bf16(A2[0][kk], Bt, c0, 0, 0, 0); c1 = __builtin_amdgcn_mfma_f32_16x16x32_bf16(A2[1][kk], Bt, c1, 0, 0, 0); }
            const int k1 = 32 * hh + 4 * nt2 + s2l;
#pragma unroll
            for (int r = 0; r < 4; ++r) { const int k = k1 + 64 * (16 * wave + 4 * fq + r); *(GAS unsigned*)(zb + (size_t)k * 16 + ch * 4) = cvt_pk_bf16(c0[r], c1[r]); } }
        LDS_WAIT(); __syncthreads();
    }
}
#if MOE_FP8
#define EXPERT_ITEM(r_) do { const int e_ = (r_) / 3072, q_ = (r_) % 3072; \
    if (q_ < 1024) transpose_item8<2>(w_g + (size_t)e_ * D * DE, D, DE, WGU8 + (size_t)e_ * 4096 * D, scr, q_, lane); \
    else if (q_ < 2048) transpose_item8<3>(w_u + (size_t)e_ * D * DE, D, DE, WGU8 + (size_t)e_ * 4096 * D, scr, q_ - 1024, lane); \
    else transpose_item8<0>(w_d + (size_t)e_ * DE * D, DE, D, WD8 + (size_t)e_ * D * DE, scr, q_ - 2048, lane); } while (0)
#else
#define EXPERT_ITEM(r_) do { const int e_ = (r_) / 3072, q_ = (r_) % 3072; \
    if (q_ < 1024) transpose_item<2>(w_g + (size_t)e_ * D * DE, D, DE, WGU + (size_t)e_ * 4096 * D, scr, q_, lane); \
    else if (q_ < 2048) transpose_item<3>(w_u + (size_t)e_ * D * DE, D, DE, WGU + (size_t)e_ * 4096 * D, scr, q_ - 1024, lane); \
    else transpose_item<0>(w_d + (size_t)e_ * DE * D, DE, D, WD + (size_t)e_ * D * DE, scr, q_ - 2048, lane); } while (0)
#endif
#ifndef EXP_P2
#define EXP_P2 10240
#endif
#ifndef EXP_P7
#define EXP_P7 14336
#endif
constexpr int EXP_TOTAL = NE * 3072, EXP_P0 = EXP_TOTAL - EXP_P2 - EXP_P7;

constexpr int NPHASE = 12;
#ifndef MOE_ALIGN
#define MOE_ALIGN true
#endif
#ifndef EXTRA_BARS
#define EXTRA_BARS 0
#endif
#ifndef STAGGER_US
#define STAGGER_US 0
#endif
#ifndef DOUBLE_PH
#define DOUBLE_PH -1
#endif
#define REP(k) for (int rep_ = 0; rep_ < ((DOUBLE_PH == (k)) ? 2 : 1); ++rep_)
#define REPBAR(k) do { if (DOUBLE_PH == (k) && rep_ == 0) xcd_barrier(bar); } while (0)
#ifndef PROBE_I
#define PROBE_I -1
#endif
#ifndef PROBE_J
#define PROBE_J -1
#endif
#ifndef DBG_PLAIN
#define DBG_PLAIN 0
#endif
#ifndef GALIGN
#define GALIGN true
#endif
#ifndef GSP2
#define GSP2 true
#endif
struct Args { const float* in[18]; float* out; unsigned char* ws; int ph_lo, ph_hi; };
__global__ void __launch_bounds__(NWAVES * 64, 2) fwd(Args args) {
    extern __shared__ __attribute__((aligned(16))) unsigned char lds_raw[];
    LAS unsigned char* lds = (LAS unsigned char*)lds_raw;
    volatile LAS unsigned* MISC = (volatile LAS unsigned*)(lds + MISC_OFF);
    const int tid = threadIdx.x, lane = tid & 63, wave = __builtin_amdgcn_readfirstlane(tid >> 6);
    const int G = gridDim.x; const int bx = blockIdx.x; const int vcu = (G % 8 == 0) ? (bx % 8) * (G / 8) + bx / 8 : bx;
    unsigned char* ws = args.ws;
    const float *x = args.in[0], *c = args.in[1], *w_ada = args.in[2], *b_ada = args.in[3], *g_mix = args.in[4], *w_in = args.in[5], *b_gate = args.in[6], *w_f = args.in[7], *w_conv = args.in[8],
                *w_co = args.in[9], *w_o = args.in[10], *g_moe = args.in[11], *w_r = args.in[12], *b_r = args.in[13], *w_g = args.in[14], *w_u = args.in[15], *w_d = args.in[16], *g_fin = args.in[17];
    float* out = args.out;
    float *modp = (float*)(ws + WS_MODP), *mod = (float*)(ws + WS_MOD), *probs = (float*)(ws + WS_PROBS), *val = (float*)(ws + WS_VAL);
    int *slot = (int*)(ws + WS_SLOT), *idx = (int*)(ws + WS_IDX);
    bf16 *Fc1 = (bf16*)(ws + WS_FC1), *Fc2 = (bf16*)(ws + WS_FC2), *WIN = (bf16*)(ws + WS_WIN), *WF = (bf16*)(ws + WS_WF), *WCO = (bf16*)(ws + WS_WCO), *WO = (bf16*)(ws + WS_WO), *WGU = (bf16*)(ws + WS_WGU), *WD = (bf16*)(ws + WS_WD);
    bf16 *H1 = (bf16*)(ws + WS_H1), *AB = (bf16*)(ws + WS_AB), *UF = (bf16*)(ws + WS_UF), *CV = (bf16*)(ws + WS_CV), *BG = (bf16*)(ws + WS_BG), *GA = (bf16*)(ws + WS_GA), *GB = (bf16*)(ws + WS_GB), *ZF = (bf16*)(ws + WS_ZF),
         *TZ = (bf16*)(ws + WS_TZ), *H2 = (bf16*)(ws + WS_H2), *HM = (bf16*)(ws + WS_HM), *Y = (bf16*)(ws + WS_Y), *X1B = (bf16*)(ws + WS_X1B);
    unsigned char *WGU8 = ws + WS_WGU, *WD8 = ws + WS_WD, *H2F8 = ws + WS_H2, *HM8 = ws + WS_HM;
    for (int u = tid; u < (LDS_BYTES - MISC_OFF) / 4; u += NWAVES * 64) ((LAS unsigned*)(lds + MISC_OFF))[u] = 0u;
    __syncthreads();
    const int lo = args.ph_lo, hi = args.ph_hi;
    XcdBarrier bar; bar.bar = (unsigned*)(ws + WS_CTL) + CW_BAR; bar.x = 0; bar.st = nullptr;
    if (hi - lo > 1) bar = xcd_barrier_post((unsigned*)(ws + WS_CTL) + CW_BAR, MISC + 8);
#define IN(k) (lo <= (k) && (k) < hi)
#if PROBE_I >= 0
    unsigned long long* tsb = (unsigned long long*)(ws + WS_CTL + 512 * 1024);
    if (bx == 0 && tid == 0) tsb[0] = __builtin_amdgcn_s_memrealtime();
#define GRID_BAR(k) do { if (IN(k) && IN((k) + 1)) xcd_barrier(bar); if (bx == 0 && tid == 0) tsb[(k) + 1] = __builtin_amdgcn_s_memrealtime(); } while (0)
#else
#define GRID_BAR(k) do { if (IN(k) && IN((k) + 1)) xcd_barrier(bar); } while (0)
#endif
    const int gw = vcu * NWAVES + wave, NGW = G * NWAVES;
    LAS float* scr = (LAS float*)(lds + wave * 16384);

    if (IN(0)) REP(0) {
        if (vcu < 96) mod_item(c, w_ada, modp, lds, vcu, tid, wave, lane);
        fc_tables(Fc1, Fc2, vcu * NWAVES * 64 + tid, G * NWAVES * 64);
        constexpr int I_WF = 2048, I_IN = 16 * 176, I_SQ = 16 * 32, I_EX = 3072, NITEMS = I_WF + I_IN + 2 * I_SQ + NE * I_EX;
        for (int it = gw; it < NITEMS; it += NGW) {
            int r = it;
            if (r < I_WF) { wf_item(w_f, WF, r, lane); continue; } r -= I_WF;
            if (r < I_IN) { transpose_item<1>(w_in, D, DIN, WIN, scr, r, lane); continue; } r -= I_IN;
            if (r < I_SQ) { transpose_item<0>(w_co, D, D, WCO, scr, r, lane); continue; } r -= I_SQ;
            if (r < I_SQ) { transpose_item<0>(w_o, D, D, WO, scr, r, lane); continue; } r -= I_SQ;
            if (r >= EXP_P0) continue;
            EXPERT_ITEM(r);
        }
        GRID_BAR(0);
    }
    if (IN(1)) REP(1) { phase_h(x, g_mix, b_ada, modp, mod, H1, lds, tid, wave, lane, vcu, G); GRID_BAR(1); }
#if EXTRA_BARS > 0
    if (IN(1) && IN(2)) { for (int eb = 0; eb < EXTRA_BARS; ++eb) xcd_barrier(bar); }
#endif
    if (IN(2)) REP(2) {
#if STAGGER_US > 0
        if (bx >= 128) { const unsigned long long t0 = __builtin_amdgcn_s_memrealtime(); while (__builtin_amdgcn_s_memrealtime() - t0 < (unsigned long long)(STAGGER_US * 100)) __builtin_amdgcn_s_sleep(8); }
#endif
        pg8::Gemm g{H1, WIN, M, DIN, D, 0, 0, nullptr}; pg8::StaticOrder S; S.init(M, DIN, G, bx);
#if DBG_PLAIN
        EpiPlain E{UF, DIN};
        pg8::gemm_phase<EpiPlain, pg8::StaticOrder, 0, GALIGN, GSP2>(lds, g, S, E);
#else
        EpiInProj E{UF, CV, BG, GA, GB, b_gate};
        pg8::gemm_phase<EpiInProj, pg8::StaticOrder, 0, GALIGN, GSP2>(lds, g, S, E);
#endif
        if (bx >= G / 2) { const int w2 = (bx - G / 2) * NWAVES + wave, nw2 = (G - G / 2) * NWAVES;
            for (int r = EXP_P0 + w2; r < EXP_P0 + EXP_P2; r += nw2) EXPERT_ITEM(r); }
        GRID_BAR(2);
    }
    if (IN(3)) REP(3) {
        for (int it = vcu; it < BATCH * 128; it += G) fft_item(lds, UF, ZF, Fc1, Fc2, it, wave, lane);
        phase_conv(CV, BG, w_conv, AB, wave, lane, vcu, G);
        GRID_BAR(3);
    }
    if (IN(4)) REP(4) {
        { pg8::Gemm g{ZF, WF, M, D, D, 0, 0, nullptr}; pg8::StaticOrder S; S.init(M, D, G, bx); EpiGateMul<0> E{TZ, GA};
          pg8::gemm_phase<EpiGateMul<0>, pg8::StaticOrder, 1, true, true>(lds, g, S, E); }
        { pg8::Gemm g{AB, WCO, M, D, D, 0, 0, nullptr}; pg8::StaticOrder S; S.init(M, D, G, bx); EpiGateMul<1> E{TZ, GB};
          pg8::gemm_phase<EpiGateMul<1>, pg8::StaticOrder, 0, true, true>(lds, g, S, E); }
        GRID_BAR(4);
    }
    if (IN(5)) REP(5) {
        pg8::Gemm g{TZ, WO, M, D, D, 0, 0, nullptr}; pg8::StaticOrder S; S.init(M, D, G, bx); EpiResid E{x, X1B, mod + 2 * D};
        pg8::gemm_phase<EpiResid, pg8::StaticOrder, 0, true, true>(lds, g, S, E);
        GRID_BAR(5);
    }
    if (IN(6)) REP(6) { phase_h2(X1B, g_moe, mod, w_r, b_r, H2, H2F8, probs, lds, tid, wave, lane, vcu, G); GRID_BAR(6); }
    if (IN(7)) REP(7) { for (int it = vcu; it < NE * BATCH; it += G) topk_item(probs, idx, val, slot, lds, it, tid, wave, lane);
        if (vcu >= NE * BATCH) { const int w7 = (vcu - NE * BATCH) * NWAVES + wave, nw7 = (G - NE * BATCH) * NWAVES;
            for (int r = EXP_P0 + EXP_P2 + w7; r < EXP_TOTAL; r += nw7) EXPERT_ITEM(r); }
        GRID_BAR(7); }
    if (IN(9)) REP(9) {
#if MOE_FP8
        pg8::Gemm g{(const bf16*)H2F8, (const bf16*)WGU8, MR, 2 * DE, D / 2, 8, (size_t)2 * DE * D / 2, idx}; pg8::StaticOrder S; S.init(MR, 2 * DE, G, bx); EpiSwiGLU8 E{HM8};
        pg8::gemm_phase<EpiSwiGLU8, pg8::StaticOrder, 2, MOE_ALIGN, true, true>(lds, g, S, E);
#else
        pg8::Gemm g{H2, WGU, MR, 2 * DE, D, 8, (size_t)2 * DE * D, idx}; pg8::StaticOrder S; S.init(MR, 2 * DE, G, bx); EpiSwiGLU E{HM};
        pg8::gemm_phase<EpiSwiGLU, pg8::StaticOrder, 2, true, true>(lds, g, S, E);
#endif
        GRID_BAR(9);
    }
    if (IN(10)) REP(10) {
#if MOE_FP8
        pg8::Gemm g{(const bf16*)HM8, (const bf16*)WD8, MR, D, DE / 2, 8, (size_t)D * DE / 2, nullptr}; pg8::StaticOrder S; S.init(MR, D, G, bx); EpiRowScale E{Y, val};
        pg8::gemm_phase<EpiRowScale, pg8::StaticOrder, 0, MOE_ALIGN, true, true>(lds, g, S, E);
#else
        pg8::Gemm g{HM, WD, MR, D, DE, 8, (size_t)D * DE, nullptr}; pg8::StaticOrder S; S.init(MR, D, G, bx); EpiRowScale E{Y, val};
        pg8::gemm_phase<EpiRowScale, pg8::StaticOrder, 0, true, true>(lds, g, S, E);
#endif
#if PROBE_I >= 0
        if (bx == 0 && tid == 0) tsb[12] = __builtin_amdgcn_s_memrealtime();
#endif
        GRID_BAR(10);
    }
#if PROBE_I >= 0
    float pert = 0.f;
    if (IN(11)) { const unsigned long long a0 = __hip_atomic_load(tsb + (PROBE_I == 100 ? 0 : PROBE_I == 9 ? 8 : PROBE_I), __ATOMIC_RELAXED, __HIP_MEMORY_SCOPE_AGENT), a1 = __hip_atomic_load(tsb + (PROBE_I == 100 ? 12 : PROBE_I == 10 ? 12 : PROBE_I + 1), __ATOMIC_RELAXED, __HIP_MEMORY_SCOPE_AGENT); pert = (float)(a1 - a0) * 0.01f * (PROBE_I == 100 ? (1.0f / 64000.0f) : (1.0f / 16000.0f)); }
    if (PROBE_I == 102) { pert = 0.f; if (bx == 0 && tid == 0) tsb[14] = __builtin_amdgcn_s_memrealtime(); __syncthreads(); }
    if (PROBE_I == 101) { pert = 0.f; if (bx == 0) { const unsigned long long a0 = __hip_atomic_load(tsb + 12, __ATOMIC_RELAXED, __HIP_MEMORY_SCOPE_AGENT); pert = (float)(__builtin_amdgcn_s_memrealtime() - a0) * 0.01f * (1.0f / 250.0f); } }
    if (IN(11)) phase_final(out, X1B, Y, slot, mod, g_fin, wave, lane, vcu, G, pert);
    if (PROBE_I == 102) {
        const unsigned long long t_a = tsb[14];
        xcd_barrier(bar);
        if (bx == 0) { const float pp = (float)(__builtin_amdgcn_s_memrealtime() - t_a) * 0.01f * (1.0f / 250.0f);
            for (int k = 0; k < 4; ++k) for (int r = 0; r < 2; ++r) { float* row = out + (size_t)(2 * (vcu * NWAVES + wave) + r + 4096 * k) * D; for (int cc = lane; cc < D; cc += 64) row[cc] += pp; } } }
#else
    if (IN(11)) REP(11) { phase_final(out, X1B, Y, slot, mod, g_fin, wave, lane, vcu, G, 0.f); if (DOUBLE_PH == 11 && rep_ == 0) xcd_barrier(bar); }
#endif

#undef IN
#undef GRID_BAR
}


struct DumpArgs { const unsigned short* p[8]; unsigned long long n[8]; int f32[8]; int nb; int pad; };
__global__ void k_dump(float* out, DumpArgs a) {
    const size_t i = (size_t)blockIdx.x * blockDim.x + threadIdx.x; float s = 0.f;
    for (int b = 0; b < a.nb; ++b) for (size_t j = i; j < a.n[b]; j += (size_t)M * D) s += (a.f32[b] ? ((const float*)a.p[b])[j] : __uint_as_float(((unsigned)a.p[b][j]) << 16)) * (float)(b + 1);
    out[i] = s;
}
#ifndef DUMP_WHICH
#define DUMP_WHICH -1
#endif
#ifndef STOP_AFTER
#define STOP_AFTER (NPHASE - 1)
#endif
#ifndef MK_PER_PHASE
#define MK_PER_PHASE 0
#endif
extern "C" void kernel_launch(void* const* d_in, const int* in_sizes, int n_in, void* d_out, int out_size, void* d_ws, size_t ws_size, hipStream_t stream) {
    static int grid = 0;
    if (grid == 0) {
        if (n_in != 18 || in_sizes[0] != M * D || out_size != M * D || ws_size < WS_END) { fprintf(stderr, "kernel_launch: unexpected shapes (n_in %d, in0 %d, out %d, ws %zu); nothing launched\n", n_in, n_in > 0 ? in_sizes[0] : -1, out_size, ws_size); grid = -1; return; }
        int dev = 0, cus = 0, per_cu = 0;
        if (hipGetDevice(&dev) != hipSuccess || hipDeviceGetAttribute(&cus, hipDeviceAttributeMultiprocessorCount, dev) != hipSuccess) { grid = -1; return; }
        if (hipFuncSetAttribute((const void*)fwd, hipFuncAttributeMaxDynamicSharedMemorySize, LDS_BYTES) != hipSuccess) { fprintf(stderr, "kernel_launch: hipFuncSetAttribute failed\n"); grid = -1; return; }
        if (hipOccupancyMaxActiveBlocksPerMultiprocessor(&per_cu, (const void*)fwd, NWAVES * 64, LDS_BYTES) != hipSuccess || per_cu < 1) { fprintf(stderr, "kernel_launch: occupancy query reports %d blocks per CU\n", per_cu); }
        (void)hipGetLastError();
        grid = cus;
    }
    if (grid < 0) return;
    (void)hipMemsetAsync((char*)d_ws + WS_CTL, 0, CTL_ZERO_BYTES, stream);
    Args a{};
    for (int i = 0; i < 18; ++i) a.in[i] = (const float*)d_in[i];
    a.out = (float*)d_out; a.ws = (unsigned char*)d_ws;
#if MK_PER_PHASE
    for (int p = 0; p < STOP_AFTER + 1; ++p) { a.ph_lo = p; a.ph_hi = p + 1; hipLaunchKernelGGL(fwd, dim3(grid), dim3(NWAVES * 64), LDS_BYTES, stream, a); }
#if DUMP_WHICH >= 0
    { DumpArgs da{}; unsigned char* w = (unsigned char*)d_ws; int nb = 0;
      auto add = [&](size_t off, size_t n, int isf = 0) { da.p[nb] = (const unsigned short*)(w + off); da.n[nb] = n; da.f32[nb] = isf; ++nb; };
      if (DUMP_WHICH == 0) { add(WS_WIN, (size_t)DIN * D); add(WS_WF, (size_t)D * D); add(WS_WCO, (size_t)D * D); add(WS_WO, (size_t)D * D); add(WS_WGU, (size_t)NE * 4096 * D); add(WS_WD, (size_t)NE * D * DE); add(WS_FC1, 8192 + 0); add(WS_MODP, 4 * 2 * 6 * D, 1); }
      if (DUMP_WHICH == 1) { add(WS_H1, (size_t)M * D); add(WS_MOD, 2 * 6 * D, 1); add(WS_FC2, 65536); }
      if (DUMP_WHICH == 2) { add(WS_UF, (size_t)M * DF); add(WS_CV, (size_t)M * D); add(WS_BG, (size_t)M * D); add(WS_GA, (size_t)M * D); add(WS_GB, (size_t)M * D); }
      if (DUMP_WHICH == 5) { add(WS_UF, (size_t)M * DIN); }
      if (DUMP_WHICH == 6) { add(WS_UF, (size_t)M * DF); add(WS_CV, (size_t)M * D); }
      if (DUMP_WHICH == 7) { add(WS_BG, (size_t)M * D); }
      if (DUMP_WHICH == 8) { add(WS_GA, (size_t)M * D); add(WS_GB, (size_t)M * D); }
      if (DUMP_WHICH == 9) { add(WS_GA, (size_t)M * D); }
      if (DUMP_WHICH == 10) { add(WS_GB, (size_t)M * D); }
      if (DUMP_WHICH == 3) { add(WS_ZF, (size_t)M * D); add(WS_AB, (size_t)M * D); }
      if (DUMP_WHICH == 4) { add(WS_TZ, (size_t)M * D); }
      da.nb = nb; hipLaunchKernelGGL(k_dump, dim3(M * D / 256), dim3(256), 0, stream, (float*)d_out, da); }
#endif
#else
    a.ph_lo = 0; a.ph_hi = NPHASE; hipLaunchKernelGGL(fwd, dim3(grid), dim3(NWAVES * 64), LDS_BYTES, stream, a);
#endif
}
```

```cpp
#include <hip/hip_runtime.h>
#include <cstdio>
#include <cstdint>
#define MK_PER_PHASE 0
#define STOP_AFTER 11
#define DUMP_WHICH -1
#define GALIGN true
#define GSP2 true
#define DBG_PLAIN 0
#define DBG_NOBIAS 0
#define DBG_NOSIG 0
#define PROBE_I -1
#define PROBE_J -1
#define DOUBLE_PH -1
#define STAGGER_US 0
#define EXTRA_BARS 0
#define DBG_EPI2 0
#ifndef DBG_EPI2
#define DBG_EPI2 0
#endif
namespace pg8 {
#define PG8_LAS __attribute__((address_space(3)))
typedef unsigned short bf16_t;
typedef short bf16x8 __attribute__((ext_vector_type(8)));
typedef float f32x4 __attribute__((ext_vector_type(4)));
typedef unsigned u32x4 __attribute__((ext_vector_type(4)));
typedef unsigned u32x2 __attribute__((ext_vector_type(2)));
typedef int v8i __attribute__((ext_vector_type(8)));
typedef int v4i __attribute__((ext_vector_type(4)));
constexpr int BM = 256, BK = 64, HALF = 128, HTB = HALF * BK * 2  , STAGE_BYTES = 8 * HTB, NXCD = 8, WGM = 8;

__host__ __device__ __forceinline__ int lds_byte(int r, int c) { const int st = (r >> 4) * 2 + (c >> 5), rr = r & 15, cc = c & 31, ob = rr * 64 + cc * 2; return st * 1024 + (ob ^ (((ob >> 9) & 1) << 5)); }
__host__ __device__ __forceinline__ void stage_rc(int b, int& R, int& C) { const int st = b / 1024, sb = b % 1024, swz = sb ^ (((sb >> 9) & 1) << 5); R = (st >> 1) * 16 + swz / 64; C = (st & 1) * 32 + (swz % 64) / 2; }
__host__ __device__ __forceinline__ int perm32(int rho) { const int n = rho >> 4, i = rho & 15; return 8 * (i >> 2) + 4 * n + (i & 3); }

struct Unit { int pm, pn; };
struct Gemm { const bf16_t* A; const bf16_t* Bt; int M, N, K; int bgrp; size_t bstride; const int* gidx; };

struct StaticOrder {
    int nM, nN, nwg, G, c;
    __host__ __device__ void init(int M, int N, int G_, int c_) { nM = M / BM; nN = N / BM; nwg = nM * nN; G = G_; c = c_; }
    __host__ __device__ bool next(int i, Unit& u) const {
        const long L = (long)i * G + c; if (L >= nwg) return false;
        int wgid = (int)L; { const int q = nwg / NXCD, r = nwg % NXCD, xcd = wgid % NXCD, off = wgid / NXCD; wgid = (xcd < r ? xcd * (q + 1) : r * (q + 1) + (xcd - r) * q) + off; }
        const int nig = WGM * nN, gid = wgid / nig, fm = gid * WGM, gsz = (nM - fm) < WGM ? (nM - fm) : WGM;
        u.pm = fm + ((wgid % nig) % gsz); u.pn = (wgid % nig) / gsz; return true;
    }
    __device__ __forceinline__ void a_ready(const Unit&) const {}
    __device__ __forceinline__ void done(const Unit&) const {}
};

typedef __bf16 bf16x2_t __attribute__((ext_vector_type(2)));
typedef float f32x2_t __attribute__((ext_vector_type(2)));
__device__ __forceinline__ unsigned cvt_pk_bf16(float lo, float hi) { const f32x2_t v = {lo, hi}; const bf16x2_t b = __builtin_convertvector(v, bf16x2_t); return __builtin_bit_cast(unsigned, b); }
__device__ __forceinline__ float bf_lo(unsigned w) { return __uint_as_float(w << 16); }
__device__ __forceinline__ float bf_hi(unsigned w) { return __uint_as_float(w & 0xffff0000u); }
__device__ __forceinline__ float sigm(float v) { return __builtin_amdgcn_rcpf(1.0f + __expf(-v)); }


template <class Epi, class Sched, int AMODE, bool ALIGN_EPI, bool SP2, bool F8 = false>
__device__ __forceinline__ void gemm_phase(PG8_LAS unsigned char* lds, const Gemm g, const Sched& S, const Epi& E) {
    const int tid = threadIdx.x, wid = __builtin_amdgcn_readfirstlane(tid >> 6), lane = tid & 63, wr = wid >> 2, wc = wid & 3, fr = lane & 15, fq = lane >> 4;
    const int K = g.K, nt = K / BK;
    unsigned voffA0[2], voffA1[2], voffB[2]; int gR[2], gC2[2];
#pragma unroll
    for (int i = 0; i < 2; ++i) { int R, C; stage_rc(tid * 16 + i * 8192, R, C); const int Rb = Epi::PERM ? ((R & ~31) + perm32(R & 31)) : R;
        voffB[i] = (unsigned)(Rb * K + C) * 2u; gR[i] = R; gC2[i] = C * 2;
        if (AMODE == 0) { voffA0[i] = (unsigned)(R * K + C) * 2u; voffA1[i] = (unsigned)((R + HALF) * K + C) * 2u; }
        else if (AMODE == 1) { voffA0[i] = (unsigned)((C >> 3) * 8192 + R) * 16u; voffA1[i] = voffA0[i] + (unsigned)HALF * 16u; }
        else { voffA0[i] = 0u; voffA1[i] = 0u; } }
    const size_t kstepB = (size_t)(BK * 2);
    const size_t kstepA = (AMODE == 1) ? (size_t)8 * 8192 * 16 : (size_t)(BK * 2);
    int nidx0[2] = {0, 0}, nidx1[2] = {0, 0}; unsigned voffN0[2] = {0u, 0u}, voffN1[2] = {0u, 0u};
#define PG8_GIDX_LOAD(u) do { if (AMODE == 2) { _Pragma("unroll") for (int _i = 0; _i < 2; ++_i) { \
        const int* _p0 = g.gidx + (size_t)(u).pm * BM + gR[_i]; const int* _p1 = _p0 + HALF; \
        asm volatile("global_load_dword %0, %1, off" : "=v"(nidx0[_i]) : "v"(_p0) : "memory"); asm volatile("global_load_dword %0, %1, off" : "=v"(nidx1[_i]) : "v"(_p1) : "memory"); } } } while (0)
#define PG8_GIDX_USE() do { if (AMODE == 2) { _Pragma("unroll") for (int _i = 0; _i < 2; ++_i) { asm volatile("" : "+v"(nidx0[_i]), "+v"(nidx1[_i])); \
        voffN0[_i] = (unsigned)nidx0[_i] * (unsigned)(K * 2) + (unsigned)gC2[_i]; voffN1[_i] = (unsigned)nidx1[_i] * (unsigned)(K * 2) + (unsigned)gC2[_i]; } } } while (0)
    const size_t hstepB = (size_t)HALF * K * 2;
    const size_t tstepB = 2 * hstepB;
    const unsigned ldsw = (unsigned)wid * 1024u;
    const int aoff = lds_byte(wr * 64 + fr, fq * 8), boff = lds_byte(wc * 32 + fr, fq * 8);
    const int aoff8a = lds_byte(wr * 64 + fr, fq * 16), boff8a = lds_byte(wc * 32 + fr, fq * 16);
#define PG8_ABASE(u) ((const char*)g.A + ((AMODE == 2) ? (size_t)0 : (AMODE == 0) ? (size_t)(u).pm * (size_t)BM * K * 2 : (size_t)((u).pm >> 5) * ((size_t)(K >> 3) * 8192 * 16) + (size_t)((u).pm & 31) * (BM * 16)))
#define PG8_BBASE(u) ((const char*)g.Bt + (g.bgrp ? (size_t)((u).pm / g.bgrp) * g.bstride * 2 : (size_t)0) + (size_t)(u).pn * tstepB)
#define PG8_SA(b, h) (((b) * 2 + (h)) * HTB)
#define PG8_SB(b, h) ((4 + (b) * 2 + (h)) * HTB)
#define PG8_STAGE(bufoff, gbase, voff) do { _Pragma("unroll") for (int _i = 0; _i < 2; ++_i) \
        __builtin_amdgcn_global_load_lds((const unsigned*)((const char*)(gbase) + (voff)[_i]), (PG8_LAS unsigned*)(lds + (bufoff) + ldsw + _i * 8192), 16, 0, 0); } while (0)
#define PG8_LDA16(dst, b, h) do { _Pragma("unroll") for (int m = 0; m < 4; ++m) _Pragma("unroll") for (int k = 0; k < 2; ++k) dst[m][k] = *(const PG8_LAS bf16x8*)(lds + PG8_SA(b, h) + aoff + m * 2048 + k * 1024); } while (0)
#define PG8_LDB16(dst, b, h) do { _Pragma("unroll") for (int n = 0; n < 2; ++n) _Pragma("unroll") for (int k = 0; k < 2; ++k) dst[n][k] = *(const PG8_LAS bf16x8*)(lds + PG8_SB(b, h) + boff + n * 2048 + k * 1024); } while (0)
#define PG8_MMA16(ai, bj, At, Bt) do { __builtin_amdgcn_s_setprio(1); _Pragma("unroll") for (int m = 0; m < 4; ++m) _Pragma("unroll") for (int n = 0; n < 2; ++n) _Pragma("unroll") for (int k = 0; k < 2; ++k) \
        acc[ai][bj][m][n] = __builtin_amdgcn_mfma_f32_16x16x32_bf16(Bt[n][k], At[m][k], acc[ai][bj][m][n], 0, 0, 0); __builtin_amdgcn_s_setprio(0); } while (0)
#define PG8_LDA8(dst, b, h) do { _Pragma("unroll") for (int m = 0; m < 4; ++m) { const v4i lo_ = *(const PG8_LAS v4i*)(lds + PG8_SA(b, h) + aoff8a + m * 2048), hi_ = *(const PG8_LAS v4i*)(lds + PG8_SA(b, h) + aoff8a + m * 2048 + 16); \
        dst[m] = (v8i){lo_.x, lo_.y, lo_.z, lo_.w, hi_.x, hi_.y, hi_.z, hi_.w}; } } while (0)
#define PG8_LDB8(dst, b, h) do { _Pragma("unroll") for (int n = 0; n < 2; ++n) { const v4i lo_ = *(const PG8_LAS v4i*)(lds + PG8_SB(b, h) + boff8a + n * 2048), hi_ = *(const PG8_LAS v4i*)(lds + PG8_SB(b, h) + boff8a + n * 2048 + 16); \
        dst[n] = (v8i){lo_.x, lo_.y, lo_.z, lo_.w, hi_.x, hi_.y, hi_.z, hi_.w}; } } while (0)
#define PG8_MMA8(ai, bj, At, Bt) do { __builtin_amdgcn_s_setprio(1); _Pragma("unroll") for (int m = 0; m < 4; ++m) _Pragma("unroll") for (int n = 0; n < 2; ++n) \
        asm volatile("v_mfma_scale_f32_16x16x128_f8f6f4 %0, %1, %2, %0, %3, %3 op_sel:[0,1,0] op_sel_hi:[0,0,0]" : "+v"(acc[ai][bj][m][n]) : "v"(Bt[n]), "v"(At[m]), "v"(f8scale)); __builtin_amdgcn_s_setprio(0); } while (0)
#define PG8_LDA(dst, b, h) do { if constexpr (F8) PG8_LDA8(dst##8, b, h); else PG8_LDA16(dst, b, h); } while (0)
#define PG8_LDB(dst, b, h) do { if constexpr (F8) PG8_LDB8(dst##8, b, h); else PG8_LDB16(dst, b, h); } while (0)
#define PG8_MMA(ai, bj, At, Bt) do { if constexpr (F8) PG8_MMA8(ai, bj, At##8, Bt##8); else PG8_MMA16(ai, bj, At, Bt); } while (0)
#define PG8_WAIT_V(n) asm volatile("s_waitcnt vmcnt(" #n ")" ::: "memory")
#define PG8_WAIT_L(n) asm volatile("s_waitcnt lgkmcnt(" #n ")" ::: "memory")
#define PG8_BAR __builtin_amdgcn_s_barrier()
#define PG8_SCHED __builtin_amdgcn_sched_barrier(0)
    Unit cur, nxt; int ui = 0;
    if (!S.next(0, cur)) return;
    f32x4 acc[2][2][4][2];
#pragma unroll
    for (int a = 0; a < 2; ++a)
#pragma unroll
        for (int b = 0; b < 2; ++b)
#pragma unroll
            for (int m = 0; m < 4; ++m)
#pragma unroll
                for (int n = 0; n < 2; ++n) acc[a][b][m][n] = (f32x4){0.f, 0.f, 0.f, 0.f};
    bf16x8 At[4][2], B0[2][2], B1[2][2]; v8i At8[4], B08[2], B18[2]; int f8scale = 0x7f7f7f78; asm volatile("" : "+v"(f8scale));
    const char* cA = PG8_ABASE(cur); const char* cB = PG8_BBASE(cur);
    S.a_ready(cur);
    if (AMODE == 2) { PG8_GIDX_LOAD(cur); asm volatile("s_waitcnt vmcnt(0)" ::: "memory"); PG8_GIDX_USE();
#pragma unroll
        for (int i = 0; i < 2; ++i) { voffA0[i] = voffN0[i]; voffA1[i] = voffN1[i]; } }
    if constexpr (SP2) {
        PG8_STAGE(PG8_SB(0, 0), cB, voffB); PG8_STAGE(PG8_SB(0, 1), cB + hstepB, voffB); PG8_STAGE(PG8_SA(0, 0), cA, voffA0); PG8_STAGE(PG8_SA(0, 1), cA, voffA1);
        if (wr == 1) PG8_BAR;
        PG8_WAIT_V(2); PG8_BAR;
        PG8_STAGE(PG8_SB(1, 0), cB + kstepB, voffB); PG8_STAGE(PG8_SA(1, 0), cA + kstepA, voffA0); PG8_STAGE(PG8_SB(1, 1), cB + hstepB + kstepB, voffB);
        PG8_WAIT_V(6); PG8_BAR;
    } else {
        PG8_STAGE(PG8_SB(0, 0), cB, voffB); PG8_STAGE(PG8_SA(0, 0), cA, voffA0); PG8_STAGE(PG8_SB(0, 1), cB + hstepB, voffB); PG8_STAGE(PG8_SA(0, 1), cA, voffA1);
        if (wr == 1) PG8_BAR;
        PG8_WAIT_V(4); PG8_BAR;
        PG8_STAGE(PG8_SB(1, 0), cB + kstepB, voffB); PG8_STAGE(PG8_SA(1, 0), cA + kstepA, voffA0); PG8_STAGE(PG8_SB(1, 1), cB + hstepB + kstepB, voffB);
        PG8_WAIT_V(6); PG8_BAR;
    }
    for (;;) {
        const bool has_next = S.next(ui + 1, nxt);
        const char* nA = has_next ? PG8_ABASE(nxt) : cA; const char* nB = has_next ? PG8_BBASE(nxt) : cB;
        if (AMODE == 2) { if (has_next) PG8_GIDX_LOAD(nxt); }
#pragma unroll 1
        for (int t = 0; t < nt; t += 2) {
            const bool last = (t == nt - 2);
            unsigned vS0[2], vS1[2];
            if (AMODE == 2) { if (last) { if (has_next) PG8_GIDX_USE(); else { _Pragma("unroll") for (int i = 0; i < 2; ++i) { voffN0[i] = voffA0[i]; voffN1[i] = voffA1[i]; } } } }
#pragma unroll
            for (int i = 0; i < 2; ++i) { vS0[i] = (AMODE == 2 && last) ? voffN0[i] : voffA0[i]; vS1[i] = (AMODE == 2 && last) ? voffN1[i] : voffA1[i]; }
            const char* a1 = cA + (size_t)(t + 1) * kstepA;
            const char* a2 = last ? nA : cA + (size_t)(t + 2) * kstepA; const char* b2 = last ? nB : cB + (size_t)(t + 2) * kstepB;
            const char* a3 = a2 + kstepA; const char* b3 = b2 + kstepB;
            if (last && has_next) S.a_ready(nxt);
            if constexpr (SP2) {
            PG8_LDB(B0, 0, 0); PG8_LDB(B1, 0, 1); PG8_SCHED; PG8_LDA(At, 0, 0); PG8_STAGE(PG8_SA(1, 1), a1, voffA1);
            PG8_WAIT_V(8); PG8_WAIT_L(0); PG8_BAR; PG8_MMA(0, 0, At, B0); PG8_MMA(0, 1, At, B1); PG8_BAR; PG8_SCHED;
            PG8_LDA(At, 0, 1); PG8_STAGE(PG8_SB(0, 0), b2, voffB); PG8_STAGE(PG8_SB(0, 1), b2 + hstepB, voffB); PG8_STAGE(PG8_SA(0, 0), a2, vS0);
            PG8_WAIT_V(8); PG8_WAIT_L(0); PG8_BAR; PG8_MMA(1, 0, At, B0); PG8_MMA(1, 1, At, B1); PG8_BAR; PG8_SCHED;
            PG8_LDB(B0, 1, 0); PG8_LDB(B1, 1, 1); PG8_SCHED; PG8_LDA(At, 1, 0); PG8_STAGE(PG8_SA(0, 1), a2, vS1);
            PG8_WAIT_V(8); PG8_WAIT_L(0); PG8_BAR; PG8_MMA(0, 0, At, B0); PG8_MMA(0, 1, At, B1); PG8_BAR; PG8_SCHED;
            PG8_LDA(At, 1, 1); PG8_STAGE(PG8_SB(1, 0), b3, voffB); PG8_STAGE(PG8_SB(1, 1), b3 + hstepB, voffB); PG8_STAGE(PG8_SA(1, 0), a3, vS0);
            PG8_WAIT_V(8); PG8_WAIT_L(0); PG8_BAR; PG8_MMA(1, 0, At, B0); PG8_MMA(1, 1, At, B1); PG8_BAR; PG8_SCHED;
            } else {
            PG8_LDB(B0, 0, 0); PG8_SCHED; PG8_LDA(At, 0, 0); PG8_STAGE(PG8_SA(1, 1), a1, voffA1);
            PG8_WAIT_L(8); PG8_BAR; PG8_WAIT_L(0); PG8_MMA(0, 0, At, B0); PG8_BAR; PG8_SCHED;
            PG8_LDB(B1, 0, 1); PG8_STAGE(PG8_SB(0, 0), b2, voffB);
            PG8_BAR; PG8_WAIT_L(0); PG8_MMA(0, 1, At, B1); PG8_BAR;
            PG8_LDA(At, 0, 1); PG8_STAGE(PG8_SA(0, 0), a2, vS0);
            PG8_BAR; PG8_WAIT_L(0); PG8_MMA(1, 0, At, B0); PG8_BAR; PG8_SCHED;
            PG8_STAGE(PG8_SB(0, 1), b2 + hstepB, voffB);
            PG8_WAIT_V(6); PG8_BAR; PG8_MMA(1, 1, At, B1); PG8_BAR;
            PG8_LDB(B0, 1, 0); PG8_SCHED; PG8_LDA(At, 1, 0); PG8_STAGE(PG8_SA(0, 1), a2, vS1);
            PG8_WAIT_L(8); PG8_BAR; PG8_WAIT_L(0); PG8_MMA(0, 0, At, B0); PG8_BAR; PG8_SCHED;
            PG8_LDB(B1, 1, 1); PG8_STAGE(PG8_SB(1, 0), b3, voffB);
            PG8_BAR; PG8_WAIT_L(0); PG8_MMA(0, 1, At, B1); PG8_BAR;
            PG8_LDA(At, 1, 1); PG8_STAGE(PG8_SA(1, 0), a3, vS0);
            PG8_BAR; PG8_WAIT_L(0); PG8_MMA(1, 0, At, B0); PG8_BAR; PG8_SCHED;
            PG8_STAGE(PG8_SB(1, 1), b3 + hstepB, voffB);
            PG8_WAIT_V(6); PG8_BAR; PG8_MMA(1, 1, At, B1); PG8_BAR;
            }
        }
        if constexpr (ALIGN_EPI) { if (wr == 0) PG8_BAR; }
        if constexpr (F8) asm volatile("s_nop 15\n\ts_nop 15\n\ts_nop 7" ::: "memory");
        E(acc, cur, wr, wc, fr, fq); S.done(cur);
#if DBG_EPI2
        if (Epi::EPI2) { asm volatile("" ::: "memory"); E(acc, cur, wr, wc, fr, fq); }
#endif
        if (!has_next) break;
#pragma unroll
        for (int a = 0; a < 2; ++a)
#pragma unroll
            for (int b = 0; b < 2; ++b)
#pragma unroll
                for (int m = 0; m < 4; ++m)
#pragma unroll
                    for (int n = 0; n < 2; ++n) acc[a][b][m][n] = (f32x4){0.f, 0.f, 0.f, 0.f};
        cur = nxt; cA = nA; cB = nB; ++ui;
        if (AMODE == 2) {
#pragma unroll
            for (int i = 0; i < 2; ++i) { voffA0[i] = voffN0[i]; voffA1[i] = voffN1[i]; } }
        if constexpr (ALIGN_EPI) { if (wr == 1) PG8_BAR; }
    }
    PG8_WAIT_V(0);
    if constexpr (!ALIGN_EPI) { if (wr == 0) PG8_BAR; }
    PG8_BAR;
#undef PG8_GIDX_LOAD
#undef PG8_GIDX_USE
#undef PG8_ABASE
#undef PG8_BBASE
#undef PG8_SA
#undef PG8_SB
#undef PG8_STAGE
#undef PG8_LDA
#undef PG8_LDA16
#undef PG8_LDA8
#undef PG8_LDB16
#undef PG8_LDB8
#undef PG8_MMA16
#undef PG8_MMA8
#undef PG8_LDB
#undef PG8_MMA
#undef PG8_WAIT_V
#undef PG8_WAIT_L
#undef PG8_BAR
#undef PG8_SCHED
}
}
constexpr int NWAVES = 8;
constexpr int BATCH = 2, SEQ = 8192, D = 1024, M = BATCH * SEQ, DF = 512, DIN = 5632, NE = 16, CAP = 1024, DE = 2048, MR = BATCH * NE * CAP  ;
constexpr float RMS_EPS = 1e-6f;
constexpr size_t MiB = 1u << 20;
constexpr size_t WS_CTL = 0, CTL_ZERO_BYTES = 1 * MiB;
constexpr size_t WS_MODP = 1 * MiB, WS_MOD = 1 * MiB + 256 * 1024, WS_FC1 = 1 * MiB + 512 * 1024, WS_FC2 = 1 * MiB + 576 * 1024;
constexpr size_t WS_PROBS = 2 * MiB, WS_SLOT = 3 * MiB, WS_IDX = 4 * MiB, WS_VAL = 4 * MiB + 128 * 1024;
constexpr size_t WS_WIN = 8 * MiB, WS_WF = 20 * MiB, WS_WCO = 22 * MiB, WS_WO = 24 * MiB, WS_WGU = 32 * MiB, WS_WD = 160 * MiB;
constexpr size_t WS_H1 = 224 * MiB, WS_AB = 224 * MiB, WS_UF = 256 * MiB, WS_CV = 272 * MiB, WS_BG = 304 * MiB, WS_GA = 336 * MiB, WS_GB = 368 * MiB, WS_ZF = 400 * MiB, WS_TZ = 432 * MiB, WS_H2 = 464 * MiB;
#ifndef MOE_FP8
#define MOE_FP8 1
#endif
constexpr size_t WS_HM = 224 * MiB, WS_Y = 432 * MiB, WS_X1B = 400 * MiB, WS_END = 496 * MiB;
constexpr int CW_BAR = 4096;
constexpr int RING_BYTES = 131072, MISC_OFF = 143360, LDS_BYTES = 147456;
constexpr int FFT_TOFF = 65536, FFT_TPITCH = 528;

#define GAS __attribute__((address_space(1)))
#define LAS __attribute__((address_space(3)))
typedef unsigned short bf16;
typedef unsigned v4u __attribute__((ext_vector_type(4)));
typedef unsigned v2u __attribute__((ext_vector_type(2)));
typedef float f32x4 __attribute__((ext_vector_type(4)));
typedef short bf16x8 __attribute__((ext_vector_type(8)));
#define LDS_WAIT() asm volatile("s_waitcnt lgkmcnt(0)" ::: "memory")
#define VM_WAIT() asm volatile("s_waitcnt vmcnt(0)" ::: "memory")
using pg8::cvt_pk_bf16; using pg8::bf_lo; using pg8::bf_hi; using pg8::sigm;
__device__ __forceinline__ float wave_sum(float v) {
#pragma unroll
    for (int o = 1; o < 64; o <<= 1) v += __shfl_xor(v, o);
    return v;
}
__device__ __forceinline__ float silu(float v) { return v * sigm(v); }
#ifndef DBG_NOBIAS
#define DBG_NOBIAS 0
#endif
#ifndef DBG_NOSIG
#define DBG_NOSIG 0
#endif
__device__ __forceinline__ float sigx(float v) { return DBG_NOSIG ? v : sigm(v); }

#define XB_TMO      128
#define XB_XCNT(j)  (256  + 64 * (j))
#define XB_XSUB(j)  (1280 + 64 * (j))
#define XB_XGEN(j)  (2304 + 64 * (j))
#define XB_TOP      3328
#define XB_TOPGEN   3392
#define XCD_BAR_WORDS 3456
#define XB_SPIN_CAP (1u << 18)
__device__ __forceinline__ unsigned xb_ld(unsigned* p)              { return __hip_atomic_load(p, __ATOMIC_RELAXED, __HIP_MEMORY_SCOPE_AGENT); }
__device__ __forceinline__ unsigned xb_add(unsigned* p, unsigned v) { return __hip_atomic_fetch_add(p, v, __ATOMIC_RELAXED, __HIP_MEMORY_SCOPE_AGENT); }
__device__ __forceinline__ unsigned xb_xcc_id() { return (unsigned)__builtin_amdgcn_s_getreg((3 << 11) | 20) & 0xFu; }
#define XB_SPIN(cond, bar) do { unsigned _sp = 0; while (cond) { __builtin_amdgcn_s_sleep(1); \
    if ((++_sp & 255u) == 0u) { if (xb_ld(&(bar)[XB_TMO])) break; if (_sp > XB_SPIN_CAP) { atomicAdd(&(bar)[XB_TMO], 1u); break; } } } } while (0)
struct XcdBarrier { unsigned* bar; unsigned x; volatile LAS unsigned* st; };
__device__ __forceinline__ XcdBarrier xcd_barrier_post(unsigned* bar, volatile LAS unsigned* st) {
    XcdBarrier b; b.bar = bar; b.x = xb_xcc_id(); b.st = st;
    if (threadIdx.x == 0) (void)xb_add(&bar[XB_XCNT(b.x)], 1u);
    return b;
}
__device__ __forceinline__ void xcd_barrier_complete(unsigned* bar, unsigned x, unsigned& nloc, unsigned& nx) {
    const unsigned G = gridDim.x * gridDim.y * gridDim.z;
    unsigned sum, cnt, mine, sp = 0u;
    for (;;) {
        sum = 0u; cnt = 0u; mine = 0u;
#pragma unroll
        for (unsigned j = 0; j < 16; ++j) { const unsigned c = xb_ld(&bar[XB_XCNT(j)]); sum += c; cnt += (c > 0u) ? 1u : 0u; mine = (j == x) ? c : mine; }
        if (sum == G) break;
        __builtin_amdgcn_s_sleep(1);
        if ((++sp & 255u) == 0u) { if (xb_ld(&bar[XB_TMO])) break; if (sp > XB_SPIN_CAP) { atomicAdd(&bar[XB_TMO], 1u); break; } }
    }
    nloc = mine > 0u ? mine : 1u; nx = cnt > 0u ? cnt : 1u;
}
__device__ __forceinline__ void xcd_barrier(const XcdBarrier& b) {
    asm volatile("s_waitcnt vmcnt(0)" ::: "memory");
    __syncthreads();
    if (threadIdx.x == 0) {
        unsigned* bar = b.bar;
        __builtin_amdgcn_s_waitcnt(0);
        unsigned nloc = b.st[0], nx = b.st[1];
        if (nloc == 0u) { xcd_barrier_complete(bar, b.x, nloc, nx); b.st[0] = nloc; b.st[1] = nx; }
        const unsigned old = xb_add(&bar[XB_XSUB(b.x)], 1u);
        const unsigned gen = old / nloc;
        if (old + 1u == (gen + 1u) * nloc) {
            __builtin_amdgcn_fence(__ATOMIC_RELEASE, "agent");
            asm volatile("s_waitcnt vmcnt(0)" ::: "memory");
            const unsigned og = xb_add(&bar[XB_TOP], 1u);
            const unsigned tg = og / nx;
            if (og + 1u == (tg + 1u) * nx) xb_add(&bar[XB_TOPGEN], 1u);
            else XB_SPIN(xb_ld(&bar[XB_TOPGEN]) == tg, bar);
            __builtin_amdgcn_fence(__ATOMIC_ACQUIRE, "agent");
            xb_add(&bar[XB_XGEN(b.x)], 1u);
            asm volatile("s_waitcnt vmcnt(0)" ::: "memory");
        } else {
            XB_SPIN(xb_ld(&bar[XB_XGEN(b.x)]) == gen, bar);
            __builtin_amdgcn_fence(__ATOMIC_ACQUIRE, "agent");
            asm volatile("s_waitcnt vmcnt(0)" ::: "memory");
        }
    }
    __syncthreads();
}

using pg8::Unit; using pg8::u32x4; using pg8::u32x2;
struct EpiInProj {
    static constexpr bool PERM = true, EPI2 = (DBG_EPI2 == 2);
    bf16 *UF, *CV, *BG, *GA, *GB; const float* b_gate;
    __device__ __forceinline__ void operator()(const f32x4 (&acc)[2][2][4][2], const Unit& u, int wr, int wc, int fr, int fq) const {
        const int row0 = u.pm * 256 + wr * 64 + fr;
        if (u.pn < 2) {
            const int b = u.pm >> 5, s0 = (u.pm & 31) * 256 + wr * 64 + fr;
#pragma unroll
            for (int ai = 0; ai < 2; ++ai)
#pragma unroll
                for (int m = 0; m < 4; ++m) { const int s = s0 + ai * 128 + m * 16;
#pragma unroll
                    for (int bj = 0; bj < 2; ++bj) { const int g4 = (u.pn * 256 + bj * 128 + wc * 32 + 8 * fq) >> 2;
#pragma unroll
                        for (int n = 0; n < 2; ++n) { const f32x4 v = acc[ai][bj][m][n]; u32x2 w; w.x = cvt_pk_bf16(v[0], v[1]); w.y = cvt_pk_bf16(v[2], v[3]);
                            *(u32x2*)(UF + ((size_t)(b * 128 + g4 + n) * 8192 + s) * 4) = w; } } }
        } else if (u.pn < 10) {
#pragma unroll
            for (int ai = 0; ai < 2; ++ai)
#pragma unroll
                for (int m = 0; m < 4; ++m) { bf16* rowp = CV + (size_t)(row0 + ai * 128 + m * 16) * D + (u.pn - 2) * 128 + wc * 16 + 4 * fq;
#pragma unroll
                    for (int bj = 0; bj < 2; ++bj) { const f32x4 v = acc[ai][bj][m][0] * acc[ai][bj][m][1]; u32x2 w; w.x = cvt_pk_bf16(v[0], v[1]); w.y = cvt_pk_bf16(v[2], v[3]);
                        *(u32x2*)(rowp + bj * 64) = w; } }
        } else if (u.pn < 14) {
#pragma unroll
            for (int ai = 0; ai < 2; ++ai)
#pragma unroll
                for (int m = 0; m < 4; ++m) { bf16* rowp = BG + (size_t)(row0 + ai * 128 + m * 16) * D + (u.pn - 10) * 256 + wc * 32 + 8 * fq;
#pragma unroll
                    for (int bj = 0; bj < 2; ++bj) { const f32x4 v0 = acc[ai][bj][m][0], v1 = acc[ai][bj][m][1]; u32x4 w; w.x = cvt_pk_bf16(v0[0], v0[1]); w.y = cvt_pk_bf16(v0[2], v0[3]); w.z = cvt_pk_bf16(v1[0], v1[1]); w.w = cvt_pk_bf16(v1[2], v1[3]);
                        *(u32x4*)(rowp + bj * 128) = w; } }
        } else {
            const int colg = (u.pn - 14) * 256 + wc * 32 + 8 * fq;
            bf16* O = (u.pn < 18) ? GA : GB;
            f32x4 bv[2][2];
#pragma unroll
            for (int bj = 0; bj < 2; ++bj)
#pragma unroll
                for (int n = 0; n < 2; ++n) bv[bj][n] = DBG_NOBIAS ? (f32x4){0.f, 0.f, 0.f, 0.f} : *(const f32x4*)(b_gate + colg + bj * 128 + 4 * n);
#pragma unroll
            for (int ai = 0; ai < 2; ++ai)
#pragma unroll
                for (int m = 0; m < 4; ++m) { bf16* rowp = O + (size_t)(row0 + ai * 128 + m * 16) * D + (colg & 1023);
#pragma unroll
                    for (int bj = 0; bj < 2; ++bj) { const f32x4 v0 = acc[ai][bj][m][0] + bv[bj][0], v1 = acc[ai][bj][m][1] + bv[bj][1]; u32x4 w;
                        w.x = cvt_pk_bf16(sigx(v0[0]), sigx(v0[1])); w.y = cvt_pk_bf16(sigx(v0[2]), sigx(v0[3])); w.z = cvt_pk_bf16(sigx(v1[0]), sigx(v1[1])); w.w = cvt_pk_bf16(sigx(v1[2]), sigx(v1[3]));
                        *(u32x4*)(rowp + bj * 128) = w; } }
        }
    }
};
template <int MODE> struct EpiGateMul {
    static constexpr bool PERM = true, EPI2 = false;
    bf16* O; const bf16* G;
    __device__ __forceinline__ void operator()(const f32x4 (&acc)[2][2][4][2], const Unit& u, int wr, int wc, int fr, int fq) const {
        const int row0 = u.pm * 256 + wr * 64 + fr, col0 = u.pn * 256 + wc * 32 + 8 * fq;
#pragma unroll
        for (int ai = 0; ai < 2; ++ai)
#pragma unroll
            for (int m = 0; m < 4; ++m) { const size_t off = (size_t)(row0 + ai * 128 + m * 16) * D + col0;
#pragma unroll
                for (int bj = 0; bj < 2; ++bj) { const u32x4 gw = *(const u32x4*)(G + off + bj * 128); const f32x4 v0 = acc[ai][bj][m][0], v1 = acc[ai][bj][m][1];
                    float r[8] = {bf_lo(gw.x) * v0[0], bf_hi(gw.x) * v0[1], bf_lo(gw.y) * v0[2], bf_hi(gw.y) * v0[3], bf_lo(gw.z) * v1[0], bf_hi(gw.z) * v1[1], bf_lo(gw.w) * v1[2], bf_hi(gw.w) * v1[3]};
                    if (MODE == 1) { const u32x4 ow = *(const u32x4*)(O + off + bj * 128);
                        r[0] += bf_lo(ow.x); r[1] += bf_hi(ow.x); r[2] += bf_lo(ow.y); r[3] += bf_hi(ow.y); r[4] += bf_lo(ow.z); r[5] += bf_hi(ow.z); r[6] += bf_lo(ow.w); r[7] += bf_hi(ow.w); }
                    u32x4 w; w.x = cvt_pk_bf16(r[0], r[1]); w.y = cvt_pk_bf16(r[2], r[3]); w.z = cvt_pk_bf16(r[4], r[5]); w.w = cvt_pk_bf16(r[6], r[7]);
                    *(u32x4*)(O + off + bj * 128) = w; } }
    }
};
struct EpiResid {
    static constexpr bool PERM = true, EPI2 = (DBG_EPI2 == 5);
    const float* x; bf16* X1B; const float* gate;
    __device__ __forceinline__ void operator()(const f32x4 (&acc)[2][2][4][2], const Unit& u, int wr, int wc, int fr, int fq) const {
        const int row0 = u.pm * 256 + wr * 64 + fr, col0 = u.pn * 256 + wc * 32 + 8 * fq, b = u.pm >> 5;
        f32x4 gv[2][2];
#pragma unroll
        for (int bj = 0; bj < 2; ++bj)
#pragma unroll
            for (int n = 0; n < 2; ++n) gv[bj][n] = *(const f32x4*)(gate + b * 6 * D + col0 + bj * 128 + 4 * n);
#pragma unroll
        for (int ai = 0; ai < 2; ++ai)
#pragma unroll
            for (int m = 0; m < 4; ++m) { const size_t off = (size_t)(row0 + ai * 128 + m * 16) * D + col0;
#pragma unroll
                for (int bj = 0; bj < 2; ++bj) { const f32x4 x0 = *(const f32x4*)(x + off + bj * 128), x1 = *(const f32x4*)(x + off + bj * 128 + 4);
                    const f32x4 v0 = x0 + gv[bj][0] * acc[ai][bj][m][0], v1 = x1 + gv[bj][1] * acc[ai][bj][m][1];
                    u32x4 w; w.x = cvt_pk_bf16(v0[0], v0[1]); w.y = cvt_pk_bf16(v0[2], v0[3]); w.z = cvt_pk_bf16(v1[0], v1[1]); w.w = cvt_pk_bf16(v1[2], v1[3]);
                    *(u32x4*)(X1B + off + bj * 128) = w; }
                asm volatile("" ::: "memory"); }
    }
};
struct EpiSwiGLU {
    static constexpr bool PERM = true, EPI2 = (DBG_EPI2 == 9);
    bf16* HM;
    __device__ __forceinline__ void operator()(const f32x4 (&acc)[2][2][4][2], const Unit& u, int wr, int wc, int fr, int fq) const {
        const int row0 = u.pm * 256 + wr * 64 + fr, col0 = u.pn * 128 + wc * 32 + 8 * fq;
#pragma unroll
        for (int ai = 0; ai < 2; ++ai)
#pragma unroll
            for (int m = 0; m < 4; ++m) { const f32x4 g0 = acc[ai][0][m][0], g1 = acc[ai][0][m][1], u0 = acc[ai][1][m][0], u1 = acc[ai][1][m][1]; u32x4 w;
                w.x = cvt_pk_bf16(silu(g0[0]) * u0[0], silu(g0[1]) * u0[1]); w.y = cvt_pk_bf16(silu(g0[2]) * u0[2], silu(g0[3]) * u0[3]);
                w.z = cvt_pk_bf16(silu(g1[0]) * u1[0], silu(g1[1]) * u1[1]); w.w = cvt_pk_bf16(silu(g1[2]) * u1[2], silu(g1[3]) * u1[3]);
                *(u32x4*)(HM + (size_t)(row0 + ai * 128 + m * 16) * DE + col0) = w; }
    }
};
__device__ __forceinline__ unsigned pk4_fp8(float a, float b2, float c, float d) { unsigned w = 0u; w = __builtin_amdgcn_cvt_pk_fp8_f32(a, b2, w, false); w = __builtin_amdgcn_cvt_pk_fp8_f32(c, d, w, true); return w; }
struct EpiSwiGLU8 {
    static constexpr bool PERM = true, EPI2 = false;
    unsigned char* HM8;
    __device__ __forceinline__ void operator()(const f32x4 (&acc)[2][2][4][2], const Unit& u, int wr, int wc, int fr, int fq) const {
        const int row0 = u.pm * 256 + wr * 64 + fr, col0 = u.pn * 128 + wc * 32 + 8 * fq;
#pragma unroll
        for (int ai = 0; ai < 2; ++ai)
#pragma unroll
            for (int m = 0; m < 4; ++m) { const f32x4 g0 = acc[ai][0][m][0], g1 = acc[ai][0][m][1], u0 = acc[ai][1][m][0], u1 = acc[ai][1][m][1]; u32x2 w;
                w.x = pk4_fp8(silu(g0[0]) * u0[0], silu(g0[1]) * u0[1], silu(g0[2]) * u0[2], silu(g0[3]) * u0[3]);
                w.y = pk4_fp8(silu(g1[0]) * u1[0], silu(g1[1]) * u1[1], silu(g1[2]) * u1[2], silu(g1[3]) * u1[3]);
                *(u32x2*)(HM8 + (size_t)(row0 + ai * 128 + m * 16) * DE + col0) = w; asm volatile("" ::: "memory"); }
    }
};
struct EpiRowScale {
    static constexpr bool PERM = true, EPI2 = (DBG_EPI2 == 10);
    bf16* Y; const float* val;
    __device__ __forceinline__ void operator()(const f32x4 (&acc)[2][2][4][2], const Unit& u, int wr, int wc, int fr, int fq) const {
        const int row0 = u.pm * 256 + wr * 64 + fr, col0 = u.pn * 256 + wc * 32 + 8 * fq;
#pragma unroll
        for (int ai = 0; ai < 2; ++ai)
#pragma unroll
            for (int m = 0; m < 4; ++m) { const int row = row0 + ai * 128 + m * 16; const float sv = val[row];
#pragma unroll
                for (int bj = 0; bj < 2; ++bj) { const f32x4 v0 = acc[ai][bj][m][0] * sv, v1 = acc[ai][bj][m][1] * sv; u32x4 w; w.x = cvt_pk_bf16(v0[0], v0[1]); w.y = cvt_pk_bf16(v0[2], v0[3]); w.z = cvt_pk_bf16(v1[0], v1[1]); w.w = cvt_pk_bf16(v1[2], v1[3]);
                    *(u32x4*)(Y + (size_t)row * D + col0 + bj * 128) = w; } }
    }
};

struct EpiPlain {
    static constexpr bool PERM = true, EPI2 = false;
    bf16* O; int ldc;
    __device__ __forceinline__ void operator()(const f32x4 (&acc)[2][2][4][2], const Unit& u, int wr, int wc, int fr, int fq) const {
        const int row0 = u.pm * 256 + wr * 64 + fr, col0 = u.pn * 256 + wc * 32 + 8 * fq;
#pragma unroll
        for (int ai = 0; ai < 2; ++ai)
#pragma unroll
            for (int m = 0; m < 4; ++m) { bf16* rowp = O + (size_t)(row0 + ai * 128 + m * 16) * ldc + col0;
#pragma unroll
                for (int bj = 0; bj < 2; ++bj) { const f32x4 v0 = acc[ai][bj][m][0], v1 = acc[ai][bj][m][1]; u32x4 w; w.x = cvt_pk_bf16(v0[0], v0[1]); w.y = cvt_pk_bf16(v0[2], v0[3]); w.z = cvt_pk_bf16(v1[0], v1[1]); w.w = cvt_pk_bf16(v1[2], v1[3]);
                    *(u32x4*)(rowp + bj * 128) = w; } }
    }
};
__device__ __forceinline__ unsigned f2bf(float f) { unsigned u = __builtin_bit_cast(unsigned, f); return (u + 0x7fffu + ((u >> 16) & 1u)) >> 16; }
__device__ __forceinline__ unsigned pk2(float lo, float hi) { return f2bf(lo) | (f2bf(hi) << 16); }
__device__ __forceinline__ int rowmap_in(int n) {
    if (n < 512) return n;
    if (n < 1536) { const int j = n - 512; return 512 + 8 * (j >> 2) + (j & 3); }
    if (n < 2560) return 2560 + (n - 1536);
    if (n < 3584) { const int j = n - 2560; return 512 + 8 * (j >> 2) + 4 + (j & 3); }
    return n;
}
template <int MAP>
__device__ __forceinline__ void transpose_item(const float* W, int K, int N, bf16* WT, LAS float* scr, int item, int lane) {
    const int nblk = N / 32, kb = item / nblk, nb = item % nblk, k0 = 64 * kb, n0 = 32 * nb;
    { f32x4 t[8];
#pragma unroll
      for (int i = 0; i < 8; ++i) t[i] = *(const GAS f32x4*)(W + (size_t)(k0 + 8 * i + (lane >> 3)) * N + n0 + 4 * (lane & 7));
#pragma unroll
      for (int i = 0; i < 8; ++i) { LAS float* d_ = scr + (8 * i + (lane >> 3)) * 33 + 4 * (lane & 7); d_[0] = t[i].x; d_[1] = t[i].y; d_[2] = t[i].z; d_[3] = t[i].w; } }
    LDS_WAIT(); asm volatile("" ::: "memory");
    const int c = lane & 7;
#pragma unroll
    for (int j = 0; j < 4; ++j) { const int n = (lane >> 3) + 8 * j; const LAS float* s = scr + (8 * c) * 33 + n;
        v4u o; o.x = pk2(s[0 * 33], s[1 * 33]); o.y = pk2(s[2 * 33], s[3 * 33]); o.z = pk2(s[4 * 33], s[5 * 33]); o.w = pk2(s[6 * 33], s[7 * 33]);
        const int ns = n0 + n; int row;
        if (MAP == 0) row = ns; else if (MAP == 1) row = rowmap_in(ns); else if (MAP == 2) row = 256 * (ns >> 7) + (ns & 127); else row = 256 * (ns >> 7) + 128 + (ns & 127);
        *(GAS v4u*)(WT + (size_t)row * K + k0 + 8 * c) = o; }
    LDS_WAIT(); asm volatile("" ::: "memory");
}
template <int MAP>
__device__ __forceinline__ void transpose_item8(const float* W, int K, int N, unsigned char* WT, LAS float* scr, int item, int lane) {
    const int nblk = N / 32, kb = item / nblk, nb = item % nblk, k0 = 64 * kb, n0 = 32 * nb;
    { f32x4 t[8];
#pragma unroll
      for (int i = 0; i < 8; ++i) t[i] = *(const GAS f32x4*)(W + (size_t)(k0 + 8 * i + (lane >> 3)) * N + n0 + 4 * (lane & 7));
#pragma unroll
      for (int i = 0; i < 8; ++i) { LAS float* d_ = scr + (8 * i + (lane >> 3)) * 33 + 4 * (lane & 7); d_[0] = t[i].x; d_[1] = t[i].y; d_[2] = t[i].z; d_[3] = t[i].w; } }
    LDS_WAIT(); asm volatile("" ::: "memory");
    const int c = lane & 3;
#pragma unroll
    for (int j = 0; j < 2; ++j) { const int n = (lane >> 2) + 16 * j; const LAS float* s = scr + (16 * c) * 33 + n; unsigned o[4];
#pragma unroll
        for (int q = 0; q < 4; ++q) { unsigned w = 0u; w = __builtin_amdgcn_cvt_pk_fp8_f32(s[(4 * q) * 33] * 128.f, s[(4 * q + 1) * 33] * 128.f, w, false); w = __builtin_amdgcn_cvt_pk_fp8_f32(s[(4 * q + 2) * 33] * 128.f, s[(4 * q + 3) * 33] * 128.f, w, true); o[q] = w; }
        const int ns = n0 + n; int row;
        if (MAP == 0) row = ns; else if (MAP == 2) row = 256 * (ns >> 7) + (ns & 127); else row = 256 * (ns >> 7) + 128 + (ns & 127);
        v4u ov; ov.x = o[0]; ov.y = o[1]; ov.z = o[2]; ov.w = o[3];
        *(GAS v4u*)(WT + (size_t)row * K + k0 + 16 * c) = ov; }
    LDS_WAIT(); asm volatile("" ::: "memory");
}
__device__ __forceinline__ void wf_item(const float* wf, bf16* WF_T, int item, int lane) {
    const int c = item >> 2, dblk = item & 3, g = c >> 7, j = c & 127, d0 = 256 * dblk + 4 * lane;
    f32x4 ac = {0.f, 0.f, 0.f, 0.f}, as = {0.f, 0.f, 0.f, 0.f};
    for (int m = 0; m < 128; ++m) { const f32x4 wv = *(const GAS f32x4*)(wf + (size_t)(g * 128 + m) * D + d0); const float fr = (float)((m * j) & 127) * (1.0f / 128.0f);
        const float cv = __builtin_amdgcn_cosf(fr), sv = __builtin_amdgcn_sinf(fr); ac += cv * wv; as += sv * wv; }
    const int kv = 8 * (c >> 2) + 2 * (c & 3);
#pragma unroll
    for (int i = 0; i < 4; ++i) *(GAS unsigned*)(WF_T + (size_t)(d0 + i) * D + kv) = pk2(ac[i] * (1.0f / 1024.0f), as[i] * (1.0f / 1024.0f));
}
__device__ __forceinline__ void fc_tables(bf16* Fc1, bf16* Fc2, int gtid, int gthreads) {
    for (int e = gtid; e < 8192 + 65536; e += gthreads) {
        if (e < 8192) { const int j = e & 7, ln = (e >> 3) & 63, kk = (e >> 9) & 1, mt = (e >> 10) & 3, hh = e >> 12, rho = ln & 15;
            const int s1 = 32 * kk + 8 * (ln >> 4) + j, k1 = 32 * hh + 16 * (mt & 1) + 4 * (rho & 3) + (rho >> 2);
            const float fr = (float)((k1 * s1) & 63) * (1.0f / 64.0f); Fc1[e] = (bf16)f2bf((mt >> 1) == 0 ? cospif(2.0f * fr) : -sinpif(2.0f * fr)); }
        else { const int q = e - 8192, j = q & 7, ln = (q >> 3) & 63, kk = (q >> 9) & 7, ro = (q >> 12) & 1, w = q >> 13;
            const int k2 = 16 * w + (ln & 15), kap = 32 * kk + 8 * (ln >> 4) + j, s2 = kap >> 1, ri = kap & 1;
            const float fr = (float)((k2 * s2) & 127) * (1.0f / 128.0f), cv = cospif(2.0f * fr), sv = sinpif(2.0f * fr);
            Fc2[q] = (bf16)f2bf(ro == 0 ? (ri == 0 ? cv : sv) : (ri == 0 ? -sv : cv)); }
    }
}
__device__ __forceinline__ void mod_item(const float* c, const float* w_ada, float* modp, LAS unsigned char* lds, int item, int tid, int wave, int lane) {
    const int cb = item % 24, kq = item / 24, col0 = 256 * cb + 4 * lane;
    f32x4 a0 = {0.f, 0.f, 0.f, 0.f}, a1 = {0.f, 0.f, 0.f, 0.f};
#pragma unroll
    for (int i0 = 0; i0 < 32; i0 += 16) { f32x4 wv[16];
#pragma unroll
        for (int i = 0; i < 16; ++i) wv[i] = *(const GAS f32x4*)(w_ada + (size_t)(256 * kq + 32 * wave + i0 + i) * 6 * D + col0);
#pragma unroll
        for (int i = 0; i < 16; ++i) { const int d = 256 * kq + 32 * wave + i0 + i; a0 += silu(c[d]) * wv[i]; a1 += silu(c[D + d]) * wv[i]; } }
    LAS f32x4* red = (LAS f32x4*)lds;
    red[(wave * 2 + 0) * 64 + lane] = a0; red[(wave * 2 + 1) * 64 + lane] = a1;
    __syncthreads();
    { const int b = tid >> 8, cc = tid & 255; const LAS float* rf = (const LAS float*)lds; float s = 0.f;
#pragma unroll
      for (int w = 0; w < 8; ++w) s += rf[((w * 2 + b) * 64) * 4 + cc];
      modp[(size_t)(kq * 2 + b) * 6 * D + 256 * cb + cc] = s; }
    __syncthreads();
}

__device__ __forceinline__ void phase_h(const float* x, const float* g_mix, const float* b_ada, const float* modp, float* mod, bf16* H1, LAS unsigned char* lds, int tid, int wave, int lane, int vcu, int G) {
    LAS float* ga = (LAS float*)lds;
    LAS float* sh = ga + 2 * D;
    { float v[8];
#pragma unroll
      for (int k = 0; k < 8; ++k) { const int i = tid + 512 * k, j = i & 2047; v[k] = b_ada[j]; }
#pragma unroll
      for (int q = 0; q < 4; ++q)
#pragma unroll
          for (int k = 0; k < 8; ++k) { const int i = tid + 512 * k, b = i >> 11, j = i & 2047; v[k] += modp[(size_t)(q * 2 + b) * 6 * D + j]; }
#pragma unroll
      for (int k = 0; k < 8; ++k) { const int i = tid + 512 * k, b = i >> 11, j = i & 2047; if (j < D) sh[b * D + j] = v[k]; else ga[b * D + j - D] = g_mix[j - D] * (1.f + v[k]); } }
    { const int i = vcu * NWAVES * 64 + tid;
      if (i < 2 * 6 * D) { const int b = i / (6 * D), j = i % (6 * D); float v = b_ada[j];
#pragma unroll
          for (int q = 0; q < 4; ++q) v += modp[(size_t)(q * 2 + b) * 6 * D + j];
          mod[i] = v; } }
    __syncthreads();
    const int gw = vcu * NWAVES + wave, NGW = G * NWAVES;
    for (int m0 = gw * 4; m0 < M; m0 += NGW * 4) { const int b = m0 >> 13;
        f32x4 v[4][4]; float s[4];
#pragma unroll
        for (int r = 0; r < 4; ++r) { const GAS f32x4* xr = (const GAS f32x4*)(x + (size_t)(m0 + r) * D) + lane;
#pragma unroll
            for (int j = 0; j < 4; ++j) v[r][j] = xr[64 * j]; }
#pragma unroll
        for (int r = 0; r < 4; ++r) { s[r] = 0.f;
#pragma unroll
            for (int j = 0; j < 4; ++j) s[r] += (v[r][j].x * v[r][j].x + v[r][j].y * v[r][j].y) + (v[r][j].z * v[r][j].z + v[r][j].w * v[r][j].w); }
#pragma unroll
        for (int o = 1; o < 64; o <<= 1) {
#pragma unroll
            for (int r = 0; r < 4; ++r) s[r] += __shfl_xor(s[r], o); }
#pragma unroll
        for (int r = 0; r < 4; ++r) { const float rr = rsqrtf(s[r] * (1.f / D) + RMS_EPS); GAS v2u* o8 = (GAS v2u*)(H1 + (size_t)(m0 + r) * D) + lane;
#pragma unroll
            for (int j = 0; j < 4; ++j) { const f32x4 gg = *(const LAS f32x4*)(ga + b * D + 4 * lane + 256 * j), ss = *(const LAS f32x4*)(sh + b * D + 4 * lane + 256 * j); const f32x4 y = v[r][j] * rr * gg + ss;
                v2u w; w.x = cvt_pk_bf16(y.x, y.y); w.y = cvt_pk_bf16(y.z, y.w); o8[64 * j] = w; } } }
    __syncthreads();
}
__device__ __forceinline__ void phase_conv(const bf16* CV, const bf16* BG, const float* w_conv, bf16* AB, int wave, int lane, int vcu, int G) {
    const int gw = vcu * NWAVES + wave, NGW = G * NWAVES;
    for (int o = gw; o < M / 8; o += NGW) { const int r0 = 8 * o, s0 = r0 & (SEQ - 1);
#pragma unroll
        for (int hseg = 0; hseg < 2; ++hseg) { const int ch = hseg * 512 + 8 * lane; const size_t off = (size_t)r0 * D + ch;
            v4u cv[10], bg[8];
#pragma unroll
            for (int jj = 0; jj < 10; ++jj) { const bool ok = (jj == 0) ? (s0 > 0) : (jj == 9) ? (s0 + 8 < SEQ) : true; cv[jj] = (v4u){0u, 0u, 0u, 0u}; if (ok) cv[jj] = *(const GAS v4u*)(CV + off + (size_t)(jj - 1) * D); }
#pragma unroll
            for (int jj = 0; jj < 8; ++jj) bg[jj] = *(const GAS v4u*)(BG + off + (size_t)jj * D);
            float w0[8], w1[8], w2[8];
#pragma unroll
            for (int q = 0; q < 2; ++q) { const f32x4 a = *(const GAS f32x4*)(w_conv + ch + 4 * q), b = *(const GAS f32x4*)(w_conv + D + ch + 4 * q), c2 = *(const GAS f32x4*)(w_conv + 2 * D + ch + 4 * q);
#pragma unroll
                for (int i2 = 0; i2 < 4; ++i2) { w0[4 * q + i2] = a[i2]; w1[4 * q + i2] = b[i2]; w2[4 * q + i2] = c2[i2]; } }
#pragma unroll
            for (int jj = 0; jj < 8; ++jj) { unsigned ow[4];
#pragma unroll
                for (int q = 0; q < 4; ++q) {
                    const float lo = bf_lo(bg[jj][q]) * (w0[2 * q] * bf_lo(cv[jj][q]) + w1[2 * q] * bf_lo(cv[jj + 1][q]) + w2[2 * q] * bf_lo(cv[jj + 2][q]));
                    const float hi = bf_hi(bg[jj][q]) * (w0[2 * q + 1] * bf_hi(cv[jj][q]) + w1[2 * q + 1] * bf_hi(cv[jj + 1][q]) + w2[2 * q + 1] * bf_hi(cv[jj + 2][q]));
                    ow[q] = cvt_pk_bf16(lo, hi); }
                v4u ov; ov.x = ow[0]; ov.y = ow[1]; ov.z = ow[2]; ov.w = ow[3];
                *(GAS v4u*)(AB + off + (size_t)jj * D) = ov; } } }
}
__device__ __forceinline__ void phase_h2(const bf16* X1B, const float* g_moe, const float* mod, const float* w_router, const float* b_router, bf16* H2, unsigned char* H2F8, float* probs,
                                         LAS unsigned char* lds, int tid, int wave, int lane, int vcu, int G) {
    LAS bf16* whi = (LAS bf16*)lds;
    LAS bf16* wlo = whi + 16384;
    LAS float* ga = (LAS float*)(lds + 65536);
    LAS float* sh = ga + 2 * D;
    for (int i = tid; i < 16384; i += NWAVES * 64) { const int j = i & 7, ln = (i >> 3) & 63, kk = i >> 9, k = 32 * kk + 8 * (ln >> 4) + j, e = ln & 15;
        const float w = w_router[k * NE + e]; const unsigned h = f2bf(w); const float wh = __uint_as_float(h << 16); whi[i] = (bf16)h; wlo[i] = (bf16)f2bf(w - wh); }
    { float a[4], b2[4], c2[4];
#pragma unroll
      for (int k = 0; k < 4; ++k) { const int i = tid + 512 * k, b = i >> 10, j = i & 1023; a[k] = mod[b * 6 * D + 3 * D + j]; b2[k] = mod[b * 6 * D + 4 * D + j]; c2[k] = g_moe[j]; }
#pragma unroll
      for (int k = 0; k < 4; ++k) { const int i = tid + 512 * k; sh[i] = a[k]; ga[i] = c2[k] * (1.f + b2[k]); } }
    __syncthreads();
    const int n = lane & 15, kq = lane >> 4;
    float br[4];
#pragma unroll
    for (int r = 0; r < 4; ++r) br[r] = b_router[4 * kq + r];
    for (int grp = wave * G + vcu; grp < M / 16; grp += NWAVES * G) { const int m0 = 16 * grp, b = m0 >> 13;
        const GAS v4u* xr = (const GAS v4u*)(X1B + (size_t)(m0 + n) * D + 8 * kq);
        v4u xf[32]; float ssq = 0.f;
#pragma unroll
        for (int kk = 0; kk < 32; ++kk) xf[kk] = xr[4 * kk];
#pragma unroll
        for (int kk = 0; kk < 32; ++kk) { const v4u w = xf[kk]; const float e0 = bf_lo(w.x), e1 = bf_hi(w.x), e2 = bf_lo(w.y), e3 = bf_hi(w.y), e4 = bf_lo(w.z), e5 = bf_hi(w.z), e6 = bf_lo(w.w), e7 = bf_hi(w.w);
            ssq += (e0 * e0 + e1 * e1) + (e2 * e2 + e3 * e3) + (e4 * e4 + e5 * e5) + (e6 * e6 + e7 * e7); }
#pragma unroll
        for (int kk = 0; kk < 32; ++kk) asm volatile("" : "+v"(xf[kk].x), "+v"(xf[kk].y), "+v"(xf[kk].z), "+v"(xf[kk].w));
        ssq += __shfl_xor(ssq, 16); ssq += __shfl_xor(ssq, 32);
        const float rstd = rsqrtf(ssq * (1.f / D) + RMS_EPS);
        f32x4 acc = {0.f, 0.f, 0.f, 0.f};
        GAS v4u* ho = (GAS v4u*)(H2 + (size_t)(m0 + n) * D + 8 * kq);
#pragma unroll
        for (int kk = 0; kk < 32; ++kk) { const v4u w = xf[kk]; const int col = 32 * kk + 8 * kq;
            const f32x4 g0 = *(const LAS f32x4*)(ga + b * D + col), g1 = *(const LAS f32x4*)(ga + b * D + col + 4), s0 = *(const LAS f32x4*)(sh + b * D + col), s1 = *(const LAS f32x4*)(sh + b * D + col + 4);
            float h[8] = {bf_lo(w.x) * rstd * g0.x + s0.x, bf_hi(w.x) * rstd * g0.y + s0.y, bf_lo(w.y) * rstd * g0.z + s0.z, bf_hi(w.y) * rstd * g0.w + s0.w,
                          bf_lo(w.z) * rstd * g1.x + s1.x, bf_hi(w.z) * rstd * g1.y + s1.y, bf_lo(w.w) * rstd * g1.z + s1.z, bf_hi(w.w) * rstd * g1.w + s1.w};
            v4u hh, hl;
            hh.x = cvt_pk_bf16(h[0], h[1]); hh.y = cvt_pk_bf16(h[2], h[3]); hh.z = cvt_pk_bf16(h[4], h[5]); hh.w = cvt_pk_bf16(h[6], h[7]);
            hl.x = cvt_pk_bf16(h[0] - bf_lo(hh.x), h[1] - bf_hi(hh.x)); hl.y = cvt_pk_bf16(h[2] - bf_lo(hh.y), h[3] - bf_hi(hh.y)); hl.z = cvt_pk_bf16(h[4] - bf_lo(hh.z), h[5] - bf_hi(hh.z)); hl.w = cvt_pk_bf16(h[6] - bf_lo(hh.w), h[7] - bf_hi(hh.w));
            if (MOE_FP8) { v2u q8; q8.x = pk4_fp8(h[0], h[1], h[2], h[3]); q8.y = pk4_fp8(h[4], h[5], h[6], h[7]); *(GAS v2u*)(H2F8 + (size_t)(m0 + n) * D + 32 * kk + 8 * kq) = q8; }
            else ho[4 * kk] = hh;
            const bf16x8 ah = *(const LAS bf16x8*)(whi + (kk * 64 + lane) * 8), al = *(const LAS bf16x8*)(wlo + (kk * 64 + lane) * 8);
            const bf16x8 bh = __builtin_bit_cast(bf16x8, hh), bl = __builtin_bit_cast(bf16x8, hl);
            acc = __builtin_amdgcn_mfma_f32_16x16x32_bf16(ah, bh, acc, 0, 0, 0); acc = __builtin_amdgcn_mfma_f32_16x16x32_bf16(al, bh, acc, 0, 0, 0); acc = __builtin_amdgcn_mfma_f32_16x16x32_bf16(ah, bl, acc, 0, 0, 0);
            asm volatile("" ::: "memory"); }
        float lg[4], mx = -3.0e38f;
#pragma unroll
        for (int r = 0; r < 4; ++r) { lg[r] = acc[r] + br[r]; mx = fmaxf(mx, lg[r]); }
        mx = fmaxf(mx, __shfl_xor(mx, 16)); mx = fmaxf(mx, __shfl_xor(mx, 32));
        float sum = 0.f;
#pragma unroll
        for (int r = 0; r < 4; ++r) { lg[r] = __expf(lg[r] - mx); sum += lg[r]; }
        sum += __shfl_xor(sum, 16); sum += __shfl_xor(sum, 32);
        const float inv = 1.0f / sum; const int s = (m0 + n) & (SEQ - 1);
#pragma unroll
        for (int r = 0; r < 4; ++r) probs[((size_t)(b * NE + 4 * kq + r)) * SEQ + s] = lg[r] * inv; }
}
__device__ __forceinline__ void topk_item(const float* probs, int* idx, float* val, int* slot, LAS unsigned char* lds, int item, int tid, int wave, int lane) {
    const int e = item >> 1, b = item & 1;
    LAS int* red = (LAS int*)lds;
    unsigned p[16];
#pragma unroll
    for (int q = 0; q < 4; ++q) { const v4u w = *(const GAS v4u*)(probs + ((size_t)(b * NE + e)) * SEQ + 16 * tid + 4 * q); p[4 * q] = w.x; p[4 * q + 1] = w.y; p[4 * q + 2] = w.z; p[4 * q + 3] = w.w; }
    unsigned prefix = 0u;
    for (int bit = 30; bit >= 0; --bit) { const unsigned cand = prefix | (1u << bit); int cnt = 0;
#pragma unroll
        for (int j = 0; j < 16; ++j) cnt += __popcll(__ballot(p[j] >= cand));
        const int par = bit & 1;
        if (lane == 0) red[par * 8 + wave] = cnt;
        __syncthreads();
        int tot = 0;
#pragma unroll
        for (int w = 0; w < 8; ++w) tot += red[par * 8 + w];
        if (tot >= CAP) prefix = cand; }
    const unsigned T = prefix;
    int cgt = 0, ceq = 0;
#pragma unroll
    for (int j = 0; j < 16; ++j) { cgt += (p[j] > T) ? 1 : 0; ceq += (p[j] == T) ? 1 : 0; }
    int sgt = cgt, seq = ceq;
#pragma unroll
    for (int o = 1; o < 64; o <<= 1) { const int a = __shfl_up(sgt, o), c = __shfl_up(seq, o); if (lane >= o) { sgt += a; seq += c; } }
    __syncthreads();
    if (lane == 63) { red[32 + wave] = sgt; red[48 + wave] = seq; }
    __syncthreads();
    int bgt = 0, beq = 0, totgt = 0;
#pragma unroll
    for (int w = 0; w < 8; ++w) { const int a = red[32 + w], c = red[48 + w]; if (w < wave) { bgt += a; beq += c; } totgt += a; }
    int rgt = bgt + sgt - cgt, req = beq + seq - ceq;
    const int need = CAP - totgt; const int rbase = (e * 2 + b) * CAP;
#pragma unroll
    for (int j = 0; j < 16; ++j) { const int tok = b * SEQ + 16 * tid + j; int sl = -1;
        if (p[j] > T) { sl = rgt; ++rgt; } else if (p[j] == T) { if (req < need) sl = totgt + req; ++req; }
        slot[(size_t)tok * NE + e] = sl;
        if (sl >= 0) { idx[rbase + sl] = tok; val[rbase + sl] = __uint_as_float(p[j]); } }
    __syncthreads();
}
__device__ __forceinline__ void phase_gather(const bf16* H2, const int* idx, bf16* XE, int wave, int lane, int vcu, int G) {
    const int gw = vcu * NWAVES + wave, NGW = G * NWAVES;
    for (int r = gw; r < MR; r += NGW) { const int tok = idx[r];
        const GAS v4u* src = (const GAS v4u*)(H2 + (size_t)tok * D) + lane; GAS v4u* dst = (GAS v4u*)(XE + (size_t)r * D) + lane;
        const v4u a = src[0], b2 = src[64]; dst[0] = a; dst[64] = b2; }
}
__device__ __forceinline__ void phase_final(float* out, const bf16* X1B, const bf16* Y, const int* slot, const float* mod, const float* g_fin, int wave, int lane, int vcu, int G, float pert) {
    const int gw = vcu * NWAVES + wave, NGW = G * NWAVES;
    int slv[2]; v2u xw[2][4];
#define PF_FETCH(mm) do { _Pragma("unroll") for (int r = 0; r < 2; ++r) { slv[r] = slot[(size_t)((mm) + r) * NE + (lane & 15)]; const GAS v2u* xr_ = (const GAS v2u*)(X1B + (size_t)((mm) + r) * D) + lane; \
        _Pragma("unroll") for (int j = 0; j < 4; ++j) xw[r][j] = xr_[64 * j]; } } while (0)
    int m0 = gw * 2;
    if (m0 < M) PF_FETCH(m0);
    for (; m0 < M; m0 += NGW * 2) { const int b = m0 >> 13;
        int cs[2]; f32x4 v[2][4], a[2][4];
#pragma unroll
        for (int r = 0; r < 2; ++r) { cs[r] = slv[r];
#pragma unroll
            for (int j = 0; j < 4; ++j) { const v2u w = xw[r][j]; v[r][j] = (f32x4){bf_lo(w.x), bf_hi(w.x), bf_lo(w.y), bf_hi(w.y)}; a[r][j] = (f32x4){0.f, 0.f, 0.f, 0.f}; } }
        const int mn = m0 + NGW * 2;
        if (mn < M) PF_FETCH(mn);
        unsigned long long mask[2]; bool more = false;
#pragma unroll
        for (int r = 0; r < 2; ++r) mask[r] = __ballot(cs[r] >= 0) & 0xFFFFull;
        do { const GAS v2u* yp[2][4]; bool ok[2][4]; v2u w[2][4][4];
#pragma unroll
            for (int r = 0; r < 2; ++r)
#pragma unroll
                for (int c = 0; c < 4; ++c) { ok[r][c] = (mask[r] != 0ull); const int e = ok[r][c] ? (int)__builtin_ctzll(mask[r]) : 0; mask[r] &= (mask[r] - 1ull);
                    const int sl = __builtin_amdgcn_readlane(cs[r], e); yp[r][c] = (const GAS v2u*)(Y + ((size_t)(e * 2 + b) * CAP + (ok[r][c] ? sl : 0)) * D) + lane; }
#pragma unroll
            for (int r = 0; r < 2; ++r)
#pragma unroll
                for (int c = 0; c < 4; ++c) if (ok[r][c]) {
#pragma unroll
                    for (int j = 0; j < 4; ++j) w[r][c][j] = yp[r][c][64 * j]; }
#pragma unroll
            for (int r = 0; r < 2; ++r)
#pragma unroll
                for (int c = 0; c < 4; ++c) if (ok[r][c]) {
#pragma unroll
                    for (int j = 0; j < 4; ++j) { a[r][j].x += bf_lo(w[r][c][j].x); a[r][j].y += bf_hi(w[r][c][j].x); a[r][j].z += bf_lo(w[r][c][j].y); a[r][j].w += bf_hi(w[r][c][j].y); } }
            more = (mask[0] | mask[1]) != 0ull;
        } while (more);
        float s[2];
#pragma unroll
        for (int r = 0; r < 2; ++r) { s[r] = 0.f;
#pragma unroll
            for (int j = 0; j < 4; ++j) { const f32x4 gf = *(const GAS f32x4*)(mod + b * 6 * D + 5 * D + 4 * lane + 256 * j); v[r][j] = v[r][j] + gf * a[r][j]; s[r] += (v[r][j].x * v[r][j].x + v[r][j].y * v[r][j].y) + (v[r][j].z * v[r][j].z + v[r][j].w * v[r][j].w); } }
#pragma unroll
        for (int o = 1; o < 64; o <<= 1) { s[0] += __shfl_xor(s[0], o); s[1] += __shfl_xor(s[1], o); }
#pragma unroll
        for (int r = 0; r < 2; ++r) { const float rr = rsqrtf(s[r] * (1.f / D) + RMS_EPS); GAS f32x4* xo = (GAS f32x4*)(out + (size_t)(m0 + r) * D) + lane;
#pragma unroll
            for (int j = 0; j < 4; ++j) { const f32x4 gg = *(const GAS f32x4*)(g_fin + 4 * lane + 256 * j); xo[64 * j] = v[r][j] * rr * gg + pert; } } }
#undef PF_FETCH
}
__device__ __forceinline__ void fft_item(LAS unsigned char* lds, const bf16* UF, bf16* ZF, const bf16* Fc1, const bf16* Fc2, int item, int wave, int lane) {
    const char* slab = (const char*)UF + (size_t)item * 65536;
    { v4u xv[8];
#pragma unroll
      for (int p = 0; p < 8; ++p) { const int s1 = 8 * p + wave; xv[p] = *(const GAS v4u*)(slab + s1 * 1024 + ((16 * lane - 32 * ((s1 >> 3) & 3)) & 1023)); }
#pragma unroll
      for (int p = 0; p < 8; ++p) *(LAS v4u*)(lds + (8 * p + wave) * 1024 + 16 * lane) = xv[p]; }
    bf16x8 A2[2][8];
#pragma unroll
    for (int ro = 0; ro < 2; ++ro)
#pragma unroll
        for (int kk = 0; kk < 8; ++kk) A2[ro][kk] = *(const GAS bf16x8*)(Fc2 + ((size_t)(((wave * 2 + ro) * 8 + kk) * 64 + lane)) * 8);
    LDS_WAIT(); __syncthreads();
    const int fr = lane & 15, fq = lane >> 4, ch = lane & 3, s2l = (lane & 15) >> 2;
    char* zb = (char*)ZF + (size_t)item * 131072;
    for (int hh = 0; hh < 2; ++hh) {
        { bf16x8 A1[4][2];
#pragma unroll
          for (int mt = 0; mt < 4; ++mt)
#pragma unroll
              for (int kk = 0; kk < 2; ++kk) A1[mt][kk] = *(const GAS bf16x8*)(Fc1 + ((size_t)(((hh * 4 + mt) * 2 + kk) * 64 + lane)) * 8);
          for (int jn = 0; jn < 4; ++jn) { const int nt = wave + 8 * jn, s2 = 4 * nt + s2l;
            bf16x8 Bx[2];
#pragma unroll
            for (int kk = 0; kk < 2; ++kk)
#pragma unroll
                for (int j = 0; j < 8; ++j) { const int s1 = 32 * kk + 8 * fq + j; Bx[kk][j] = *(const LAS short*)(lds + s1 * 1024 + ((s2 * 8 + ch * 2 + 32 * fq) & 1023)); }
            f32x4 acc[4];
#pragma unroll
            for (int mt = 0; mt < 4; ++mt) { acc[mt] = (f32x4){0.f, 0.f, 0.f, 0.f};
#pragma unroll
                for (int kk = 0; kk < 2; ++kk) acc[mt] = __builtin_amdgcn_mfma_f32_16x16x32_bf16(A1[mt][kk], Bx[kk], acc[mt], 0, 0, 0); }
#pragma unroll
            for (int blk = 0; blk < 2; ++blk)
#pragma unroll
                for (int r = 0; r < 4; ++r) { const int k1l = 16 * blk + 4 * r + fq, k1 = 32 * hh + k1l; const float dr = acc[blk][r], di = acc[2 + blk][r];
                    const float frac = (float)((s2 * k1) & 8191) * (1.0f / 8192.0f), c = __builtin_amdgcn_cosf(frac), s = __builtin_amdgcn_sinf(frac);
                    *(LAS unsigned*)(lds + FFT_TOFF + (k1l * 4 + ch) * FFT_TPITCH + s2 * 4) = cvt_pk_bf16(dr * c + di * s, di * c - dr * s); } } }
        LDS_WAIT(); __syncthreads();
        for (int nt2 = 0; nt2 < 8; ++nt2) { f32x4 c0 = {0.f, 0.f, 0.f, 0.f}, c1 = {0.f, 0.f, 0.f, 0.f};
#pragma unroll
            for (int kk = 0; kk < 8; ++kk) { const bf16x8 Bt = *(const LAS bf16x8*)(lds + FFT_TOFF + (16 * nt2 + fr) * FFT_TPITCH + kk * 64 + fq * 16);
                c0 = __builtin_amdgcn_mfma_f32_16x16x32_bf16(A2[0][kk], Bt, c0, 0, 0, 0); c1 = __builtin_amdgcn_mfma_f32_16x16x32_bf16(A2[1][kk], Bt, c1, 0, 0, 0); }
            const int k1 = 32 * hh + 4 * nt2 + s2l;
#pragma unroll
            for (int r = 0; r < 4; ++r) { const int k = k1 + 64 * (16 * wave + 4 * fq + r); *(GAS unsigned*)(zb + (size_t)k * 16 + ch * 4) = cvt_pk_bf16(c0[r], c1[r]); } }
        LDS_WAIT(); __syncthreads();
    }
}
#if MOE_FP8
#define EXPERT_ITEM(r_) do { const int e_ = (r_) / 3072, q_ = (r_) % 3072; \
    if (q_ < 1024) transpose_item8<2>(w_g + (size_t)e_ * D * DE, D, DE, WGU8 + (size_t)e_ * 4096 * D, scr, q_, lane); \
    else if (q_ < 2048) transpose_item8<3>(w_u + (size_t)e_ * D * DE, D, DE, WGU8 + (size_t)e_ * 4096 * D, scr, q_ - 1024, lane); \
    else transpose_item8<0>(w_d + (size_t)e_ * DE * D, DE, D, WD8 + (size_t)e_ * D * DE, scr, q_ - 2048, lane); } while (0)
#else
#define EXPERT_ITEM(r_) do { const int e_ = (r_) / 3072, q_ = (r_) % 3072; \
    if (q_ < 1024) transpose_item<2>(w_g + (size_t)e_ * D * DE, D, DE, WGU + (size_t)e_ * 4096 * D, scr, q_, lane); \
    else if (q_ < 2048) transpose_item<3>(w_u + (size_t)e_ * D * DE, D, DE, WGU + (size_t)e_ * 4096 * D, scr, q_ - 1024, lane); \
    else transpose_item<0>(w_d + (size_t)e_ * DE * D, DE, D, WD + (size_t)e_ * D * DE, scr, q_ - 2048, lane); } while (0)
#endif
#ifndef EXP_P2
#define EXP_P2 10240
#endif
#ifndef EXP_P7
#define EXP_P7 14336
#endif
#ifndef EXP_P6
#define EXP_P6 16384
#endif
constexpr int EXP_TOTAL = NE * 3072, EXP_P0 = EXP_TOTAL - EXP_P2 - EXP_P7 - EXP_P6;

constexpr int NPHASE = 12;
#ifndef MOE_ALIGN
#define MOE_ALIGN true
#endif
#ifndef EXTRA_BARS
#define EXTRA_BARS 0
#endif
#ifndef STAGGER_US
#define STAGGER_US 0
#endif
#ifndef DOUBLE_PH
#define DOUBLE_PH -1
#endif
#define REP(k) for (int rep_ = 0; rep_ < ((DOUBLE_PH == (k)) ? 2 : 1); ++rep_)
#define REPBAR(k) do { if (DOUBLE_PH == (k) && rep_ == 0) xcd_barrier(bar); } while (0)
#ifndef PROBE_I
#define PROBE_I -1
#endif
#ifndef PROBE_J
#define PROBE_J -1
#endif
#ifndef DBG_PLAIN
#define DBG_PLAIN 0
#endif
#ifndef GALIGN
#define GALIGN true
#endif
#ifndef GSP2
#define GSP2 true
#endif
struct Args { const float* in[18]; float* out; unsigned char* ws; int ph_lo, ph_hi; };
__global__ void __launch_bounds__(NWAVES * 64, 2) fwd(Args args) {
    extern __shared__ __attribute__((aligned(16))) unsigned char lds_raw[];
    LAS unsigned char* lds = (LAS unsigned char*)lds_raw;
    volatile LAS unsigned* MISC = (volatile LAS unsigned*)(lds + MISC_OFF);
    const int tid = threadIdx.x, lane = tid & 63, wave = __builtin_amdgcn_readfirstlane(tid >> 6);
    const int G = gridDim.x; const int bx = blockIdx.x; const int vcu = (G % 8 == 0) ? (bx % 8) * (G / 8) + bx / 8 : bx;
    unsigned char* ws = args.ws;
    const float *x = args.in[0], *c = args.in[1], *w_ada = args.in[2], *b_ada = args.in[3], *g_mix = args.in[4], *w_in = args.in[5], *b_gate = args.in[6], *w_f = args.in[7], *w_conv = args.in[8],
                *w_co = args.in[9], *w_o = args.in[10], *g_moe = args.in[11], *w_r = args.in[12], *b_r = args.in[13], *w_g = args.in[14], *w_u = args.in[15], *w_d = args.in[16], *g_fin = args.in[17];
    float* out = args.out;
    float *modp = (float*)(ws + WS_MODP), *mod = (float*)(ws + WS_MOD), *probs = (float*)(ws + WS_PROBS), *val = (float*)(ws + WS_VAL);
    int *slot = (int*)(ws + WS_SLOT), *idx = (int*)(ws + WS_IDX);
    bf16 *Fc1 = (bf16*)(ws + WS_FC1), *Fc2 = (bf16*)(ws + WS_FC2), *WIN = (bf16*)(ws + WS_WIN), *WF = (bf16*)(ws + WS_WF), *WCO = (bf16*)(ws + WS_WCO), *WO = (bf16*)(ws + WS_WO), *WGU = (bf16*)(ws + WS_WGU), *WD = (bf16*)(ws + WS_WD);
    bf16 *H1 = (bf16*)(ws + WS_H1), *AB = (bf16*)(ws + WS_AB), *UF = (bf16*)(ws + WS_UF), *CV = (bf16*)(ws + WS_CV), *BG = (bf16*)(ws + WS_BG), *GA = (bf16*)(ws + WS_GA), *GB = (bf16*)(ws + WS_GB), *ZF = (bf16*)(ws + WS_ZF),
         *TZ = (bf16*)(ws + WS_TZ), *H2 = (bf16*)(ws + WS_H2), *HM = (bf16*)(ws + WS_HM), *Y = (bf16*)(ws + WS_Y), *X1B = (bf16*)(ws + WS_X1B);
    unsigned char *WGU8 = ws + WS_WGU, *WD8 = ws + WS_WD, *H2F8 = ws + WS_H2, *HM8 = ws + WS_HM;
    for (int u = tid; u < (LDS_BYTES - MISC_OFF) / 4; u += NWAVES * 64) ((LAS unsigned*)(lds + MISC_OFF))[u] = 0u;
    __syncthreads();
    const int lo = args.ph_lo, hi = args.ph_hi;
    XcdBarrier bar; bar.bar = (unsigned*)(ws + WS_CTL) + CW_BAR; bar.x = 0; bar.st = nullptr;
    if (hi - lo > 1) bar = xcd_barrier_post((unsigned*)(ws + WS_CTL) + CW_BAR, MISC + 8);
#define IN(k) (lo <= (k) && (k) < hi)
#if PROBE_I >= 0
    unsigned long long* tsb = (unsigned long long*)(ws + WS_CTL + 512 * 1024);
    if (bx == 0 && tid == 0) tsb[0] = __builtin_amdgcn_s_memrealtime();
#define GRID_BAR(k) do { if (IN(k) && IN((k) + 1)) xcd_barrier(bar); if (bx == 0 && tid == 0) tsb[(k) + 1] = __builtin_amdgcn_s_memrealtime(); } while (0)
#else
#define GRID_BAR(k) do { if (IN(k) && IN((k) + 1)) xcd_barrier(bar); } while (0)
#endif
    const int gw = vcu * NWAVES + wave, NGW = G * NWAVES;
    LAS float* scr = (LAS float*)(lds + wave * 16384);

    if (IN(0)) REP(0) {
        if (vcu < 96) mod_item(c, w_ada, modp, lds, vcu, tid, wave, lane);
#if PROBE_I >= 0
        if (bx == 0 && tid == 0) tsb[22] = __builtin_amdgcn_s_memrealtime();
#endif
        fc_tables(Fc1, Fc2, vcu * NWAVES * 64 + tid, G * NWAVES * 64);
#if PROBE_I >= 0
        if (bx == 0 && tid == 0) tsb[23] = __builtin_amdgcn_s_memrealtime();
#endif
        constexpr int I_WF = 2048, I_IN = 16 * 176, I_SQ = 16 * 32, I_EX = 3072, NITEMS = I_WF + I_IN + 2 * I_SQ + NE * I_EX;
        if (vcu >= 96) { const int w0 = (vcu - 96) * NWAVES + wave, nw0 = (G - 96) * NWAVES;
            for (int r = w0; r < I_WF; r += nw0) wf_item(w_f, WF, r, lane); }
        for (int it = I_WF + gw; it < NITEMS; it += NGW) {
            int r = it - I_WF;
            if (r < I_IN) { transpose_item<1>(w_in, D, DIN, WIN, scr, r, lane); continue; } r -= I_IN;
            if (r < I_SQ) { transpose_item<0>(w_co, D, D, WCO, scr, r, lane); continue; } r -= I_SQ;
            if (r < I_SQ) { transpose_item<0>(w_o, D, D, WO, scr, r, lane); continue; } r -= I_SQ;
            if (r >= EXP_P0) continue;
            EXPERT_ITEM(r);
        }
#if PROBE_I >= 0
        asm volatile("s_waitcnt vmcnt(0)" ::: "memory"); __syncthreads(); if (bx == 0 && tid == 0) tsb[24] = __builtin_amdgcn_s_memrealtime();
#endif
        GRID_BAR(0);
    }
    if (IN(1)) REP(1) { phase_h(x, g_mix, b_ada, modp, mod, H1, lds, tid, wave, lane, vcu, G); GRID_BAR(1); }
#if EXTRA_BARS > 0
    if (IN(1) && IN(2)) { for (int eb = 0; eb < EXTRA_BARS; ++eb) xcd_barrier(bar); }
#endif
    if (IN(2)) REP(2) {
#if STAGGER_US > 0
        if (bx >= 128) { const unsigned long long t0 = __builtin_amdgcn_s_memrealtime(); while (__builtin_amdgcn_s_memrealtime() - t0 < (unsigned long long)(STAGGER_US * 100)) __builtin_amdgcn_s_sleep(8); }
#endif
        pg8::Gemm g{H1, WIN, M, DIN, D, 0, 0, nullptr}; pg8::StaticOrder S; S.init(M, DIN, G, bx);
#if DBG_PLAIN
        EpiPlain E{UF, DIN};
        pg8::gemm_phase<EpiPlain, pg8::StaticOrder, 0, GALIGN, GSP2>(lds, g, S, E);
#else
        EpiInProj E{UF, CV, BG, GA, GB, b_gate};
        pg8::gemm_phase<EpiInProj, pg8::StaticOrder, 0, GALIGN, GSP2>(lds, g, S, E);
#endif
        if (bx >= G / 2) { const int w2 = (bx - G / 2) * NWAVES + wave, nw2 = (G - G / 2) * NWAVES;
            for (int r = EXP_P0 + EXP_P6 + w2; r < EXP_P0 + EXP_P6 + EXP_P2; r += nw2) EXPERT_ITEM(r); }
        GRID_BAR(2);
    }
    if (IN(3)) REP(3) {
        if (bx & 1) phase_conv(CV, BG, w_conv, AB, wave, lane, vcu, G);
        for (int it = vcu; it < BATCH * 128; it += G) fft_item(lds, UF, ZF, Fc1, Fc2, it, wave, lane);
#if PROBE_I >= 0
        __syncthreads(); if (bx == 0 && tid == 0) tsb[20] = __builtin_amdgcn_s_memrealtime();
#endif
        if (!(bx & 1)) phase_conv(CV, BG, w_conv, AB, wave, lane, vcu, G);
#if PROBE_I >= 0
        asm volatile("s_waitcnt vmcnt(0)" ::: "memory"); __syncthreads(); if (bx == 0 && tid == 0) tsb[21] = __builtin_amdgcn_s_memrealtime();
#endif
        GRID_BAR(3);
    }
    if (IN(4)) REP(4) {
        { pg8::Gemm g{ZF, WF, M, D, D, 0, 0, nullptr}; pg8::StaticOrder S; S.init(M, D, G, bx); EpiGateMul<0> E{TZ, GA};
          pg8::gemm_phase<EpiGateMul<0>, pg8::StaticOrder, 1, true, true>(lds, g, S, E); }
        { pg8::Gemm g{AB, WCO, M, D, D, 0, 0, nullptr}; pg8::StaticOrder S; S.init(M, D, G, bx); EpiGateMul<1> E{TZ, GB};
          pg8::gemm_phase<EpiGateMul<1>, pg8::StaticOrder, 0, true, true>(lds, g, S, E); }
        GRID_BAR(4);
    }
    if (IN(5)) REP(5) {
        pg8::Gemm g{TZ, WO, M, D, D, 0, 0, nullptr}; pg8::StaticOrder S; S.init(M, D, G, bx); EpiResid E{x, X1B, mod + 2 * D};
        pg8::gemm_phase<EpiResid, pg8::StaticOrder, 0, true, true>(lds, g, S, E);
        GRID_BAR(5);
    }
    if (IN(6)) REP(6) { phase_h2(X1B, g_moe, mod, w_r, b_r, H2, H2F8, probs, lds, tid, wave, lane, vcu, G);
        if (wave >= 4) { LAS float* scr6 = (LAS float*)(lds + 81920 + (wave - 4) * 8448);
            const int w6 = vcu * 4 + (wave - 4), nw6 = G * 4; LAS float* scr = scr6;
            for (int r = EXP_P0 + w6; r < EXP_P0 + EXP_P6; r += nw6) EXPERT_ITEM(r); }
        __syncthreads(); GRID_BAR(6); }
    if (IN(7)) REP(7) { for (int it = vcu; it < NE * BATCH; it += G) topk_item(probs, idx, val, slot, lds, it, tid, wave, lane);
        if (vcu >= NE * BATCH) { const int w7 = (vcu - NE * BATCH) * NWAVES + wave, nw7 = (G - NE * BATCH) * NWAVES;
            for (int r = EXP_P0 + EXP_P6 + EXP_P2 + w7; r < EXP_TOTAL; r += nw7) EXPERT_ITEM(r); }
        GRID_BAR(7); }
    if (IN(9)) REP(9) {
#if MOE_FP8
        pg8::Gemm g{(const bf16*)H2F8, (const bf16*)WGU8, MR, 2 * DE, D / 2, 8, (size_t)2 * DE * D / 2, idx}; pg8::StaticOrder S; S.init(MR, 2 * DE, G, bx); EpiSwiGLU8 E{HM8};
        pg8::gemm_phase<EpiSwiGLU8, pg8::StaticOrder, 2, MOE_ALIGN, true, true>(lds, g, S, E);
#else
        pg8::Gemm g{H2, WGU, MR, 2 * DE, D, 8, (size_t)2 * DE * D, idx}; pg8::StaticOrder S; S.init(MR, 2 * DE, G, bx); EpiSwiGLU E{HM};
        pg8::gemm_phase<EpiSwiGLU, pg8::StaticOrder, 2, true, true>(lds, g, S, E);
#endif
        GRID_BAR(9);
    }
    if (IN(10)) REP(10) {
#if MOE_FP8
        pg8::Gemm g{(const bf16*)HM8, (const bf16*)WD8, MR, D, DE / 2, 8, (size_t)D * DE / 2, nullptr}; pg8::StaticOrder S; S.init(MR, D, G, bx); EpiRowScale E{Y, val};
        pg8::gemm_phase<EpiRowScale, pg8::StaticOrder, 0, MOE_ALIGN, true, true>(lds, g, S, E);
#else
        pg8::Gemm g{HM, WD, MR, D, DE, 8, (size_t)D * DE, nullptr}; pg8::StaticOrder S; S.init(MR, D, G, bx); EpiRowScale E{Y, val};
        pg8::gemm_phase<EpiRowScale, pg8::StaticOrder, 0, true, true>(lds, g, S, E);
#endif
#if PROBE_I >= 0
        if (bx == 0 && tid == 0) tsb[12] = __builtin_amdgcn_s_memrealtime();
#endif
        GRID_BAR(10);
    }
#if PROBE_I >= 0
    float pert = 0.f;
    if (IN(11)) { const unsigned long long a0 = __hip_atomic_load(tsb + (PROBE_I == 100 ? 0 : PROBE_I == 9 ? 8 : PROBE_I), __ATOMIC_RELAXED, __HIP_MEMORY_SCOPE_AGENT), a1 = __hip_atomic_load(tsb + (PROBE_I == 100 ? 12 : PROBE_I == 10 ? 12 : PROBE_I + 1), __ATOMIC_RELAXED, __HIP_MEMORY_SCOPE_AGENT); pert = (float)(a1 - a0) * 0.01f * (PROBE_I == 100 ? (1.0f / 64000.0f) : (1.0f / 16000.0f)); }
    if (PROBE_I == 102) { pert = 0.f; if (bx == 0 && tid == 0) tsb[14] = __builtin_amdgcn_s_memrealtime(); __syncthreads(); }
    if (PROBE_I >= 310 && PROBE_I <= 313) { pert = 0.f; if (bx == 0) { const int ia = (PROBE_I == 310 ? 0 : PROBE_I == 311 ? 22 : PROBE_I == 312 ? 23 : 24), ib = (PROBE_I == 310 ? 22 : PROBE_I == 311 ? 23 : PROBE_I == 312 ? 24 : 1);
        const unsigned long long a0 = __hip_atomic_load(tsb + ia, __ATOMIC_RELAXED, __HIP_MEMORY_SCOPE_AGENT), a1 = __hip_atomic_load(tsb + ib, __ATOMIC_RELAXED, __HIP_MEMORY_SCOPE_AGENT); pert = (float)(a1 - a0) * 0.01f * (1.0f / 250.0f); } }
    else if (PROBE_I == 300 || PROBE_I == 301 || PROBE_I == 302) { pert = 0.f; if (bx == 0) { const unsigned long long a0 = __hip_atomic_load(tsb + (PROBE_I == 300 ? 3 : PROBE_I == 301 ? 20 : 21), __ATOMIC_RELAXED, __HIP_MEMORY_SCOPE_AGENT), a1 = __hip_atomic_load(tsb + (PROBE_I == 300 ? 20 : PROBE_I == 301 ? 21 : 4), __ATOMIC_RELAXED, __HIP_MEMORY_SCOPE_AGENT); pert = (float)(a1 - a0) * 0.01f * (1.0f / 250.0f); } }
    else if (PROBE_I >= 200) { pert = 0.f; if (bx == 0) { const int k_ = PROBE_I - 200; const unsigned long long a0 = __hip_atomic_load(tsb + (k_ == 9 ? 8 : k_), __ATOMIC_RELAXED, __HIP_MEMORY_SCOPE_AGENT), a1 = __hip_atomic_load(tsb + k_ + 1, __ATOMIC_RELAXED, __HIP_MEMORY_SCOPE_AGENT); pert = (float)(a1 - a0) * 0.01f * (1.0f / 250.0f); } }
    if (PROBE_I == 101) { pert = 0.f; if (bx == 0) { const unsigned long long a0 = __hip_atomic_load(tsb + 12, __ATOMIC_RELAXED, __HIP_MEMORY_SCOPE_AGENT); pert = (float)(__builtin_amdgcn_s_memrealtime() - a0) * 0.01f * (1.0f / 250.0f); } }
    if (IN(11)) phase_final(out, X1B, Y, slot, mod, g_fin, wave, lane, vcu, G, pert);
    if (PROBE_I == 102) {
        const unsigned long long t_a = tsb[14];
        xcd_barrier(bar);
        if (bx == 0) { const float pp = (float)(__builtin_amdgcn_s_memrealtime() - t_a) * 0.01f * (1.0f / 250.0f);
            for (int k = 0; k < 4; ++k) for (int r = 0; r < 2; ++r) { float* row = out + (size_t)(2 * (vcu * NWAVES + wave) + r + 4096 * k) * D; for (int cc = lane; cc < D; cc += 64) row[cc] += pp; } } }
#else
    if (IN(11)) REP(11) { phase_final(out, X1B, Y, slot, mod, g_fin, wave, lane, vcu, G, 0.f); if (DOUBLE_PH == 11 && rep_ == 0) xcd_barrier(bar); }
#endif

#undef IN
#undef GRID_BAR
}


struct DumpArgs { const unsigned short* p[8]; unsigned long long n[8]; int f32[8]; int nb; int pad; };
__global__ void k_dump(float* out, DumpArgs a) {
    const size_t i = (size_t)blockIdx.x * blockDim.x + threadIdx.x; float s = 0.f;
    for (int b = 0; b < a.nb; ++b) for (size_t j = i; j < a.n[b]; j += (size_t)M * D) s += (a.f32[b] ? ((const float*)a.p[b])[j] : __uint_as_float(((unsigned)a.p[b][j]) << 16)) * (float)(b + 1);
    out[i] = s;
}
#ifndef DUMP_WHICH
#define DUMP_WHICH -1
#endif
#ifndef STOP_AFTER
#define STOP_AFTER (NPHASE - 1)
#endif
#ifndef MK_PER_PHASE
#define MK_PER_PHASE 0
#endif
extern "C" void kernel_launch(void* const* d_in, const int* in_sizes, int n_in, void* d_out, int out_size, void* d_ws, size_t ws_size, hipStream_t stream) {
    static int grid = 0;
    if (grid == 0) {
        if (n_in != 18 || in_sizes[0] != M * D || out_size != M * D || ws_size < WS_END) { fprintf(stderr, "kernel_launch: unexpected shapes (n_in %d, in0 %d, out %d, ws %zu); nothing launched\n", n_in, n_in > 0 ? in_sizes[0] : -1, out_size, ws_size); grid = -1; return; }
        int dev = 0, cus = 0, per_cu = 0;
        if (hipGetDevice(&dev) != hipSuccess || hipDeviceGetAttribute(&cus, hipDeviceAttributeMultiprocessorCount, dev) != hipSuccess) { grid = -1; return; }
        if (hipFuncSetAttribute((const void*)fwd, hipFuncAttributeMaxDynamicSharedMemorySize, LDS_BYTES) != hipSuccess) { fprintf(stderr, "kernel_launch: hipFuncSetAttribute failed\n"); grid = -1; return; }
        if (hipOccupancyMaxActiveBlocksPerMultiprocessor(&per_cu, (const void*)fwd, NWAVES * 64, LDS_BYTES) != hipSuccess || per_cu < 1) { fprintf(stderr, "kernel_launch: occupancy query reports %d blocks per CU\n", per_cu); }
        (void)hipGetLastError();
        grid = cus;
    }
    if (grid < 0) return;
    (void)hipMemsetAsync((char*)d_ws + WS_CTL, 0, CTL_ZERO_BYTES, stream);
    Args a{};
    for (int i = 0; i < 18; ++i) a.in[i] = (const float*)d_in[i];
    a.out = (float*)d_out; a.ws = (unsigned char*)d_ws;
#if MK_PER_PHASE
    for (int p = 0; p < STOP_AFTER + 1; ++p) { a.ph_lo = p; a.ph_hi = p + 1; hipLaunchKernelGGL(fwd, dim3(grid), dim3(NWAVES * 64), LDS_BYTES, stream, a); }
#if DUMP_WHICH >= 0
    { DumpArgs da{}; unsigned char* w = (unsigned char*)d_ws; int nb = 0;
      auto add = [&](size_t off, size_t n, int isf = 0) { da.p[nb] = (const unsigned short*)(w + off); da.n[nb] = n; da.f32[nb] = isf; ++nb; };
      if (DUMP_WHICH == 0) { add(WS_WIN, (size_t)DIN * D); add(WS_WF, (size_t)D * D); add(WS_WCO, (size_t)D * D); add(WS_WO, (size_t)D * D); add(WS_WGU, (size_t)NE * 4096 * D); add(WS_WD, (size_t)NE * D * DE); add(WS_FC1, 8192 + 0); add(WS_MODP, 4 * 2 * 6 * D, 1); }
      if (DUMP_WHICH == 1) { add(WS_H1, (size_t)M * D); add(WS_MOD, 2 * 6 * D, 1); add(WS_FC2, 65536); }
      if (DUMP_WHICH == 2) { add(WS_UF, (size_t)M * DF); add(WS_CV, (size_t)M * D); add(WS_BG, (size_t)M * D); add(WS_GA, (size_t)M * D); add(WS_GB, (size_t)M * D); }
      if (DUMP_WHICH == 5) { add(WS_UF, (size_t)M * DIN); }
      if (DUMP_WHICH == 6) { add(WS_UF, (size_t)M * DF); add(WS_CV, (size_t)M * D); }
      if (DUMP_WHICH == 7) { add(WS_BG, (size_t)M * D); }
      if (DUMP_WHICH == 8) { add(WS_GA, (size_t)M * D); add(WS_GB, (size_t)M * D); }
      if (DUMP_WHICH == 9) { add(WS_GA, (size_t)M * D); }
      if (DUMP_WHICH == 10) { add(WS_GB, (size_t)M * D); }
      if (DUMP_WHICH == 3) { add(WS_ZF, (size_t)M * D); add(WS_AB, (size_t)M * D); }
      if (DUMP_WHICH == 4) { add(WS_TZ, (size_t)M * D); }
      da.nb = nb; hipLaunchKernelGGL(k_dump, dim3(M * D / 256), dim3(256), 0, stream, (float*)d_out, da); }
#endif
#else
    a.ph_lo = 0; a.ph_hi = NPHASE; hipLaunchKernelGGL(fwd, dim3(grid), dim3(NWAVES * 64), LDS_BYTES, stream, a);
#endif
}
```

```cpp
#include <hip/hip_runtime.h>
#include <cstdio>
#include <cstdint>
#define MK_PER_PHASE 0
#define STOP_AFTER 11
#define DUMP_WHICH -1
#define GALIGN true
#define GSP2 true
#define DBG_PLAIN 0
#define DBG_NOBIAS 0
#define DBG_NOSIG 0
#define PROBE_I -1
#define PROBE_J -1
#define DOUBLE_PH -1
#define STAGGER_US 0
#define EXTRA_BARS 0
#define DBG_EPI2 0
#ifndef DBG_EPI2
#define DBG_EPI2 0
#endif
namespace pg8 {
#define PG8_LAS __attribute__((address_space(3)))
typedef unsigned short bf16_t;
typedef short bf16x8 __attribute__((ext_vector_type(8)));
typedef float f32x4 __attribute__((ext_vector_type(4)));
typedef unsigned u32x4 __attribute__((ext_vector_type(4)));
typedef unsigned u32x2 __attribute__((ext_vector_type(2)));
typedef int v8i __attribute__((ext_vector_type(8)));
typedef int v4i __attribute__((ext_vector_type(4)));
constexpr int BM = 256, BK = 64, HALF = 128, HTB = HALF * BK * 2  , STAGE_BYTES = 8 * HTB, NXCD = 8, WGM = 8;

__host__ __device__ __forceinline__ int lds_byte(int r, int c) { const int st = (r >> 4) * 2 + (c >> 5), rr = r & 15, cc = c & 31, ob = rr * 64 + cc * 2; return st * 1024 + (ob ^ (((ob >> 9) & 1) << 5)); }
__host__ __device__ __forceinline__ void stage_rc(int b, int& R, int& C) { const int st = b / 1024, sb = b % 1024, swz = sb ^ (((sb >> 9) & 1) << 5); R = (st >> 1) * 16 + swz / 64; C = (st & 1) * 32 + (swz % 64) / 2; }
__host__ __device__ __forceinline__ int perm32(int rho) { const int n = rho >> 4, i = rho & 15; return 8 * (i >> 2) + 4 * n + (i & 3); }

struct Unit { int pm, pn; };
struct Gemm { const bf16_t* A; const bf16_t* Bt; int M, N, K; int bgrp; size_t bstride; const int* gidx; };

struct StaticOrder {
    int nM, nN, nwg, G, c;
    __host__ __device__ void init(int M, int N, int G_, int c_) { nM = M / BM; nN = N / BM; nwg = nM * nN; G = G_; c = c_; }
    __host__ __device__ bool next(int i, Unit& u) const {
        const long L = (long)i * G + c; if (L >= nwg) return false;
        int wgid = (int)L; { const int q = nwg / NXCD, r = nwg % NXCD, xcd = wgid % NXCD, off = wgid / NXCD; wgid = (xcd < r ? xcd * (q + 1) : r * (q + 1) + (xcd - r) * q) + off; }
        const int nig = WGM * nN, gid = wgid / nig, fm = gid * WGM, gsz = (nM - fm) < WGM ? (nM - fm) : WGM;
        u.pm = fm + ((wgid % nig) % gsz); u.pn = (wgid % nig) / gsz; return true;
    }
    __device__ __forceinline__ void a_ready(const Unit&) const {}
    __device__ __forceinline__ void done(const Unit&) const {}
};

typedef __bf16 bf16x2_t __attribute__((ext_vector_type(2)));
typedef float f32x2_t __attribute__((ext_vector_type(2)));
__device__ __forceinline__ unsigned cvt_pk_bf16(float lo, float hi) { const f32x2_t v = {lo, hi}; const bf16x2_t b = __builtin_convertvector(v, bf16x2_t); return __builtin_bit_cast(unsigned, b); }
__device__ __forceinline__ float bf_lo(unsigned w) { return __uint_as_float(w << 16); }
__device__ __forceinline__ float bf_hi(unsigned w) { return __uint_as_float(w & 0xffff0000u); }
__device__ __forceinline__ float sigm(float v) { return __builtin_amdgcn_rcpf(1.0f + __expf(-v)); }


template <class Epi, class Sched, int AMODE, bool ALIGN_EPI, bool SP2, bool F8 = false>
__device__ __forceinline__ void gemm_phase(PG8_LAS unsigned char* lds, const Gemm g, const Sched& S, const Epi& E) {
    const int tid = threadIdx.x, wid = __builtin_amdgcn_readfirstlane(tid >> 6), lane = tid & 63, wr = wid >> 2, wc = wid & 3, fr = lane & 15, fq = lane >> 4;
    const int K = g.K, nt = K / BK;
    unsigned voffA0[2], voffA1[2], voffB[2]; int gR[2], gC2[2];
#pragma unroll
    for (int i = 0; i < 2; ++i) { int R, C; stage_rc(tid * 16 + i * 8192, R, C); const int Rb = Epi::PERM ? ((R & ~31) + perm32(R & 31)) : R;
        voffB[i] = (unsigned)(Rb * K + C) * 2u; gR[i] = R; gC2[i] = C * 2;
        if (AMODE == 0) { voffA0[i] = (unsigned)(R * K + C) * 2u; voffA1[i] = (unsigned)((R + HALF) * K + C) * 2u; }
        else if (AMODE == 1) { voffA0[i] = (unsigned)((C >> 3) * 8192 + R) * 16u; voffA1[i] = voffA0[i] + (unsigned)HALF * 16u; }
        else { voffA0[i] = 0u; voffA1[i] = 0u; } }
    const size_t kstepB = (size_t)(BK * 2);
    const size_t kstepA = (AMODE == 1) ? (size_t)8 * 8192 * 16 : (size_t)(BK * 2);
    int nidx0[2] = {0, 0}, nidx1[2] = {0, 0}; unsigned voffN0[2] = {0u, 0u}, voffN1[2] = {0u, 0u};
#define PG8_GIDX_LOAD(u) do { if (AMODE == 2) { _Pragma("unroll") for (int _i = 0; _i < 2; ++_i) { \
        const int* _p0 = g.gidx + (size_t)(u).pm * BM + gR[_i]; const int* _p1 = _p0 + HALF; \
        asm volatile("global_load_dword %0, %1, off" : "=v"(nidx0[_i]) : "v"(_p0) : "memory"); asm volatile("global_load_dword %0, %1, off" : "=v"(nidx1[_i]) : "v"(_p1) : "memory"); } } } while (0)
#define PG8_GIDX_USE() do { if (AMODE == 2) { _Pragma("unroll") for (int _i = 0; _i < 2; ++_i) { asm volatile("" : "+v"(nidx0[_i]), "+v"(nidx1[_i])); \
        voffN0[_i] = (unsigned)nidx0[_i] * (unsigned)(K * 2) + (unsigned)gC2[_i]; voffN1[_i] = (unsigned)nidx1[_i] * (unsigned)(K * 2) + (unsigned)gC2[_i]; } } } while (0)
    const size_t hstepB = (size_t)HALF * K * 2;
    const size_t tstepB = 2 * hstepB;
    const unsigned ldsw = (unsigned)wid * 1024u;
    const int aoff = lds_byte(wr * 64 + fr, fq * 8), boff = lds_byte(wc * 32 + fr, fq * 8);
    const int aoff8a = lds_byte(wr * 64 + fr, fq * 16), boff8a = lds_byte(wc * 32 + fr, fq * 16);
#define PG8_ABASE(u) ((const char*)g.A + ((AMODE == 2) ? (size_t)0 : (AMODE == 0) ? (size_t)(u).pm * (size_t)BM * K * 2 : (size_t)((u).pm >> 5) * ((size_t)(K >> 3) * 8192 * 16) + (size_t)((u).pm & 31) * (BM * 16)))
#define PG8_BBASE(u) ((const char*)g.Bt + (g.bgrp ? (size_t)((u).pm / g.bgrp) * g.bstride * 2 : (size_t)0) + (size_t)(u).pn * tstepB)
#define PG8_SA(b, h) (((b) * 2 + (h)) * HTB)
#define PG8_SB(b, h) ((4 + (b) * 2 + (h)) * HTB)
#define PG8_STAGE(bufoff, gbase, voff) do { _Pragma("unroll") for (int _i = 0; _i < 2; ++_i) \
        __builtin_amdgcn_global_load_lds((const unsigned*)((const char*)(gbase) + (voff)[_i]), (PG8_LAS unsigned*)(lds + (bufoff) + ldsw + _i * 8192), 16, 0, 0); } while (0)
#define PG8_LDA16(dst, b, h) do { _Pragma("unroll") for (int m = 0; m < 4; ++m) _Pragma("unroll") for (int k = 0; k < 2; ++k) dst[m][k] = *(const PG8_LAS bf16x8*)(lds + PG8_SA(b, h) + aoff + m * 2048 + k * 1024); } while (0)
#define PG8_LDB16(dst, b, h) do { _Pragma("unroll") for (int n = 0; n < 2; ++n) _Pragma("unroll") for (int k = 0; k < 2; ++k) dst[n][k] = *(const PG8_LAS bf16x8*)(lds + PG8_SB(b, h) + boff + n * 2048 + k * 1024); } while (0)
#define PG8_MMA16(ai, bj, At, Bt) do { __builtin_amdgcn_s_setprio(1); _Pragma("unroll") for (int m = 0; m < 4; ++m) _Pragma("unroll") for (int n = 0; n < 2; ++n) _Pragma("unroll") for (int k = 0; k < 2; ++k) \
        acc[ai][bj][m][n] = __builtin_amdgcn_mfma_f32_16x16x32_bf16(Bt[n][k], At[m][k], acc[ai][bj][m][n], 0, 0, 0); __builtin_amdgcn_s_setprio(0); } while (0)
#define PG8_LDA8(dst, b, h) do { _Pragma("unroll") for (int m = 0; m < 4; ++m) { const v4i lo_ = *(const PG8_LAS v4i*)(lds + PG8_SA(b, h) + aoff8a + m * 2048), hi_ = *(const PG8_LAS v4i*)(lds + PG8_SA(b, h) + aoff8a + m * 2048 + 16); \
        dst[m] = (v8i){lo_.x, lo_.y, lo_.z, lo_.w, hi_.x, hi_.y, hi_.z, hi_.w}; } } while (0)
#define PG8_LDB8(dst, b, h) do { _Pragma("unroll") for (int n = 0; n < 2; ++n) { const v4i lo_ = *(const PG8_LAS v4i*)(lds + PG8_SB(b, h) + boff8a + n * 2048), hi_ = *(const PG8_LAS v4i*)(lds + PG8_SB(b, h) + boff8a + n * 2048 + 16); \
        dst[n] = (v8i){lo_.x, lo_.y, lo_.z, lo_.w, hi_.x, hi_.y, hi_.z, hi_.w}; } } while (0)
#define PG8_MMA8(ai, bj, At, Bt) do { __builtin_amdgcn_s_setprio(1); _Pragma("unroll") for (int m = 0; m < 4; ++m) _Pragma("unroll") for (int n = 0; n < 2; ++n) \
        asm volatile("v_mfma_scale_f32_16x16x128_f8f6f4 %0, %1, %2, %0, %3, %3 op_sel:[0,1,0] op_sel_hi:[0,0,0]" : "+v"(acc[ai][bj][m][n]) : "v"(Bt[n]), "v"(At[m]), "v"(f8scale)); __builtin_amdgcn_s_setprio(0); } while (0)
#define PG8_LDA(dst, b, h) do { if constexpr (F8) PG8_LDA8(dst##8, b, h); else PG8_LDA16(dst, b, h); } while (0)
#define PG8_LDB(dst, b, h) do { if constexpr (F8) PG8_LDB8(dst##8, b, h); else PG8_LDB16(dst, b, h); } while (0)
#define PG8_MMA(ai, bj, At, Bt) do { if constexpr (F8) PG8_MMA8(ai, bj, At##8, Bt##8); else PG8_MMA16(ai, bj, At, Bt); } while (0)
#define PG8_WAIT_V(n) asm volatile("s_waitcnt vmcnt(" #n ")" ::: "memory")
#define PG8_WAIT_L(n) asm volatile("s_waitcnt lgkmcnt(" #n ")" ::: "memory")
#define PG8_BAR __builtin_amdgcn_s_barrier()
#define PG8_SCHED __builtin_amdgcn_sched_barrier(0)
    Unit cur, nxt; int ui = 0;
    if (!S.next(0, cur)) return;
    f32x4 acc[2][2][4][2];
#pragma unroll
    for (int a = 0; a < 2; ++a)
#pragma unroll
        for (int b = 0; b < 2; ++b)
#pragma unroll
            for (int m = 0; m < 4; ++m)
#pragma unroll
                for (int n = 0; n < 2; ++n) acc[a][b][m][n] = (f32x4){0.f, 0.f, 0.f, 0.f};
    bf16x8 At[4][2], B0[2][2], B1[2][2]; v8i At8[4], B08[2], B18[2]; int f8scale = 0x7f7f7f78; asm volatile("" : "+v"(f8scale));
    const char* cA = PG8_ABASE(cur); const char* cB = PG8_BBASE(cur);
    S.a_ready(cur);
    if (AMODE == 2) { PG8_GIDX_LOAD(cur); asm volatile("s_waitcnt vmcnt(0)" ::: "memory"); PG8_GIDX_USE();
#pragma unroll
        for (int i = 0; i < 2; ++i) { voffA0[i] = voffN0[i]; voffA1[i] = voffN1[i]; } }
    if constexpr (SP2) {
        PG8_STAGE(PG8_SB(0, 0), cB, voffB); PG8_STAGE(PG8_SB(0, 1), cB + hstepB, voffB); PG8_STAGE(PG8_SA(0, 0), cA, voffA0); PG8_STAGE(PG8_SA(0, 1), cA, voffA1);
        if (wr == 1) PG8_BAR;
        PG8_WAIT_V(2); PG8_BAR;
        PG8_STAGE(PG8_SB(1, 0), cB + kstepB, voffB); PG8_STAGE(PG8_SA(1, 0), cA + kstepA, voffA0); PG8_STAGE(PG8_SB(1, 1), cB + hstepB + kstepB, voffB);
        PG8_WAIT_V(6); PG8_BAR;
    } else {
        PG8_STAGE(PG8_SB(0, 0), cB, voffB); PG8_STAGE(PG8_SA(0, 0), cA, voffA0); PG8_STAGE(PG8_SB(0, 1), cB + hstepB, voffB); PG8_STAGE(PG8_SA(0, 1), cA, voffA1);
        if (wr == 1) PG8_BAR;
        PG8_WAIT_V(4); PG8_BAR;
        PG8_STAGE(PG8_SB(1, 0), cB + kstepB, voffB); PG8_STAGE(PG8_SA(1, 0), cA + kstepA, voffA0); PG8_STAGE(PG8_SB(1, 1), cB + hstepB + kstepB, voffB);
        PG8_WAIT_V(6); PG8_BAR;
    }
    for (;;) {
        const bool has_next = S.next(ui + 1, nxt);
        const char* nA = has_next ? PG8_ABASE(nxt) : cA; const char* nB = has_next ? PG8_BBASE(nxt) : cB;
        if (AMODE == 2) { if (has_next) PG8_GIDX_LOAD(nxt); }
#pragma unroll 1
        for (int t = 0; t < nt; t += 2) {
            const bool last = (t == nt - 2);
            unsigned vS0[2], vS1[2];
            if (AMODE == 2) { if (last) { if (has_next) PG8_GIDX_USE(); else { _Pragma("unroll") for (int i = 0; i < 2; ++i) { voffN0[i] = voffA0[i]; voffN1[i] = voffA1[i]; } } } }
#pragma unroll
            for (int i = 0; i < 2; ++i) { vS0[i] = (AMODE == 2 && last) ? voffN0[i] : voffA0[i]; vS1[i] = (AMODE == 2 && last) ? voffN1[i] : voffA1[i]; }
            const char* a1 = cA + (size_t)(t + 1) * kstepA;
            const char* a2 = last ? nA : cA + (size_t)(t + 2) * kstepA; const char* b2 = last ? nB : cB + (size_t)(t + 2) * kstepB;
            const char* a3 = a2 + kstepA; const char* b3 = b2 + kstepB;
            if (last && has_next) S.a_ready(nxt);
            if constexpr (SP2) {
            PG8_LDB(B0, 0, 0); PG8_LDB(B1, 0, 1); PG8_SCHED; PG8_LDA(At, 0, 0); PG8_STAGE(PG8_SA(1, 1), a1, voffA1);
            PG8_WAIT_V(8); PG8_WAIT_L(0); PG8_BAR; PG8_MMA(0, 0, At, B0); PG8_MMA(0, 1, At, B1); PG8_BAR; PG8_SCHED;
            PG8_LDA(At, 0, 1); PG8_STAGE(PG8_SB(0, 0), b2, voffB); PG8_STAGE(PG8_SB(0, 1), b2 + hstepB, voffB); PG8_STAGE(PG8_SA(0, 0), a2, vS0);
            PG8_WAIT_V(8); PG8_WAIT_L(0); PG8_BAR; PG8_MMA(1, 0, At, B0); PG8_MMA(1, 1, At, B1); PG8_BAR; PG8_SCHED;
            PG8_LDB(B0, 1, 0); PG8_LDB(B1, 1, 1); PG8_SCHED; PG8_LDA(At, 1, 0); PG8_STAGE(PG8_SA(0, 1), a2, vS1);
            PG8_WAIT_V(8); PG8_WAIT_L(0); PG8_BAR; PG8_MMA(0, 0, At, B0); PG8_MMA(0, 1, At, B1); PG8_BAR; PG8_SCHED;
            PG8_LDA(At, 1, 1); PG8_STAGE(PG8_SB(1, 0), b3, voffB); PG8_STAGE(PG8_SB(1, 1), b3 + hstepB, voffB); PG8_STAGE(PG8_SA(1, 0), a3, vS0);
            PG8_WAIT_V(8); PG8_WAIT_L(0); PG8_BAR; PG8_MMA(1, 0, At, B0); PG8_MMA(1, 1, At, B1); PG8_BAR; PG8_SCHED;
            } else {
            PG8_LDB(B0, 0, 0); PG8_SCHED; PG8_LDA(At, 0, 0); PG8_STAGE(PG8_SA(1, 1), a1, voffA1);
            PG8_WAIT_L(8); PG8_BAR; PG8_WAIT_L(0); PG8_MMA(0, 0, At, B0); PG8_BAR; PG8_SCHED;
            PG8_LDB(B1, 0, 1); PG8_STAGE(PG8_SB(0, 0), b2, voffB);
            PG8_BAR; PG8_WAIT_L(0); PG8_MMA(0, 1, At, B1); PG8_BAR;
            PG8_LDA(At, 0, 1); PG8_STAGE(PG8_SA(0, 0), a2, vS0);
            PG8_BAR; PG8_WAIT_L(0); PG8_MMA(1, 0, At, B0); PG8_BAR; PG8_SCHED;
            PG8_STAGE(PG8_SB(0, 1), b2 + hstepB, voffB);
            PG8_WAIT_V(6); PG8_BAR; PG8_MMA(1, 1, At, B1); PG8_BAR;
            PG8_LDB(B0, 1, 0); PG8_SCHED; PG8_LDA(At, 1, 0); PG8_STAGE(PG8_SA(0, 1), a2, vS1);
            PG8_WAIT_L(8); PG8_BAR; PG8_WAIT_L(0); PG8_MMA(0, 0, At, B0); PG8_BAR; PG8_SCHED;
            PG8_LDB(B1, 1, 1); PG8_STAGE(PG8_SB(1, 0), b3, voffB);
            PG8_BAR; PG8_WAIT_L(0); PG8_MMA(0, 1, At, B1); PG8_BAR;
            PG8_LDA(At, 1, 1); PG8_STAGE(PG8_SA(1, 0), a3, vS0);
            PG8_BAR; PG8_WAIT_L(0); PG8_MMA(1, 0, At, B0); PG8_BAR; PG8_SCHED;
            PG8_STAGE(PG8_SB(1, 1), b3 + hstepB, voffB);
            PG8_WAIT_V(6); PG8_BAR; PG8_MMA(1, 1, At, B1); PG8_BAR;
            }
        }
        if constexpr (ALIGN_EPI) { if (wr == 0) PG8_BAR; }
        if constexpr (F8) asm volatile("s_nop 15\n\ts_nop 15\n\ts_nop 7" ::: "memory");
        E(acc, cur, wr, wc, fr, fq); S.done(cur);
#if DBG_EPI2
        if (Epi::EPI2) { asm volatile("" ::: "memory"); E(acc, cur, wr, wc, fr, fq); }
#endif
        if (!has_next) break;
#pragma unroll
        for (int a = 0; a < 2; ++a)
#pragma unroll
            for (int b = 0; b < 2; ++b)
#pragma unroll
                for (int m = 0; m < 4; ++m)
#pragma unroll
                    for (int n = 0; n < 2; ++n) acc[a][b][m][n] = (f32x4){0.f, 0.f, 0.f, 0.f};
        cur = nxt; cA = nA; cB = nB; ++ui;
        if (AMODE == 2) {
#pragma unroll
            for (int i = 0; i < 2; ++i) { voffA0[i] = voffN0[i]; voffA1[i] = voffN1[i]; } }
        if constexpr (ALIGN_EPI) { if (wr == 1) PG8_BAR; }
    }
    PG8_WAIT_V(0);
    if constexpr (!ALIGN_EPI) { if (wr == 0) PG8_BAR; }
    PG8_BAR;
#undef PG8_GIDX_LOAD
#undef PG8_GIDX_USE
#undef PG8_ABASE
#undef PG8_BBASE
#undef PG8_SA
#undef PG8_SB
#undef PG8_STAGE
#undef PG8_LDA
#undef PG8_LDA16
#undef PG8_LDA8
#undef PG8_LDB16
#undef PG8_LDB8
#undef PG8_MMA16
#undef PG8_MMA8
#undef PG8_LDB
#undef PG8_MMA
#undef PG8_WAIT_V
#undef PG8_WAIT_L
#undef PG8_BAR
#undef PG8_SCHED
}
}
constexpr int NWAVES = 8;
constexpr int BATCH = 2, SEQ = 8192, D = 1024, M = BATCH * SEQ, DF = 512, DIN = 5632, NE = 16, CAP = 1024, DE = 2048, MR = BATCH * NE * CAP  ;
constexpr float RMS_EPS = 1e-6f;
constexpr size_t MiB = 1u << 20;
constexpr size_t WS_CTL = 0, CTL_ZERO_BYTES = 32 * 1024;
constexpr size_t WS_MODP = 1 * MiB, WS_MOD = 1 * MiB + 256 * 1024, WS_FC1 = 1 * MiB + 512 * 1024, WS_FC2 = 1 * MiB + 576 * 1024;
constexpr size_t WS_PROBS = 2 * MiB, WS_SLOT = 3 * MiB, WS_IDX = 4 * MiB, WS_VAL = 4 * MiB + 128 * 1024;
constexpr size_t WS_WIN = 8 * MiB, WS_WF = 20 * MiB, WS_WCO = 22 * MiB, WS_WO = 24 * MiB, WS_WGU = 32 * MiB, WS_WD = 160 * MiB;
constexpr size_t WS_H1 = 224 * MiB, WS_AB = 224 * MiB, WS_UF = 256 * MiB, WS_CV = 272 * MiB, WS_BG = 304 * MiB, WS_GA = 336 * MiB, WS_GB = 368 * MiB, WS_ZF = 400 * MiB, WS_TZ = 432 * MiB, WS_H2 = 464 * MiB;
#ifndef MOE_FP8
#define MOE_FP8 1
#endif
constexpr size_t WS_HM = 224 * MiB, WS_Y = 432 * MiB, WS_X1B = 400 * MiB, WS_END = 496 * MiB;
constexpr int CW_BAR = 4096;
constexpr int RING_BYTES = 131072, MISC_OFF = 143360, LDS_BYTES = 147456;
constexpr int FFT_TOFF = 65536, FFT_TPITCH = 528;

#define GAS __attribute__((address_space(1)))
#define LAS __attribute__((address_space(3)))
typedef unsigned short bf16;
typedef unsigned v4u __attribute__((ext_vector_type(4)));
typedef unsigned v2u __attribute__((ext_vector_type(2)));
typedef float f32x4 __attribute__((ext_vector_type(4)));
typedef short bf16x8 __attribute__((ext_vector_type(8)));
#define LDS_WAIT() asm volatile("s_waitcnt lgkmcnt(0)" ::: "memory")
#define VM_WAIT() asm volatile("s_waitcnt vmcnt(0)" ::: "memory")
using pg8::cvt_pk_bf16; using pg8::bf_lo; using pg8::bf_hi; using pg8::sigm;
__device__ __forceinline__ float wave_sum(float v) {
#pragma unroll
    for (int o = 1; o < 64; o <<= 1) v += __shfl_xor(v, o);
    return v;
}
__device__ __forceinline__ float silu(float v) { return v * sigm(v); }
#ifndef DBG_NOBIAS
#define DBG_NOBIAS 0
#endif
#ifndef DBG_NOSIG
#define DBG_NOSIG 0
#endif
__device__ __forceinline__ float sigx(float v) { return DBG_NOSIG ? v : sigm(v); }

#define XB_TMO      128
#define XB_XCNT(j)  (256  + 64 * (j))
#define XB_XSUB(j)  (1280 + 64 * (j))
#define XB_XGEN(j)  (2304 + 64 * (j))
#define XB_TOP      3328
#define XB_TOPGEN   3392
#define XCD_BAR_WORDS 3456
#define XB_SPIN_CAP (1u << 18)
__device__ __forceinline__ unsigned xb_ld(unsigned* p)              { return __hip_atomic_load(p, __ATOMIC_RELAXED, __HIP_MEMORY_SCOPE_AGENT); }
__device__ __forceinline__ unsigned xb_add(unsigned* p, unsigned v) { return __hip_atomic_fetch_add(p, v, __ATOMIC_RELAXED, __HIP_MEMORY_SCOPE_AGENT); }
__device__ __forceinline__ unsigned xb_xcc_id() { return (unsigned)__builtin_amdgcn_s_getreg((3 << 11) | 20) & 0xFu; }
#define XB_SPIN(cond, bar) do { unsigned _sp = 0; while (cond) { __builtin_amdgcn_s_sleep(1); \
    if ((++_sp & 255u) == 0u) { if (xb_ld(&(bar)[XB_TMO])) break; if (_sp > XB_SPIN_CAP) { atomicAdd(&(bar)[XB_TMO], 1u); break; } } } } while (0)
struct XcdBarrier { unsigned* bar; unsigned x; volatile LAS unsigned* st; };
__device__ __forceinline__ XcdBarrier xcd_barrier_post(unsigned* bar, volatile LAS unsigned* st) {
    XcdBarrier b; b.bar = bar; b.x = xb_xcc_id(); b.st = st;
    if (threadIdx.x == 0) (void)xb_add(&bar[XB_XCNT(b.x)], 1u);
    return b;
}
__device__ __forceinline__ void xcd_barrier_complete(unsigned* bar, unsigned x, unsigned& nloc, unsigned& nx) {
    const unsigned G = gridDim.x * gridDim.y * gridDim.z;
    unsigned sum, cnt, mine, sp = 0u;
    for (;;) {
        sum = 0u; cnt = 0u; mine = 0u;
#pragma unroll
        for (unsigned j = 0; j < 16; ++j) { const unsigned c = xb_ld(&bar[XB_XCNT(j)]); sum += c; cnt += (c > 0u) ? 1u : 0u; mine = (j == x) ? c : mine; }
        if (sum == G) break;
        __builtin_amdgcn_s_sleep(1);
        if ((++sp & 255u) == 0u) { if (xb_ld(&bar[XB_TMO])) break; if (sp > XB_SPIN_CAP) { atomicAdd(&bar[XB_TMO], 1u); break; } }
    }
    nloc = mine > 0u ? mine : 1u; nx = cnt > 0u ? cnt : 1u;
}
__device__ __forceinline__ void xcd_barrier(const XcdBarrier& b) {
    asm volatile("s_waitcnt vmcnt(0)" ::: "memory");
    __syncthreads();
    if (threadIdx.x == 0) {
        unsigned* bar = b.bar;
        __builtin_amdgcn_s_waitcnt(0);
        unsigned nloc = b.st[0], nx = b.st[1];
        if (nloc == 0u) { xcd_barrier_complete(bar, b.x, nloc, nx); b.st[0] = nloc; b.st[1] = nx; }
        const unsigned old = xb_add(&bar[XB_XSUB(b.x)], 1u);
        const unsigned gen = old / nloc;
        if (old + 1u == (gen + 1u) * nloc) {
            __builtin_amdgcn_fence(__ATOMIC_RELEASE, "agent");
            asm volatile("s_waitcnt vmcnt(0)" ::: "memory");
            const unsigned og = xb_add(&bar[XB_TOP], 1u);
            const unsigned tg = og / nx;
            if (og + 1u == (tg + 1u) * nx) xb_add(&bar[XB_TOPGEN], 1u);
            else XB_SPIN(xb_ld(&bar[XB_TOPGEN]) == tg, bar);
            __builtin_amdgcn_fence(__ATOMIC_ACQUIRE, "agent");
            xb_add(&bar[XB_XGEN(b.x)], 1u);
            asm volatile("s_waitcnt vmcnt(0)" ::: "memory");
        } else {
            XB_SPIN(xb_ld(&bar[XB_XGEN(b.x)]) == gen, bar);
            __builtin_amdgcn_fence(__ATOMIC_ACQUIRE, "agent");
            asm volatile("s_waitcnt vmcnt(0)" ::: "memory");
        }
    }
    __syncthreads();
}

using pg8::Unit; using pg8::u32x4; using pg8::u32x2;
__device__ __forceinline__ unsigned pk4_u8(float a, float b2, float c, float d) { return (unsigned)__builtin_rintf(a * 255.f) | ((unsigned)__builtin_rintf(b2 * 255.f) << 8) | ((unsigned)__builtin_rintf(c * 255.f) << 16) | ((unsigned)__builtin_rintf(d * 255.f) << 24); }
struct EpiInProj {
    static constexpr bool PERM = true, EPI2 = (DBG_EPI2 == 2);
    bf16 *UF, *CV, *BG, *GA, *GB; const float* b_gate;
    __device__ __forceinline__ void operator()(const f32x4 (&acc)[2][2][4][2], const Unit& u, int wr, int wc, int fr, int fq) const {
        const int row0 = u.pm * 256 + wr * 64 + fr;
        if (u.pn < 2) {
            const int b = u.pm >> 5, s0 = (u.pm & 31) * 256 + wr * 64 + fr;
#pragma unroll
            for (int ai = 0; ai < 2; ++ai)
#pragma unroll
                for (int m = 0; m < 4; ++m) { const int s = s0 + ai * 128 + m * 16;
#pragma unroll
                    for (int bj = 0; bj < 2; ++bj) { const int g4 = (u.pn * 256 + bj * 128 + wc * 32 + 8 * fq) >> 2;
#pragma unroll
                        for (int n = 0; n < 2; ++n) { const f32x4 v = acc[ai][bj][m][n]; u32x2 w; w.x = cvt_pk_bf16(v[0], v[1]); w.y = cvt_pk_bf16(v[2], v[3]);
                            *(u32x2*)(UF + ((size_t)(b * 128 + g4 + n) * 8192 + s) * 4) = w; } } }
        } else if (u.pn < 10) {
#pragma unroll
            for (int ai = 0; ai < 2; ++ai)
#pragma unroll
                for (int m = 0; m < 4; ++m) { bf16* rowp = CV + (size_t)(row0 + ai * 128 + m * 16) * D + (u.pn - 2) * 128 + wc * 16 + 4 * fq;
#pragma unroll
                    for (int bj = 0; bj < 2; ++bj) { const f32x4 v = acc[ai][bj][m][0] * acc[ai][bj][m][1]; u32x2 w; w.x = cvt_pk_bf16(v[0], v[1]); w.y = cvt_pk_bf16(v[2], v[3]);
                        *(u32x2*)(rowp + bj * 64) = w; } }
        } else if (u.pn < 14) {
#pragma unroll
            for (int ai = 0; ai < 2; ++ai)
#pragma unroll
                for (int m = 0; m < 4; ++m) { bf16* rowp = BG + (size_t)(row0 + ai * 128 + m * 16) * D + (u.pn - 10) * 256 + wc * 32 + 8 * fq;
#pragma unroll
                    for (int bj = 0; bj < 2; ++bj) { const f32x4 v0 = acc[ai][bj][m][0], v1 = acc[ai][bj][m][1]; u32x4 w; w.x = cvt_pk_bf16(v0[0], v0[1]); w.y = cvt_pk_bf16(v0[2], v0[3]); w.z = cvt_pk_bf16(v1[0], v1[1]); w.w = cvt_pk_bf16(v1[2], v1[3]);
                        *(u32x4*)(rowp + bj * 128) = w; } }
        } else {
            const int colg = (u.pn - 14) * 256 + wc * 32 + 8 * fq;
            bf16* O = (u.pn < 18) ? GA : GB;
            f32x4 bv[2][2];
#pragma unroll
            for (int bj = 0; bj < 2; ++bj)
#pragma unroll
                for (int n = 0; n < 2; ++n) bv[bj][n] = DBG_NOBIAS ? (f32x4){0.f, 0.f, 0.f, 0.f} : *(const f32x4*)(b_gate + colg + bj * 128 + 4 * n);
#pragma unroll
            for (int ai = 0; ai < 2; ++ai)
#pragma unroll
                for (int m = 0; m < 4; ++m) { unsigned char* rowp8 = (unsigned char*)O + (size_t)(row0 + ai * 128 + m * 16) * D + (colg & 1023);
#pragma unroll
                    for (int bj = 0; bj < 2; ++bj) { const f32x4 v0 = acc[ai][bj][m][0] + bv[bj][0], v1 = acc[ai][bj][m][1] + bv[bj][1]; u32x2 w;
                        w.x = pk4_u8(sigx(v0[0]), sigx(v0[1]), sigx(v0[2]), sigx(v0[3])); w.y = pk4_u8(sigx(v1[0]), sigx(v1[1]), sigx(v1[2]), sigx(v1[3]));
                        *(u32x2*)(rowp8 + bj * 128) = w; } }
        }
    }
};
template <int MODE> struct EpiGateMul {
    static constexpr bool PERM = true, EPI2 = false;
    bf16* O; const bf16* G;
    __device__ __forceinline__ void operator()(const f32x4 (&acc)[2][2][4][2], const Unit& u, int wr, int wc, int fr, int fq) const {
        const int row0 = u.pm * 256 + wr * 64 + fr, col0 = u.pn * 256 + wc * 32 + 8 * fq;
#pragma unroll
        for (int ai = 0; ai < 2; ++ai)
#pragma unroll
            for (int m = 0; m < 4; ++m) { const size_t off = (size_t)(row0 + ai * 128 + m * 16) * D + col0;
#pragma unroll
                for (int bj = 0; bj < 2; ++bj) { const u32x2 gw = *(const u32x2*)((const unsigned char*)G + off + bj * 128); const f32x4 v0 = acc[ai][bj][m][0] * (1.0f / 255.0f), v1 = acc[ai][bj][m][1] * (1.0f / 255.0f);
                    float r[8] = {(float)(gw.x & 0xffu) * v0[0], (float)((gw.x >> 8) & 0xffu) * v0[1], (float)((gw.x >> 16) & 0xffu) * v0[2], (float)(gw.x >> 24) * v0[3],
                                  (float)(gw.y & 0xffu) * v1[0], (float)((gw.y >> 8) & 0xffu) * v1[1], (float)((gw.y >> 16) & 0xffu) * v1[2], (float)(gw.y >> 24) * v1[3]};
                    if (MODE == 1) { const u32x4 ow = *(const u32x4*)(O + off + bj * 128);
                        r[0] += bf_lo(ow.x); r[1] += bf_hi(ow.x); r[2] += bf_lo(ow.y); r[3] += bf_hi(ow.y); r[4] += bf_lo(ow.z); r[5] += bf_hi(ow.z); r[6] += bf_lo(ow.w); r[7] += bf_hi(ow.w); }
                    u32x4 w; w.x = cvt_pk_bf16(r[0], r[1]); w.y = cvt_pk_bf16(r[2], r[3]); w.z = cvt_pk_bf16(r[4], r[5]); w.w = cvt_pk_bf16(r[6], r[7]);
                    *(u32x4*)(O + off + bj * 128) = w; } }
    }
};
struct EpiResid {
    static constexpr bool PERM = true, EPI2 = (DBG_EPI2 == 5);
    const float* x; bf16* X1B; const float* gate;
    __device__ __forceinline__ void operator()(const f32x4 (&acc)[2][2][4][2], const Unit& u, int wr, int wc, int fr, int fq) const {
        const int row0 = u.pm * 256 + wr * 64 + fr, col0 = u.pn * 256 + wc * 32 + 8 * fq, b = u.pm >> 5;
        f32x4 gv[2][2];
#pragma unroll
        for (int bj = 0; bj < 2; ++bj)
#pragma unroll
            for (int n = 0; n < 2; ++n) gv[bj][n] = *(const f32x4*)(gate + b * 6 * D + col0 + bj * 128 + 4 * n);
#pragma unroll
        for (int ai = 0; ai < 2; ++ai)
#pragma unroll
            for (int m = 0; m < 4; ++m) { const size_t off = (size_t)(row0 + ai * 128 + m * 16) * D + col0;
#pragma unroll
                for (int bj = 0; bj < 2; ++bj) { const f32x4 x0 = *(const f32x4*)(x + off + bj * 128), x1 = *(const f32x4*)(x + off + bj * 128 + 4);
                    const f32x4 v0 = x0 + gv[bj][0] * acc[ai][bj][m][0], v1 = x1 + gv[bj][1] * acc[ai][bj][m][1];
                    u32x4 w; w.x = cvt_pk_bf16(v0[0], v0[1]); w.y = cvt_pk_bf16(v0[2], v0[3]); w.z = cvt_pk_bf16(v1[0], v1[1]); w.w = cvt_pk_bf16(v1[2], v1[3]);
                    *(u32x4*)(X1B + off + bj * 128) = w; }
                asm volatile("" ::: "memory"); }
    }
};
struct EpiSwiGLU {
    static constexpr bool PERM = true, EPI2 = (DBG_EPI2 == 9);
    bf16* HM;
    __device__ __forceinline__ void operator()(const f32x4 (&acc)[2][2][4][2], const Unit& u, int wr, int wc, int fr, int fq) const {
        const int row0 = u.pm * 256 + wr * 64 + fr, col0 = u.pn * 128 + wc * 32 + 8 * fq;
#pragma unroll
        for (int ai = 0; ai < 2; ++ai)
#pragma unroll
            for (int m = 0; m < 4; ++m) { const f32x4 g0 = acc[ai][0][m][0], g1 = acc[ai][0][m][1], u0 = acc[ai][1][m][0], u1 = acc[ai][1][m][1]; u32x4 w;
                w.x = cvt_pk_bf16(silu(g0[0]) * u0[0], silu(g0[1]) * u0[1]); w.y = cvt_pk_bf16(silu(g0[2]) * u0[2], silu(g0[3]) * u0[3]);
                w.z = cvt_pk_bf16(silu(g1[0]) * u1[0], silu(g1[1]) * u1[1]); w.w = cvt_pk_bf16(silu(g1[2]) * u1[2], silu(g1[3]) * u1[3]);
                *(u32x4*)(HM + (size_t)(row0 + ai * 128 + m * 16) * DE + col0) = w; }
    }
};
__device__ __forceinline__ unsigned pk4_fp8(float a, float b2, float c, float d) { unsigned w = 0u; w = __builtin_amdgcn_cvt_pk_fp8_f32(a, b2, w, false); w = __builtin_amdgcn_cvt_pk_fp8_f32(c, d, w, true); return w; }
struct EpiSwiGLU8 {
    static constexpr bool PERM = true, EPI2 = false;
    unsigned char* HM8;
    __device__ __forceinline__ void operator()(const f32x4 (&acc)[2][2][4][2], const Unit& u, int wr, int wc, int fr, int fq) const {
        const int row0 = u.pm * 256 + wr * 64 + fr, col0 = u.pn * 128 + wc * 32 + 8 * fq;
#pragma unroll
        for (int ai = 0; ai < 2; ++ai)
#pragma unroll
            for (int m = 0; m < 4; ++m) { const f32x4 g0 = acc[ai][0][m][0], g1 = acc[ai][0][m][1], u0 = acc[ai][1][m][0], u1 = acc[ai][1][m][1]; u32x2 w;
                w.x = pk4_fp8(silu(g0[0]) * u0[0], silu(g0[1]) * u0[1], silu(g0[2]) * u0[2], silu(g0[3]) * u0[3]);
                w.y = pk4_fp8(silu(g1[0]) * u1[0], silu(g1[1]) * u1[1], silu(g1[2]) * u1[2], silu(g1[3]) * u1[3]);
                *(u32x2*)(HM8 + (size_t)(row0 + ai * 128 + m * 16) * DE + col0) = w; asm volatile("" ::: "memory"); }
    }
};
struct EpiRowScale {
    static constexpr bool PERM = true, EPI2 = (DBG_EPI2 == 10);
    bf16* Y; const float* val;
    __device__ __forceinline__ void operator()(const f32x4 (&acc)[2][2][4][2], const Unit& u, int wr, int wc, int fr, int fq) const {
        const int row0 = u.pm * 256 + wr * 64 + fr, col0 = u.pn * 256 + wc * 32 + 8 * fq;
#pragma unroll
        for (int ai = 0; ai < 2; ++ai)
#pragma unroll
            for (int m = 0; m < 4; ++m) { const int row = row0 + ai * 128 + m * 16; const float sv = val[row];
#pragma unroll
                for (int bj = 0; bj < 2; ++bj) { const f32x4 v0 = acc[ai][bj][m][0] * sv, v1 = acc[ai][bj][m][1] * sv; u32x4 w; w.x = cvt_pk_bf16(v0[0], v0[1]); w.y = cvt_pk_bf16(v0[2], v0[3]); w.z = cvt_pk_bf16(v1[0], v1[1]); w.w = cvt_pk_bf16(v1[2], v1[3]);
                    *(u32x4*)(Y + (size_t)row * D + col0 + bj * 128) = w; } }
    }
};

struct EpiPlain {
    static constexpr bool PERM = true, EPI2 = false;
    bf16* O; int ldc;
    __device__ __forceinline__ void operator()(const f32x4 (&acc)[2][2][4][2], const Unit& u, int wr, int wc, int fr, int fq) const {
        const int row0 = u.pm * 256 + wr * 64 + fr, col0 = u.pn * 256 + wc * 32 + 8 * fq;
#pragma unroll
        for (int ai = 0; ai < 2; ++ai)
#pragma unroll
            for (int m = 0; m < 4; ++m) { bf16* rowp = O + (size_t)(row0 + ai * 128 + m * 16) * ldc + col0;
#pragma unroll
                for (int bj = 0; bj < 2; ++bj) { const f32x4 v0 = acc[ai][bj][m][0], v1 = acc[ai][bj][m][1]; u32x4 w; w.x = cvt_pk_bf16(v0[0], v0[1]); w.y = cvt_pk_bf16(v0[2], v0[3]); w.z = cvt_pk_bf16(v1[0], v1[1]); w.w = cvt_pk_bf16(v1[2], v1[3]);
                    *(u32x4*)(rowp + bj * 128) = w; } }
    }
};
__device__ __forceinline__ unsigned f2bf(float f) { unsigned u = __builtin_bit_cast(unsigned, f); return (u + 0x7fffu + ((u >> 16) & 1u)) >> 16; }
__device__ __forceinline__ unsigned pk2(float lo, float hi) { return f2bf(lo) | (f2bf(hi) << 16); }
__device__ __forceinline__ int rowmap_in(int n) {
    if (n < 512) return n;
    if (n < 1536) { const int j = n - 512; return 512 + 8 * (j >> 2) + (j & 3); }
    if (n < 2560) return 2560 + (n - 1536);
    if (n < 3584) { const int j = n - 2560; return 512 + 8 * (j >> 2) + 4 + (j & 3); }
    return n;
}
template <int MAP>
__device__ __forceinline__ void transpose_item(const float* W, int K, int N, bf16* WT, LAS float* scr, int item, int lane) {
    const int nblk = N / 32, kb = item / nblk, nb = item % nblk, k0 = 64 * kb, n0 = 32 * nb;
    { f32x4 t[8];
#pragma unroll
      for (int i = 0; i < 8; ++i) t[i] = *(const GAS f32x4*)(W + (size_t)(k0 + 8 * i + (lane >> 3)) * N + n0 + 4 * (lane & 7));
#pragma unroll
      for (int i = 0; i < 8; ++i) { LAS float* d_ = scr + (8 * i + (lane >> 3)) * 33 + 4 * (lane & 7); d_[0] = t[i].x; d_[1] = t[i].y; d_[2] = t[i].z; d_[3] = t[i].w; } }
    LDS_WAIT(); asm volatile("" ::: "memory");
    const int c = lane & 7;
#pragma unroll
    for (int j = 0; j < 4; ++j) { const int n = (lane >> 3) + 8 * j; const LAS float* s = scr + (8 * c) * 33 + n;
        v4u o; o.x = pk2(s[0 * 33], s[1 * 33]); o.y = pk2(s[2 * 33], s[3 * 33]); o.z = pk2(s[4 * 33], s[5 * 33]); o.w = pk2(s[6 * 33], s[7 * 33]);
        const int ns = n0 + n; int row;
        if (MAP == 0) row = ns; else if (MAP == 1) row = rowmap_in(ns); else if (MAP == 2) row = 256 * (ns >> 7) + (ns & 127); else row = 256 * (ns >> 7) + 128 + (ns & 127);
        *(GAS v4u*)(WT + (size_t)row * K + k0 + 8 * c) = o; }
    LDS_WAIT(); asm volatile("" ::: "memory");
}
template <int MAP>
__device__ __forceinline__ void transpose_item8(const float* W, int K, int N, unsigned char* WT, LAS float* scr, int item, int lane) {
    const int nblk = N / 32, kb = item / nblk, nb = item % nblk, k0 = 64 * kb, n0 = 32 * nb;
    { f32x4 t[8];
#pragma unroll
      for (int i = 0; i < 8; ++i) t[i] = *(const GAS f32x4*)(W + (size_t)(k0 + 8 * i + (lane >> 3)) * N + n0 + 4 * (lane & 7));
#pragma unroll
      for (int i = 0; i < 8; ++i) { LAS float* d_ = scr + (8 * i + (lane >> 3)) * 33 + 4 * (lane & 7); d_[0] = t[i].x; d_[1] = t[i].y; d_[2] = t[i].z; d_[3] = t[i].w; } }
    LDS_WAIT(); asm volatile("" ::: "memory");
    const int c = lane & 3;
#pragma unroll
    for (int j = 0; j < 2; ++j) { const int n = (lane >> 2) + 16 * j; const LAS float* s = scr + (16 * c) * 33 + n; unsigned o[4];
#pragma unroll
        for (int q = 0; q < 4; ++q) { unsigned w = 0u; w = __builtin_amdgcn_cvt_pk_fp8_f32(s[(4 * q) * 33] * 128.f, s[(4 * q + 1) * 33] * 128.f, w, false); w = __builtin_amdgcn_cvt_pk_fp8_f32(s[(4 * q + 2) * 33] * 128.f, s[(4 * q + 3) * 33] * 128.f, w, true); o[q] = w; }
        const int ns = n0 + n; int row;
        if (MAP == 0) row = ns; else if (MAP == 2) row = 256 * (ns >> 7) + (ns & 127); else row = 256 * (ns >> 7) + 128 + (ns & 127);
        v4u ov; ov.x = o[0]; ov.y = o[1]; ov.z = o[2]; ov.w = o[3];
        *(GAS v4u*)(WT + (size_t)row * K + k0 + 16 * c) = ov; }
    LDS_WAIT(); asm volatile("" ::: "memory");
}
__device__ __forceinline__ void wf_item(const float* wf, bf16* WF_T, int item, int lane) {
    const int c = item >> 2, dblk = item & 3, g = c >> 7, j = c & 127, d0 = 256 * dblk + 4 * lane;
    f32x4 ac = {0.f, 0.f, 0.f, 0.f}, as = {0.f, 0.f, 0.f, 0.f};
    for (int m = 0; m < 128; ++m) { const f32x4 wv = *(const GAS f32x4*)(wf + (size_t)(g * 128 + m) * D + d0); const float fr = (float)((m * j) & 127) * (1.0f / 128.0f);
        const float cv = __builtin_amdgcn_cosf(fr), sv = __builtin_amdgcn_sinf(fr); ac += cv * wv; as += sv * wv; }
    const int kv = 8 * (c >> 2) + 2 * (c & 3);
#pragma unroll
    for (int i = 0; i < 4; ++i) *(GAS unsigned*)(WF_T + (size_t)(d0 + i) * D + kv) = pk2(ac[i] * (1.0f / 1024.0f), as[i] * (1.0f / 1024.0f));
}
__device__ __forceinline__ void fc_tables(bf16* Fc1, bf16* Fc2, int gtid, int gthreads) {
    for (int e = gtid; e < 8192 + 65536; e += gthreads) {
        if (e < 8192) { const int j = e & 7, ln = (e >> 3) & 63, kk = (e >> 9) & 1, mt = (e >> 10) & 3, hh = e >> 12, rho = ln & 15;
            const int s1 = 32 * kk + 8 * (ln >> 4) + j, k1 = 32 * hh + 16 * (mt & 1) + 4 * (rho & 3) + (rho >> 2);
            const float fr = (float)((k1 * s1) & 63) * (1.0f / 64.0f); Fc1[e] = (bf16)f2bf((mt >> 1) == 0 ? cospif(2.0f * fr) : -sinpif(2.0f * fr)); }
        else { const int q = e - 8192, j = q & 7, ln = (q >> 3) & 63, kk = (q >> 9) & 7, ro = (q >> 12) & 1, w = q >> 13;
            const int k2 = 16 * w + (ln & 15), kap = 32 * kk + 8 * (ln >> 4) + j, s2 = kap >> 1, ri = kap & 1;
            const float fr = (float)((k2 * s2) & 127) * (1.0f / 128.0f), cv = cospif(2.0f * fr), sv = sinpif(2.0f * fr);
            Fc2[q] = (bf16)f2bf(ro == 0 ? (ri == 0 ? cv : sv) : (ri == 0 ? -sv : cv)); }
    }
}
__device__ __forceinline__ void mod_item(const float* c, const float* w_ada, float* modp, LAS unsigned char* lds, int item, int tid, int wave, int lane) {
    const int cb = item % 24, kq = item / 24, col0 = 256 * cb + 4 * lane;
    f32x4 a0 = {0.f, 0.f, 0.f, 0.f}, a1 = {0.f, 0.f, 0.f, 0.f};
#pragma unroll
    for (int i0 = 0; i0 < 32; i0 += 16) { f32x4 wv[16];
#pragma unroll
        for (int i = 0; i < 16; ++i) wv[i] = *(const GAS f32x4*)(w_ada + (size_t)(256 * kq + 32 * wave + i0 + i) * 6 * D + col0);
#pragma unroll
        for (int i = 0; i < 16; ++i) { const int d = 256 * kq + 32 * wave + i0 + i; a0 += silu(c[d]) * wv[i]; a1 += silu(c[D + d]) * wv[i]; } }
    LAS f32x4* red = (LAS f32x4*)lds;
    red[(wave * 2 + 0) * 64 + lane] = a0; red[(wave * 2 + 1) * 64 + lane] = a1;
    __syncthreads();
    { const int b = tid >> 8, cc = tid & 255; const LAS float* rf = (const LAS float*)lds; float s = 0.f;
#pragma unroll
      for (int w = 0; w < 8; ++w) s += rf[((w * 2 + b) * 64) * 4 + cc];
      modp[(size_t)(kq * 2 + b) * 6 * D + 256 * cb + cc] = s; }
    __syncthreads();
}

__device__ __forceinline__ void phase_h(const float* x, const float* g_mix, const float* b_ada, const float* modp, float* mod, bf16* H1, LAS unsigned char* lds, int tid, int wave, int lane, int vcu, int G) {
    LAS float* ga = (LAS float*)lds;
    LAS float* sh = ga + 2 * D;
    { float v[8];
#pragma unroll
      for (int k = 0; k < 8; ++k) { const int i = tid + 512 * k, j = i & 2047; v[k] = b_ada[j]; }
#pragma unroll
      for (int q = 0; q < 4; ++q)
#pragma unroll
          for (int k = 0; k < 8; ++k) { const int i = tid + 512 * k, b = i >> 11, j = i & 2047; v[k] += modp[(size_t)(q * 2 + b) * 6 * D + j]; }
#pragma unroll
      for (int k = 0; k < 8; ++k) { const int i = tid + 512 * k, b = i >> 11, j = i & 2047; if (j < D) sh[b * D + j] = v[k]; else ga[b * D + j - D] = g_mix[j - D] * (1.f + v[k]); } }
    { const int i = vcu * NWAVES * 64 + tid;
      if (i < 2 * 6 * D) { const int b = i / (6 * D), j = i % (6 * D); float v = b_ada[j];
#pragma unroll
          for (int q = 0; q < 4; ++q) v += modp[(size_t)(q * 2 + b) * 6 * D + j];
          mod[i] = v; } }
    __syncthreads();
    const int gw = vcu * NWAVES + wave, NGW = G * NWAVES;
    for (int m0 = gw * 4; m0 < M; m0 += NGW * 4) { const int b = m0 >> 13;
        f32x4 v[4][4]; float s[4];
#pragma unroll
        for (int r = 0; r < 4; ++r) { const GAS f32x4* xr = (const GAS f32x4*)(x + (size_t)(m0 + r) * D) + lane;
#pragma unroll
            for (int j = 0; j < 4; ++j) v[r][j] = xr[64 * j]; }
#pragma unroll
        for (int r = 0; r < 4; ++r) { s[r] = 0.f;
#pragma unroll
            for (int j = 0; j < 4; ++j) s[r] += (v[r][j].x * v[r][j].x + v[r][j].y * v[r][j].y) + (v[r][j].z * v[r][j].z + v[r][j].w * v[r][j].w); }
#pragma unroll
        for (int o = 1; o < 64; o <<= 1) {
#pragma unroll
            for (int r = 0; r < 4; ++r) s[r] += __shfl_xor(s[r], o); }
#pragma unroll
        for (int r = 0; r < 4; ++r) { const float rr = rsqrtf(s[r] * (1.f / D) + RMS_EPS); GAS v2u* o8 = (GAS v2u*)(H1 + (size_t)(m0 + r) * D) + lane;
#pragma unroll
            for (int j = 0; j < 4; ++j) { const f32x4 gg = *(const LAS f32x4*)(ga + b * D + 4 * lane + 256 * j), ss = *(const LAS f32x4*)(sh + b * D + 4 * lane + 256 * j); const f32x4 y = v[r][j] * rr * gg + ss;
                v2u w; w.x = cvt_pk_bf16(y.x, y.y); w.y = cvt_pk_bf16(y.z, y.w); o8[64 * j] = w; } } }
    __syncthreads();
}
__device__ __forceinline__ void phase_conv(const bf16* CV, const bf16* BG, const float* w_conv, bf16* AB, int wave, int lane, int vcu, int G) {
    const int gw = vcu * NWAVES + wave, NGW = G * NWAVES;
    for (int o = gw; o < M / 8; o += NGW) { const int r0 = 8 * o, s0 = r0 & (SEQ - 1);
#pragma unroll
        for (int hseg = 0; hseg < 2; ++hseg) { const int ch = hseg * 512 + 8 * lane; const size_t off = (size_t)r0 * D + ch;
            v4u cv[10], bg[8];
#pragma unroll
            for (int jj = 0; jj < 10; ++jj) { const bool ok = (jj == 0) ? (s0 > 0) : (jj == 9) ? (s0 + 8 < SEQ) : true; cv[jj] = (v4u){0u, 0u, 0u, 0u}; if (ok) cv[jj] = *(const GAS v4u*)(CV + off + (size_t)(jj - 1) * D); }
#pragma unroll
            for (int jj = 0; jj < 8; ++jj) bg[jj] = *(const GAS v4u*)(BG + off + (size_t)jj * D);
            float w0[8], w1[8], w2[8];
#pragma unroll
            for (int q = 0; q < 2; ++q) { const f32x4 a = *(const GAS f32x4*)(w_conv + ch + 4 * q), b = *(const GAS f32x4*)(w_conv + D + ch + 4 * q), c2 = *(const GAS f32x4*)(w_conv + 2 * D + ch + 4 * q);
#pragma unroll
                for (int i2 = 0; i2 < 4; ++i2) { w0[4 * q + i2] = a[i2]; w1[4 * q + i2] = b[i2]; w2[4 * q + i2] = c2[i2]; } }
#pragma unroll
            for (int jj = 0; jj < 8; ++jj) { unsigned ow[4];
#pragma unroll
                for (int q = 0; q < 4; ++q) {
                    const float lo = bf_lo(bg[jj][q]) * (w0[2 * q] * bf_lo(cv[jj][q]) + w1[2 * q] * bf_lo(cv[jj + 1][q]) + w2[2 * q] * bf_lo(cv[jj + 2][q]));
                    const float hi = bf_hi(bg[jj][q]) * (w0[2 * q + 1] * bf_hi(cv[jj][q]) + w1[2 * q + 1] * bf_hi(cv[jj + 1][q]) + w2[2 * q + 1] * bf_hi(cv[jj + 2][q]));
                    ow[q] = cvt_pk_bf16(lo, hi); }
                v4u ov; ov.x = ow[0]; ov.y = ow[1]; ov.z = ow[2]; ov.w = ow[3];
                *(GAS v4u*)(AB + off + (size_t)jj * D) = ov; } } }
}
__device__ __forceinline__ void phase_h2(const bf16* X1B, const float* g_moe, const float* mod, const float* w_router, const float* b_router, bf16* H2, unsigned char* H2F8, float* probs,
                                         LAS unsigned char* lds, int tid, int wave, int lane, int vcu, int G) {
    LAS bf16* whi = (LAS bf16*)lds;
    LAS bf16* wlo = whi + 16384;
    LAS float* ga = (LAS float*)(lds + 65536);
    LAS float* sh = ga + 2 * D;
    for (int i = tid; i < 16384; i += NWAVES * 64) { const int j = i & 7, ln = (i >> 3) & 63, kk = i >> 9, k = 32 * kk + 8 * (ln >> 4) + j, e = ln & 15;
        const float w = w_router[k * NE + e]; const unsigned h = f2bf(w); const float wh = __uint_as_float(h << 16); whi[i] = (bf16)h; wlo[i] = (bf16)f2bf(w - wh); }
    { float a[4], b2[4], c2[4];
#pragma unroll
      for (int k = 0; k < 4; ++k) { const int i = tid + 512 * k, b = i >> 10, j = i & 1023; a[k] = mod[b * 6 * D + 3 * D + j]; b2[k] = mod[b * 6 * D + 4 * D + j]; c2[k] = g_moe[j]; }
#pragma unroll
      for (int k = 0; k < 4; ++k) { const int i = tid + 512 * k; sh[i] = a[k]; ga[i] = c2[k] * (1.f + b2[k]); } }
    __syncthreads();
    const int n = lane & 15, kq = lane >> 4;
    float br[4];
#pragma unroll
    for (int r = 0; r < 4; ++r) br[r] = b_router[4 * kq + r];
    for (int grp = wave * G + vcu; grp < M / 16; grp += NWAVES * G) { const int m0 = 16 * grp, b = m0 >> 13;
        const GAS v4u* xr = (const GAS v4u*)(X1B + (size_t)(m0 + n) * D + 8 * kq);
        v4u xf[32]; float ssq = 0.f;
#pragma unroll
        for (int kk = 0; kk < 32; ++kk) xf[kk] = xr[4 * kk];
#pragma unroll
        for (int kk = 0; kk < 32; ++kk) { const v4u w = xf[kk]; const float e0 = bf_lo(w.x), e1 = bf_hi(w.x), e2 = bf_lo(w.y), e3 = bf_hi(w.y), e4 = bf_lo(w.z), e5 = bf_hi(w.z), e6 = bf_lo(w.w), e7 = bf_hi(w.w);
            ssq += (e0 * e0 + e1 * e1) + (e2 * e2 + e3 * e3) + (e4 * e4 + e5 * e5) + (e6 * e6 + e7 * e7); }
#pragma unroll
        for (int kk = 0; kk < 32; ++kk) asm volatile("" : "+v"(xf[kk].x), "+v"(xf[kk].y), "+v"(xf[kk].z), "+v"(xf[kk].w));
        ssq += __shfl_xor(ssq, 16); ssq += __shfl_xor(ssq, 32);
        const float rstd = rsqrtf(ssq * (1.f / D) + RMS_EPS);
        f32x4 acc = {0.f, 0.f, 0.f, 0.f};
        GAS v4u* ho = (GAS v4u*)(H2 + (size_t)(m0 + n) * D + 8 * kq);
#pragma unroll
        for (int kk = 0; kk < 32; ++kk) { const v4u w = xf[kk]; const int col = 32 * kk + 8 * kq;
            const f32x4 g0 = *(const LAS f32x4*)(ga + b * D + col), g1 = *(const LAS f32x4*)(ga + b * D + col + 4), s0 = *(const LAS f32x4*)(sh + b * D + col), s1 = *(const LAS f32x4*)(sh + b * D + col + 4);
            float h[8] = {bf_lo(w.x) * rstd * g0.x + s0.x, bf_hi(w.x) * rstd * g0.y + s0.y, bf_lo(w.y) * rstd * g0.z + s0.z, bf_hi(w.y) * rstd * g0.w + s0.w,
                          bf_lo(w.z) * rstd * g1.x + s1.x, bf_hi(w.z) * rstd * g1.y + s1.y, bf_lo(w.w) * rstd * g1.z + s1.z, bf_hi(w.w) * rstd * g1.w + s1.w};
            v4u hh, hl;
            hh.x = cvt_pk_bf16(h[0], h[1]); hh.y = cvt_pk_bf16(h[2], h[3]); hh.z = cvt_pk_bf16(h[4], h[5]); hh.w = cvt_pk_bf16(h[6], h[7]);
            hl.x = cvt_pk_bf16(h[0] - bf_lo(hh.x), h[1] - bf_hi(hh.x)); hl.y = cvt_pk_bf16(h[2] - bf_lo(hh.y), h[3] - bf_hi(hh.y)); hl.z = cvt_pk_bf16(h[4] - bf_lo(hh.z), h[5] - bf_hi(hh.z)); hl.w = cvt_pk_bf16(h[6] - bf_lo(hh.w), h[7] - bf_hi(hh.w));
            if (MOE_FP8) { v2u q8; q8.x = pk4_fp8(h[0], h[1], h[2], h[3]); q8.y = pk4_fp8(h[4], h[5], h[6], h[7]); *(GAS v2u*)(H2F8 + (size_t)(m0 + n) * D + 32 * kk + 8 * kq) = q8; }
            else ho[4 * kk] = hh;
            const bf16x8 ah = *(const LAS bf16x8*)(whi + (kk * 64 + lane) * 8), al = *(const LAS bf16x8*)(wlo + (kk * 64 + lane) * 8);
            const bf16x8 bh = __builtin_bit_cast(bf16x8, hh), bl = __builtin_bit_cast(bf16x8, hl);
            acc = __builtin_amdgcn_mfma_f32_16x16x32_bf16(ah, bh, acc, 0, 0, 0); acc = __builtin_amdgcn_mfma_f32_16x16x32_bf16(al, bh, acc, 0, 0, 0); acc = __builtin_amdgcn_mfma_f32_16x16x32_bf16(ah, bl, acc, 0, 0, 0);
            asm volatile("" ::: "memory"); }
        float lg[4], mx = -3.0e38f;
#pragma unroll
        for (int r = 0; r < 4; ++r) { lg[r] = acc[r] + br[r]; mx = fmaxf(mx, lg[r]); }
        mx = fmaxf(mx, __shfl_xor(mx, 16)); mx = fmaxf(mx, __shfl_xor(mx, 32));
        float sum = 0.f;
#pragma unroll
        for (int r = 0; r < 4; ++r) { lg[r] = __expf(lg[r] - mx); sum += lg[r]; }
        sum += __shfl_xor(sum, 16); sum += __shfl_xor(sum, 32);
        const float inv = 1.0f / sum; const int s = (m0 + n) & (SEQ - 1);
#pragma unroll
        for (int r = 0; r < 4; ++r) probs[((size_t)(b * NE + 4 * kq + r)) * SEQ + s] = lg[r] * inv; }
}
__device__ __forceinline__ void topk_item(const float* probs, int* idx, float* val, int* slot, LAS unsigned char* lds, int item, int tid, int wave, int lane) {
    const int e = item >> 1, b = item & 1;
    LAS int* red = (LAS int*)lds;
    unsigned p[16];
#pragma unroll
    for (int q = 0; q < 4; ++q) { const v4u w = *(const GAS v4u*)(probs + ((size_t)(b * NE + e)) * SEQ + 16 * tid + 4 * q); p[4 * q] = w.x; p[4 * q + 1] = w.y; p[4 * q + 2] = w.z; p[4 * q + 3] = w.w; }
    unsigned prefix = 0u;
    for (int bit = 30; bit >= 0; --bit) { const unsigned cand = prefix | (1u << bit); int cnt = 0;
#pragma unroll
        for (int j = 0; j < 16; ++j) cnt += __popcll(__ballot(p[j] >= cand));
        const int par = bit & 1;
        if (lane == 0) red[par * 8 + wave] = cnt;
        __syncthreads();
        int tot = 0;
#pragma unroll
        for (int w = 0; w < 8; ++w) tot += red[par * 8 + w];
        if (tot >= CAP) prefix = cand; }
    const unsigned T = prefix;
    int cgt = 0, ceq = 0;
#pragma unroll
    for (int j = 0; j < 16; ++j) { cgt += (p[j] > T) ? 1 : 0; ceq += (p[j] == T) ? 1 : 0; }
    int sgt = cgt, seq = ceq;
#pragma unroll
    for (int o = 1; o < 64; o <<= 1) { const int a = __shfl_up(sgt, o), c = __shfl_up(seq, o); if (lane >= o) { sgt += a; seq += c; } }
    __syncthreads();
    if (lane == 63) { red[32 + wave] = sgt; red[48 + wave] = seq; }
    __syncthreads();
    int bgt = 0, beq = 0, totgt = 0;
#pragma unroll
    for (int w = 0; w < 8; ++w) { const int a = red[32 + w], c = red[48 + w]; if (w < wave) { bgt += a; beq += c; } totgt += a; }
    int rgt = bgt + sgt - cgt, req = beq + seq - ceq;
    const int need = CAP - totgt; const int rbase = (e * 2 + b) * CAP;
#pragma unroll
    for (int j = 0; j < 16; ++j) { const int tok = b * SEQ + 16 * tid + j; int sl = -1;
        if (p[j] > T) { sl = rgt; ++rgt; } else if (p[j] == T) { if (req < need) sl = totgt + req; ++req; }
        slot[(size_t)tok * NE + e] = sl;
        if (sl >= 0) { idx[rbase + sl] = tok; val[rbase + sl] = __uint_as_float(p[j]); } }
    __syncthreads();
}
__device__ __forceinline__ void phase_gather(const bf16* H2, const int* idx, bf16* XE, int wave, int lane, int vcu, int G) {
    const int gw = vcu * NWAVES + wave, NGW = G * NWAVES;
    for (int r = gw; r < MR; r += NGW) { const int tok = idx[r];
        const GAS v4u* src = (const GAS v4u*)(H2 + (size_t)tok * D) + lane; GAS v4u* dst = (GAS v4u*)(XE + (size_t)r * D) + lane;
        const v4u a = src[0], b2 = src[64]; dst[0] = a; dst[64] = b2; }
}
__device__ __forceinline__ void phase_final(float* out, const bf16* X1B, const bf16* Y, const int* slot, const float* mod, const float* g_fin, int wave, int lane, int vcu, int G, float pert) {
    const int gw = vcu * NWAVES + wave, NGW = G * NWAVES;
    int slv[2]; v2u xw[2][4];
#define PF_FETCH(mm) do { _Pragma("unroll") for (int r = 0; r < 2; ++r) { slv[r] = slot[(size_t)((mm) + r) * NE + (lane & 15)]; const GAS v2u* xr_ = (const GAS v2u*)(X1B + (size_t)((mm) + r) * D) + lane; \
        _Pragma("unroll") for (int j = 0; j < 4; ++j) xw[r][j] = xr_[64 * j]; } } while (0)
    int m0 = gw * 2;
    if (m0 < M) PF_FETCH(m0);
    for (; m0 < M; m0 += NGW * 2) { const int b = m0 >> 13;
        int cs[2]; f32x4 v[2][4], a[2][4];
#pragma unroll
        for (int r = 0; r < 2; ++r) { cs[r] = slv[r];
#pragma unroll
            for (int j = 0; j < 4; ++j) { const v2u w = xw[r][j]; v[r][j] = (f32x4){bf_lo(w.x), bf_hi(w.x), bf_lo(w.y), bf_hi(w.y)}; a[r][j] = (f32x4){0.f, 0.f, 0.f, 0.f}; } }
        const int mn = m0 + NGW * 2;
        if (mn < M) PF_FETCH(mn);
        unsigned long long mask[2]; bool more = false;
#pragma unroll
        for (int r = 0; r < 2; ++r) mask[r] = __ballot(cs[r] >= 0) & 0xFFFFull;
        do { const GAS v2u* yp[2][4]; bool ok[2][4]; v2u w[2][4][4];
#pragma unroll
            for (int r = 0; r < 2; ++r)
#pragma unroll
                for (int c = 0; c < 4; ++c) { ok[r][c] = (mask[r] != 0ull); const int e = ok[r][c] ? (int)__builtin_ctzll(mask[r]) : 0; mask[r] &= (mask[r] - 1ull);
                    const int sl = __builtin_amdgcn_readlane(cs[r], e); yp[r][c] = (const GAS v2u*)(Y + ((size_t)(e * 2 + b) * CAP + (ok[r][c] ? sl : 0)) * D) + lane; }
#pragma unroll
            for (int r = 0; r < 2; ++r)
#pragma unroll
                for (int c = 0; c < 4; ++c) if (ok[r][c]) {
#pragma unroll
                    for (int j = 0; j < 4; ++j) w[r][c][j] = yp[r][c][64 * j]; }
#pragma unroll
            for (int r = 0; r < 2; ++r)
#pragma unroll
                for (int c = 0; c < 4; ++c) if (ok[r][c]) {
#pragma unroll
                    for (int j = 0; j < 4; ++j) { a[r][j].x += bf_lo(w[r][c][j].x); a[r][j].y += bf_hi(w[r][c][j].x); a[r][j].z += bf_lo(w[r][c][j].y); a[r][j].w += bf_hi(w[r][c][j].y); } }
            more = (mask[0] | mask[1]) != 0ull;
        } while (more);
        float s[2];
#pragma unroll
        for (int r = 0; r < 2; ++r) { s[r] = 0.f;
#pragma unroll
            for (int j = 0; j < 4; ++j) { const f32x4 gf = *(const GAS f32x4*)(mod + b * 6 * D + 5 * D + 4 * lane + 256 * j); v[r][j] = v[r][j] + gf * a[r][j]; s[r] += (v[r][j].x * v[r][j].x + v[r][j].y * v[r][j].y) + (v[r][j].z * v[r][j].z + v[r][j].w * v[r][j].w); } }
#pragma unroll
        for (int o = 1; o < 64; o <<= 1) { s[0] += __shfl_xor(s[0], o); s[1] += __shfl_xor(s[1], o); }
#pragma unroll
        for (int r = 0; r < 2; ++r) { const float rr = rsqrtf(s[r] * (1.f / D) + RMS_EPS); GAS f32x4* xo = (GAS f32x4*)(out + (size_t)(m0 + r) * D) + lane;
#pragma unroll
            for (int j = 0; j < 4; ++j) { const f32x4 gg = *(const GAS f32x4*)(g_fin + 4 * lane + 256 * j); xo[64 * j] = v[r][j] * rr * gg + pert; } } }
#undef PF_FETCH
}
__device__ __forceinline__ void fft_item(LAS unsigned char* lds, const bf16* UF, bf16* ZF, const bf16* Fc1, const bf16* Fc2, int item, int wave, int lane) {
    const char* slab = (const char*)UF + (size_t)item * 65536;
    { v4u xv[8];
#pragma unroll
      for (int p = 0; p < 8; ++p) { const int s1 = 8 * p + wave; xv[p] = *(const GAS v4u*)(slab + s1 * 1024 + ((16 * lane - 32 * ((s1 >> 3) & 3)) & 1023)); }
#pragma unroll
      for (int p = 0; p < 8; ++p) *(LAS v4u*)(lds + (8 * p + wave) * 1024 + 16 * lane) = xv[p]; }
    bf16x8 A2[2][8];
#pragma unroll
    for (int ro = 0; ro < 2; ++ro)
#pragma unroll
        for (int kk = 0; kk < 8; ++kk) A2[ro][kk] = *(const GAS bf16x8*)(Fc2 + ((size_t)(((wave * 2 + ro) * 8 + kk) * 64 + lane)) * 8);
    LDS_WAIT(); __syncthreads();
    const int fr = lane & 15, fq = lane >> 4, ch = lane & 3, s2l = (lane & 15) >> 2;
    char* zb = (char*)ZF + (size_t)item * 131072;
    for (int hh = 0; hh < 2; ++hh) {
        { bf16x8 A1[4][2];
#pragma unroll
          for (int mt = 0; mt < 4; ++mt)
#pragma unroll
              for (int kk = 0; kk < 2; ++kk) A1[mt][kk] = *(const GAS bf16x8*)(Fc1 + ((size_t)(((hh * 4 + mt) * 2 + kk) * 64 + lane)) * 8);
          for (int jn = 0; jn < 4; ++jn) { const int nt = wave + 8 * jn, s2 = 4 * nt + s2l;
            bf16x8 Bx[2];
#pragma unroll
            for (int kk = 0; kk < 2; ++kk)
#pragma unroll
                for (int j = 0; j < 8; ++j) { const int s1 = 32 * kk + 8 * fq + j; Bx[kk][j] = *(const LAS short*)(lds + s1 * 1024 + ((s2 * 8 + ch * 2 + 32 * fq) & 1023)); }
            f32x4 acc[4];
#pragma unroll
            for (int mt = 0; mt < 4; ++mt) { acc[mt] = (f32x4){0.f, 0.f, 0.f, 0.f};
#pragma unroll
                for (int kk = 0; kk < 2; ++kk) acc[mt] = __builtin_amdgcn_mfma_f32_16x16x32_bf16(A1[mt][kk], Bx[kk], acc[mt], 0, 0, 0); }
#pragma unroll
            for (int blk = 0; blk < 2; ++blk)
#pragma unroll
                for (int r = 0; r < 4; ++r) { const int k1l = 16 * blk + 4 * r + fq, k1 = 32 * hh + k1l; const float dr = acc[blk][r], di = acc[2 + blk][r];
                    const float frac = (float)((s2 * k1) & 8191) * (1.0f / 8192.0f), c = __builtin_amdgcn_cosf(frac), s = __builtin_amdgcn_sinf(frac);
                    *(LAS unsigned*)(lds + FFT_TOFF + (k1l * 4 + ch) * FFT_TPITCH + s2 * 4) = cvt_pk_bf16(dr * c + di * s, di * c - dr * s); } } }
        LDS_WAIT(); __syncthreads();
        for (int nt2 = 0; nt2 < 8; ++nt2) { f32x4 c0 = {0.f, 0.f, 0.f, 0.f}, c1 = {0.f, 0.f, 0.f, 0.f};
#pragma unroll
            for (int kk = 0; kk < 8; ++kk) { const bf16x8 Bt = *(const LAS bf16x8*)(lds + FFT_TOFF + (16 * nt2 + fr) * FFT_TPITCH + kk * 64 + fq * 16);
                c0 = __builtin_amdgcn_mfma_f32_16x16x32_bf16(A2[0][kk], Bt, c0, 0, 0, 0); c1 = __builtin_amdgcn_mfma_f32_16x16x32_bf16(A2[1][kk], Bt, c1, 0, 0, 0); }
            const int k1 = 32 * hh + 4 * nt2 + s2l;
#pragma unroll
            for (int r = 0; r < 4; ++r) { const int k = k1 + 64 * (16 * wave + 4 * fq + r); *(GAS unsigned*)(zb + (size_t)k * 16 + ch * 4) = cvt_pk_bf16(c0[r], c1[r]); } }
        LDS_WAIT(); __syncthreads();
    }
}
#if MOE_FP8
#define EXPERT_ITEM(r_) do { const int e_ = (r_) / 3072, q_ = (r_) % 3072; \
    if (q_ < 1024) transpose_item8<2>(w_g + (size_t)e_ * D * DE, D, DE, WGU8 + (size_t)e_ * 4096 * D, scr, q_, lane); \
    else if (q_ < 2048) transpose_item8<3>(w_u + (size_t)e_ * D * DE, D, DE, WGU8 + (size_t)e_ * 4096 * D, scr, q_ - 1024, lane); \
    else transpose_item8<0>(w_d + (size_t)e_ * DE * D, DE, D, WD8 + (size_t)e_ * D * DE, scr, q_ - 2048, lane); } while (0)
#else
#define EXPERT_ITEM(r_) do { const int e_ = (r_) / 3072, q_ = (r_) % 3072; \
    if (q_ < 1024) transpose_item<2>(w_g + (size_t)e_ * D * DE, D, DE, WGU + (size_t)e_ * 4096 * D, scr, q_, lane); \
    else if (q_ < 2048) transpose_item<3>(w_u + (size_t)e_ * D * DE, D, DE, WGU + (size_t)e_ * 4096 * D, scr, q_ - 1024, lane); \
    else transpose_item<0>(w_d + (size_t)e_ * DE * D, DE, D, WD + (size_t)e_ * D * DE, scr, q_ - 2048, lane); } while (0)
#endif
#ifndef EXP_P2
#define EXP_P2 10240
#endif
#ifndef EXP_P7
#define EXP_P7 14336
#endif
#ifndef EXP_P6
#define EXP_P6 16384
#endif
constexpr int EXP_TOTAL = NE * 3072, EXP_P0 = EXP_TOTAL - EXP_P2 - EXP_P7 - EXP_P6;

constexpr int NPHASE = 12;
#ifndef MOE_ALIGN
#define MOE_ALIGN true
#endif
#ifndef EXTRA_BARS
#define EXTRA_BARS 0
#endif
#ifndef STAGGER_US
#define STAGGER_US 0
#endif
#ifndef DOUBLE_PH
#define DOUBLE_PH -1
#endif
#define REP(k) for (int rep_ = 0; rep_ < ((DOUBLE_PH == (k)) ? 2 : 1); ++rep_)
#define REPBAR(k) do { if (DOUBLE_PH == (k) && rep_ == 0) xcd_barrier(bar); } while (0)
#ifndef PROBE_I
#define PROBE_I -1
#endif
#ifndef PROBE_J
#define PROBE_J -1
#endif
#ifndef DBG_PLAIN
#define DBG_PLAIN 0
#endif
#ifndef GALIGN
#define GALIGN true
#endif
#ifndef GSP2
#define GSP2 true
#endif
struct Args { const float* in[18]; float* out; unsigned char* ws; int ph_lo, ph_hi; };
__global__ void __launch_bounds__(NWAVES * 64, 2) fwd(Args args) {
    extern __shared__ __attribute__((aligned(16))) unsigned char lds_raw[];
    LAS unsigned char* lds = (LAS unsigned char*)lds_raw;
    volatile LAS unsigned* MISC = (volatile LAS unsigned*)(lds + MISC_OFF);
    const int tid = threadIdx.x, lane = tid & 63, wave = __builtin_amdgcn_readfirstlane(tid >> 6);
    const int G = gridDim.x; const int bx = blockIdx.x; const int vcu = (G % 8 == 0) ? (bx % 8) * (G / 8) + bx / 8 : bx;
    unsigned char* ws = args.ws;
    const float *x = args.in[0], *c = args.in[1], *w_ada = args.in[2], *b_ada = args.in[3], *g_mix = args.in[4], *w_in = args.in[5], *b_gate = args.in[6], *w_f = args.in[7], *w_conv = args.in[8],
                *w_co = args.in[9], *w_o = args.in[10], *g_moe = args.in[11], *w_r = args.in[12], *b_r = args.in[13], *w_g = args.in[14], *w_u = args.in[15], *w_d = args.in[16], *g_fin = args.in[17];
    float* out = args.out;
    float *modp = (float*)(ws + WS_MODP), *mod = (float*)(ws + WS_MOD), *probs = (float*)(ws + WS_PROBS), *val = (float*)(ws + WS_VAL);
    int *slot = (int*)(ws + WS_SLOT), *idx = (int*)(ws + WS_IDX);
    bf16 *Fc1 = (bf16*)(ws + WS_FC1), *Fc2 = (bf16*)(ws + WS_FC2), *WIN = (bf16*)(ws + WS_WIN), *WF = (bf16*)(ws + WS_WF), *WCO = (bf16*)(ws + WS_WCO), *WO = (bf16*)(ws + WS_WO), *WGU = (bf16*)(ws + WS_WGU), *WD = (bf16*)(ws + WS_WD);
    bf16 *H1 = (bf16*)(ws + WS_H1), *AB = (bf16*)(ws + WS_AB), *UF = (bf16*)(ws + WS_UF), *CV = (bf16*)(ws + WS_CV), *BG = (bf16*)(ws + WS_BG), *GA = (bf16*)(ws + WS_GA), *GB = (bf16*)(ws + WS_GB), *ZF = (bf16*)(ws + WS_ZF),
         *TZ = (bf16*)(ws + WS_TZ), *H2 = (bf16*)(ws + WS_H2), *HM = (bf16*)(ws + WS_HM), *Y = (bf16*)(ws + WS_Y), *X1B = (bf16*)(ws + WS_X1B);
    unsigned char *WGU8 = ws + WS_WGU, *WD8 = ws + WS_WD, *H2F8 = ws + WS_H2, *HM8 = ws + WS_HM;
    for (int u = tid; u < (LDS_BYTES - MISC_OFF) / 4; u += NWAVES * 64) ((LAS unsigned*)(lds + MISC_OFF))[u] = 0u;
    __syncthreads();
    const int lo = args.ph_lo, hi = args.ph_hi;
    XcdBarrier bar; bar.bar = (unsigned*)(ws + WS_CTL) + CW_BAR; bar.x = 0; bar.st = nullptr;
    if (hi - lo > 1) bar = xcd_barrier_post((unsigned*)(ws + WS_CTL) + CW_BAR, MISC + 8);
#define IN(k) (lo <= (k) && (k) < hi)
#if PROBE_I >= 0
    unsigned long long* tsb = (unsigned long long*)(ws + WS_CTL + 512 * 1024);
    if (bx == 0 && tid == 0) tsb[0] = __builtin_amdgcn_s_memrealtime();
#define GRID_BAR(k) do { if (IN(k) && IN((k) + 1)) xcd_barrier(bar); if (bx == 0 && tid == 0) tsb[(k) + 1] = __builtin_amdgcn_s_memrealtime(); } while (0)
#else
#define GRID_BAR(k) do { if (IN(k) && IN((k) + 1)) xcd_barrier(bar); } while (0)
#endif
    const int gw = vcu * NWAVES + wave, NGW = G * NWAVES;
    LAS float* scr = (LAS float*)(lds + wave * 16384);

    if (IN(0)) REP(0) {
        if (vcu < 96) mod_item(c, w_ada, modp, lds, vcu, tid, wave, lane);
#if PROBE_I >= 0
        if (bx == 0 && tid == 0) tsb[22] = __builtin_amdgcn_s_memrealtime();
#endif
        fc_tables(Fc1, Fc2, vcu * NWAVES * 64 + tid, G * NWAVES * 64);
#if PROBE_I >= 0
        if (bx == 0 && tid == 0) tsb[23] = __builtin_amdgcn_s_memrealtime();
#endif
        constexpr int I_WF = 2048, I_IN = 16 * 176, I_SQ = 16 * 32, I_EX = 3072, NITEMS = I_WF + I_IN + 2 * I_SQ + NE * I_EX;
        if (vcu >= 96) { const int w0 = (vcu - 96) * NWAVES + wave, nw0 = (G - 96) * NWAVES;
            for (int r = w0; r < I_WF; r += nw0) wf_item(w_f, WF, r, lane); }
        for (int it = I_WF + gw; it < NITEMS; it += NGW) {
            int r = it - I_WF;
            if (r < I_IN) { transpose_item<1>(w_in, D, DIN, WIN, scr, r, lane); continue; } r -= I_IN;
            if (r < I_SQ) { transpose_item<0>(w_co, D, D, WCO, scr, r, lane); continue; } r -= I_SQ;
            if (r < I_SQ) { transpose_item<0>(w_o, D, D, WO, scr, r, lane); continue; } r -= I_SQ;
            if (r >= EXP_P0) continue;
            EXPERT_ITEM(r);
        }
#if PROBE_I >= 0
        asm volatile("s_waitcnt vmcnt(0)" ::: "memory"); __syncthreads(); if (bx == 0 && tid == 0) tsb[24] = __builtin_amdgcn_s_memrealtime();
#endif
        GRID_BAR(0);
    }
    if (IN(1)) REP(1) { phase_h(x, g_mix, b_ada, modp, mod, H1, lds, tid, wave, lane, vcu, G); GRID_BAR(1); }
#if EXTRA_BARS > 0
    if (IN(1) && IN(2)) { for (int eb = 0; eb < EXTRA_BARS; ++eb) xcd_barrier(bar); }
#endif
    if (IN(2)) REP(2) {
#if STAGGER_US > 0
        if (bx >= 128) { const unsigned long long t0 = __builtin_amdgcn_s_memrealtime(); while (__builtin_amdgcn_s_memrealtime() - t0 < (unsigned long long)(STAGGER_US * 100)) __builtin_amdgcn_s_sleep(8); }
#endif
        pg8::Gemm g{H1, WIN, M, DIN, D, 0, 0, nullptr}; pg8::StaticOrder S; S.init(M, DIN, G, bx);
#if DBG_PLAIN
        EpiPlain E{UF, DIN};
        pg8::gemm_phase<EpiPlain, pg8::StaticOrder, 0, GALIGN, GSP2>(lds, g, S, E);
#else
        EpiInProj E{UF, CV, BG, GA, GB, b_gate};
        pg8::gemm_phase<EpiInProj, pg8::StaticOrder, 0, GALIGN, GSP2>(lds, g, S, E);
#endif
        if (bx >= G / 2) { const int w2 = (bx - G / 2) * NWAVES + wave, nw2 = (G - G / 2) * NWAVES;
            for (int r = EXP_P0 + EXP_P6 + w2; r < EXP_P0 + EXP_P6 + EXP_P2; r += nw2) EXPERT_ITEM(r); }
        GRID_BAR(2);
    }
    if (IN(3)) REP(3) {
        if (bx & 1) phase_conv(CV, BG, w_conv, AB, wave, lane, vcu, G);
        for (int it = vcu; it < BATCH * 128; it += G) fft_item(lds, UF, ZF, Fc1, Fc2, it, wave, lane);
#if PROBE_I >= 0
        __syncthreads(); if (bx == 0 && tid == 0) tsb[20] = __builtin_amdgcn_s_memrealtime();
#endif
        if (!(bx & 1)) phase_conv(CV, BG, w_conv, AB, wave, lane, vcu, G);
#if PROBE_I >= 0
        asm volatile("s_waitcnt vmcnt(0)" ::: "memory"); __syncthreads(); if (bx == 0 && tid == 0) tsb[21] = __builtin_amdgcn_s_memrealtime();
#endif
        GRID_BAR(3);
    }
    if (IN(4)) REP(4) {
        { pg8::Gemm g{ZF, WF, M, D, D, 0, 0, nullptr}; pg8::StaticOrder S; S.init(M, D, G, bx); EpiGateMul<0> E{TZ, GA};
          pg8::gemm_phase<EpiGateMul<0>, pg8::StaticOrder, 1, true, true>(lds, g, S, E); }
        { pg8::Gemm g{AB, WCO, M, D, D, 0, 0, nullptr}; pg8::StaticOrder S; S.init(M, D, G, bx); EpiGateMul<1> E{TZ, GB};
          pg8::gemm_phase<EpiGateMul<1>, pg8::StaticOrder, 0, true, true>(lds, g, S, E); }
        GRID_BAR(4);
    }
    if (IN(5)) REP(5) {
        pg8::Gemm g{TZ, WO, M, D, D, 0, 0, nullptr}; pg8::StaticOrder S; S.init(M, D, G, bx); EpiResid E{x, X1B, mod + 2 * D};
        pg8::gemm_phase<EpiResid, pg8::StaticOrder, 0, true, true>(lds, g, S, E);
        GRID_BAR(5);
    }
    if (IN(6)) REP(6) { phase_h2(X1B, g_moe, mod, w_r, b_r, H2, H2F8, probs, lds, tid, wave, lane, vcu, G);
        if (wave >= 4) { LAS float* scr6 = (LAS float*)(lds + 81920 + (wave - 4) * 8448);
            const int w6 = vcu * 4 + (wave - 4), nw6 = G * 4; LAS float* scr = scr6;
            for (int r = EXP_P0 + w6; r < EXP_P0 + EXP_P6; r += nw6) EXPERT_ITEM(r); }
        __syncthreads(); GRID_BAR(6); }
    if (IN(7)) REP(7) { for (int it = vcu; it < NE * BATCH; it += G) topk_item(probs, idx, val, slot, lds, it, tid, wave, lane);
        if (vcu >= NE * BATCH) { const int w7 = (vcu - NE * BATCH) * NWAVES + wave, nw7 = (G - NE * BATCH) * NWAVES;
            for (int r = EXP_P0 + EXP_P6 + EXP_P2 + w7; r < EXP_TOTAL; r += nw7) EXPERT_ITEM(r); }
        GRID_BAR(7); }
    if (IN(9)) REP(9) {
#if MOE_FP8
        pg8::Gemm g{(const bf16*)H2F8, (const bf16*)WGU8, MR, 2 * DE, D / 2, 8, (size_t)2 * DE * D / 2, idx}; pg8::StaticOrder S; S.init(MR, 2 * DE, G, bx); EpiSwiGLU8 E{HM8};
        pg8::gemm_phase<EpiSwiGLU8, pg8::StaticOrder, 2, MOE_ALIGN, true, true>(lds, g, S, E);
#else
        pg8::Gemm g{H2, WGU, MR, 2 * DE, D, 8, (size_t)2 * DE * D, idx}; pg8::StaticOrder S; S.init(MR, 2 * DE, G, bx); EpiSwiGLU E{HM};
        pg8::gemm_phase<EpiSwiGLU, pg8::StaticOrder, 2, true, true>(lds, g, S, E);
#endif
        GRID_BAR(9);
    }
    if (IN(10)) REP(10) {
#if MOE_FP8
        pg8::Gemm g{(const bf16*)HM8, (const bf16*)WD8, MR, D, DE / 2, 8, (size_t)D * DE / 2, nullptr}; pg8::StaticOrder S; S.init(MR, D, G, bx); EpiRowScale E{Y, val};
        pg8::gemm_phase<EpiRowScale, pg8::StaticOrder, 0, MOE_ALIGN, true, true>(lds, g, S, E);
#else
        pg8::Gemm g{HM, WD, MR, D, DE, 8, (size_t)D * DE, nullptr}; pg8::StaticOrder S; S.init(MR, D, G, bx); EpiRowScale E{Y, val};
        pg8::gemm_phase<EpiRowScale, pg8::StaticOrder, 0, true, true>(lds, g, S, E);
#endif
#if PROBE_I >= 0
        if (bx == 0 && tid == 0) tsb[12] = __builtin_amdgcn_s_memrealtime();
#endif
        GRID_BAR(10);
    }
#if PROBE_I >= 0
    float pert = 0.f;
    if (IN(11)) { const unsigned long long a0 = __hip_atomic_load(tsb + (PROBE_I == 100 ? 0 : PROBE_I == 9 ? 8 : PROBE_I), __ATOMIC_RELAXED, __HIP_MEMORY_SCOPE_AGENT), a1 = __hip_atomic_load(tsb + (PROBE_I == 100 ? 12 : PROBE_I == 10 ? 12 : PROBE_I + 1), __ATOMIC_RELAXED, __HIP_MEMORY_SCOPE_AGENT); pert = (float)(a1 - a0) * 0.01f * (PROBE_I == 100 ? (1.0f / 64000.0f) : (1.0f / 16000.0f)); }
    if (PROBE_I == 102) { pert = 0.f; if (bx == 0 && tid == 0) tsb[14] = __builtin_amdgcn_s_memrealtime(); __syncthreads(); }
    if (PROBE_I >= 310 && PROBE_I <= 313) { pert = 0.f; if (bx == 0) { const int ia = (PROBE_I == 310 ? 0 : PROBE_I == 311 ? 22 : PROBE_I == 312 ? 23 : 24), ib = (PROBE_I == 310 ? 22 : PROBE_I == 311 ? 23 : PROBE_I == 312 ? 24 : 1);
        const unsigned long long a0 = __hip_atomic_load(tsb + ia, __ATOMIC_RELAXED, __HIP_MEMORY_SCOPE_AGENT), a1 = __hip_atomic_load(tsb + ib, __ATOMIC_RELAXED, __HIP_MEMORY_SCOPE_AGENT); pert = (float)(a1 - a0) * 0.01f * (1.0f / 250.0f); } }
    else if (PROBE_I == 300 || PROBE_I == 301 || PROBE_I == 302) { pert = 0.f; if (bx == 0) { const unsigned long long a0 = __hip_atomic_load(tsb + (PROBE_I == 300 ? 3 : PROBE_I == 301 ? 20 : 21), __ATOMIC_RELAXED, __HIP_MEMORY_SCOPE_AGENT), a1 = __hip_atomic_load(tsb + (PROBE_I == 300 ? 20 : PROBE_I == 301 ? 21 : 4), __ATOMIC_RELAXED, __HIP_MEMORY_SCOPE_AGENT); pert = (float)(a1 - a0) * 0.01f * (1.0f / 250.0f); } }
    else if (PROBE_I >= 200) { pert = 0.f; if (bx == 0) { const int k_ = PROBE_I - 200; const unsigned long long a0 = __hip_atomic_load(tsb + (k_ == 9 ? 8 : k_), __ATOMIC_RELAXED, __HIP_MEMORY_SCOPE_AGENT), a1 = __hip_atomic_load(tsb + k_ + 1, __ATOMIC_RELAXED, __HIP_MEMORY_SCOPE_AGENT); pert = (float)(a1 - a0) * 0.01f * (1.0f / 250.0f); } }
    if (PROBE_I == 101) { pert = 0.f; if (bx == 0) { const unsigned long long a0 = __hip_atomic_load(tsb + 12, __ATOMIC_RELAXED, __HIP_MEMORY_SCOPE_AGENT); pert = (float)(__builtin_amdgcn_s_memrealtime() - a0) * 0.01f * (1.0f / 250.0f); } }
    if (IN(11)) phase_final(out, X1B, Y, slot, mod, g_fin, wave, lane, vcu, G, pert);
    if (PROBE_I == 102) {
        const unsigned long long t_a = tsb[14];
        xcd_barrier(bar);
        if (bx == 0) { const float pp = (float)(__builtin_amdgcn_s_memrealtime() - t_a) * 0.01f * (1.0f / 250.0f);
            for (int k = 0; k < 4; ++k) for (int r = 0; r < 2; ++r) { float* row = out + (size_t)(2 * (vcu * NWAVES + wave) + r + 4096 * k) * D; for (int cc = lane; cc < D; cc += 64) row[cc] += pp; } } }
#else
    if (IN(11)) REP(11) { phase_final(out, X1B, Y, slot, mod, g_fin, wave, lane, vcu, G, 0.f); if (DOUBLE_PH == 11 && rep_ == 0) xcd_barrier(bar); }
#endif

#undef IN
#undef GRID_BAR
}


struct DumpArgs { const unsigned short* p[8]; unsigned long long n[8]; int f32[8]; int nb; int pad; };
__global__ void k_dump(float* out, DumpArgs a) {
    const size_t i = (size_t)blockIdx.x * blockDim.x + threadIdx.x; float s = 0.f;
    for (int b = 0; b < a.nb; ++b) for (size_t j = i; j < a.n[b]; j += (size_t)M * D) s += (a.f32[b] ? ((const float*)a.p[b])[j] : __uint_as_float(((unsigned)a.p[b][j]) << 16)) * (float)(b + 1);
    out[i] = s;
}
#ifndef DUMP_WHICH
#define DUMP_WHICH -1
#endif
#ifndef STOP_AFTER
#define STOP_AFTER (NPHASE - 1)
#endif
#ifndef MK_PER_PHASE
#define MK_PER_PHASE 0
#endif
extern "C" void kernel_launch(void* const* d_in, const int* in_sizes, int n_in, void* d_out, int out_size, void* d_ws, size_t ws_size, hipStream_t stream) {
    static int grid = 0;
    if (grid == 0) {
        if (n_in != 18 || in_sizes[0] != M * D || out_size != M * D || ws_size < WS_END) { fprintf(stderr, "kernel_launch: unexpected shapes (n_in %d, in0 %d, out %d, ws %zu); nothing launched\n", n_in, n_in > 0 ? in_sizes[0] : -1, out_size, ws_size); grid = -1; return; }
        int dev = 0, cus = 0, per_cu = 0;
        if (hipGetDevice(&dev) != hipSuccess || hipDeviceGetAttribute(&cus, hipDeviceAttributeMultiprocessorCount, dev) != hipSuccess) { grid = -1; return; }
        if (hipFuncSetAttribute((const void*)fwd, hipFuncAttributeMaxDynamicSharedMemorySize, LDS_BYTES) != hipSuccess) { fprintf(stderr, "kernel_launch: hipFuncSetAttribute failed\n"); grid = -1; return; }
        if (hipOccupancyMaxActiveBlocksPerMultiprocessor(&per_cu, (const void*)fwd, NWAVES * 64, LDS_BYTES) != hipSuccess || per_cu < 1) { fprintf(stderr, "kernel_launch: occupancy query reports %d blocks per CU\n", per_cu); }
        (void)hipGetLastError();
        grid = cus;
    }
    if (grid < 0) return;
    (void)hipMemsetAsync((char*)d_ws + WS_CTL, 0, CTL_ZERO_BYTES, stream);
    Args a{};
    for (int i = 0; i < 18; ++i) a.in[i] = (const float*)d_in[i];
    a.out = (float*)d_out; a.ws = (unsigned char*)d_ws;
#if MK_PER_PHASE
    for (int p = 0; p < STOP_AFTER + 1; ++p) { a.ph_lo = p; a.ph_hi = p + 1; hipLaunchKernelGGL(fwd, dim3(grid), dim3(NWAVES * 64), LDS_BYTES, stream, a); }
#if DUMP_WHICH >= 0
    { DumpArgs da{}; unsigned char* w = (unsigned char*)d_ws; int nb = 0;
      auto add = [&](size_t off, size_t n, int isf = 0) { da.p[nb] = (const unsigned short*)(w + off); da.n[nb] = n; da.f32[nb] = isf; ++nb; };
      if (DUMP_WHICH == 0) { add(WS_WIN, (size_t)DIN * D); add(WS_WF, (size_t)D * D); add(WS_WCO, (size_t)D * D); add(WS_WO, (size_t)D * D); add(WS_WGU, (size_t)NE * 4096 * D); add(WS_WD, (size_t)NE * D * DE); add(WS_FC1, 8192 + 0); add(WS_MODP, 4 * 2 * 6 * D, 1); }
      if (DUMP_WHICH == 1) { add(WS_H1, (size_t)M * D); add(WS_MOD, 2 * 6 * D, 1); add(WS_FC2, 65536); }
      if (DUMP_WHICH == 2) { add(WS_UF, (size_t)M * DF); add(WS_CV, (size_t)M * D); add(WS_BG, (size_t)M * D); add(WS_GA, (size_t)M * D); add(WS_GB, (size_t)M * D); }
      if (DUMP_WHICH == 5) { add(WS_UF, (size_t)M * DIN); }
      if (DUMP_WHICH == 6) { add(WS_UF, (size_t)M * DF); add(WS_CV, (size_t)M * D); }
      if (DUMP_WHICH == 7) { add(WS_BG, (size_t)M * D); }
      if (DUMP_WHICH == 8) { add(WS_GA, (size_t)M * D); add(WS_GB, (size_t)M * D); }
      if (DUMP_WHICH == 9) { add(WS_GA, (size_t)M * D); }
      if (DUMP_WHICH == 10) { add(WS_GB, (size_t)M * D); }
      if (DUMP_WHICH == 3) { add(WS_ZF, (size_t)M * D); add(WS_AB, (size_t)M * D); }
      if (DUMP_WHICH == 4) { add(WS_TZ, (size_t)M * D); }
      da.nb = nb; hipLaunchKernelGGL(k_dump, dim3(M * D / 256), dim3(256), 0, stream, (float*)d_out, da); }
#endif
#else
    a.ph_lo = 0; a.ph_hi = NPHASE; hipLaunchKernelGGL(fwd, dim3(grid), dim3(NWAVES * 64), LDS_BYTES, stream, a);
#endif
}
```

```cpp
#include <hip/hip_runtime.h>
#include <cstdio>
#include <cstdint>
#define MK_PER_PHASE 0
#define STOP_AFTER 11
#define DUMP_WHICH -1
#define GALIGN true
#define GSP2 true
#define DBG_PLAIN 0
#define DBG_NOBIAS 0
#define DBG_NOSIG 0
#define PROBE_I -1
#define PROBE_J -1
#define DOUBLE_PH -1
#define STAGGER_US 0
#define EXTRA_BARS 0
#define DBG_EPI2 0
#ifndef DBG_EPI2
#define DBG_EPI2 0
#endif
namespace pg8 {
#define PG8_LAS __attribute__((address_space(3)))
typedef unsigned short bf16_t;
typedef short bf16x8 __attribute__((ext_vector_type(8)));
typedef float f32x4 __attribute__((ext_vector_type(4)));
typedef unsigned u32x4 __attribute__((ext_vector_type(4)));
typedef unsigned u32x2 __attribute__((ext_vector_type(2)));
typedef int v8i __attribute__((ext_vector_type(8)));
typedef int v4i __attribute__((ext_vector_type(4)));
constexpr int BM = 256, BK = 64, HALF = 128, HTB = HALF * BK * 2  , STAGE_BYTES = 8 * HTB, NXCD = 8, WGM = 8;

__host__ __device__ __forceinline__ int lds_byte(int r, int c) { const int st = (r >> 4) * 2 + (c >> 5), rr = r & 15, cc = c & 31, ob = rr * 64 + cc * 2; return st * 1024 + (ob ^ (((ob >> 9) & 1) << 5)); }
__host__ __device__ __forceinline__ void stage_rc(int b, int& R, int& C) { const int st = b / 1024, sb = b % 1024, swz = sb ^ (((sb >> 9) & 1) << 5); R = (st >> 1) * 16 + swz / 64; C = (st & 1) * 32 + (swz % 64) / 2; }
__host__ __device__ __forceinline__ int perm32(int rho) { const int n = rho >> 4, i = rho & 15; return 8 * (i >> 2) + 4 * n + (i & 3); }

struct Unit { int pm, pn; };
struct Gemm { const bf16_t* A; const bf16_t* Bt; int M, N, K; int bgrp; size_t bstride; const int* gidx; };

struct StaticOrder {
    int nM, nN, nwg, G, c;
    __host__ __device__ void init(int M, int N, int G_, int c_) { nM = M / BM; nN = N / BM; nwg = nM * nN; G = G_; c = c_; }
    __host__ __device__ bool next(int i, Unit& u) const {
        const long L = (long)i * G + c; if (L >= nwg) return false;
        int wgid = (int)L; { const int q = nwg / NXCD, r = nwg % NXCD, xcd = wgid % NXCD, off = wgid / NXCD; wgid = (xcd < r ? xcd * (q + 1) : r * (q + 1) + (xcd - r) * q) + off; }
        const int nig = WGM * nN, gid = wgid / nig, fm = gid * WGM, gsz = (nM - fm) < WGM ? (nM - fm) : WGM;
        u.pm = fm + ((wgid % nig) % gsz); u.pn = (wgid % nig) / gsz; return true;
    }
    __device__ __forceinline__ void a_ready(const Unit&) const {}
    __device__ __forceinline__ void done(const Unit&) const {}
};

typedef __bf16 bf16x2_t __attribute__((ext_vector_type(2)));
typedef float f32x2_t __attribute__((ext_vector_type(2)));
__device__ __forceinline__ unsigned cvt_pk_bf16(float lo, float hi) { const f32x2_t v = {lo, hi}; const bf16x2_t b = __builtin_convertvector(v, bf16x2_t); return __builtin_bit_cast(unsigned, b); }
__device__ __forceinline__ float bf_lo(unsigned w) { return __uint_as_float(w << 16); }
__device__ __forceinline__ float bf_hi(unsigned w) { return __uint_as_float(w & 0xffff0000u); }
__device__ __forceinline__ float sigm(float v) { return __builtin_amdgcn_rcpf(1.0f + __expf(-v)); }


template <class Epi, class Sched, int AMODE, bool ALIGN_EPI, bool SP2, bool F8 = false>
__device__ __forceinline__ void gemm_phase(PG8_LAS unsigned char* lds, const Gemm g, const Sched& S, const Epi& E) {
    const int tid = threadIdx.x, wid = __builtin_amdgcn_readfirstlane(tid >> 6), lane = tid & 63, wr = wid >> 2, wc = wid & 3, fr = lane & 15, fq = lane >> 4;
    const int K = g.K, nt = K / BK;
    unsigned voffA0[2], voffA1[2], voffB[2]; int gR[2], gC2[2];
#pragma unroll
    for (int i = 0; i < 2; ++i) { int R, C; stage_rc(tid * 16 + i * 8192, R, C); const int Rb = Epi::PERM ? ((R & ~31) + perm32(R & 31)) : R;
        voffB[i] = (unsigned)(Rb * K + C) * 2u; gR[i] = R; gC2[i] = C * 2;
        if (AMODE == 0) { voffA0[i] = (unsigned)(R * K + C) * 2u; voffA1[i] = (unsigned)((R + HALF) * K + C) * 2u; }
        else if (AMODE == 1) { voffA0[i] = (unsigned)((C >> 3) * 8192 + R) * 16u; voffA1[i] = voffA0[i] + (unsigned)HALF * 16u; }
        else { voffA0[i] = 0u; voffA1[i] = 0u; } }
    const size_t kstepB = (size_t)(BK * 2);
    const size_t kstepA = (AMODE == 1) ? (size_t)8 * 8192 * 16 : (size_t)(BK * 2);
    int nidx0[2] = {0, 0}, nidx1[2] = {0, 0}; unsigned voffN0[2] = {0u, 0u}, voffN1[2] = {0u, 0u};
#define PG8_GIDX_LOAD(u) do { if (AMODE == 2) { _Pragma("unroll") for (int _i = 0; _i < 2; ++_i) { \
        const int* _p0 = g.gidx + (size_t)(u).pm * BM + gR[_i]; const int* _p1 = _p0 + HALF; \
        asm volatile("global_load_dword %0, %1, off" : "=v"(nidx0[_i]) : "v"(_p0) : "memory"); asm volatile("global_load_dword %0, %1, off" : "=v"(nidx1[_i]) : "v"(_p1) : "memory"); } } } while (0)
#define PG8_GIDX_USE() do { if (AMODE == 2) { _Pragma("unroll") for (int _i = 0; _i < 2; ++_i) { asm volatile("" : "+v"(nidx0[_i]), "+v"(nidx1[_i])); \
        voffN0[_i] = (unsigned)nidx0[_i] * (unsigned)(K * 2) + (unsigned)gC2[_i]; voffN1[_i] = (unsigned)nidx1[_i] * (unsigned)(K * 2) + (unsigned)gC2[_i]; } } } while (0)
    const size_t hstepB = (size_t)HALF * K * 2;
    const size_t tstepB = 2 * hstepB;
    const unsigned ldsw = (unsigned)wid * 1024u;
    const int aoff = lds_byte(wr * 64 + fr, fq * 8), boff = lds_byte(wc * 32 + fr, fq * 8);
    const int aoff8a = lds_byte(wr * 64 + fr, fq * 16), boff8a = lds_byte(wc * 32 + fr, fq * 16);
#define PG8_ABASE(u) ((const char*)g.A + ((AMODE == 2) ? (size_t)0 : (AMODE == 0) ? (size_t)(u).pm * (size_t)BM * K * 2 : (size_t)((u).pm >> 5) * ((size_t)(K >> 3) * 8192 * 16) + (size_t)((u).pm & 31) * (BM * 16)))
#define PG8_BBASE(u) ((const char*)g.Bt + (g.bgrp ? (size_t)((u).pm / g.bgrp) * g.bstride * 2 : (size_t)0) + (size_t)(u).pn * tstepB)
#define PG8_SA(b, h) (((b) * 2 + (h)) * HTB)
#define PG8_SB(b, h) ((4 + (b) * 2 + (h)) * HTB)
#define PG8_STAGE(bufoff, gbase, voff) do { _Pragma("unroll") for (int _i = 0; _i < 2; ++_i) \
        __builtin_amdgcn_global_load_lds((const unsigned*)((const char*)(gbase) + (voff)[_i]), (PG8_LAS unsigned*)(lds + (bufoff) + ldsw + _i * 8192), 16, 0, 0); } while (0)
#define PG8_LDA16(dst, b, h) do { _Pragma("unroll") for (int m = 0; m < 4; ++m) _Pragma("unroll") for (int k = 0; k < 2; ++k) dst[m][k] = *(const PG8_LAS bf16x8*)(lds + PG8_SA(b, h) + aoff + m * 2048 + k * 1024); } while (0)
#define PG8_LDB16(dst, b, h) do { _Pragma("unroll") for (int n = 0; n < 2; ++n) _Pragma("unroll") for (int k = 0; k < 2; ++k) dst[n][k] = *(const PG8_LAS bf16x8*)(lds + PG8_SB(b, h) + boff + n * 2048 + k * 1024); } while (0)
#define PG8_MMA16(ai, bj, At, Bt) do { __builtin_amdgcn_s_setprio(1); _Pragma("unroll") for (int m = 0; m < 4; ++m) _Pragma("unroll") for (int n = 0; n < 2; ++n) _Pragma("unroll") for (int k = 0; k < 2; ++k) \
        acc[ai][bj][m][n] = __builtin_amdgcn_mfma_f32_16x16x32_bf16(Bt[n][k], At[m][k], acc[ai][bj][m][n], 0, 0, 0); __builtin_amdgcn_s_setprio(0); } while (0)
#define PG8_LDA8(dst, b, h) do { _Pragma("unroll") for (int m = 0; m < 4; ++m) { const v4i lo_ = *(const PG8_LAS v4i*)(lds + PG8_SA(b, h) + aoff8a + m * 2048), hi_ = *(const PG8_LAS v4i*)(lds + PG8_SA(b, h) + aoff8a + m * 2048 + 16); \
        dst[m] = (v8i){lo_.x, lo_.y, lo_.z, lo_.w, hi_.x, hi_.y, hi_.z, hi_.w}; } } while (0)
#define PG8_LDB8(dst, b, h) do { _Pragma("unroll") for (int n = 0; n < 2; ++n) { const v4i lo_ = *(const PG8_LAS v4i*)(lds + PG8_SB(b, h) + boff8a + n * 2048), hi_ = *(const PG8_LAS v4i*)(lds + PG8_SB(b, h) + boff8a + n * 2048 + 16); \
        dst[n] = (v8i){lo_.x, lo_.y, lo_.z, lo_.w, hi_.x, hi_.y, hi_.z, hi_.w}; } } while (0)
#define PG8_MMA8(ai, bj, At, Bt) do { __builtin_amdgcn_s_setprio(1); _Pragma("unroll") for (int m = 0; m < 4; ++m) _Pragma("unroll") for (int n = 0; n < 2; ++n) \
        asm volatile("v_mfma_scale_f32_16x16x128_f8f6f4 %0, %1, %2, %0, %3, %3 op_sel:[0,1,0] op_sel_hi:[0,0,0]" : "+v"(acc[ai][bj][m][n]) : "v"(Bt[n]), "v"(At[m]), "v"(f8scale)); __builtin_amdgcn_s_setprio(0); } while (0)
#define PG8_LDA(dst, b, h) do { if constexpr (F8) PG8_LDA8(dst##8, b, h); else PG8_LDA16(dst, b, h); } while (0)
#define PG8_LDB(dst, b, h) do { if constexpr (F8) PG8_LDB8(dst##8, b, h); else PG8_LDB16(dst, b, h); } while (0)
#define PG8_MMA(ai, bj, At, Bt) do { if constexpr (F8) PG8_MMA8(ai, bj, At##8, Bt##8); else PG8_MMA16(ai, bj, At, Bt); } while (0)
#define PG8_WAIT_V(n) asm volatile("s_waitcnt vmcnt(" #n ")" ::: "memory")
#define PG8_WAIT_L(n) asm volatile("s_waitcnt lgkmcnt(" #n ")" ::: "memory")
#define PG8_BAR __builtin_amdgcn_s_barrier()
#define PG8_SCHED __builtin_amdgcn_sched_barrier(0)
    Unit cur, nxt; int ui = 0;
    if (!S.next(0, cur)) return;
    f32x4 acc[2][2][4][2];
#pragma unroll
    for (int a = 0; a < 2; ++a)
#pragma unroll
        for (int b = 0; b < 2; ++b)
#pragma unroll
            for (int m = 0; m < 4; ++m)
#pragma unroll
                for (int n = 0; n < 2; ++n) acc[a][b][m][n] = (f32x4){0.f, 0.f, 0.f, 0.f};
    bf16x8 At[4][2], B0[2][2], B1[2][2]; v8i At8[4], B08[2], B18[2]; int f8scale = 0x7f7f7f78; asm volatile("" : "+v"(f8scale));
    const char* cA = PG8_ABASE(cur); const char* cB = PG8_BBASE(cur);
    S.a_ready(cur);
    if (AMODE == 2) { PG8_GIDX_LOAD(cur); asm volatile("s_waitcnt vmcnt(0)" ::: "memory"); PG8_GIDX_USE();
#pragma unroll
        for (int i = 0; i < 2; ++i) { voffA0[i] = voffN0[i]; voffA1[i] = voffN1[i]; } }
    if constexpr (SP2) {
        PG8_STAGE(PG8_SB(0, 0), cB, voffB); PG8_STAGE(PG8_SB(0, 1), cB + hstepB, voffB); PG8_STAGE(PG8_SA(0, 0), cA, voffA0); PG8_STAGE(PG8_SA(0, 1), cA, voffA1);
        if (wr == 1) PG8_BAR;
        PG8_WAIT_V(2); PG8_BAR;
        PG8_STAGE(PG8_SB(1, 0), cB + kstepB, voffB); PG8_STAGE(PG8_SA(1, 0), cA + kstepA, voffA0); PG8_STAGE(PG8_SB(1, 1), cB + hstepB + kstepB, voffB);
        PG8_WAIT_V(6); PG8_BAR;
    } else {
        PG8_STAGE(PG8_SB(0, 0), cB, voffB); PG8_STAGE(PG8_SA(0, 0), cA, voffA0); PG8_STAGE(PG8_SB(0, 1), cB + hstepB, voffB); PG8_STAGE(PG8_SA(0, 1), cA, voffA1);
        if (wr == 1) PG8_BAR;
        PG8_WAIT_V(4); PG8_BAR;
        PG8_STAGE(PG8_SB(1, 0), cB + kstepB, voffB); PG8_STAGE(PG8_SA(1, 0), cA + kstepA, voffA0); PG8_STAGE(PG8_SB(1, 1), cB + hstepB + kstepB, voffB);
        PG8_WAIT_V(6); PG8_BAR;
    }
    for (;;) {
        const bool has_next = S.next(ui + 1, nxt);
        const char* nA = has_next ? PG8_ABASE(nxt) : cA; const char* nB = has_next ? PG8_BBASE(nxt) : cB;
        if (AMODE == 2) { if (has_next) PG8_GIDX_LOAD(nxt); }
#pragma unroll 1
        for (int t = 0; t < nt; t += 2) {
            const bool last = (t == nt - 2);
            unsigned vS0[2], vS1[2];
            if (AMODE == 2) { if (last) { if (has_next) PG8_GIDX_USE(); else { _Pragma("unroll") for (int i = 0; i < 2; ++i) { voffN0[i] = voffA0[i]; voffN1[i] = voffA1[i]; } } } }
#pragma unroll
            for (int i = 0; i < 2; ++i) { vS0[i] = (AMODE == 2 && last) ? voffN0[i] : voffA0[i]; vS1[i] = (AMODE == 2 && last) ? voffN1[i] : voffA1[i]; }
            const char* a1 = cA + (size_t)(t + 1) * kstepA;
            const char* a2 = last ? nA : cA + (size_t)(t + 2) * kstepA; const char* b2 = last ? nB : cB + (size_t)(t + 2) * kstepB;
            const char* a3 = a2 + kstepA; const char* b3 = b2 + kstepB;
            if (last && has_next) S.a_ready(nxt);
            if constexpr (SP2) {
            PG8_LDB(B0, 0, 0); PG8_LDB(B1, 0, 1); PG8_SCHED; PG8_LDA(At, 0, 0); PG8_STAGE(PG8_SA(1, 1), a1, voffA1);
            PG8_WAIT_V(8); PG8_WAIT_L(0); PG8_BAR; PG8_MMA(0, 0, At, B0); PG8_MMA(0, 1, At, B1); PG8_BAR; PG8_SCHED;
            PG8_LDA(At, 0, 1); PG8_STAGE(PG8_SB(0, 0), b2, voffB); PG8_STAGE(PG8_SB(0, 1), b2 + hstepB, voffB); PG8_STAGE(PG8_SA(0, 0), a2, vS0);
            PG8_WAIT_V(8); PG8_WAIT_L(0); PG8_BAR; PG8_MMA(1, 0, At, B0); PG8_MMA(1, 1, At, B1); PG8_BAR; PG8_SCHED;
            PG8_LDB(B0, 1, 0); PG8_LDB(B1, 1, 1); PG8_SCHED; PG8_LDA(At, 1, 0); PG8_STAGE(PG8_SA(0, 1), a2, vS1);
            PG8_WAIT_V(8); PG8_WAIT_L(0); PG8_BAR; PG8_MMA(0, 0, At, B0); PG8_MMA(0, 1, At, B1); PG8_BAR; PG8_SCHED;
            PG8_LDA(At, 1, 1); PG8_STAGE(PG8_SB(1, 0), b3, voffB); PG8_STAGE(PG8_SB(1, 1), b3 + hstepB, voffB); PG8_STAGE(PG8_SA(1, 0), a3, vS0);
            PG8_WAIT_V(8); PG8_WAIT_L(0); PG8_BAR; PG8_MMA(1, 0, At, B0); PG8_MMA(1, 1, At, B1); PG8_BAR; PG8_SCHED;
            } else {
            PG8_LDB(B0, 0, 0); PG8_SCHED; PG8_LDA(At, 0, 0); PG8_STAGE(PG8_SA(1, 1), a1, voffA1);
            PG8_WAIT_L(8); PG8_BAR; PG8_WAIT_L(0); PG8_MMA(0, 0, At, B0); PG8_BAR; PG8_SCHED;
            PG8_LDB(B1, 0, 1); PG8_STAGE(PG8_SB(0, 0), b2, voffB);
            PG8_BAR; PG8_WAIT_L(0); PG8_MMA(0, 1, At, B1); PG8_BAR;
            PG8_LDA(At, 0, 1); PG8_STAGE(PG8_SA(0, 0), a2, vS0);
            PG8_BAR; PG8_WAIT_L(0); PG8_MMA(1, 0, At, B0); PG8_BAR; PG8_SCHED;
            PG8_STAGE(PG8_SB(0, 1), b2 + hstepB, voffB);
            PG8_WAIT_V(6); PG8_BAR; PG8_MMA(1, 1, At, B1); PG8_BAR;
            PG8_LDB(B0, 1, 0); PG8_SCHED; PG8_LDA(At, 1, 0); PG8_STAGE(PG8_SA(0, 1), a2, vS1);
            PG8_WAIT_L(8); PG8_BAR; PG8_WAIT_L(0); PG8_MMA(0, 0, At, B0); PG8_BAR; PG8_SCHED;
            PG8_LDB(B1, 1, 1); PG8_STAGE(PG8_SB(1, 0), b3, voffB);
            PG8_BAR; PG8_WAIT_L(0); PG8_MMA(0, 1, At, B1); PG8_BAR;
            PG8_LDA(At, 1, 1); PG8_STAGE(PG8_SA(1, 0), a3, vS0);
            PG8_BAR; PG8_WAIT_L(0); PG8_MMA(1, 0, At, B0); PG8_BAR; PG8_SCHED;
            PG8_STAGE(PG8_SB(1, 1), b3 + hstepB, voffB);
            PG8_WAIT_V(6); PG8_BAR; PG8_MMA(1, 1, At, B1); PG8_BAR;
            }
        }
        if constexpr (ALIGN_EPI) { if (wr == 0) PG8_BAR; }
        if constexpr (F8) asm volatile("s_nop 15\n\ts_nop 15\n\ts_nop 7" ::: "memory");
        E(acc, cur, wr, wc, fr, fq); S.done(cur);
#if DBG_EPI2
        if (Epi::EPI2) { asm volatile("" ::: "memory"); E(acc, cur, wr, wc, fr, fq); }
#endif
        if (!has_next) break;
#pragma unroll
        for (int a = 0; a < 2; ++a)
#pragma unroll
            for (int b = 0; b < 2; ++b)
#pragma unroll
                for (int m = 0; m < 4; ++m)
#pragma unroll
                    for (int n = 0; n < 2; ++n) acc[a][b][m][n] = (f32x4){0.f, 0.f, 0.f, 0.f};
        cur = nxt; cA = nA; cB = nB; ++ui;
        if (AMODE == 2) {
#pragma unroll
            for (int i = 0; i < 2; ++i) { voffA0[i] = voffN0[i]; voffA1[i] = voffN1[i]; } }
        if constexpr (ALIGN_EPI) { if (wr == 1) PG8_BAR; }
    }
    PG8_WAIT_V(0);
    if constexpr (!ALIGN_EPI) { if (wr == 0) PG8_BAR; }
    PG8_BAR;
#undef PG8_GIDX_LOAD
#undef PG8_GIDX_USE
#undef PG8_ABASE
#undef PG8_BBASE
#undef PG8_SA
#undef PG8_SB
#undef PG8_STAGE
#undef PG8_LDA
#undef PG8_LDA16
#undef PG8_LDA8
#undef PG8_LDB16
#undef PG8_LDB8
#undef PG8_MMA16
#undef PG8_MMA8
#undef PG8_LDB
#undef PG8_MMA
#undef PG8_WAIT_V
#undef PG8_WAIT_L
#undef PG8_BAR
#undef PG8_SCHED
}
}
constexpr int NWAVES = 8;
constexpr int BATCH = 2, SEQ = 8192, D = 1024, M = BATCH * SEQ, DF = 512, DIN = 5632, NE = 16, CAP = 1024, DE = 2048, MR = BATCH * NE * CAP  ;
constexpr float RMS_EPS = 1e-6f;
constexpr size_t MiB = 1u << 20;
constexpr size_t WS_CTL = 0, CTL_ZERO_BYTES = 32 * 1024;
constexpr size_t WS_MODP = 1 * MiB, WS_MOD = 1 * MiB + 256 * 1024, WS_FC1 = 1 * MiB + 512 * 1024, WS_FC2 = 1 * MiB + 576 * 1024;
constexpr size_t WS_PROBS = 2 * MiB, WS_SLOT = 3 * MiB, WS_IDX = 4 * MiB, WS_VAL = 4 * MiB + 128 * 1024;
constexpr size_t WS_WIN = 8 * MiB, WS_WF = 20 * MiB, WS_WCO = 22 * MiB, WS_WO = 24 * MiB, WS_WGU = 32 * MiB, WS_WD = 160 * MiB;
constexpr size_t WS_H1 = 224 * MiB, WS_AB = 224 * MiB, WS_UF = 256 * MiB, WS_CV = 272 * MiB, WS_BG = 304 * MiB, WS_GA = 336 * MiB, WS_GB = 368 * MiB, WS_ZF = 400 * MiB, WS_TZ = 432 * MiB, WS_H2 = 464 * MiB;
#ifndef MOE_FP8
#define MOE_FP8 1
#endif
constexpr size_t WS_HM = 224 * MiB, WS_Y = 432 * MiB, WS_X1B = 400 * MiB, WS_END = 496 * MiB;
constexpr int CW_BAR = 4096;
constexpr int RING_BYTES = 131072, MISC_OFF = 143360, LDS_BYTES = 147456;
constexpr int FFT_TOFF = 65536, FFT_TPITCH = 528;

#define GAS __attribute__((address_space(1)))
#define LAS __attribute__((address_space(3)))
typedef unsigned short bf16;
typedef unsigned v4u __attribute__((ext_vector_type(4)));
typedef unsigned v2u __attribute__((ext_vector_type(2)));
typedef float f32x4 __attribute__((ext_vector_type(4)));
typedef short bf16x8 __attribute__((ext_vector_type(8)));
#define LDS_WAIT() asm volatile("s_waitcnt lgkmcnt(0)" ::: "memory")
#define VM_WAIT() asm volatile("s_waitcnt vmcnt(0)" ::: "memory")
using pg8::cvt_pk_bf16; using pg8::bf_lo; using pg8::bf_hi; using pg8::sigm;
__device__ __forceinline__ float wave_sum(float v) {
#pragma unroll
    for (int o = 1; o < 64; o <<= 1) v += __shfl_xor(v, o);
    return v;
}
__device__ __forceinline__ float silu(float v) { return v * sigm(v); }
#ifndef DBG_NOBIAS
#define DBG_NOBIAS 0
#endif
#ifndef DBG_NOSIG
#define DBG_NOSIG 0
#endif
__device__ __forceinline__ float sigx(float v) { return DBG_NOSIG ? v : sigm(v); }

#define XB_TMO      128
#define XB_XCNT(j)  (256  + 64 * (j))
#define XB_XSUB(j)  (1280 + 64 * (j))
#define XB_XGEN(j)  (2304 + 64 * (j))
#define XB_TOP      3328
#define XB_TOPGEN   3392
#define XCD_BAR_WORDS 3456
#define XB_SPIN_CAP (1u << 18)
__device__ __forceinline__ unsigned xb_ld(unsigned* p)              { return __hip_atomic_load(p, __ATOMIC_RELAXED, __HIP_MEMORY_SCOPE_AGENT); }
__device__ __forceinline__ unsigned xb_add(unsigned* p, unsigned v) { return __hip_atomic_fetch_add(p, v, __ATOMIC_RELAXED, __HIP_MEMORY_SCOPE_AGENT); }
__device__ __forceinline__ unsigned xb_xcc_id() { return (unsigned)__builtin_amdgcn_s_getreg((3 << 11) | 20) & 0xFu; }
#define XB_SPIN(cond, bar) do { unsigned _sp = 0; while (cond) { __builtin_amdgcn_s_sleep(1); \
    if ((++_sp & 255u) == 0u) { if (xb_ld(&(bar)[XB_TMO])) break; if (_sp > XB_SPIN_CAP) { atomicAdd(&(bar)[XB_TMO], 1u); break; } } } } while (0)
struct XcdBarrier { unsigned* bar; unsigned x; volatile LAS unsigned* st; };
__device__ __forceinline__ XcdBarrier xcd_barrier_post(unsigned* bar, volatile LAS unsigned* st) {
    XcdBarrier b; b.bar = bar; b.x = xb_xcc_id(); b.st = st;
    if (threadIdx.x == 0) (void)xb_add(&bar[XB_XCNT(b.x)], 1u);
    return b;
}
__device__ __forceinline__ void xcd_barrier_complete(unsigned* bar, unsigned x, unsigned& nloc, unsigned& nx) {
    const unsigned G = gridDim.x * gridDim.y * gridDim.z;
    unsigned sum, cnt, mine, sp = 0u;
    for (;;) {
        sum = 0u; cnt = 0u; mine = 0u;
#pragma unroll
        for (unsigned j = 0; j < 16; ++j) { const unsigned c = xb_ld(&bar[XB_XCNT(j)]); sum += c; cnt += (c > 0u) ? 1u : 0u; mine = (j == x) ? c : mine; }
        if (sum == G) break;
        __builtin_amdgcn_s_sleep(1);
        if ((++sp & 255u) == 0u) { if (xb_ld(&bar[XB_TMO])) break; if (sp > XB_SPIN_CAP) { atomicAdd(&bar[XB_TMO], 1u); break; } }
    }
    nloc = mine > 0u ? mine : 1u; nx = cnt > 0u ? cnt : 1u;
}
__device__ __forceinline__ void xcd_barrier(const XcdBarrier& b) {
    asm volatile("s_waitcnt vmcnt(0)" ::: "memory");
    __syncthreads();
    if (threadIdx.x == 0) {
        unsigned* bar = b.bar;
        __builtin_amdgcn_s_waitcnt(0);
        unsigned nloc = b.st[0], nx = b.st[1];
        if (nloc == 0u) { xcd_barrier_complete(bar, b.x, nloc, nx); b.st[0] = nloc; b.st[1] = nx; }
        const unsigned old = xb_add(&bar[XB_XSUB(b.x)], 1u);
        const unsigned gen = old / nloc;
        if (old + 1u == (gen + 1u) * nloc) {
            __builtin_amdgcn_fence(__ATOMIC_RELEASE, "agent");
            asm volatile("s_waitcnt vmcnt(0)" ::: "memory");
            const unsigned og = xb_add(&bar[XB_TOP], 1u);
            const unsigned tg = og / nx;
            if (og + 1u == (tg + 1u) * nx) xb_add(&bar[XB_TOPGEN], 1u);
            else XB_SPIN(xb_ld(&bar[XB_TOPGEN]) == tg, bar);
            __builtin_amdgcn_fence(__ATOMIC_ACQUIRE, "agent");
            xb_add(&bar[XB_XGEN(b.x)], 1u);
            asm volatile("s_waitcnt vmcnt(0)" ::: "memory");
        } else {
            XB_SPIN(xb_ld(&bar[XB_XGEN(b.x)]) == gen, bar);
            __builtin_amdgcn_fence(__ATOMIC_ACQUIRE, "agent");
            asm volatile("s_waitcnt vmcnt(0)" ::: "memory");
        }
    }
    __syncthreads();
}

using pg8::Unit; using pg8::u32x4; using pg8::u32x2;
__device__ __forceinline__ unsigned pk4_u8(float a, float b2, float c, float d) { return (unsigned)__builtin_rintf(a * 255.f) | ((unsigned)__builtin_rintf(b2 * 255.f) << 8) | ((unsigned)__builtin_rintf(c * 255.f) << 16) | ((unsigned)__builtin_rintf(d * 255.f) << 24); }
#ifndef NT_INPROJ
#define NT_INPROJ 0
#endif
#if NT_INPROJ
#define ST_NT(T, p, v) __builtin_nontemporal_store((v), (T*)(p))
#else
#define ST_NT(T, p, v) (*(T*)(p) = (v))
#endif
struct EpiInProj {
    static constexpr bool PERM = true, EPI2 = (DBG_EPI2 == 2);
    bf16 *UF, *CV, *BG, *GA, *GB; const float* b_gate;
    __device__ __forceinline__ void operator()(const f32x4 (&acc)[2][2][4][2], const Unit& u, int wr, int wc, int fr, int fq) const {
        const int row0 = u.pm * 256 + wr * 64 + fr;
        if (u.pn < 2) {
            const int b = u.pm >> 5, s0 = (u.pm & 31) * 256 + wr * 64 + fr;
#pragma unroll
            for (int ai = 0; ai < 2; ++ai)
#pragma unroll
                for (int m = 0; m < 4; ++m) { const int s = s0 + ai * 128 + m * 16;
#pragma unroll
                    for (int bj = 0; bj < 2; ++bj) { const int g4 = (u.pn * 256 + bj * 128 + wc * 32 + 8 * fq) >> 2;
#pragma unroll
                        for (int n = 0; n < 2; ++n) { const f32x4 v = acc[ai][bj][m][n]; u32x2 w; w.x = cvt_pk_bf16(v[0], v[1]); w.y = cvt_pk_bf16(v[2], v[3]);
                            ST_NT(u32x2, UF + ((size_t)(b * 128 + g4 + n) * 8192 + s) * 4, w); } } }
        } else if (u.pn < 10) {
#pragma unroll
            for (int ai = 0; ai < 2; ++ai)
#pragma unroll
                for (int m = 0; m < 4; ++m) { bf16* rowp = CV + (size_t)(row0 + ai * 128 + m * 16) * D + (u.pn - 2) * 128 + wc * 16 + 4 * fq;
#pragma unroll
                    for (int bj = 0; bj < 2; ++bj) { const f32x4 v = acc[ai][bj][m][0] * acc[ai][bj][m][1]; u32x2 w; w.x = cvt_pk_bf16(v[0], v[1]); w.y = cvt_pk_bf16(v[2], v[3]);
                        ST_NT(u32x2, rowp + bj * 64, w); } }
        } else if (u.pn < 14) {
#pragma unroll
            for (int ai = 0; ai < 2; ++ai)
#pragma unroll
                for (int m = 0; m < 4; ++m) { bf16* rowp = BG + (size_t)(row0 + ai * 128 + m * 16) * D + (u.pn - 10) * 256 + wc * 32 + 8 * fq;
#pragma unroll
                    for (int bj = 0; bj < 2; ++bj) { const f32x4 v0 = acc[ai][bj][m][0], v1 = acc[ai][bj][m][1]; u32x4 w; w.x = cvt_pk_bf16(v0[0], v0[1]); w.y = cvt_pk_bf16(v0[2], v0[3]); w.z = cvt_pk_bf16(v1[0], v1[1]); w.w = cvt_pk_bf16(v1[2], v1[3]);
                        ST_NT(u32x4, rowp + bj * 128, w); } }
        } else {
            const int colg = (u.pn - 14) * 256 + wc * 32 + 8 * fq;
            bf16* O = (u.pn < 18) ? GA : GB;
            f32x4 bv[2][2];
#pragma unroll
            for (int bj = 0; bj < 2; ++bj)
#pragma unroll
                for (int n = 0; n < 2; ++n) bv[bj][n] = DBG_NOBIAS ? (f32x4){0.f, 0.f, 0.f, 0.f} : *(const f32x4*)(b_gate + colg + bj * 128 + 4 * n);
#pragma unroll
            for (int ai = 0; ai < 2; ++ai)
#pragma unroll
                for (int m = 0; m < 4; ++m) { unsigned char* rowp8 = (unsigned char*)O + (size_t)(row0 + ai * 128 + m * 16) * D + (colg & 1023);
#pragma unroll
                    for (int bj = 0; bj < 2; ++bj) { const f32x4 v0 = acc[ai][bj][m][0] + bv[bj][0], v1 = acc[ai][bj][m][1] + bv[bj][1]; u32x2 w;
                        w.x = pk4_u8(sigx(v0[0]), sigx(v0[1]), sigx(v0[2]), sigx(v0[3])); w.y = pk4_u8(sigx(v1[0]), sigx(v1[1]), sigx(v1[2]), sigx(v1[3]));
                        ST_NT(u32x2, rowp8 + bj * 128, w); } }
        }
    }
};
template <int MODE> struct EpiGateMul {
    static constexpr bool PERM = true, EPI2 = false;
    bf16* O; const bf16* G;
    __device__ __forceinline__ void operator()(const f32x4 (&acc)[2][2][4][2], const Unit& u, int wr, int wc, int fr, int fq) const {
        const int row0 = u.pm * 256 + wr * 64 + fr, col0 = u.pn * 256 + wc * 32 + 8 * fq;
#pragma unroll
        for (int ai = 0; ai < 2; ++ai)
#pragma unroll
            for (int m = 0; m < 4; ++m) { const size_t off = (size_t)(row0 + ai * 128 + m * 16) * D + col0;
#pragma unroll
                for (int bj = 0; bj < 2; ++bj) { const u32x2 gw = __builtin_nontemporal_load((const u32x2*)((const unsigned char*)G + off + bj * 128)); const f32x4 v0 = acc[ai][bj][m][0] * (1.0f / 255.0f), v1 = acc[ai][bj][m][1] * (1.0f / 255.0f);
                    float r[8] = {(float)(gw.x & 0xffu) * v0[0], (float)((gw.x >> 8) & 0xffu) * v0[1], (float)((gw.x >> 16) & 0xffu) * v0[2], (float)(gw.x >> 24) * v0[3],
                                  (float)(gw.y & 0xffu) * v1[0], (float)((gw.y >> 8) & 0xffu) * v1[1], (float)((gw.y >> 16) & 0xffu) * v1[2], (float)(gw.y >> 24) * v1[3]};
                    if (MODE == 1) { const u32x4 ow = __builtin_nontemporal_load((const u32x4*)(O + off + bj * 128));
                        r[0] += bf_lo(ow.x); r[1] += bf_hi(ow.x); r[2] += bf_lo(ow.y); r[3] += bf_hi(ow.y); r[4] += bf_lo(ow.z); r[5] += bf_hi(ow.z); r[6] += bf_lo(ow.w); r[7] += bf_hi(ow.w); }
                    u32x4 w; w.x = cvt_pk_bf16(r[0], r[1]); w.y = cvt_pk_bf16(r[2], r[3]); w.z = cvt_pk_bf16(r[4], r[5]); w.w = cvt_pk_bf16(r[6], r[7]);
                    *(u32x4*)(O + off + bj * 128) = w; } }
    }
};
struct EpiResid {
    static constexpr bool PERM = true, EPI2 = (DBG_EPI2 == 5);
    const float* x; bf16* X1B; const float* gate;
    __device__ __forceinline__ void operator()(const f32x4 (&acc)[2][2][4][2], const Unit& u, int wr, int wc, int fr, int fq) const {
        const int row0 = u.pm * 256 + wr * 64 + fr, col0 = u.pn * 256 + wc * 32 + 8 * fq, b = u.pm >> 5;
        f32x4 gv[2][2];
#pragma unroll
        for (int bj = 0; bj < 2; ++bj)
#pragma unroll
            for (int n = 0; n < 2; ++n) gv[bj][n] = *(const f32x4*)(gate + b * 6 * D + col0 + bj * 128 + 4 * n);
#pragma unroll
        for (int ai = 0; ai < 2; ++ai)
#pragma unroll
            for (int m = 0; m < 4; ++m) { const size_t off = (size_t)(row0 + ai * 128 + m * 16) * D + col0;
#pragma unroll
                for (int bj = 0; bj < 2; ++bj) { const f32x4 x0 = __builtin_nontemporal_load((const f32x4*)(x + off + bj * 128)), x1 = __builtin_nontemporal_load((const f32x4*)(x + off + bj * 128 + 4));
                    const f32x4 v0 = x0 + gv[bj][0] * acc[ai][bj][m][0], v1 = x1 + gv[bj][1] * acc[ai][bj][m][1];
                    u32x4 w; w.x = cvt_pk_bf16(v0[0], v0[1]); w.y = cvt_pk_bf16(v0[2], v0[3]); w.z = cvt_pk_bf16(v1[0], v1[1]); w.w = cvt_pk_bf16(v1[2], v1[3]);
                    *(u32x4*)(X1B + off + bj * 128) = w; }
                asm volatile("" ::: "memory"); }
    }
};
struct EpiSwiGLU {
    static constexpr bool PERM = true, EPI2 = (DBG_EPI2 == 9);
    bf16* HM;
    __device__ __forceinline__ void operator()(const f32x4 (&acc)[2][2][4][2], const Unit& u, int wr, int wc, int fr, int fq) const {
        const int row0 = u.pm * 256 + wr * 64 + fr, col0 = u.pn * 128 + wc * 32 + 8 * fq;
#pragma unroll
        for (int ai = 0; ai < 2; ++ai)
#pragma unroll
            for (int m = 0; m < 4; ++m) { const f32x4 g0 = acc[ai][0][m][0], g1 = acc[ai][0][m][1], u0 = acc[ai][1][m][0], u1 = acc[ai][1][m][1]; u32x4 w;
                w.x = cvt_pk_bf16(silu(g0[0]) * u0[0], silu(g0[1]) * u0[1]); w.y = cvt_pk_bf16(silu(g0[2]) * u0[2], silu(g0[3]) * u0[3]);
                w.z = cvt_pk_bf16(silu(g1[0]) * u1[0], silu(g1[1]) * u1[1]); w.w = cvt_pk_bf16(silu(g1[2]) * u1[2], silu(g1[3]) * u1[3]);
                *(u32x4*)(HM + (size_t)(row0 + ai * 128 + m * 16) * DE + col0) = w; }
    }
};
__device__ __forceinline__ unsigned pk4_fp8(float a, float b2, float c, float d) { unsigned w = 0u; w = __builtin_amdgcn_cvt_pk_fp8_f32(a, b2, w, false); w = __builtin_amdgcn_cvt_pk_fp8_f32(c, d, w, true); return w; }
struct EpiSwiGLU8 {
    static constexpr bool PERM = true, EPI2 = false;
    unsigned char* HM8;
    __device__ __forceinline__ void operator()(const f32x4 (&acc)[2][2][4][2], const Unit& u, int wr, int wc, int fr, int fq) const {
        const int row0 = u.pm * 256 + wr * 64 + fr, col0 = u.pn * 128 + wc * 32 + 8 * fq;
#pragma unroll
        for (int ai = 0; ai < 2; ++ai)
#pragma unroll
            for (int m = 0; m < 4; ++m) { const f32x4 g0 = acc[ai][0][m][0], g1 = acc[ai][0][m][1], u0 = acc[ai][1][m][0], u1 = acc[ai][1][m][1]; u32x2 w;
                w.x = pk4_fp8(silu(g0[0]) * u0[0], silu(g0[1]) * u0[1], silu(g0[2]) * u0[2], silu(g0[3]) * u0[3]);
                w.y = pk4_fp8(silu(g1[0]) * u1[0], silu(g1[1]) * u1[1], silu(g1[2]) * u1[2], silu(g1[3]) * u1[3]);
                *(u32x2*)(HM8 + (size_t)(row0 + ai * 128 + m * 16) * DE + col0) = w; asm volatile("" ::: "memory"); }
    }
};
struct EpiRowScale {
    static constexpr bool PERM = true, EPI2 = (DBG_EPI2 == 10);
    bf16* Y; const float* val;
    __device__ __forceinline__ void operator()(const f32x4 (&acc)[2][2][4][2], const Unit& u, int wr, int wc, int fr, int fq) const {
        const int row0 = u.pm * 256 + wr * 64 + fr, col0 = u.pn * 256 + wc * 32 + 8 * fq;
#pragma unroll
        for (int ai = 0; ai < 2; ++ai)
#pragma unroll
            for (int m = 0; m < 4; ++m) { const int row = row0 + ai * 128 + m * 16; const float sv = val[row];
#pragma unroll
                for (int bj = 0; bj < 2; ++bj) { const f32x4 v0 = acc[ai][bj][m][0] * sv, v1 = acc[ai][bj][m][1] * sv; u32x4 w; w.x = cvt_pk_bf16(v0[0], v0[1]); w.y = cvt_pk_bf16(v0[2], v0[3]); w.z = cvt_pk_bf16(v1[0], v1[1]); w.w = cvt_pk_bf16(v1[2], v1[3]);
                    *(u32x4*)(Y + (size_t)row * D + col0 + bj * 128) = w; } }
    }
};

struct EpiPlain {
    static constexpr bool PERM = true, EPI2 = false;
    bf16* O; int ldc;
    __device__ __forceinline__ void operator()(const f32x4 (&acc)[2][2][4][2], const Unit& u, int wr, int wc, int fr, int fq) const {
        const int row0 = u.pm * 256 + wr * 64 + fr, col0 = u.pn * 256 + wc * 32 + 8 * fq;
#pragma unroll
        for (int ai = 0; ai < 2; ++ai)
#pragma unroll
            for (int m = 0; m < 4; ++m) { bf16* rowp = O + (size_t)(row0 + ai * 128 + m * 16) * ldc + col0;
#pragma unroll
                for (int bj = 0; bj < 2; ++bj) { const f32x4 v0 = acc[ai][bj][m][0], v1 = acc[ai][bj][m][1]; u32x4 w; w.x = cvt_pk_bf16(v0[0], v0[1]); w.y = cvt_pk_bf16(v0[2], v0[3]); w.z = cvt_pk_bf16(v1[0], v1[1]); w.w = cvt_pk_bf16(v1[2], v1[3]);
                    *(u32x4*)(rowp + bj * 128) = w; } }
    }
};
#ifndef NT_WLOAD
#define NT_WLOAD 1
#endif
__device__ __forceinline__ unsigned f2bf(float f) { unsigned u = __builtin_bit_cast(unsigned, f); return (u + 0x7fffu + ((u >> 16) & 1u)) >> 16; }
__device__ __forceinline__ unsigned pk2(float lo, float hi) { return f2bf(lo) | (f2bf(hi) << 16); }
__device__ __forceinline__ int rowmap_in(int n) {
    if (n < 512) return n;
    if (n < 1536) { const int j = n - 512; return 512 + 8 * (j >> 2) + (j & 3); }
    if (n < 2560) return 2560 + (n - 1536);
    if (n < 3584) { const int j = n - 2560; return 512 + 8 * (j >> 2) + 4 + (j & 3); }
    return n;
}
template <int MAP>
__device__ __forceinline__ void transpose_item(const float* W, int K, int N, bf16* WT, LAS float* scr, int item, int lane) {
    const int nblk = N / 32, kb = item / nblk, nb = item % nblk, k0 = 64 * kb, n0 = 32 * nb;
    { f32x4 t[8];
#pragma unroll
      for (int i = 0; i < 8; ++i) t[i] = NT_WLOAD ? __builtin_nontemporal_load((const GAS f32x4*)(W + (size_t)(k0 + 8 * i + (lane >> 3)) * N + n0 + 4 * (lane & 7))) : *(const GAS f32x4*)(W + (size_t)(k0 + 8 * i + (lane >> 3)) * N + n0 + 4 * (lane & 7));
#pragma unroll
      for (int i = 0; i < 8; ++i) { LAS float* d_ = scr + (8 * i + (lane >> 3)) * 33 + 4 * (lane & 7); d_[0] = t[i].x; d_[1] = t[i].y; d_[2] = t[i].z; d_[3] = t[i].w; } }
    LDS_WAIT(); asm volatile("" ::: "memory");
    const int c = lane & 7;
#pragma unroll
    for (int j = 0; j < 4; ++j) { const int n = (lane >> 3) + 8 * j; const LAS float* s = scr + (8 * c) * 33 + n;
        v4u o; o.x = pk2(s[0 * 33], s[1 * 33]); o.y = pk2(s[2 * 33], s[3 * 33]); o.z = pk2(s[4 * 33], s[5 * 33]); o.w = pk2(s[6 * 33], s[7 * 33]);
        const int ns = n0 + n; int row;
        if (MAP == 0) row = ns; else if (MAP == 1) row = rowmap_in(ns); else if (MAP == 2) row = 256 * (ns >> 7) + (ns & 127); else row = 256 * (ns >> 7) + 128 + (ns & 127);
        *(GAS v4u*)(WT + (size_t)row * K + k0 + 8 * c) = o; }
    LDS_WAIT(); asm volatile("" ::: "memory");
}
template <int MAP>
__device__ __forceinline__ void transpose_item8(const float* W, int K, int N, unsigned char* WT, LAS float* scr, int item, int lane) {
    const int nblk = N / 32, kb = item / nblk, nb = item % nblk, k0 = 64 * kb, n0 = 32 * nb;
    { f32x4 t[8];
#pragma unroll
      for (int i = 0; i < 8; ++i) t[i] = NT_WLOAD ? __builtin_nontemporal_load((const GAS f32x4*)(W + (size_t)(k0 + 8 * i + (lane >> 3)) * N + n0 + 4 * (lane & 7))) : *(const GAS f32x4*)(W + (size_t)(k0 + 8 * i + (lane >> 3)) * N + n0 + 4 * (lane & 7));
#pragma unroll
      for (int i = 0; i < 8; ++i) { LAS float* d_ = scr + (8 * i + (lane >> 3)) * 33 + 4 * (lane & 7); d_[0] = t[i].x; d_[1] = t[i].y; d_[2] = t[i].z; d_[3] = t[i].w; } }
    LDS_WAIT(); asm volatile("" ::: "memory");
    const int c = lane & 3;
#pragma unroll
    for (int j = 0; j < 2; ++j) { const int n = (lane >> 2) + 16 * j; const LAS float* s = scr + (16 * c) * 33 + n; unsigned o[4];
#pragma unroll
        for (int q = 0; q < 4; ++q) { unsigned w = 0u; w = __builtin_amdgcn_cvt_pk_fp8_f32(s[(4 * q) * 33] * 128.f, s[(4 * q + 1) * 33] * 128.f, w, false); w = __builtin_amdgcn_cvt_pk_fp8_f32(s[(4 * q + 2) * 33] * 128.f, s[(4 * q + 3) * 33] * 128.f, w, true); o[q] = w; }
        const int ns = n0 + n; int row;
        if (MAP == 0) row = ns; else if (MAP == 2) row = 256 * (ns >> 7) + (ns & 127); else row = 256 * (ns >> 7) + 128 + (ns & 127);
        v4u ov; ov.x = o[0]; ov.y = o[1]; ov.z = o[2]; ov.w = o[3];
        *(GAS v4u*)(WT + (size_t)row * K + k0 + 16 * c) = ov; }
    LDS_WAIT(); asm volatile("" ::: "memory");
}
__device__ __forceinline__ void wf_item(const float* wf, bf16* WF_T, int item, int lane) {
    const int c = item >> 2, dblk = item & 3, g = c >> 7, j = c & 127, d0 = 256 * dblk + 4 * lane;
    f32x4 ac = {0.f, 0.f, 0.f, 0.f}, as = {0.f, 0.f, 0.f, 0.f};
    for (int m = 0; m < 128; ++m) { const f32x4 wv = *(const GAS f32x4*)(wf + (size_t)(g * 128 + m) * D + d0); const float fr = (float)((m * j) & 127) * (1.0f / 128.0f);
        const float cv = __builtin_amdgcn_cosf(fr), sv = __builtin_amdgcn_sinf(fr); ac += cv * wv; as += sv * wv; }
    const int kv = 8 * (c >> 2) + 2 * (c & 3);
#pragma unroll
    for (int i = 0; i < 4; ++i) *(GAS unsigned*)(WF_T + (size_t)(d0 + i) * D + kv) = pk2(ac[i] * (1.0f / 1024.0f), as[i] * (1.0f / 1024.0f));
}
__device__ __forceinline__ void fc_tables(bf16* Fc1, bf16* Fc2, int gtid, int gthreads) {
    for (int e = gtid; e < 8192 + 65536; e += gthreads) {
        if (e < 8192) { const int j = e & 7, ln = (e >> 3) & 63, kk = (e >> 9) & 1, mt = (e >> 10) & 3, hh = e >> 12, rho = ln & 15;
            const int s1 = 32 * kk + 8 * (ln >> 4) + j, k1 = 32 * hh + 16 * (mt & 1) + 4 * (rho & 3) + (rho >> 2);
            const float fr = (float)((k1 * s1) & 63) * (1.0f / 64.0f); Fc1[e] = (bf16)f2bf((mt >> 1) == 0 ? cospif(2.0f * fr) : -sinpif(2.0f * fr)); }
        else { const int q = e - 8192, j = q & 7, ln = (q >> 3) & 63, kk = (q >> 9) & 7, ro = (q >> 12) & 1, w = q >> 13;
            const int k2 = 16 * w + (ln & 15), kap = 32 * kk + 8 * (ln >> 4) + j, s2 = kap >> 1, ri = kap & 1;
            const float fr = (float)((k2 * s2) & 127) * (1.0f / 128.0f), cv = cospif(2.0f * fr), sv = sinpif(2.0f * fr);
            Fc2[q] = (bf16)f2bf(ro == 0 ? (ri == 0 ? cv : sv) : (ri == 0 ? -sv : cv)); }
    }
}
__device__ __forceinline__ void mod_item(const float* c, const float* w_ada, float* modp, LAS unsigned char* lds, int item, int tid, int wave, int lane) {
    const int cb = item % 24, kq = item / 24, col0 = 256 * cb + 4 * lane;
    f32x4 a0 = {0.f, 0.f, 0.f, 0.f}, a1 = {0.f, 0.f, 0.f, 0.f};
#pragma unroll
    for (int i0 = 0; i0 < 32; i0 += 16) { f32x4 wv[16];
#pragma unroll
        for (int i = 0; i < 16; ++i) wv[i] = __builtin_nontemporal_load((const GAS f32x4*)(w_ada + (size_t)(256 * kq + 32 * wave + i0 + i) * 6 * D + col0));
#pragma unroll
        for (int i = 0; i < 16; ++i) { const int d = 256 * kq + 32 * wave + i0 + i; a0 += silu(c[d]) * wv[i]; a1 += silu(c[D + d]) * wv[i]; } }
    LAS f32x4* red = (LAS f32x4*)lds;
    red[(wave * 2 + 0) * 64 + lane] = a0; red[(wave * 2 + 1) * 64 + lane] = a1;
    __syncthreads();
    { const int b = tid >> 8, cc = tid & 255; const LAS float* rf = (const LAS float*)lds; float s = 0.f;
#pragma unroll
      for (int w = 0; w < 8; ++w) s += rf[((w * 2 + b) * 64) * 4 + cc];
      modp[(size_t)(kq * 2 + b) * 6 * D + 256 * cb + cc] = s; }
    __syncthreads();
}

__device__ __forceinline__ void phase_h(const float* x, const float* g_mix, const float* b_ada, const float* modp, float* mod, bf16* H1, LAS unsigned char* lds, int tid, int wave, int lane, int vcu, int G) {
    LAS float* ga = (LAS float*)lds;
    LAS float* sh = ga + 2 * D;
    { float v[8];
#pragma unroll
      for (int k = 0; k < 8; ++k) { const int i = tid + 512 * k, j = i & 2047; v[k] = b_ada[j]; }
#pragma unroll
      for (int q = 0; q < 4; ++q)
#pragma unroll
          for (int k = 0; k < 8; ++k) { const int i = tid + 512 * k, b = i >> 11, j = i & 2047; v[k] += modp[(size_t)(q * 2 + b) * 6 * D + j]; }
#pragma unroll
      for (int k = 0; k < 8; ++k) { const int i = tid + 512 * k, b = i >> 11, j = i & 2047; if (j < D) sh[b * D + j] = v[k]; else ga[b * D + j - D] = g_mix[j - D] * (1.f + v[k]); } }
    { const int i = vcu * NWAVES * 64 + tid;
      if (i < 2 * 6 * D) { const int b = i / (6 * D), j = i % (6 * D); float v = b_ada[j];
#pragma unroll
          for (int q = 0; q < 4; ++q) v += modp[(size_t)(q * 2 + b) * 6 * D + j];
          mod[i] = v; } }
    __syncthreads();
    const int gw = vcu * NWAVES + wave, NGW = G * NWAVES;
    for (int m0 = gw * 4; m0 < M; m0 += NGW * 4) { const int b = m0 >> 13;
        f32x4 v[4][4]; float s[4];
#pragma unroll
        for (int r = 0; r < 4; ++r) { const GAS f32x4* xr = (const GAS f32x4*)(x + (size_t)(m0 + r) * D) + lane;
#pragma unroll
            for (int j = 0; j < 4; ++j) v[r][j] = __builtin_nontemporal_load(xr + 64 * j); }
#pragma unroll
        for (int r = 0; r < 4; ++r) { s[r] = 0.f;
#pragma unroll
            for (int j = 0; j < 4; ++j) s[r] += (v[r][j].x * v[r][j].x + v[r][j].y * v[r][j].y) + (v[r][j].z * v[r][j].z + v[r][j].w * v[r][j].w); }
#pragma unroll
        for (int o = 1; o < 64; o <<= 1) {
#pragma unroll
            for (int r = 0; r < 4; ++r) s[r] += __shfl_xor(s[r], o); }
#pragma unroll
        for (int r = 0; r < 4; ++r) { const float rr = rsqrtf(s[r] * (1.f / D) + RMS_EPS); GAS v2u* o8 = (GAS v2u*)(H1 + (size_t)(m0 + r) * D) + lane;
#pragma unroll
            for (int j = 0; j < 4; ++j) { const f32x4 gg = *(const LAS f32x4*)(ga + b * D + 4 * lane + 256 * j), ss = *(const LAS f32x4*)(sh + b * D + 4 * lane + 256 * j); const f32x4 y = v[r][j] * rr * gg + ss;
                v2u w; w.x = cvt_pk_bf16(y.x, y.y); w.y = cvt_pk_bf16(y.z, y.w); o8[64 * j] = w; } } }
    __syncthreads();
}
__device__ __forceinline__ void phase_conv(const bf16* CV, const bf16* BG, const float* w_conv, bf16* AB, int wave, int lane, int vcu, int G) {
    const int gw = vcu * NWAVES + wave, NGW = G * NWAVES;
    for (int o = gw; o < M / 8; o += NGW) { const int r0 = 8 * o, s0 = r0 & (SEQ - 1);
#pragma unroll
        for (int hseg = 0; hseg < 2; ++hseg) { const int ch = hseg * 512 + 8 * lane; const size_t off = (size_t)r0 * D + ch;
            v4u cv[10], bg[8];
#pragma unroll
            for (int jj = 0; jj < 10; ++jj) { const bool ok = (jj == 0) ? (s0 > 0) : (jj == 9) ? (s0 + 8 < SEQ) : true; cv[jj] = (v4u){0u, 0u, 0u, 0u}; if (ok) cv[jj] = __builtin_nontemporal_load((const GAS v4u*)(CV + off + (size_t)(jj - 1) * D)); }
#pragma unroll
            for (int jj = 0; jj < 8; ++jj) bg[jj] = __builtin_nontemporal_load((const GAS v4u*)(BG + off + (size_t)jj * D));
            float w0[8], w1[8], w2[8];
#pragma unroll
            for (int q = 0; q < 2; ++q) { const f32x4 a = *(const GAS f32x4*)(w_conv + ch + 4 * q), b = *(const GAS f32x4*)(w_conv + D + ch + 4 * q), c2 = *(const GAS f32x4*)(w_conv + 2 * D + ch + 4 * q);
#pragma unroll
                for (int i2 = 0; i2 < 4; ++i2) { w0[4 * q + i2] = a[i2]; w1[4 * q + i2] = b[i2]; w2[4 * q + i2] = c2[i2]; } }
#pragma unroll
            for (int jj = 0; jj < 8; ++jj) { unsigned ow[4];
#pragma unroll
                for (int q = 0; q < 4; ++q) {
                    const float lo = bf_lo(bg[jj][q]) * (w0[2 * q] * bf_lo(cv[jj][q]) + w1[2 * q] * bf_lo(cv[jj + 1][q]) + w2[2 * q] * bf_lo(cv[jj + 2][q]));
                    const float hi = bf_hi(bg[jj][q]) * (w0[2 * q + 1] * bf_hi(cv[jj][q]) + w1[2 * q + 1] * bf_hi(cv[jj + 1][q]) + w2[2 * q + 1] * bf_hi(cv[jj + 2][q]));
                    ow[q] = cvt_pk_bf16(lo, hi); }
                v4u ov; ov.x = ow[0]; ov.y = ow[1]; ov.z = ow[2]; ov.w = ow[3];
                *(GAS v4u*)(AB + off + (size_t)jj * D) = ov; } } }
}
__device__ __forceinline__ void phase_h2(const bf16* X1B, const float* g_moe, const float* mod, const float* w_router, const float* b_router, bf16* H2, unsigned char* H2F8, float* probs,
                                         LAS unsigned char* lds, int tid, int wave, int lane, int vcu, int G) {
    LAS bf16* whi = (LAS bf16*)lds;
    LAS bf16* wlo = whi + 16384;
    LAS float* ga = (LAS float*)(lds + 65536);
    LAS float* sh = ga + 2 * D;
    for (int i = tid; i < 16384; i += NWAVES * 64) { const int j = i & 7, ln = (i >> 3) & 63, kk = i >> 9, k = 32 * kk + 8 * (ln >> 4) + j, e = ln & 15;
        const float w = w_router[k * NE + e]; const unsigned h = f2bf(w); const float wh = __uint_as_float(h << 16); whi[i] = (bf16)h; wlo[i] = (bf16)f2bf(w - wh); }
    { float a[4], b2[4], c2[4];
#pragma unroll
      for (int k = 0; k < 4; ++k) { const int i = tid + 512 * k, b = i >> 10, j = i & 1023; a[k] = mod[b * 6 * D + 3 * D + j]; b2[k] = mod[b * 6 * D + 4 * D + j]; c2[k] = g_moe[j]; }
#pragma unroll
      for (int k = 0; k < 4; ++k) { const int i = tid + 512 * k; sh[i] = a[k]; ga[i] = c2[k] * (1.f + b2[k]); } }
    __syncthreads();
    const int n = lane & 15, kq = lane >> 4;
    float br[4];
#pragma unroll
    for (int r = 0; r < 4; ++r) br[r] = b_router[4 * kq + r];
    for (int grp = wave * G + vcu; grp < M / 16; grp += NWAVES * G) { const int m0 = 16 * grp, b = m0 >> 13;
        const GAS v4u* xr = (const GAS v4u*)(X1B + (size_t)(m0 + n) * D + 8 * kq);
        v4u xf[32]; float ssq = 0.f;
#pragma unroll
        for (int kk = 0; kk < 32; ++kk) xf[kk] = __builtin_nontemporal_load(xr + 4 * kk);
#pragma unroll
        for (int kk = 0; kk < 32; ++kk) { const v4u w = xf[kk]; const float e0 = bf_lo(w.x), e1 = bf_hi(w.x), e2 = bf_lo(w.y), e3 = bf_hi(w.y), e4 = bf_lo(w.z), e5 = bf_hi(w.z), e6 = bf_lo(w.w), e7 = bf_hi(w.w);
            ssq += (e0 * e0 + e1 * e1) + (e2 * e2 + e3 * e3) + (e4 * e4 + e5 * e5) + (e6 * e6 + e7 * e7); }
#pragma unroll
        for (int kk = 0; kk < 32; ++kk) asm volatile("" : "+v"(xf[kk].x), "+v"(xf[kk].y), "+v"(xf[kk].z), "+v"(xf[kk].w));
        ssq += __shfl_xor(ssq, 16); ssq += __shfl_xor(ssq, 32);
        const float rstd = rsqrtf(ssq * (1.f / D) + RMS_EPS);
        f32x4 acc = {0.f, 0.f, 0.f, 0.f};
        GAS v4u* ho = (GAS v4u*)(H2 + (size_t)(m0 + n) * D + 8 * kq);
#pragma unroll
        for (int kk = 0; kk < 32; ++kk) { const v4u w = xf[kk]; const int col = 32 * kk + 8 * kq;
            const f32x4 g0 = *(const LAS f32x4*)(ga + b * D + col), g1 = *(const LAS f32x4*)(ga + b * D + col + 4), s0 = *(const LAS f32x4*)(sh + b * D + col), s1 = *(const LAS f32x4*)(sh + b * D + col + 4);
            float h[8] = {bf_lo(w.x) * rstd * g0.x + s0.x, bf_hi(w.x) * rstd * g0.y + s0.y, bf_lo(w.y) * rstd * g0.z + s0.z, bf_hi(w.y) * rstd * g0.w + s0.w,
                          bf_lo(w.z) * rstd * g1.x + s1.x, bf_hi(w.z) * rstd * g1.y + s1.y, bf_lo(w.w) * rstd * g1.z + s1.z, bf_hi(w.w) * rstd * g1.w + s1.w};
            v4u hh, hl;
            hh.x = cvt_pk_bf16(h[0], h[1]); hh.y = cvt_pk_bf16(h[2], h[3]); hh.z = cvt_pk_bf16(h[4], h[5]); hh.w = cvt_pk_bf16(h[6], h[7]);
            hl.x = cvt_pk_bf16(h[0] - bf_lo(hh.x), h[1] - bf_hi(hh.x)); hl.y = cvt_pk_bf16(h[2] - bf_lo(hh.y), h[3] - bf_hi(hh.y)); hl.z = cvt_pk_bf16(h[4] - bf_lo(hh.z), h[5] - bf_hi(hh.z)); hl.w = cvt_pk_bf16(h[6] - bf_lo(hh.w), h[7] - bf_hi(hh.w));
            if (MOE_FP8) { v2u q8; q8.x = pk4_fp8(h[0], h[1], h[2], h[3]); q8.y = pk4_fp8(h[4], h[5], h[6], h[7]); *(GAS v2u*)(H2F8 + (size_t)(m0 + n) * D + 32 * kk + 8 * kq) = q8; }
            else ho[4 * kk] = hh;
            const bf16x8 ah = *(const LAS bf16x8*)(whi + (kk * 64 + lane) * 8), al = *(const LAS bf16x8*)(wlo + (kk * 64 + lane) * 8);
            const bf16x8 bh = __builtin_bit_cast(bf16x8, hh), bl = __builtin_bit_cast(bf16x8, hl);
            acc = __builtin_amdgcn_mfma_f32_16x16x32_bf16(ah, bh, acc, 0, 0, 0); acc = __builtin_amdgcn_mfma_f32_16x16x32_bf16(al, bh, acc, 0, 0, 0); acc = __builtin_amdgcn_mfma_f32_16x16x32_bf16(ah, bl, acc, 0, 0, 0);
            asm volatile("" ::: "memory"); }
        float lg[4], mx = -3.0e38f;
#pragma unroll
        for (int r = 0; r < 4; ++r) { lg[r] = acc[r] + br[r]; mx = fmaxf(mx, lg[r]); }
        mx = fmaxf(mx, __shfl_xor(mx, 16)); mx = fmaxf(mx, __shfl_xor(mx, 32));
        float sum = 0.f;
#pragma unroll
        for (int r = 0; r < 4; ++r) { lg[r] = __expf(lg[r] - mx); sum += lg[r]; }
        sum += __shfl_xor(sum, 16); sum += __shfl_xor(sum, 32);
        const float inv = 1.0f / sum; const int s = (m0 + n) & (SEQ - 1);
#pragma unroll
        for (int r = 0; r < 4; ++r) probs[((size_t)(b * NE + 4 * kq + r)) * SEQ + s] = lg[r] * inv; }
}
__device__ __forceinline__ void topk_item(const float* probs, int* idx, float* val, int* slot, LAS unsigned char* lds, int item, int tid, int wave, int lane) {
    const int e = item >> 1, b = item & 1;
    LAS int* red = (LAS int*)lds;
    unsigned p[16];
#pragma unroll
    for (int q = 0; q < 4; ++q) { const v4u w = __builtin_nontemporal_load((const GAS v4u*)(probs + ((size_t)(b * NE + e)) * SEQ + 16 * tid + 4 * q)); p[4 * q] = w.x; p[4 * q + 1] = w.y; p[4 * q + 2] = w.z; p[4 * q + 3] = w.w; }
    unsigned prefix = 0u;
    for (int bit = 30; bit >= 0; --bit) { const unsigned cand = prefix | (1u << bit); int cnt = 0;
#pragma unroll
        for (int j = 0; j < 16; ++j) cnt += __popcll(__ballot(p[j] >= cand));
        const int par = bit & 1;
        if (lane == 0) red[par * 8 + wave] = cnt;
        __syncthreads();
        int tot = 0;
#pragma unroll
        for (int w = 0; w < 8; ++w) tot += red[par * 8 + w];
        if (tot >= CAP) prefix = cand; }
    const unsigned T = prefix;
    int cgt = 0, ceq = 0;
#pragma unroll
    for (int j = 0; j < 16; ++j) { cgt += (p[j] > T) ? 1 : 0; ceq += (p[j] == T) ? 1 : 0; }
    int sgt = cgt, seq = ceq;
#pragma unroll
    for (int o = 1; o < 64; o <<= 1) { const int a = __shfl_up(sgt, o), c = __shfl_up(seq, o); if (lane >= o) { sgt += a; seq += c; } }
    __syncthreads();
    if (lane == 63) { red[32 + wave] = sgt; red[48 + wave] = seq; }
    __syncthreads();
    int bgt = 0, beq = 0, totgt = 0;
#pragma unroll
    for (int w = 0; w < 8; ++w) { const int a = red[32 + w], c = red[48 + w]; if (w < wave) { bgt += a; beq += c; } totgt += a; }
    int rgt = bgt + sgt - cgt, req = beq + seq - ceq;
    const int need = CAP - totgt; const int rbase = (e * 2 + b) * CAP;
#pragma unroll
    for (int j = 0; j < 16; ++j) { const int tok = b * SEQ + 16 * tid + j; int sl = -1;
        if (p[j] > T) { sl = rgt; ++rgt; } else if (p[j] == T) { if (req < need) sl = totgt + req; ++req; }
        slot[(size_t)tok * NE + e] = sl;
        if (sl >= 0) { idx[rbase + sl] = tok; val[rbase + sl] = __uint_as_float(p[j]); } }
    __syncthreads();
}
__device__ __forceinline__ void phase_gather(const bf16* H2, const int* idx, bf16* XE, int wave, int lane, int vcu, int G) {
    const int gw = vcu * NWAVES + wave, NGW = G * NWAVES;
    for (int r = gw; r < MR; r += NGW) { const int tok = idx[r];
        const GAS v4u* src = (const GAS v4u*)(H2 + (size_t)tok * D) + lane; GAS v4u* dst = (GAS v4u*)(XE + (size_t)r * D) + lane;
        const v4u a = src[0], b2 = src[64]; dst[0] = a; dst[64] = b2; }
}
__device__ __forceinline__ void phase_final(float* out, const bf16* X1B, const bf16* Y, const int* slot, const float* mod, const float* g_fin, int wave, int lane, int vcu, int G, float pert) {
    const int gw = vcu * NWAVES + wave, NGW = G * NWAVES;
    int slv[2]; v2u xw[2][4];
#define PF_FETCH(mm) do { _Pragma("unroll") for (int r = 0; r < 2; ++r) { slv[r] = slot[(size_t)((mm) + r) * NE + (lane & 15)]; const GAS v2u* xr_ = (const GAS v2u*)(X1B + (size_t)((mm) + r) * D) + lane; \
        _Pragma("unroll") for (int j = 0; j < 4; ++j) xw[r][j] = __builtin_nontemporal_load(xr_ + 64 * j); } } while (0)
    int m0 = gw * 2;
    if (m0 < M) PF_FETCH(m0);
    for (; m0 < M; m0 += NGW * 2) { const int b = m0 >> 13;
        int cs[2]; f32x4 v[2][4], a[2][4];
#pragma unroll
        for (int r = 0; r < 2; ++r) { cs[r] = slv[r];
#pragma unroll
            for (int j = 0; j < 4; ++j) { const v2u w = xw[r][j]; v[r][j] = (f32x4){bf_lo(w.x), bf_hi(w.x), bf_lo(w.y), bf_hi(w.y)}; a[r][j] = (f32x4){0.f, 0.f, 0.f, 0.f}; } }
        const int mn = m0 + NGW * 2;
        if (mn < M) PF_FETCH(mn);
        unsigned long long mask[2]; bool more = false;
#pragma unroll
        for (int r = 0; r < 2; ++r) mask[r] = __ballot(cs[r] >= 0) & 0xFFFFull;
        do { const GAS v2u* yp[2][4]; bool ok[2][4]; v2u w[2][4][4];
#pragma unroll
            for (int r = 0; r < 2; ++r)
#pragma unroll
                for (int c = 0; c < 4; ++c) { ok[r][c] = (mask[r] != 0ull); const int e = ok[r][c] ? (int)__builtin_ctzll(mask[r]) : 0; mask[r] &= (mask[r] - 1ull);
                    const int sl = __builtin_amdgcn_readlane(cs[r], e); yp[r][c] = (const GAS v2u*)(Y + ((size_t)(e * 2 + b) * CAP + (ok[r][c] ? sl : 0)) * D) + lane; }
#pragma unroll
            for (int r = 0; r < 2; ++r)
#pragma unroll
                for (int c = 0; c < 4; ++c) if (ok[r][c]) {
#pragma unroll
                    for (int j = 0; j < 4; ++j) w[r][c][j] = __builtin_nontemporal_load(yp[r][c] + 64 * j); }
#pragma unroll
            for (int r = 0; r < 2; ++r)
#pragma unroll
                for (int c = 0; c < 4; ++c) if (ok[r][c]) {
#pragma unroll
                    for (int j = 0; j < 4; ++j) { a[r][j].x += bf_lo(w[r][c][j].x); a[r][j].y += bf_hi(w[r][c][j].x); a[r][j].z += bf_lo(w[r][c][j].y); a[r][j].w += bf_hi(w[r][c][j].y); } }
            more = (mask[0] | mask[1]) != 0ull;
        } while (more);
        float s[2];
#pragma unroll
        for (int r = 0; r < 2; ++r) { s[r] = 0.f;
#pragma unroll
            for (int j = 0; j < 4; ++j) { const f32x4 gf = *(const GAS f32x4*)(mod + b * 6 * D + 5 * D + 4 * lane + 256 * j); v[r][j] = v[r][j] + gf * a[r][j]; s[r] += (v[r][j].x * v[r][j].x + v[r][j].y * v[r][j].y) + (v[r][j].z * v[r][j].z + v[r][j].w * v[r][j].w); } }
#pragma unroll
        for (int o = 1; o < 64; o <<= 1) { s[0] += __shfl_xor(s[0], o); s[1] += __shfl_xor(s[1], o); }
#pragma unroll
        for (int r = 0; r < 2; ++r) { const float rr = rsqrtf(s[r] * (1.f / D) + RMS_EPS); GAS f32x4* xo = (GAS f32x4*)(out + (size_t)(m0 + r) * D) + lane;
#pragma unroll
            for (int j = 0; j < 4; ++j) { const f32x4 gg = *(const GAS f32x4*)(g_fin + 4 * lane + 256 * j); __builtin_nontemporal_store(v[r][j] * rr * gg + pert, xo + 64 * j); } } }
#undef PF_FETCH
}
__device__ __forceinline__ void fft_item(LAS unsigned char* lds, const bf16* UF, bf16* ZF, const bf16* Fc1, const bf16* Fc2, int item, int wave, int lane) {
    const char* slab = (const char*)UF + (size_t)item * 65536;
    { v4u xv[8];
#pragma unroll
      for (int p = 0; p < 8; ++p) { const int s1 = 8 * p + wave; xv[p] = __builtin_nontemporal_load((const GAS v4u*)(slab + s1 * 1024 + ((16 * lane - 32 * ((s1 >> 3) & 3)) & 1023))); }
#pragma unroll
      for (int p = 0; p < 8; ++p) *(LAS v4u*)(lds + (8 * p + wave) * 1024 + 16 * lane) = xv[p]; }
    bf16x8 A2[2][8];
#pragma unroll
    for (int ro = 0; ro < 2; ++ro)
#pragma unroll
        for (int kk = 0; kk < 8; ++kk) A2[ro][kk] = *(const GAS bf16x8*)(Fc2 + ((size_t)(((wave * 2 + ro) * 8 + kk) * 64 + lane)) * 8);
    LDS_WAIT(); __syncthreads();
    const int fr = lane & 15, fq = lane >> 4, ch = lane & 3, s2l = (lane & 15) >> 2;
    char* zb = (char*)ZF + (size_t)item * 131072;
    for (int hh = 0; hh < 2; ++hh) {
        { bf16x8 A1[4][2];
#pragma unroll
          for (int mt = 0; mt < 4; ++mt)
#pragma unroll
              for (int kk = 0; kk < 2; ++kk) A1[mt][kk] = *(const GAS bf16x8*)(Fc1 + ((size_t)(((hh * 4 + mt) * 2 + kk) * 64 + lane)) * 8);
          for (int jn = 0; jn < 4; ++jn) { const int nt = wave + 8 * jn, s2 = 4 * nt + s2l;
            bf16x8 Bx[2];
#pragma unroll
            for (int kk = 0; kk < 2; ++kk)
#pragma unroll
                for (int j = 0; j < 8; ++j) { const int s1 = 32 * kk + 8 * fq + j; Bx[kk][j] = *(const LAS short*)(lds + s1 * 1024 + ((s2 * 8 + ch * 2 + 32 * fq) & 1023)); }
            f32x4 acc[4];
#pragma unroll
            for (int mt = 0; mt < 4; ++mt) { acc[mt] = (f32x4){0.f, 0.f, 0.f, 0.f};
#pragma unroll
                for (int kk = 0; kk < 2; ++kk) acc[mt] = __builtin_amdgcn_mfma_f32_16x16x32_bf16(A1[mt][kk], Bx[kk], acc[mt], 0, 0, 0); }
#pragma unroll
            for (int blk = 0; blk < 2; ++blk)
#pragma unroll
                for (int r = 0; r < 4; ++r) { const int k1l = 16 * blk + 4 * r + fq, k1 = 32 * hh + k1l; const float dr = acc[blk][r], di = acc[2 + blk][r];
                    const float frac = (float)((s2 * k1) & 8191) * (1.0f / 8192.0f), c = __builtin_amdgcn_cosf(frac), s = __builtin_amdgcn_sinf(frac);
                    *(LAS unsigned*)(lds + FFT_TOFF + (k1l * 4 + ch) * FFT_TPITCH + s2 * 4) = cvt_pk_bf16(dr * c + di * s, di * c - dr * s); } } }
        LDS_WAIT(); __syncthreads();
        for (int nt2 = 0; nt2 < 8; ++nt2) { f32x4 c0 = {0.f, 0.f, 0.f, 0.f}, c1 = {0.f, 0.f, 0.f, 0.f};
#pragma unroll
            for (int kk = 0; kk < 8; ++kk) { const bf16x8 Bt = *(const LAS bf16x8*)(lds + FFT_TOFF + (16 * nt2 + fr) * FFT_TPITCH + kk * 64 + fq * 16);
                c0 = __builtin_amdgcn_mfma_f32_16x16x32_bf16(A2[0][kk], Bt, c0, 0, 0, 0); c1 = __builtin_amdgcn_mfma_f32_16x16x32_bf16(A2[1][kk], Bt, c1, 0, 0, 0); }
            const int k1 = 32 * hh + 4 * nt2 + s2l;
#pragma unroll
            for (int r = 0; r < 4; ++r) { const int k = k1 + 64 * (16 * wave + 4 * fq + r); *(GAS unsigned*)(zb + (size_t)k * 16 + ch * 4) = cvt_pk_bf16(c0[r], c1[r]); } }
        LDS_WAIT(); __syncthreads();
    }
}
#if MOE_FP8
#define EXPERT_ITEM(r_) do { const int e_ = (r_) / 3072, q_ = (r_) % 3072; \
    if (q_ < 1024) transpose_item8<2>(w_g + (size_t)e_ * D * DE, D, DE, WGU8 + (size_t)e_ * 4096 * D, scr, q_, lane); \
    else if (q_ < 2048) transpose_item8<3>(w_u + (size_t)e_ * D * DE, D, DE, WGU8 + (size_t)e_ * 4096 * D, scr, q_ - 1024, lane); \
    else transpose_item8<0>(w_d + (size_t)e_ * DE * D, DE, D, WD8 + (size_t)e_ * D * DE, scr, q_ - 2048, lane); } while (0)
#else
#define EXPERT_ITEM(r_) do { const int e_ = (r_) / 3072, q_ = (r_) % 3072; \
    if (q_ < 1024) transpose_item<2>(w_g + (size_t)e_ * D * DE, D, DE, WGU + (size_t)e_ * 4096 * D, scr, q_, lane); \
    else if (q_ < 2048) transpose_item<3>(w_u + (size_t)e_ * D * DE, D, DE, WGU + (size_t)e_ * 4096 * D, scr, q_ - 1024, lane); \
    else transpose_item<0>(w_d + (size_t)e_ * DE * D, DE, D, WD + (size_t)e_ * D * DE, scr, q_ - 2048, lane); } while (0)
#endif
#ifndef EXP_P2
#define EXP_P2 10240
#endif
#ifndef EXP_P7
#define EXP_P7 14336
#endif
#ifndef EXP_P6
#define EXP_P6 16384
#endif
constexpr int EXP_TOTAL = NE * 3072, EXP_P0 = EXP_TOTAL - EXP_P2 - EXP_P7 - EXP_P6;

constexpr int NPHASE = 12;
#ifndef MOE_ALIGN
#define MOE_ALIGN true
#endif
#ifndef EXTRA_BARS
#define EXTRA_BARS 0
#endif
#ifndef STAGGER_US
#define STAGGER_US 0
#endif
#ifndef DOUBLE_PH
#define DOUBLE_PH -1
#endif
#define REP(k) for (int rep_ = 0; rep_ < ((DOUBLE_PH == (k)) ? 2 : 1); ++rep_)
#define REPBAR(k) do { if (DOUBLE_PH == (k) && rep_ == 0) xcd_barrier(bar); } while (0)
#ifndef PROBE_I
#define PROBE_I -1
#endif
#ifndef PROBE_J
#define PROBE_J -1
#endif
#ifndef DBG_PLAIN
#define DBG_PLAIN 0
#endif
#ifndef GALIGN
#define GALIGN true
#endif
#ifndef GSP2
#define GSP2 true
#endif
struct Args { const float* in[18]; float* out; unsigned char* ws; int ph_lo, ph_hi; };
__global__ void __launch_bounds__(NWAVES * 64, 2) fwd(Args args) {
    extern __shared__ __attribute__((aligned(16))) unsigned char lds_raw[];
    LAS unsigned char* lds = (LAS unsigned char*)lds_raw;
    volatile LAS unsigned* MISC = (volatile LAS unsigned*)(lds + MISC_OFF);
    const int tid = threadIdx.x, lane = tid & 63, wave = __builtin_amdgcn_readfirstlane(tid >> 6);
    const int G = gridDim.x; const int bx = blockIdx.x; const int vcu = (G % 8 == 0) ? (bx % 8) * (G / 8) + bx / 8 : bx;
    unsigned char* ws = args.ws;
    const float *x = args.in[0], *c = args.in[1], *w_ada = args.in[2], *b_ada = args.in[3], *g_mix = args.in[4], *w_in = args.in[5], *b_gate = args.in[6], *w_f = args.in[7], *w_conv = args.in[8],
                *w_co = args.in[9], *w_o = args.in[10], *g_moe = args.in[11], *w_r = args.in[12], *b_r = args.in[13], *w_g = args.in[14], *w_u = args.in[15], *w_d = args.in[16], *g_fin = args.in[17];
    float* out = args.out;
    float *modp = (float*)(ws + WS_MODP), *mod = (float*)(ws + WS_MOD), *probs = (float*)(ws + WS_PROBS), *val = (float*)(ws + WS_VAL);
    int *slot = (int*)(ws + WS_SLOT), *idx = (int*)(ws + WS_IDX);
    bf16 *Fc1 = (bf16*)(ws + WS_FC1), *Fc2 = (bf16*)(ws + WS_FC2), *WIN = (bf16*)(ws + WS_WIN), *WF = (bf16*)(ws + WS_WF), *WCO = (bf16*)(ws + WS_WCO), *WO = (bf16*)(ws + WS_WO), *WGU = (bf16*)(ws + WS_WGU), *WD = (bf16*)(ws + WS_WD);
    bf16 *H1 = (bf16*)(ws + WS_H1), *AB = (bf16*)(ws + WS_AB), *UF = (bf16*)(ws + WS_UF), *CV = (bf16*)(ws + WS_CV), *BG = (bf16*)(ws + WS_BG), *GA = (bf16*)(ws + WS_GA), *GB = (bf16*)(ws + WS_GB), *ZF = (bf16*)(ws + WS_ZF),
         *TZ = (bf16*)(ws + WS_TZ), *H2 = (bf16*)(ws + WS_H2), *HM = (bf16*)(ws + WS_HM), *Y = (bf16*)(ws + WS_Y), *X1B = (bf16*)(ws + WS_X1B);
    unsigned char *WGU8 = ws + WS_WGU, *WD8 = ws + WS_WD, *H2F8 = ws + WS_H2, *HM8 = ws + WS_HM;
    for (int u = tid; u < (LDS_BYTES - MISC_OFF) / 4; u += NWAVES * 64) ((LAS unsigned*)(lds + MISC_OFF))[u] = 0u;
    __syncthreads();
    const int lo = args.ph_lo, hi = args.ph_hi;
    XcdBarrier bar; bar.bar = (unsigned*)(ws + WS_CTL) + CW_BAR; bar.x = 0; bar.st = nullptr;
    if (hi - lo > 1) bar = xcd_barrier_post((unsigned*)(ws + WS_CTL) + CW_BAR, MISC + 8);
#define IN(k) (lo <= (k) && (k) < hi)
#if PROBE_I >= 0
    unsigned long long* tsb = (unsigned long long*)(ws + WS_CTL + 512 * 1024);
    if (bx == 0 && tid == 0) tsb[0] = __builtin_amdgcn_s_memrealtime();
#define GRID_BAR(k) do { if (IN(k) && IN((k) + 1)) xcd_barrier(bar); if (bx == 0 && tid == 0) tsb[(k) + 1] = __builtin_amdgcn_s_memrealtime(); } while (0)
#else
#define GRID_BAR(k) do { if (IN(k) && IN((k) + 1)) xcd_barrier(bar); } while (0)
#endif
    const int gw = vcu * NWAVES + wave, NGW = G * NWAVES;
    LAS float* scr = (LAS float*)(lds + wave * 16384);

    if (IN(0)) REP(0) {
        if (vcu < 96) mod_item(c, w_ada, modp, lds, vcu, tid, wave, lane);
#if PROBE_I >= 0
        if (bx == 0 && tid == 0) tsb[22] = __builtin_amdgcn_s_memrealtime();
#endif
        fc_tables(Fc1, Fc2, vcu * NWAVES * 64 + tid, G * NWAVES * 64);
#if PROBE_I >= 0
        if (bx == 0 && tid == 0) tsb[23] = __builtin_amdgcn_s_memrealtime();
#endif
        constexpr int I_WF = 2048, I_IN = 16 * 176, I_SQ = 16 * 32, I_EX = 3072, NITEMS = I_WF + I_IN + 2 * I_SQ + NE * I_EX;
        if (vcu >= 96) { const int w0 = (vcu - 96) * NWAVES + wave, nw0 = (G - 96) * NWAVES;
            for (int r = w0; r < I_WF; r += nw0) wf_item(w_f, WF, r, lane); }
        for (int it = I_WF + gw; it < NITEMS; it += NGW) {
            int r = it - I_WF;
            if (r < I_IN) { transpose_item<1>(w_in, D, DIN, WIN, scr, r, lane); continue; } r -= I_IN;
            if (r < I_SQ) { transpose_item<0>(w_co, D, D, WCO, scr, r, lane); continue; } r -= I_SQ;
            if (r < I_SQ) { transpose_item<0>(w_o, D, D, WO, scr, r, lane); continue; } r -= I_SQ;
            if (r >= EXP_P0) continue;
            EXPERT_ITEM(r);
        }
#if PROBE_I >= 0
        asm volatile("s_waitcnt vmcnt(0)" ::: "memory"); __syncthreads(); if (bx == 0 && tid == 0) tsb[24] = __builtin_amdgcn_s_memrealtime();
#endif
        GRID_BAR(0);
    }
    if (IN(1)) REP(1) { phase_h(x, g_mix, b_ada, modp, mod, H1, lds, tid, wave, lane, vcu, G); GRID_BAR(1); }
#if EXTRA_BARS > 0
    if (IN(1) && IN(2)) { for (int eb = 0; eb < EXTRA_BARS; ++eb) xcd_barrier(bar); }
#endif
    if (IN(2)) REP(2) {
#if STAGGER_US > 0
        if (bx >= 128) { const unsigned long long t0 = __builtin_amdgcn_s_memrealtime(); while (__builtin_amdgcn_s_memrealtime() - t0 < (unsigned long long)(STAGGER_US * 100)) __builtin_amdgcn_s_sleep(8); }
#endif
        pg8::Gemm g{H1, WIN, M, DIN, D, 0, 0, nullptr}; pg8::StaticOrder S; S.init(M, DIN, G, bx);
#if DBG_PLAIN
        EpiPlain E{UF, DIN};
        pg8::gemm_phase<EpiPlain, pg8::StaticOrder, 0, GALIGN, GSP2>(lds, g, S, E);
#else
        EpiInProj E{UF, CV, BG, GA, GB, b_gate};
        pg8::gemm_phase<EpiInProj, pg8::StaticOrder, 0, GALIGN, GSP2>(lds, g, S, E);
#endif
        if (bx >= G / 2) { const int w2 = (bx - G / 2) * NWAVES + wave, nw2 = (G - G / 2) * NWAVES;
            for (int r = EXP_P0 + EXP_P6 + w2; r < EXP_P0 + EXP_P6 + EXP_P2; r += nw2) EXPERT_ITEM(r); }
        GRID_BAR(2);
    }
    if (IN(3)) REP(3) {
        if (bx & 1) phase_conv(CV, BG, w_conv, AB, wave, lane, vcu, G);
        for (int it = vcu; it < BATCH * 128; it += G) fft_item(lds, UF, ZF, Fc1, Fc2, it, wave, lane);
#if PROBE_I >= 0
        __syncthreads(); if (bx == 0 && tid == 0) tsb[20] = __builtin_amdgcn_s_memrealtime();
#endif
        if (!(bx & 1)) phase_conv(CV, BG, w_conv, AB, wave, lane, vcu, G);
#if PROBE_I >= 0
        asm volatile("s_waitcnt vmcnt(0)" ::: "memory"); __syncthreads(); if (bx == 0 && tid == 0) tsb[21] = __builtin_amdgcn_s_memrealtime();
#endif
        GRID_BAR(3);
    }
    if (IN(4)) REP(4) {
        { pg8::Gemm g{ZF, WF, M, D, D, 0, 0, nullptr}; pg8::StaticOrder S; S.init(M, D, G, bx); EpiGateMul<0> E{TZ, GA};
          pg8::gemm_phase<EpiGateMul<0>, pg8::StaticOrder, 1, true, true>(lds, g, S, E); }
        { pg8::Gemm g{AB, WCO, M, D, D, 0, 0, nullptr}; pg8::StaticOrder S; S.init(M, D, G, bx); EpiGateMul<1> E{TZ, GB};
          pg8::gemm_phase<EpiGateMul<1>, pg8::StaticOrder, 0, true, true>(lds, g, S, E); }
        GRID_BAR(4);
    }
    if (IN(5)) REP(5) {
        pg8::Gemm g{TZ, WO, M, D, D, 0, 0, nullptr}; pg8::StaticOrder S; S.init(M, D, G, bx); EpiResid E{x, X1B, mod + 2 * D};
        pg8::gemm_phase<EpiResid, pg8::StaticOrder, 0, true, true>(lds, g, S, E);
        GRID_BAR(5);
    }
    if (IN(6)) REP(6) { phase_h2(X1B, g_moe, mod, w_r, b_r, H2, H2F8, probs, lds, tid, wave, lane, vcu, G);
        if (wave >= 4) { LAS float* scr6 = (LAS float*)(lds + 81920 + (wave - 4) * 8448);
            const int w6 = vcu * 4 + (wave - 4), nw6 = G * 4; LAS float* scr = scr6;
            for (int r = EXP_P0 + w6; r < EXP_P0 + EXP_P6; r += nw6) EXPERT_ITEM(r); }
        __syncthreads(); GRID_BAR(6); }
    if (IN(7)) REP(7) { for (int it = vcu; it < NE * BATCH; it += G) topk_item(probs, idx, val, slot, lds, it, tid, wave, lane);
        if (vcu >= NE * BATCH) { const int w7 = (vcu - NE * BATCH) * NWAVES + wave, nw7 = (G - NE * BATCH) * NWAVES;
            for (int r = EXP_P0 + EXP_P6 + EXP_P2 + w7; r < EXP_TOTAL; r += nw7) EXPERT_ITEM(r); }
        GRID_BAR(7); }
    if (IN(9)) REP(9) {
#if MOE_FP8
        pg8::Gemm g{(const bf16*)H2F8, (const bf16*)WGU8, MR, 2 * DE, D / 2, 8, (size_t)2 * DE * D / 2, idx}; pg8::StaticOrder S; S.init(MR, 2 * DE, G, bx); EpiSwiGLU8 E{HM8};
        pg8::gemm_phase<EpiSwiGLU8, pg8::StaticOrder, 2, MOE_ALIGN, true, true>(lds, g, S, E);
#else
        pg8::Gemm g{H2, WGU, MR, 2 * DE, D, 8, (size_t)2 * DE * D, idx}; pg8::StaticOrder S; S.init(MR, 2 * DE, G, bx); EpiSwiGLU E{HM};
        pg8::gemm_phase<EpiSwiGLU, pg8::StaticOrder, 2, true, true>(lds, g, S, E);
#endif
        GRID_BAR(9);
    }
    if (IN(10)) REP(10) {
#if MOE_FP8
        pg8::Gemm g{(const bf16*)HM8, (const bf16*)WD8, MR, D, DE / 2, 8, (size_t)D * DE / 2, nullptr}; pg8::StaticOrder S; S.init(MR, D, G, bx); EpiRowScale E{Y, val};
        pg8::gemm_phase<EpiRowScale, pg8::StaticOrder, 0, MOE_ALIGN, true, true>(lds, g, S, E);
#else
        pg8::Gemm g{HM, WD, MR, D, DE, 8, (size_t)D * DE, nullptr}; pg8::StaticOrder S; S.init(MR, D, G, bx); EpiRowScale E{Y, val};
        pg8::gemm_phase<EpiRowScale, pg8::StaticOrder, 0, true, true>(lds, g, S, E);
#endif
#if PROBE_I >= 0
        if (bx == 0 && tid == 0) tsb[12] = __builtin_amdgcn_s_memrealtime();
#endif
        GRID_BAR(10);
    }
#if PROBE_I >= 0
    float pert = 0.f;
    if (IN(11)) { const unsigned long long a0 = __hip_atomic_load(tsb + (PROBE_I == 100 ? 0 : PROBE_I == 9 ? 8 : PROBE_I), __ATOMIC_RELAXED, __HIP_MEMORY_SCOPE_AGENT), a1 = __hip_atomic_load(tsb + (PROBE_I == 100 ? 12 : PROBE_I == 10 ? 12 : PROBE_I + 1), __ATOMIC_RELAXED, __HIP_MEMORY_SCOPE_AGENT); pert = (float)(a1 - a0) * 0.01f * (PROBE_I == 100 ? (1.0f / 64000.0f) : (1.0f / 16000.0f)); }
    if (PROBE_I == 102) { pert = 0.f; if (bx == 0 && tid == 0) tsb[14] = __builtin_amdgcn_s_memrealtime(); __syncthreads(); }
    if (PROBE_I >= 310 && PROBE_I <= 313) { pert = 0.f; if (bx == 0) { const int ia = (PROBE_I == 310 ? 0 : PROBE_I == 311 ? 22 : PROBE_I == 312 ? 23 : 24), ib = (PROBE_I == 310 ? 22 : PROBE_I == 311 ? 23 : PROBE_I == 312 ? 24 : 1);
        const unsigned long long a0 = __hip_atomic_load(tsb + ia, __ATOMIC_RELAXED, __HIP_MEMORY_SCOPE_AGENT), a1 = __hip_atomic_load(tsb + ib, __ATOMIC_RELAXED, __HIP_MEMORY_SCOPE_AGENT); pert = (float)(a1 - a0) * 0.01f * (1.0f / 250.0f); } }
    else if (PROBE_I == 300 || PROBE_I == 301 || PROBE_I == 302) { pert = 0.f; if (bx == 0) { const unsigned long long a0 = __hip_atomic_load(tsb + (PROBE_I == 300 ? 3 : PROBE_I == 301 ? 20 : 21), __ATOMIC_RELAXED, __HIP_MEMORY_SCOPE_AGENT), a1 = __hip_atomic_load(tsb + (PROBE_I == 300 ? 20 : PROBE_I == 301 ? 21 : 4), __ATOMIC_RELAXED, __HIP_MEMORY_SCOPE_AGENT); pert = (float)(a1 - a0) * 0.01f * (1.0f / 250.0f); } }
    else if (PROBE_I >= 200) { pert = 0.f; if (bx == 0) { const int k_ = PROBE_I - 200; const unsigned long long a0 = __hip_atomic_load(tsb + (k_ == 9 ? 8 : k_), __ATOMIC_RELAXED, __HIP_MEMORY_SCOPE_AGENT), a1 = __hip_atomic_load(tsb + k_ + 1, __ATOMIC_RELAXED, __HIP_MEMORY_SCOPE_AGENT); pert = (float)(a1 - a0) * 0.01f * (1.0f / 250.0f); } }
    if (PROBE_I == 101) { pert = 0.f; if (bx == 0) { const unsigned long long a0 = __hip_atomic_load(tsb + 12, __ATOMIC_RELAXED, __HIP_MEMORY_SCOPE_AGENT); pert = (float)(__builtin_amdgcn_s_memrealtime() - a0) * 0.01f * (1.0f / 250.0f); } }
    if (IN(11)) phase_final(out, X1B, Y, slot, mod, g_fin, wave, lane, vcu, G, pert);
    if (PROBE_I == 102) {
        const unsigned long long t_a = tsb[14];
        xcd_barrier(bar);
        if (bx == 0) { const float pp = (float)(__builtin_amdgcn_s_memrealtime() - t_a) * 0.01f * (1.0f / 250.0f);
            for (int k = 0; k < 4; ++k) for (int r = 0; r < 2; ++r) { float* row = out + (size_t)(2 * (vcu * NWAVES + wave) + r + 4096 * k) * D; for (int cc = lane; cc < D; cc += 64) row[cc] += pp; } } }
#else
    if (IN(11)) REP(11) { phase_final(out, X1B, Y, slot, mod, g_fin, wave, lane, vcu, G, 0.f); if (DOUBLE_PH == 11 && rep_ == 0) xcd_barrier(bar); }
#endif

#undef IN
#undef GRID_BAR
}


struct DumpArgs { const unsigned short* p[8]; unsigned long long n[8]; int f32[8]; int nb; int pad; };
__global__ void k_dump(float* out, DumpArgs a) {
    const size_t i = (size_t)blockIdx.x * blockDim.x + threadIdx.x; float s = 0.f;
    for (int b = 0; b < a.nb; ++b) for (size_t j = i; j < a.n[b]; j += (size_t)M * D) s += (a.f32[b] ? ((const float*)a.p[b])[j] : __uint_as_float(((unsigned)a.p[b][j]) << 16)) * (float)(b + 1);
    out[i] = s;
}
#ifndef DUMP_WHICH
#define DUMP_WHICH -1
#endif
#ifndef STOP_AFTER
#define STOP_AFTER (NPHASE - 1)
#endif
#ifndef MK_PER_PHASE
#define MK_PER_PHASE 0
#endif
extern "C" void kernel_launch(void* const* d_in, const int* in_sizes, int n_in, void* d_out, int out_size, void* d_ws, size_t ws_size, hipStream_t stream) {
    static int grid = 0;
    if (grid == 0) {
        if (n_in != 18 || in_sizes[0] != M * D || out_size != M * D || ws_size < WS_END) { fprintf(stderr, "kernel_launch: unexpected shapes (n_in %d, in0 %d, out %d, ws %zu); nothing launched\n", n_in, n_in > 0 ? in_sizes[0] : -1, out_size, ws_size); grid = -1; return; }
        int dev = 0, cus = 0, per_cu = 0;
        if (hipGetDevice(&dev) != hipSuccess || hipDeviceGetAttribute(&cus, hipDeviceAttributeMultiprocessorCount, dev) != hipSuccess) { grid = -1; return; }
        if (hipFuncSetAttribute((const void*)fwd, hipFuncAttributeMaxDynamicSharedMemorySize, LDS_BYTES) != hipSuccess) { fprintf(stderr, "kernel_launch: hipFuncSetAttribute failed\n"); grid = -1; return; }
        if (hipOccupancyMaxActiveBlocksPerMultiprocessor(&per_cu, (const void*)fwd, NWAVES * 64, LDS_BYTES) != hipSuccess || per_cu < 1) { fprintf(stderr, "kernel_launch: occupancy query reports %d blocks per CU\n", per_cu); }
        (void)hipGetLastError();
        grid = cus;
    }
    if (grid < 0) return;
    (void)hipMemsetAsync((char*)d_ws + WS_CTL, 0, CTL_ZERO_BYTES, stream);
    Args a{};
    for (int i = 0; i < 18; ++i) a.in[i] = (const float*)d_in[i];
    a.out = (float*)d_out; a.ws = (unsigned char*)d_ws;
#if MK_PER_PHASE
    for (int p = 0; p < STOP_AFTER + 1; ++p) { a.ph_lo = p; a.ph_hi = p + 1; hipLaunchKernelGGL(fwd, dim3(grid), dim3(NWAVES * 64), LDS_BYTES, stream, a); }
#if DUMP_WHICH >= 0
    { DumpArgs da{}; unsigned char* w = (unsigned char*)d_ws; int nb = 0;
      auto add = [&](size_t off, size_t n, int isf = 0) { da.p[nb] = (const unsigned short*)(w + off); da.n[nb] = n; da.f32[nb] = isf; ++nb; };
      if (DUMP_WHICH == 0) { add(WS_WIN, (size_t)DIN * D); add(WS_WF, (size_t)D * D); add(WS_WCO, (size_t)D * D); add(WS_WO, (size_t)D * D); add(WS_WGU, (size_t)NE * 4096 * D); add(WS_WD, (size_t)NE * D * DE); add(WS_FC1, 8192 + 0); add(WS_MODP, 4 * 2 * 6 * D, 1); }
      if (DUMP_WHICH == 1) { add(WS_H1, (size_t)M * D); add(WS_MOD, 2 * 6 * D, 1); add(WS_FC2, 65536); }
      if (DUMP_WHICH == 2) { add(WS_UF, (size_t)M * DF); add(WS_CV, (size_t)M * D); add(WS_BG, (size_t)M * D); add(WS_GA, (size_t)M * D); add(WS_GB, (size_t)M * D); }
      if (DUMP_WHICH == 5) { add(WS_UF, (size_t)M * DIN); }
      if (DUMP_WHICH == 6) { add(WS_UF, (size_t)M * DF); add(WS_CV, (size_t)M * D); }
      if (DUMP_WHICH == 7) { add(WS_BG, (size_t)M * D); }
      if (DUMP_WHICH == 8) { add(WS_GA, (size_t)M * D); add(WS_GB, (size_t)M * D); }
      if (DUMP_WHICH == 9) { add(WS_GA, (size_t)M * D); }
      if (DUMP_WHICH == 10) { add(WS_GB, (size_t)M * D); }
      if (DUMP_WHICH == 3) { add(WS_ZF, (size_t)M * D); add(WS_AB, (size_t)M * D); }
      if (DUMP_WHICH == 4) { add(WS_TZ, (size_t)M * D); }
      da.nb = nb; hipLaunchKernelGGL(k_dump, dim3(M * D / 256), dim3(256), 0, stream, (float*)d_out, da); }
#endif
#else
    a.ph_lo = 0; a.ph_hi = NPHASE; hipLaunchKernelGGL(fwd, dim3(grid), dim3(NWAVES * 64), LDS_BYTES, stream, a);
#endif
}
```

```cpp
#include <hip/hip_runtime.h>
#include <cstdio>
#include <cstdint>
#define MK_PER_PHASE 0
#define STOP_AFTER 11
#define DUMP_WHICH -1
#define GALIGN true
#define GSP2 true
#define DBG_PLAIN 0
#define DBG_NOBIAS 0
#define DBG_NOSIG 0
#define PROBE_I -1
#define PROBE_J -1
#define DOUBLE_PH -1
#define STAGGER_US 0
#define EXTRA_BARS 0
#define DBG_EPI2 0
#ifndef PROBE_I
#define PROBE_I -1
#endif
#ifndef DBG_EPI2
#define DBG_EPI2 0
#endif
namespace pg8 {
#define PG8_LAS __attribute__((address_space(3)))
typedef unsigned short bf16_t;
typedef short bf16x8 __attribute__((ext_vector_type(8)));
typedef float f32x4 __attribute__((ext_vector_type(4)));
typedef unsigned u32x4 __attribute__((ext_vector_type(4)));
typedef unsigned u32x2 __attribute__((ext_vector_type(2)));
typedef int v8i __attribute__((ext_vector_type(8)));
typedef int v4i __attribute__((ext_vector_type(4)));
constexpr int BM = 256, BK = 64, HALF = 128, HTB = HALF * BK * 2  , STAGE_BYTES = 8 * HTB, NXCD = 8, WGM = 8;

__host__ __device__ __forceinline__ int lds_byte(int r, int c) { const int st = (r >> 4) * 2 + (c >> 5), rr = r & 15, cc = c & 31, ob = rr * 64 + cc * 2; return st * 1024 + (ob ^ (((ob >> 9) & 1) << 5)); }
__host__ __device__ __forceinline__ void stage_rc(int b, int& R, int& C) { const int st = b / 1024, sb = b % 1024, swz = sb ^ (((sb >> 9) & 1) << 5); R = (st >> 1) * 16 + swz / 64; C = (st & 1) * 32 + (swz % 64) / 2; }
__host__ __device__ __forceinline__ int perm32(int rho) { const int n = rho >> 4, i = rho & 15; return 8 * (i >> 2) + 4 * n + (i & 3); }

struct Unit { int pm, pn; };
struct Gemm { const bf16_t* A; const bf16_t* Bt; int M, N, K; int bgrp; size_t bstride; const int* gidx; unsigned long long* ts; };

struct StaticOrder {
    int nM, nN, nwg, G, c;
    __host__ __device__ void init(int M, int N, int G_, int c_) { nM = M / BM; nN = N / BM; nwg = nM * nN; G = G_; c = c_; }
    __host__ __device__ bool next(int i, Unit& u) const {
        const long L = (long)i * G + c; if (L >= nwg) return false;
        int wgid = (int)L; { const int q = nwg / NXCD, r = nwg % NXCD, xcd = wgid % NXCD, off = wgid / NXCD; wgid = (xcd < r ? xcd * (q + 1) : r * (q + 1) + (xcd - r) * q) + off; }
        const int nig = WGM * nN, gid = wgid / nig, fm = gid * WGM, gsz = (nM - fm) < WGM ? (nM - fm) : WGM;
        u.pm = fm + ((wgid % nig) % gsz); u.pn = (wgid % nig) / gsz; return true;
    }
    __device__ __forceinline__ void a_ready(const Unit&) const {}
    __device__ __forceinline__ void done(const Unit&) const {}
};

typedef __bf16 bf16x2_t __attribute__((ext_vector_type(2)));
typedef float f32x2_t __attribute__((ext_vector_type(2)));
__device__ __forceinline__ unsigned cvt_pk_bf16(float lo, float hi) { const f32x2_t v = {lo, hi}; const bf16x2_t b = __builtin_convertvector(v, bf16x2_t); return __builtin_bit_cast(unsigned, b); }
__device__ __forceinline__ float bf_lo(unsigned w) { return __uint_as_float(w << 16); }
__device__ __forceinline__ float bf_hi(unsigned w) { return __uint_as_float(w & 0xffff0000u); }
__device__ __forceinline__ float sigm(float v) { return __builtin_amdgcn_rcpf(1.0f + __expf(-v)); }


template <class Epi, class Sched, int AMODE, bool ALIGN_EPI, bool SP2, bool F8 = false>
__device__ __forceinline__ void gemm_phase(PG8_LAS unsigned char* lds, const Gemm g, const Sched& S, const Epi& E) {
    const int tid = threadIdx.x, wid = __builtin_amdgcn_readfirstlane(tid >> 6), lane = tid & 63, wr = wid >> 2, wc = wid & 3, fr = lane & 15, fq = lane >> 4;
    const int K = g.K, nt = K / BK;
    unsigned voffA0[2], voffA1[2], voffB[2]; int gR[2], gC2[2];
#pragma unroll
    for (int i = 0; i < 2; ++i) { int R, C; stage_rc(tid * 16 + i * 8192, R, C); const int Rb = Epi::PERM ? ((R & ~31) + perm32(R & 31)) : R;
        voffB[i] = (unsigned)(Rb * K + C) * 2u; gR[i] = R; gC2[i] = C * 2;
        if (AMODE == 0) { voffA0[i] = (unsigned)(R * K + C) * 2u; voffA1[i] = (unsigned)((R + HALF) * K + C) * 2u; }
        else if (AMODE == 1) { voffA0[i] = (unsigned)((C >> 3) * 8192 + R) * 16u; voffA1[i] = voffA0[i] + (unsigned)HALF * 16u; }
        else { voffA0[i] = 0u; voffA1[i] = 0u; } }
    const size_t kstepB = (size_t)(BK * 2);
    const size_t kstepA = (AMODE == 1) ? (size_t)8 * 8192 * 16 : (size_t)(BK * 2);
    int nidx0[2] = {0, 0}, nidx1[2] = {0, 0}; unsigned voffN0[2] = {0u, 0u}, voffN1[2] = {0u, 0u};
#define PG8_GIDX_LOAD(u) do { if (AMODE == 2) { _Pragma("unroll") for (int _i = 0; _i < 2; ++_i) { \
        const int* _p0 = g.gidx + (size_t)(u).pm * BM + gR[_i]; const int* _p1 = _p0 + HALF; \
        asm volatile("global_load_dword %0, %1, off" : "=v"(nidx0[_i]) : "v"(_p0) : "memory"); asm volatile("global_load_dword %0, %1, off" : "=v"(nidx1[_i]) : "v"(_p1) : "memory"); } } } while (0)
#define PG8_GIDX_USE() do { if (AMODE == 2) { _Pragma("unroll") for (int _i = 0; _i < 2; ++_i) { asm volatile("" : "+v"(nidx0[_i]), "+v"(nidx1[_i])); \
        voffN0[_i] = (unsigned)nidx0[_i] * (unsigned)(K * 2) + (unsigned)gC2[_i]; voffN1[_i] = (unsigned)nidx1[_i] * (unsigned)(K * 2) + (unsigned)gC2[_i]; } } } while (0)
    const size_t hstepB = (size_t)HALF * K * 2;
    const size_t tstepB = 2 * hstepB;
    const unsigned ldsw = (unsigned)wid * 1024u;
    const int aoff = lds_byte(wr * 64 + fr, fq * 8), boff = lds_byte(wc * 32 + fr, fq * 8);
    const int aoff8a = lds_byte(wr * 64 + fr, fq * 16), boff8a = lds_byte(wc * 32 + fr, fq * 16);
#define PG8_ABASE(u) ((const char*)g.A + ((AMODE == 2) ? (size_t)0 : (AMODE == 0) ? (size_t)(u).pm * (size_t)BM * K * 2 : (size_t)((u).pm >> 5) * ((size_t)(K >> 3) * 8192 * 16) + (size_t)((u).pm & 31) * (BM * 16)))
#define PG8_BBASE(u) ((const char*)g.Bt + (g.bgrp ? (size_t)((u).pm / g.bgrp) * g.bstride * 2 : (size_t)0) + (size_t)(u).pn * tstepB)
#define PG8_SA(b, h) (((b) * 2 + (h)) * HTB)
#define PG8_SB(b, h) ((4 + (b) * 2 + (h)) * HTB)
#define PG8_STAGE(bufoff, gbase, voff) do { _Pragma("unroll") for (int _i = 0; _i < 2; ++_i) \
        __builtin_amdgcn_global_load_lds((const unsigned*)((const char*)(gbase) + (voff)[_i]), (PG8_LAS unsigned*)(lds + (bufoff) + ldsw + _i * 8192), 16, 0, 0); } while (0)
#define PG8_LDA16(dst, b, h) do { _Pragma("unroll") for (int m = 0; m < 4; ++m) _Pragma("unroll") for (int k = 0; k < 2; ++k) dst[m][k] = *(const PG8_LAS bf16x8*)(lds + PG8_SA(b, h) + aoff + m * 2048 + k * 1024); } while (0)
#define PG8_LDB16(dst, b, h) do { _Pragma("unroll") for (int n = 0; n < 2; ++n) _Pragma("unroll") for (int k = 0; k < 2; ++k) dst[n][k] = *(const PG8_LAS bf16x8*)(lds + PG8_SB(b, h) + boff + n * 2048 + k * 1024); } while (0)
#define PG8_MMA16(ai, bj, At, Bt) do { __builtin_amdgcn_s_setprio(1); _Pragma("unroll") for (int m = 0; m < 4; ++m) _Pragma("unroll") for (int n = 0; n < 2; ++n) _Pragma("unroll") for (int k = 0; k < 2; ++k) \
        acc[ai][bj][m][n] = __builtin_amdgcn_mfma_f32_16x16x32_bf16(Bt[n][k], At[m][k], acc[ai][bj][m][n], 0, 0, 0); __builtin_amdgcn_s_setprio(0); } while (0)
#define PG8_LDA8(dst, b, h) do { _Pragma("unroll") for (int m = 0; m < 4; ++m) { const v4i lo_ = *(const PG8_LAS v4i*)(lds + PG8_SA(b, h) + aoff8a + m * 2048), hi_ = *(const PG8_LAS v4i*)(lds + PG8_SA(b, h) + aoff8a + m * 2048 + 16); \
        dst[m] = (v8i){lo_.x, lo_.y, lo_.z, lo_.w, hi_.x, hi_.y, hi_.z, hi_.w}; } } while (0)
#define PG8_LDB8(dst, b, h) do { _Pragma("unroll") for (int n = 0; n < 2; ++n) { const v4i lo_ = *(const PG8_LAS v4i*)(lds + PG8_SB(b, h) + boff8a + n * 2048), hi_ = *(const PG8_LAS v4i*)(lds + PG8_SB(b, h) + boff8a + n * 2048 + 16); \
        dst[n] = (v8i){lo_.x, lo_.y, lo_.z, lo_.w, hi_.x, hi_.y, hi_.z, hi_.w}; } } while (0)
#define PG8_MMA8(ai, bj, At, Bt) do { __builtin_amdgcn_s_setprio(1); _Pragma("unroll") for (int m = 0; m < 4; ++m) _Pragma("unroll") for (int n = 0; n < 2; ++n) \
        asm volatile("v_mfma_scale_f32_16x16x128_f8f6f4 %0, %1, %2, %0, %3, %3 op_sel:[0,1,0] op_sel_hi:[0,0,0]" : "+v"(acc[ai][bj][m][n]) : "v"(Bt[n]), "v"(At[m]), "v"(f8scale)); __builtin_amdgcn_s_setprio(0); } while (0)
#define PG8_LDA(dst, b, h) do { if constexpr (F8) PG8_LDA8(dst##8, b, h); else PG8_LDA16(dst, b, h); } while (0)
#define PG8_LDB(dst, b, h) do { if constexpr (F8) PG8_LDB8(dst##8, b, h); else PG8_LDB16(dst, b, h); } while (0)
#define PG8_MMA(ai, bj, At, Bt) do { if constexpr (F8) PG8_MMA8(ai, bj, At##8, Bt##8); else PG8_MMA16(ai, bj, At, Bt); } while (0)
#define PG8_WAIT_V(n) asm volatile("s_waitcnt vmcnt(" #n ")" ::: "memory")
#define PG8_WAIT_VE() do { if (epi_st == 0) PG8_WAIT_V(8); else if (epi_st == 8) PG8_WAIT_V(16); else if (epi_st == 16) PG8_WAIT_V(24); else PG8_WAIT_V(40); } while (0)
#define PG8_WAIT_L(n) asm volatile("s_waitcnt lgkmcnt(" #n ")" ::: "memory")
#define PG8_BAR __builtin_amdgcn_s_barrier()
#define PG8_SCHED __builtin_amdgcn_sched_barrier(0)
    Unit cur, nxt; int ui = 0; int epi_st = 0;
    if (!S.next(0, cur)) return;
    f32x4 acc[2][2][4][2];
#pragma unroll
    for (int a = 0; a < 2; ++a)
#pragma unroll
        for (int b = 0; b < 2; ++b)
#pragma unroll
            for (int m = 0; m < 4; ++m)
#pragma unroll
                for (int n = 0; n < 2; ++n) acc[a][b][m][n] = (f32x4){0.f, 0.f, 0.f, 0.f};
    bf16x8 At[4][2], B0[2][2], B1[2][2]; v8i At8[4], B08[2], B18[2]; int f8scale = 0x7f7f7f78; asm volatile("" : "+v"(f8scale));
    const char* cA = PG8_ABASE(cur); const char* cB = PG8_BBASE(cur);
    S.a_ready(cur);
    if (AMODE == 2) { PG8_GIDX_LOAD(cur); asm volatile("s_waitcnt vmcnt(0)" ::: "memory"); PG8_GIDX_USE();
#pragma unroll
        for (int i = 0; i < 2; ++i) { voffA0[i] = voffN0[i]; voffA1[i] = voffN1[i]; } }
    if constexpr (SP2) {
        PG8_STAGE(PG8_SB(0, 0), cB, voffB); PG8_STAGE(PG8_SB(0, 1), cB + hstepB, voffB); PG8_STAGE(PG8_SA(0, 0), cA, voffA0); PG8_STAGE(PG8_SA(0, 1), cA, voffA1);
        if (wr == 1) PG8_BAR;
        PG8_WAIT_V(2); PG8_BAR;
        PG8_STAGE(PG8_SB(1, 0), cB + kstepB, voffB); PG8_STAGE(PG8_SA(1, 0), cA + kstepA, voffA0); PG8_STAGE(PG8_SB(1, 1), cB + hstepB + kstepB, voffB);
        PG8_WAIT_V(6); PG8_BAR;
    } else {
        PG8_STAGE(PG8_SB(0, 0), cB, voffB); PG8_STAGE(PG8_SA(0, 0), cA, voffA0); PG8_STAGE(PG8_SB(0, 1), cB + hstepB, voffB); PG8_STAGE(PG8_SA(0, 1), cA, voffA1);
        if (wr == 1) PG8_BAR;
        PG8_WAIT_V(4); PG8_BAR;
        PG8_STAGE(PG8_SB(1, 0), cB + kstepB, voffB); PG8_STAGE(PG8_SA(1, 0), cA + kstepA, voffA0); PG8_STAGE(PG8_SB(1, 1), cB + hstepB + kstepB, voffB);
        PG8_WAIT_V(6); PG8_BAR;
    }
    for (;;) {
        const bool has_next = S.next(ui + 1, nxt);
        const char* nA = has_next ? PG8_ABASE(nxt) : cA; const char* nB = has_next ? PG8_BBASE(nxt) : cB;
        if (AMODE == 2) { if (has_next) PG8_GIDX_LOAD(nxt); }
#if PROBE_I >= 0
        if (Epi::STAMP && ui == 1 && blockIdx.x == 0 && threadIdx.x == 0) g.ts[30] = __builtin_amdgcn_s_memrealtime();
#endif
#pragma unroll 1
        for (int t = 0; t < nt; t += 2) {
            const bool last = (t == nt - 2);
            unsigned vS0[2], vS1[2];
            if (AMODE == 2) { if (last) { if (has_next) PG8_GIDX_USE(); else { _Pragma("unroll") for (int i = 0; i < 2; ++i) { voffN0[i] = voffA0[i]; voffN1[i] = voffA1[i]; } } } }
#pragma unroll
            for (int i = 0; i < 2; ++i) { vS0[i] = (AMODE == 2 && last) ? voffN0[i] : voffA0[i]; vS1[i] = (AMODE == 2 && last) ? voffN1[i] : voffA1[i]; }
            const char* a1 = cA + (size_t)(t + 1) * kstepA;
            const char* a2 = last ? nA : cA + (size_t)(t + 2) * kstepA; const char* b2 = last ? nB : cB + (size_t)(t + 2) * kstepB;
            const char* a3 = a2 + kstepA; const char* b3 = b2 + kstepB;
            if (last && has_next) S.a_ready(nxt);
            if constexpr (SP2) {
            PG8_LDB(B0, 0, 0); PG8_LDB(B1, 0, 1); PG8_SCHED; PG8_LDA(At, 0, 0); PG8_STAGE(PG8_SA(1, 1), a1, voffA1);
            PG8_WAIT_VE(); PG8_WAIT_L(0); PG8_BAR; PG8_MMA(0, 0, At, B0); PG8_MMA(0, 1, At, B1); PG8_BAR; PG8_SCHED;
            PG8_LDA(At, 0, 1); PG8_STAGE(PG8_SB(0, 0), b2, voffB); PG8_STAGE(PG8_SB(0, 1), b2 + hstepB, voffB); PG8_STAGE(PG8_SA(0, 0), a2, vS0);
            PG8_WAIT_VE(); epi_st = 0; PG8_WAIT_L(0); PG8_BAR; PG8_MMA(1, 0, At, B0); PG8_MMA(1, 1, At, B1); PG8_BAR; PG8_SCHED;
            PG8_LDB(B0, 1, 0); PG8_LDB(B1, 1, 1); PG8_SCHED; PG8_LDA(At, 1, 0); PG8_STAGE(PG8_SA(0, 1), a2, vS1);
            PG8_WAIT_V(8); PG8_WAIT_L(0); PG8_BAR; PG8_MMA(0, 0, At, B0); PG8_MMA(0, 1, At, B1); PG8_BAR; PG8_SCHED;
            PG8_LDA(At, 1, 1); PG8_STAGE(PG8_SB(1, 0), b3, voffB); PG8_STAGE(PG8_SB(1, 1), b3 + hstepB, voffB); PG8_STAGE(PG8_SA(1, 0), a3, vS0);
            PG8_WAIT_V(8); PG8_WAIT_L(0); PG8_BAR; PG8_MMA(1, 0, At, B0); PG8_MMA(1, 1, At, B1); PG8_BAR; PG8_SCHED;
            } else {
            PG8_LDB(B0, 0, 0); PG8_SCHED; PG8_LDA(At, 0, 0); PG8_STAGE(PG8_SA(1, 1), a1, voffA1);
            PG8_WAIT_L(8); PG8_BAR; PG8_WAIT_L(0); PG8_MMA(0, 0, At, B0); PG8_BAR; PG8_SCHED;
            PG8_LDB(B1, 0, 1); PG8_STAGE(PG8_SB(0, 0), b2, voffB);
            PG8_BAR; PG8_WAIT_L(0); PG8_MMA(0, 1, At, B1); PG8_BAR;
            PG8_LDA(At, 0, 1); PG8_STAGE(PG8_SA(0, 0), a2, vS0);
            PG8_BAR; PG8_WAIT_L(0); PG8_MMA(1, 0, At, B0); PG8_BAR; PG8_SCHED;
            PG8_STAGE(PG8_SB(0, 1), b2 + hstepB, voffB);
            PG8_WAIT_V(6); PG8_BAR; PG8_MMA(1, 1, At, B1); PG8_BAR;
            PG8_LDB(B0, 1, 0); PG8_SCHED; PG8_LDA(At, 1, 0); PG8_STAGE(PG8_SA(0, 1), a2, vS1);
            PG8_WAIT_L(8); PG8_BAR; PG8_WAIT_L(0); PG8_MMA(0, 0, At, B0); PG8_BAR; PG8_SCHED;
            PG8_LDB(B1, 1, 1); PG8_STAGE(PG8_SB(1, 0), b3, voffB);
            PG8_BAR; PG8_WAIT_L(0); PG8_MMA(0, 1, At, B1); PG8_BAR;
            PG8_LDA(At, 1, 1); PG8_STAGE(PG8_SA(1, 0), a3, vS0);
            PG8_BAR; PG8_WAIT_L(0); PG8_MMA(1, 0, At, B0); PG8_BAR; PG8_SCHED;
            PG8_STAGE(PG8_SB(1, 1), b3 + hstepB, voffB);
            PG8_WAIT_V(6); PG8_BAR; PG8_MMA(1, 1, At, B1); PG8_BAR;
            }
        }
#if PROBE_I >= 0
        if (Epi::STAMP && ui == 1 && blockIdx.x == 0 && threadIdx.x == 0) g.ts[31] = __builtin_amdgcn_s_memrealtime();
#endif
        if constexpr (ALIGN_EPI) { if (wr == 0) PG8_BAR; }
        if constexpr (F8) asm volatile("s_nop 15\n\ts_nop 15\n\ts_nop 7" ::: "memory");
        E(acc, cur, wr, wc, fr, fq); S.done(cur);
#if DBG_EPI2
        if (Epi::EPI2) { asm volatile("" ::: "memory"); E(acc, cur, wr, wc, fr, fq); }
#endif
#if PROBE_I >= 0
        if (Epi::STAMP && ui == 1 && blockIdx.x == 0 && threadIdx.x == 0) g.ts[32] = __builtin_amdgcn_s_memrealtime();
        if (Epi::STAMP && ui == 2 && blockIdx.x == 0 && threadIdx.x == 0) g.ts[33] = __builtin_amdgcn_s_memrealtime();
#endif
        if (!has_next) break;
        epi_st = E.nst(cur);
#pragma unroll
        for (int a = 0; a < 2; ++a)
#pragma unroll
            for (int b = 0; b < 2; ++b)
#pragma unroll
                for (int m = 0; m < 4; ++m)
#pragma unroll
                    for (int n = 0; n < 2; ++n) acc[a][b][m][n] = (f32x4){0.f, 0.f, 0.f, 0.f};
        cur = nxt; cA = nA; cB = nB; ++ui;
        if (AMODE == 2) {
#pragma unroll
            for (int i = 0; i < 2; ++i) { voffA0[i] = voffN0[i]; voffA1[i] = voffN1[i]; } }
        if constexpr (ALIGN_EPI) { if (wr == 1) PG8_BAR; }
    }
    PG8_WAIT_V(0);
    if constexpr (!ALIGN_EPI) { if (wr == 0) PG8_BAR; }
    PG8_BAR;
#undef PG8_GIDX_LOAD
#undef PG8_GIDX_USE
#undef PG8_ABASE
#undef PG8_BBASE
#undef PG8_SA
#undef PG8_SB
#undef PG8_STAGE
#undef PG8_LDA
#undef PG8_LDA16
#undef PG8_LDA8
#undef PG8_LDB16
#undef PG8_LDB8
#undef PG8_MMA16
#undef PG8_MMA8
#undef PG8_LDB
#undef PG8_MMA
#undef PG8_WAIT_V
#undef PG8_WAIT_VE
#undef PG8_WAIT_L
#undef PG8_BAR
#undef PG8_SCHED
}
}
constexpr int NWAVES = 8;
constexpr int BATCH = 2, SEQ = 8192, D = 1024, M = BATCH * SEQ, DF = 512, DIN = 5632, NE = 16, CAP = 1024, DE = 2048, MR = BATCH * NE * CAP  ;
constexpr float RMS_EPS = 1e-6f;
constexpr size_t MiB = 1u << 20;
constexpr size_t WS_CTL = 0, CTL_ZERO_BYTES = 32 * 1024;
constexpr size_t WS_MODP = 1 * MiB, WS_MOD = 1 * MiB + 256 * 1024, WS_FC1 = 1 * MiB + 512 * 1024, WS_FC2 = 1 * MiB + 576 * 1024;
constexpr size_t WS_PROBS = 2 * MiB, WS_SLOT = 3 * MiB, WS_IDX = 4 * MiB, WS_VAL = 4 * MiB + 128 * 1024;
constexpr size_t WS_WIN = 8 * MiB, WS_WF = 20 * MiB, WS_WCO = 22 * MiB, WS_WO = 24 * MiB, WS_WGU = 32 * MiB, WS_WD = 160 * MiB;
constexpr size_t WS_H1 = 224 * MiB, WS_AB = 224 * MiB, WS_UF = 256 * MiB, WS_CV = 272 * MiB, WS_BG = 304 * MiB, WS_GA = 336 * MiB, WS_GB = 368 * MiB, WS_ZF = 400 * MiB, WS_TZ = 432 * MiB, WS_H2 = 464 * MiB;
#ifndef MOE_FP8
#define MOE_FP8 1
#endif
constexpr size_t WS_HM = 224 * MiB, WS_Y = 432 * MiB, WS_X1B = 400 * MiB, WS_END = 496 * MiB;
constexpr int CW_BAR = 4096;
constexpr int RING_BYTES = 131072, MISC_OFF = 143360, LDS_BYTES = 147456;
constexpr int FFT_TOFF = 65536, FFT_TPITCH = 528;

#define GAS __attribute__((address_space(1)))
#define LAS __attribute__((address_space(3)))
typedef unsigned short bf16;
typedef unsigned v4u __attribute__((ext_vector_type(4)));
typedef unsigned v2u __attribute__((ext_vector_type(2)));
typedef float f32x4 __attribute__((ext_vector_type(4)));
typedef short bf16x8 __attribute__((ext_vector_type(8)));
#define LDS_WAIT() asm volatile("s_waitcnt lgkmcnt(0)" ::: "memory")
#define VM_WAIT() asm volatile("s_waitcnt vmcnt(0)" ::: "memory")
using pg8::cvt_pk_bf16; using pg8::bf_lo; using pg8::bf_hi; using pg8::sigm;
__device__ __forceinline__ float wave_sum(float v) {
#pragma unroll
    for (int o = 1; o < 64; o <<= 1) v += __shfl_xor(v, o);
    return v;
}
__device__ __forceinline__ float silu(float v) { return v * sigm(v); }
#ifndef DBG_NOBIAS
#define DBG_NOBIAS 0
#endif
#ifndef DBG_NOSIG
#define DBG_NOSIG 0
#endif
__device__ __forceinline__ float sigx(float v) { return DBG_NOSIG ? v : sigm(v); }

#define XB_TMO      128
#define XB_XCNT(j)  (256  + 64 * (j))
#define XB_XSUB(j)  (1280 + 64 * (j))
#define XB_XGEN(j)  (2304 + 64 * (j))
#define XB_TOP      3328
#define XB_TOPGEN   3392
#define XCD_BAR_WORDS 3456
#define XB_SPIN_CAP (1u << 18)
__device__ __forceinline__ unsigned xb_ld(unsigned* p)              { return __hip_atomic_load(p, __ATOMIC_RELAXED, __HIP_MEMORY_SCOPE_AGENT); }
__device__ __forceinline__ unsigned xb_add(unsigned* p, unsigned v) { return __hip_atomic_fetch_add(p, v, __ATOMIC_RELAXED, __HIP_MEMORY_SCOPE_AGENT); }
__device__ __forceinline__ unsigned xb_xcc_id() { return (unsigned)__builtin_amdgcn_s_getreg((3 << 11) | 20) & 0xFu; }
#define XB_SPIN(cond, bar) do { unsigned _sp = 0; while (cond) { __builtin_amdgcn_s_sleep(1); \
    if ((++_sp & 255u) == 0u) { if (xb_ld(&(bar)[XB_TMO])) break; if (_sp > XB_SPIN_CAP) { atomicAdd(&(bar)[XB_TMO], 1u); break; } } } } while (0)
struct XcdBarrier { unsigned* bar; unsigned x; volatile LAS unsigned* st; };
__device__ __forceinline__ XcdBarrier xcd_barrier_post(unsigned* bar, volatile LAS unsigned* st) {
    XcdBarrier b; b.bar = bar; b.x = xb_xcc_id(); b.st = st;
    if (threadIdx.x == 0) (void)xb_add(&bar[XB_XCNT(b.x)], 1u);
    return b;
}
__device__ __forceinline__ void xcd_barrier_complete(unsigned* bar, unsigned x, unsigned& nloc, unsigned& nx) {
    const unsigned G = gridDim.x * gridDim.y * gridDim.z;
    unsigned sum, cnt, mine, sp = 0u;
    for (;;) {
        sum = 0u; cnt = 0u; mine = 0u;
#pragma unroll
        for (unsigned j = 0; j < 16; ++j) { const unsigned c = xb_ld(&bar[XB_XCNT(j)]); sum += c; cnt += (c > 0u) ? 1u : 0u; mine = (j == x) ? c : mine; }
        if (sum == G) break;
        __builtin_amdgcn_s_sleep(1);
        if ((++sp & 255u) == 0u) { if (xb_ld(&bar[XB_TMO])) break; if (sp > XB_SPIN_CAP) { atomicAdd(&bar[XB_TMO], 1u); break; } }
    }
    nloc = mine > 0u ? mine : 1u; nx = cnt > 0u ? cnt : 1u;
}
__device__ __forceinline__ void xcd_barrier(const XcdBarrier& b) {
    asm volatile("s_waitcnt vmcnt(0)" ::: "memory");
    __syncthreads();
    if (threadIdx.x == 0) {
        unsigned* bar = b.bar;
        __builtin_amdgcn_s_waitcnt(0);
        unsigned nloc = b.st[0], nx = b.st[1];
        if (nloc == 0u) { xcd_barrier_complete(bar, b.x, nloc, nx); b.st[0] = nloc; b.st[1] = nx; }
        const unsigned old = xb_add(&bar[XB_XSUB(b.x)], 1u);
        const unsigned gen = old / nloc;
        if (old + 1u == (gen + 1u) * nloc) {
            __builtin_amdgcn_fence(__ATOMIC_RELEASE, "agent");
            asm volatile("s_waitcnt vmcnt(0)" ::: "memory");
            const unsigned og = xb_add(&bar[XB_TOP], 1u);
            const unsigned tg = og / nx;
            if (og + 1u == (tg + 1u) * nx) xb_add(&bar[XB_TOPGEN], 1u);
            else XB_SPIN(xb_ld(&bar[XB_TOPGEN]) == tg, bar);
            __builtin_amdgcn_fence(__ATOMIC_ACQUIRE, "agent");
            xb_add(&bar[XB_XGEN(b.x)], 1u);
            asm volatile("s_waitcnt vmcnt(0)" ::: "memory");
        } else {
            XB_SPIN(xb_ld(&bar[XB_XGEN(b.x)]) == gen, bar);
            __builtin_amdgcn_fence(__ATOMIC_ACQUIRE, "agent");
            asm volatile("s_waitcnt vmcnt(0)" ::: "memory");
        }
    }
    __syncthreads();
}

using pg8::Unit; using pg8::u32x4; using pg8::u32x2;
__device__ __forceinline__ unsigned pk4_u8(float a, float b2, float c, float d) { return (unsigned)__builtin_rintf(a * 255.f) | ((unsigned)__builtin_rintf(b2 * 255.f) << 8) | ((unsigned)__builtin_rintf(c * 255.f) << 16) | ((unsigned)__builtin_rintf(d * 255.f) << 24); }
#ifndef ST_AHEAD
#define ST_AHEAD 0
#endif
#ifndef NT_INPROJ
#define NT_INPROJ 0
#endif
#if NT_INPROJ == 2
__device__ __forceinline__ void st_sc1(u32x4* p, u32x4 v) { asm volatile("global_store_dwordx4 %0, %1, off sc1" :: "v"(p), "v"(v) : "memory"); }
__device__ __forceinline__ void st_sc1(u32x2* p, u32x2 v) { asm volatile("global_store_dwordx2 %0, %1, off sc1" :: "v"(p), "v"(v) : "memory"); }
#define ST_NT(T, p, v) st_sc1((T*)(p), (v))
#elif NT_INPROJ
#define ST_NT(T, p, v) __builtin_nontemporal_store((v), (T*)(p))
#else
#define ST_NT(T, p, v) (*(T*)(p) = (v))
#endif
struct EpiInProj {
    static constexpr bool PERM = true, EPI2 = (DBG_EPI2 == 2), STAMP = (PROBE_I >= 320 && PROBE_I < 330);
    bf16 *UF, *CV, *BG, *GA, *GB; const float* b_gate;
    __device__ __forceinline__ int nst(const Unit& u) const { return ST_AHEAD ? ((u.pn < 2) ? 32 : 16) : 0; }
    __device__ __forceinline__ void operator()(const f32x4 (&acc)[2][2][4][2], const Unit& u, int wr, int wc, int fr, int fq) const {
        const int row0 = u.pm * 256 + wr * 64 + fr;
        if (u.pn < 2) {
            const int b = u.pm >> 5, s0 = (u.pm & 31) * 256 + wr * 64 + fr;
#pragma unroll
            for (int ai = 0; ai < 2; ++ai)
#pragma unroll
                for (int m = 0; m < 4; ++m) { const int s = s0 + ai * 128 + m * 16;
#pragma unroll
                    for (int bj = 0; bj < 2; ++bj) { const int g4 = (u.pn * 256 + bj * 128 + wc * 32 + 8 * fq) >> 2;
#pragma unroll
                        for (int n = 0; n < 2; ++n) { const f32x4 v = acc[ai][bj][m][n]; u32x2 w; w.x = cvt_pk_bf16(v[0], v[1]); w.y = cvt_pk_bf16(v[2], v[3]);
                            ST_NT(u32x2, UF + ((size_t)(b * 128 + g4 + n) * 8192 + s) * 4, w); } } }
        } else if (u.pn < 10) {
#pragma unroll
            for (int ai = 0; ai < 2; ++ai)
#pragma unroll
                for (int m = 0; m < 4; ++m) { bf16* rowp = CV + (size_t)(row0 + ai * 128 + m * 16) * D + (u.pn - 2) * 128 + wc * 16 + 4 * fq;
#pragma unroll
                    for (int bj = 0; bj < 2; ++bj) { const f32x4 v = acc[ai][bj][m][0] * acc[ai][bj][m][1]; u32x2 w; w.x = cvt_pk_bf16(v[0], v[1]); w.y = cvt_pk_bf16(v[2], v[3]);
                        ST_NT(u32x2, rowp + bj * 64, w); } }
        } else if (u.pn < 14) {
#pragma unroll
            for (int ai = 0; ai < 2; ++ai)
#pragma unroll
                for (int m = 0; m < 4; ++m) { bf16* rowp = BG + (size_t)(row0 + ai * 128 + m * 16) * D + (u.pn - 10) * 256 + wc * 32 + 8 * fq;
#pragma unroll
                    for (int bj = 0; bj < 2; ++bj) { const f32x4 v0 = acc[ai][bj][m][0], v1 = acc[ai][bj][m][1]; u32x4 w; w.x = cvt_pk_bf16(v0[0], v0[1]); w.y = cvt_pk_bf16(v0[2], v0[3]); w.z = cvt_pk_bf16(v1[0], v1[1]); w.w = cvt_pk_bf16(v1[2], v1[3]);
                        ST_NT(u32x4, rowp + bj * 128, w); } }
        } else {
            const int colg = (u.pn - 14) * 256 + wc * 32 + 8 * fq;
            bf16* O = (u.pn < 18) ? GA : GB;
            f32x4 bv[2][2];
#pragma unroll
            for (int bj = 0; bj < 2; ++bj)
#pragma unroll
                for (int n = 0; n < 2; ++n) bv[bj][n] = DBG_NOBIAS ? (f32x4){0.f, 0.f, 0.f, 0.f} : *(const f32x4*)(b_gate + colg + bj * 128 + 4 * n);
#pragma unroll
            for (int ai = 0; ai < 2; ++ai)
#pragma unroll
                for (int m = 0; m < 4; ++m) { unsigned char* rowp8 = (unsigned char*)O + (size_t)(row0 + ai * 128 + m * 16) * D + (colg & 1023);
#pragma unroll
                    for (int bj = 0; bj < 2; ++bj) { const f32x4 v0 = acc[ai][bj][m][0] + bv[bj][0], v1 = acc[ai][bj][m][1] + bv[bj][1]; u32x2 w;
                        w.x = pk4_u8(sigx(v0[0]), sigx(v0[1]), sigx(v0[2]), sigx(v0[3])); w.y = pk4_u8(sigx(v1[0]), sigx(v1[1]), sigx(v1[2]), sigx(v1[3]));
                        ST_NT(u32x2, rowp8 + bj * 128, w); } }
        }
    }
};
template <int MODE> struct EpiGateMul {
    static constexpr bool PERM = true, EPI2 = false, STAMP = false;
    bf16* O; const bf16* G;
    __device__ __forceinline__ int nst(const Unit&) const { return 0; }
    __device__ __forceinline__ void operator()(const f32x4 (&acc)[2][2][4][2], const Unit& u, int wr, int wc, int fr, int fq) const {
        const int row0 = u.pm * 256 + wr * 64 + fr, col0 = u.pn * 256 + wc * 32 + 8 * fq;
#pragma unroll
        for (int ai = 0; ai < 2; ++ai)
#pragma unroll
            for (int m = 0; m < 4; ++m) { const size_t off = (size_t)(row0 + ai * 128 + m * 16) * D + col0;
#pragma unroll
                for (int bj = 0; bj < 2; ++bj) { const u32x2 gw = __builtin_nontemporal_load((const u32x2*)((const unsigned char*)G + off + bj * 128)); const f32x4 v0 = acc[ai][bj][m][0] * (1.0f / 255.0f), v1 = acc[ai][bj][m][1] * (1.0f / 255.0f);
                    float r[8] = {(float)(gw.x & 0xffu) * v0[0], (float)((gw.x >> 8) & 0xffu) * v0[1], (float)((gw.x >> 16) & 0xffu) * v0[2], (float)(gw.x >> 24) * v0[3],
                                  (float)(gw.y & 0xffu) * v1[0], (float)((gw.y >> 8) & 0xffu) * v1[1], (float)((gw.y >> 16) & 0xffu) * v1[2], (float)(gw.y >> 24) * v1[3]};
                    if (MODE == 1) { const u32x4 ow = __builtin_nontemporal_load((const u32x4*)(O + off + bj * 128));
                        r[0] += bf_lo(ow.x); r[1] += bf_hi(ow.x); r[2] += bf_lo(ow.y); r[3] += bf_hi(ow.y); r[4] += bf_lo(ow.z); r[5] += bf_hi(ow.z); r[6] += bf_lo(ow.w); r[7] += bf_hi(ow.w); }
                    u32x4 w; w.x = cvt_pk_bf16(r[0], r[1]); w.y = cvt_pk_bf16(r[2], r[3]); w.z = cvt_pk_bf16(r[4], r[5]); w.w = cvt_pk_bf16(r[6], r[7]);
                    *(u32x4*)(O + off + bj * 128) = w; } }
    }
};
struct EpiResid {
    static constexpr bool PERM = true, EPI2 = (DBG_EPI2 == 5), STAMP = false;
    const float* x; bf16* X1B; const float* gate;
    __device__ __forceinline__ int nst(const Unit&) const { return 0; }
    __device__ __forceinline__ void operator()(const f32x4 (&acc)[2][2][4][2], const Unit& u, int wr, int wc, int fr, int fq) const {
        const int row0 = u.pm * 256 + wr * 64 + fr, col0 = u.pn * 256 + wc * 32 + 8 * fq, b = u.pm >> 5;
        f32x4 gv[2][2];
#pragma unroll
        for (int bj = 0; bj < 2; ++bj)
#pragma unroll
            for (int n = 0; n < 2; ++n) gv[bj][n] = *(const f32x4*)(gate + b * 6 * D + col0 + bj * 128 + 4 * n);
#pragma unroll
        for (int ai = 0; ai < 2; ++ai)
#pragma unroll
            for (int m = 0; m < 4; ++m) { const size_t off = (size_t)(row0 + ai * 128 + m * 16) * D + col0;
#pragma unroll
                for (int bj = 0; bj < 2; ++bj) { const f32x4 x0 = __builtin_nontemporal_load((const f32x4*)(x + off + bj * 128)), x1 = __builtin_nontemporal_load((const f32x4*)(x + off + bj * 128 + 4));
                    const f32x4 v0 = x0 + gv[bj][0] * acc[ai][bj][m][0], v1 = x1 + gv[bj][1] * acc[ai][bj][m][1];
                    u32x4 w; w.x = cvt_pk_bf16(v0[0], v0[1]); w.y = cvt_pk_bf16(v0[2], v0[3]); w.z = cvt_pk_bf16(v1[0], v1[1]); w.w = cvt_pk_bf16(v1[2], v1[3]);
                    *(u32x4*)(X1B + off + bj * 128) = w; }
                asm volatile("" ::: "memory"); }
    }
};
struct EpiSwiGLU {
    static constexpr bool PERM = true, EPI2 = (DBG_EPI2 == 9), STAMP = false;
    bf16* HM;
    __device__ __forceinline__ int nst(const Unit&) const { return 0; }
    __device__ __forceinline__ void operator()(const f32x4 (&acc)[2][2][4][2], const Unit& u, int wr, int wc, int fr, int fq) const {
        const int row0 = u.pm * 256 + wr * 64 + fr, col0 = u.pn * 128 + wc * 32 + 8 * fq;
#pragma unroll
        for (int ai = 0; ai < 2; ++ai)
#pragma unroll
            for (int m = 0; m < 4; ++m) { const f32x4 g0 = acc[ai][0][m][0], g1 = acc[ai][0][m][1], u0 = acc[ai][1][m][0], u1 = acc[ai][1][m][1]; u32x4 w;
                w.x = cvt_pk_bf16(silu(g0[0]) * u0[0], silu(g0[1]) * u0[1]); w.y = cvt_pk_bf16(silu(g0[2]) * u0[2], silu(g0[3]) * u0[3]);
                w.z = cvt_pk_bf16(silu(g1[0]) * u1[0], silu(g1[1]) * u1[1]); w.w = cvt_pk_bf16(silu(g1[2]) * u1[2], silu(g1[3]) * u1[3]);
                *(u32x4*)(HM + (size_t)(row0 + ai * 128 + m * 16) * DE + col0) = w; }
    }
};
__device__ __forceinline__ unsigned pk4_fp8(float a, float b2, float c, float d) { unsigned w = 0u; w = __builtin_amdgcn_cvt_pk_fp8_f32(a, b2, w, false); w = __builtin_amdgcn_cvt_pk_fp8_f32(c, d, w, true); return w; }
struct EpiSwiGLU8 {
    static constexpr bool PERM = true, EPI2 = false, STAMP = (PROBE_I >= 330 && PROBE_I < 340);
    unsigned char* HM8;
    __device__ __forceinline__ int nst(const Unit&) const { return ST_AHEAD ? 8 : 0; }
    __device__ __forceinline__ void operator()(const f32x4 (&acc)[2][2][4][2], const Unit& u, int wr, int wc, int fr, int fq) const {
        const int row0 = u.pm * 256 + wr * 64 + fr, col0 = u.pn * 128 + wc * 32 + 8 * fq;
#pragma unroll
        for (int ai = 0; ai < 2; ++ai)
#pragma unroll
            for (int m = 0; m < 4; ++m) { const f32x4 g0 = acc[ai][0][m][0], g1 = acc[ai][0][m][1], u0 = acc[ai][1][m][0], u1 = acc[ai][1][m][1]; u32x2 w;
                w.x = pk4_fp8(silu(g0[0]) * u0[0], silu(g0[1]) * u0[1], silu(g0[2]) * u0[2], silu(g0[3]) * u0[3]);
                w.y = pk4_fp8(silu(g1[0]) * u1[0], silu(g1[1]) * u1[1], silu(g1[2]) * u1[2], silu(g1[3]) * u1[3]);
                *(u32x2*)(HM8 + (size_t)(row0 + ai * 128 + m * 16) * DE + col0) = w; asm volatile("" ::: "memory"); }
    }
};
struct EpiRowScale {
    static constexpr bool PERM = true, EPI2 = (DBG_EPI2 == 10), STAMP = false;
    bf16* Y; const float* val;
    __device__ __forceinline__ int nst(const Unit&) const { return 0; }
    __device__ __forceinline__ void operator()(const f32x4 (&acc)[2][2][4][2], const Unit& u, int wr, int wc, int fr, int fq) const {
        const int row0 = u.pm * 256 + wr * 64 + fr, col0 = u.pn * 256 + wc * 32 + 8 * fq;
#pragma unroll
        for (int ai = 0; ai < 2; ++ai)
#pragma unroll
            for (int m = 0; m < 4; ++m) { const int row = row0 + ai * 128 + m * 16; const float sv = val[row];
#pragma unroll
                for (int bj = 0; bj < 2; ++bj) { const f32x4 v0 = acc[ai][bj][m][0] * sv, v1 = acc[ai][bj][m][1] * sv; u32x4 w; w.x = cvt_pk_bf16(v0[0], v0[1]); w.y = cvt_pk_bf16(v0[2], v0[3]); w.z = cvt_pk_bf16(v1[0], v1[1]); w.w = cvt_pk_bf16(v1[2], v1[3]);
                    *(u32x4*)(Y + (size_t)row * D + col0 + bj * 128) = w; } }
    }
};

struct EpiPlain {
    static constexpr bool PERM = true, EPI2 = false, STAMP = false;
    bf16* O; int ldc;
    __device__ __forceinline__ int nst(const Unit&) const { return 0; }
    __device__ __forceinline__ void operator()(const f32x4 (&acc)[2][2][4][2], const Unit& u, int wr, int wc, int fr, int fq) const {
        const int row0 = u.pm * 256 + wr * 64 + fr, col0 = u.pn * 256 + wc * 32 + 8 * fq;
#pragma unroll
        for (int ai = 0; ai < 2; ++ai)
#pragma unroll
            for (int m = 0; m < 4; ++m) { bf16* rowp = O + (size_t)(row0 + ai * 128 + m * 16) * ldc + col0;
#pragma unroll
                for (int bj = 0; bj < 2; ++bj) { const f32x4 v0 = acc[ai][bj][m][0], v1 = acc[ai][bj][m][1]; u32x4 w; w.x = cvt_pk_bf16(v0[0], v0[1]); w.y = cvt_pk_bf16(v0[2], v0[3]); w.z = cvt_pk_bf16(v1[0], v1[1]); w.w = cvt_pk_bf16(v1[2], v1[3]);
                    *(u32x4*)(rowp + bj * 128) = w; } }
    }
};
#ifndef NT_WLOAD
#define NT_WLOAD 1
#endif
__device__ __forceinline__ unsigned f2bf(float f) { unsigned u = __builtin_bit_cast(unsigned, f); return (u + 0x7fffu + ((u >> 16) & 1u)) >> 16; }
__device__ __forceinline__ unsigned pk2(float lo, float hi) { return f2bf(lo) | (f2bf(hi) << 16); }
__device__ __forceinline__ int rowmap_in(int n) {
    if (n < 512) return n;
    if (n < 1536) { const int j = n - 512; return 512 + 8 * (j >> 2) + (j & 3); }
    if (n < 2560) return 2560 + (n - 1536);
    if (n < 3584) { const int j = n - 2560; return 512 + 8 * (j >> 2) + 4 + (j & 3); }
    return n;
}
template <int MAP>
__device__ __forceinline__ void transpose_item(const float* W, int K, int N, bf16* WT, LAS float* scr, int item, int lane) {
    const int nblk = N / 32, kb = item / nblk, nb = item % nblk, k0 = 64 * kb, n0 = 32 * nb;
    { f32x4 t[8];
#pragma unroll
      for (int i = 0; i < 8; ++i) t[i] = NT_WLOAD ? __builtin_nontemporal_load((const GAS f32x4*)(W + (size_t)(k0 + 8 * i + (lane >> 3)) * N + n0 + 4 * (lane & 7))) : *(const GAS f32x4*)(W + (size_t)(k0 + 8 * i + (lane >> 3)) * N + n0 + 4 * (lane & 7));
#pragma unroll
      for (int i = 0; i < 8; ++i) { LAS float* d_ = scr + (8 * i + (lane >> 3)) * 33 + 4 * (lane & 7); d_[0] = t[i].x; d_[1] = t[i].y; d_[2] = t[i].z; d_[3] = t[i].w; } }
    LDS_WAIT(); asm volatile("" ::: "memory");
    const int c = lane & 7;
#pragma unroll
    for (int j = 0; j < 4; ++j) { const int n = (lane >> 3) + 8 * j; const LAS float* s = scr + (8 * c) * 33 + n;
        v4u o; o.x = pk2(s[0 * 33], s[1 * 33]); o.y = pk2(s[2 * 33], s[3 * 33]); o.z = pk2(s[4 * 33], s[5 * 33]); o.w = pk2(s[6 * 33], s[7 * 33]);
        const int ns = n0 + n; int row;
        if (MAP == 0) row = ns; else if (MAP == 1) row = rowmap_in(ns); else if (MAP == 2) row = 256 * (ns >> 7) + (ns & 127); else row = 256 * (ns >> 7) + 128 + (ns & 127);
        *(GAS v4u*)(WT + (size_t)row * K + k0 + 8 * c) = o; }
    LDS_WAIT(); asm volatile("" ::: "memory");
}
template <int MAP>
__device__ __forceinline__ void transpose_item8(const float* W, int K, int N, unsigned char* WT, LAS float* scr, int item, int lane) {
    const int nblk = N / 32, kb = item / nblk, nb = item % nblk, k0 = 64 * kb, n0 = 32 * nb;
    { f32x4 t[8];
#pragma unroll
      for (int i = 0; i < 8; ++i) t[i] = NT_WLOAD ? __builtin_nontemporal_load((const GAS f32x4*)(W + (size_t)(k0 + 8 * i + (lane >> 3)) * N + n0 + 4 * (lane & 7))) : *(const GAS f32x4*)(W + (size_t)(k0 + 8 * i + (lane >> 3)) * N + n0 + 4 * (lane & 7));
#pragma unroll
      for (int i = 0; i < 8; ++i) { LAS float* d_ = scr + (8 * i + (lane >> 3)) * 33 + 4 * (lane & 7); d_[0] = t[i].x; d_[1] = t[i].y; d_[2] = t[i].z; d_[3] = t[i].w; } }
    LDS_WAIT(); asm volatile("" ::: "memory");
    const int c = lane & 3;
#pragma unroll
    for (int j = 0; j < 2; ++j) { const int n = (lane >> 2) + 16 * j; const LAS float* s = scr + (16 * c) * 33 + n; unsigned o[4];
#pragma unroll
        for (int q = 0; q < 4; ++q) { unsigned w = 0u; w = __builtin_amdgcn_cvt_pk_fp8_f32(s[(4 * q) * 33] * 128.f, s[(4 * q + 1) * 33] * 128.f, w, false); w = __builtin_amdgcn_cvt_pk_fp8_f32(s[(4 * q + 2) * 33] * 128.f, s[(4 * q + 3) * 33] * 128.f, w, true); o[q] = w; }
        const int ns = n0 + n; int row;
        if (MAP == 0) row = ns; else if (MAP == 2) row = 256 * (ns >> 7) + (ns & 127); else row = 256 * (ns >> 7) + 128 + (ns & 127);
        v4u ov; ov.x = o[0]; ov.y = o[1]; ov.z = o[2]; ov.w = o[3];
        *(GAS v4u*)(WT + (size_t)row * K + k0 + 16 * c) = ov; }
    LDS_WAIT(); asm volatile("" ::: "memory");
}
__device__ __forceinline__ void wf_item(const float* wf, bf16* WF_T, int item, int lane) {
    const int c = item >> 2, dblk = item & 3, g = c >> 7, j = c & 127, d0 = 256 * dblk + 4 * lane;
    f32x4 ac = {0.f, 0.f, 0.f, 0.f}, as = {0.f, 0.f, 0.f, 0.f};
    for (int m = 0; m < 128; ++m) { const f32x4 wv = *(const GAS f32x4*)(wf + (size_t)(g * 128 + m) * D + d0); const float fr = (float)((m * j) & 127) * (1.0f / 128.0f);
        const float cv = __builtin_amdgcn_cosf(fr), sv = __builtin_amdgcn_sinf(fr); ac += cv * wv; as += sv * wv; }
    const int kv = 8 * (c >> 2) + 2 * (c & 3);
#pragma unroll
    for (int i = 0; i < 4; ++i) *(GAS unsigned*)(WF_T + (size_t)(d0 + i) * D + kv) = pk2(ac[i] * (1.0f / 1024.0f), as[i] * (1.0f / 1024.0f));
}
__device__ __forceinline__ void fc_tables(bf16* Fc1, bf16* Fc2, int gtid, int gthreads) {
    for (int e = gtid; e < 8192 + 65536; e += gthreads) {
        if (e < 8192) { const int j = e & 7, ln = (e >> 3) & 63, kk = (e >> 9) & 1, mt = (e >> 10) & 3, hh = e >> 12, rho = ln & 15;
            const int s1 = 32 * kk + 8 * (ln >> 4) + j, k1 = 32 * hh + 16 * (mt & 1) + 4 * (rho & 3) + (rho >> 2);
            const float fr = (float)((k1 * s1) & 63) * (1.0f / 64.0f); Fc1[e] = (bf16)f2bf((mt >> 1) == 0 ? cospif(2.0f * fr) : -sinpif(2.0f * fr)); }
        else { const int q = e - 8192, j = q & 7, ln = (q >> 3) & 63, kk = (q >> 9) & 7, ro = (q >> 12) & 1, w = q >> 13;
            const int k2 = 16 * w + (ln & 15), kap = 32 * kk + 8 * (ln >> 4) + j, s2 = kap >> 1, ri = kap & 1;
            const float fr = (float)((k2 * s2) & 127) * (1.0f / 128.0f), cv = cospif(2.0f * fr), sv = sinpif(2.0f * fr);
            Fc2[q] = (bf16)f2bf(ro == 0 ? (ri == 0 ? cv : sv) : (ri == 0 ? -sv : cv)); }
    }
}
__device__ __forceinline__ void mod_item(const float* c, const float* w_ada, float* modp, LAS unsigned char* lds, int item, int tid, int wave, int lane) {
    const int cb = item % 24, kq = item / 24, col0 = 256 * cb + 4 * lane;
    f32x4 a0 = {0.f, 0.f, 0.f, 0.f}, a1 = {0.f, 0.f, 0.f, 0.f};
#pragma unroll
    for (int i0 = 0; i0 < 32; i0 += 16) { f32x4 wv[16];
#pragma unroll
        for (int i = 0; i < 16; ++i) wv[i] = __builtin_nontemporal_load((const GAS f32x4*)(w_ada + (size_t)(256 * kq + 32 * wave + i0 + i) * 6 * D + col0));
#pragma unroll
        for (int i = 0; i < 16; ++i) { const int d = 256 * kq + 32 * wave + i0 + i; a0 += silu(c[d]) * wv[i]; a1 += silu(c[D + d]) * wv[i]; } }
    LAS f32x4* red = (LAS f32x4*)lds;
    red[(wave * 2 + 0) * 64 + lane] = a0; red[(wave * 2 + 1) * 64 + lane] = a1;
    __syncthreads();
    { const int b = tid >> 8, cc = tid & 255; const LAS float* rf = (const LAS float*)lds; float s = 0.f;
#pragma unroll
      for (int w = 0; w < 8; ++w) s += rf[((w * 2 + b) * 64) * 4 + cc];
      modp[(size_t)(kq * 2 + b) * 6 * D + 256 * cb + cc] = s; }
    __syncthreads();
}

__device__ __forceinline__ void phase_h(const float* x, const float* g_mix, const float* b_ada, const float* modp, float* mod, bf16* H1, LAS unsigned char* lds, int tid, int wave, int lane, int vcu, int G) {
    LAS float* ga = (LAS float*)lds;
    LAS float* sh = ga + 2 * D;
    { float v[8];
#pragma unroll
      for (int k = 0; k < 8; ++k) { const int i = tid + 512 * k, j = i & 2047; v[k] = b_ada[j]; }
#pragma unroll
      for (int q = 0; q < 4; ++q)
#pragma unroll
          for (int k = 0; k < 8; ++k) { const int i = tid + 512 * k, b = i >> 11, j = i & 2047; v[k] += modp[(size_t)(q * 2 + b) * 6 * D + j]; }
#pragma unroll
      for (int k = 0; k < 8; ++k) { const int i = tid + 512 * k, b = i >> 11, j = i & 2047; if (j < D) sh[b * D + j] = v[k]; else ga[b * D + j - D] = g_mix[j - D] * (1.f + v[k]); } }
    { const int i = vcu * NWAVES * 64 + tid;
      if (i < 2 * 6 * D) { const int b = i / (6 * D), j = i % (6 * D); float v = b_ada[j];
#pragma unroll
          for (int q = 0; q < 4; ++q) v += modp[(size_t)(q * 2 + b) * 6 * D + j];
          mod[i] = v; } }
    __syncthreads();
    const int gw = vcu * NWAVES + wave, NGW = G * NWAVES;
    for (int m0 = gw * 4; m0 < M; m0 += NGW * 4) { const int b = m0 >> 13;
        f32x4 v[4][4]; float s[4];
#pragma unroll
        for (int r = 0; r < 4; ++r) { const GAS f32x4* xr = (const GAS f32x4*)(x + (size_t)(m0 + r) * D) + lane;
#pragma unroll
            for (int j = 0; j < 4; ++j) v[r][j] = __builtin_nontemporal_load(xr + 64 * j); }
#pragma unroll
        for (int r = 0; r < 4; ++r) { s[r] = 0.f;
#pragma unroll
            for (int j = 0; j < 4; ++j) s[r] += (v[r][j].x * v[r][j].x + v[r][j].y * v[r][j].y) + (v[r][j].z * v[r][j].z + v[r][j].w * v[r][j].w); }
#pragma unroll
        for (int o = 1; o < 64; o <<= 1) {
#pragma unroll
            for (int r = 0; r < 4; ++r) s[r] += __shfl_xor(s[r], o); }
#pragma unroll
        for (int r = 0; r < 4; ++r) { const float rr = rsqrtf(s[r] * (1.f / D) + RMS_EPS); GAS v2u* o8 = (GAS v2u*)(H1 + (size_t)(m0 + r) * D) + lane;
#pragma unroll
            for (int j = 0; j < 4; ++j) { const f32x4 gg = *(const LAS f32x4*)(ga + b * D + 4 * lane + 256 * j), ss = *(const LAS f32x4*)(sh + b * D + 4 * lane + 256 * j); const f32x4 y = v[r][j] * rr * gg + ss;
                v2u w; w.x = cvt_pk_bf16(y.x, y.y); w.y = cvt_pk_bf16(y.z, y.w); o8[64 * j] = w; } } }
    __syncthreads();
}
__device__ __forceinline__ void phase_conv(const bf16* CV, const bf16* BG, const float* w_conv, bf16* AB, int wave, int lane, int vcu, int G) {
    const int gw = vcu * NWAVES + wave, NGW = G * NWAVES;
    for (int o = gw; o < M / 8; o += NGW) { const int r0 = 8 * o, s0 = r0 & (SEQ - 1);
#pragma unroll
        for (int hseg = 0; hseg < 2; ++hseg) { const int ch = hseg * 512 + 8 * lane; const size_t off = (size_t)r0 * D + ch;
            v4u cv[10], bg[8];
#pragma unroll
            for (int jj = 0; jj < 10; ++jj) { const bool ok = (jj == 0) ? (s0 > 0) : (jj == 9) ? (s0 + 8 < SEQ) : true; cv[jj] = (v4u){0u, 0u, 0u, 0u}; if (ok) cv[jj] = __builtin_nontemporal_load((const GAS v4u*)(CV + off + (size_t)(jj - 1) * D)); }
#pragma unroll
            for (int jj = 0; jj < 8; ++jj) bg[jj] = __builtin_nontemporal_load((const GAS v4u*)(BG + off + (size_t)jj * D));
            float w0[8], w1[8], w2[8];
#pragma unroll
            for (int q = 0; q < 2; ++q) { const f32x4 a = *(const GAS f32x4*)(w_conv + ch + 4 * q), b = *(const GAS f32x4*)(w_conv + D + ch + 4 * q), c2 = *(const GAS f32x4*)(w_conv + 2 * D + ch + 4 * q);
#pragma unroll
                for (int i2 = 0; i2 < 4; ++i2) { w0[4 * q + i2] = a[i2]; w1[4 * q + i2] = b[i2]; w2[4 * q + i2] = c2[i2]; } }
#pragma unroll
            for (int jj = 0; jj < 8; ++jj) { unsigned ow[4];
#pragma unroll
                for (int q = 0; q < 4; ++q) {
                    const float lo = bf_lo(bg[jj][q]) * (w0[2 * q] * bf_lo(cv[jj][q]) + w1[2 * q] * bf_lo(cv[jj + 1][q]) + w2[2 * q] * bf_lo(cv[jj + 2][q]));
                    const float hi = bf_hi(bg[jj][q]) * (w0[2 * q + 1] * bf_hi(cv[jj][q]) + w1[2 * q + 1] * bf_hi(cv[jj + 1][q]) + w2[2 * q + 1] * bf_hi(cv[jj + 2][q]));
                    ow[q] = cvt_pk_bf16(lo, hi); }
                v4u ov; ov.x = ow[0]; ov.y = ow[1]; ov.z = ow[2]; ov.w = ow[3];
                *(GAS v4u*)(AB + off + (size_t)jj * D) = ov; } } }
}
__device__ __forceinline__ void phase_h2(const bf16* X1B, const float* g_moe, const float* mod, const float* w_router, const float* b_router, bf16* H2, unsigned char* H2F8, float* probs,
                                         LAS unsigned char* lds, int tid, int wave, int lane, int vcu, int G) {
    LAS bf16* whi = (LAS bf16*)lds;
    LAS bf16* wlo = whi + 16384;
    LAS float* ga = (LAS float*)(lds + 65536);
    LAS float* sh = ga + 2 * D;
    for (int i = tid; i < 16384; i += NWAVES * 64) { const int j = i & 7, ln = (i >> 3) & 63, kk = i >> 9, k = 32 * kk + 8 * (ln >> 4) + j, e = ln & 15;
        const float w = w_router[k * NE + e]; const unsigned h = f2bf(w); const float wh = __uint_as_float(h << 16); whi[i] = (bf16)h; wlo[i] = (bf16)f2bf(w - wh); }
    { float a[4], b2[4], c2[4];
#pragma unroll
      for (int k = 0; k < 4; ++k) { const int i = tid + 512 * k, b = i >> 10, j = i & 1023; a[k] = mod[b * 6 * D + 3 * D + j]; b2[k] = mod[b * 6 * D + 4 * D + j]; c2[k] = g_moe[j]; }
#pragma unroll
      for (int k = 0; k < 4; ++k) { const int i = tid + 512 * k; sh[i] = a[k]; ga[i] = c2[k] * (1.f + b2[k]); } }
    __syncthreads();
    const int n = lane & 15, kq = lane >> 4;
    float br[4];
#pragma unroll
    for (int r = 0; r < 4; ++r) br[r] = b_router[4 * kq + r];
    for (int grp = wave * G + vcu; grp < M / 16; grp += NWAVES * G) { const int m0 = 16 * grp, b = m0 >> 13;
        const GAS v4u* xr = (const GAS v4u*)(X1B + (size_t)(m0 + n) * D + 8 * kq);
        v4u xf[32]; float ssq = 0.f;
#pragma unroll
        for (int kk = 0; kk < 32; ++kk) xf[kk] = __builtin_nontemporal_load(xr + 4 * kk);
#pragma unroll
        for (int kk = 0; kk < 32; ++kk) { const v4u w = xf[kk]; const float e0 = bf_lo(w.x), e1 = bf_hi(w.x), e2 = bf_lo(w.y), e3 = bf_hi(w.y), e4 = bf_lo(w.z), e5 = bf_hi(w.z), e6 = bf_lo(w.w), e7 = bf_hi(w.w);
            ssq += (e0 * e0 + e1 * e1) + (e2 * e2 + e3 * e3) + (e4 * e4 + e5 * e5) + (e6 * e6 + e7 * e7); }
#pragma unroll
        for (int kk = 0; kk < 32; ++kk) asm volatile("" : "+v"(xf[kk].x), "+v"(xf[kk].y), "+v"(xf[kk].z), "+v"(xf[kk].w));
        ssq += __shfl_xor(ssq, 16); ssq += __shfl_xor(ssq, 32);
        const float rstd = rsqrtf(ssq * (1.f / D) + RMS_EPS);
        f32x4 acc = {0.f, 0.f, 0.f, 0.f};
        GAS v4u* ho = (GAS v4u*)(H2 + (size_t)(m0 + n) * D + 8 * kq);
#pragma unroll
        for (int kk = 0; kk < 32; ++kk) { const v4u w = xf[kk]; const int col = 32 * kk + 8 * kq;
            const f32x4 g0 = *(const LAS f32x4*)(ga + b * D + col), g1 = *(const LAS f32x4*)(ga + b * D + col + 4), s0 = *(const LAS f32x4*)(sh + b * D + col), s1 = *(const LAS f32x4*)(sh + b * D + col + 4);
            float h[8] = {bf_lo(w.x) * rstd * g0.x + s0.x, bf_hi(w.x) * rstd * g0.y + s0.y, bf_lo(w.y) * rstd * g0.z + s0.z, bf_hi(w.y) * rstd * g0.w + s0.w,
                          bf_lo(w.z) * rstd * g1.x + s1.x, bf_hi(w.z) * rstd * g1.y + s1.y, bf_lo(w.w) * rstd * g1.z + s1.z, bf_hi(w.w) * rstd * g1.w + s1.w};
            v4u hh, hl;
            hh.x = cvt_pk_bf16(h[0], h[1]); hh.y = cvt_pk_bf16(h[2], h[3]); hh.z = cvt_pk_bf16(h[4], h[5]); hh.w = cvt_pk_bf16(h[6], h[7]);
            hl.x = cvt_pk_bf16(h[0] - bf_lo(hh.x), h[1] - bf_hi(hh.x)); hl.y = cvt_pk_bf16(h[2] - bf_lo(hh.y), h[3] - bf_hi(hh.y)); hl.z = cvt_pk_bf16(h[4] - bf_lo(hh.z), h[5] - bf_hi(hh.z)); hl.w = cvt_pk_bf16(h[6] - bf_lo(hh.w), h[7] - bf_hi(hh.w));
            if (MOE_FP8) { v2u q8; q8.x = pk4_fp8(h[0], h[1], h[2], h[3]); q8.y = pk4_fp8(h[4], h[5], h[6], h[7]); *(GAS v2u*)(H2F8 + (size_t)(m0 + n) * D + 32 * kk + 8 * kq) = q8; }
            else ho[4 * kk] = hh;
            const bf16x8 ah = *(const LAS bf16x8*)(whi + (kk * 64 + lane) * 8), al = *(const LAS bf16x8*)(wlo + (kk * 64 + lane) * 8);
            const bf16x8 bh = __builtin_bit_cast(bf16x8, hh), bl = __builtin_bit_cast(bf16x8, hl);
            acc = __builtin_amdgcn_mfma_f32_16x16x32_bf16(ah, bh, acc, 0, 0, 0); acc = __builtin_amdgcn_mfma_f32_16x16x32_bf16(al, bh, acc, 0, 0, 0); acc = __builtin_amdgcn_mfma_f32_16x16x32_bf16(ah, bl, acc, 0, 0, 0);
            asm volatile("" ::: "memory"); }
        float lg[4], mx = -3.0e38f;
#pragma unroll
        for (int r = 0; r < 4; ++r) { lg[r] = acc[r] + br[r]; mx = fmaxf(mx, lg[r]); }
        mx = fmaxf(mx, __shfl_xor(mx, 16)); mx = fmaxf(mx, __shfl_xor(mx, 32));
        float sum = 0.f;
#pragma unroll
        for (int r = 0; r < 4; ++r) { lg[r] = __expf(lg[r] - mx); sum += lg[r]; }
        sum += __shfl_xor(sum, 16); sum += __shfl_xor(sum, 32);
        const float inv = 1.0f / sum; const int s = (m0 + n) & (SEQ - 1);
#pragma unroll
        for (int r = 0; r < 4; ++r) probs[((size_t)(b * NE + 4 * kq + r)) * SEQ + s] = lg[r] * inv; }
}
__device__ __forceinline__ void topk_item(const float* probs, int* idx, float* val, int* slot, LAS unsigned char* lds, int item, int tid, int wave, int lane) {
    const int e = item >> 1, b = item & 1;
    LAS int* red = (LAS int*)lds;
    unsigned p[16];
#pragma unroll
    for (int q = 0; q < 4; ++q) { const v4u w = __builtin_nontemporal_load((const GAS v4u*)(probs + ((size_t)(b * NE + e)) * SEQ + 16 * tid + 4 * q)); p[4 * q] = w.x; p[4 * q + 1] = w.y; p[4 * q + 2] = w.z; p[4 * q + 3] = w.w; }
    unsigned prefix = 0u;
    for (int bit = 30; bit >= 0; --bit) { const unsigned cand = prefix | (1u << bit); int cnt = 0;
#pragma unroll
        for (int j = 0; j < 16; ++j) cnt += __popcll(__ballot(p[j] >= cand));
        const int par = bit & 1;
        if (lane == 0) red[par * 8 + wave] = cnt;
        __syncthreads();
        int tot = 0;
#pragma unroll
        for (int w = 0; w < 8; ++w) tot += red[par * 8 + w];
        if (tot >= CAP) prefix = cand; }
    const unsigned T = prefix;
    int cgt = 0, ceq = 0;
#pragma unroll
    for (int j = 0; j < 16; ++j) { cgt += (p[j] > T) ? 1 : 0; ceq += (p[j] == T) ? 1 : 0; }
    int sgt = cgt, seq = ceq;
#pragma unroll
    for (int o = 1; o < 64; o <<= 1) { const int a = __shfl_up(sgt, o), c = __shfl_up(seq, o); if (lane >= o) { sgt += a; seq += c; } }
    __syncthreads();
    if (lane == 63) { red[32 + wave] = sgt; red[48 + wave] = seq; }
    __syncthreads();
    int bgt = 0, beq = 0, totgt = 0;
#pragma unroll
    for (int w = 0; w < 8; ++w) { const int a = red[32 + w], c = red[48 + w]; if (w < wave) { bgt += a; beq += c; } totgt += a; }
    int rgt = bgt + sgt - cgt, req = beq + seq - ceq;
    const int need = CAP - totgt; const int rbase = (e * 2 + b) * CAP;
#pragma unroll
    for (int j = 0; j < 16; ++j) { const int tok = b * SEQ + 16 * tid + j; int sl = -1;
        if (p[j] > T) { sl = rgt; ++rgt; } else if (p[j] == T) { if (req < need) sl = totgt + req; ++req; }
        slot[(size_t)tok * NE + e] = sl;
        if (sl >= 0) { idx[rbase + sl] = tok; val[rbase + sl] = __uint_as_float(p[j]); } }
    __syncthreads();
}
__device__ __forceinline__ void phase_gather(const bf16* H2, const int* idx, bf16* XE, int wave, int lane, int vcu, int G) {
    const int gw = vcu * NWAVES + wave, NGW = G * NWAVES;
    for (int r = gw; r < MR; r += NGW) { const int tok = idx[r];
        const GAS v4u* src = (const GAS v4u*)(H2 + (size_t)tok * D) + lane; GAS v4u* dst = (GAS v4u*)(XE + (size_t)r * D) + lane;
        const v4u a = src[0], b2 = src[64]; dst[0] = a; dst[64] = b2; }
}
__device__ __forceinline__ void phase_final(float* out, const bf16* X1B, const bf16* Y, const int* slot, const float* mod, const float* g_fin, int wave, int lane, int vcu, int G, float pert) {
    const int gw = vcu * NWAVES + wave, NGW = G * NWAVES;
    int slv[2]; v2u xw[2][4];
#define PF_FETCH(mm) do { _Pragma("unroll") for (int r = 0; r < 2; ++r) { slv[r] = slot[(size_t)((mm) + r) * NE + (lane & 15)]; const GAS v2u* xr_ = (const GAS v2u*)(X1B + (size_t)((mm) + r) * D) + lane; \
        _Pragma("unroll") for (int j = 0; j < 4; ++j) xw[r][j] = __builtin_nontemporal_load(xr_ + 64 * j); } } while (0)
    int m0 = gw * 2;
    if (m0 < M) PF_FETCH(m0);
    for (; m0 < M; m0 += NGW * 2) { const int b = m0 >> 13;
        int cs[2]; f32x4 v[2][4], a[2][4];
#pragma unroll
        for (int r = 0; r < 2; ++r) { cs[r] = slv[r];
#pragma unroll
            for (int j = 0; j < 4; ++j) { const v2u w = xw[r][j]; v[r][j] = (f32x4){bf_lo(w.x), bf_hi(w.x), bf_lo(w.y), bf_hi(w.y)}; a[r][j] = (f32x4){0.f, 0.f, 0.f, 0.f}; } }
        const int mn = m0 + NGW * 2;
        if (mn < M) PF_FETCH(mn);
        unsigned long long mask[2]; bool more = false;
#pragma unroll
        for (int r = 0; r < 2; ++r) mask[r] = __ballot(cs[r] >= 0) & 0xFFFFull;
        do { const GAS v2u* yp[2][4]; bool ok[2][4]; v2u w[2][4][4];
#pragma unroll
            for (int r = 0; r < 2; ++r)
#pragma unroll
                for (int c = 0; c < 4; ++c) { ok[r][c] = (mask[r] != 0ull); const int e = ok[r][c] ? (int)__builtin_ctzll(mask[r]) : 0; mask[r] &= (mask[r] - 1ull);
                    const int sl = __builtin_amdgcn_readlane(cs[r], e); yp[r][c] = (const GAS v2u*)(Y + ((size_t)(e * 2 + b) * CAP + (ok[r][c] ? sl : 0)) * D) + lane; }
#pragma unroll
            for (int r = 0; r < 2; ++r)
#pragma unroll
                for (int c = 0; c < 4; ++c) if (ok[r][c]) {
#pragma unroll
                    for (int j = 0; j < 4; ++j) w[r][c][j] = __builtin_nontemporal_load(yp[r][c] + 64 * j); }
#pragma unroll
            for (int r = 0; r < 2; ++r)
#pragma unroll
                for (int c = 0; c < 4; ++c) if (ok[r][c]) {
#pragma unroll
                    for (int j = 0; j < 4; ++j) { a[r][j].x += bf_lo(w[r][c][j].x); a[r][j].y += bf_hi(w[r][c][j].x); a[r][j].z += bf_lo(w[r][c][j].y); a[r][j].w += bf_hi(w[r][c][j].y); } }
            more = (mask[0] | mask[1]) != 0ull;
        } while (more);
        float s[2];
#pragma unroll
        for (int r = 0; r < 2; ++r) { s[r] = 0.f;
#pragma unroll
            for (int j = 0; j < 4; ++j) { const f32x4 gf = *(const GAS f32x4*)(mod + b * 6 * D + 5 * D + 4 * lane + 256 * j); v[r][j] = v[r][j] + gf * a[r][j]; s[r] += (v[r][j].x * v[r][j].x + v[r][j].y * v[r][j].y) + (v[r][j].z * v[r][j].z + v[r][j].w * v[r][j].w); } }
#pragma unroll
        for (int o = 1; o < 64; o <<= 1) { s[0] += __shfl_xor(s[0], o); s[1] += __shfl_xor(s[1], o); }
#pragma unroll
        for (int r = 0; r < 2; ++r) { const float rr = rsqrtf(s[r] * (1.f / D) + RMS_EPS); GAS f32x4* xo = (GAS f32x4*)(out + (size_t)(m0 + r) * D) + lane;
#pragma unroll
            for (int j = 0; j < 4; ++j) { const f32x4 gg = *(const GAS f32x4*)(g_fin + 4 * lane + 256 * j); __builtin_nontemporal_store(v[r][j] * rr * gg + pert, xo + 64 * j); } } }
#undef PF_FETCH
}
__device__ __forceinline__ void fft_item(LAS unsigned char* lds, const bf16* UF, bf16* ZF, const bf16* Fc1, const bf16* Fc2, int item, int wave, int lane, unsigned long long* ts) {
#define FFT_STAMP(i_) do { if (ts && blockIdx.x == 0 && threadIdx.x == 0) ts[34 + (i_)] = __builtin_amdgcn_s_memrealtime(); } while (0)
    FFT_STAMP(0);
    const char* slab = (const char*)UF + (size_t)item * 65536;
    { v4u xv[8];
#pragma unroll
      for (int p = 0; p < 8; ++p) { const int s1 = 8 * p + wave; xv[p] = __builtin_nontemporal_load((const GAS v4u*)(slab + s1 * 1024 + ((16 * lane - 32 * ((s1 >> 3) & 3)) & 1023))); }
#pragma unroll
      for (int p = 0; p < 8; ++p) *(LAS v4u*)(lds + (8 * p + wave) * 1024 + 16 * lane) = xv[p]; }
    bf16x8 A2[2][8];
#pragma unroll
    for (int ro = 0; ro < 2; ++ro)
#pragma unroll
        for (int kk = 0; kk < 8; ++kk) A2[ro][kk] = *(const GAS bf16x8*)(Fc2 + ((size_t)(((wave * 2 + ro) * 8 + kk) * 64 + lane)) * 8);
    LDS_WAIT(); __syncthreads(); FFT_STAMP(1);
    const int fr = lane & 15, fq = lane >> 4, ch = lane & 3, s2l = (lane & 15) >> 2;
    char* zb = (char*)ZF + (size_t)item * 131072;
    for (int hh = 0; hh < 2; ++hh) {
        { bf16x8 A1[4][2];
#pragma unroll
          for (int mt = 0; mt < 4; ++mt)
#pragma unroll
              for (int kk = 0; kk < 2; ++kk) A1[mt][kk] = *(const GAS bf16x8*)(Fc1 + ((size_t)(((hh * 4 + mt) * 2 + kk) * 64 + lane)) * 8);
          for (int jn = 0; jn < 4; ++jn) { const int nt = wave + 8 * jn, s2 = 4 * nt + s2l;
            bf16x8 Bx[2];
#pragma unroll
            for (int kk = 0; kk < 2; ++kk)
#pragma unroll
                for (int j = 0; j < 8; ++j) { const int s1 = 32 * kk + 8 * fq + j; Bx[kk][j] = *(const LAS short*)(lds + s1 * 1024 + ((s2 * 8 + ch * 2 + 32 * fq) & 1023)); }
            f32x4 acc[4];
#pragma unroll
            for (int mt = 0; mt < 4; ++mt) { acc[mt] = (f32x4){0.f, 0.f, 0.f, 0.f};
#pragma unroll
                for (int kk = 0; kk < 2; ++kk) acc[mt] = __builtin_amdgcn_mfma_f32_16x16x32_bf16(A1[mt][kk], Bx[kk], acc[mt], 0, 0, 0); }
#pragma unroll
            for (int blk = 0; blk < 2; ++blk)
#pragma unroll
                for (int r = 0; r < 4; ++r) { const int k1l = 16 * blk + 4 * r + fq, k1 = 32 * hh + k1l; const float dr = acc[blk][r], di = acc[2 + blk][r];
                    const float frac = (float)((s2 * k1) & 8191) * (1.0f / 8192.0f), c = __builtin_amdgcn_cosf(frac), s = __builtin_amdgcn_sinf(frac);
                    *(LAS unsigned*)(lds + FFT_TOFF + (k1l * 4 + ch) * FFT_TPITCH + s2 * 4) = cvt_pk_bf16(dr * c + di * s, di * c - dr * s); } } }
        LDS_WAIT(); __syncthreads(); if (hh == 0) FFT_STAMP(2);
        for (int nt2 = 0; nt2 < 8; ++nt2) { f32x4 c0 = {0.f, 0.f, 0.f, 0.f}, c1 = {0.f, 0.f, 0.f, 0.f};
#pragma unroll
            for (int kk = 0; kk < 8; ++kk) { const bf16x8 Bt = *(const LAS bf16x8*)(lds + FFT_TOFF + (16 * nt2 + fr) * FFT_TPITCH + kk * 64 + fq * 16);
                c0 = __builtin_amdgcn_mfma_f32_16x16x32_bf16(A2[0][kk], Bt, c0, 0, 0, 0); c1 = __builtin_amdgcn_mfma_f32_16x16x32_bf16(A2[1][kk], Bt, c1, 0, 0, 0); }
            const int k1 = 32 * hh + 4 * nt2 + s2l;
#pragma unroll
            for (int r = 0; r < 4; ++r) { const int k = k1 + 64 * (16 * wave + 4 * fq + r); *(GAS unsigned*)(zb + (size_t)k * 16 + ch * 4) = cvt_pk_bf16(c0[r], c1[r]); } }
        LDS_WAIT(); __syncthreads(); if (hh == 0) FFT_STAMP(3);
    }
    FFT_STAMP(4);
#undef FFT_STAMP
}
#if MOE_FP8
#define EXPERT_ITEM(r_) do { const int e_ = (r_) / 3072, q_ = (r_) % 3072; \
    if (q_ < 1024) transpose_item8<2>(w_g + (size_t)e_ * D * DE, D, DE, WGU8 + (size_t)e_ * 4096 * D, scr, q_, lane); \
    else if (q_ < 2048) transpose_item8<3>(w_u + (size_t)e_ * D * DE, D, DE, WGU8 + (size_t)e_ * 4096 * D, scr, q_ - 1024, lane); \
    else transpose_item8<0>(w_d + (size_t)e_ * DE * D, DE, D, WD8 + (size_t)e_ * D * DE, scr, q_ - 2048, lane); } while (0)
#else
#define EXPERT_ITEM(r_) do { const int e_ = (r_) / 3072, q_ = (r_) % 3072; \
    if (q_ < 1024) transpose_item<2>(w_g + (size_t)e_ * D * DE, D, DE, WGU + (size_t)e_ * 4096 * D, scr, q_, lane); \
    else if (q_ < 2048) transpose_item<3>(w_u + (size_t)e_ * D * DE, D, DE, WGU + (size_t)e_ * 4096 * D, scr, q_ - 1024, lane); \
    else transpose_item<0>(w_d + (size_t)e_ * DE * D, DE, D, WD + (size_t)e_ * D * DE, scr, q_ - 2048, lane); } while (0)
#endif
#ifndef EXP_P2
#define EXP_P2 10240
#endif
#ifndef EXP_P7
#define EXP_P7 14336
#endif
#ifndef EXP_P6
#define EXP_P6 16384
#endif
constexpr int EXP_TOTAL = NE * 3072, EXP_P0 = EXP_TOTAL - EXP_P2 - EXP_P7 - EXP_P6;

constexpr int NPHASE = 12;
#ifndef MOE_ALIGN
#define MOE_ALIGN true
#endif
#ifndef EXTRA_BARS
#define EXTRA_BARS 0
#endif
#ifndef STAGGER_US
#define STAGGER_US 0
#endif
#ifndef DOUBLE_PH
#define DOUBLE_PH -1
#endif
#define REP(k) for (int rep_ = 0; rep_ < ((DOUBLE_PH == (k)) ? 2 : 1); ++rep_)
#define REPBAR(k) do { if (DOUBLE_PH == (k) && rep_ == 0) xcd_barrier(bar); } while (0)
#ifndef PROBE_I
#define PROBE_I -1
#endif
#ifndef PROBE_J
#define PROBE_J -1
#endif
#ifndef DBG_PLAIN
#define DBG_PLAIN 0
#endif
#ifndef GALIGN
#define GALIGN true
#endif
#ifndef GSP2
#define GSP2 true
#endif
struct Args { const float* in[18]; float* out; unsigned char* ws; int ph_lo, ph_hi; };
__global__ void __launch_bounds__(NWAVES * 64, 2) fwd(Args args) {
    extern __shared__ __attribute__((aligned(16))) unsigned char lds_raw[];
    LAS unsigned char* lds = (LAS unsigned char*)lds_raw;
    volatile LAS unsigned* MISC = (volatile LAS unsigned*)(lds + MISC_OFF);
    const int tid = threadIdx.x, lane = tid & 63, wave = __builtin_amdgcn_readfirstlane(tid >> 6);
    const int G = gridDim.x; const int bx = blockIdx.x; const int vcu = (G % 8 == 0) ? (bx % 8) * (G / 8) + bx / 8 : bx;
    unsigned char* ws = args.ws;
    const float *x = args.in[0], *c = args.in[1], *w_ada = args.in[2], *b_ada = args.in[3], *g_mix = args.in[4], *w_in = args.in[5], *b_gate = args.in[6], *w_f = args.in[7], *w_conv = args.in[8],
                *w_co = args.in[9], *w_o = args.in[10], *g_moe = args.in[11], *w_r = args.in[12], *b_r = args.in[13], *w_g = args.in[14], *w_u = args.in[15], *w_d = args.in[16], *g_fin = args.in[17];
    float* out = args.out;
    float *modp = (float*)(ws + WS_MODP), *mod = (float*)(ws + WS_MOD), *probs = (float*)(ws + WS_PROBS), *val = (float*)(ws + WS_VAL);
    int *slot = (int*)(ws + WS_SLOT), *idx = (int*)(ws + WS_IDX);
    bf16 *Fc1 = (bf16*)(ws + WS_FC1), *Fc2 = (bf16*)(ws + WS_FC2), *WIN = (bf16*)(ws + WS_WIN), *WF = (bf16*)(ws + WS_WF), *WCO = (bf16*)(ws + WS_WCO), *WO = (bf16*)(ws + WS_WO), *WGU = (bf16*)(ws + WS_WGU), *WD = (bf16*)(ws + WS_WD);
    bf16 *H1 = (bf16*)(ws + WS_H1), *AB = (bf16*)(ws + WS_AB), *UF = (bf16*)(ws + WS_UF), *CV = (bf16*)(ws + WS_CV), *BG = (bf16*)(ws + WS_BG), *GA = (bf16*)(ws + WS_GA), *GB = (bf16*)(ws + WS_GB), *ZF = (bf16*)(ws + WS_ZF),
         *TZ = (bf16*)(ws + WS_TZ), *H2 = (bf16*)(ws + WS_H2), *HM = (bf16*)(ws + WS_HM), *Y = (bf16*)(ws + WS_Y), *X1B = (bf16*)(ws + WS_X1B);
    unsigned char *WGU8 = ws + WS_WGU, *WD8 = ws + WS_WD, *H2F8 = ws + WS_H2, *HM8 = ws + WS_HM;
    for (int u = tid; u < (LDS_BYTES - MISC_OFF) / 4; u += NWAVES * 64) ((LAS unsigned*)(lds + MISC_OFF))[u] = 0u;
    __syncthreads();
    const int lo = args.ph_lo, hi = args.ph_hi;
    XcdBarrier bar; bar.bar = (unsigned*)(ws + WS_CTL) + CW_BAR; bar.x = 0; bar.st = nullptr;
    if (hi - lo > 1) bar = xcd_barrier_post((unsigned*)(ws + WS_CTL) + CW_BAR, MISC + 8);
#define IN(k) (lo <= (k) && (k) < hi)
#if PROBE_I >= 0
    unsigned long long* tsb = (unsigned long long*)(ws + WS_CTL + 512 * 1024);
    if (bx == 0 && tid == 0) tsb[0] = __builtin_amdgcn_s_memrealtime();
#define GRID_BAR(k) do { if (IN(k) && IN((k) + 1)) xcd_barrier(bar); if (bx == 0 && tid == 0) tsb[(k) + 1] = __builtin_amdgcn_s_memrealtime(); } while (0)
#else
#define GRID_BAR(k) do { if (IN(k) && IN((k) + 1)) xcd_barrier(bar); } while (0)
#endif
    const int gw = vcu * NWAVES + wave, NGW = G * NWAVES;
    LAS float* scr = (LAS float*)(lds + wave * 16384);

    if (IN(0)) REP(0) {
        if (vcu < 96) mod_item(c, w_ada, modp, lds, vcu, tid, wave, lane);
#if PROBE_I >= 0
        if (bx == 0 && tid == 0) tsb[22] = __builtin_amdgcn_s_memrealtime();
#endif
        fc_tables(Fc1, Fc2, vcu * NWAVES * 64 + tid, G * NWAVES * 64);
#if PROBE_I >= 0
        if (bx == 0 && tid == 0) tsb[23] = __builtin_amdgcn_s_memrealtime();
#endif
        constexpr int I_WF = 2048, I_IN = 16 * 176, I_SQ = 16 * 32, I_EX = 3072, NITEMS = I_WF + I_IN + 2 * I_SQ + NE * I_EX;
        if (vcu >= 96) { const int w0 = (vcu - 96) * NWAVES + wave, nw0 = (G - 96) * NWAVES;
            for (int r = w0; r < I_WF; r += nw0) wf_item(w_f, WF, r, lane); }
        for (int it = I_WF + gw; it < NITEMS; it += NGW) {
            int r = it - I_WF;
            if (r < I_IN) { transpose_item<1>(w_in, D, DIN, WIN, scr, r, lane); continue; } r -= I_IN;
            if (r < I_SQ) { transpose_item<0>(w_co, D, D, WCO, scr, r, lane); continue; } r -= I_SQ;
            if (r < I_SQ) { transpose_item<0>(w_o, D, D, WO, scr, r, lane); continue; } r -= I_SQ;
            if (r >= EXP_P0) continue;
            EXPERT_ITEM(r);
        }
#if PROBE_I >= 0
        asm volatile("s_waitcnt vmcnt(0)" ::: "memory"); __syncthreads(); if (bx == 0 && tid == 0) tsb[24] = __builtin_amdgcn_s_memrealtime();
#endif
        GRID_BAR(0);
    }
    if (IN(1)) REP(1) { phase_h(x, g_mix, b_ada, modp, mod, H1, lds, tid, wave, lane, vcu, G); GRID_BAR(1); }
#if EXTRA_BARS > 0
    if (IN(1) && IN(2)) { for (int eb = 0; eb < EXTRA_BARS; ++eb) xcd_barrier(bar); }
#endif
    if (IN(2)) REP(2) {
#if STAGGER_US > 0
        if (bx >= 128) { const unsigned long long t0 = __builtin_amdgcn_s_memrealtime(); while (__builtin_amdgcn_s_memrealtime() - t0 < (unsigned long long)(STAGGER_US * 100)) __builtin_amdgcn_s_sleep(8); }
#endif
        pg8::Gemm g{H1, WIN, M, DIN, D, 0, 0, nullptr, (unsigned long long*)(ws + WS_CTL + 512 * 1024)}; pg8::StaticOrder S; S.init(M, DIN, G, bx);
#if DBG_PLAIN
        EpiPlain E{UF, DIN};
        pg8::gemm_phase<EpiPlain, pg8::StaticOrder, 0, GALIGN, GSP2>(lds, g, S, E);
#else
        EpiInProj E{UF, CV, BG, GA, GB, b_gate};
        pg8::gemm_phase<EpiInProj, pg8::StaticOrder, 0, GALIGN, GSP2>(lds, g, S, E);
#endif
        if (bx >= G / 2) { const int w2 = (bx - G / 2) * NWAVES + wave, nw2 = (G - G / 2) * NWAVES;
            for (int r = EXP_P0 + EXP_P6 + w2; r < EXP_P0 + EXP_P6 + EXP_P2; r += nw2) EXPERT_ITEM(r); }
        GRID_BAR(2);
    }
    if (IN(3)) REP(3) {
        if (bx & 1) phase_conv(CV, BG, w_conv, AB, wave, lane, vcu, G);
        for (int it = vcu; it < BATCH * 128; it += G) fft_item(lds, UF, ZF, Fc1, Fc2, it, wave, lane, (PROBE_I >= 340 && PROBE_I < 350) ? (unsigned long long*)(ws + WS_CTL + 512 * 1024) : nullptr);
#if PROBE_I >= 0
        __syncthreads(); if (bx == 0 && tid == 0) tsb[20] = __builtin_amdgcn_s_memrealtime();
#endif
        if (!(bx & 1)) phase_conv(CV, BG, w_conv, AB, wave, lane, vcu, G);
#if PROBE_I >= 0
        asm volatile("s_waitcnt vmcnt(0)" ::: "memory"); __syncthreads(); if (bx == 0 && tid == 0) tsb[21] = __builtin_amdgcn_s_memrealtime();
#endif
        GRID_BAR(3);
    }
    if (IN(4)) REP(4) {
        { pg8::Gemm g{ZF, WF, M, D, D, 0, 0, nullptr, (unsigned long long*)(ws + WS_CTL + 512 * 1024)}; pg8::StaticOrder S; S.init(M, D, G, bx); EpiGateMul<0> E{TZ, GA};
          pg8::gemm_phase<EpiGateMul<0>, pg8::StaticOrder, 1, true, true>(lds, g, S, E); }
        { pg8::Gemm g{AB, WCO, M, D, D, 0, 0, nullptr, (unsigned long long*)(ws + WS_CTL + 512 * 1024)}; pg8::StaticOrder S; S.init(M, D, G, bx); EpiGateMul<1> E{TZ, GB};
          pg8::gemm_phase<EpiGateMul<1>, pg8::StaticOrder, 0, true, true>(lds, g, S, E); }
        GRID_BAR(4);
    }
    if (IN(5)) REP(5) {
        pg8::Gemm g{TZ, WO, M, D, D, 0, 0, nullptr, (unsigned long long*)(ws + WS_CTL + 512 * 1024)}; pg8::StaticOrder S; S.init(M, D, G, bx); EpiResid E{x, X1B, mod + 2 * D};
        pg8::gemm_phase<EpiResid, pg8::StaticOrder, 0, true, true>(lds, g, S, E);
        GRID_BAR(5);
    }
    if (IN(6)) REP(6) { phase_h2(X1B, g_moe, mod, w_r, b_r, H2, H2F8, probs, lds, tid, wave, lane, vcu, G);
        if (wave >= 4) { LAS float* scr6 = (LAS float*)(lds + 81920 + (wave - 4) * 8448);
            const int w6 = vcu * 4 + (wave - 4), nw6 = G * 4; LAS float* scr = scr6;
            for (int r = EXP_P0 + w6; r < EXP_P0 + EXP_P6; r += nw6) EXPERT_ITEM(r); }
        __syncthreads(); GRID_BAR(6); }
    if (IN(7)) REP(7) { for (int it = vcu; it < NE * BATCH; it += G) topk_item(probs, idx, val, slot, lds, it, tid, wave, lane);
        if (vcu >= NE * BATCH) { const int w7 = (vcu - NE * BATCH) * NWAVES + wave, nw7 = (G - NE * BATCH) * NWAVES;
            for (int r = EXP_P0 + EXP_P6 + EXP_P2 + w7; r < EXP_TOTAL; r += nw7) EXPERT_ITEM(r); }
        GRID_BAR(7); }
    if (IN(9)) REP(9) {
#if MOE_FP8
        pg8::Gemm g{(const bf16*)H2F8, (const bf16*)WGU8, MR, 2 * DE, D / 2, 8, (size_t)2 * DE * D / 2, idx, (unsigned long long*)(ws + WS_CTL + 512 * 1024)}; pg8::StaticOrder S; S.init(MR, 2 * DE, G, bx); EpiSwiGLU8 E{HM8};
        pg8::gemm_phase<EpiSwiGLU8, pg8::StaticOrder, 2, MOE_ALIGN, true, true>(lds, g, S, E);
#else
        pg8::Gemm g{H2, WGU, MR, 2 * DE, D, 8, (size_t)2 * DE * D, idx, (unsigned long long*)(ws + WS_CTL + 512 * 1024)}; pg8::StaticOrder S; S.init(MR, 2 * DE, G, bx); EpiSwiGLU E{HM};
        pg8::gemm_phase<EpiSwiGLU, pg8::StaticOrder, 2, true, true>(lds, g, S, E);
#endif
        GRID_BAR(9);
    }
    if (IN(10)) REP(10) {
#if MOE_FP8
        pg8::Gemm g{(const bf16*)HM8, (const bf16*)WD8, MR, D, DE / 2, 8, (size_t)D * DE / 2, nullptr, (unsigned long long*)(ws + WS_CTL + 512 * 1024)}; pg8::StaticOrder S; S.init(MR, D, G, bx); EpiRowScale E{Y, val};
        pg8::gemm_phase<EpiRowScale, pg8::StaticOrder, 0, MOE_ALIGN, true, true>(lds, g, S, E);
#else
        pg8::Gemm g{HM, WD, MR, D, DE, 8, (size_t)D * DE, nullptr, (unsigned long long*)(ws + WS_CTL + 512 * 1024)}; pg8::StaticOrder S; S.init(MR, D, G, bx); EpiRowScale E{Y, val};
        pg8::gemm_phase<EpiRowScale, pg8::StaticOrder, 0, true, true>(lds, g, S, E);
#endif
#if PROBE_I >= 0
        if (bx == 0 && tid == 0) tsb[12] = __builtin_amdgcn_s_memrealtime();
#endif
        GRID_BAR(10);
    }
#if PROBE_I >= 0
    float pert = 0.f;
    if (IN(11)) { const unsigned long long a0 = __hip_atomic_load(tsb + (PROBE_I == 100 ? 0 : PROBE_I == 9 ? 8 : PROBE_I), __ATOMIC_RELAXED, __HIP_MEMORY_SCOPE_AGENT), a1 = __hip_atomic_load(tsb + (PROBE_I == 100 ? 12 : PROBE_I == 10 ? 12 : PROBE_I + 1), __ATOMIC_RELAXED, __HIP_MEMORY_SCOPE_AGENT); pert = (float)(a1 - a0) * 0.01f * (PROBE_I == 100 ? (1.0f / 64000.0f) : (1.0f / 16000.0f)); }
    if (PROBE_I == 102) { pert = 0.f; if (bx == 0 && tid == 0) tsb[14] = __builtin_amdgcn_s_memrealtime(); __syncthreads(); }
    if (PROBE_I >= 340 && PROBE_I < 344) { pert = 0.f; if (bx == 0) { const int q_ = PROBE_I - 340; const unsigned long long a0 = __hip_atomic_load(tsb + 34 + q_, __ATOMIC_RELAXED, __HIP_MEMORY_SCOPE_AGENT), a1 = __hip_atomic_load(tsb + 35 + q_, __ATOMIC_RELAXED, __HIP_MEMORY_SCOPE_AGENT); pert = (float)(a1 - a0) * 0.01f * (1.0f / 250.0f); } }
    else if ((PROBE_I >= 320 && PROBE_I < 323) || (PROBE_I >= 330 && PROBE_I < 333)) { pert = 0.f; if (bx == 0) { const int q_ = PROBE_I % 10; const unsigned long long a0 = __hip_atomic_load(tsb + 30 + q_, __ATOMIC_RELAXED, __HIP_MEMORY_SCOPE_AGENT), a1 = __hip_atomic_load(tsb + 31 + q_, __ATOMIC_RELAXED, __HIP_MEMORY_SCOPE_AGENT); pert = (float)(a1 - a0) * 0.01f * (1.0f / 250.0f); } }
    else if (PROBE_I >= 310 && PROBE_I <= 313) { pert = 0.f; if (bx == 0) { const int ia = (PROBE_I == 310 ? 0 : PROBE_I == 311 ? 22 : PROBE_I == 312 ? 23 : 24), ib = (PROBE_I == 310 ? 22 : PROBE_I == 311 ? 23 : PROBE_I == 312 ? 24 : 1);
        const unsigned long long a0 = __hip_atomic_load(tsb + ia, __ATOMIC_RELAXED, __HIP_MEMORY_SCOPE_AGENT), a1 = __hip_atomic_load(tsb + ib, __ATOMIC_RELAXED, __HIP_MEMORY_SCOPE_AGENT); pert = (float)(a1 - a0) * 0.01f * (1.0f / 250.0f); } }
    else if (PROBE_I == 300 || PROBE_I == 301 || PROBE_I == 302) { pert = 0.f; if (bx == 0) { const unsigned long long a0 = __hip_atomic_load(tsb + (PROBE_I == 300 ? 3 : PROBE_I == 301 ? 20 : 21), __ATOMIC_RELAXED, __HIP_MEMORY_SCOPE_AGENT), a1 = __hip_atomic_load(tsb + (PROBE_I == 300 ? 20 : PROBE_I == 301 ? 21 : 4), __ATOMIC_RELAXED, __HIP_MEMORY_SCOPE_AGENT); pert = (float)(a1 - a0) * 0.01f * (1.0f / 250.0f); } }
    else if (PROBE_I >= 200) { pert = 0.f; if (bx == 0) { const int k_ = PROBE_I - 200; const unsigned long long a0 = __hip_atomic_load(tsb + (k_ == 9 ? 8 : k_), __ATOMIC_RELAXED, __HIP_MEMORY_SCOPE_AGENT), a1 = __hip_atomic_load(tsb + k_ + 1, __ATOMIC_RELAXED, __HIP_MEMORY_SCOPE_AGENT); pert = (float)(a1 - a0) * 0.01f * (1.0f / 250.0f); } }
    if (PROBE_I == 101) { pert = 0.f; if (bx == 0) { const unsigned long long a0 = __hip_atomic_load(tsb + 12, __ATOMIC_RELAXED, __HIP_MEMORY_SCOPE_AGENT); pert = (float)(__builtin_amdgcn_s_memrealtime() - a0) * 0.01f * (1.0f / 250.0f); } }
    if (IN(11)) phase_final(out, X1B, Y, slot, mod, g_fin, wave, lane, vcu, G, pert);
    if (PROBE_I == 102) {
        const unsigned long long t_a = tsb[14];
        xcd_barrier(bar);
        if (bx == 0) { const float pp = (float)(__builtin_amdgcn_s_memrealtime() - t_a) * 0.01f * (1.0f / 250.0f);
            for (int k = 0; k < 4; ++k) for (int r = 0; r < 2; ++r) { float* row = out + (size_t)(2 * (vcu * NWAVES + wave) + r + 4096 * k) * D; for (int cc = lane; cc < D; cc += 64) row[cc] += pp; } } }
#else
    if (IN(11)) REP(11) { phase_final(out, X1B, Y, slot, mod, g_fin, wave, lane, vcu, G, 0.f); if (DOUBLE_PH == 11 && rep_ == 0) xcd_barrier(bar); }
#endif

#undef IN
#undef GRID_BAR
}


struct DumpArgs { const unsigned short* p[8]; unsigned long long n[8]; int f32[8]; int nb; int pad; };
__global__ void k_dump(float* out, DumpArgs a) {
    const size_t i = (size_t)blockIdx.x * blockDim.x + threadIdx.x; float s = 0.f;
    for (int b = 0; b < a.nb; ++b) for (size_t j = i; j < a.n[b]; j += (size_t)M * D) s += (a.f32[b] ? ((const float*)a.p[b])[j] : __uint_as_float(((unsigned)a.p[b][j]) << 16)) * (float)(b + 1);
    out[i] = s;
}
#ifndef DUMP_WHICH
#define DUMP_WHICH -1
#endif
#ifndef STOP_AFTER
#define STOP_AFTER (NPHASE - 1)
#endif
#ifndef MK_PER_PHASE
#define MK_PER_PHASE 0
#endif
extern "C" void kernel_launch(void* const* d_in, const int* in_sizes, int n_in, void* d_out, int out_size, void* d_ws, size_t ws_size, hipStream_t stream) {
    static int grid = 0;
    if (grid == 0) {
        if (n_in != 18 || in_sizes[0] != M * D || out_size != M * D || ws_size < WS_END) { fprintf(stderr, "kernel_launch: unexpected shapes (n_in %d, in0 %d, out %d, ws %zu); nothing launched\n", n_in, n_in > 0 ? in_sizes[0] : -1, out_size, ws_size); grid = -1; return; }
        int dev = 0, cus = 0, per_cu = 0;
        if (hipGetDevice(&dev) != hipSuccess || hipDeviceGetAttribute(&cus, hipDeviceAttributeMultiprocessorCount, dev) != hipSuccess) { grid = -1; return; }
        if (hipFuncSetAttribute((const void*)fwd, hipFuncAttributeMaxDynamicSharedMemorySize, LDS_BYTES) != hipSuccess) { fprintf(stderr, "kernel_launch: hipFuncSetAttribute failed\n"); grid = -1; return; }
        if (hipOccupancyMaxActiveBlocksPerMultiprocessor(&per_cu, (const void*)fwd, NWAVES * 64, LDS_BYTES) != hipSuccess || per_cu < 1) { fprintf(stderr, "kernel_launch: occupancy query reports %d blocks per CU\n", per_cu); }
        (void)hipGetLastError();
        grid = cus;
    }
    if (grid < 0) return;
    (void)hipMemsetAsync((char*)d_ws + WS_CTL, 0, CTL_ZERO_BYTES, stream);
    Args a{};
    for (int i = 0; i < 18; ++i) a.in[i] = (const float*)d_in[i];
    a.out = (float*)d_out; a.ws = (unsigned char*)d_ws;
#if MK_PER_PHASE
    for (int p = 0; p < STOP_AFTER + 1; ++p) { a.ph_lo = p; a.ph_hi = p + 1; hipLaunchKernelGGL(fwd, dim3(grid), dim3(NWAVES * 64), LDS_BYTES, stream, a); }
#if DUMP_WHICH >= 0
    { DumpArgs da{}; unsigned char* w = (unsigned char*)d_ws; int nb = 0;
      auto add = [&](size_t off, size_t n, int isf = 0) { da.p[nb] = (const unsigned short*)(w + off); da.n[nb] = n; da.f32[nb] = isf; ++nb; };
      if (DUMP_WHICH == 0) { add(WS_WIN, (size_t)DIN * D); add(WS_WF, (size_t)D * D); add(WS_WCO, (size_t)D * D); add(WS_WO, (size_t)D * D); add(WS_WGU, (size_t)NE * 4096 * D); add(WS_WD, (size_t)NE * D * DE); add(WS_FC1, 8192 + 0); add(WS_MODP, 4 * 2 * 6 * D, 1); }
      if (DUMP_WHICH == 1) { add(WS_H1, (size_t)M * D); add(WS_MOD, 2 * 6 * D, 1); add(WS_FC2, 65536); }
      if (DUMP_WHICH == 2) { add(WS_UF, (size_t)M * DF); add(WS_CV, (size_t)M * D); add(WS_BG, (size_t)M * D); add(WS_GA, (size_t)M * D); add(WS_GB, (size_t)M * D); }
      if (DUMP_WHICH == 5) { add(WS_UF, (size_t)M * DIN); }
      if (DUMP_WHICH == 6) { add(WS_UF, (size_t)M * DF); add(WS_CV, (size_t)M * D); }
      if (DUMP_WHICH == 7) { add(WS_BG, (size_t)M * D); }
      if (DUMP_WHICH == 8) { add(WS_GA, (size_t)M * D); add(WS_GB, (size_t)M * D); }
      if (DUMP_WHICH == 9) { add(WS_GA, (size_t)M * D); }
      if (DUMP_WHICH == 10) { add(WS_GB, (size_t)M * D); }
      if (DUMP_WHICH == 3) { add(WS_ZF, (size_t)M * D); add(WS_AB, (size_t)M * D); }
      if (DUMP_WHICH == 4) { add(WS_TZ, (size_t)M * D); }
      da.nb = nb; hipLaunchKernelGGL(k_dump, dim3(M * D / 256), dim3(256), 0, stream, (float*)d_out, da); }
#endif
#else
    a.ph_lo = 0; a.ph_hi = NPHASE; hipLaunchKernelGGL(fwd, dim3(grid), dim3(NWAVES * 64), LDS_BYTES, stream, a);
#endif
}
```

```cpp
#include <hip/hip_runtime.h>
#include <cstdio>
#include <cstdint>
#define MK_PER_PHASE 0
#define STOP_AFTER 11
#define DUMP_WHICH -1
#define GALIGN true
#define GSP2 true
#define DBG_PLAIN 0
#define DBG_NOBIAS 0
#define DBG_NOSIG 0
#define PROBE_I -1
#define PROBE_J -1
#define DOUBLE_PH -1
#define STAGGER_US 0
#define EXTRA_BARS 0
#define DBG_EPI2 0
#ifndef PROBE_I
#define PROBE_I -1
#endif
#ifndef DBG_EPI2
#define DBG_EPI2 0
#endif
namespace pg8 {
#define PG8_LAS __attribute__((address_space(3)))
typedef unsigned short bf16_t;
typedef short bf16x8 __attribute__((ext_vector_type(8)));
typedef float f32x4 __attribute__((ext_vector_type(4)));
typedef unsigned u32x4 __attribute__((ext_vector_type(4)));
typedef unsigned u32x2 __attribute__((ext_vector_type(2)));
typedef int v8i __attribute__((ext_vector_type(8)));
typedef int v4i __attribute__((ext_vector_type(4)));
constexpr int BM = 256, BK = 64, HALF = 128, HTB = HALF * BK * 2  , STAGE_BYTES = 8 * HTB, NXCD = 8, WGM = 8;

__host__ __device__ __forceinline__ int lds_byte(int r, int c) { const int st = (r >> 4) * 2 + (c >> 5), rr = r & 15, cc = c & 31, ob = rr * 64 + cc * 2; return st * 1024 + (ob ^ (((ob >> 9) & 1) << 5)); }
__host__ __device__ __forceinline__ void stage_rc(int b, int& R, int& C) { const int st = b / 1024, sb = b % 1024, swz = sb ^ (((sb >> 9) & 1) << 5); R = (st >> 1) * 16 + swz / 64; C = (st & 1) * 32 + (swz % 64) / 2; }
__host__ __device__ __forceinline__ int perm32(int rho) { const int n = rho >> 4, i = rho & 15; return 8 * (i >> 2) + 4 * n + (i & 3); }

struct Unit { int pm, pn; };
struct Gemm { const bf16_t* A; const bf16_t* Bt; int M, N, K; int bgrp; size_t bstride; const int* gidx; unsigned long long* ts; const bf16_t* A2; int asplit; };

struct StaticOrder {
    int nM, nN, nwg, G, c;
    __host__ __device__ void init(int M, int N, int G_, int c_) { nM = M / BM; nN = N / BM; nwg = nM * nN; G = G_; c = c_; }
    __host__ __device__ bool next(int i, Unit& u) const {
        const long L = (long)i * G + c; if (L >= nwg) return false;
        int wgid = (int)L; { const int q = nwg / NXCD, r = nwg % NXCD, xcd = wgid % NXCD, off = wgid / NXCD; wgid = (xcd < r ? xcd * (q + 1) : r * (q + 1) + (xcd - r) * q) + off; }
        const int nig = WGM * nN, gid = wgid / nig, fm = gid * WGM, gsz = (nM - fm) < WGM ? (nM - fm) : WGM;
        u.pm = fm + ((wgid % nig) % gsz); u.pn = (wgid % nig) / gsz; return true;
    }
    __device__ __forceinline__ void a_ready(const Unit&) const {}
    __device__ __forceinline__ void done(const Unit&) const {}
};

typedef __bf16 bf16x2_t __attribute__((ext_vector_type(2)));
typedef float f32x2_t __attribute__((ext_vector_type(2)));
__device__ __forceinline__ unsigned cvt_pk_bf16(float lo, float hi) { const f32x2_t v = {lo, hi}; const bf16x2_t b = __builtin_convertvector(v, bf16x2_t); return __builtin_bit_cast(unsigned, b); }
__device__ __forceinline__ float bf_lo(unsigned w) { return __uint_as_float(w << 16); }
__device__ __forceinline__ float bf_hi(unsigned w) { return __uint_as_float(w & 0xffff0000u); }
__device__ __forceinline__ float sigm(float v) { return __builtin_amdgcn_rcpf(1.0f + __expf(-v)); }


template <class Epi, class Sched, int AMODE, bool ALIGN_EPI, bool SP2, bool F8 = false>
__device__ __forceinline__ void gemm_phase(PG8_LAS unsigned char* lds, const Gemm g, const Sched& S, const Epi& E) {
    const int tid = threadIdx.x, wid = __builtin_amdgcn_readfirstlane(tid >> 6), lane = tid & 63, wr = wid >> 2, wc = wid & 3, fr = lane & 15, fq = lane >> 4;
    const int K = g.K, nt = K / BK;
    unsigned voffA0[2], voffA1[2], voffB[2]; int gR[2], gC2[2];
#pragma unroll
    for (int i = 0; i < 2; ++i) { int R, C; stage_rc(tid * 16 + i * 8192, R, C); const int Rb = Epi::PERM ? ((R & ~31) + perm32(R & 31)) : R;
        voffB[i] = (unsigned)(Rb * K + C) * 2u; gR[i] = R; gC2[i] = C * 2;
        if (AMODE == 0) { voffA0[i] = (unsigned)(R * K + C) * 2u; voffA1[i] = (unsigned)((R + HALF) * K + C) * 2u; }
        else if (AMODE == 1) { voffA0[i] = (unsigned)((C >> 3) * 8192 + R) * 16u; voffA1[i] = voffA0[i] + (unsigned)HALF * 16u; }
        else if (AMODE == 3) { voffA0[i] = (unsigned)((C >> 3) * 8192 + R) * 16u; voffA1[i] = voffA0[i] + (unsigned)HALF * 16u; }
        else { voffA0[i] = 0u; voffA1[i] = 0u; } }
    const size_t kstepB = (size_t)(BK * 2);
    size_t kstepA = (AMODE == 1 || AMODE == 3) ? (size_t)8 * 8192 * 16 : (size_t)(BK * 2), kstepAN = kstepA;
    unsigned vrm0[2] = {0u, 0u}, vrm1[2] = {0u, 0u}, vbl0[2] = {0u, 0u}, vbl1[2] = {0u, 0u};
    if (AMODE == 3) {
#pragma unroll
        for (int i = 0; i < 2; ++i) { vbl0[i] = voffA0[i]; vbl1[i] = voffA1[i]; vrm0[i] = (unsigned)(gR[i] * K) * 2u + (unsigned)gC2[i]; vrm1[i] = (unsigned)((gR[i] + HALF) * K) * 2u + (unsigned)gC2[i]; } }
    int nidx0[2] = {0, 0}, nidx1[2] = {0, 0}; unsigned voffN0[2] = {0u, 0u}, voffN1[2] = {0u, 0u};
#define PG8_GIDX_LOAD(u) do { if (AMODE == 2) { _Pragma("unroll") for (int _i = 0; _i < 2; ++_i) { \
        const int* _p0 = g.gidx + (size_t)(u).pm * BM + gR[_i]; const int* _p1 = _p0 + HALF; \
        asm volatile("global_load_dword %0, %1, off" : "=v"(nidx0[_i]) : "v"(_p0) : "memory"); asm volatile("global_load_dword %0, %1, off" : "=v"(nidx1[_i]) : "v"(_p1) : "memory"); } } } while (0)
#define PG8_GIDX_USE() do { if (AMODE == 2) { _Pragma("unroll") for (int _i = 0; _i < 2; ++_i) { asm volatile("" : "+v"(nidx0[_i]), "+v"(nidx1[_i])); \
        voffN0[_i] = (unsigned)nidx0[_i] * (unsigned)(K * 2) + (unsigned)gC2[_i]; voffN1[_i] = (unsigned)nidx1[_i] * (unsigned)(K * 2) + (unsigned)gC2[_i]; } } } while (0)
    const size_t hstepB = (size_t)HALF * K * 2;
    const size_t tstepB = 2 * hstepB;
    const unsigned ldsw = (unsigned)wid * 1024u;
    const int aoff = lds_byte(wr * 64 + fr, fq * 8), boff = lds_byte(wc * 32 + fr, fq * 8);
    const int aoff8a = lds_byte(wr * 64 + fr, fq * 16), boff8a = lds_byte(wc * 32 + fr, fq * 16);
#define PG8_BLK3(u) ((u).pn < g.asplit)
#define PG8_ABASE(u) ((AMODE == 3) ? (PG8_BLK3(u) ? (const char*)g.A + (size_t)((u).pm >> 5) * ((size_t)(K >> 3) * 8192 * 16) + (size_t)((u).pm & 31) * (BM * 16) : (const char*)g.A2 + (size_t)(u).pm * (size_t)BM * K * 2) : (const char*)g.A + ((AMODE == 2) ? (size_t)0 : (AMODE == 0) ? (size_t)(u).pm * (size_t)BM * K * 2 : (size_t)((u).pm >> 5) * ((size_t)(K >> 3) * 8192 * 16) + (size_t)((u).pm & 31) * (BM * 16)))
#define PG8_BBASE(u) ((const char*)g.Bt + (g.bgrp ? (size_t)((u).pm / g.bgrp) * g.bstride * 2 : (size_t)0) + (size_t)(u).pn * tstepB)
#define PG8_SA(b, h) (((b) * 2 + (h)) * HTB)
#define PG8_SB(b, h) ((4 + (b) * 2 + (h)) * HTB)
#define PG8_STAGE(bufoff, gbase, voff) do { _Pragma("unroll") for (int _i = 0; _i < 2; ++_i) \
        __builtin_amdgcn_global_load_lds((const unsigned*)((const char*)(gbase) + (voff)[_i]), (PG8_LAS unsigned*)(lds + (bufoff) + ldsw + _i * 8192), 16, 0, 0); } while (0)
#define PG8_LDA16(dst, b, h) do { _Pragma("unroll") for (int m = 0; m < 4; ++m) _Pragma("unroll") for (int k = 0; k < 2; ++k) dst[m][k] = *(const PG8_LAS bf16x8*)(lds + PG8_SA(b, h) + aoff + m * 2048 + k * 1024); } while (0)
#define PG8_LDB16(dst, b, h) do { _Pragma("unroll") for (int n = 0; n < 2; ++n) _Pragma("unroll") for (int k = 0; k < 2; ++k) dst[n][k] = *(const PG8_LAS bf16x8*)(lds + PG8_SB(b, h) + boff + n * 2048 + k * 1024); } while (0)
#define PG8_MMA16(ai, bj, At, Bt) do { __builtin_amdgcn_s_setprio(1); _Pragma("unroll") for (int m = 0; m < 4; ++m) _Pragma("unroll") for (int n = 0; n < 2; ++n) _Pragma("unroll") for (int k = 0; k < 2; ++k) \
        acc[ai][bj][m][n] = __builtin_amdgcn_mfma_f32_16x16x32_bf16(Bt[n][k], At[m][k], acc[ai][bj][m][n], 0, 0, 0); __builtin_amdgcn_s_setprio(0); } while (0)
#define PG8_LDA8(dst, b, h) do { _Pragma("unroll") for (int m = 0; m < 4; ++m) { const v4i lo_ = *(const PG8_LAS v4i*)(lds + PG8_SA(b, h) + aoff8a + m * 2048), hi_ = *(const PG8_LAS v4i*)(lds + PG8_SA(b, h) + aoff8a + m * 2048 + 16); \
        dst[m] = (v8i){lo_.x, lo_.y, lo_.z, lo_.w, hi_.x, hi_.y, hi_.z, hi_.w}; } } while (0)
#define PG8_LDB8(dst, b, h) do { _Pragma("unroll") for (int n = 0; n < 2; ++n) { const v4i lo_ = *(const PG8_LAS v4i*)(lds + PG8_SB(b, h) + boff8a + n * 2048), hi_ = *(const PG8_LAS v4i*)(lds + PG8_SB(b, h) + boff8a + n * 2048 + 16); \
        dst[n] = (v8i){lo_.x, lo_.y, lo_.z, lo_.w, hi_.x, hi_.y, hi_.z, hi_.w}; } } while (0)
#define PG8_MMA8(ai, bj, At, Bt) do { __builtin_amdgcn_s_setprio(1); _Pragma("unroll") for (int m = 0; m < 4; ++m) _Pragma("unroll") for (int n = 0; n < 2; ++n) \
        asm volatile("v_mfma_scale_f32_16x16x128_f8f6f4 %0, %1, %2, %0, %3, %3 op_sel:[0,1,0] op_sel_hi:[0,0,0]" : "+v"(acc[ai][bj][m][n]) : "v"(Bt[n]), "v"(At[m]), "v"(f8scale)); __builtin_amdgcn_s_setprio(0); } while (0)
#define PG8_LDA(dst, b, h) do { if constexpr (F8) PG8_LDA8(dst##8, b, h); else PG8_LDA16(dst, b, h); } while (0)
#define PG8_LDB(dst, b, h) do { if constexpr (F8) PG8_LDB8(dst##8, b, h); else PG8_LDB16(dst, b, h); } while (0)
#define PG8_MMA(ai, bj, At, Bt) do { if constexpr (F8) PG8_MMA8(ai, bj, At##8, Bt##8); else PG8_MMA16(ai, bj, At, Bt); } while (0)
#define PG8_WAIT_V(n) asm volatile("s_waitcnt vmcnt(" #n ")" ::: "memory")
#define PG8_WAIT_VE() do { if (epi_st == 0) PG8_WAIT_V(8); else if (epi_st == 8) PG8_WAIT_V(16); else if (epi_st == 16) PG8_WAIT_V(24); else PG8_WAIT_V(40); } while (0)
#define PG8_WAIT_L(n) asm volatile("s_waitcnt lgkmcnt(" #n ")" ::: "memory")
#define PG8_BAR __builtin_amdgcn_s_barrier()
#define PG8_SCHED __builtin_amdgcn_sched_barrier(0)
    Unit cur, nxt; int ui = 0; int epi_st = 0;
    if (!S.next(0, cur)) return;
    f32x4 acc[2][2][4][2];
#pragma unroll
    for (int a = 0; a < 2; ++a)
#pragma unroll
        for (int b = 0; b < 2; ++b)
#pragma unroll
            for (int m = 0; m < 4; ++m)
#pragma unroll
                for (int n = 0; n < 2; ++n) acc[a][b][m][n] = (f32x4){0.f, 0.f, 0.f, 0.f};
    bf16x8 At[4][2], B0[2][2], B1[2][2]; v8i At8[4], B08[2], B18[2]; int f8scale = 0x7f7f7f78; asm volatile("" : "+v"(f8scale));
    const char* cA = PG8_ABASE(cur); const char* cB = PG8_BBASE(cur);
    S.a_ready(cur);
    if (AMODE == 3) { const bool blk = PG8_BLK3(cur); kstepA = blk ? (size_t)8 * 8192 * 16 : (size_t)(BK * 2);
#pragma unroll
        for (int i = 0; i < 2; ++i) { voffA0[i] = blk ? vbl0[i] : vrm0[i]; voffA1[i] = blk ? vbl1[i] : vrm1[i]; } }
    if (AMODE == 2) { PG8_GIDX_LOAD(cur); asm volatile("s_waitcnt vmcnt(0)" ::: "memory"); PG8_GIDX_USE();
#pragma unroll
        for (int i = 0; i < 2; ++i) { voffA0[i] = voffN0[i]; voffA1[i] = voffN1[i]; } }
    if constexpr (SP2) {
        PG8_STAGE(PG8_SB(0, 0), cB, voffB); PG8_STAGE(PG8_SB(0, 1), cB + hstepB, voffB); PG8_STAGE(PG8_SA(0, 0), cA, voffA0); PG8_STAGE(PG8_SA(0, 1), cA, voffA1);
        if (wr == 1) PG8_BAR;
        PG8_WAIT_V(2); PG8_BAR;
        PG8_STAGE(PG8_SB(1, 0), cB + kstepB, voffB); PG8_STAGE(PG8_SA(1, 0), cA + kstepA, voffA0); PG8_STAGE(PG8_SB(1, 1), cB + hstepB + kstepB, voffB);
        PG8_WAIT_V(6); PG8_BAR;
    } else {
        PG8_STAGE(PG8_SB(0, 0), cB, voffB); PG8_STAGE(PG8_SA(0, 0), cA, voffA0); PG8_STAGE(PG8_SB(0, 1), cB + hstepB, voffB); PG8_STAGE(PG8_SA(0, 1), cA, voffA1);
        if (wr == 1) PG8_BAR;
        PG8_WAIT_V(4); PG8_BAR;
        PG8_STAGE(PG8_SB(1, 0), cB + kstepB, voffB); PG8_STAGE(PG8_SA(1, 0), cA + kstepA, voffA0); PG8_STAGE(PG8_SB(1, 1), cB + hstepB + kstepB, voffB);
        PG8_WAIT_V(6); PG8_BAR;
    }
    for (;;) {
        const bool has_next = S.next(ui + 1, nxt);
        const char* nA = has_next ? PG8_ABASE(nxt) : cA; const char* nB = has_next ? PG8_BBASE(nxt) : cB;
        if (AMODE == 3) { const bool blkn = has_next ? PG8_BLK3(nxt) : PG8_BLK3(cur); kstepAN = blkn ? (size_t)8 * 8192 * 16 : (size_t)(BK * 2);
#pragma unroll
            for (int i = 0; i < 2; ++i) { voffN0[i] = blkn ? vbl0[i] : vrm0[i]; voffN1[i] = blkn ? vbl1[i] : vrm1[i]; } }
        if (AMODE == 2) { if (has_next) PG8_GIDX_LOAD(nxt); }
#if PROBE_I >= 0
        if (Epi::STAMP && ui == 1 && blockIdx.x == 0 && threadIdx.x == 0) g.ts[30] = __builtin_amdgcn_s_memrealtime();
#endif
#pragma unroll 1
        for (int t = 0; t < nt; t += 2) {
            const bool last = (t == nt - 2);
            unsigned vS0[2], vS1[2];
            if (AMODE == 2) { if (last) { if (has_next) PG8_GIDX_USE(); else { _Pragma("unroll") for (int i = 0; i < 2; ++i) { voffN0[i] = voffA0[i]; voffN1[i] = voffA1[i]; } } } }
#pragma unroll
            for (int i = 0; i < 2; ++i) { vS0[i] = ((AMODE == 2 || AMODE == 3) && last) ? voffN0[i] : voffA0[i]; vS1[i] = ((AMODE == 2 || AMODE == 3) && last) ? voffN1[i] : voffA1[i]; }
            const char* a1 = cA + (size_t)(t + 1) * kstepA;
            const char* a2 = last ? nA : cA + (size_t)(t + 2) * kstepA; const char* b2 = last ? nB : cB + (size_t)(t + 2) * kstepB;
            const char* a3 = a2 + ((AMODE == 3 && last) ? kstepAN : kstepA); const char* b3 = b2 + kstepB;
            if (last && has_next) S.a_ready(nxt);
            if constexpr (SP2) {
            PG8_LDB(B0, 0, 0); PG8_LDB(B1, 0, 1); PG8_SCHED; PG8_LDA(At, 0, 0); PG8_STAGE(PG8_SA(1, 1), a1, voffA1);
            PG8_WAIT_VE(); PG8_WAIT_L(0); PG8_BAR; PG8_MMA(0, 0, At, B0); PG8_MMA(0, 1, At, B1); PG8_BAR; PG8_SCHED;
            PG8_LDA(At, 0, 1); PG8_STAGE(PG8_SB(0, 0), b2, voffB); PG8_STAGE(PG8_SB(0, 1), b2 + hstepB, voffB); PG8_STAGE(PG8_SA(0, 0), a2, vS0);
            PG8_WAIT_VE(); epi_st = 0; PG8_WAIT_L(0); PG8_BAR; PG8_MMA(1, 0, At, B0); PG8_MMA(1, 1, At, B1); PG8_BAR; PG8_SCHED;
            PG8_LDB(B0, 1, 0); PG8_LDB(B1, 1, 1); PG8_SCHED; PG8_LDA(At, 1, 0); PG8_STAGE(PG8_SA(0, 1), a2, vS1);
            PG8_WAIT_V(8); PG8_WAIT_L(0); PG8_BAR; PG8_MMA(0, 0, At, B0); PG8_MMA(0, 1, At, B1); PG8_BAR; PG8_SCHED;
            PG8_LDA(At, 1, 1); PG8_STAGE(PG8_SB(1, 0), b3, voffB); PG8_STAGE(PG8_SB(1, 1), b3 + hstepB, voffB); PG8_STAGE(PG8_SA(1, 0), a3, vS0);
            PG8_WAIT_V(8); PG8_WAIT_L(0); PG8_BAR; PG8_MMA(1, 0, At, B0); PG8_MMA(1, 1, At, B1); PG8_BAR; PG8_SCHED;
            } else {
            PG8_LDB(B0, 0, 0); PG8_SCHED; PG8_LDA(At, 0, 0); PG8_STAGE(PG8_SA(1, 1), a1, voffA1);
            PG8_WAIT_L(8); PG8_BAR; PG8_WAIT_L(0); PG8_MMA(0, 0, At, B0); PG8_BAR; PG8_SCHED;
            PG8_LDB(B1, 0, 1); PG8_STAGE(PG8_SB(0, 0), b2, voffB);
            PG8_BAR; PG8_WAIT_L(0); PG8_MMA(0, 1, At, B1); PG8_BAR;
            PG8_LDA(At, 0, 1); PG8_STAGE(PG8_SA(0, 0), a2, vS0);
            PG8_BAR; PG8_WAIT_L(0); PG8_MMA(1, 0, At, B0); PG8_BAR; PG8_SCHED;
            PG8_STAGE(PG8_SB(0, 1), b2 + hstepB, voffB);
            PG8_WAIT_V(6); PG8_BAR; PG8_MMA(1, 1, At, B1); PG8_BAR;
            PG8_LDB(B0, 1, 0); PG8_SCHED; PG8_LDA(At, 1, 0); PG8_STAGE(PG8_SA(0, 1), a2, vS1);
            PG8_WAIT_L(8); PG8_BAR; PG8_WAIT_L(0); PG8_MMA(0, 0, At, B0); PG8_BAR; PG8_SCHED;
            PG8_LDB(B1, 1, 1); PG8_STAGE(PG8_SB(1, 0), b3, voffB);
            PG8_BAR; PG8_WAIT_L(0); PG8_MMA(0, 1, At, B1); PG8_BAR;
            PG8_LDA(At, 1, 1); PG8_STAGE(PG8_SA(1, 0), a3, vS0);
            PG8_BAR; PG8_WAIT_L(0); PG8_MMA(1, 0, At, B0); PG8_BAR; PG8_SCHED;
            PG8_STAGE(PG8_SB(1, 1), b3 + hstepB, voffB);
            PG8_WAIT_V(6); PG8_BAR; PG8_MMA(1, 1, At, B1); PG8_BAR;
            }
        }
#if PROBE_I >= 0
        if (Epi::STAMP && ui == 1 && blockIdx.x == 0 && threadIdx.x == 0) g.ts[31] = __builtin_amdgcn_s_memrealtime();
#endif
        if constexpr (ALIGN_EPI) { if (wr == 0) PG8_BAR; }
        if constexpr (F8) asm volatile("s_nop 15\n\ts_nop 15\n\ts_nop 7" ::: "memory");
        E(acc, cur, wr, wc, fr, fq); S.done(cur);
#if DBG_EPI2
        if (Epi::EPI2) { asm volatile("" ::: "memory"); E(acc, cur, wr, wc, fr, fq); }
#endif
#if PROBE_I >= 0
        if (Epi::STAMP && ui == 1 && blockIdx.x == 0 && threadIdx.x == 0) g.ts[32] = __builtin_amdgcn_s_memrealtime();
        if (Epi::STAMP && ui == 2 && blockIdx.x == 0 && threadIdx.x == 0) g.ts[33] = __builtin_amdgcn_s_memrealtime();
#endif
        if (!has_next) break;
        epi_st = E.nst(cur);
#pragma unroll
        for (int a = 0; a < 2; ++a)
#pragma unroll
            for (int b = 0; b < 2; ++b)
#pragma unroll
                for (int m = 0; m < 4; ++m)
#pragma unroll
                    for (int n = 0; n < 2; ++n) acc[a][b][m][n] = (f32x4){0.f, 0.f, 0.f, 0.f};
        cur = nxt; cA = nA; cB = nB; ++ui;
        if (AMODE == 2 || AMODE == 3) {
#pragma unroll
            for (int i = 0; i < 2; ++i) { voffA0[i] = voffN0[i]; voffA1[i] = voffN1[i]; } }
        if (AMODE == 3) kstepA = kstepAN;
        if constexpr (ALIGN_EPI) { if (wr == 1) PG8_BAR; }
    }
    PG8_WAIT_V(0);
    if constexpr (!ALIGN_EPI) { if (wr == 0) PG8_BAR; }
    PG8_BAR;
#undef PG8_GIDX_LOAD
#undef PG8_GIDX_USE
#undef PG8_BLK3
#undef PG8_ABASE
#undef PG8_BBASE
#undef PG8_SA
#undef PG8_SB
#undef PG8_STAGE
#undef PG8_LDA
#undef PG8_LDA16
#undef PG8_LDA8
#undef PG8_LDB16
#undef PG8_LDB8
#undef PG8_MMA16
#undef PG8_MMA8
#undef PG8_LDB
#undef PG8_MMA
#undef PG8_WAIT_V
#undef PG8_WAIT_VE
#undef PG8_WAIT_L
#undef PG8_BAR
#undef PG8_SCHED
}
}
constexpr int NWAVES = 8;
constexpr int BATCH = 2, SEQ = 8192, D = 1024, M = BATCH * SEQ, DF = 512, DIN = 5632, NE = 16, CAP = 1024, DE = 2048, MR = BATCH * NE * CAP  ;
constexpr float RMS_EPS = 1e-6f;
constexpr size_t MiB = 1u << 20;
constexpr size_t WS_CTL = 0, CTL_ZERO_BYTES = 32 * 1024;
constexpr size_t WS_MODP = 1 * MiB, WS_MOD = 1 * MiB + 256 * 1024, WS_FC1 = 1 * MiB + 512 * 1024, WS_FC2 = 1 * MiB + 576 * 1024;
constexpr size_t WS_PROBS = 2 * MiB, WS_SLOT = 3 * MiB, WS_IDX = 4 * MiB, WS_VAL = 4 * MiB + 128 * 1024;
constexpr size_t WS_WIN = 8 * MiB, WS_WF = 20 * MiB, WS_WCO = 22 * MiB, WS_WO = 24 * MiB, WS_WGU = 32 * MiB, WS_WD = 160 * MiB;
constexpr size_t WS_H1 = 224 * MiB, WS_AB = 224 * MiB, WS_UF = 256 * MiB, WS_CV = 272 * MiB, WS_BG = 304 * MiB, WS_GA = 336 * MiB, WS_GB = 368 * MiB, WS_ZF = 400 * MiB, WS_TZ = 432 * MiB, WS_H2 = 464 * MiB;
#ifndef MOE_FP8
#define MOE_FP8 1
#endif
constexpr size_t WS_HM = 224 * MiB, WS_Y = 432 * MiB, WS_X1B = 400 * MiB, WS_END = 496 * MiB;
constexpr int CW_BAR = 4096;
constexpr int RING_BYTES = 131072, MISC_OFF = 143360, LDS_BYTES = 147456;
constexpr int FFT_TOFF = 65536, FFT_TPITCH = 528;

#define GAS __attribute__((address_space(1)))
#define LAS __attribute__((address_space(3)))
typedef unsigned short bf16;
typedef unsigned v4u __attribute__((ext_vector_type(4)));
typedef unsigned v2u __attribute__((ext_vector_type(2)));
typedef float f32x4 __attribute__((ext_vector_type(4)));
typedef short bf16x8 __attribute__((ext_vector_type(8)));
#define LDS_WAIT() asm volatile("s_waitcnt lgkmcnt(0)" ::: "memory")
#define VM_WAIT() asm volatile("s_waitcnt vmcnt(0)" ::: "memory")
using pg8::cvt_pk_bf16; using pg8::bf_lo; using pg8::bf_hi; using pg8::sigm;
__device__ __forceinline__ float wave_sum(float v) {
#pragma unroll
    for (int o = 1; o < 64; o <<= 1) v += __shfl_xor(v, o);
    return v;
}
__device__ __forceinline__ float silu(float v) { return v * sigm(v); }
#ifndef DBG_NOBIAS
#define DBG_NOBIAS 0
#endif
#ifndef DBG_NOSIG
#define DBG_NOSIG 0
#endif
__device__ __forceinline__ float sigx(float v) { return DBG_NOSIG ? v : sigm(v); }

#define XB_TMO      128
#define XB_XCNT(j)  (256  + 64 * (j))
#define XB_XSUB(j)  (1280 + 64 * (j))
#define XB_XGEN(j)  (2304 + 64 * (j))
#define XB_TOP      3328
#define XB_TOPGEN   3392
#define XCD_BAR_WORDS 3456
#define XB_SPIN_CAP (1u << 18)
__device__ __forceinline__ unsigned xb_ld(unsigned* p)              { return __hip_atomic_load(p, __ATOMIC_RELAXED, __HIP_MEMORY_SCOPE_AGENT); }
__device__ __forceinline__ unsigned xb_add(unsigned* p, unsigned v) { return __hip_atomic_fetch_add(p, v, __ATOMIC_RELAXED, __HIP_MEMORY_SCOPE_AGENT); }
__device__ __forceinline__ unsigned xb_xcc_id() { return (unsigned)__builtin_amdgcn_s_getreg((3 << 11) | 20) & 0xFu; }
#define XB_SPIN(cond, bar) do { unsigned _sp = 0; while (cond) { __builtin_amdgcn_s_sleep(1); \
    if ((++_sp & 255u) == 0u) { if (xb_ld(&(bar)[XB_TMO])) break; if (_sp > XB_SPIN_CAP) { atomicAdd(&(bar)[XB_TMO], 1u); break; } } } } while (0)
struct XcdBarrier { unsigned* bar; unsigned x; volatile LAS unsigned* st; };
__device__ __forceinline__ XcdBarrier xcd_barrier_post(unsigned* bar, volatile LAS unsigned* st) {
    XcdBarrier b; b.bar = bar; b.x = xb_xcc_id(); b.st = st;
    if (threadIdx.x == 0) (void)xb_add(&bar[XB_XCNT(b.x)], 1u);
    return b;
}
__device__ __forceinline__ void xcd_barrier_complete(unsigned* bar, unsigned x, unsigned& nloc, unsigned& nx) {
    const unsigned G = gridDim.x * gridDim.y * gridDim.z;
    unsigned sum, cnt, mine, sp = 0u;
    for (;;) {
        sum = 0u; cnt = 0u; mine = 0u;
#pragma unroll
        for (unsigned j = 0; j < 16; ++j) { const unsigned c = xb_ld(&bar[XB_XCNT(j)]); sum += c; cnt += (c > 0u) ? 1u : 0u; mine = (j == x) ? c : mine; }
        if (sum == G) break;
        __builtin_amdgcn_s_sleep(1);
        if ((++sp & 255u) == 0u) { if (xb_ld(&bar[XB_TMO])) break; if (sp > XB_SPIN_CAP) { atomicAdd(&bar[XB_TMO], 1u); break; } }
    }
    nloc = mine > 0u ? mine : 1u; nx = cnt > 0u ? cnt : 1u;
}
__device__ __forceinline__ void xcd_barrier(const XcdBarrier& b) {
    asm volatile("s_waitcnt vmcnt(0)" ::: "memory");
    __syncthreads();
    if (threadIdx.x == 0) {
        unsigned* bar = b.bar;
        __builtin_amdgcn_s_waitcnt(0);
        unsigned nloc = b.st[0], nx = b.st[1];
        if (nloc == 0u) { xcd_barrier_complete(bar, b.x, nloc, nx); b.st[0] = nloc; b.st[1] = nx; }
        const unsigned old = xb_add(&bar[XB_XSUB(b.x)], 1u);
        const unsigned gen = old / nloc;
        if (old + 1u == (gen + 1u) * nloc) {
            __builtin_amdgcn_fence(__ATOMIC_RELEASE, "agent");
            asm volatile("s_waitcnt vmcnt(0)" ::: "memory");
            const unsigned og = xb_add(&bar[XB_TOP], 1u);
            const unsigned tg = og / nx;
            if (og + 1u == (tg + 1u) * nx) xb_add(&bar[XB_TOPGEN], 1u);
            else XB_SPIN(xb_ld(&bar[XB_TOPGEN]) == tg, bar);
            __builtin_amdgcn_fence(__ATOMIC_ACQUIRE, "agent");
            xb_add(&bar[XB_XGEN(b.x)], 1u);
            asm volatile("s_waitcnt vmcnt(0)" ::: "memory");
        } else {
            XB_SPIN(xb_ld(&bar[XB_XGEN(b.x)]) == gen, bar);
            __builtin_amdgcn_fence(__ATOMIC_ACQUIRE, "agent");
            asm volatile("s_waitcnt vmcnt(0)" ::: "memory");
        }
    }
    __syncthreads();
}

using pg8::Unit; using pg8::u32x4; using pg8::u32x2;
__device__ __forceinline__ unsigned pk4_u8(float a, float b2, float c, float d) { return (unsigned)__builtin_rintf(a * 255.f) | ((unsigned)__builtin_rintf(b2 * 255.f) << 8) | ((unsigned)__builtin_rintf(c * 255.f) << 16) | ((unsigned)__builtin_rintf(d * 255.f) << 24); }
#ifndef ST_AHEAD
#define ST_AHEAD 0
#endif
#ifndef NT_INPROJ
#define NT_INPROJ 0
#endif
#if NT_INPROJ == 2
__device__ __forceinline__ void st_sc1(u32x4* p, u32x4 v) { asm volatile("global_store_dwordx4 %0, %1, off sc1" :: "v"(p), "v"(v) : "memory"); }
__device__ __forceinline__ void st_sc1(u32x2* p, u32x2 v) { asm volatile("global_store_dwordx2 %0, %1, off sc1" :: "v"(p), "v"(v) : "memory"); }
#define ST_NT(T, p, v) st_sc1((T*)(p), (v))
#elif NT_INPROJ
#define ST_NT(T, p, v) __builtin_nontemporal_store((v), (T*)(p))
#else
#define ST_NT(T, p, v) (*(T*)(p) = (v))
#endif
struct EpiInProj {
    static constexpr bool PERM = true, EPI2 = (DBG_EPI2 == 2), STAMP = (PROBE_I >= 320 && PROBE_I < 330);
    bf16 *UF, *CV, *BG, *GA, *GB; const float* b_gate;
    __device__ __forceinline__ int nst(const Unit& u) const { return ST_AHEAD ? ((u.pn < 2) ? 32 : 16) : 0; }
    __device__ __forceinline__ void operator()(const f32x4 (&acc)[2][2][4][2], const Unit& u, int wr, int wc, int fr, int fq) const {
        const int row0 = u.pm * 256 + wr * 64 + fr;
        if (u.pn < 2) {
            const int b = u.pm >> 5, s0 = (u.pm & 31) * 256 + wr * 64 + fr;
#pragma unroll
            for (int ai = 0; ai < 2; ++ai)
#pragma unroll
                for (int m = 0; m < 4; ++m) { const int s = s0 + ai * 128 + m * 16;
#pragma unroll
                    for (int bj = 0; bj < 2; ++bj) { const int g4 = (u.pn * 256 + bj * 128 + wc * 32 + 8 * fq) >> 2;
#pragma unroll
                        for (int n = 0; n < 2; ++n) { const f32x4 v = acc[ai][bj][m][n]; u32x2 w; w.x = cvt_pk_bf16(v[0], v[1]); w.y = cvt_pk_bf16(v[2], v[3]);
                            ST_NT(u32x2, UF + ((size_t)(b * 128 + g4 + n) * 8192 + s) * 4, w); } } }
        } else if (u.pn < 10) {
#pragma unroll
            for (int ai = 0; ai < 2; ++ai)
#pragma unroll
                for (int m = 0; m < 4; ++m) { bf16* rowp = CV + (size_t)(row0 + ai * 128 + m * 16) * D + (u.pn - 2) * 128 + wc * 16 + 4 * fq;
#pragma unroll
                    for (int bj = 0; bj < 2; ++bj) { const f32x4 v = acc[ai][bj][m][0] * acc[ai][bj][m][1]; u32x2 w; w.x = cvt_pk_bf16(v[0], v[1]); w.y = cvt_pk_bf16(v[2], v[3]);
                        ST_NT(u32x2, rowp + bj * 64, w); } }
        } else if (u.pn < 14) {
#pragma unroll
            for (int ai = 0; ai < 2; ++ai)
#pragma unroll
                for (int m = 0; m < 4; ++m) { bf16* rowp = BG + (size_t)(row0 + ai * 128 + m * 16) * D + (u.pn - 10) * 256 + wc * 32 + 8 * fq;
#pragma unroll
                    for (int bj = 0; bj < 2; ++bj) { const f32x4 v0 = acc[ai][bj][m][0], v1 = acc[ai][bj][m][1]; u32x4 w; w.x = cvt_pk_bf16(v0[0], v0[1]); w.y = cvt_pk_bf16(v0[2], v0[3]); w.z = cvt_pk_bf16(v1[0], v1[1]); w.w = cvt_pk_bf16(v1[2], v1[3]);
                        ST_NT(u32x4, rowp + bj * 128, w); } }
        } else {
            const int colg = (u.pn - 14) * 256 + wc * 32 + 8 * fq;
            bf16* O = (u.pn < 18) ? GA : GB;
            f32x4 bv[2][2];
#pragma unroll
            for (int bj = 0; bj < 2; ++bj)
#pragma unroll
                for (int n = 0; n < 2; ++n) bv[bj][n] = DBG_NOBIAS ? (f32x4){0.f, 0.f, 0.f, 0.f} : *(const f32x4*)(b_gate + colg + bj * 128 + 4 * n);
#pragma unroll
            for (int ai = 0; ai < 2; ++ai)
#pragma unroll
                for (int m = 0; m < 4; ++m) { unsigned char* rowp8 = (unsigned char*)O + (size_t)(row0 + ai * 128 + m * 16) * D + (colg & 1023);
#pragma unroll
                    for (int bj = 0; bj < 2; ++bj) { const f32x4 v0 = acc[ai][bj][m][0] + bv[bj][0], v1 = acc[ai][bj][m][1] + bv[bj][1]; u32x2 w;
                        w.x = pk4_u8(sigx(v0[0]), sigx(v0[1]), sigx(v0[2]), sigx(v0[3])); w.y = pk4_u8(sigx(v1[0]), sigx(v1[1]), sigx(v1[2]), sigx(v1[3]));
                        ST_NT(u32x2, rowp8 + bj * 128, w); } }
        }
    }
};
template <int MODE> struct EpiGateMul {
    static constexpr bool PERM = true, EPI2 = false, STAMP = false;
    bf16* O; const bf16* G;
    __device__ __forceinline__ int nst(const Unit&) const { return 0; }
    __device__ __forceinline__ void operator()(const f32x4 (&acc)[2][2][4][2], const Unit& u, int wr, int wc, int fr, int fq) const {
        const int row0 = u.pm * 256 + wr * 64 + fr, col0 = u.pn * 256 + wc * 32 + 8 * fq;
#pragma unroll
        for (int ai = 0; ai < 2; ++ai)
#pragma unroll
            for (int m = 0; m < 4; ++m) { const size_t off = (size_t)(row0 + ai * 128 + m * 16) * D + col0;
#pragma unroll
                for (int bj = 0; bj < 2; ++bj) { const u32x2 gw = __builtin_nontemporal_load((const u32x2*)((const unsigned char*)G + off + bj * 128)); const f32x4 v0 = acc[ai][bj][m][0] * (1.0f / 255.0f), v1 = acc[ai][bj][m][1] * (1.0f / 255.0f);
                    float r[8] = {(float)(gw.x & 0xffu) * v0[0], (float)((gw.x >> 8) & 0xffu) * v0[1], (float)((gw.x >> 16) & 0xffu) * v0[2], (float)(gw.x >> 24) * v0[3],
                                  (float)(gw.y & 0xffu) * v1[0], (float)((gw.y >> 8) & 0xffu) * v1[1], (float)((gw.y >> 16) & 0xffu) * v1[2], (float)(gw.y >> 24) * v1[3]};
                    if (MODE == 1) { const u32x4 ow = __builtin_nontemporal_load((const u32x4*)(O + off + bj * 128));
                        r[0] += bf_lo(ow.x); r[1] += bf_hi(ow.x); r[2] += bf_lo(ow.y); r[3] += bf_hi(ow.y); r[4] += bf_lo(ow.z); r[5] += bf_hi(ow.z); r[6] += bf_lo(ow.w); r[7] += bf_hi(ow.w); }
                    u32x4 w; w.x = cvt_pk_bf16(r[0], r[1]); w.y = cvt_pk_bf16(r[2], r[3]); w.z = cvt_pk_bf16(r[4], r[5]); w.w = cvt_pk_bf16(r[6], r[7]);
                    *(u32x4*)(O + off + bj * 128) = w; } }
    }
};
struct EpiGateBoth {
    static constexpr bool PERM = true, EPI2 = false, STAMP = false;
    bf16* O; const bf16* GAp; const bf16* GBp;
    __device__ __forceinline__ int nst(const Unit&) const { return 0; }
    __device__ __forceinline__ void operator()(const f32x4 (&acc)[2][2][4][2], const Unit& u, int wr, int wc, int fr, int fq) const {
        Unit v = u; const bool second = u.pn >= 4; v.pn = u.pn & 3;
        if (!second) { EpiGateMul<0> E{O, GAp}; E(acc, v, wr, wc, fr, fq); } else { EpiGateMul<1> E{O, GBp}; E(acc, v, wr, wc, fr, fq); }
    }
};
struct EpiResid {
    static constexpr bool PERM = true, EPI2 = (DBG_EPI2 == 5), STAMP = false;
    const float* x; bf16* X1B; const float* gate;
    __device__ __forceinline__ int nst(const Unit&) const { return 0; }
    __device__ __forceinline__ void operator()(const f32x4 (&acc)[2][2][4][2], const Unit& u, int wr, int wc, int fr, int fq) const {
        const int row0 = u.pm * 256 + wr * 64 + fr, col0 = u.pn * 256 + wc * 32 + 8 * fq, b = u.pm >> 5;
        f32x4 gv[2][2];
#pragma unroll
        for (int bj = 0; bj < 2; ++bj)
#pragma unroll
            for (int n = 0; n < 2; ++n) gv[bj][n] = *(const f32x4*)(gate + b * 6 * D + col0 + bj * 128 + 4 * n);
#pragma unroll
        for (int ai = 0; ai < 2; ++ai)
#pragma unroll
            for (int m = 0; m < 4; ++m) { const size_t off = (size_t)(row0 + ai * 128 + m * 16) * D + col0;
#pragma unroll
                for (int bj = 0; bj < 2; ++bj) { const f32x4 x0 = __builtin_nontemporal_load((const f32x4*)(x + off + bj * 128)), x1 = __builtin_nontemporal_load((const f32x4*)(x + off + bj * 128 + 4));
                    const f32x4 v0 = x0 + gv[bj][0] * acc[ai][bj][m][0], v1 = x1 + gv[bj][1] * acc[ai][bj][m][1];
                    u32x4 w; w.x = cvt_pk_bf16(v0[0], v0[1]); w.y = cvt_pk_bf16(v0[2], v0[3]); w.z = cvt_pk_bf16(v1[0], v1[1]); w.w = cvt_pk_bf16(v1[2], v1[3]);
                    *(u32x4*)(X1B + off + bj * 128) = w; }
                asm volatile("" ::: "memory"); }
    }
};
struct EpiSwiGLU {
    static constexpr bool PERM = true, EPI2 = (DBG_EPI2 == 9), STAMP = false;
    bf16* HM;
    __device__ __forceinline__ int nst(const Unit&) const { return 0; }
    __device__ __forceinline__ void operator()(const f32x4 (&acc)[2][2][4][2], const Unit& u, int wr, int wc, int fr, int fq) const {
        const int row0 = u.pm * 256 + wr * 64 + fr, col0 = u.pn * 128 + wc * 32 + 8 * fq;
#pragma unroll
        for (int ai = 0; ai < 2; ++ai)
#pragma unroll
            for (int m = 0; m < 4; ++m) { const f32x4 g0 = acc[ai][0][m][0], g1 = acc[ai][0][m][1], u0 = acc[ai][1][m][0], u1 = acc[ai][1][m][1]; u32x4 w;
                w.x = cvt_pk_bf16(silu(g0[0]) * u0[0], silu(g0[1]) * u0[1]); w.y = cvt_pk_bf16(silu(g0[2]) * u0[2], silu(g0[3]) * u0[3]);
                w.z = cvt_pk_bf16(silu(g1[0]) * u1[0], silu(g1[1]) * u1[1]); w.w = cvt_pk_bf16(silu(g1[2]) * u1[2], silu(g1[3]) * u1[3]);
                *(u32x4*)(HM + (size_t)(row0 + ai * 128 + m * 16) * DE + col0) = w; }
    }
};
__device__ __forceinline__ unsigned pk4_fp8(float a, float b2, float c, float d) { unsigned w = 0u; w = __builtin_amdgcn_cvt_pk_fp8_f32(a, b2, w, false); w = __builtin_amdgcn_cvt_pk_fp8_f32(c, d, w, true); return w; }
struct EpiSwiGLU8 {
    static constexpr bool PERM = true, EPI2 = false, STAMP = (PROBE_I >= 330 && PROBE_I < 340);
    unsigned char* HM8;
    __device__ __forceinline__ int nst(const Unit&) const { return ST_AHEAD ? 8 : 0; }
    __device__ __forceinline__ void operator()(const f32x4 (&acc)[2][2][4][2], const Unit& u, int wr, int wc, int fr, int fq) const {
        const int row0 = u.pm * 256 + wr * 64 + fr, col0 = u.pn * 128 + wc * 32 + 8 * fq;
#pragma unroll
        for (int ai = 0; ai < 2; ++ai)
#pragma unroll
            for (int m = 0; m < 4; ++m) { const f32x4 g0 = acc[ai][0][m][0], g1 = acc[ai][0][m][1], u0 = acc[ai][1][m][0], u1 = acc[ai][1][m][1]; u32x2 w;
                w.x = pk4_fp8(silu(g0[0]) * u0[0], silu(g0[1]) * u0[1], silu(g0[2]) * u0[2], silu(g0[3]) * u0[3]);
                w.y = pk4_fp8(silu(g1[0]) * u1[0], silu(g1[1]) * u1[1], silu(g1[2]) * u1[2], silu(g1[3]) * u1[3]);
                *(u32x2*)(HM8 + (size_t)(row0 + ai * 128 + m * 16) * DE + col0) = w; asm volatile("" ::: "memory"); }
    }
};
struct EpiRowScale {
    static constexpr bool PERM = true, EPI2 = (DBG_EPI2 == 10), STAMP = false;
    bf16* Y; const float* val;
    __device__ __forceinline__ int nst(const Unit&) const { return 0; }
    __device__ __forceinline__ void operator()(const f32x4 (&acc)[2][2][4][2], const Unit& u, int wr, int wc, int fr, int fq) const {
        const int row0 = u.pm * 256 + wr * 64 + fr, col0 = u.pn * 256 + wc * 32 + 8 * fq;
#pragma unroll
        for (int ai = 0; ai < 2; ++ai)
#pragma unroll
            for (int m = 0; m < 4; ++m) { const int row = row0 + ai * 128 + m * 16; const float sv = val[row];
#pragma unroll
                for (int bj = 0; bj < 2; ++bj) { const f32x4 v0 = acc[ai][bj][m][0] * sv, v1 = acc[ai][bj][m][1] * sv; u32x4 w; w.x = cvt_pk_bf16(v0[0], v0[1]); w.y = cvt_pk_bf16(v0[2], v0[3]); w.z = cvt_pk_bf16(v1[0], v1[1]); w.w = cvt_pk_bf16(v1[2], v1[3]);
                    *(u32x4*)(Y + (size_t)row * D + col0 + bj * 128) = w; } }
    }
};

struct EpiPlain {
    static constexpr bool PERM = true, EPI2 = false, STAMP = false;
    bf16* O; int ldc;
    __device__ __forceinline__ int nst(const Unit&) const { return 0; }
    __device__ __forceinline__ void operator()(const f32x4 (&acc)[2][2][4][2], const Unit& u, int wr, int wc, int fr, int fq) const {
        const int row0 = u.pm * 256 + wr * 64 + fr, col0 = u.pn * 256 + wc * 32 + 8 * fq;
#pragma unroll
        for (int ai = 0; ai < 2; ++ai)
#pragma unroll
            for (int m = 0; m < 4; ++m) { bf16* rowp = O + (size_t)(row0 + ai * 128 + m * 16) * ldc + col0;
#pragma unroll
                for (int bj = 0; bj < 2; ++bj) { const f32x4 v0 = acc[ai][bj][m][0], v1 = acc[ai][bj][m][1]; u32x4 w; w.x = cvt_pk_bf16(v0[0], v0[1]); w.y = cvt_pk_bf16(v0[2], v0[3]); w.z = cvt_pk_bf16(v1[0], v1[1]); w.w = cvt_pk_bf16(v1[2], v1[3]);
                    *(u32x4*)(rowp + bj * 128) = w; } }
    }
};
#ifndef NT_WLOAD
#define NT_WLOAD 1
#endif
__device__ __forceinline__ unsigned f2bf(float f) { unsigned u = __builtin_bit_cast(unsigned, f); return (u + 0x7fffu + ((u >> 16) & 1u)) >> 16; }
__device__ __forceinline__ unsigned pk2(float lo, float hi) { return f2bf(lo) | (f2bf(hi) << 16); }
__device__ __forceinline__ int rowmap_in(int n) {
    if (n < 512) return n;
    if (n < 1536) { const int j = n - 512; return 512 + 8 * (j >> 2) + (j & 3); }
    if (n < 2560) return 2560 + (n - 1536);
    if (n < 3584) { const int j = n - 2560; return 512 + 8 * (j >> 2) + 4 + (j & 3); }
    return n;
}
template <int MAP>
__device__ __forceinline__ void transpose_item(const float* W, int K, int N, bf16* WT, LAS float* scr, int item, int lane) {
    const int nblk = N / 32, kb = item / nblk, nb = item % nblk, k0 = 64 * kb, n0 = 32 * nb;
    { f32x4 t[8];
#pragma unroll
      for (int i = 0; i < 8; ++i) t[i] = NT_WLOAD ? __builtin_nontemporal_load((const GAS f32x4*)(W + (size_t)(k0 + 8 * i + (lane >> 3)) * N + n0 + 4 * (lane & 7))) : *(const GAS f32x4*)(W + (size_t)(k0 + 8 * i + (lane >> 3)) * N + n0 + 4 * (lane & 7));
#pragma unroll
      for (int i = 0; i < 8; ++i) { LAS float* d_ = scr + (8 * i + (lane >> 3)) * 33 + 4 * (lane & 7); d_[0] = t[i].x; d_[1] = t[i].y; d_[2] = t[i].z; d_[3] = t[i].w; } }
    LDS_WAIT(); asm volatile("" ::: "memory");
    const int c = lane & 7;
#pragma unroll
    for (int j = 0; j < 4; ++j) { const int n = (lane >> 3) + 8 * j; const LAS float* s = scr + (8 * c) * 33 + n;
        v4u o; o.x = pk2(s[0 * 33], s[1 * 33]); o.y = pk2(s[2 * 33], s[3 * 33]); o.z = pk2(s[4 * 33], s[5 * 33]); o.w = pk2(s[6 * 33], s[7 * 33]);
        const int ns = n0 + n; int row;
        if (MAP == 0) row = ns; else if (MAP == 1) row = rowmap_in(ns); else if (MAP == 2) row = 256 * (ns >> 7) + (ns & 127); else row = 256 * (ns >> 7) + 128 + (ns & 127);
        *(GAS v4u*)(WT + (size_t)row * K + k0 + 8 * c) = o; }
    LDS_WAIT(); asm volatile("" ::: "memory");
}
template <int MAP>
__device__ __forceinline__ void transpose_item8(const float* W, int K, int N, unsigned char* WT, LAS float* scr, int item, int lane) {
    const int nblk = N / 32, kb = item / nblk, nb = item % nblk, k0 = 64 * kb, n0 = 32 * nb;
    { f32x4 t[8];
#pragma unroll
      for (int i = 0; i < 8; ++i) t[i] = NT_WLOAD ? __builtin_nontemporal_load((const GAS f32x4*)(W + (size_t)(k0 + 8 * i + (lane >> 3)) * N + n0 + 4 * (lane & 7))) : *(const GAS f32x4*)(W + (size_t)(k0 + 8 * i + (lane >> 3)) * N + n0 + 4 * (lane & 7));
#pragma unroll
      for (int i = 0; i < 8; ++i) { LAS float* d_ = scr + (8 * i + (lane >> 3)) * 33 + 4 * (lane & 7); d_[0] = t[i].x; d_[1] = t[i].y; d_[2] = t[i].z; d_[3] = t[i].w; } }
    LDS_WAIT(); asm volatile("" ::: "memory");
    const int c = lane & 3;
#pragma unroll
    for (int j = 0; j < 2; ++j) { const int n = (lane >> 2) + 16 * j; const LAS float* s = scr + (16 * c) * 33 + n; unsigned o[4];
#pragma unroll
        for (int q = 0; q < 4; ++q) { unsigned w = 0u; w = __builtin_amdgcn_cvt_pk_fp8_f32(s[(4 * q) * 33] * 128.f, s[(4 * q + 1) * 33] * 128.f, w, false); w = __builtin_amdgcn_cvt_pk_fp8_f32(s[(4 * q + 2) * 33] * 128.f, s[(4 * q + 3) * 33] * 128.f, w, true); o[q] = w; }
        const int ns = n0 + n; int row;
        if (MAP == 0) row = ns; else if (MAP == 2) row = 256 * (ns >> 7) + (ns & 127); else row = 256 * (ns >> 7) + 128 + (ns & 127);
        v4u ov; ov.x = o[0]; ov.y = o[1]; ov.z = o[2]; ov.w = o[3];
        *(GAS v4u*)(WT + (size_t)row * K + k0 + 16 * c) = ov; }
    LDS_WAIT(); asm volatile("" ::: "memory");
}
#define EXPW_PARAMS const float* xw_g, const float* xw_u, const float* xw_d, unsigned char* xWGU8, unsigned char* xWD8
#define EXPW_ARGS xw_g, xw_u, xw_d, xWGU8, xWD8
__device__ __forceinline__ void exp_src(EXPW_PARAMS, int r, const float*& W, int& N, int& k0, int& n0) {
    const int e = r / 3072, q = r % 3072, t = q >> 10, it = q & 1023;
    if (t < 2) { W = (t == 0 ? xw_g : xw_u) + (size_t)e * D * DE; N = DE; } else { W = xw_d + (size_t)e * DE * D; N = D; }
    const int nblk = N / 32; k0 = 64 * (it / nblk); n0 = 32 * (it % nblk);
}
__device__ __forceinline__ void exp_load(EXPW_PARAMS, int r, int lane, f32x4 (&t)[8]) {
    const float* W; int N, k0, n0; exp_src(EXPW_ARGS, r, W, N, k0, n0);
#pragma unroll
    for (int i = 0; i < 8; ++i) t[i] = __builtin_nontemporal_load((const GAS f32x4*)(W + (size_t)(k0 + 8 * i + (lane >> 3)) * N + n0 + 4 * (lane & 7)));
}
__device__ __forceinline__ void exp_finish(EXPW_PARAMS, int r, int lane, const f32x4 (&t)[8], LAS float* scr) {
    const float* W; int N, k0, n0; exp_src(EXPW_ARGS, r, W, N, k0, n0);
    const int e = r / 3072, ty = (r % 3072) >> 10, K = (ty < 2) ? D : DE;
    unsigned char* WT = (ty < 2) ? xWGU8 + (size_t)e * 4096 * D : xWD8 + (size_t)e * D * DE;
#pragma unroll
    for (int i = 0; i < 8; ++i) { LAS float* d_ = scr + (8 * i + (lane >> 3)) * 33 + 4 * (lane & 7); d_[0] = t[i].x; d_[1] = t[i].y; d_[2] = t[i].z; d_[3] = t[i].w; }
    LDS_WAIT(); asm volatile("" ::: "memory");
    const int c = lane & 3;
#pragma unroll
    for (int j = 0; j < 2; ++j) { const int n = (lane >> 2) + 16 * j; const LAS float* s = scr + (16 * c) * 33 + n; unsigned o[4];
#pragma unroll
        for (int q = 0; q < 4; ++q) { unsigned w = 0u; w = __builtin_amdgcn_cvt_pk_fp8_f32(s[(4 * q) * 33] * 128.f, s[(4 * q + 1) * 33] * 128.f, w, false); w = __builtin_amdgcn_cvt_pk_fp8_f32(s[(4 * q + 2) * 33] * 128.f, s[(4 * q + 3) * 33] * 128.f, w, true); o[q] = w; }
        const int ns = n0 + n; const int row = (ty == 2) ? ns : 256 * (ns >> 7) + (ty == 1 ? 128 : 0) + (ns & 127);
        v4u ov; ov.x = o[0]; ov.y = o[1]; ov.z = o[2]; ov.w = o[3];
        *(GAS v4u*)(WT + (size_t)row * K + k0 + 16 * c) = ov; }
    LDS_WAIT(); asm volatile("" ::: "memory");
}
__device__ __forceinline__ void expert_range(EXPW_PARAMS, int first, int end, int stride, int lane, LAS float* scr) {
    if (first >= end) return;
    f32x4 t[8]; exp_load(EXPW_ARGS, first, lane, t);
    for (int r = first; r < end; r += stride) { f32x4 tn[8]; const int rn = r + stride; const bool more = rn < end;
        if (more) exp_load(EXPW_ARGS, rn, lane, tn);
        exp_finish(EXPW_ARGS, r, lane, t, scr);
        if (more) {
#pragma unroll
            for (int i = 0; i < 8; ++i) t[i] = tn[i]; } }
}
__device__ __forceinline__ void wf_item(const float* wf, bf16* WF_T, int item, int lane) {
    const int c = item >> 2, dblk = item & 3, g = c >> 7, j = c & 127, d0 = 256 * dblk + 4 * lane;
    f32x4 ac = {0.f, 0.f, 0.f, 0.f}, as = {0.f, 0.f, 0.f, 0.f};
    for (int m = 0; m < 128; ++m) { const f32x4 wv = *(const GAS f32x4*)(wf + (size_t)(g * 128 + m) * D + d0); const float fr = (float)((m * j) & 127) * (1.0f / 128.0f);
        const float cv = __builtin_amdgcn_cosf(fr), sv = __builtin_amdgcn_sinf(fr); ac += cv * wv; as += sv * wv; }
    const int kv = 8 * (c >> 2) + 2 * (c & 3);
#pragma unroll
    for (int i = 0; i < 4; ++i) *(GAS unsigned*)(WF_T + (size_t)(d0 + i) * D + kv) = pk2(ac[i] * (1.0f / 1024.0f), as[i] * (1.0f / 1024.0f));
}
__device__ __forceinline__ void fc_tables(bf16* Fc1, bf16* Fc2, int gtid, int gthreads) {
    for (int e = gtid; e < 8192 + 65536; e += gthreads) {
        if (e < 8192) { const int j = e & 7, ln = (e >> 3) & 63, kk = (e >> 9) & 1, mt = (e >> 10) & 3, hh = e >> 12, rho = ln & 15;
            const int s1 = 32 * kk + 8 * (ln >> 4) + j, k1 = 32 * hh + 16 * (mt & 1) + 4 * (rho & 3) + (rho >> 2);
            const float fr = (float)((k1 * s1) & 63) * (1.0f / 64.0f); Fc1[e] = (bf16)f2bf((mt >> 1) == 0 ? cospif(2.0f * fr) : -sinpif(2.0f * fr)); }
        else { const int q = e - 8192, j = q & 7, ln = (q >> 3) & 63, kk = (q >> 9) & 7, ro = (q >> 12) & 1, w = q >> 13;
            const int k2 = 16 * w + (ln & 15), kap = 32 * kk + 8 * (ln >> 4) + j, s2 = kap >> 1, ri = kap & 1;
            const float fr = (float)((k2 * s2) & 127) * (1.0f / 128.0f), cv = cospif(2.0f * fr), sv = sinpif(2.0f * fr);
            Fc2[q] = (bf16)f2bf(ro == 0 ? (ri == 0 ? cv : sv) : (ri == 0 ? -sv : cv)); }
    }
}
__device__ __forceinline__ void mod_item(const float* c, const float* w_ada, float* modp, LAS unsigned char* lds, int item, int tid, int wave, int lane) {
    const int cb = item % 24, kq = item / 24, col0 = 256 * cb + 4 * lane;
    f32x4 a0 = {0.f, 0.f, 0.f, 0.f}, a1 = {0.f, 0.f, 0.f, 0.f};
#pragma unroll
    for (int i0 = 0; i0 < 32; i0 += 16) { f32x4 wv[16];
#pragma unroll
        for (int i = 0; i < 16; ++i) wv[i] = __builtin_nontemporal_load((const GAS f32x4*)(w_ada + (size_t)(256 * kq + 32 * wave + i0 + i) * 6 * D + col0));
#pragma unroll
        for (int i = 0; i < 16; ++i) { const int d = 256 * kq + 32 * wave + i0 + i; a0 += silu(c[d]) * wv[i]; a1 += silu(c[D + d]) * wv[i]; } }
    LAS f32x4* red = (LAS f32x4*)lds;
    red[(wave * 2 + 0) * 64 + lane] = a0; red[(wave * 2 + 1) * 64 + lane] = a1;
    __syncthreads();
    { const int b = tid >> 8, cc = tid & 255; const LAS float* rf = (const LAS float*)lds; float s = 0.f;
#pragma unroll
      for (int w = 0; w < 8; ++w) s += rf[((w * 2 + b) * 64) * 4 + cc];
      modp[(size_t)(kq * 2 + b) * 6 * D + 256 * cb + cc] = s; }
    asm volatile("s_waitcnt vmcnt(0)" ::: "memory");
    __syncthreads();
}

__device__ __forceinline__ void phase_h(const float* x, const float* g_mix, const float* b_ada, const float* modp, float* mod, bf16* H1, LAS unsigned char* lds, int tid, int wave, int lane, int vcu, int G) {
    LAS float* ga = (LAS float*)lds;
    LAS float* sh = ga + 2 * D;
    { float v[8];
#pragma unroll
      for (int k = 0; k < 8; ++k) { const int i = tid + 512 * k, j = i & 2047; v[k] = b_ada[j]; }
#pragma unroll
      for (int q = 0; q < 4; ++q)
#pragma unroll
          for (int k = 0; k < 8; ++k) { const int i = tid + 512 * k, b = i >> 11, j = i & 2047; v[k] += modp[(size_t)(q * 2 + b) * 6 * D + j]; }
#pragma unroll
      for (int k = 0; k < 8; ++k) { const int i = tid + 512 * k, b = i >> 11, j = i & 2047; if (j < D) sh[b * D + j] = v[k]; else ga[b * D + j - D] = g_mix[j - D] * (1.f + v[k]); } }
    { const int i = vcu * NWAVES * 64 + tid;
      if (i < 2 * 6 * D) { const int b = i / (6 * D), j = i % (6 * D); float v = b_ada[j];
#pragma unroll
          for (int q = 0; q < 4; ++q) v += modp[(size_t)(q * 2 + b) * 6 * D + j];
          mod[i] = v; } }
    __syncthreads();
    const int gw = vcu * NWAVES + wave, NGW = G * NWAVES;
    for (int m0 = gw * 4; m0 < M; m0 += NGW * 4) { const int b = m0 >> 13;
        f32x4 v[4][4]; float s[4];
#pragma unroll
        for (int r = 0; r < 4; ++r) { const GAS f32x4* xr = (const GAS f32x4*)(x + (size_t)(m0 + r) * D) + lane;
#pragma unroll
            for (int j = 0; j < 4; ++j) v[r][j] = __builtin_nontemporal_load(xr + 64 * j); }
#pragma unroll
        for (int r = 0; r < 4; ++r) { s[r] = 0.f;
#pragma unroll
            for (int j = 0; j < 4; ++j) s[r] += (v[r][j].x * v[r][j].x + v[r][j].y * v[r][j].y) + (v[r][j].z * v[r][j].z + v[r][j].w * v[r][j].w); }
#pragma unroll
        for (int o = 1; o < 64; o <<= 1) {
#pragma unroll
            for (int r = 0; r < 4; ++r) s[r] += __shfl_xor(s[r], o); }
#pragma unroll
        for (int r = 0; r < 4; ++r) { const float rr = rsqrtf(s[r] * (1.f / D) + RMS_EPS); GAS v2u* o8 = (GAS v2u*)(H1 + (size_t)(m0 + r) * D) + lane;
#pragma unroll
            for (int j = 0; j < 4; ++j) { const f32x4 gg = *(const LAS f32x4*)(ga + b * D + 4 * lane + 256 * j), ss = *(const LAS f32x4*)(sh + b * D + 4 * lane + 256 * j); const f32x4 y = v[r][j] * rr * gg + ss;
                v2u w; w.x = cvt_pk_bf16(y.x, y.y); w.y = cvt_pk_bf16(y.z, y.w); o8[64 * j] = w; } } }
    __syncthreads();
}
__device__ __forceinline__ void phase_conv(const bf16* CV, const bf16* BG, const float* w_conv, bf16* AB, int wave, int lane, int vcu, int G) {
    const int gw = vcu * NWAVES + wave, NGW = G * NWAVES;
    for (int o = gw; o < M / 8; o += NGW) { const int r0 = 8 * o, s0 = r0 & (SEQ - 1);
#pragma unroll
        for (int hseg = 0; hseg < 2; ++hseg) { const int ch = hseg * 512 + 8 * lane; const size_t off = (size_t)r0 * D + ch;
            v4u cv[10], bg[8];
#pragma unroll
            for (int jj = 0; jj < 10; ++jj) { const bool ok = (jj == 0) ? (s0 > 0) : (jj == 9) ? (s0 + 8 < SEQ) : true; cv[jj] = (v4u){0u, 0u, 0u, 0u}; if (ok) cv[jj] = __builtin_nontemporal_load((const GAS v4u*)(CV + off + (size_t)(jj - 1) * D)); }
#pragma unroll
            for (int jj = 0; jj < 8; ++jj) bg[jj] = __builtin_nontemporal_load((const GAS v4u*)(BG + off + (size_t)jj * D));
            float w0[8], w1[8], w2[8];
#pragma unroll
            for (int q = 0; q < 2; ++q) { const f32x4 a = *(const GAS f32x4*)(w_conv + ch + 4 * q), b = *(const GAS f32x4*)(w_conv + D + ch + 4 * q), c2 = *(const GAS f32x4*)(w_conv + 2 * D + ch + 4 * q);
#pragma unroll
                for (int i2 = 0; i2 < 4; ++i2) { w0[4 * q + i2] = a[i2]; w1[4 * q + i2] = b[i2]; w2[4 * q + i2] = c2[i2]; } }
#pragma unroll
            for (int jj = 0; jj < 8; ++jj) { unsigned ow[4];
#pragma unroll
                for (int q = 0; q < 4; ++q) {
                    const float lo = bf_lo(bg[jj][q]) * (w0[2 * q] * bf_lo(cv[jj][q]) + w1[2 * q] * bf_lo(cv[jj + 1][q]) + w2[2 * q] * bf_lo(cv[jj + 2][q]));
                    const float hi = bf_hi(bg[jj][q]) * (w0[2 * q + 1] * bf_hi(cv[jj][q]) + w1[2 * q + 1] * bf_hi(cv[jj + 1][q]) + w2[2 * q + 1] * bf_hi(cv[jj + 2][q]));
                    ow[q] = cvt_pk_bf16(lo, hi); }
                v4u ov; ov.x = ow[0]; ov.y = ow[1]; ov.z = ow[2]; ov.w = ow[3];
                *(GAS v4u*)(AB + off + (size_t)jj * D) = ov; } } }
}
__device__ __forceinline__ void phase_h2(const bf16* X1B, const float* g_moe, const float* mod, const float* w_router, const float* b_router, bf16* H2, unsigned char* H2F8, float* probs,
                                         LAS unsigned char* lds, int tid, int wave, int lane, int vcu, int G) {
    LAS bf16* whi = (LAS bf16*)lds;
    LAS bf16* wlo = whi + 16384;
    LAS float* ga = (LAS float*)(lds + 65536);
    LAS float* sh = ga + 2 * D;
    for (int i = tid; i < 16384; i += NWAVES * 64) { const int j = i & 7, ln = (i >> 3) & 63, kk = i >> 9, k = 32 * kk + 8 * (ln >> 4) + j, e = ln & 15;
        const float w = w_router[k * NE + e]; const unsigned h = f2bf(w); const float wh = __uint_as_float(h << 16); whi[i] = (bf16)h; wlo[i] = (bf16)f2bf(w - wh); }
    { float a[4], b2[4], c2[4];
#pragma unroll
      for (int k = 0; k < 4; ++k) { const int i = tid + 512 * k, b = i >> 10, j = i & 1023; a[k] = mod[b * 6 * D + 3 * D + j]; b2[k] = mod[b * 6 * D + 4 * D + j]; c2[k] = g_moe[j]; }
#pragma unroll
      for (int k = 0; k < 4; ++k) { const int i = tid + 512 * k; sh[i] = a[k]; ga[i] = c2[k] * (1.f + b2[k]); } }
    __syncthreads();
    const int n = lane & 15, kq = lane >> 4;
    float br[4];
#pragma unroll
    for (int r = 0; r < 4; ++r) br[r] = b_router[4 * kq + r];
    for (int grp = wave * G + vcu; grp < M / 16; grp += NWAVES * G) { const int m0 = 16 * grp, b = m0 >> 13;
        const GAS v4u* xr = (const GAS v4u*)(X1B + (size_t)(m0 + n) * D + 8 * kq);
        v4u xf[32]; float ssq = 0.f;
#pragma unroll
        for (int kk = 0; kk < 32; ++kk) xf[kk] = __builtin_nontemporal_load(xr + 4 * kk);
#pragma unroll
        for (int kk = 0; kk < 32; ++kk) { const v4u w = xf[kk]; const float e0 = bf_lo(w.x), e1 = bf_hi(w.x), e2 = bf_lo(w.y), e3 = bf_hi(w.y), e4 = bf_lo(w.z), e5 = bf_hi(w.z), e6 = bf_lo(w.w), e7 = bf_hi(w.w);
            ssq += (e0 * e0 + e1 * e1) + (e2 * e2 + e3 * e3) + (e4 * e4 + e5 * e5) + (e6 * e6 + e7 * e7); }
#pragma unroll
        for (int kk = 0; kk < 32; ++kk) asm volatile("" : "+v"(xf[kk].x), "+v"(xf[kk].y), "+v"(xf[kk].z), "+v"(xf[kk].w));
        ssq += __shfl_xor(ssq, 16); ssq += __shfl_xor(ssq, 32);
        const float rstd = rsqrtf(ssq * (1.f / D) + RMS_EPS);
        f32x4 acc = {0.f, 0.f, 0.f, 0.f};
        GAS v4u* ho = (GAS v4u*)(H2 + (size_t)(m0 + n) * D + 8 * kq);
#pragma unroll
        for (int kk = 0; kk < 32; ++kk) { const v4u w = xf[kk]; const int col = 32 * kk + 8 * kq;
            const f32x4 g0 = *(const LAS f32x4*)(ga + b * D + col), g1 = *(const LAS f32x4*)(ga + b * D + col + 4), s0 = *(const LAS f32x4*)(sh + b * D + col), s1 = *(const LAS f32x4*)(sh + b * D + col + 4);
            float h[8] = {bf_lo(w.x) * rstd * g0.x + s0.x, bf_hi(w.x) * rstd * g0.y + s0.y, bf_lo(w.y) * rstd * g0.z + s0.z, bf_hi(w.y) * rstd * g0.w + s0.w,
                          bf_lo(w.z) * rstd * g1.x + s1.x, bf_hi(w.z) * rstd * g1.y + s1.y, bf_lo(w.w) * rstd * g1.z + s1.z, bf_hi(w.w) * rstd * g1.w + s1.w};
            v4u hh, hl;
            hh.x = cvt_pk_bf16(h[0], h[1]); hh.y = cvt_pk_bf16(h[2], h[3]); hh.z = cvt_pk_bf16(h[4], h[5]); hh.w = cvt_pk_bf16(h[6], h[7]);
            hl.x = cvt_pk_bf16(h[0] - bf_lo(hh.x), h[1] - bf_hi(hh.x)); hl.y = cvt_pk_bf16(h[2] - bf_lo(hh.y), h[3] - bf_hi(hh.y)); hl.z = cvt_pk_bf16(h[4] - bf_lo(hh.z), h[5] - bf_hi(hh.z)); hl.w = cvt_pk_bf16(h[6] - bf_lo(hh.w), h[7] - bf_hi(hh.w));
            if (MOE_FP8) { v2u q8; q8.x = pk4_fp8(h[0], h[1], h[2], h[3]); q8.y = pk4_fp8(h[4], h[5], h[6], h[7]); *(GAS v2u*)(H2F8 + (size_t)(m0 + n) * D + 32 * kk + 8 * kq) = q8; }
            else ho[4 * kk] = hh;
            const bf16x8 ah = *(const LAS bf16x8*)(whi + (kk * 64 + lane) * 8), al = *(const LAS bf16x8*)(wlo + (kk * 64 + lane) * 8);
            const bf16x8 bh = __builtin_bit_cast(bf16x8, hh), bl = __builtin_bit_cast(bf16x8, hl);
            acc = __builtin_amdgcn_mfma_f32_16x16x32_bf16(ah, bh, acc, 0, 0, 0); acc = __builtin_amdgcn_mfma_f32_16x16x32_bf16(al, bh, acc, 0, 0, 0); acc = __builtin_amdgcn_mfma_f32_16x16x32_bf16(ah, bl, acc, 0, 0, 0);
            asm volatile("" ::: "memory"); }
        float lg[4], mx = -3.0e38f;
#pragma unroll
        for (int r = 0; r < 4; ++r) { lg[r] = acc[r] + br[r]; mx = fmaxf(mx, lg[r]); }
        mx = fmaxf(mx, __shfl_xor(mx, 16)); mx = fmaxf(mx, __shfl_xor(mx, 32));
        float sum = 0.f;
#pragma unroll
        for (int r = 0; r < 4; ++r) { lg[r] = __expf(lg[r] - mx); sum += lg[r]; }
        sum += __shfl_xor(sum, 16); sum += __shfl_xor(sum, 32);
        const float inv = 1.0f / sum; const int s = (m0 + n) & (SEQ - 1);
#pragma unroll
        for (int r = 0; r < 4; ++r) probs[((size_t)(b * NE + 4 * kq + r)) * SEQ + s] = lg[r] * inv; }
}
__device__ __forceinline__ void topk_item(const float* probs, int* idx, float* val, int* slot, LAS unsigned char* lds, int item, int tid, int wave, int lane) {
    const int e = item >> 1, b = item & 1;
    LAS int* red = (LAS int*)lds;
    unsigned p[16];
#pragma unroll
    for (int q = 0; q < 4; ++q) { const v4u w = __builtin_nontemporal_load((const GAS v4u*)(probs + ((size_t)(b * NE + e)) * SEQ + 16 * tid + 4 * q)); p[4 * q] = w.x; p[4 * q + 1] = w.y; p[4 * q + 2] = w.z; p[4 * q + 3] = w.w; }
    unsigned prefix = 0u;
    for (int bit = 30; bit >= 0; --bit) { const unsigned cand = prefix | (1u << bit); int cnt = 0;
#pragma unroll
        for (int j = 0; j < 16; ++j) cnt += __popcll(__ballot(p[j] >= cand));
        const int par = bit & 1;
        if (lane == 0) red[par * 8 + wave] = cnt;
        __syncthreads();
        int tot = 0;
#pragma unroll
        for (int w = 0; w < 8; ++w) tot += red[par * 8 + w];
        if (tot >= CAP) prefix = cand; }
    const unsigned T = prefix;
    int cgt = 0, ceq = 0;
#pragma unroll
    for (int j = 0; j < 16; ++j) { cgt += (p[j] > T) ? 1 : 0; ceq += (p[j] == T) ? 1 : 0; }
    int sgt = cgt, seq = ceq;
#pragma unroll
    for (int o = 1; o < 64; o <<= 1) { const int a = __shfl_up(sgt, o), c = __shfl_up(seq, o); if (lane >= o) { sgt += a; seq += c; } }
    __syncthreads();
    if (lane == 63) { red[32 + wave] = sgt; red[48 + wave] = seq; }
    __syncthreads();
    int bgt = 0, beq = 0, totgt = 0;
#pragma unroll
    for (int w = 0; w < 8; ++w) { const int a = red[32 + w], c = red[48 + w]; if (w < wave) { bgt += a; beq += c; } totgt += a; }
    int rgt = bgt + sgt - cgt, req = beq + seq - ceq;
    const int need = CAP - totgt; const int rbase = (e * 2 + b) * CAP;
#pragma unroll
    for (int j = 0; j < 16; ++j) { const int tok = b * SEQ + 16 * tid + j; int sl = -1;
        if (p[j] > T) { sl = rgt; ++rgt; } else if (p[j] == T) { if (req < need) sl = totgt + req; ++req; }
        slot[(size_t)tok * NE + e] = sl;
        if (sl >= 0) { idx[rbase + sl] = tok; val[rbase + sl] = __uint_as_float(p[j]); } }
    __syncthreads();
}
__device__ __forceinline__ void phase_gather(const bf16* H2, const int* idx, bf16* XE, int wave, int lane, int vcu, int G) {
    const int gw = vcu * NWAVES + wave, NGW = G * NWAVES;
    for (int r = gw; r < MR; r += NGW) { const int tok = idx[r];
        const GAS v4u* src = (const GAS v4u*)(H2 + (size_t)tok * D) + lane; GAS v4u* dst = (GAS v4u*)(XE + (size_t)r * D) + lane;
        const v4u a = src[0], b2 = src[64]; dst[0] = a; dst[64] = b2; }
}
__device__ __forceinline__ void phase_final(float* out, const bf16* X1B, const bf16* Y, const int* slot, const float* mod, const float* g_fin, int wave, int lane, int vcu, int G, float pert) {
    const int gw = vcu * NWAVES + wave, NGW = G * NWAVES;
    int slv[2]; v2u xw[2][4];
#define PF_FETCH(mm) do { _Pragma("unroll") for (int r = 0; r < 2; ++r) { slv[r] = slot[(size_t)((mm) + r) * NE + (lane & 15)]; const GAS v2u* xr_ = (const GAS v2u*)(X1B + (size_t)((mm) + r) * D) + lane; \
        _Pragma("unroll") for (int j = 0; j < 4; ++j) xw[r][j] = __builtin_nontemporal_load(xr_ + 64 * j); } } while (0)
    int m0 = gw * 2;
    if (m0 < M) PF_FETCH(m0);
    for (; m0 < M; m0 += NGW * 2) { const int b = m0 >> 13;
        int cs[2]; f32x4 v[2][4], a[2][4];
#pragma unroll
        for (int r = 0; r < 2; ++r) { cs[r] = slv[r];
#pragma unroll
            for (int j = 0; j < 4; ++j) { const v2u w = xw[r][j]; v[r][j] = (f32x4){bf_lo(w.x), bf_hi(w.x), bf_lo(w.y), bf_hi(w.y)}; a[r][j] = (f32x4){0.f, 0.f, 0.f, 0.f}; } }
        const int mn = m0 + NGW * 2;
        if (mn < M) PF_FETCH(mn);
        unsigned long long mask[2]; bool more = false;
#pragma unroll
        for (int r = 0; r < 2; ++r) mask[r] = __ballot(cs[r] >= 0) & 0xFFFFull;
        do { const GAS v2u* yp[2][4]; bool ok[2][4]; v2u w[2][4][4];
#pragma unroll
            for (int r = 0; r < 2; ++r)
#pragma unroll
                for (int c = 0; c < 4; ++c) { ok[r][c] = (mask[r] != 0ull); const int e = ok[r][c] ? (int)__builtin_ctzll(mask[r]) : 0; mask[r] &= (mask[r] - 1ull);
                    const int sl = __builtin_amdgcn_readlane(cs[r], e); yp[r][c] = (const GAS v2u*)(Y + ((size_t)(e * 2 + b) * CAP + (ok[r][c] ? sl : 0)) * D) + lane; }
#pragma unroll
            for (int r = 0; r < 2; ++r)
#pragma unroll
                for (int c = 0; c < 4; ++c) if (ok[r][c]) {
#pragma unroll
                    for (int j = 0; j < 4; ++j) w[r][c][j] = __builtin_nontemporal_load(yp[r][c] + 64 * j); }
#pragma unroll
            for (int r = 0; r < 2; ++r)
#pragma unroll
                for (int c = 0; c < 4; ++c) if (ok[r][c]) {
#pragma unroll
                    for (int j = 0; j < 4; ++j) { a[r][j].x += bf_lo(w[r][c][j].x); a[r][j].y += bf_hi(w[r][c][j].x); a[r][j].z += bf_lo(w[r][c][j].y); a[r][j].w += bf_hi(w[r][c][j].y); } }
            more = (mask[0] | mask[1]) != 0ull;
        } while (more);
        float s[2];
#pragma unroll
        for (int r = 0; r < 2; ++r) { s[r] = 0.f;
#pragma unroll
            for (int j = 0; j < 4; ++j) { const f32x4 gf = *(const GAS f32x4*)(mod + b * 6 * D + 5 * D + 4 * lane + 256 * j); v[r][j] = v[r][j] + gf * a[r][j]; s[r] += (v[r][j].x * v[r][j].x + v[r][j].y * v[r][j].y) + (v[r][j].z * v[r][j].z + v[r][j].w * v[r][j].w); } }
#pragma unroll
        for (int o = 1; o < 64; o <<= 1) { s[0] += __shfl_xor(s[0], o); s[1] += __shfl_xor(s[1], o); }
#pragma unroll
        for (int r = 0; r < 2; ++r) { const float rr = rsqrtf(s[r] * (1.f / D) + RMS_EPS); GAS f32x4* xo = (GAS f32x4*)(out + (size_t)(m0 + r) * D) + lane;
#pragma unroll
            for (int j = 0; j < 4; ++j) { const f32x4 gg = *(const GAS f32x4*)(g_fin + 4 * lane + 256 * j); __builtin_nontemporal_store(v[r][j] * rr * gg + pert, xo + 64 * j); } } }
#undef PF_FETCH
}
__device__ __forceinline__ void fft_item(LAS unsigned char* lds, const bf16* UF, bf16* ZF, const bf16* Fc1, const bf16* Fc2, int item, int wave, int lane, unsigned long long* ts) {
#define FFT_STAMP(i_) do { if (ts && blockIdx.x == 0 && threadIdx.x == 0) ts[34 + (i_)] = __builtin_amdgcn_s_memrealtime(); } while (0)
    FFT_STAMP(0);
    const char* slab = (const char*)UF + (size_t)item * 65536;
    { v4u xv[8];
#pragma unroll
      for (int p = 0; p < 8; ++p) { const int s1 = 8 * p + wave; xv[p] = __builtin_nontemporal_load((const GAS v4u*)(slab + s1 * 1024 + ((16 * lane - 32 * ((s1 >> 3) & 3)) & 1023))); }
#pragma unroll
      for (int p = 0; p < 8; ++p) *(LAS v4u*)(lds + (8 * p + wave) * 1024 + 16 * lane) = xv[p]; }
    bf16x8 A2[2][8];
#pragma unroll
    for (int ro = 0; ro < 2; ++ro)
#pragma unroll
        for (int kk = 0; kk < 8; ++kk) A2[ro][kk] = *(const GAS bf16x8*)(Fc2 + ((size_t)(((wave * 2 + ro) * 8 + kk) * 64 + lane)) * 8);
    LDS_WAIT(); __syncthreads(); FFT_STAMP(1);
    const int fr = lane & 15, fq = lane >> 4, ch = lane & 3, s2l = (lane & 15) >> 2;
    char* zb = (char*)ZF + (size_t)item * 131072;
    for (int hh = 0; hh < 2; ++hh) {
        { bf16x8 A1[4][2];
#pragma unroll
          for (int mt = 0; mt < 4; ++mt)
#pragma unroll
              for (int kk = 0; kk < 2; ++kk) A1[mt][kk] = *(const GAS bf16x8*)(Fc1 + ((size_t)(((hh * 4 + mt) * 2 + kk) * 64 + lane)) * 8);
          for (int jn = 0; jn < 4; ++jn) { const int nt = wave + 8 * jn, s2 = 4 * nt + s2l;
            bf16x8 Bx[2];
#pragma unroll
            for (int kk = 0; kk < 2; ++kk)
#pragma unroll
                for (int j = 0; j < 8; ++j) { const int s1 = 32 * kk + 8 * fq + j; Bx[kk][j] = *(const LAS short*)(lds + s1 * 1024 + ((s2 * 8 + ch * 2 + 32 * fq) & 1023)); }
            f32x4 acc[4];
#pragma unroll
            for (int mt = 0; mt < 4; ++mt) { acc[mt] = (f32x4){0.f, 0.f, 0.f, 0.f};
#pragma unroll
                for (int kk = 0; kk < 2; ++kk) acc[mt] = __builtin_amdgcn_mfma_f32_16x16x32_bf16(A1[mt][kk], Bx[kk], acc[mt], 0, 0, 0); }
#pragma unroll
            for (int blk = 0; blk < 2; ++blk)
#pragma unroll
                for (int r = 0; r < 4; ++r) { const int k1l = 16 * blk + 4 * r + fq, k1 = 32 * hh + k1l; const float dr = acc[blk][r], di = acc[2 + blk][r];
                    const float frac = (float)((s2 * k1) & 8191) * (1.0f / 8192.0f), c = __builtin_amdgcn_cosf(frac), s = __builtin_amdgcn_sinf(frac);
                    *(LAS unsigned*)(lds + FFT_TOFF + (k1l * 4 + ch) * FFT_TPITCH + s2 * 4) = cvt_pk_bf16(dr * c + di * s, di * c - dr * s); } } }
        LDS_WAIT(); __syncthreads(); if (hh == 0) FFT_STAMP(2);
        for (int nt2 = 0; nt2 < 8; ++nt2) { f32x4 c0 = {0.f, 0.f, 0.f, 0.f}, c1 = {0.f, 0.f, 0.f, 0.f};
#pragma unroll
            for (int kk = 0; kk < 8; ++kk) { const bf16x8 Bt = *(const LAS bf16x8*)(lds + FFT_TOFF + (16 * nt2 + fr) * FFT_TPITCH + kk * 64 + fq * 16);
                c0 = __builtin_amdgcn_mfma_f32_16x16x32_bf16(A2[0][kk], Bt, c0, 0, 0, 0); c1 = __builtin_amdgcn_mfma_f32_16x16x32_bf16(A2[1][kk], Bt, c1, 0, 0, 0); }
            const int k1 = 32 * hh + 4 * nt2 + s2l;
#pragma unroll
            for (int r = 0; r < 4; ++r) { const int k = k1 + 64 * (16 * wave + 4 * fq + r); *(GAS unsigned*)(zb + (size_t)k * 16 + ch * 4) = cvt_pk_bf16(c0[r], c1[r]); } }
        LDS_WAIT(); __syncthreads(); if (hh == 0) FFT_STAMP(3);
    }
    FFT_STAMP(4);
#undef FFT_STAMP
}
#if MOE_FP8
#define EXPERT_ITEM(r_) do { const int e_ = (r_) / 3072, q_ = (r_) % 3072; \
    if (q_ < 1024) transpose_item8<2>(w_g + (size_t)e_ * D * DE, D, DE, WGU8 + (size_t)e_ * 4096 * D, scr, q_, lane); \
    else if (q_ < 2048) transpose_item8<3>(w_u + (size_t)e_ * D * DE, D, DE, WGU8 + (size_t)e_ * 4096 * D, scr, q_ - 1024, lane); \
    else transpose_item8<0>(w_d + (size_t)e_ * DE * D, DE, D, WD8 + (size_t)e_ * D * DE, scr, q_ - 2048, lane); } while (0)
#else
#define EXPERT_ITEM(r_) do { const int e_ = (r_) / 3072, q_ = (r_) % 3072; \
    if (q_ < 1024) transpose_item<2>(w_g + (size_t)e_ * D * DE, D, DE, WGU + (size_t)e_ * 4096 * D, scr, q_, lane); \
    else if (q_ < 2048) transpose_item<3>(w_u + (size_t)e_ * D * DE, D, DE, WGU + (size_t)e_ * 4096 * D, scr, q_ - 1024, lane); \
    else transpose_item<0>(w_d + (size_t)e_ * DE * D, DE, D, WD + (size_t)e_ * D * DE, scr, q_ - 2048, lane); } while (0)
#endif
#ifndef EXP_P2
#define EXP_P2 10240
#endif
#ifndef EXP_P7
#define EXP_P7 14336
#endif
#ifndef EXP_P6
#define EXP_P6 16384
#endif
constexpr int EXP_TOTAL = NE * 3072, EXP_P0 = EXP_TOTAL - EXP_P2 - EXP_P7 - EXP_P6;

constexpr int NPHASE = 12;
#ifndef P2_GEMM_CUS
#define P2_GEMM_CUS 235
#endif
constexpr int CW_MODCNT = 2048;
#ifndef P4_FUSED
#define P4_FUSED 0
#endif
#ifndef MOE_ALIGN
#define MOE_ALIGN true
#endif
#ifndef EXTRA_BARS
#define EXTRA_BARS 0
#endif
#ifndef STAGGER_US
#define STAGGER_US 0
#endif
#ifndef DOUBLE_PH
#define DOUBLE_PH -1
#endif
#define REP(k) for (int rep_ = 0; rep_ < ((DOUBLE_PH == (k)) ? 2 : 1); ++rep_)
#define REPBAR(k) do { if (DOUBLE_PH == (k) && rep_ == 0) xcd_barrier(bar); } while (0)
#ifndef PROBE_I
#define PROBE_I -1
#endif
#ifndef PROBE_J
#define PROBE_J -1
#endif
#ifndef DBG_PLAIN
#define DBG_PLAIN 0
#endif
#ifndef GALIGN
#define GALIGN true
#endif
#ifndef GSP2
#define GSP2 true
#endif
struct Args { const float* in[18]; float* out; unsigned char* ws; int ph_lo, ph_hi; };
__global__ void __launch_bounds__(NWAVES * 64, 2) fwd(Args args) {
    extern __shared__ __attribute__((aligned(16))) unsigned char lds_raw[];
    LAS unsigned char* lds = (LAS unsigned char*)lds_raw;
    volatile LAS unsigned* MISC = (volatile LAS unsigned*)(lds + MISC_OFF);
    const int tid = threadIdx.x, lane = tid & 63, wave = __builtin_amdgcn_readfirstlane(tid >> 6);
    const int G = gridDim.x; const int bx = blockIdx.x; const int vcu = (G % 8 == 0) ? (bx % 8) * (G / 8) + bx / 8 : bx;
    unsigned char* ws = args.ws;
    const float *x = args.in[0], *c = args.in[1], *w_ada = args.in[2], *b_ada = args.in[3], *g_mix = args.in[4], *w_in = args.in[5], *b_gate = args.in[6], *w_f = args.in[7], *w_conv = args.in[8],
                *w_co = args.in[9], *w_o = args.in[10], *g_moe = args.in[11], *w_r = args.in[12], *b_r = args.in[13], *w_g = args.in[14], *w_u = args.in[15], *w_d = args.in[16], *g_fin = args.in[17];
    float* out = args.out;
    float *modp = (float*)(ws + WS_MODP), *mod = (float*)(ws + WS_MOD), *probs = (float*)(ws + WS_PROBS), *val = (float*)(ws + WS_VAL);
    int *slot = (int*)(ws + WS_SLOT), *idx = (int*)(ws + WS_IDX);
    bf16 *Fc1 = (bf16*)(ws + WS_FC1), *Fc2 = (bf16*)(ws + WS_FC2), *WIN = (bf16*)(ws + WS_WIN), *WF = (bf16*)(ws + WS_WF), *WCO = (bf16*)(ws + WS_WCO), *WO = (bf16*)(ws + WS_WO), *WGU = (bf16*)(ws + WS_WGU), *WD = (bf16*)(ws + WS_WD);
    bf16 *H1 = (bf16*)(ws + WS_H1), *AB = (bf16*)(ws + WS_AB), *UF = (bf16*)(ws + WS_UF), *CV = (bf16*)(ws + WS_CV), *BG = (bf16*)(ws + WS_BG), *GA = (bf16*)(ws + WS_GA), *GB = (bf16*)(ws + WS_GB), *ZF = (bf16*)(ws + WS_ZF),
         *TZ = (bf16*)(ws + WS_TZ), *H2 = (bf16*)(ws + WS_H2), *HM = (bf16*)(ws + WS_HM), *Y = (bf16*)(ws + WS_Y), *X1B = (bf16*)(ws + WS_X1B);
    unsigned char *WGU8 = ws + WS_WGU, *WD8 = ws + WS_WD, *H2F8 = ws + WS_H2, *HM8 = ws + WS_HM;
    for (int u = tid; u < (LDS_BYTES - MISC_OFF) / 4; u += NWAVES * 64) ((LAS unsigned*)(lds + MISC_OFF))[u] = 0u;
    __syncthreads();
    const int lo = args.ph_lo, hi = args.ph_hi;
    XcdBarrier bar; bar.bar = (unsigned*)(ws + WS_CTL) + CW_BAR; bar.x = 0; bar.st = nullptr;
    if (hi - lo > 1) bar = xcd_barrier_post((unsigned*)(ws + WS_CTL) + CW_BAR, MISC + 8);
#define IN(k) (lo <= (k) && (k) < hi)
#if PROBE_I >= 0
    unsigned long long* tsb = (unsigned long long*)(ws + WS_CTL + 512 * 1024);
    if (bx == 0 && tid == 0) tsb[0] = __builtin_amdgcn_s_memrealtime();
#define GRID_BAR(k) do { if (IN(k) && IN((k) + 1)) xcd_barrier(bar); if (bx == 0 && tid == 0) tsb[(k) + 1] = __builtin_amdgcn_s_memrealtime(); } while (0)
#else
#define GRID_BAR(k) do { if (IN(k) && IN((k) + 1)) xcd_barrier(bar); } while (0)
#endif
    const int gw = vcu * NWAVES + wave, NGW = G * NWAVES;
    LAS float* scr = (LAS float*)(lds + wave * 16384);

    if (IN(0)) REP(0) {
        if (vcu < 96) { mod_item(c, w_ada, modp, lds, vcu, tid, wave, lane);
            if (tid == 0) { __builtin_amdgcn_fence(__ATOMIC_RELEASE, "agent"); asm volatile("s_waitcnt vmcnt(0)" ::: "memory");
                (void)xb_add((unsigned*)(ws + WS_CTL) + CW_MODCNT, 1u); } }
#if PROBE_I >= 0
        if (bx == 0 && tid == 0) tsb[22] = __builtin_amdgcn_s_memrealtime();
#endif
        fc_tables(Fc1, Fc2, vcu * NWAVES * 64 + tid, G * NWAVES * 64);
#if PROBE_I >= 0
        if (bx == 0 && tid == 0) tsb[23] = __builtin_amdgcn_s_memrealtime();
#endif
        constexpr int I_WF = 2048, I_IN = 16 * 176, I_SQ = 16 * 32, I_EX = 3072, NITEMS = I_WF + I_IN + 2 * I_SQ + NE * I_EX;
        if (vcu >= 96) { const int w0 = (vcu - 96) * NWAVES + wave, nw0 = (G - 96) * NWAVES;
            for (int r = w0; r < I_WF; r += nw0) wf_item(w_f, WF, r, lane); }
        for (int it = I_WF + gw; it < I_WF + I_IN + 2 * I_SQ; it += NGW) {
            int r = it - I_WF;
            if (r < I_IN) { transpose_item<1>(w_in, D, DIN, WIN, scr, r, lane); continue; } r -= I_IN;
            if (r < I_SQ) { transpose_item<0>(w_co, D, D, WCO, scr, r, lane); continue; } r -= I_SQ;
            if (r < I_SQ) { transpose_item<0>(w_o, D, D, WO, scr, r, lane); continue; } r -= I_SQ;
            break;
        }
        expert_range(w_g, w_u, w_d, WGU8, WD8, gw, EXP_P0, NGW, lane, scr);
#if PROBE_I >= 0
        asm volatile("s_waitcnt vmcnt(0)" ::: "memory"); __syncthreads(); if (bx == 0 && tid == 0) tsb[24] = __builtin_amdgcn_s_memrealtime();
#endif
        if (tid == 0) { unsigned* cnt = (unsigned*)(ws + WS_CTL) + CW_MODCNT; unsigned sp = 0u;
            while (xb_ld(cnt) < 96u) { __builtin_amdgcn_s_sleep(2); if (++sp > (1u << 22)) break; }
            __builtin_amdgcn_fence(__ATOMIC_ACQUIRE, "agent"); asm volatile("s_waitcnt vmcnt(0)" ::: "memory"); }
        __syncthreads();
        phase_h(x, g_mix, b_ada, modp, mod, H1, lds, tid, wave, lane, vcu, G);
        GRID_BAR(1);
    }
#if EXTRA_BARS > 0
    if (IN(1) && IN(2)) { for (int eb = 0; eb < EXTRA_BARS; ++eb) xcd_barrier(bar); }
#endif
    if (IN(2)) REP(2) {
#if STAGGER_US > 0
        if (bx >= 128) { const unsigned long long t0 = __builtin_amdgcn_s_memrealtime(); while (__builtin_amdgcn_s_memrealtime() - t0 < (unsigned long long)(STAGGER_US * 100)) __builtin_amdgcn_s_sleep(8); }
#endif
#if P2_GEMM_CUS > 0
        if (bx >= P2_GEMM_CUS) {
            const int w2 = (bx - P2_GEMM_CUS) * NWAVES + wave, nw2 = (G - P2_GEMM_CUS) * NWAVES;
            expert_range(w_g, w_u, w_d, WGU8, WD8, EXP_P0 + EXP_P6 + w2, EXP_P0 + EXP_P6 + EXP_P2, nw2, lane, scr); }
        else {
        pg8::Gemm g{H1, WIN, M, DIN, D, 0, 0, nullptr, (unsigned long long*)(ws + WS_CTL + 512 * 1024), nullptr, 0}; pg8::StaticOrder S; S.init(M, DIN, P2_GEMM_CUS, bx);
        EpiInProj E{UF, CV, BG, GA, GB, b_gate};
        pg8::gemm_phase<EpiInProj, pg8::StaticOrder, 0, GALIGN, GSP2>(lds, g, S, E); }
#else
        pg8::Gemm g{H1, WIN, M, DIN, D, 0, 0, nullptr, (unsigned long long*)(ws + WS_CTL + 512 * 1024), nullptr, 0}; pg8::StaticOrder S; S.init(M, DIN, G, bx);
#if DBG_PLAIN
        EpiPlain E{UF, DIN};
        pg8::gemm_phase<EpiPlain, pg8::StaticOrder, 0, GALIGN, GSP2>(lds, g, S, E);
#else
        EpiInProj E{UF, CV, BG, GA, GB, b_gate};
        pg8::gemm_phase<EpiInProj, pg8::StaticOrder, 0, GALIGN, GSP2>(lds, g, S, E);
#endif
        if (bx >= G / 2) { const int w2 = (bx - G / 2) * NWAVES + wave, nw2 = (G - G / 2) * NWAVES;
            expert_range(w_g, w_u, w_d, WGU8, WD8, EXP_P0 + EXP_P6 + w2, EXP_P0 + EXP_P6 + EXP_P2, nw2, lane, scr); }
#endif
        GRID_BAR(2);
    }
    if (IN(3)) REP(3) {
        if (bx & 1) phase_conv(CV, BG, w_conv, AB, wave, lane, vcu, G);
        for (int it = vcu; it < BATCH * 128; it += G) fft_item(lds, UF, ZF, Fc1, Fc2, it, wave, lane, (PROBE_I >= 340 && PROBE_I < 350) ? (unsigned long long*)(ws + WS_CTL + 512 * 1024) : nullptr);
#if PROBE_I >= 0
        __syncthreads(); if (bx == 0 && tid == 0) tsb[20] = __builtin_amdgcn_s_memrealtime();
#endif
        if (!(bx & 1)) phase_conv(CV, BG, w_conv, AB, wave, lane, vcu, G);
#if PROBE_I >= 0
        asm volatile("s_waitcnt vmcnt(0)" ::: "memory"); __syncthreads(); if (bx == 0 && tid == 0) tsb[21] = __builtin_amdgcn_s_memrealtime();
#endif
        GRID_BAR(3);
    }
    if (IN(4)) REP(4) {
#if P4_FUSED
        { pg8::Gemm g{ZF, WF, M, 2 * D, D, 0, 0, nullptr, (unsigned long long*)(ws + WS_CTL + 512 * 1024), AB, 4}; pg8::StaticOrder S; S.init(M, 2 * D, G, bx); EpiGateBoth E{TZ, GA, GB};
          pg8::gemm_phase<EpiGateBoth, pg8::StaticOrder, 3, true, true>(lds, g, S, E); }
#else
        { pg8::Gemm g{ZF, WF, M, D, D, 0, 0, nullptr, (unsigned long long*)(ws + WS_CTL + 512 * 1024), nullptr, 0}; pg8::StaticOrder S; S.init(M, D, G, bx); EpiGateMul<0> E{TZ, GA};
          pg8::gemm_phase<EpiGateMul<0>, pg8::StaticOrder, 1, true, true>(lds, g, S, E); }
        { pg8::Gemm g{AB, WCO, M, D, D, 0, 0, nullptr, (unsigned long long*)(ws + WS_CTL + 512 * 1024), nullptr, 0}; pg8::StaticOrder S; S.init(M, D, G, bx); EpiGateMul<1> E{TZ, GB};
          pg8::gemm_phase<EpiGateMul<1>, pg8::StaticOrder, 0, true, true>(lds, g, S, E); }
#endif
        GRID_BAR(4);
    }
    if (IN(5)) REP(5) {
        pg8::Gemm g{TZ, WO, M, D, D, 0, 0, nullptr, (unsigned long long*)(ws + WS_CTL + 512 * 1024), nullptr, 0}; pg8::StaticOrder S; S.init(M, D, G, bx); EpiResid E{x, X1B, mod + 2 * D};
        pg8::gemm_phase<EpiResid, pg8::StaticOrder, 0, true, true>(lds, g, S, E);
        GRID_BAR(5);
    }
    if (IN(6)) REP(6) { phase_h2(X1B, g_moe, mod, w_r, b_r, H2, H2F8, probs, lds, tid, wave, lane, vcu, G);
        if (wave >= 4) { LAS float* scr6 = (LAS float*)(lds + 81920 + (wave - 4) * 8448);
            const int w6 = vcu * 4 + (wave - 4), nw6 = G * 4; LAS float* scr = scr6;
            expert_range(w_g, w_u, w_d, WGU8, WD8, EXP_P0 + w6, EXP_P0 + EXP_P6, nw6, lane, scr); }
        __syncthreads(); GRID_BAR(6); }
    if (IN(7)) REP(7) { for (int it = vcu; it < NE * BATCH; it += G) topk_item(probs, idx, val, slot, lds, it, tid, wave, lane);
        if (vcu >= NE * BATCH) { const int w7 = (vcu - NE * BATCH) * NWAVES + wave, nw7 = (G - NE * BATCH) * NWAVES;
            expert_range(w_g, w_u, w_d, WGU8, WD8, EXP_P0 + EXP_P6 + EXP_P2 + w7, EXP_TOTAL, nw7, lane, scr); }
        GRID_BAR(7); }
    if (IN(9)) REP(9) {
#if MOE_FP8
        pg8::Gemm g{(const bf16*)H2F8, (const bf16*)WGU8, MR, 2 * DE, D / 2, 8, (size_t)2 * DE * D / 2, idx, (unsigned long long*)(ws + WS_CTL + 512 * 1024), nullptr, 0}; pg8::StaticOrder S; S.init(MR, 2 * DE, G, bx); EpiSwiGLU8 E{HM8};
        pg8::gemm_phase<EpiSwiGLU8, pg8::StaticOrder, 2, MOE_ALIGN, true, true>(lds, g, S, E);
#else
        pg8::Gemm g{H2, WGU, MR, 2 * DE, D, 8, (size_t)2 * DE * D, idx, (unsigned long long*)(ws + WS_CTL + 512 * 1024), nullptr, 0}; pg8::StaticOrder S; S.init(MR, 2 * DE, G, bx); EpiSwiGLU E{HM};
        pg8::gemm_phase<EpiSwiGLU, pg8::StaticOrder, 2, true, true>(lds, g, S, E);
#endif
        GRID_BAR(9);
    }
    if (IN(10)) REP(10) {
#if MOE_FP8
        pg8::Gemm g{(const bf16*)HM8, (const bf16*)WD8, MR, D, DE / 2, 8, (size_t)D * DE / 2, nullptr, (unsigned long long*)(ws + WS_CTL + 512 * 1024), nullptr, 0}; pg8::StaticOrder S; S.init(MR, D, G, bx); EpiRowScale E{Y, val};
        pg8::gemm_phase<EpiRowScale, pg8::StaticOrder, 0, MOE_ALIGN, true, true>(lds, g, S, E);
#else
        pg8::Gemm g{HM, WD, MR, D, DE, 8, (size_t)D * DE, nullptr, (unsigned long long*)(ws + WS_CTL + 512 * 1024), nullptr, 0}; pg8::StaticOrder S; S.init(MR, D, G, bx); EpiRowScale E{Y, val};
        pg8::gemm_phase<EpiRowScale, pg8::StaticOrder, 0, true, true>(lds, g, S, E);
#endif
#if PROBE_I >= 0
        if (bx == 0 && tid == 0) tsb[12] = __builtin_amdgcn_s_memrealtime();
#endif
        GRID_BAR(10);
    }
#if PROBE_I >= 0
    float pert = 0.f;
    if (IN(11)) { const unsigned long long a0 = __hip_atomic_load(tsb + (PROBE_I == 100 ? 0 : PROBE_I == 9 ? 8 : PROBE_I), __ATOMIC_RELAXED, __HIP_MEMORY_SCOPE_AGENT), a1 = __hip_atomic_load(tsb + (PROBE_I == 100 ? 12 : PROBE_I == 10 ? 12 : PROBE_I + 1), __ATOMIC_RELAXED, __HIP_MEMORY_SCOPE_AGENT); pert = (float)(a1 - a0) * 0.01f * (PROBE_I == 100 ? (1.0f / 64000.0f) : (1.0f / 16000.0f)); }
    if (PROBE_I == 102) { pert = 0.f; if (bx == 0 && tid == 0) tsb[14] = __builtin_amdgcn_s_memrealtime(); __syncthreads(); }
    if (PROBE_I >= 340 && PROBE_I < 344) { pert = 0.f; if (bx == 0) { const int q_ = PROBE_I - 340; const unsigned long long a0 = __hip_atomic_load(tsb + 34 + q_, __ATOMIC_RELAXED, __HIP_MEMORY_SCOPE_AGENT), a1 = __hip_atomic_load(tsb + 35 + q_, __ATOMIC_RELAXED, __HIP_MEMORY_SCOPE_AGENT); pert = (float)(a1 - a0) * 0.01f * (1.0f / 250.0f); } }
    else if ((PROBE_I >= 320 && PROBE_I < 323) || (PROBE_I >= 330 && PROBE_I < 333)) { pert = 0.f; if (bx == 0) { const int q_ = PROBE_I % 10; const unsigned long long a0 = __hip_atomic_load(tsb + 30 + q_, __ATOMIC_RELAXED, __HIP_MEMORY_SCOPE_AGENT), a1 = __hip_atomic_load(tsb + 31 + q_, __ATOMIC_RELAXED, __HIP_MEMORY_SCOPE_AGENT); pert = (float)(a1 - a0) * 0.01f * (1.0f / 250.0f); } }
    else if (PROBE_I >= 310 && PROBE_I <= 313) { pert = 0.f; if (bx == 0) { const int ia = (PROBE_I == 310 ? 0 : PROBE_I == 311 ? 22 : PROBE_I == 312 ? 23 : 24), ib = (PROBE_I == 310 ? 22 : PROBE_I == 311 ? 23 : PROBE_I == 312 ? 24 : 1);
        const unsigned long long a0 = __hip_atomic_load(tsb + ia, __ATOMIC_RELAXED, __HIP_MEMORY_SCOPE_AGENT), a1 = __hip_atomic_load(tsb + ib, __ATOMIC_RELAXED, __HIP_MEMORY_SCOPE_AGENT); pert = (float)(a1 - a0) * 0.01f * (1.0f / 250.0f); } }
    else if (PROBE_I == 300 || PROBE_I == 301 || PROBE_I == 302) { pert = 0.f; if (bx == 0) { const unsigned long long a0 = __hip_atomic_load(tsb + (PROBE_I == 300 ? 3 : PROBE_I == 301 ? 20 : 21), __ATOMIC_RELAXED, __HIP_MEMORY_SCOPE_AGENT), a1 = __hip_atomic_load(tsb + (PROBE_I == 300 ? 20 : PROBE_I == 301 ? 21 : 4), __ATOMIC_RELAXED, __HIP_MEMORY_SCOPE_AGENT); pert = (float)(a1 - a0) * 0.01f * (1.0f / 250.0f); } }
    else if (PROBE_I >= 200) { pert = 0.f; if (bx == 0) { const int k_ = PROBE_I - 200; const unsigned long long a0 = __hip_atomic_load(tsb + (k_ == 9 ? 8 : k_), __ATOMIC_RELAXED, __HIP_MEMORY_SCOPE_AGENT), a1 = __hip_atomic_load(tsb + k_ + 1, __ATOMIC_RELAXED, __HIP_MEMORY_SCOPE_AGENT); pert = (float)(a1 - a0) * 0.01f * (1.0f / 250.0f); } }
    if (PROBE_I == 101) { pert = 0.f; if (bx == 0) { const unsigned long long a0 = __hip_atomic_load(tsb + 12, __ATOMIC_RELAXED, __HIP_MEMORY_SCOPE_AGENT); pert = (float)(__builtin_amdgcn_s_memrealtime() - a0) * 0.01f * (1.0f / 250.0f); } }
    if (IN(11)) phase_final(out, X1B, Y, slot, mod, g_fin, wave, lane, vcu, G, pert);
    if (PROBE_I == 102) {
        const unsigned long long t_a = tsb[14];
        xcd_barrier(bar);
        if (bx == 0) { const float pp = (float)(__builtin_amdgcn_s_memrealtime() - t_a) * 0.01f * (1.0f / 250.0f);
            for (int k = 0; k < 4; ++k) for (int r = 0; r < 2; ++r) { float* row = out + (size_t)(2 * (vcu * NWAVES + wave) + r + 4096 * k) * D; for (int cc = lane; cc < D; cc += 64) row[cc] += pp; } } }
#else
    if (IN(11)) REP(11) { phase_final(out, X1B, Y, slot, mod, g_fin, wave, lane, vcu, G, 0.f); if (DOUBLE_PH == 11 && rep_ == 0) xcd_barrier(bar); }
#endif

#undef IN
#undef GRID_BAR
}


struct DumpArgs { const unsigned short* p[8]; unsigned long long n[8]; int f32[8]; int nb; int pad; };
__global__ void k_dump(float* out, DumpArgs a) {
    const size_t i = (size_t)blockIdx.x * blockDim.x + threadIdx.x; float s = 0.f;
    for (int b = 0; b < a.nb; ++b) for (size_t j = i; j < a.n[b]; j += (size_t)M * D) s += (a.f32[b] ? ((const float*)a.p[b])[j] : __uint_as_float(((unsigned)a.p[b][j]) << 16)) * (float)(b + 1);
    out[i] = s;
}
#ifndef DUMP_WHICH
#define DUMP_WHICH -1
#endif
#ifndef STOP_AFTER
#define STOP_AFTER (NPHASE - 1)
#endif
#ifndef MK_PER_PHASE
#define MK_PER_PHASE 0
#endif
extern "C" void kernel_launch(void* const* d_in, const int* in_sizes, int n_in, void* d_out, int out_size, void* d_ws, size_t ws_size, hipStream_t stream) {
    static int grid = 0;
    if (grid == 0) {
        if (n_in != 18 || in_sizes[0] != M * D || out_size != M * D || ws_size < WS_END) { fprintf(stderr, "kernel_launch: unexpected shapes (n_in %d, in0 %d, out %d, ws %zu); nothing launched\n", n_in, n_in > 0 ? in_sizes[0] : -1, out_size, ws_size); grid = -1; return; }
        int dev = 0, cus = 0, per_cu = 0;
        if (hipGetDevice(&dev) != hipSuccess || hipDeviceGetAttribute(&cus, hipDeviceAttributeMultiprocessorCount, dev) != hipSuccess) { grid = -1; return; }
        if (hipFuncSetAttribute((const void*)fwd, hipFuncAttributeMaxDynamicSharedMemorySize, LDS_BYTES) != hipSuccess) { fprintf(stderr, "kernel_launch: hipFuncSetAttribute failed\n"); grid = -1; return; }
        if (hipOccupancyMaxActiveBlocksPerMultiprocessor(&per_cu, (const void*)fwd, NWAVES * 64, LDS_BYTES) != hipSuccess || per_cu < 1) { fprintf(stderr, "kernel_launch: occupancy query reports %d blocks per CU\n", per_cu); }
        (void)hipGetLastError();
        grid = cus;
    }
    if (grid < 0) return;
    (void)hipMemsetAsync((char*)d_ws + WS_CTL, 0, CTL_ZERO_BYTES, stream);
    Args a{};
    for (int i = 0; i < 18; ++i) a.in[i] = (const float*)d_in[i];
    a.out = (float*)d_out; a.ws = (unsigned char*)d_ws;
#if MK_PER_PHASE
    for (int p = 0; p < STOP_AFTER + 1; ++p) { a.ph_lo = p; a.ph_hi = p + 1; hipLaunchKernelGGL(fwd, dim3(grid), dim3(NWAVES * 64), LDS_BYTES, stream, a); }
#if DUMP_WHICH >= 0
    { DumpArgs da{}; unsigned char* w = (unsigned char*)d_ws; int nb = 0;
      auto add = [&](size_t off, size_t n, int isf = 0) { da.p[nb] = (const unsigned short*)(w + off); da.n[nb] = n; da.f32[nb] = isf; ++nb; };
      if (DUMP_WHICH == 0) { add(WS_WIN, (size_t)DIN * D); add(WS_WF, (size_t)D * D); add(WS_WCO, (size_t)D * D); add(WS_WO, (size_t)D * D); add(WS_WGU, (size_t)NE * 4096 * D); add(WS_WD, (size_t)NE * D * DE); add(WS_FC1, 8192 + 0); add(WS_MODP, 4 * 2 * 6 * D, 1); }
      if (DUMP_WHICH == 1) { add(WS_H1, (size_t)M * D); add(WS_MOD, 2 * 6 * D, 1); add(WS_FC2, 65536); }
      if (DUMP_WHICH == 2) { add(WS_UF, (size_t)M * DF); add(WS_CV, (size_t)M * D); add(WS_BG, (size_t)M * D); add(WS_GA, (size_t)M * D); add(WS_GB, (size_t)M * D); }
      if (DUMP_WHICH == 5) { add(WS_UF, (size_t)M * DIN); }
      if (DUMP_WHICH == 6) { add(WS_UF, (size_t)M * DF); add(WS_CV, (size_t)M * D); }
      if (DUMP_WHICH == 7) { add(WS_BG, (size_t)M * D); }
      if (DUMP_WHICH == 8) { add(WS_GA, (size_t)M * D); add(WS_GB, (size_t)M * D); }
      if (DUMP_WHICH == 9) { add(WS_GA, (size_t)M * D); }
      if (DUMP_WHICH == 10) { add(WS_GB, (size_t)M * D); }
      if (DUMP_WHICH == 3) { add(WS_ZF, (size_t)M * D); add(WS_AB, (size_t)M * D); }
      if (DUMP_WHICH == 4) { add(WS_TZ, (size_t)M * D); }
      da.nb = nb; hipLaunchKernelGGL(k_dump, dim3(M * D / 256), dim3(256), 0, stream, (float*)d_out, da); }
#endif
#else
    a.ph_lo = 0; a.ph_hi = NPHASE; hipLaunchKernelGGL(fwd, dim3(grid), dim3(NWAVES * 64), LDS_BYTES, stream, a);
#endif
}
```

```cpp
#include <hip/hip_runtime.h>
#include <cstdio>
#include <cstdint>
#define MK_PER_PHASE 0
#define STOP_AFTER 11
#define DUMP_WHICH -1
#define GALIGN true
#define GSP2 true
#define DBG_PLAIN 0
#define DBG_NOBIAS 0
#define DBG_NOSIG 0
#define PROBE_I -1
#define PROBE_J -1
#define DOUBLE_PH -1
#define STAGGER_US 0
#define EXTRA_BARS 0
#define DBG_EPI2 0
#ifndef PROBE_I
#define PROBE_I -1
#endif
#ifndef DBG_EPI2
#define DBG_EPI2 0
#endif
namespace pg8 {
#define PG8_LAS __attribute__((address_space(3)))
typedef unsigned short bf16_t;
typedef short bf16x8 __attribute__((ext_vector_type(8)));
typedef float f32x4 __attribute__((ext_vector_type(4)));
typedef unsigned u32x4 __attribute__((ext_vector_type(4)));
typedef unsigned u32x2 __attribute__((ext_vector_type(2)));
typedef int v8i __attribute__((ext_vector_type(8)));
typedef int v4i __attribute__((ext_vector_type(4)));
constexpr int BM = 256, BK = 64, HALF = 128, HTB = HALF * BK * 2  , STAGE_BYTES = 8 * HTB, NXCD = 8, WGM = 8;

__host__ __device__ __forceinline__ int lds_byte(int r, int c) { const int st = (r >> 4) * 2 + (c >> 5), rr = r & 15, cc = c & 31, ob = rr * 64 + cc * 2; return st * 1024 + (ob ^ (((ob >> 9) & 1) << 5)); }
__host__ __device__ __forceinline__ void stage_rc(int b, int& R, int& C) { const int st = b / 1024, sb = b % 1024, swz = sb ^ (((sb >> 9) & 1) << 5); R = (st >> 1) * 16 + swz / 64; C = (st & 1) * 32 + (swz % 64) / 2; }
__host__ __device__ __forceinline__ int perm32(int rho) { const int n = rho >> 4, i = rho & 15; return 8 * (i >> 2) + 4 * n + (i & 3); }

struct Unit { int pm, pn; };
struct Gemm { const bf16_t* A; const bf16_t* Bt; int M, N, K; int bgrp; size_t bstride; const int* gidx; unsigned long long* ts; const bf16_t* A2; int asplit; };

struct StaticOrder {
    int nM, nN, nwg, G, c;
    __host__ __device__ void init(int M, int N, int G_, int c_) { nM = M / BM; nN = N / BM; nwg = nM * nN; G = G_; c = c_; }
    __host__ __device__ bool next(int i, Unit& u) const {
        const long L = (long)i * G + c; if (L >= nwg) return false;
        int wgid = (int)L; { const int q = nwg / NXCD, r = nwg % NXCD, xcd = wgid % NXCD, off = wgid / NXCD; wgid = (xcd < r ? xcd * (q + 1) : r * (q + 1) + (xcd - r) * q) + off; }
        const int nig = WGM * nN, gid = wgid / nig, fm = gid * WGM, gsz = (nM - fm) < WGM ? (nM - fm) : WGM;
        u.pm = fm + ((wgid % nig) % gsz); u.pn = (wgid % nig) / gsz; return true;
    }
    __device__ __forceinline__ void a_ready(const Unit&) const {}
    __device__ __forceinline__ void done(const Unit&) const {}
};

typedef __bf16 bf16x2_t __attribute__((ext_vector_type(2)));
typedef float f32x2_t __attribute__((ext_vector_type(2)));
__device__ __forceinline__ unsigned cvt_pk_bf16(float lo, float hi) { const f32x2_t v = {lo, hi}; const bf16x2_t b = __builtin_convertvector(v, bf16x2_t); return __builtin_bit_cast(unsigned, b); }
__device__ __forceinline__ float bf_lo(unsigned w) { return __uint_as_float(w << 16); }
__device__ __forceinline__ float bf_hi(unsigned w) { return __uint_as_float(w & 0xffff0000u); }
__device__ __forceinline__ float sigm(float v) { return __builtin_amdgcn_rcpf(1.0f + __expf(-v)); }


template <class Epi, class Sched, int AMODE, bool ALIGN_EPI, bool SP2, bool F8 = false>
__device__ __forceinline__ void gemm_phase(PG8_LAS unsigned char* lds, const Gemm g, const Sched& S, const Epi& E) {
    const int tid = threadIdx.x, wid = __builtin_amdgcn_readfirstlane(tid >> 6), lane = tid & 63, wr = wid >> 2, wc = wid & 3, fr = lane & 15, fq = lane >> 4;
    const int K = g.K, nt = K / BK;
    unsigned voffA0[2], voffA1[2], voffB[2]; int gR[2], gC2[2];
#pragma unroll
    for (int i = 0; i < 2; ++i) { int R, C; stage_rc(tid * 16 + i * 8192, R, C); const int Rb = Epi::PERM ? ((R & ~31) + perm32(R & 31)) : R;
        voffB[i] = (unsigned)(Rb * K + C) * 2u; gR[i] = R; gC2[i] = C * 2;
        if (AMODE == 0) { voffA0[i] = (unsigned)(R * K + C) * 2u; voffA1[i] = (unsigned)((R + HALF) * K + C) * 2u; }
        else if (AMODE == 1) { voffA0[i] = (unsigned)((C >> 3) * 8192 + R) * 16u; voffA1[i] = voffA0[i] + (unsigned)HALF * 16u; }
        else if (AMODE == 3) { voffA0[i] = (unsigned)((C >> 3) * 8192 + R) * 16u; voffA1[i] = voffA0[i] + (unsigned)HALF * 16u; }
        else { voffA0[i] = 0u; voffA1[i] = 0u; } }
    const size_t kstepB = (size_t)(BK * 2);
    size_t kstepA = (AMODE == 1 || AMODE == 3) ? (size_t)8 * 8192 * 16 : (size_t)(BK * 2), kstepAN = kstepA;
    unsigned vrm0[2] = {0u, 0u}, vrm1[2] = {0u, 0u}, vbl0[2] = {0u, 0u}, vbl1[2] = {0u, 0u};
    if (AMODE == 3) {
#pragma unroll
        for (int i = 0; i < 2; ++i) { vbl0[i] = voffA0[i]; vbl1[i] = voffA1[i]; vrm0[i] = (unsigned)(gR[i] * K) * 2u + (unsigned)gC2[i]; vrm1[i] = (unsigned)((gR[i] + HALF) * K) * 2u + (unsigned)gC2[i]; } }
    int nidx0[2] = {0, 0}, nidx1[2] = {0, 0}; unsigned voffN0[2] = {0u, 0u}, voffN1[2] = {0u, 0u};
#define PG8_GIDX_LOAD(u) do { if (AMODE == 2) { _Pragma("unroll") for (int _i = 0; _i < 2; ++_i) { \
        const int* _p0 = g.gidx + (size_t)(u).pm * BM + gR[_i]; const int* _p1 = _p0 + HALF; \
        asm volatile("global_load_dword %0, %1, off" : "=v"(nidx0[_i]) : "v"(_p0) : "memory"); asm volatile("global_load_dword %0, %1, off" : "=v"(nidx1[_i]) : "v"(_p1) : "memory"); } } } while (0)
#define PG8_GIDX_USE() do { if (AMODE == 2) { _Pragma("unroll") for (int _i = 0; _i < 2; ++_i) { asm volatile("" : "+v"(nidx0[_i]), "+v"(nidx1[_i])); \
        voffN0[_i] = (unsigned)nidx0[_i] * (unsigned)(K * 2) + (unsigned)gC2[_i]; voffN1[_i] = (unsigned)nidx1[_i] * (unsigned)(K * 2) + (unsigned)gC2[_i]; } } } while (0)
    const size_t hstepB = (size_t)HALF * K * 2;
    const size_t tstepB = 2 * hstepB;
    const unsigned ldsw = (unsigned)wid * 1024u;
    const int aoff = lds_byte(wr * 64 + fr, fq * 8), boff = lds_byte(wc * 32 + fr, fq * 8);
    const int aoff8a = lds_byte(wr * 64 + fr, fq * 16), boff8a = lds_byte(wc * 32 + fr, fq * 16);
#define PG8_BLK3(u) ((u).pn < g.asplit)
#define PG8_ABASE(u) ((AMODE == 3) ? (PG8_BLK3(u) ? (const char*)g.A + (size_t)((u).pm >> 5) * ((size_t)(K >> 3) * 8192 * 16) + (size_t)((u).pm & 31) * (BM * 16) : (const char*)g.A2 + (size_t)(u).pm * (size_t)BM * K * 2) : (const char*)g.A + ((AMODE == 2) ? (size_t)0 : (AMODE == 0) ? (size_t)(u).pm * (size_t)BM * K * 2 : (size_t)((u).pm >> 5) * ((size_t)(K >> 3) * 8192 * 16) + (size_t)((u).pm & 31) * (BM * 16)))
#define PG8_BBASE(u) ((const char*)g.Bt + (g.bgrp ? (size_t)((u).pm / g.bgrp) * g.bstride * 2 : (size_t)0) + (size_t)(u).pn * tstepB)
#define PG8_SA(b, h) (((b) * 2 + (h)) * HTB)
#define PG8_SB(b, h) ((4 + (b) * 2 + (h)) * HTB)
#define PG8_STAGE(bufoff, gbase, voff) do { _Pragma("unroll") for (int _i = 0; _i < 2; ++_i) \
        __builtin_amdgcn_global_load_lds((const unsigned*)((const char*)(gbase) + (voff)[_i]), (PG8_LAS unsigned*)(lds + (bufoff) + ldsw + _i * 8192), 16, 0, 0); } while (0)
#define PG8_LDA16(dst, b, h) do { _Pragma("unroll") for (int m = 0; m < 4; ++m) _Pragma("unroll") for (int k = 0; k < 2; ++k) dst[m][k] = *(const PG8_LAS bf16x8*)(lds + PG8_SA(b, h) + aoff + m * 2048 + k * 1024); } while (0)
#define PG8_LDB16(dst, b, h) do { _Pragma("unroll") for (int n = 0; n < 2; ++n) _Pragma("unroll") for (int k = 0; k < 2; ++k) dst[n][k] = *(const PG8_LAS bf16x8*)(lds + PG8_SB(b, h) + boff + n * 2048 + k * 1024); } while (0)
#define PG8_MMA16(ai, bj, At, Bt) do { __builtin_amdgcn_s_setprio(1); _Pragma("unroll") for (int m = 0; m < 4; ++m) _Pragma("unroll") for (int n = 0; n < 2; ++n) _Pragma("unroll") for (int k = 0; k < 2; ++k) \
        acc[ai][bj][m][n] = __builtin_amdgcn_mfma_f32_16x16x32_bf16(Bt[n][k], At[m][k], acc[ai][bj][m][n], 0, 0, 0); __builtin_amdgcn_s_setprio(0); } while (0)
#define PG8_LDA8(dst, b, h) do { _Pragma("unroll") for (int m = 0; m < 4; ++m) { const v4i lo_ = *(const PG8_LAS v4i*)(lds + PG8_SA(b, h) + aoff8a + m * 2048), hi_ = *(const PG8_LAS v4i*)(lds + PG8_SA(b, h) + aoff8a + m * 2048 + 16); \
        dst[m] = (v8i){lo_.x, lo_.y, lo_.z, lo_.w, hi_.x, hi_.y, hi_.z, hi_.w}; } } while (0)
#define PG8_LDB8(dst, b, h) do { _Pragma("unroll") for (int n = 0; n < 2; ++n) { const v4i lo_ = *(const PG8_LAS v4i*)(lds + PG8_SB(b, h) + boff8a + n * 2048), hi_ = *(const PG8_LAS v4i*)(lds + PG8_SB(b, h) + boff8a + n * 2048 + 16); \
        dst[n] = (v8i){lo_.x, lo_.y, lo_.z, lo_.w, hi_.x, hi_.y, hi_.z, hi_.w}; } } while (0)
#define PG8_MMA8(ai, bj, At, Bt) do { __builtin_amdgcn_s_setprio(1); _Pragma("unroll") for (int m = 0; m < 4; ++m) _Pragma("unroll") for (int n = 0; n < 2; ++n) \
        asm volatile("v_mfma_scale_f32_16x16x128_f8f6f4 %0, %1, %2, %0, %3, %3 op_sel:[0,1,0] op_sel_hi:[0,0,0]" : "+v"(acc[ai][bj][m][n]) : "v"(Bt[n]), "v"(At[m]), "v"(f8scale)); __builtin_amdgcn_s_setprio(0); } while (0)
#define PG8_LDA(dst, b, h) do { if constexpr (F8) PG8_LDA8(dst##8, b, h); else PG8_LDA16(dst, b, h); } while (0)
#define PG8_LDB(dst, b, h) do { if constexpr (F8) PG8_LDB8(dst##8, b, h); else PG8_LDB16(dst, b, h); } while (0)
#define PG8_MMA(ai, bj, At, Bt) do { if constexpr (F8) PG8_MMA8(ai, bj, At##8, Bt##8); else PG8_MMA16(ai, bj, At, Bt); } while (0)
#define PG8_WAIT_V(n) asm volatile("s_waitcnt vmcnt(" #n ")" ::: "memory")
#define PG8_WAIT_VE() do { if (epi_st == 0) PG8_WAIT_V(8); else if (epi_st == 8) PG8_WAIT_V(16); else if (epi_st == 16) PG8_WAIT_V(24); else PG8_WAIT_V(40); } while (0)
#define PG8_WAIT_L(n) asm volatile("s_waitcnt lgkmcnt(" #n ")" ::: "memory")
#define PG8_BAR __builtin_amdgcn_s_barrier()
#define PG8_SCHED __builtin_amdgcn_sched_barrier(0)
    Unit cur, nxt; int ui = 0; int epi_st = 0;
    if (!S.next(0, cur)) return;
    f32x4 acc[2][2][4][2];
#pragma unroll
    for (int a = 0; a < 2; ++a)
#pragma unroll
        for (int b = 0; b < 2; ++b)
#pragma unroll
            for (int m = 0; m < 4; ++m)
#pragma unroll
                for (int n = 0; n < 2; ++n) acc[a][b][m][n] = (f32x4){0.f, 0.f, 0.f, 0.f};
    bf16x8 At[4][2], B0[2][2], B1[2][2]; v8i At8[4], B08[2], B18[2]; int f8scale = 0x7f7f7f78; asm volatile("" : "+v"(f8scale));
    const char* cA = PG8_ABASE(cur); const char* cB = PG8_BBASE(cur);
    S.a_ready(cur);
    if (AMODE == 3) { const bool blk = PG8_BLK3(cur); kstepA = blk ? (size_t)8 * 8192 * 16 : (size_t)(BK * 2);
#pragma unroll
        for (int i = 0; i < 2; ++i) { voffA0[i] = blk ? vbl0[i] : vrm0[i]; voffA1[i] = blk ? vbl1[i] : vrm1[i]; } }
    if (AMODE == 2) { PG8_GIDX_LOAD(cur); asm volatile("s_waitcnt vmcnt(0)" ::: "memory"); PG8_GIDX_USE();
#pragma unroll
        for (int i = 0; i < 2; ++i) { voffA0[i] = voffN0[i]; voffA1[i] = voffN1[i]; } }
    if constexpr (SP2) {
        PG8_STAGE(PG8_SB(0, 0), cB, voffB); PG8_STAGE(PG8_SB(0, 1), cB + hstepB, voffB); PG8_STAGE(PG8_SA(0, 0), cA, voffA0); PG8_STAGE(PG8_SA(0, 1), cA, voffA1);
        if (wr == 1) PG8_BAR;
        PG8_WAIT_V(2); PG8_BAR;
        PG8_STAGE(PG8_SB(1, 0), cB + kstepB, voffB); PG8_STAGE(PG8_SA(1, 0), cA + kstepA, voffA0); PG8_STAGE(PG8_SB(1, 1), cB + hstepB + kstepB, voffB);
        PG8_WAIT_V(6); PG8_BAR;
    } else {
        PG8_STAGE(PG8_SB(0, 0), cB, voffB); PG8_STAGE(PG8_SA(0, 0), cA, voffA0); PG8_STAGE(PG8_SB(0, 1), cB + hstepB, voffB); PG8_STAGE(PG8_SA(0, 1), cA, voffA1);
        if (wr == 1) PG8_BAR;
        PG8_WAIT_V(4); PG8_BAR;
        PG8_STAGE(PG8_SB(1, 0), cB + kstepB, voffB); PG8_STAGE(PG8_SA(1, 0), cA + kstepA, voffA0); PG8_STAGE(PG8_SB(1, 1), cB + hstepB + kstepB, voffB);
        PG8_WAIT_V(6); PG8_BAR;
    }
    for (;;) {
        const bool has_next = S.next(ui + 1, nxt);
        const char* nA = has_next ? PG8_ABASE(nxt) : cA; const char* nB = has_next ? PG8_BBASE(nxt) : cB;
        if (AMODE == 3) { const bool blkn = has_next ? PG8_BLK3(nxt) : PG8_BLK3(cur); kstepAN = blkn ? (size_t)8 * 8192 * 16 : (size_t)(BK * 2);
#pragma unroll
            for (int i = 0; i < 2; ++i) { voffN0[i] = blkn ? vbl0[i] : vrm0[i]; voffN1[i] = blkn ? vbl1[i] : vrm1[i]; } }
        if (AMODE == 2) { if (has_next) PG8_GIDX_LOAD(nxt); }
#if PROBE_I >= 0
        if (Epi::STAMP && ui == 1 && blockIdx.x == 0 && threadIdx.x == 0) g.ts[30] = __builtin_amdgcn_s_memrealtime();
#endif
#pragma unroll 1
        for (int t = 0; t < nt; t += 2) {
            const bool last = (t == nt - 2);
            unsigned vS0[2], vS1[2];
            if (AMODE == 2) { if (last) { if (has_next) PG8_GIDX_USE(); else { _Pragma("unroll") for (int i = 0; i < 2; ++i) { voffN0[i] = voffA0[i]; voffN1[i] = voffA1[i]; } } } }
#pragma unroll
            for (int i = 0; i < 2; ++i) { vS0[i] = ((AMODE == 2 || AMODE == 3) && last) ? voffN0[i] : voffA0[i]; vS1[i] = ((AMODE == 2 || AMODE == 3) && last) ? voffN1[i] : voffA1[i]; }
            const char* a1 = cA + (size_t)(t + 1) * kstepA;
            const char* a2 = last ? nA : cA + (size_t)(t + 2) * kstepA; const char* b2 = last ? nB : cB + (size_t)(t + 2) * kstepB;
            const char* a3 = a2 + ((AMODE == 3 && last) ? kstepAN : kstepA); const char* b3 = b2 + kstepB;
            if (last && has_next) S.a_ready(nxt);
            if constexpr (SP2) {
            PG8_LDB(B0, 0, 0); PG8_LDB(B1, 0, 1); PG8_SCHED; PG8_LDA(At, 0, 0); PG8_STAGE(PG8_SA(1, 1), a1, voffA1);
            PG8_WAIT_VE(); PG8_WAIT_L(0); PG8_BAR; PG8_MMA(0, 0, At, B0); PG8_MMA(0, 1, At, B1); PG8_BAR; PG8_SCHED;
            PG8_LDA(At, 0, 1); PG8_STAGE(PG8_SB(0, 0), b2, voffB); PG8_STAGE(PG8_SB(0, 1), b2 + hstepB, voffB); PG8_STAGE(PG8_SA(0, 0), a2, vS0);
            PG8_WAIT_VE(); epi_st = 0; PG8_WAIT_L(0); PG8_BAR; PG8_MMA(1, 0, At, B0); PG8_MMA(1, 1, At, B1); PG8_BAR; PG8_SCHED;
            PG8_LDB(B0, 1, 0); PG8_LDB(B1, 1, 1); PG8_SCHED; PG8_LDA(At, 1, 0); PG8_STAGE(PG8_SA(0, 1), a2, vS1);
            PG8_WAIT_V(8); PG8_WAIT_L(0); PG8_BAR; PG8_MMA(0, 0, At, B0); PG8_MMA(0, 1, At, B1); PG8_BAR; PG8_SCHED;
            PG8_LDA(At, 1, 1); PG8_STAGE(PG8_SB(1, 0), b3, voffB); PG8_STAGE(PG8_SB(1, 1), b3 + hstepB, voffB); PG8_STAGE(PG8_SA(1, 0), a3, vS0);
            PG8_WAIT_V(8); PG8_WAIT_L(0); PG8_BAR; PG8_MMA(1, 0, At, B0); PG8_MMA(1, 1, At, B1); PG8_BAR; PG8_SCHED;
            } else {
            PG8_LDB(B0, 0, 0); PG8_SCHED; PG8_LDA(At, 0, 0); PG8_STAGE(PG8_SA(1, 1), a1, voffA1);
            PG8_WAIT_L(8); PG8_BAR; PG8_WAIT_L(0); PG8_MMA(0, 0, At, B0); PG8_BAR; PG8_SCHED;
            PG8_LDB(B1, 0, 1); PG8_STAGE(PG8_SB(0, 0), b2, voffB);
            PG8_BAR; PG8_WAIT_L(0); PG8_MMA(0, 1, At, B1); PG8_BAR;
            PG8_LDA(At, 0, 1); PG8_STAGE(PG8_SA(0, 0), a2, vS0);
            PG8_BAR; PG8_WAIT_L(0); PG8_MMA(1, 0, At, B0); PG8_BAR; PG8_SCHED;
            PG8_STAGE(PG8_SB(0, 1), b2 + hstepB, voffB);
            PG8_WAIT_V(6); PG8_BAR; PG8_MMA(1, 1, At, B1); PG8_BAR;
            PG8_LDB(B0, 1, 0); PG8_SCHED; PG8_LDA(At, 1, 0); PG8_STAGE(PG8_SA(0, 1), a2, vS1);
            PG8_WAIT_L(8); PG8_BAR; PG8_WAIT_L(0); PG8_MMA(0, 0, At, B0); PG8_BAR; PG8_SCHED;
            PG8_LDB(B1, 1, 1); PG8_STAGE(PG8_SB(1, 0), b3, voffB);
            PG8_BAR; PG8_WAIT_L(0); PG8_MMA(0, 1, At, B1); PG8_BAR;
            PG8_LDA(At, 1, 1); PG8_STAGE(PG8_SA(1, 0), a3, vS0);
            PG8_BAR; PG8_WAIT_L(0); PG8_MMA(1, 0, At, B0); PG8_BAR; PG8_SCHED;
            PG8_STAGE(PG8_SB(1, 1), b3 + hstepB, voffB);
            PG8_WAIT_V(6); PG8_BAR; PG8_MMA(1, 1, At, B1); PG8_BAR;
            }
        }
#if PROBE_I >= 0
        if (Epi::STAMP && ui == 1 && blockIdx.x == 0 && threadIdx.x == 0) g.ts[31] = __builtin_amdgcn_s_memrealtime();
#endif
        if constexpr (ALIGN_EPI) { if (wr == 0) PG8_BAR; }
        if constexpr (F8) asm volatile("s_nop 15\n\ts_nop 15\n\ts_nop 7" ::: "memory");
        E(acc, cur, wr, wc, fr, fq); S.done(cur);
#if DBG_EPI2
        if (Epi::EPI2) { asm volatile("" ::: "memory"); E(acc, cur, wr, wc, fr, fq); }
#endif
#if PROBE_I >= 0
        if (Epi::STAMP && ui == 1 && blockIdx.x == 0 && threadIdx.x == 0) g.ts[32] = __builtin_amdgcn_s_memrealtime();
        if (Epi::STAMP && ui == 2 && blockIdx.x == 0 && threadIdx.x == 0) g.ts[33] = __builtin_amdgcn_s_memrealtime();
#endif
        if (!has_next) break;
        epi_st = E.nst(cur);
#pragma unroll
        for (int a = 0; a < 2; ++a)
#pragma unroll
            for (int b = 0; b < 2; ++b)
#pragma unroll
                for (int m = 0; m < 4; ++m)
#pragma unroll
                    for (int n = 0; n < 2; ++n) acc[a][b][m][n] = (f32x4){0.f, 0.f, 0.f, 0.f};
        cur = nxt; cA = nA; cB = nB; ++ui;
        if (AMODE == 2 || AMODE == 3) {
#pragma unroll
            for (int i = 0; i < 2; ++i) { voffA0[i] = voffN0[i]; voffA1[i] = voffN1[i]; } }
        if (AMODE == 3) kstepA = kstepAN;
        if constexpr (ALIGN_EPI) { if (wr == 1) PG8_BAR; }
    }
    PG8_WAIT_V(0);
    if constexpr (!ALIGN_EPI) { if (wr == 0) PG8_BAR; }
    PG8_BAR;
#undef PG8_GIDX_LOAD
#undef PG8_GIDX_USE
#undef PG8_BLK3
#undef PG8_ABASE
#undef PG8_BBASE
#undef PG8_SA
#undef PG8_SB
#undef PG8_STAGE
#undef PG8_LDA
#undef PG8_LDA16
#undef PG8_LDA8
#undef PG8_LDB16
#undef PG8_LDB8
#undef PG8_MMA16
#undef PG8_MMA8
#undef PG8_LDB
#undef PG8_MMA
#undef PG8_WAIT_V
#undef PG8_WAIT_VE
#undef PG8_WAIT_L
#undef PG8_BAR
#undef PG8_SCHED
}
}
constexpr int NWAVES = 8;
constexpr int BATCH = 2, SEQ = 8192, D = 1024, M = BATCH * SEQ, DF = 512, DIN = 5632, NE = 16, CAP = 1024, DE = 2048, MR = BATCH * NE * CAP  ;
constexpr float RMS_EPS = 1e-6f;
constexpr size_t MiB = 1u << 20;
constexpr size_t WS_CTL = 0, CTL_ZERO_BYTES = 32 * 1024;
constexpr size_t WS_MODP = 1 * MiB, WS_MOD = 1 * MiB + 256 * 1024, WS_FC1 = 1 * MiB + 512 * 1024, WS_FC2 = 1 * MiB + 576 * 1024;
constexpr size_t WS_PROBS = 2 * MiB, WS_SLOT = 3 * MiB, WS_IDX = 4 * MiB, WS_VAL = 4 * MiB + 128 * 1024;
constexpr size_t WS_WIN = 8 * MiB, WS_WF = 20 * MiB, WS_WCO = 22 * MiB, WS_WO = 24 * MiB, WS_WGU = 32 * MiB, WS_WD = 160 * MiB;
constexpr size_t WS_H1 = 224 * MiB, WS_AB = 224 * MiB, WS_UF = 256 * MiB, WS_CV = 272 * MiB, WS_BG = 304 * MiB, WS_GA = 336 * MiB, WS_GB = 368 * MiB, WS_ZF = 400 * MiB, WS_TZ = 432 * MiB, WS_H2 = 464 * MiB;
#ifndef MOE_FP8
#define MOE_FP8 1
#endif
constexpr size_t WS_HM = 224 * MiB, WS_Y = 432 * MiB, WS_X1B = 400 * MiB, WS_END = 496 * MiB;
constexpr int CW_BAR = 4096;
constexpr int RING_BYTES = 131072, MISC_OFF = 143360, LDS_BYTES = 147456;
constexpr int FFT_TOFF = 65536, FFT_TPITCH = 528;

#define GAS __attribute__((address_space(1)))
#define LAS __attribute__((address_space(3)))
typedef unsigned short bf16;
typedef unsigned v4u __attribute__((ext_vector_type(4)));
typedef unsigned v2u __attribute__((ext_vector_type(2)));
typedef float f32x4 __attribute__((ext_vector_type(4)));
typedef short bf16x8 __attribute__((ext_vector_type(8)));
#define LDS_WAIT() asm volatile("s_waitcnt lgkmcnt(0)" ::: "memory")
#define VM_WAIT() asm volatile("s_waitcnt vmcnt(0)" ::: "memory")
using pg8::cvt_pk_bf16; using pg8::bf_lo; using pg8::bf_hi; using pg8::sigm;
__device__ __forceinline__ float wave_sum(float v) {
#pragma unroll
    for (int o = 1; o < 64; o <<= 1) v += __shfl_xor(v, o);
    return v;
}
__device__ __forceinline__ float silu(float v) { return v * sigm(v); }
#ifndef DBG_NOBIAS
#define DBG_NOBIAS 0
#endif
#ifndef DBG_NOSIG
#define DBG_NOSIG 0
#endif
__device__ __forceinline__ float sigx(float v) { return DBG_NOSIG ? v : sigm(v); }

#define XB_TMO      128
#define XB_XCNT(j)  (256  + 64 * (j))
#define XB_XSUB(j)  (1280 + 64 * (j))
#define XB_XGEN(j)  (2304 + 64 * (j))
#define XB_TOP      3328
#define XB_TOPGEN   3392
#define XCD_BAR_WORDS 3456
#define XB_SPIN_CAP (1u << 18)
__device__ __forceinline__ unsigned xb_ld(unsigned* p)              { return __hip_atomic_load(p, __ATOMIC_RELAXED, __HIP_MEMORY_SCOPE_AGENT); }
__device__ __forceinline__ unsigned xb_add(unsigned* p, unsigned v) { return __hip_atomic_fetch_add(p, v, __ATOMIC_RELAXED, __HIP_MEMORY_SCOPE_AGENT); }
__device__ __forceinline__ unsigned xb_xcc_id() { return (unsigned)__builtin_amdgcn_s_getreg((3 << 11) | 20) & 0xFu; }
#define XB_SPIN(cond, bar) do { unsigned _sp = 0; while (cond) { __builtin_amdgcn_s_sleep(1); \
    if ((++_sp & 255u) == 0u) { if (xb_ld(&(bar)[XB_TMO])) break; if (_sp > XB_SPIN_CAP) { atomicAdd(&(bar)[XB_TMO], 1u); break; } } } } while (0)
struct XcdBarrier { unsigned* bar; unsigned x; volatile LAS unsigned* st; };
__device__ __forceinline__ XcdBarrier xcd_barrier_post(unsigned* bar, volatile LAS unsigned* st) {
    XcdBarrier b; b.bar = bar; b.x = xb_xcc_id(); b.st = st;
    if (threadIdx.x == 0) (void)xb_add(&bar[XB_XCNT(b.x)], 1u);
    return b;
}
__device__ __forceinline__ void xcd_barrier_complete(unsigned* bar, unsigned x, unsigned& nloc, unsigned& nx) {
    const unsigned G = gridDim.x * gridDim.y * gridDim.z;
    unsigned sum, cnt, mine, sp = 0u;
    for (;;) {
        sum = 0u; cnt = 0u; mine = 0u;
#pragma unroll
        for (unsigned j = 0; j < 16; ++j) { const unsigned c = xb_ld(&bar[XB_XCNT(j)]); sum += c; cnt += (c > 0u) ? 1u : 0u; mine = (j == x) ? c : mine; }
        if (sum == G) break;
        __builtin_amdgcn_s_sleep(1);
        if ((++sp & 255u) == 0u) { if (xb_ld(&bar[XB_TMO])) break; if (sp > XB_SPIN_CAP) { atomicAdd(&bar[XB_TMO], 1u); break; } }
    }
    nloc = mine > 0u ? mine : 1u; nx = cnt > 0u ? cnt : 1u;
}
__device__ __forceinline__ void xcd_barrier(const XcdBarrier& b) {
    asm volatile("s_waitcnt vmcnt(0)" ::: "memory");
    __syncthreads();
    if (threadIdx.x == 0) {
        unsigned* bar = b.bar;
        __builtin_amdgcn_s_waitcnt(0);
        unsigned nloc = b.st[0], nx = b.st[1];
        if (nloc == 0u) { xcd_barrier_complete(bar, b.x, nloc, nx); b.st[0] = nloc; b.st[1] = nx; }
        const unsigned old = xb_add(&bar[XB_XSUB(b.x)], 1u);
        const unsigned gen = old / nloc;
        if (old + 1u == (gen + 1u) * nloc) {
            __builtin_amdgcn_fence(__ATOMIC_RELEASE, "agent");
            asm volatile("s_waitcnt vmcnt(0)" ::: "memory");
            const unsigned og = xb_add(&bar[XB_TOP], 1u);
            const unsigned tg = og / nx;
            if (og + 1u == (tg + 1u) * nx) xb_add(&bar[XB_TOPGEN], 1u);
            else XB_SPIN(xb_ld(&bar[XB_TOPGEN]) == tg, bar);
            __builtin_amdgcn_fence(__ATOMIC_ACQUIRE, "agent");
            xb_add(&bar[XB_XGEN(b.x)], 1u);
            asm volatile("s_waitcnt vmcnt(0)" ::: "memory");
        } else {
            XB_SPIN(xb_ld(&bar[XB_XGEN(b.x)]) == gen, bar);
            __builtin_amdgcn_fence(__ATOMIC_ACQUIRE, "agent");
            asm volatile("s_waitcnt vmcnt(0)" ::: "memory");
        }
    }
    __syncthreads();
}

using pg8::Unit; using pg8::u32x4; using pg8::u32x2;
__device__ __forceinline__ unsigned pk4_u8(float a, float b2, float c, float d) { return (unsigned)__builtin_rintf(a * 255.f) | ((unsigned)__builtin_rintf(b2 * 255.f) << 8) | ((unsigned)__builtin_rintf(c * 255.f) << 16) | ((unsigned)__builtin_rintf(d * 255.f) << 24); }
#ifndef ST_AHEAD
#define ST_AHEAD 0
#endif
#ifndef NT_INPROJ
#define NT_INPROJ 0
#endif
#if NT_INPROJ == 2
__device__ __forceinline__ void st_sc1(u32x4* p, u32x4 v) { asm volatile("global_store_dwordx4 %0, %1, off sc1" :: "v"(p), "v"(v) : "memory"); }
__device__ __forceinline__ void st_sc1(u32x2* p, u32x2 v) { asm volatile("global_store_dwordx2 %0, %1, off sc1" :: "v"(p), "v"(v) : "memory"); }
#define ST_NT(T, p, v) st_sc1((T*)(p), (v))
#elif NT_INPROJ
#define ST_NT(T, p, v) __builtin_nontemporal_store((v), (T*)(p))
#else
#define ST_NT(T, p, v) (*(T*)(p) = (v))
#endif
struct EpiInProj {
    static constexpr bool PERM = true, EPI2 = (DBG_EPI2 == 2), STAMP = (PROBE_I >= 320 && PROBE_I < 330);
    bf16 *UF, *CV, *BG, *GA, *GB; const float* b_gate;
    __device__ __forceinline__ int nst(const Unit& u) const { return ST_AHEAD ? ((u.pn < 2) ? 32 : 16) : 0; }
    __device__ __forceinline__ void operator()(const f32x4 (&acc)[2][2][4][2], const Unit& u, int wr, int wc, int fr, int fq) const {
        const int row0 = u.pm * 256 + wr * 64 + fr;
        if (u.pn < 2) {
            const int b = u.pm >> 5, s0 = (u.pm & 31) * 256 + wr * 64 + fr;
#pragma unroll
            for (int ai = 0; ai < 2; ++ai)
#pragma unroll
                for (int m = 0; m < 4; ++m) { const int s = s0 + ai * 128 + m * 16;
#pragma unroll
                    for (int bj = 0; bj < 2; ++bj) { const int g4 = (u.pn * 256 + bj * 128 + wc * 32 + 8 * fq) >> 2;
#pragma unroll
                        for (int n = 0; n < 2; ++n) { const f32x4 v = acc[ai][bj][m][n]; u32x2 w; w.x = cvt_pk_bf16(v[0], v[1]); w.y = cvt_pk_bf16(v[2], v[3]);
                            ST_NT(u32x2, UF + ((size_t)(b * 128 + g4 + n) * 8192 + s) * 4, w); } } }
        } else if (u.pn < 10) {
#pragma unroll
            for (int ai = 0; ai < 2; ++ai)
#pragma unroll
                for (int m = 0; m < 4; ++m) { bf16* rowp = CV + (size_t)(row0 + ai * 128 + m * 16) * D + (u.pn - 2) * 128 + wc * 16 + 4 * fq;
#pragma unroll
                    for (int bj = 0; bj < 2; ++bj) { const f32x4 v = acc[ai][bj][m][0] * acc[ai][bj][m][1]; u32x2 w; w.x = cvt_pk_bf16(v[0], v[1]); w.y = cvt_pk_bf16(v[2], v[3]);
                        ST_NT(u32x2, rowp + bj * 64, w); } }
        } else if (u.pn < 14) {
#pragma unroll
            for (int ai = 0; ai < 2; ++ai)
#pragma unroll
                for (int m = 0; m < 4; ++m) { bf16* rowp = BG + (size_t)(row0 + ai * 128 + m * 16) * D + (u.pn - 10) * 256 + wc * 32 + 8 * fq;
#pragma unroll
                    for (int bj = 0; bj < 2; ++bj) { const f32x4 v0 = acc[ai][bj][m][0], v1 = acc[ai][bj][m][1]; u32x4 w; w.x = cvt_pk_bf16(v0[0], v0[1]); w.y = cvt_pk_bf16(v0[2], v0[3]); w.z = cvt_pk_bf16(v1[0], v1[1]); w.w = cvt_pk_bf16(v1[2], v1[3]);
                        ST_NT(u32x4, rowp + bj * 128, w); } }
        } else {
            const int colg = (u.pn - 14) * 256 + wc * 32 + 8 * fq;
            bf16* O = (u.pn < 18) ? GA : GB;
            f32x4 bv[2][2];
#pragma unroll
            for (int bj = 0; bj < 2; ++bj)
#pragma unroll
                for (int n = 0; n < 2; ++n) bv[bj][n] = DBG_NOBIAS ? (f32x4){0.f, 0.f, 0.f, 0.f} : *(const f32x4*)(b_gate + colg + bj * 128 + 4 * n);
#pragma unroll
            for (int ai = 0; ai < 2; ++ai)
#pragma unroll
                for (int m = 0; m < 4; ++m) { unsigned char* rowp8 = (unsigned char*)O + (size_t)(row0 + ai * 128 + m * 16) * D + (colg & 1023);
#pragma unroll
                    for (int bj = 0; bj < 2; ++bj) { const f32x4 v0 = acc[ai][bj][m][0] + bv[bj][0], v1 = acc[ai][bj][m][1] + bv[bj][1]; u32x2 w;
                        w.x = pk4_u8(sigx(v0[0]), sigx(v0[1]), sigx(v0[2]), sigx(v0[3])); w.y = pk4_u8(sigx(v1[0]), sigx(v1[1]), sigx(v1[2]), sigx(v1[3]));
                        ST_NT(u32x2, rowp8 + bj * 128, w); } }
        }
    }
};
template <int MODE> struct EpiGateMul {
    static constexpr bool PERM = true, EPI2 = false, STAMP = false;
    bf16* O; const bf16* G;
    __device__ __forceinline__ int nst(const Unit&) const { return 0; }
    __device__ __forceinline__ void operator()(const f32x4 (&acc)[2][2][4][2], const Unit& u, int wr, int wc, int fr, int fq) const {
        const int row0 = u.pm * 256 + wr * 64 + fr, col0 = u.pn * 256 + wc * 32 + 8 * fq;
#pragma unroll
        for (int ai = 0; ai < 2; ++ai)
#pragma unroll
            for (int m = 0; m < 4; ++m) { const size_t off = (size_t)(row0 + ai * 128 + m * 16) * D + col0;
#pragma unroll
                for (int bj = 0; bj < 2; ++bj) { const u32x2 gw = __builtin_nontemporal_load((const u32x2*)((const unsigned char*)G + off + bj * 128)); const f32x4 v0 = acc[ai][bj][m][0] * (1.0f / 255.0f), v1 = acc[ai][bj][m][1] * (1.0f / 255.0f);
                    float r[8] = {(float)(gw.x & 0xffu) * v0[0], (float)((gw.x >> 8) & 0xffu) * v0[1], (float)((gw.x >> 16) & 0xffu) * v0[2], (float)(gw.x >> 24) * v0[3],
                                  (float)(gw.y & 0xffu) * v1[0], (float)((gw.y >> 8) & 0xffu) * v1[1], (float)((gw.y >> 16) & 0xffu) * v1[2], (float)(gw.y >> 24) * v1[3]};
                    if (MODE == 1) { const u32x4 ow = __builtin_nontemporal_load((const u32x4*)(O + off + bj * 128));
                        r[0] += bf_lo(ow.x); r[1] += bf_hi(ow.x); r[2] += bf_lo(ow.y); r[3] += bf_hi(ow.y); r[4] += bf_lo(ow.z); r[5] += bf_hi(ow.z); r[6] += bf_lo(ow.w); r[7] += bf_hi(ow.w); }
                    u32x4 w; w.x = cvt_pk_bf16(r[0], r[1]); w.y = cvt_pk_bf16(r[2], r[3]); w.z = cvt_pk_bf16(r[4], r[5]); w.w = cvt_pk_bf16(r[6], r[7]);
                    *(u32x4*)(O + off + bj * 128) = w; } }
    }
};
struct EpiGateBoth {
    static constexpr bool PERM = true, EPI2 = false, STAMP = false;
    bf16* O; const bf16* GAp; const bf16* GBp;
    __device__ __forceinline__ int nst(const Unit&) const { return 0; }
    __device__ __forceinline__ void operator()(const f32x4 (&acc)[2][2][4][2], const Unit& u, int wr, int wc, int fr, int fq) const {
        Unit v = u; const bool second = u.pn >= 4; v.pn = u.pn & 3;
        if (!second) { EpiGateMul<0> E{O, GAp}; E(acc, v, wr, wc, fr, fq); } else { EpiGateMul<1> E{O, GBp}; E(acc, v, wr, wc, fr, fq); }
    }
};
struct EpiResid {
    static constexpr bool PERM = true, EPI2 = (DBG_EPI2 == 5), STAMP = false;
    const float* x; bf16* X1B; const float* gate;
    __device__ __forceinline__ int nst(const Unit&) const { return 0; }
    __device__ __forceinline__ void operator()(const f32x4 (&acc)[2][2][4][2], const Unit& u, int wr, int wc, int fr, int fq) const {
        const int row0 = u.pm * 256 + wr * 64 + fr, col0 = u.pn * 256 + wc * 32 + 8 * fq, b = u.pm >> 5;
        f32x4 gv[2][2];
#pragma unroll
        for (int bj = 0; bj < 2; ++bj)
#pragma unroll
            for (int n = 0; n < 2; ++n) gv[bj][n] = *(const f32x4*)(gate + b * 6 * D + col0 + bj * 128 + 4 * n);
#pragma unroll
        for (int ai = 0; ai < 2; ++ai)
#pragma unroll
            for (int m = 0; m < 4; ++m) { const size_t off = (size_t)(row0 + ai * 128 + m * 16) * D + col0;
#pragma unroll
                for (int bj = 0; bj < 2; ++bj) { const f32x4 x0 = __builtin_nontemporal_load((const f32x4*)(x + off + bj * 128)), x1 = __builtin_nontemporal_load((const f32x4*)(x + off + bj * 128 + 4));
                    const f32x4 v0 = x0 + gv[bj][0] * acc[ai][bj][m][0], v1 = x1 + gv[bj][1] * acc[ai][bj][m][1];
                    u32x4 w; w.x = cvt_pk_bf16(v0[0], v0[1]); w.y = cvt_pk_bf16(v0[2], v0[3]); w.z = cvt_pk_bf16(v1[0], v1[1]); w.w = cvt_pk_bf16(v1[2], v1[3]);
                    *(u32x4*)(X1B + off + bj * 128) = w; }
                asm volatile("" ::: "memory"); }
    }
};
struct EpiSwiGLU {
    static constexpr bool PERM = true, EPI2 = (DBG_EPI2 == 9), STAMP = false;
    bf16* HM;
    __device__ __forceinline__ int nst(const Unit&) const { return 0; }
    __device__ __forceinline__ void operator()(const f32x4 (&acc)[2][2][4][2], const Unit& u, int wr, int wc, int fr, int fq) const {
        const int row0 = u.pm * 256 + wr * 64 + fr, col0 = u.pn * 128 + wc * 32 + 8 * fq;
#pragma unroll
        for (int ai = 0; ai < 2; ++ai)
#pragma unroll
            for (int m = 0; m < 4; ++m) { const f32x4 g0 = acc[ai][0][m][0], g1 = acc[ai][0][m][1], u0 = acc[ai][1][m][0], u1 = acc[ai][1][m][1]; u32x4 w;
                w.x = cvt_pk_bf16(silu(g0[0]) * u0[0], silu(g0[1]) * u0[1]); w.y = cvt_pk_bf16(silu(g0[2]) * u0[2], silu(g0[3]) * u0[3]);
                w.z = cvt_pk_bf16(silu(g1[0]) * u1[0], silu(g1[1]) * u1[1]); w.w = cvt_pk_bf16(silu(g1[2]) * u1[2], silu(g1[3]) * u1[3]);
                *(u32x4*)(HM + (size_t)(row0 + ai * 128 + m * 16) * DE + col0) = w; }
    }
};
__device__ __forceinline__ unsigned pk4_fp8(float a, float b2, float c, float d) { unsigned w = 0u; w = __builtin_amdgcn_cvt_pk_fp8_f32(a, b2, w, false); w = __builtin_amdgcn_cvt_pk_fp8_f32(c, d, w, true); return w; }
struct EpiSwiGLU8 {
    static constexpr bool PERM = true, EPI2 = false, STAMP = (PROBE_I >= 330 && PROBE_I < 340);
    unsigned char* HM8;
    __device__ __forceinline__ int nst(const Unit&) const { return ST_AHEAD ? 8 : 0; }
    __device__ __forceinline__ void operator()(const f32x4 (&acc)[2][2][4][2], const Unit& u, int wr, int wc, int fr, int fq) const {
        const int row0 = u.pm * 256 + wr * 64 + fr, col0 = u.pn * 128 + wc * 32 + 8 * fq;
#pragma unroll
        for (int ai = 0; ai < 2; ++ai)
#pragma unroll
            for (int m = 0; m < 4; ++m) { const f32x4 g0 = acc[ai][0][m][0], g1 = acc[ai][0][m][1], u0 = acc[ai][1][m][0], u1 = acc[ai][1][m][1]; u32x2 w;
                w.x = pk4_fp8(silu(g0[0]) * u0[0], silu(g0[1]) * u0[1], silu(g0[2]) * u0[2], silu(g0[3]) * u0[3]);
                w.y = pk4_fp8(silu(g1[0]) * u1[0], silu(g1[1]) * u1[1], silu(g1[2]) * u1[2], silu(g1[3]) * u1[3]);
                *(u32x2*)(HM8 + (size_t)(row0 + ai * 128 + m * 16) * DE + col0) = w; asm volatile("" ::: "memory"); }
    }
};
struct EpiRowScale {
    static constexpr bool PERM = true, EPI2 = (DBG_EPI2 == 10), STAMP = false;
    bf16* Y; const float* val;
    __device__ __forceinline__ int nst(const Unit&) const { return 0; }
    __device__ __forceinline__ void operator()(const f32x4 (&acc)[2][2][4][2], const Unit& u, int wr, int wc, int fr, int fq) const {
        const int row0 = u.pm * 256 + wr * 64 + fr, col0 = u.pn * 256 + wc * 32 + 8 * fq;
#pragma unroll
        for (int ai = 0; ai < 2; ++ai)
#pragma unroll
            for (int m = 0; m < 4; ++m) { const int row = row0 + ai * 128 + m * 16; const float sv = val[row];
#pragma unroll
                for (int bj = 0; bj < 2; ++bj) { const f32x4 v0 = acc[ai][bj][m][0] * sv, v1 = acc[ai][bj][m][1] * sv; u32x4 w; w.x = cvt_pk_bf16(v0[0], v0[1]); w.y = cvt_pk_bf16(v0[2], v0[3]); w.z = cvt_pk_bf16(v1[0], v1[1]); w.w = cvt_pk_bf16(v1[2], v1[3]);
                    *(u32x4*)(Y + (size_t)row * D + col0 + bj * 128) = w; } }
    }
};

struct EpiPlain {
    static constexpr bool PERM = true, EPI2 = false, STAMP = false;
    bf16* O; int ldc;
    __device__ __forceinline__ int nst(const Unit&) const { return 0; }
    __device__ __forceinline__ void operator()(const f32x4 (&acc)[2][2][4][2], const Unit& u, int wr, int wc, int fr, int fq) const {
        const int row0 = u.pm * 256 + wr * 64 + fr, col0 = u.pn * 256 + wc * 32 + 8 * fq;
#pragma unroll
        for (int ai = 0; ai < 2; ++ai)
#pragma unroll
            for (int m = 0; m < 4; ++m) { bf16* rowp = O + (size_t)(row0 + ai * 128 + m * 16) * ldc + col0;
#pragma unroll
                for (int bj = 0; bj < 2; ++bj) { const f32x4 v0 = acc[ai][bj][m][0], v1 = acc[ai][bj][m][1]; u32x4 w; w.x = cvt_pk_bf16(v0[0], v0[1]); w.y = cvt_pk_bf16(v0[2], v0[3]); w.z = cvt_pk_bf16(v1[0], v1[1]); w.w = cvt_pk_bf16(v1[2], v1[3]);
                    *(u32x4*)(rowp + bj * 128) = w; } }
    }
};
#ifndef NT_WLOAD
#define NT_WLOAD 1
#endif
__device__ __forceinline__ unsigned f2bf(float f) { unsigned u = __builtin_bit_cast(unsigned, f); return (u + 0x7fffu + ((u >> 16) & 1u)) >> 16; }
__device__ __forceinline__ unsigned pk2(float lo, float hi) { return f2bf(lo) | (f2bf(hi) << 16); }
__device__ __forceinline__ int rowmap_in(int n) {
    if (n < 512) return n;
    if (n < 1536) { const int j = n - 512; return 512 + 8 * (j >> 2) + (j & 3); }
    if (n < 2560) return 2560 + (n - 1536);
    if (n < 3584) { const int j = n - 2560; return 512 + 8 * (j >> 2) + 4 + (j & 3); }
    return n;
}
template <int MAP>
__device__ __forceinline__ void transpose_item(const float* W, int K, int N, bf16* WT, LAS float* scr, int item, int lane) {
    const int nblk = N / 32, kb = item / nblk, nb = item % nblk, k0 = 64 * kb, n0 = 32 * nb;
    { f32x4 t[8];
#pragma unroll
      for (int i = 0; i < 8; ++i) t[i] = NT_WLOAD ? __builtin_nontemporal_load((const GAS f32x4*)(W + (size_t)(k0 + 8 * i + (lane >> 3)) * N + n0 + 4 * (lane & 7))) : *(const GAS f32x4*)(W + (size_t)(k0 + 8 * i + (lane >> 3)) * N + n0 + 4 * (lane & 7));
#pragma unroll
      for (int i = 0; i < 8; ++i) { LAS float* d_ = scr + (8 * i + (lane >> 3)) * 33 + 4 * (lane & 7); d_[0] = t[i].x; d_[1] = t[i].y; d_[2] = t[i].z; d_[3] = t[i].w; } }
    LDS_WAIT(); asm volatile("" ::: "memory");
    const int c = lane & 7;
#pragma unroll
    for (int j = 0; j < 4; ++j) { const int n = (lane >> 3) + 8 * j; const LAS float* s = scr + (8 * c) * 33 + n;
        v4u o; o.x = pk2(s[0 * 33], s[1 * 33]); o.y = pk2(s[2 * 33], s[3 * 33]); o.z = pk2(s[4 * 33], s[5 * 33]); o.w = pk2(s[6 * 33], s[7 * 33]);
        const int ns = n0 + n; int row;
        if (MAP == 0) row = ns; else if (MAP == 1) row = rowmap_in(ns); else if (MAP == 2) row = 256 * (ns >> 7) + (ns & 127); else row = 256 * (ns >> 7) + 128 + (ns & 127);
        *(GAS v4u*)(WT + (size_t)row * K + k0 + 8 * c) = o; }
    LDS_WAIT(); asm volatile("" ::: "memory");
}
template <int MAP>
__device__ __forceinline__ void transpose_item8(const float* W, int K, int N, unsigned char* WT, LAS float* scr, int item, int lane) {
    const int nblk = N / 32, kb = item / nblk, nb = item % nblk, k0 = 64 * kb, n0 = 32 * nb;
    { f32x4 t[8];
#pragma unroll
      for (int i = 0; i < 8; ++i) t[i] = NT_WLOAD ? __builtin_nontemporal_load((const GAS f32x4*)(W + (size_t)(k0 + 8 * i + (lane >> 3)) * N + n0 + 4 * (lane & 7))) : *(const GAS f32x4*)(W + (size_t)(k0 + 8 * i + (lane >> 3)) * N + n0 + 4 * (lane & 7));
#pragma unroll
      for (int i = 0; i < 8; ++i) { LAS float* d_ = scr + (8 * i + (lane >> 3)) * 33 + 4 * (lane & 7); d_[0] = t[i].x; d_[1] = t[i].y; d_[2] = t[i].z; d_[3] = t[i].w; } }
    LDS_WAIT(); asm volatile("" ::: "memory");
    const int c = lane & 3;
#pragma unroll
    for (int j = 0; j < 2; ++j) { const int n = (lane >> 2) + 16 * j; const LAS float* s = scr + (16 * c) * 33 + n; unsigned o[4];
#pragma unroll
        for (int q = 0; q < 4; ++q) { unsigned w = 0u; w = __builtin_amdgcn_cvt_pk_fp8_f32(s[(4 * q) * 33] * 128.f, s[(4 * q + 1) * 33] * 128.f, w, false); w = __builtin_amdgcn_cvt_pk_fp8_f32(s[(4 * q + 2) * 33] * 128.f, s[(4 * q + 3) * 33] * 128.f, w, true); o[q] = w; }
        const int ns = n0 + n; int row;
        if (MAP == 0) row = ns; else if (MAP == 2) row = 256 * (ns >> 7) + (ns & 127); else row = 256 * (ns >> 7) + 128 + (ns & 127);
        v4u ov; ov.x = o[0]; ov.y = o[1]; ov.z = o[2]; ov.w = o[3];
        *(GAS v4u*)(WT + (size_t)row * K + k0 + 16 * c) = ov; }
    LDS_WAIT(); asm volatile("" ::: "memory");
}
#define EXPW_PARAMS const float* xw_g, const float* xw_u, const float* xw_d, unsigned char* xWGU8, unsigned char* xWD8
#define EXPW_ARGS xw_g, xw_u, xw_d, xWGU8, xWD8
__device__ __forceinline__ void exp_src(EXPW_PARAMS, int r, const float*& W, int& N, int& k0, int& n0) {
    const int e = r / 3072, q = r % 3072, t = q >> 10, it = q & 1023;
    if (t < 2) { W = (t == 0 ? xw_g : xw_u) + (size_t)e * D * DE; N = DE; } else { W = xw_d + (size_t)e * DE * D; N = D; }
    const int nblk = N / 32; k0 = 64 * (it / nblk); n0 = 32 * (it % nblk);
}
__device__ __forceinline__ void exp_load(EXPW_PARAMS, int r, int lane, f32x4 (&t)[8]) {
    const float* W; int N, k0, n0; exp_src(EXPW_ARGS, r, W, N, k0, n0);
#pragma unroll
    for (int i = 0; i < 8; ++i) t[i] = __builtin_nontemporal_load((const GAS f32x4*)(W + (size_t)(k0 + 8 * i + (lane >> 3)) * N + n0 + 4 * (lane & 7)));
}
__device__ __forceinline__ void exp_finish(EXPW_PARAMS, int r, int lane, const f32x4 (&t)[8], LAS float* scr) {
    const float* W; int N, k0, n0; exp_src(EXPW_ARGS, r, W, N, k0, n0);
    const int e = r / 3072, ty = (r % 3072) >> 10, K = (ty < 2) ? D : DE;
    unsigned char* WT = (ty < 2) ? xWGU8 + (size_t)e * 4096 * D : xWD8 + (size_t)e * D * DE;
#pragma unroll
    for (int i = 0; i < 8; ++i) { LAS float* d_ = scr + (8 * i + (lane >> 3)) * 33 + 4 * (lane & 7); d_[0] = t[i].x; d_[1] = t[i].y; d_[2] = t[i].z; d_[3] = t[i].w; }
    LDS_WAIT(); asm volatile("" ::: "memory");
    const int c = lane & 3;
#pragma unroll
    for (int j = 0; j < 2; ++j) { const int n = (lane >> 2) + 16 * j; const LAS float* s = scr + (16 * c) * 33 + n; unsigned o[4];
#pragma unroll
        for (int q = 0; q < 4; ++q) { unsigned w = 0u; w = __builtin_amdgcn_cvt_pk_fp8_f32(s[(4 * q) * 33] * 128.f, s[(4 * q + 1) * 33] * 128.f, w, false); w = __builtin_amdgcn_cvt_pk_fp8_f32(s[(4 * q + 2) * 33] * 128.f, s[(4 * q + 3) * 33] * 128.f, w, true); o[q] = w; }
        const int ns = n0 + n; const int row = (ty == 2) ? ns : 256 * (ns >> 7) + (ty == 1 ? 128 : 0) + (ns & 127);
        v4u ov; ov.x = o[0]; ov.y = o[1]; ov.z = o[2]; ov.w = o[3];
        *(GAS v4u*)(WT + (size_t)row * K + k0 + 16 * c) = ov; }
    LDS_WAIT(); asm volatile("" ::: "memory");
}
__device__ __forceinline__ void expert_range(EXPW_PARAMS, int first, int end, int stride, int lane, LAS float* scr) {
    if (first >= end) return;
    f32x4 t[8]; exp_load(EXPW_ARGS, first, lane, t);
    for (int r = first; r < end; r += stride) { f32x4 tn[8]; const int rn = r + stride; const bool more = rn < end;
        if (more) exp_load(EXPW_ARGS, rn, lane, tn);
        exp_finish(EXPW_ARGS, r, lane, t, scr);
        if (more) {
#pragma unroll
            for (int i = 0; i < 8; ++i) t[i] = tn[i]; } }
}
__device__ __forceinline__ void wf_item(const float* wf, bf16* WF_T, int item, int lane) {
    const int c = item >> 2, dblk = item & 3, g = c >> 7, j = c & 127, d0 = 256 * dblk + 4 * lane;
    f32x4 ac = {0.f, 0.f, 0.f, 0.f}, as = {0.f, 0.f, 0.f, 0.f};
    for (int m = 0; m < 128; ++m) { const f32x4 wv = *(const GAS f32x4*)(wf + (size_t)(g * 128 + m) * D + d0); const float fr = (float)((m * j) & 127) * (1.0f / 128.0f);
        const float cv = __builtin_amdgcn_cosf(fr), sv = __builtin_amdgcn_sinf(fr); ac += cv * wv; as += sv * wv; }
    const int kv = 8 * (c >> 2) + 2 * (c & 3);
#pragma unroll
    for (int i = 0; i < 4; ++i) *(GAS unsigned*)(WF_T + (size_t)(d0 + i) * D + kv) = pk2(ac[i] * (1.0f / 1024.0f), as[i] * (1.0f / 1024.0f));
}
__device__ __forceinline__ void fc_tables(bf16* Fc1, bf16* Fc2, int gtid, int gthreads) {
    for (int e = gtid; e < 8192 + 65536; e += gthreads) {
        if (e < 8192) { const int j = e & 7, ln = (e >> 3) & 63, kk = (e >> 9) & 1, mt = (e >> 10) & 3, hh = e >> 12, rho = ln & 15;
            const int s1 = 32 * kk + 8 * (ln >> 4) + j, k1 = 32 * hh + 16 * (mt & 1) + 4 * (rho & 3) + (rho >> 2);
            const float fr = (float)((k1 * s1) & 63) * (1.0f / 64.0f); Fc1[e] = (bf16)f2bf((mt >> 1) == 0 ? cospif(2.0f * fr) : -sinpif(2.0f * fr)); }
        else { const int q = e - 8192, j = q & 7, ln = (q >> 3) & 63, kk = (q >> 9) & 7, ro = (q >> 12) & 1, w = q >> 13;
            const int k2 = 16 * w + (ln & 15), kap = 32 * kk + 8 * (ln >> 4) + j, s2 = kap >> 1, ri = kap & 1;
            const float fr = (float)((k2 * s2) & 127) * (1.0f / 128.0f), cv = cospif(2.0f * fr), sv = sinpif(2.0f * fr);
            Fc2[q] = (bf16)f2bf(ro == 0 ? (ri == 0 ? cv : sv) : (ri == 0 ? -sv : cv)); }
    }
}
__device__ __forceinline__ void mod_item(const float* c, const float* w_ada, float* modp, LAS unsigned char* lds, int item, int tid, int wave, int lane) {
    const int cb = item % 24, kq = item / 24, col0 = 256 * cb + 4 * lane;
    f32x4 a0 = {0.f, 0.f, 0.f, 0.f}, a1 = {0.f, 0.f, 0.f, 0.f};
#pragma unroll
    for (int i0 = 0; i0 < 32; i0 += 16) { f32x4 wv[16];
#pragma unroll
        for (int i = 0; i < 16; ++i) wv[i] = __builtin_nontemporal_load((const GAS f32x4*)(w_ada + (size_t)(256 * kq + 32 * wave + i0 + i) * 6 * D + col0));
#pragma unroll
        for (int i = 0; i < 16; ++i) { const int d = 256 * kq + 32 * wave + i0 + i; a0 += silu(c[d]) * wv[i]; a1 += silu(c[D + d]) * wv[i]; } }
    LAS f32x4* red = (LAS f32x4*)lds;
    red[(wave * 2 + 0) * 64 + lane] = a0; red[(wave * 2 + 1) * 64 + lane] = a1;
    __syncthreads();
    { const int b = tid >> 8, cc = tid & 255; const LAS float* rf = (const LAS float*)lds; float s = 0.f;
#pragma unroll
      for (int w = 0; w < 8; ++w) s += rf[((w * 2 + b) * 64) * 4 + cc];
      modp[(size_t)(kq * 2 + b) * 6 * D + 256 * cb + cc] = s; }
    asm volatile("s_waitcnt vmcnt(0)" ::: "memory");
    __syncthreads();
}

__device__ __forceinline__ void phase_h(const float* x, const float* g_mix, const float* b_ada, const float* modp, float* mod, bf16* H1, LAS unsigned char* lds, int tid, int wave, int lane, int vcu, int G) {
    LAS float* ga = (LAS float*)lds;
    LAS float* sh = ga + 2 * D;
    { float v[8];
#pragma unroll
      for (int k = 0; k < 8; ++k) { const int i = tid + 512 * k, j = i & 2047; v[k] = b_ada[j]; }
#pragma unroll
      for (int q = 0; q < 4; ++q)
#pragma unroll
          for (int k = 0; k < 8; ++k) { const int i = tid + 512 * k, b = i >> 11, j = i & 2047; v[k] += modp[(size_t)(q * 2 + b) * 6 * D + j]; }
#pragma unroll
      for (int k = 0; k < 8; ++k) { const int i = tid + 512 * k, b = i >> 11, j = i & 2047; if (j < D) sh[b * D + j] = v[k]; else ga[b * D + j - D] = g_mix[j - D] * (1.f + v[k]); } }
    { const int i = vcu * NWAVES * 64 + tid;
      if (i < 2 * 6 * D) { const int b = i / (6 * D), j = i % (6 * D); float v = b_ada[j];
#pragma unroll
          for (int q = 0; q < 4; ++q) v += modp[(size_t)(q * 2 + b) * 6 * D + j];
          mod[i] = v; } }
    __syncthreads();
    const int gw = vcu * NWAVES + wave, NGW = G * NWAVES;
    for (int m0 = gw * 4; m0 < M; m0 += NGW * 4) { const int b = m0 >> 13;
        f32x4 v[4][4]; float s[4];
#pragma unroll
        for (int r = 0; r < 4; ++r) { const GAS f32x4* xr = (const GAS f32x4*)(x + (size_t)(m0 + r) * D) + lane;
#pragma unroll
            for (int j = 0; j < 4; ++j) v[r][j] = __builtin_nontemporal_load(xr + 64 * j); }
#pragma unroll
        for (int r = 0; r < 4; ++r) { s[r] = 0.f;
#pragma unroll
            for (int j = 0; j < 4; ++j) s[r] += (v[r][j].x * v[r][j].x + v[r][j].y * v[r][j].y) + (v[r][j].z * v[r][j].z + v[r][j].w * v[r][j].w); }
#pragma unroll
        for (int o = 1; o < 64; o <<= 1) {
#pragma unroll
            for (int r = 0; r < 4; ++r) s[r] += __shfl_xor(s[r], o); }
#pragma unroll
        for (int r = 0; r < 4; ++r) { const float rr = rsqrtf(s[r] * (1.f / D) + RMS_EPS); GAS v2u* o8 = (GAS v2u*)(H1 + (size_t)(m0 + r) * D) + lane;
#pragma unroll
            for (int j = 0; j < 4; ++j) { const f32x4 gg = *(const LAS f32x4*)(ga + b * D + 4 * lane + 256 * j), ss = *(const LAS f32x4*)(sh + b * D + 4 * lane + 256 * j); const f32x4 y = v[r][j] * rr * gg + ss;
                v2u w; w.x = cvt_pk_bf16(y.x, y.y); w.y = cvt_pk_bf16(y.z, y.w); o8[64 * j] = w; } } }
    __syncthreads();
}
__device__ __forceinline__ void phase_conv(const bf16* CV, const bf16* BG, const float* w_conv, bf16* AB, int wave, int lane, int vcu, int G) {
    const int gw = vcu * NWAVES + wave, NGW = G * NWAVES;
    for (int o = gw; o < M / 8; o += NGW) { const int r0 = 8 * o, s0 = r0 & (SEQ - 1);
#pragma unroll
        for (int hseg = 0; hseg < 2; ++hseg) { const int ch = hseg * 512 + 8 * lane; const size_t off = (size_t)r0 * D + ch;
            v4u cv[10], bg[8];
#pragma unroll
            for (int jj = 0; jj < 10; ++jj) { const bool ok = (jj == 0) ? (s0 > 0) : (jj == 9) ? (s0 + 8 < SEQ) : true; cv[jj] = (v4u){0u, 0u, 0u, 0u}; if (ok) cv[jj] = __builtin_nontemporal_load((const GAS v4u*)(CV + off + (size_t)(jj - 1) * D)); }
#pragma unroll
            for (int jj = 0; jj < 8; ++jj) bg[jj] = __builtin_nontemporal_load((const GAS v4u*)(BG + off + (size_t)jj * D));
            float w0[8], w1[8], w2[8];
#pragma unroll
            for (int q = 0; q < 2; ++q) { const f32x4 a = *(const GAS f32x4*)(w_conv + ch + 4 * q), b = *(const GAS f32x4*)(w_conv + D + ch + 4 * q), c2 = *(const GAS f32x4*)(w_conv + 2 * D + ch + 4 * q);
#pragma unroll
                for (int i2 = 0; i2 < 4; ++i2) { w0[4 * q + i2] = a[i2]; w1[4 * q + i2] = b[i2]; w2[4 * q + i2] = c2[i2]; } }
#pragma unroll
            for (int jj = 0; jj < 8; ++jj) { unsigned ow[4];
#pragma unroll
                for (int q = 0; q < 4; ++q) {
                    const float lo = bf_lo(bg[jj][q]) * (w0[2 * q] * bf_lo(cv[jj][q]) + w1[2 * q] * bf_lo(cv[jj + 1][q]) + w2[2 * q] * bf_lo(cv[jj + 2][q]));
                    const float hi = bf_hi(bg[jj][q]) * (w0[2 * q + 1] * bf_hi(cv[jj][q]) + w1[2 * q + 1] * bf_hi(cv[jj + 1][q]) + w2[2 * q + 1] * bf_hi(cv[jj + 2][q]));
                    ow[q] = cvt_pk_bf16(lo, hi); }
                v4u ov; ov.x = ow[0]; ov.y = ow[1]; ov.z = ow[2]; ov.w = ow[3];
                *(GAS v4u*)(AB + off + (size_t)jj * D) = ov; } } }
}
__device__ __forceinline__ void phase_h2(const bf16* X1B, const float* g_moe, const float* mod, const float* w_router, const float* b_router, bf16* H2, unsigned char* H2F8, float* probs,
                                         LAS unsigned char* lds, int tid, int wave, int lane, int vcu, int G) {
    LAS bf16* whi = (LAS bf16*)lds;
    LAS bf16* wlo = whi + 16384;
    LAS float* ga = (LAS float*)(lds + 65536);
    LAS float* sh = ga + 2 * D;
    for (int i = tid; i < 16384; i += NWAVES * 64) { const int j = i & 7, ln = (i >> 3) & 63, kk = i >> 9, k = 32 * kk + 8 * (ln >> 4) + j, e = ln & 15;
        const float w = w_router[k * NE + e]; const unsigned h = f2bf(w); const float wh = __uint_as_float(h << 16); whi[i] = (bf16)h; wlo[i] = (bf16)f2bf(w - wh); }
    { float a[4], b2[4], c2[4];
#pragma unroll
      for (int k = 0; k < 4; ++k) { const int i = tid + 512 * k, b = i >> 10, j = i & 1023; a[k] = mod[b * 6 * D + 3 * D + j]; b2[k] = mod[b * 6 * D + 4 * D + j]; c2[k] = g_moe[j]; }
#pragma unroll
      for (int k = 0; k < 4; ++k) { const int i = tid + 512 * k; sh[i] = a[k]; ga[i] = c2[k] * (1.f + b2[k]); } }
    __syncthreads();
    const int n = lane & 15, kq = lane >> 4;
    float br[4];
#pragma unroll
    for (int r = 0; r < 4; ++r) br[r] = b_router[4 * kq + r];
    for (int grp = wave * G + vcu; grp < M / 16; grp += NWAVES * G) { const int m0 = 16 * grp, b = m0 >> 13;
        const GAS v4u* xr = (const GAS v4u*)(X1B + (size_t)(m0 + n) * D + 8 * kq);
        v4u xf[32]; float ssq = 0.f;
#pragma unroll
        for (int kk = 0; kk < 32; ++kk) xf[kk] = __builtin_nontemporal_load(xr + 4 * kk);
#pragma unroll
        for (int kk = 0; kk < 32; ++kk) { const v4u w = xf[kk]; const float e0 = bf_lo(w.x), e1 = bf_hi(w.x), e2 = bf_lo(w.y), e3 = bf_hi(w.y), e4 = bf_lo(w.z), e5 = bf_hi(w.z), e6 = bf_lo(w.w), e7 = bf_hi(w.w);
            ssq += (e0 * e0 + e1 * e1) + (e2 * e2 + e3 * e3) + (e4 * e4 + e5 * e5) + (e6 * e6 + e7 * e7); }
#pragma unroll
        for (int kk = 0; kk < 32; ++kk) asm volatile("" : "+v"(xf[kk].x), "+v"(xf[kk].y), "+v"(xf[kk].z), "+v"(xf[kk].w));
        ssq += __shfl_xor(ssq, 16); ssq += __shfl_xor(ssq, 32);
        const float rstd = rsqrtf(ssq * (1.f / D) + RMS_EPS);
        f32x4 acc = {0.f, 0.f, 0.f, 0.f};
        GAS v4u* ho = (GAS v4u*)(H2 + (size_t)(m0 + n) * D + 8 * kq);
#pragma unroll
        for (int kk = 0; kk < 32; ++kk) { const v4u w = xf[kk]; const int col = 32 * kk + 8 * kq;
            const f32x4 g0 = *(const LAS f32x4*)(ga + b * D + col), g1 = *(const LAS f32x4*)(ga + b * D + col + 4), s0 = *(const LAS f32x4*)(sh + b * D + col), s1 = *(const LAS f32x4*)(sh + b * D + col + 4);
            float h[8] = {bf_lo(w.x) * rstd * g0.x + s0.x, bf_hi(w.x) * rstd * g0.y + s0.y, bf_lo(w.y) * rstd * g0.z + s0.z, bf_hi(w.y) * rstd * g0.w + s0.w,
                          bf_lo(w.z) * rstd * g1.x + s1.x, bf_hi(w.z) * rstd * g1.y + s1.y, bf_lo(w.w) * rstd * g1.z + s1.z, bf_hi(w.w) * rstd * g1.w + s1.w};
            v4u hh, hl;
            hh.x = cvt_pk_bf16(h[0], h[1]); hh.y = cvt_pk_bf16(h[2], h[3]); hh.z = cvt_pk_bf16(h[4], h[5]); hh.w = cvt_pk_bf16(h[6], h[7]);
            hl.x = cvt_pk_bf16(h[0] - bf_lo(hh.x), h[1] - bf_hi(hh.x)); hl.y = cvt_pk_bf16(h[2] - bf_lo(hh.y), h[3] - bf_hi(hh.y)); hl.z = cvt_pk_bf16(h[4] - bf_lo(hh.z), h[5] - bf_hi(hh.z)); hl.w = cvt_pk_bf16(h[6] - bf_lo(hh.w), h[7] - bf_hi(hh.w));
            if (MOE_FP8) { v2u q8; q8.x = pk4_fp8(h[0], h[1], h[2], h[3]); q8.y = pk4_fp8(h[4], h[5], h[6], h[7]); *(GAS v2u*)(H2F8 + (size_t)(m0 + n) * D + 32 * kk + 8 * kq) = q8; }
            else ho[4 * kk] = hh;
            const bf16x8 ah = *(const LAS bf16x8*)(whi + (kk * 64 + lane) * 8), al = *(const LAS bf16x8*)(wlo + (kk * 64 + lane) * 8);
            const bf16x8 bh = __builtin_bit_cast(bf16x8, hh), bl = __builtin_bit_cast(bf16x8, hl);
            acc = __builtin_amdgcn_mfma_f32_16x16x32_bf16(ah, bh, acc, 0, 0, 0); acc = __builtin_amdgcn_mfma_f32_16x16x32_bf16(al, bh, acc, 0, 0, 0); acc = __builtin_amdgcn_mfma_f32_16x16x32_bf16(ah, bl, acc, 0, 0, 0);
            asm volatile("" ::: "memory"); }
        float lg[4], mx = -3.0e38f;
#pragma unroll
        for (int r = 0; r < 4; ++r) { lg[r] = acc[r] + br[r]; mx = fmaxf(mx, lg[r]); }
        mx = fmaxf(mx, __shfl_xor(mx, 16)); mx = fmaxf(mx, __shfl_xor(mx, 32));
        float sum = 0.f;
#pragma unroll
        for (int r = 0; r < 4; ++r) { lg[r] = __expf(lg[r] - mx); sum += lg[r]; }
        sum += __shfl_xor(sum, 16); sum += __shfl_xor(sum, 32);
        const float inv = 1.0f / sum; const int s = (m0 + n) & (SEQ - 1);
#pragma unroll
        for (int r = 0; r < 4; ++r) probs[((size_t)(b * NE + 4 * kq + r)) * SEQ + s] = lg[r] * inv; }
}
__device__ __forceinline__ void topk_item(const float* probs, int* idx, float* val, int* slot, LAS unsigned char* lds, int item, int tid, int wave, int lane) {
    const int e = item >> 1, b = item & 1;
    LAS int* red = (LAS int*)lds;
    unsigned p[16];
#pragma unroll
    for (int q = 0; q < 4; ++q) { const v4u w = __builtin_nontemporal_load((const GAS v4u*)(probs + ((size_t)(b * NE + e)) * SEQ + 16 * tid + 4 * q)); p[4 * q] = w.x; p[4 * q + 1] = w.y; p[4 * q + 2] = w.z; p[4 * q + 3] = w.w; }
    unsigned prefix = 0u;
    for (int bit = 30; bit >= 0; --bit) { const unsigned cand = prefix | (1u << bit); int cnt = 0;
#pragma unroll
        for (int j = 0; j < 16; ++j) cnt += __popcll(__ballot(p[j] >= cand));
        const int par = bit & 1;
        if (lane == 0) red[par * 8 + wave] = cnt;
        __syncthreads();
        int tot = 0;
#pragma unroll
        for (int w = 0; w < 8; ++w) tot += red[par * 8 + w];
        if (tot >= CAP) prefix = cand; }
    const unsigned T = prefix;
    int cgt = 0, ceq = 0;
#pragma unroll
    for (int j = 0; j < 16; ++j) { cgt += (p[j] > T) ? 1 : 0; ceq += (p[j] == T) ? 1 : 0; }
    int sgt = cgt, seq = ceq;
#pragma unroll
    for (int o = 1; o < 64; o <<= 1) { const int a = __shfl_up(sgt, o), c = __shfl_up(seq, o); if (lane >= o) { sgt += a; seq += c; } }
    __syncthreads();
    if (lane == 63) { red[32 + wave] = sgt; red[48 + wave] = seq; }
    __syncthreads();
    int bgt = 0, beq = 0, totgt = 0;
#pragma unroll
    for (int w = 0; w < 8; ++w) { const int a = red[32 + w], c = red[48 + w]; if (w < wave) { bgt += a; beq += c; } totgt += a; }
    int rgt = bgt + sgt - cgt, req = beq + seq - ceq;
    const int need = CAP - totgt; const int rbase = (e * 2 + b) * CAP;
#pragma unroll
    for (int j = 0; j < 16; ++j) { const int tok = b * SEQ + 16 * tid + j; int sl = -1;
        if (p[j] > T) { sl = rgt; ++rgt; } else if (p[j] == T) { if (req < need) sl = totgt + req; ++req; }
        slot[(size_t)tok * NE + e] = sl;
        if (sl >= 0) { idx[rbase + sl] = tok; val[rbase + sl] = __uint_as_float(p[j]); } }
    __syncthreads();
}
__device__ __forceinline__ void phase_gather(const bf16* H2, const int* idx, bf16* XE, int wave, int lane, int vcu, int G) {
    const int gw = vcu * NWAVES + wave, NGW = G * NWAVES;
    for (int r = gw; r < MR; r += NGW) { const int tok = idx[r];
        const GAS v4u* src = (const GAS v4u*)(H2 + (size_t)tok * D) + lane; GAS v4u* dst = (GAS v4u*)(XE + (size_t)r * D) + lane;
        const v4u a = src[0], b2 = src[64]; dst[0] = a; dst[64] = b2; }
}
__device__ __forceinline__ void phase_final(float* out, const bf16* X1B, const bf16* Y, const int* slot, const float* mod, const float* g_fin, int wave, int lane, int vcu, int G, float pert) {
    const int gw = vcu * NWAVES + wave, NGW = G * NWAVES;
    int slv[2]; v2u xw[2][4];
#define PF_FETCH(mm) do { _Pragma("unroll") for (int r = 0; r < 2; ++r) { slv[r] = slot[(size_t)((mm) + r) * NE + (lane & 15)]; const GAS v2u* xr_ = (const GAS v2u*)(X1B + (size_t)((mm) + r) * D) + lane; \
        _Pragma("unroll") for (int j = 0; j < 4; ++j) xw[r][j] = __builtin_nontemporal_load(xr_ + 64 * j); } } while (0)
    int m0 = gw * 2;
    if (m0 < M) PF_FETCH(m0);
    for (; m0 < M; m0 += NGW * 2) { const int b = m0 >> 13;
        int cs[2]; f32x4 v[2][4], a[2][4];
#pragma unroll
        for (int r = 0; r < 2; ++r) { cs[r] = slv[r];
#pragma unroll
            for (int j = 0; j < 4; ++j) { const v2u w = xw[r][j]; v[r][j] = (f32x4){bf_lo(w.x), bf_hi(w.x), bf_lo(w.y), bf_hi(w.y)}; a[r][j] = (f32x4){0.f, 0.f, 0.f, 0.f}; } }
        const int mn = m0 + NGW * 2;
        if (mn < M) PF_FETCH(mn);
        unsigned long long mask[2]; bool more = false;
#pragma unroll
        for (int r = 0; r < 2; ++r) mask[r] = __ballot(cs[r] >= 0) & 0xFFFFull;
        do { const GAS v2u* yp[2][4]; bool ok[2][4]; v2u w[2][4][4];
#pragma unroll
            for (int r = 0; r < 2; ++r)
#pragma unroll
                for (int c = 0; c < 4; ++c) { ok[r][c] = (mask[r] != 0ull); const int e = ok[r][c] ? (int)__builtin_ctzll(mask[r]) : 0; mask[r] &= (mask[r] - 1ull);
                    const int sl = __builtin_amdgcn_readlane(cs[r], e); yp[r][c] = (const GAS v2u*)(Y + ((size_t)(e * 2 + b) * CAP + (ok[r][c] ? sl : 0)) * D) + lane; }
#pragma unroll
            for (int r = 0; r < 2; ++r)
#pragma unroll
                for (int c = 0; c < 4; ++c) if (ok[r][c]) {
#pragma unroll
                    for (int j = 0; j < 4; ++j) w[r][c][j] = __builtin_nontemporal_load(yp[r][c] + 64 * j); }
#pragma unroll
            for (int r = 0; r < 2; ++r)
#pragma unroll
                for (int c = 0; c < 4; ++c) if (ok[r][c]) {
#pragma unroll
                    for (int j = 0; j < 4; ++j) { a[r][j].x += bf_lo(w[r][c][j].x); a[r][j].y += bf_hi(w[r][c][j].x); a[r][j].z += bf_lo(w[r][c][j].y); a[r][j].w += bf_hi(w[r][c][j].y); } }
            more = (mask[0] | mask[1]) != 0ull;
        } while (more);
        float s[2];
#pragma unroll
        for (int r = 0; r < 2; ++r) { s[r] = 0.f;
#pragma unroll
            for (int j = 0; j < 4; ++j) { const f32x4 gf = *(const GAS f32x4*)(mod + b * 6 * D + 5 * D + 4 * lane + 256 * j); v[r][j] = v[r][j] + gf * a[r][j]; s[r] += (v[r][j].x * v[r][j].x + v[r][j].y * v[r][j].y) + (v[r][j].z * v[r][j].z + v[r][j].w * v[r][j].w); } }
#pragma unroll
        for (int o = 1; o < 64; o <<= 1) { s[0] += __shfl_xor(s[0], o); s[1] += __shfl_xor(s[1], o); }
#pragma unroll
        for (int r = 0; r < 2; ++r) { const float rr = rsqrtf(s[r] * (1.f / D) + RMS_EPS); GAS f32x4* xo = (GAS f32x4*)(out + (size_t)(m0 + r) * D) + lane;
#pragma unroll
            for (int j = 0; j < 4; ++j) { const f32x4 gg = *(const GAS f32x4*)(g_fin + 4 * lane + 256 * j); __builtin_nontemporal_store(v[r][j] * rr * gg + pert, xo + 64 * j); } } }
#undef PF_FETCH
}
__device__ __forceinline__ void fft_item(LAS unsigned char* lds, const bf16* UF, bf16* ZF, const bf16* Fc1, const bf16* Fc2, int item, int wave, int lane, unsigned long long* ts) {
#define FFT_STAMP(i_) do { if (ts && blockIdx.x == 0 && threadIdx.x == 0) ts[34 + (i_)] = __builtin_amdgcn_s_memrealtime(); } while (0)
    FFT_STAMP(0);
    const char* slab = (const char*)UF + (size_t)item * 65536;
    { v4u xv[8];
#pragma unroll
      for (int p = 0; p < 8; ++p) { const int s1 = 8 * p + wave; xv[p] = __builtin_nontemporal_load((const GAS v4u*)(slab + s1 * 1024 + ((16 * lane - 32 * ((s1 >> 3) & 3)) & 1023))); }
#pragma unroll
      for (int p = 0; p < 8; ++p) *(LAS v4u*)(lds + (8 * p + wave) * 1024 + 16 * lane) = xv[p]; }
    bf16x8 A2[2][8];
#pragma unroll
    for (int ro = 0; ro < 2; ++ro)
#pragma unroll
        for (int kk = 0; kk < 8; ++kk) A2[ro][kk] = *(const GAS bf16x8*)(Fc2 + ((size_t)(((wave * 2 + ro) * 8 + kk) * 64 + lane)) * 8);
    LDS_WAIT(); __syncthreads(); FFT_STAMP(1);
    const int fr = lane & 15, fq = lane >> 4, ch = lane & 3, s2l = (lane & 15) >> 2;
    char* zb = (char*)ZF + (size_t)item * 131072;
    for (int hh = 0; hh < 2; ++hh) {
        { bf16x8 A1[4][2];
#pragma unroll
          for (int mt = 0; mt < 4; ++mt)
#pragma unroll
              for (int kk = 0; kk < 2; ++kk) A1[mt][kk] = *(const GAS bf16x8*)(Fc1 + ((size_t)(((hh * 4 + mt) * 2 + kk) * 64 + lane)) * 8);
          for (int jn = 0; jn < 4; ++jn) { const int nt = wave + 8 * jn, s2 = 4 * nt + s2l;
            bf16x8 Bx[2];
#pragma unroll
            for (int kk = 0; kk < 2; ++kk)
#pragma unroll
                for (int j = 0; j < 8; ++j) { const int s1 = 32 * kk + 8 * fq + j; Bx[kk][j] = *(const LAS short*)(lds + s1 * 1024 + ((s2 * 8 + ch * 2 + 32 * fq) & 1023)); }
            f32x4 acc[4];
#pragma unroll
            for (int mt = 0; mt < 4; ++mt) { acc[mt] = (f32x4){0.f, 0.f, 0.f, 0.f};
#pragma unroll
                for (int kk = 0; kk < 2; ++kk) acc[mt] = __builtin_amdgcn_mfma_f32_16x16x32_bf16(A1[mt][kk], Bx[kk], acc[mt], 0, 0, 0); }
#pragma unroll
            for (int blk = 0; blk < 2; ++blk)
#pragma unroll
                for (int r = 0; r < 4; ++r) { const int k1l = 16 * blk + 4 * r + fq, k1 = 32 * hh + k1l; const float dr = acc[blk][r], di = acc[2 + blk][r];
                    const float frac = (float)((s2 * k1) & 8191) * (1.0f / 8192.0f), c = __builtin_amdgcn_cosf(frac), s = __builtin_amdgcn_sinf(frac);
                    *(LAS unsigned*)(lds + FFT_TOFF + (k1l * 4 + ch) * FFT_TPITCH + s2 * 4) = cvt_pk_bf16(dr * c + di * s, di * c - dr * s); } } }
        LDS_WAIT(); __syncthreads(); if (hh == 0) FFT_STAMP(2);
        for (int nt2 = 0; nt2 < 8; ++nt2) { f32x4 c0 = {0.f, 0.f, 0.f, 0.f}, c1 = {0.f, 0.f, 0.f, 0.f};
#pragma unroll
            for (int kk = 0; kk < 8; ++kk) { const bf16x8 Bt = *(const LAS bf16x8*)(lds + FFT_TOFF + (16 * nt2 + fr) * FFT_TPITCH + kk * 64 + fq * 16);
                c0 = __builtin_amdgcn_mfma_f32_16x16x32_bf16(A2[0][kk], Bt, c0, 0, 0, 0); c1 = __builtin_amdgcn_mfma_f32_16x16x32_bf16(A2[1][kk], Bt, c1, 0, 0, 0); }
            const int k1 = 32 * hh + 4 * nt2 + s2l;
#pragma unroll
            for (int r = 0; r < 4; ++r) { const int k = k1 + 64 * (16 * wave + 4 * fq + r); *(GAS unsigned*)(zb + (size_t)k * 16 + ch * 4) = cvt_pk_bf16(c0[r], c1[r]); } }
        LDS_WAIT(); __syncthreads(); if (hh == 0) FFT_STAMP(3);
    }
    FFT_STAMP(4);
#undef FFT_STAMP
}
#if MOE_FP8
#define EXPERT_ITEM(r_) do { const int e_ = (r_) / 3072, q_ = (r_) % 3072; \
    if (q_ < 1024) transpose_item8<2>(w_g + (size_t)e_ * D * DE, D, DE, WGU8 + (size_t)e_ * 4096 * D, scr, q_, lane); \
    else if (q_ < 2048) transpose_item8<3>(w_u + (size_t)e_ * D * DE, D, DE, WGU8 + (size_t)e_ * 4096 * D, scr, q_ - 1024, lane); \
    else transpose_item8<0>(w_d + (size_t)e_ * DE * D, DE, D, WD8 + (size_t)e_ * D * DE, scr, q_ - 2048, lane); } while (0)
#else
#define EXPERT_ITEM(r_) do { const int e_ = (r_) / 3072, q_ = (r_) % 3072; \
    if (q_ < 1024) transpose_item<2>(w_g + (size_t)e_ * D * DE, D, DE, WGU + (size_t)e_ * 4096 * D, scr, q_, lane); \
    else if (q_ < 2048) transpose_item<3>(w_u + (size_t)e_ * D * DE, D, DE, WGU + (size_t)e_ * 4096 * D, scr, q_ - 1024, lane); \
    else transpose_item<0>(w_d + (size_t)e_ * DE * D, DE, D, WD + (size_t)e_ * D * DE, scr, q_ - 2048, lane); } while (0)
#endif
#ifndef EXP_P2
#define EXP_P2 10240
#endif
#ifndef EXP_P7
#define EXP_P7 14336
#endif
#ifndef EXP_P6
#define EXP_P6 16384
#endif
constexpr int EXP_TOTAL = NE * 3072, EXP_P0 = EXP_TOTAL - EXP_P2 - EXP_P7 - EXP_P6;

constexpr int NPHASE = 12;
#ifndef P2_GEMM_CUS
#define P2_GEMM_CUS 235
#endif
constexpr int CW_MODCNT = 2048;
#ifndef P4_FUSED
#define P4_FUSED 0
#endif
#ifndef MOE_ALIGN
#define MOE_ALIGN true
#endif
#ifndef EXTRA_BARS
#define EXTRA_BARS 0
#endif
#ifndef STAGGER_US
#define STAGGER_US 0
#endif
#ifndef DOUBLE_PH
#define DOUBLE_PH -1
#endif
#define REP(k) for (int rep_ = 0; rep_ < ((DOUBLE_PH == (k)) ? 2 : 1); ++rep_)
#define REPBAR(k) do { if (DOUBLE_PH == (k) && rep_ == 0) xcd_barrier(bar); } while (0)
#ifndef PROBE_I
#define PROBE_I -1
#endif
#ifndef PROBE_J
#define PROBE_J -1
#endif
#ifndef DBG_PLAIN
#define DBG_PLAIN 0
#endif
#ifndef GALIGN
#define GALIGN true
#endif
#ifndef GSP2
#define GSP2 true
#endif
struct Args { const float* in[18]; float* out; unsigned char* ws; int ph_lo, ph_hi; };
__global__ void __launch_bounds__(NWAVES * 64, 2) fwd(Args args) {
    extern __shared__ __attribute__((aligned(16))) unsigned char lds_raw[];
    LAS unsigned char* lds = (LAS unsigned char*)lds_raw;
    volatile LAS unsigned* MISC = (volatile LAS unsigned*)(lds + MISC_OFF);
    const int tid = threadIdx.x, lane = tid & 63, wave = __builtin_amdgcn_readfirstlane(tid >> 6);
    const int G = gridDim.x; const int bx = blockIdx.x; const int vcu = (G % 8 == 0) ? (bx % 8) * (G / 8) + bx / 8 : bx;
    unsigned char* ws = args.ws;
    const float *x = args.in[0], *c = args.in[1], *w_ada = args.in[2], *b_ada = args.in[3], *g_mix = args.in[4], *w_in = args.in[5], *b_gate = args.in[6], *w_f = args.in[7], *w_conv = args.in[8],
                *w_co = args.in[9], *w_o = args.in[10], *g_moe = args.in[11], *w_r = args.in[12], *b_r = args.in[13], *w_g = args.in[14], *w_u = args.in[15], *w_d = args.in[16], *g_fin = args.in[17];
    float* out = args.out;
    float *modp = (float*)(ws + WS_MODP), *mod = (float*)(ws + WS_MOD), *probs = (float*)(ws + WS_PROBS), *val = (float*)(ws + WS_VAL);
    int *slot = (int*)(ws + WS_SLOT), *idx = (int*)(ws + WS_IDX);
    bf16 *Fc1 = (bf16*)(ws + WS_FC1), *Fc2 = (bf16*)(ws + WS_FC2), *WIN = (bf16*)(ws + WS_WIN), *WF = (bf16*)(ws + WS_WF), *WCO = (bf16*)(ws + WS_WCO), *WO = (bf16*)(ws + WS_WO), *WGU = (bf16*)(ws + WS_WGU), *WD = (bf16*)(ws + WS_WD);
    bf16 *H1 = (bf16*)(ws + WS_H1), *AB = (bf16*)(ws + WS_AB), *UF = (bf16*)(ws + WS_UF), *CV = (bf16*)(ws + WS_CV), *BG = (bf16*)(ws + WS_BG), *GA = (bf16*)(ws + WS_GA), *GB = (bf16*)(ws + WS_GB), *ZF = (bf16*)(ws + WS_ZF),
         *TZ = (bf16*)(ws + WS_TZ), *H2 = (bf16*)(ws + WS_H2), *HM = (bf16*)(ws + WS_HM), *Y = (bf16*)(ws + WS_Y), *X1B = (bf16*)(ws + WS_X1B);
    unsigned char *WGU8 = ws + WS_WGU, *WD8 = ws + WS_WD, *H2F8 = ws + WS_H2, *HM8 = ws + WS_HM;
    for (int u = tid; u < (LDS_BYTES - MISC_OFF) / 4; u += NWAVES * 64) ((LAS unsigned*)(lds + MISC_OFF))[u] = 0u;
    __syncthreads();
    const int lo = args.ph_lo, hi = args.ph_hi;
    XcdBarrier bar; bar.bar = (unsigned*)(ws + WS_CTL) + CW_BAR; bar.x = 0; bar.st = nullptr;
    if (hi - lo > 1) bar = xcd_barrier_post((unsigned*)(ws + WS_CTL) + CW_BAR, MISC + 8);
#define IN(k) (lo <= (k) && (k) < hi)
#if PROBE_I >= 0
    unsigned long long* tsb = (unsigned long long*)(ws + WS_CTL + 512 * 1024);
    if (bx == 0 && tid == 0) tsb[0] = __builtin_amdgcn_s_memrealtime();
#define GRID_BAR(k) do { if (IN(k) && IN((k) + 1)) xcd_barrier(bar); if (bx == 0 && tid == 0) tsb[(k) + 1] = __builtin_amdgcn_s_memrealtime(); } while (0)
#else
#define GRID_BAR(k) do { if (IN(k) && IN((k) + 1)) xcd_barrier(bar); } while (0)
#endif
    const int gw = vcu * NWAVES + wave, NGW = G * NWAVES;
    LAS float* scr = (LAS float*)(lds + wave * 16384);

    if (IN(0)) REP(0) {
        if (vcu < 96) { mod_item(c, w_ada, modp, lds, vcu, tid, wave, lane);
            if (tid == 0) { __builtin_amdgcn_fence(__ATOMIC_RELEASE, "agent"); asm volatile("s_waitcnt vmcnt(0)" ::: "memory");
                (void)xb_add((unsigned*)(ws + WS_CTL) + CW_MODCNT, 1u); } }
#if PROBE_I >= 0
        if (bx == 0 && tid == 0) tsb[22] = __builtin_amdgcn_s_memrealtime();
#endif
        fc_tables(Fc1, Fc2, vcu * NWAVES * 64 + tid, G * NWAVES * 64);
#if PROBE_I >= 0
        if (bx == 0 && tid == 0) tsb[23] = __builtin_amdgcn_s_memrealtime();
#endif
        constexpr int I_WF = 2048, I_IN = 16 * 176, I_SQ = 16 * 32, I_EX = 3072, NITEMS = I_WF + I_IN + 2 * I_SQ + NE * I_EX;
        if (vcu >= 96) { const int w0 = (vcu - 96) * NWAVES + wave, nw0 = (G - 96) * NWAVES;
            for (int r = w0; r < I_WF; r += nw0) wf_item(w_f, WF, r, lane); }
        for (int it = I_WF + gw; it < I_WF + I_IN + 2 * I_SQ; it += NGW) {
            int r = it - I_WF;
            if (r < I_IN) { transpose_item<1>(w_in, D, DIN, WIN, scr, r, lane); continue; } r -= I_IN;
            if (r < I_SQ) { transpose_item<0>(w_co, D, D, WCO, scr, r, lane); continue; } r -= I_SQ;
            if (r < I_SQ) { transpose_item<0>(w_o, D, D, WO, scr, r, lane); continue; } r -= I_SQ;
            break;
        }
        expert_range(w_g, w_u, w_d, WGU8, WD8, gw, EXP_P0, NGW, lane, scr);
#if PROBE_I >= 0
        asm volatile("s_waitcnt vmcnt(0)" ::: "memory"); __syncthreads(); if (bx == 0 && tid == 0) tsb[24] = __builtin_amdgcn_s_memrealtime();
#endif
        if (tid == 0) { unsigned* cnt = (unsigned*)(ws + WS_CTL) + CW_MODCNT; unsigned sp = 0u;
            while (xb_ld(cnt) < 96u) { __builtin_amdgcn_s_sleep(2); if (++sp > (1u << 22)) break; }
            __builtin_amdgcn_fence(__ATOMIC_ACQUIRE, "agent"); asm volatile("s_waitcnt vmcnt(0)" ::: "memory"); }
        __syncthreads();
        phase_h(x, g_mix, b_ada, modp, mod, H1, lds, tid, wave, lane, vcu, G);
        GRID_BAR(1);
    }
#if EXTRA_BARS > 0
    if (IN(1) && IN(2)) { for (int eb = 0; eb < EXTRA_BARS; ++eb) xcd_barrier(bar); }
#endif
    if (IN(2)) REP(2) {
#if STAGGER_US > 0
        if (bx >= 128) { const unsigned long long t0 = __builtin_amdgcn_s_memrealtime(); while (__builtin_amdgcn_s_memrealtime() - t0 < (unsigned long long)(STAGGER_US * 100)) __builtin_amdgcn_s_sleep(8); }
#endif
#if P2_GEMM_CUS > 0
        const int gcus = (G > P2_GEMM_CUS + 8) ? P2_GEMM_CUS : G - 1;
        if (bx >= gcus) {
            const int w2 = (bx - gcus) * NWAVES + wave, nw2 = (G - gcus) * NWAVES;
            expert_range(w_g, w_u, w_d, WGU8, WD8, EXP_P0 + EXP_P6 + w2, EXP_P0 + EXP_P6 + EXP_P2, nw2, lane, scr); }
        else {
        pg8::Gemm g{H1, WIN, M, DIN, D, 0, 0, nullptr, (unsigned long long*)(ws + WS_CTL + 512 * 1024), nullptr, 0}; pg8::StaticOrder S; S.init(M, DIN, gcus, bx);
        EpiInProj E{UF, CV, BG, GA, GB, b_gate};
        pg8::gemm_phase<EpiInProj, pg8::StaticOrder, 0, GALIGN, GSP2>(lds, g, S, E); }
#else
        pg8::Gemm g{H1, WIN, M, DIN, D, 0, 0, nullptr, (unsigned long long*)(ws + WS_CTL + 512 * 1024), nullptr, 0}; pg8::StaticOrder S; S.init(M, DIN, G, bx);
#if DBG_PLAIN
        EpiPlain E{UF, DIN};
        pg8::gemm_phase<EpiPlain, pg8::StaticOrder, 0, GALIGN, GSP2>(lds, g, S, E);
#else
        EpiInProj E{UF, CV, BG, GA, GB, b_gate};
        pg8::gemm_phase<EpiInProj, pg8::StaticOrder, 0, GALIGN, GSP2>(lds, g, S, E);
#endif
        if (bx >= G / 2) { const int w2 = (bx - G / 2) * NWAVES + wave, nw2 = (G - G / 2) * NWAVES;
            expert_range(w_g, w_u, w_d, WGU8, WD8, EXP_P0 + EXP_P6 + w2, EXP_P0 + EXP_P6 + EXP_P2, nw2, lane, scr); }
#endif
        GRID_BAR(2);
    }
    if (IN(3)) REP(3) {
        if (bx & 1) phase_conv(CV, BG, w_conv, AB, wave, lane, vcu, G);
        for (int it = vcu; it < BATCH * 128; it += G) fft_item(lds, UF, ZF, Fc1, Fc2, it, wave, lane, (PROBE_I >= 340 && PROBE_I < 350) ? (unsigned long long*)(ws + WS_CTL + 512 * 1024) : nullptr);
#if PROBE_I >= 0
        __syncthreads(); if (bx == 0 && tid == 0) tsb[20] = __builtin_amdgcn_s_memrealtime();
#endif
        if (!(bx & 1)) phase_conv(CV, BG, w_conv, AB, wave, lane, vcu, G);
#if PROBE_I >= 0
        asm volatile("s_waitcnt vmcnt(0)" ::: "memory"); __syncthreads(); if (bx == 0 && tid == 0) tsb[21] = __builtin_amdgcn_s_memrealtime();
#endif
        GRID_BAR(3);
    }
    if (IN(4)) REP(4) {
#if P4_FUSED
        { pg8::Gemm g{ZF, WF, M, 2 * D, D, 0, 0, nullptr, (unsigned long long*)(ws + WS_CTL + 512 * 1024), AB, 4}; pg8::StaticOrder S; S.init(M, 2 * D, G, bx); EpiGateBoth E{TZ, GA, GB};
          pg8::gemm_phase<EpiGateBoth, pg8::StaticOrder, 3, true, true>(lds, g, S, E); }
#else
        { pg8::Gemm g{ZF, WF, M, D, D, 0, 0, nullptr, (unsigned long long*)(ws + WS_CTL + 512 * 1024), nullptr, 0}; pg8::StaticOrder S; S.init(M, D, G, bx); EpiGateMul<0> E{TZ, GA};
          pg8::gemm_phase<EpiGateMul<0>, pg8::StaticOrder, 1, true, true>(lds, g, S, E); }
        { pg8::Gemm g{AB, WCO, M, D, D, 0, 0, nullptr, (unsigned long long*)(ws + WS_CTL + 512 * 1024), nullptr, 0}; pg8::StaticOrder S; S.init(M, D, G, bx); EpiGateMul<1> E{TZ, GB};
          pg8::gemm_phase<EpiGateMul<1>, pg8::StaticOrder, 0, true, true>(lds, g, S, E); }
#endif
        GRID_BAR(4);
    }
    if (IN(5)) REP(5) {
        pg8::Gemm g{TZ, WO, M, D, D, 0, 0, nullptr, (unsigned long long*)(ws + WS_CTL + 512 * 1024), nullptr, 0}; pg8::StaticOrder S; S.init(M, D, G, bx); EpiResid E{x, X1B, mod + 2 * D};
        pg8::gemm_phase<EpiResid, pg8::StaticOrder, 0, true, true>(lds, g, S, E);
        GRID_BAR(5);
    }
    if (IN(6)) REP(6) { phase_h2(X1B, g_moe, mod, w_r, b_r, H2, H2F8, probs, lds, tid, wave, lane, vcu, G);
        if (wave >= 4) { LAS float* scr6 = (LAS float*)(lds + 81920 + (wave - 4) * 8448);
            const int w6 = vcu * 4 + (wave - 4), nw6 = G * 4; LAS float* scr = scr6;
            expert_range(w_g, w_u, w_d, WGU8, WD8, EXP_P0 + w6, EXP_P0 + EXP_P6, nw6, lane, scr); }
        __syncthreads(); GRID_BAR(6); }
    if (IN(7)) REP(7) { for (int it = vcu; it < NE * BATCH; it += G) topk_item(probs, idx, val, slot, lds, it, tid, wave, lane);
        if (vcu >= NE * BATCH) { const int w7 = (vcu - NE * BATCH) * NWAVES + wave, nw7 = (G - NE * BATCH) * NWAVES;
            expert_range(w_g, w_u, w_d, WGU8, WD8, EXP_P0 + EXP_P6 + EXP_P2 + w7, EXP_TOTAL, nw7, lane, scr); }
        GRID_BAR(7); }
    if (IN(9)) REP(9) {
#if MOE_FP8
        pg8::Gemm g{(const bf16*)H2F8, (const bf16*)WGU8, MR, 2 * DE, D / 2, 8, (size_t)2 * DE * D / 2, idx, (unsigned long long*)(ws + WS_CTL + 512 * 1024), nullptr, 0}; pg8::StaticOrder S; S.init(MR, 2 * DE, G, bx); EpiSwiGLU8 E{HM8};
        pg8::gemm_phase<EpiSwiGLU8, pg8::StaticOrder, 2, MOE_ALIGN, true, true>(lds, g, S, E);
#else
        pg8::Gemm g{H2, WGU, MR, 2 * DE, D, 8, (size_t)2 * DE * D, idx, (unsigned long long*)(ws + WS_CTL + 512 * 1024), nullptr, 0}; pg8::StaticOrder S; S.init(MR, 2 * DE, G, bx); EpiSwiGLU E{HM};
        pg8::gemm_phase<EpiSwiGLU, pg8::StaticOrder, 2, true, true>(lds, g, S, E);
#endif
        GRID_BAR(9);
    }
    if (IN(10)) REP(10) {
#if MOE_FP8
        pg8::Gemm g{(const bf16*)HM8, (const bf16*)WD8, MR, D, DE / 2, 8, (size_t)D * DE / 2, nullptr, (unsigned long long*)(ws + WS_CTL + 512 * 1024), nullptr, 0}; pg8::StaticOrder S; S.init(MR, D, G, bx); EpiRowScale E{Y, val};
        pg8::gemm_phase<EpiRowScale, pg8::StaticOrder, 0, MOE_ALIGN, true, true>(lds, g, S, E);
#else
        pg8::Gemm g{HM, WD, MR, D, DE, 8, (size_t)D * DE, nullptr, (unsigned long long*)(ws + WS_CTL + 512 * 1024), nullptr, 0}; pg8::StaticOrder S; S.init(MR, D, G, bx); EpiRowScale E{Y, val};
        pg8::gemm_phase<EpiRowScale, pg8::StaticOrder, 0, true, true>(lds, g, S, E);
#endif
#if PROBE_I >= 0
        if (bx == 0 && tid == 0) tsb[12] = __builtin_amdgcn_s_memrealtime();
#endif
        GRID_BAR(10);
    }
#if PROBE_I >= 0
    float pert = 0.f;
    if (IN(11)) { const unsigned long long a0 = __hip_atomic_load(tsb + (PROBE_I == 100 ? 0 : PROBE_I == 9 ? 8 : PROBE_I), __ATOMIC_RELAXED, __HIP_MEMORY_SCOPE_AGENT), a1 = __hip_atomic_load(tsb + (PROBE_I == 100 ? 12 : PROBE_I == 10 ? 12 : PROBE_I + 1), __ATOMIC_RELAXED, __HIP_MEMORY_SCOPE_AGENT); pert = (float)(a1 - a0) * 0.01f * (PROBE_I == 100 ? (1.0f / 64000.0f) : (1.0f / 16000.0f)); }
    if (PROBE_I == 102) { pert = 0.f; if (bx == 0 && tid == 0) tsb[14] = __builtin_amdgcn_s_memrealtime(); __syncthreads(); }
    if (PROBE_I >= 340 && PROBE_I < 344) { pert = 0.f; if (bx == 0) { const int q_ = PROBE_I - 340; const unsigned long long a0 = __hip_atomic_load(tsb + 34 + q_, __ATOMIC_RELAXED, __HIP_MEMORY_SCOPE_AGENT), a1 = __hip_atomic_load(tsb + 35 + q_, __ATOMIC_RELAXED, __HIP_MEMORY_SCOPE_AGENT); pert = (float)(a1 - a0) * 0.01f * (1.0f / 250.0f); } }
    else if ((PROBE_I >= 320 && PROBE_I < 323) || (PROBE_I >= 330 && PROBE_I < 333)) { pert = 0.f; if (bx == 0) { const int q_ = PROBE_I % 10; const unsigned long long a0 = __hip_atomic_load(tsb + 30 + q_, __ATOMIC_RELAXED, __HIP_MEMORY_SCOPE_AGENT), a1 = __hip_atomic_load(tsb + 31 + q_, __ATOMIC_RELAXED, __HIP_MEMORY_SCOPE_AGENT); pert = (float)(a1 - a0) * 0.01f * (1.0f / 250.0f); } }
    else if (PROBE_I >= 310 && PROBE_I <= 313) { pert = 0.f; if (bx == 0) { const int ia = (PROBE_I == 310 ? 0 : PROBE_I == 311 ? 22 : PROBE_I == 312 ? 23 : 24), ib = (PROBE_I == 310 ? 22 : PROBE_I == 311 ? 23 : PROBE_I == 312 ? 24 : 1);
        const unsigned long long a0 = __hip_atomic_load(tsb + ia, __ATOMIC_RELAXED, __HIP_MEMORY_SCOPE_AGENT), a1 = __hip_atomic_load(tsb + ib, __ATOMIC_RELAXED, __HIP_MEMORY_SCOPE_AGENT); pert = (float)(a1 - a0) * 0.01f * (1.0f / 250.0f); } }
    else if (PROBE_I == 300 || PROBE_I == 301 || PROBE_I == 302) { pert = 0.f; if (bx == 0) { const unsigned long long a0 = __hip_atomic_load(tsb + (PROBE_I == 300 ? 3 : PROBE_I == 301 ? 20 : 21), __ATOMIC_RELAXED, __HIP_MEMORY_SCOPE_AGENT), a1 = __hip_atomic_load(tsb + (PROBE_I == 300 ? 20 : PROBE_I == 301 ? 21 : 4), __ATOMIC_RELAXED, __HIP_MEMORY_SCOPE_AGENT); pert = (float)(a1 - a0) * 0.01f * (1.0f / 250.0f); } }
    else if (PROBE_I >= 200) { pert = 0.f; if (bx == 0) { const int k_ = PROBE_I - 200; const unsigned long long a0 = __hip_atomic_load(tsb + (k_ == 9 ? 8 : k_), __ATOMIC_RELAXED, __HIP_MEMORY_SCOPE_AGENT), a1 = __hip_atomic_load(tsb + k_ + 1, __ATOMIC_RELAXED, __HIP_MEMORY_SCOPE_AGENT); pert = (float)(a1 - a0) * 0.01f * (1.0f / 250.0f); } }
    if (PROBE_I == 101) { pert = 0.f; if (bx == 0) { const unsigned long long a0 = __hip_atomic_load(tsb + 12, __ATOMIC_RELAXED, __HIP_MEMORY_SCOPE_AGENT); pert = (float)(__builtin_amdgcn_s_memrealtime() - a0) * 0.01f * (1.0f / 250.0f); } }
    if (IN(11)) phase_final(out, X1B, Y, slot, mod, g_fin, wave, lane, vcu, G, pert);
    if (PROBE_I == 102) {
        const unsigned long long t_a = tsb[14];
        xcd_barrier(bar);
        if (bx == 0) { const float pp = (float)(__builtin_amdgcn_s_memrealtime() - t_a) * 0.01f * (1.0f / 250.0f);
            for (int k = 0; k < 4; ++k) for (int r = 0; r < 2; ++r) { float* row = out + (size_t)(2 * (vcu * NWAVES + wave) + r + 4096 * k) * D; for (int cc = lane; cc < D; cc += 64) row[cc] += pp; } } }
#else
    if (IN(11)) REP(11) { phase_final(out, X1B, Y, slot, mod, g_fin, wave, lane, vcu, G, 0.f); if (DOUBLE_PH == 11 && rep_ == 0) xcd_barrier(bar); }
#endif

#undef IN
#undef GRID_BAR
}


struct DumpArgs { const unsigned short* p[8]; unsigned long long n[8]; int f32[8]; int nb; int pad; };
__global__ void k_dump(float* out, DumpArgs a) {
    const size_t i = (size_t)blockIdx.x * blockDim.x + threadIdx.x; float s = 0.f;
    for (int b = 0; b < a.nb; ++b) for (size_t j = i; j < a.n[b]; j += (size_t)M * D) s += (a.f32[b] ? ((const float*)a.p[b])[j] : __uint_as_float(((unsigned)a.p[b][j]) << 16)) * (float)(b + 1);
    out[i] = s;
}
#ifndef DUMP_WHICH
#define DUMP_WHICH -1
#endif
#ifndef STOP_AFTER
#define STOP_AFTER (NPHASE - 1)
#endif
#ifndef MK_PER_PHASE
#define MK_PER_PHASE 0
#endif
extern "C" void kernel_launch(void* const* d_in, const int* in_sizes, int n_in, void* d_out, int out_size, void* d_ws, size_t ws_size, hipStream_t stream) {
    static int grid = 0;
    if (grid == 0) {
        if (n_in != 18 || in_sizes[0] != M * D || out_size != M * D || ws_size < WS_END) { fprintf(stderr, "kernel_launch: unexpected shapes (n_in %d, in0 %d, out %d, ws %zu); nothing launched\n", n_in, n_in > 0 ? in_sizes[0] : -1, out_size, ws_size); grid = -1; return; }
        int dev = 0, cus = 0, per_cu = 0;
        if (hipGetDevice(&dev) != hipSuccess || hipDeviceGetAttribute(&cus, hipDeviceAttributeMultiprocessorCount, dev) != hipSuccess) { grid = -1; return; }
        if (hipFuncSetAttribute((const void*)fwd, hipFuncAttributeMaxDynamicSharedMemorySize, LDS_BYTES) != hipSuccess) { fprintf(stderr, "kernel_launch: hipFuncSetAttribute failed\n"); grid = -1; return; }
        if (hipOccupancyMaxActiveBlocksPerMultiprocessor(&per_cu, (const void*)fwd, NWAVES * 64, LDS_BYTES) != hipSuccess || per_cu < 1) { fprintf(stderr, "kernel_launch: occupancy query reports %d blocks per CU\n", per_cu); }
        (void)hipGetLastError();
        grid = cus;
    }
    if (grid < 0) return;
    (void)hipMemsetAsync((char*)d_ws + WS_CTL, 0, CTL_ZERO_BYTES, stream);
    Args a{};
    for (int i = 0; i < 18; ++i) a.in[i] = (const float*)d_in[i];
    a.out = (float*)d_out; a.ws = (unsigned char*)d_ws;
#if MK_PER_PHASE
    for (int p = 0; p < STOP_AFTER + 1; ++p) { a.ph_lo = p; a.ph_hi = p + 1; hipLaunchKernelGGL(fwd, dim3(grid), dim3(NWAVES * 64), LDS_BYTES, stream, a); }
#if DUMP_WHICH >= 0
    { DumpArgs da{}; unsigned char* w = (unsigned char*)d_ws; int nb = 0;
      auto add = [&](size_t off, size_t n, int isf = 0) { da.p[nb] = (const unsigned short*)(w + off); da.n[nb] = n; da.f32[nb] = isf; ++nb; };
      if (DUMP_WHICH == 0) { add(WS_WIN, (size_t)DIN * D); add(WS_WF, (size_t)D * D); add(WS_WCO, (size_t)D * D); add(WS_WO, (size_t)D * D); add(WS_WGU, (size_t)NE * 4096 * D); add(WS_WD, (size_t)NE * D * DE); add(WS_FC1, 8192 + 0); add(WS_MODP, 4 * 2 * 6 * D, 1); }
      if (DUMP_WHICH == 1) { add(WS_H1, (size_t)M * D); add(WS_MOD, 2 * 6 * D, 1); add(WS_FC2, 65536); }
      if (DUMP_WHICH == 2) { add(WS_UF, (size_t)M * DF); add(WS_CV, (size_t)M * D); add(WS_BG, (size_t)M * D); add(WS_GA, (size_t)M * D); add(WS_GB, (size_t)M * D); }
      if (DUMP_WHICH == 5) { add(WS_UF, (size_t)M * DIN); }
      if (DUMP_WHICH == 6) { add(WS_UF, (size_t)M * DF); add(WS_CV, (size_t)M * D); }
      if (DUMP_WHICH == 7) { add(WS_BG, (size_t)M * D); }
      if (DUMP_WHICH == 8) { add(WS_GA, (size_t)M * D); add(WS_GB, (size_t)M * D); }
      if (DUMP_WHICH == 9) { add(WS_GA, (size_t)M * D); }
      if (DUMP_WHICH == 10) { add(WS_GB, (size_t)M * D); }
      if (DUMP_WHICH == 3) { add(WS_ZF, (size_t)M * D); add(WS_AB, (size_t)M * D); }
      if (DUMP_WHICH == 4) { add(WS_TZ, (size_t)M * D); }
      da.nb = nb; hipLaunchKernelGGL(k_dump, dim3(M * D / 256), dim3(256), 0, stream, (float*)d_out, da); }
#endif
#else
    a.ph_lo = 0; a.ph_hi = NPHASE; hipLaunchKernelGGL(fwd, dim3(grid), dim3(NWAVES * 64), LDS_BYTES, stream, a);
#endif
}
```

```cpp
#include <hip/hip_runtime.h>
#include <cstdio>
#include <cstdint>
#define MK_PER_PHASE 0
#define STOP_AFTER 11
#define DUMP_WHICH -1
#define GALIGN true
#define GSP2 true
#define DBG_PLAIN 0
#define DBG_NOBIAS 0
#define DBG_NOSIG 0
#define PROBE_I -1
#define PROBE_J -1
#define DOUBLE_PH -1
#define STAGGER_US 0
#define EXTRA_BARS 0
#define DBG_EPI2 0
#ifndef PROBE_I
#define PROBE_I -1
#endif
#ifndef DBG_EPI2
#define DBG_EPI2 0
#endif
namespace pg8 {
#define PG8_LAS __attribute__((address_space(3)))
typedef unsigned short bf16_t;
typedef short bf16x8 __attribute__((ext_vector_type(8)));
typedef float f32x4 __attribute__((ext_vector_type(4)));
typedef unsigned u32x4 __attribute__((ext_vector_type(4)));
typedef unsigned u32x2 __attribute__((ext_vector_type(2)));
typedef int v8i __attribute__((ext_vector_type(8)));
typedef int v4i __attribute__((ext_vector_type(4)));
constexpr int BM = 256, BK = 64, HALF = 128, HTB = HALF * BK * 2  , STAGE_BYTES = 8 * HTB, NXCD = 8, WGM = 8;

__host__ __device__ __forceinline__ int lds_byte(int r, int c) { const int st = (r >> 4) * 2 + (c >> 5), rr = r & 15, cc = c & 31, ob = rr * 64 + cc * 2; return st * 1024 + (ob ^ (((ob >> 9) & 1) << 5)); }
__host__ __device__ __forceinline__ void stage_rc(int b, int& R, int& C) { const int st = b / 1024, sb = b % 1024, swz = sb ^ (((sb >> 9) & 1) << 5); R = (st >> 1) * 16 + swz / 64; C = (st & 1) * 32 + (swz % 64) / 2; }
__host__ __device__ __forceinline__ int perm32(int rho) { const int n = rho >> 4, i = rho & 15; return 8 * (i >> 2) + 4 * n + (i & 3); }

struct Unit { int pm, pn; };
struct Gemm { const bf16_t* A; const bf16_t* Bt; int M, N, K; int bgrp; size_t bstride; const int* gidx; unsigned long long* ts; const bf16_t* A2; int asplit; };

struct StaticOrder {
    int nM, nN, nwg, G, c;
    __host__ __device__ void init(int M, int N, int G_, int c_) { nM = M / BM; nN = N / BM; nwg = nM * nN; G = G_; c = c_; }
    __host__ __device__ bool next(int i, Unit& u) const {
        const long L = (long)i * G + c; if (L >= nwg) return false;
        int wgid = (int)L; { const int q = nwg / NXCD, r = nwg % NXCD, xcd = wgid % NXCD, off = wgid / NXCD; wgid = (xcd < r ? xcd * (q + 1) : r * (q + 1) + (xcd - r) * q) + off; }
        const int nig = WGM * nN, gid = wgid / nig, fm = gid * WGM, gsz = (nM - fm) < WGM ? (nM - fm) : WGM;
        u.pm = fm + ((wgid % nig) % gsz); u.pn = (wgid % nig) / gsz; return true;
    }
    __device__ __forceinline__ void a_ready(const Unit&) const {}
    __device__ __forceinline__ void done(const Unit&) const {}
};

typedef __bf16 bf16x2_t __attribute__((ext_vector_type(2)));
typedef float f32x2_t __attribute__((ext_vector_type(2)));
__device__ __forceinline__ unsigned cvt_pk_bf16(float lo, float hi) { const f32x2_t v = {lo, hi}; const bf16x2_t b = __builtin_convertvector(v, bf16x2_t); return __builtin_bit_cast(unsigned, b); }
__device__ __forceinline__ float bf_lo(unsigned w) { return __uint_as_float(w << 16); }
__device__ __forceinline__ float bf_hi(unsigned w) { return __uint_as_float(w & 0xffff0000u); }
__device__ __forceinline__ float sigm(float v) { return __builtin_amdgcn_rcpf(1.0f + __expf(-v)); }


template <class Epi, class Sched, int AMODE, bool ALIGN_EPI, bool SP2, bool F8 = false>
__device__ __forceinline__ void gemm_phase(PG8_LAS unsigned char* lds, const Gemm g, const Sched& S, const Epi& E) {
    const int tid = threadIdx.x, wid = __builtin_amdgcn_readfirstlane(tid >> 6), lane = tid & 63, wr = wid >> 2, wc = wid & 3, fr = lane & 15, fq = lane >> 4;
    const int K = g.K, nt = K / BK;
    unsigned voffA0[2], voffA1[2], voffB[2]; int gR[2], gC2[2];
#pragma unroll
    for (int i = 0; i < 2; ++i) { int R, C; stage_rc(tid * 16 + i * 8192, R, C); const int Rb = Epi::PERM ? ((R & ~31) + perm32(R & 31)) : R;
        voffB[i] = (unsigned)(Rb * K + C) * 2u; gR[i] = R; gC2[i] = C * 2;
        if (AMODE == 0) { voffA0[i] = (unsigned)(R * K + C) * 2u; voffA1[i] = (unsigned)((R + HALF) * K + C) * 2u; }
        else if (AMODE == 1) { voffA0[i] = (unsigned)((C >> 3) * 8192 + R) * 16u; voffA1[i] = voffA0[i] + (unsigned)HALF * 16u; }
        else if (AMODE == 3) { voffA0[i] = (unsigned)((C >> 3) * 8192 + R) * 16u; voffA1[i] = voffA0[i] + (unsigned)HALF * 16u; }
        else { voffA0[i] = 0u; voffA1[i] = 0u; } }
    const size_t kstepB = (size_t)(BK * 2);
    size_t kstepA = (AMODE == 1 || AMODE == 3) ? (size_t)8 * 8192 * 16 : (size_t)(BK * 2), kstepAN = kstepA;
    unsigned vrm0[2] = {0u, 0u}, vrm1[2] = {0u, 0u}, vbl0[2] = {0u, 0u}, vbl1[2] = {0u, 0u};
    if (AMODE == 3) {
#pragma unroll
        for (int i = 0; i < 2; ++i) { vbl0[i] = voffA0[i]; vbl1[i] = voffA1[i]; vrm0[i] = (unsigned)(gR[i] * K) * 2u + (unsigned)gC2[i]; vrm1[i] = (unsigned)((gR[i] + HALF) * K) * 2u + (unsigned)gC2[i]; } }
    int nidx0[2] = {0, 0}, nidx1[2] = {0, 0}; unsigned voffN0[2] = {0u, 0u}, voffN1[2] = {0u, 0u};
#define PG8_GIDX_LOAD(u) do { if (AMODE == 2) { _Pragma("unroll") for (int _i = 0; _i < 2; ++_i) { \
        const int* _p0 = g.gidx + (size_t)(u).pm * BM + gR[_i]; const int* _p1 = _p0 + HALF; \
        asm volatile("global_load_dword %0, %1, off" : "=v"(nidx0[_i]) : "v"(_p0) : "memory"); asm volatile("global_load_dword %0, %1, off" : "=v"(nidx1[_i]) : "v"(_p1) : "memory"); } } } while (0)
#define PG8_GIDX_USE() do { if (AMODE == 2) { _Pragma("unroll") for (int _i = 0; _i < 2; ++_i) { asm volatile("" : "+v"(nidx0[_i]), "+v"(nidx1[_i])); \
        voffN0[_i] = (unsigned)nidx0[_i] * (unsigned)(K * 2) + (unsigned)gC2[_i]; voffN1[_i] = (unsigned)nidx1[_i] * (unsigned)(K * 2) + (unsigned)gC2[_i]; } } } while (0)
    const size_t hstepB = (size_t)HALF * K * 2;
    const size_t tstepB = 2 * hstepB;
    const unsigned ldsw = (unsigned)wid * 1024u;
    const int aoff = lds_byte(wr * 64 + fr, fq * 8), boff = lds_byte(wc * 32 + fr, fq * 8);
    const int aoff8a = lds_byte(wr * 64 + fr, fq * 16), boff8a = lds_byte(wc * 32 + fr, fq * 16);
#define PG8_BLK3(u) ((u).pn < g.asplit)
#define PG8_ABASE(u) ((AMODE == 3) ? (PG8_BLK3(u) ? (const char*)g.A + (size_t)((u).pm >> 5) * ((size_t)(K >> 3) * 8192 * 16) + (size_t)((u).pm & 31) * (BM * 16) : (const char*)g.A2 + (size_t)(u).pm * (size_t)BM * K * 2) : (const char*)g.A + ((AMODE == 2) ? (size_t)0 : (AMODE == 0) ? (size_t)(u).pm * (size_t)BM * K * 2 : (size_t)((u).pm >> 5) * ((size_t)(K >> 3) * 8192 * 16) + (size_t)((u).pm & 31) * (BM * 16)))
#define PG8_BBASE(u) ((const char*)g.Bt + (g.bgrp ? (size_t)((u).pm / g.bgrp) * g.bstride * 2 : (size_t)0) + (size_t)(u).pn * tstepB)
#define PG8_SA(b, h) (((b) * 2 + (h)) * HTB)
#define PG8_SB(b, h) ((4 + (b) * 2 + (h)) * HTB)
#define PG8_STAGE(bufoff, gbase, voff) do { _Pragma("unroll") for (int _i = 0; _i < 2; ++_i) \
        __builtin_amdgcn_global_load_lds((const unsigned*)((const char*)(gbase) + (voff)[_i]), (PG8_LAS unsigned*)(lds + (bufoff) + ldsw + _i * 8192), 16, 0, 0); } while (0)
#define PG8_LDA16(dst, b, h) do { _Pragma("unroll") for (int m = 0; m < 4; ++m) _Pragma("unroll") for (int k = 0; k < 2; ++k) dst[m][k] = *(const PG8_LAS bf16x8*)(lds + PG8_SA(b, h) + aoff + m * 2048 + k * 1024); } while (0)
#define PG8_LDB16(dst, b, h) do { _Pragma("unroll") for (int n = 0; n < 2; ++n) _Pragma("unroll") for (int k = 0; k < 2; ++k) dst[n][k] = *(const PG8_LAS bf16x8*)(lds + PG8_SB(b, h) + boff + n * 2048 + k * 1024); } while (0)
#define PG8_MMA16(ai, bj, At, Bt) do { __builtin_amdgcn_s_setprio(1); _Pragma("unroll") for (int m = 0; m < 4; ++m) _Pragma("unroll") for (int n = 0; n < 2; ++n) _Pragma("unroll") for (int k = 0; k < 2; ++k) \
        acc[ai][bj][m][n] = __builtin_amdgcn_mfma_f32_16x16x32_bf16(Bt[n][k], At[m][k], acc[ai][bj][m][n], 0, 0, 0); __builtin_amdgcn_s_setprio(0); } while (0)
#define PG8_LDA8(dst, b, h) do { _Pragma("unroll") for (int m = 0; m < 4; ++m) { const v4i lo_ = *(const PG8_LAS v4i*)(lds + PG8_SA(b, h) + aoff8a + m * 2048), hi_ = *(const PG8_LAS v4i*)(lds + PG8_SA(b, h) + aoff8a + m * 2048 + 16); \
        dst[m] = (v8i){lo_.x, lo_.y, lo_.z, lo_.w, hi_.x, hi_.y, hi_.z, hi_.w}; } } while (0)
#define PG8_LDB8(dst, b, h) do { _Pragma("unroll") for (int n = 0; n < 2; ++n) { const v4i lo_ = *(const PG8_LAS v4i*)(lds + PG8_SB(b, h) + boff8a + n * 2048), hi_ = *(const PG8_LAS v4i*)(lds + PG8_SB(b, h) + boff8a + n * 2048 + 16); \
        dst[n] = (v8i){lo_.x, lo_.y, lo_.z, lo_.w, hi_.x, hi_.y, hi_.z, hi_.w}; } } while (0)
#define PG8_MMA8(ai, bj, At, Bt) do { __builtin_amdgcn_s_setprio(1); _Pragma("unroll") for (int m = 0; m < 4; ++m) _Pragma("unroll") for (int n = 0; n < 2; ++n) \
        asm volatile("v_mfma_scale_f32_16x16x128_f8f6f4 %0, %1, %2, %0, %3, %3 op_sel:[0,1,0] op_sel_hi:[0,0,0]" : "+v"(acc[ai][bj][m][n]) : "v"(Bt[n]), "v"(At[m]), "v"(f8scale)); __builtin_amdgcn_s_setprio(0); } while (0)
#define PG8_LDA(dst, b, h) do { if constexpr (F8) PG8_LDA8(dst##8, b, h); else PG8_LDA16(dst, b, h); } while (0)
#define PG8_LDB(dst, b, h) do { if constexpr (F8) PG8_LDB8(dst##8, b, h); else PG8_LDB16(dst, b, h); } while (0)
#define PG8_MMA(ai, bj, At, Bt) do { if constexpr (F8) PG8_MMA8(ai, bj, At##8, Bt##8); else PG8_MMA16(ai, bj, At, Bt); } while (0)
#define PG8_WAIT_V(n) asm volatile("s_waitcnt vmcnt(" #n ")" ::: "memory")
#define PG8_WAIT_VE() do { if (epi_st == 0) PG8_WAIT_V(8); else if (epi_st == 8) PG8_WAIT_V(16); else if (epi_st == 16) PG8_WAIT_V(24); else PG8_WAIT_V(40); } while (0)
#define PG8_WAIT_L(n) asm volatile("s_waitcnt lgkmcnt(" #n ")" ::: "memory")
#define PG8_BAR __builtin_amdgcn_s_barrier()
#define PG8_SCHED __builtin_amdgcn_sched_barrier(0)
    Unit cur, nxt; int ui = 0; int epi_st = 0;
    if (!S.next(0, cur)) return;
    f32x4 acc[2][2][4][2];
#pragma unroll
    for (int a = 0; a < 2; ++a)
#pragma unroll
        for (int b = 0; b < 2; ++b)
#pragma unroll
            for (int m = 0; m < 4; ++m)
#pragma unroll
                for (int n = 0; n < 2; ++n) acc[a][b][m][n] = (f32x4){0.f, 0.f, 0.f, 0.f};
    bf16x8 At[4][2], B0[2][2], B1[2][2]; v8i At8[4], B08[2], B18[2]; int f8scale = 0x7f7f7f78; asm volatile("" : "+v"(f8scale));
    const char* cA = PG8_ABASE(cur); const char* cB = PG8_BBASE(cur);
    S.a_ready(cur);
    if (AMODE == 3) { const bool blk = PG8_BLK3(cur); kstepA = blk ? (size_t)8 * 8192 * 16 : (size_t)(BK * 2);
#pragma unroll
        for (int i = 0; i < 2; ++i) { voffA0[i] = blk ? vbl0[i] : vrm0[i]; voffA1[i] = blk ? vbl1[i] : vrm1[i]; } }
    if (AMODE == 2) { PG8_GIDX_LOAD(cur); asm volatile("s_waitcnt vmcnt(0)" ::: "memory"); PG8_GIDX_USE();
#pragma unroll
        for (int i = 0; i < 2; ++i) { voffA0[i] = voffN0[i]; voffA1[i] = voffN1[i]; } }
    if constexpr (SP2) {
        PG8_STAGE(PG8_SB(0, 0), cB, voffB); PG8_STAGE(PG8_SB(0, 1), cB + hstepB, voffB); PG8_STAGE(PG8_SA(0, 0), cA, voffA0); PG8_STAGE(PG8_SA(0, 1), cA, voffA1);
        if (wr == 1) PG8_BAR;
        PG8_WAIT_V(2); PG8_BAR;
        PG8_STAGE(PG8_SB(1, 0), cB + kstepB, voffB); PG8_STAGE(PG8_SA(1, 0), cA + kstepA, voffA0); PG8_STAGE(PG8_SB(1, 1), cB + hstepB + kstepB, voffB);
        PG8_WAIT_V(6); PG8_BAR;
    } else {
        PG8_STAGE(PG8_SB(0, 0), cB, voffB); PG8_STAGE(PG8_SA(0, 0), cA, voffA0); PG8_STAGE(PG8_SB(0, 1), cB + hstepB, voffB); PG8_STAGE(PG8_SA(0, 1), cA, voffA1);
        if (wr == 1) PG8_BAR;
        PG8_WAIT_V(4); PG8_BAR;
        PG8_STAGE(PG8_SB(1, 0), cB + kstepB, voffB); PG8_STAGE(PG8_SA(1, 0), cA + kstepA, voffA0); PG8_STAGE(PG8_SB(1, 1), cB + hstepB + kstepB, voffB);
        PG8_WAIT_V(6); PG8_BAR;
    }
    for (;;) {
        const bool has_next = S.next(ui + 1, nxt);
        const char* nA = has_next ? PG8_ABASE(nxt) : cA; const char* nB = has_next ? PG8_BBASE(nxt) : cB;
        if (AMODE == 3) { const bool blkn = has_next ? PG8_BLK3(nxt) : PG8_BLK3(cur); kstepAN = blkn ? (size_t)8 * 8192 * 16 : (size_t)(BK * 2);
#pragma unroll
            for (int i = 0; i < 2; ++i) { voffN0[i] = blkn ? vbl0[i] : vrm0[i]; voffN1[i] = blkn ? vbl1[i] : vrm1[i]; } }
        if (AMODE == 2) { if (has_next) PG8_GIDX_LOAD(nxt); }
#if PROBE_I >= 0
        if (Epi::STAMP && ui == 1 && blockIdx.x == 0 && threadIdx.x == 0) g.ts[30] = __builtin_amdgcn_s_memrealtime();
#endif
#pragma unroll 1
        for (int t = 0; t < nt; t += 2) {
            const bool last = (t == nt - 2);
            unsigned vS0[2], vS1[2];
            if (AMODE == 2) { if (last) { if (has_next) PG8_GIDX_USE(); else { _Pragma("unroll") for (int i = 0; i < 2; ++i) { voffN0[i] = voffA0[i]; voffN1[i] = voffA1[i]; } } } }
#pragma unroll
            for (int i = 0; i < 2; ++i) { vS0[i] = ((AMODE == 2 || AMODE == 3) && last) ? voffN0[i] : voffA0[i]; vS1[i] = ((AMODE == 2 || AMODE == 3) && last) ? voffN1[i] : voffA1[i]; }
            const char* a1 = cA + (size_t)(t + 1) * kstepA;
            const char* a2 = last ? nA : cA + (size_t)(t + 2) * kstepA; const char* b2 = last ? nB : cB + (size_t)(t + 2) * kstepB;
            const char* a3 = a2 + ((AMODE == 3 && last) ? kstepAN : kstepA); const char* b3 = b2 + kstepB;
            if (last && has_next) S.a_ready(nxt);
            if constexpr (SP2) {
            PG8_LDB(B0, 0, 0); PG8_LDB(B1, 0, 1); PG8_SCHED; PG8_LDA(At, 0, 0); PG8_STAGE(PG8_SA(1, 1), a1, voffA1);
            PG8_WAIT_VE(); PG8_WAIT_L(0); PG8_BAR; PG8_MMA(0, 0, At, B0); PG8_MMA(0, 1, At, B1); PG8_BAR; PG8_SCHED;
            PG8_LDA(At, 0, 1); PG8_STAGE(PG8_SB(0, 0), b2, voffB); PG8_STAGE(PG8_SB(0, 1), b2 + hstepB, voffB); PG8_STAGE(PG8_SA(0, 0), a2, vS0);
            PG8_WAIT_VE(); epi_st = 0; PG8_WAIT_L(0); PG8_BAR; PG8_MMA(1, 0, At, B0); PG8_MMA(1, 1, At, B1); PG8_BAR; PG8_SCHED;
            PG8_LDB(B0, 1, 0); PG8_LDB(B1, 1, 1); PG8_SCHED; PG8_LDA(At, 1, 0); PG8_STAGE(PG8_SA(0, 1), a2, vS1);
            PG8_WAIT_V(8); PG8_WAIT_L(0); PG8_BAR; PG8_MMA(0, 0, At, B0); PG8_MMA(0, 1, At, B1); PG8_BAR; PG8_SCHED;
            PG8_LDA(At, 1, 1); PG8_STAGE(PG8_SB(1, 0), b3, voffB); PG8_STAGE(PG8_SB(1, 1), b3 + hstepB, voffB); PG8_STAGE(PG8_SA(1, 0), a3, vS0);
            PG8_WAIT_V(8); PG8_WAIT_L(0); PG8_BAR; PG8_MMA(1, 0, At, B0); PG8_MMA(1, 1, At, B1); PG8_BAR; PG8_SCHED;
            } else {
            PG8_LDB(B0, 0, 0); PG8_SCHED; PG8_LDA(At, 0, 0); PG8_STAGE(PG8_SA(1, 1), a1, voffA1);
            PG8_WAIT_L(8); PG8_BAR; PG8_WAIT_L(0); PG8_MMA(0, 0, At, B0); PG8_BAR; PG8_SCHED;
            PG8_LDB(B1, 0, 1); PG8_STAGE(PG8_SB(0, 0), b2, voffB);
            PG8_BAR; PG8_WAIT_L(0); PG8_MMA(0, 1, At, B1); PG8_BAR;
            PG8_LDA(At, 0, 1); PG8_STAGE(PG8_SA(0, 0), a2, vS0);
            PG8_BAR; PG8_WAIT_L(0); PG8_MMA(1, 0, At, B0); PG8_BAR; PG8_SCHED;
            PG8_STAGE(PG8_SB(0, 1), b2 + hstepB, voffB);
            PG8_WAIT_V(6); PG8_BAR; PG8_MMA(1, 1, At, B1); PG8_BAR;
            PG8_LDB(B0, 1, 0); PG8_SCHED; PG8_LDA(At, 1, 0); PG8_STAGE(PG8_SA(0, 1), a2, vS1);
            PG8_WAIT_L(8); PG8_BAR; PG8_WAIT_L(0); PG8_MMA(0, 0, At, B0); PG8_BAR; PG8_SCHED;
            PG8_LDB(B1, 1, 1); PG8_STAGE(PG8_SB(1, 0), b3, voffB);
            PG8_BAR; PG8_WAIT_L(0); PG8_MMA(0, 1, At, B1); PG8_BAR;
            PG8_LDA(At, 1, 1); PG8_STAGE(PG8_SA(1, 0), a3, vS0);
            PG8_BAR; PG8_WAIT_L(0); PG8_MMA(1, 0, At, B0); PG8_BAR; PG8_SCHED;
            PG8_STAGE(PG8_SB(1, 1), b3 + hstepB, voffB);
            PG8_WAIT_V(6); PG8_BAR; PG8_MMA(1, 1, At, B1); PG8_BAR;
            }
        }
#if PROBE_I >= 0
        if (Epi::STAMP && ui == 1 && blockIdx.x == 0 && threadIdx.x == 0) g.ts[31] = __builtin_amdgcn_s_memrealtime();
#endif
        if constexpr (ALIGN_EPI) { if (wr == 0) PG8_BAR; }
        if constexpr (F8) asm volatile("s_nop 15\n\ts_nop 15\n\ts_nop 7" ::: "memory");
        E(acc, cur, wr, wc, fr, fq); S.done(cur);
#if DBG_EPI2
        if (Epi::EPI2) { asm volatile("" ::: "memory"); E(acc, cur, wr, wc, fr, fq); }
#endif
#if PROBE_I >= 0
        if (Epi::STAMP && ui == 1 && blockIdx.x == 0 && threadIdx.x == 0) g.ts[32] = __builtin_amdgcn_s_memrealtime();
        if (Epi::STAMP && ui == 2 && blockIdx.x == 0 && threadIdx.x == 0) g.ts[33] = __builtin_amdgcn_s_memrealtime();
#endif
        if (!has_next) break;
        epi_st = E.nst(cur);
#pragma unroll
        for (int a = 0; a < 2; ++a)
#pragma unroll
            for (int b = 0; b < 2; ++b)
#pragma unroll
                for (int m = 0; m < 4; ++m)
#pragma unroll
                    for (int n = 0; n < 2; ++n) acc[a][b][m][n] = (f32x4){0.f, 0.f, 0.f, 0.f};
        cur = nxt; cA = nA; cB = nB; ++ui;
        if (AMODE == 2 || AMODE == 3) {
#pragma unroll
            for (int i = 0; i < 2; ++i) { voffA0[i] = voffN0[i]; voffA1[i] = voffN1[i]; } }
        if (AMODE == 3) kstepA = kstepAN;
        if constexpr (ALIGN_EPI) { if (wr == 1) PG8_BAR; }
    }
    PG8_WAIT_V(0);
    if constexpr (!ALIGN_EPI) { if (wr == 0) PG8_BAR; }
    PG8_BAR;
#undef PG8_GIDX_LOAD
#undef PG8_GIDX_USE
#undef PG8_BLK3
#undef PG8_ABASE
#undef PG8_BBASE
#undef PG8_SA
#undef PG8_SB
#undef PG8_STAGE
#undef PG8_LDA
#undef PG8_LDA16
#undef PG8_LDA8
#undef PG8_LDB16
#undef PG8_LDB8
#undef PG8_MMA16
#undef PG8_MMA8
#undef PG8_LDB
#undef PG8_MMA
#undef PG8_WAIT_V
#undef PG8_WAIT_VE
#undef PG8_WAIT_L
#undef PG8_BAR
#undef PG8_SCHED
}
}
constexpr int NWAVES = 8;
constexpr int BATCH = 2, SEQ = 8192, D = 1024, M = BATCH * SEQ, DF = 512, DIN = 5632, NE = 16, CAP = 1024, DE = 2048, MR = BATCH * NE * CAP  ;
constexpr float RMS_EPS = 1e-6f;
constexpr size_t MiB = 1u << 20;
constexpr size_t WS_CTL = 0, CTL_ZERO_BYTES = 32 * 1024;
constexpr size_t WS_MODP = 1 * MiB, WS_MOD = 1 * MiB + 256 * 1024, WS_FC1 = 1 * MiB + 512 * 1024, WS_FC2 = 1 * MiB + 576 * 1024;
constexpr size_t WS_PROBS = 2 * MiB, WS_SLOT = 3 * MiB, WS_IDX = 4 * MiB, WS_VAL = 4 * MiB + 128 * 1024;
constexpr size_t WS_WIN = 8 * MiB, WS_WF = 20 * MiB, WS_WCO = 22 * MiB, WS_WO = 24 * MiB, WS_WGU = 32 * MiB, WS_WD = 160 * MiB;
constexpr size_t WS_H1 = 224 * MiB, WS_AB = 224 * MiB, WS_UF = 256 * MiB, WS_CV = 272 * MiB, WS_BG = 304 * MiB, WS_GA = 336 * MiB, WS_GB = 368 * MiB, WS_ZF = 400 * MiB, WS_TZ = 432 * MiB, WS_H2 = 464 * MiB;
#ifndef MOE_FP8
#define MOE_FP8 1
#endif
constexpr size_t WS_HM = 224 * MiB, WS_Y = 432 * MiB, WS_X1B = 400 * MiB, WS_END = 496 * MiB;
constexpr int CW_BAR = 4096;
constexpr int RING_BYTES = 131072, MISC_OFF = 143360, LDS_BYTES = 147456;
constexpr int FFT_TOFF = 65536, FFT_TPITCH = 528;

#define GAS __attribute__((address_space(1)))
#define LAS __attribute__((address_space(3)))
typedef unsigned short bf16;
typedef unsigned v4u __attribute__((ext_vector_type(4)));
typedef unsigned v2u __attribute__((ext_vector_type(2)));
typedef float f32x4 __attribute__((ext_vector_type(4)));
typedef short bf16x8 __attribute__((ext_vector_type(8)));
#define LDS_WAIT() asm volatile("s_waitcnt lgkmcnt(0)" ::: "memory")
#define VM_WAIT() asm volatile("s_waitcnt vmcnt(0)" ::: "memory")
using pg8::cvt_pk_bf16; using pg8::bf_lo; using pg8::bf_hi; using pg8::sigm;
__device__ __forceinline__ float wave_sum(float v) {
#pragma unroll
    for (int o = 1; o < 64; o <<= 1) v += __shfl_xor(v, o);
    return v;
}
__device__ __forceinline__ float silu(float v) { return v * sigm(v); }
#ifndef DBG_NOBIAS
#define DBG_NOBIAS 0
#endif
#ifndef DBG_NOSIG
#define DBG_NOSIG 0
#endif
__device__ __forceinline__ float sigx(float v) { return DBG_NOSIG ? v : sigm(v); }

#define XB_TMO      128
#define XB_XCNT(j)  (256  + 64 * (j))
#define XB_XSUB(j)  (1280 + 64 * (j))
#define XB_XGEN(j)  (2304 + 64 * (j))
#define XB_TOP      3328
#define XB_TOPGEN   3392
#define XCD_BAR_WORDS 3456
#define XB_SPIN_CAP (1u << 18)
__device__ __forceinline__ unsigned xb_ld(unsigned* p)              { return __hip_atomic_load(p, __ATOMIC_RELAXED, __HIP_MEMORY_SCOPE_AGENT); }
__device__ __forceinline__ unsigned xb_add(unsigned* p, unsigned v) { return __hip_atomic_fetch_add(p, v, __ATOMIC_RELAXED, __HIP_MEMORY_SCOPE_AGENT); }
__device__ __forceinline__ unsigned xb_xcc_id() { return (unsigned)__builtin_amdgcn_s_getreg((3 << 11) | 20) & 0xFu; }
#define XB_SPIN(cond, bar) do { unsigned _sp = 0; while (cond) { __builtin_amdgcn_s_sleep(1); \
    if ((++_sp & 255u) == 0u) { if (xb_ld(&(bar)[XB_TMO])) break; if (_sp > XB_SPIN_CAP) { atomicAdd(&(bar)[XB_TMO], 1u); break; } } } } while (0)
struct XcdBarrier { unsigned* bar; unsigned x; volatile LAS unsigned* st; };
__device__ __forceinline__ XcdBarrier xcd_barrier_post(unsigned* bar, volatile LAS unsigned* st) {
    XcdBarrier b; b.bar = bar; b.x = xb_xcc_id(); b.st = st;
    if (threadIdx.x == 0) (void)xb_add(&bar[XB_XCNT(b.x)], 1u);
    return b;
}
__device__ __forceinline__ void xcd_barrier_complete(unsigned* bar, unsigned x, unsigned& nloc, unsigned& nx) {
    const unsigned G = gridDim.x * gridDim.y * gridDim.z;
    unsigned sum, cnt, mine, sp = 0u;
    for (;;) {
        sum = 0u; cnt = 0u; mine = 0u;
#pragma unroll
        for (unsigned j = 0; j < 16; ++j) { const unsigned c = xb_ld(&bar[XB_XCNT(j)]); sum += c; cnt += (c > 0u) ? 1u : 0u; mine = (j == x) ? c : mine; }
        if (sum == G) break;
        __builtin_amdgcn_s_sleep(1);
        if ((++sp & 255u) == 0u) { if (xb_ld(&bar[XB_TMO])) break; if (sp > XB_SPIN_CAP) { atomicAdd(&bar[XB_TMO], 1u); break; } }
    }
    nloc = mine > 0u ? mine : 1u; nx = cnt > 0u ? cnt : 1u;
}
__device__ __forceinline__ void xcd_barrier(const XcdBarrier& b) {
    asm volatile("s_waitcnt vmcnt(0)" ::: "memory");
    __syncthreads();
    if (threadIdx.x == 0) {
        unsigned* bar = b.bar;
        __builtin_amdgcn_s_waitcnt(0);
        unsigned nloc = b.st[0], nx = b.st[1];
        if (nloc == 0u) { xcd_barrier_complete(bar, b.x, nloc, nx); b.st[0] = nloc; b.st[1] = nx; }
        const unsigned old = xb_add(&bar[XB_XSUB(b.x)], 1u);
        const unsigned gen = old / nloc;
        if (old + 1u == (gen + 1u) * nloc) {
            __builtin_amdgcn_fence(__ATOMIC_RELEASE, "agent");
            asm volatile("s_waitcnt vmcnt(0)" ::: "memory");
            const unsigned og = xb_add(&bar[XB_TOP], 1u);
            const unsigned tg = og / nx;
            if (og + 1u == (tg + 1u) * nx) xb_add(&bar[XB_TOPGEN], 1u);
            else XB_SPIN(xb_ld(&bar[XB_TOPGEN]) == tg, bar);
            __builtin_amdgcn_fence(__ATOMIC_ACQUIRE, "agent");
            xb_add(&bar[XB_XGEN(b.x)], 1u);
            asm volatile("s_waitcnt vmcnt(0)" ::: "memory");
        } else {
            XB_SPIN(xb_ld(&bar[XB_XGEN(b.x)]) == gen, bar);
            __builtin_amdgcn_fence(__ATOMIC_ACQUIRE, "agent");
            asm volatile("s_waitcnt vmcnt(0)" ::: "memory");
        }
    }
    __syncthreads();
}

using pg8::Unit; using pg8::u32x4; using pg8::u32x2;
__device__ __forceinline__ unsigned pk4_u8(float a, float b2, float c, float d) { return (unsigned)__builtin_rintf(a * 255.f) | ((unsigned)__builtin_rintf(b2 * 255.f) << 8) | ((unsigned)__builtin_rintf(c * 255.f) << 16) | ((unsigned)__builtin_rintf(d * 255.f) << 24); }
#ifndef ST_AHEAD
#define ST_AHEAD 0
#endif
#ifndef NT_INPROJ
#define NT_INPROJ 0
#endif
#if NT_INPROJ == 2
__device__ __forceinline__ void st_sc1(u32x4* p, u32x4 v) { asm volatile("global_store_dwordx4 %0, %1, off sc1" :: "v"(p), "v"(v) : "memory"); }
__device__ __forceinline__ void st_sc1(u32x2* p, u32x2 v) { asm volatile("global_store_dwordx2 %0, %1, off sc1" :: "v"(p), "v"(v) : "memory"); }
#define ST_NT(T, p, v) st_sc1((T*)(p), (v))
#elif NT_INPROJ
#define ST_NT(T, p, v) __builtin_nontemporal_store((v), (T*)(p))
#else
#define ST_NT(T, p, v) (*(T*)(p) = (v))
#endif
struct EpiInProj {
    static constexpr bool PERM = true, EPI2 = (DBG_EPI2 == 2), STAMP = (PROBE_I >= 320 && PROBE_I < 330);
    bf16 *UF, *CV, *BG, *GA, *GB; const float* b_gate;
    __device__ __forceinline__ int nst(const Unit& u) const { return ST_AHEAD ? ((u.pn < 2) ? 32 : 16) : 0; }
    __device__ __forceinline__ void operator()(const f32x4 (&acc)[2][2][4][2], const Unit& u, int wr, int wc, int fr, int fq) const {
        const int row0 = u.pm * 256 + wr * 64 + fr;
        if (u.pn < 2) {
            const int b = u.pm >> 5, s0 = (u.pm & 31) * 256 + wr * 64 + fr;
#pragma unroll
            for (int ai = 0; ai < 2; ++ai)
#pragma unroll
                for (int m = 0; m < 4; ++m) { const int s = s0 + ai * 128 + m * 16;
#pragma unroll
                    for (int bj = 0; bj < 2; ++bj) { const int g4 = (u.pn * 256 + bj * 128 + wc * 32 + 8 * fq) >> 2;
#pragma unroll
                        for (int n = 0; n < 2; ++n) { const f32x4 v = acc[ai][bj][m][n]; u32x2 w; w.x = cvt_pk_bf16(v[0], v[1]); w.y = cvt_pk_bf16(v[2], v[3]);
                            ST_NT(u32x2, UF + ((size_t)(b * 128 + g4 + n) * 8192 + s) * 4, w); } } }
        } else if (u.pn < 10) {
#pragma unroll
            for (int ai = 0; ai < 2; ++ai)
#pragma unroll
                for (int m = 0; m < 4; ++m) { bf16* rowp = CV + (size_t)(row0 + ai * 128 + m * 16) * D + (u.pn - 2) * 128 + wc * 16 + 4 * fq;
#pragma unroll
                    for (int bj = 0; bj < 2; ++bj) { const f32x4 v = acc[ai][bj][m][0] * acc[ai][bj][m][1]; u32x2 w; w.x = cvt_pk_bf16(v[0], v[1]); w.y = cvt_pk_bf16(v[2], v[3]);
                        ST_NT(u32x2, rowp + bj * 64, w); } }
        } else if (u.pn < 14) {
#pragma unroll
            for (int ai = 0; ai < 2; ++ai)
#pragma unroll
                for (int m = 0; m < 4; ++m) { bf16* rowp = BG + (size_t)(row0 + ai * 128 + m * 16) * D + (u.pn - 10) * 256 + wc * 32 + 8 * fq;
#pragma unroll
                    for (int bj = 0; bj < 2; ++bj) { const f32x4 v0 = acc[ai][bj][m][0], v1 = acc[ai][bj][m][1]; u32x4 w; w.x = cvt_pk_bf16(v0[0], v0[1]); w.y = cvt_pk_bf16(v0[2], v0[3]); w.z = cvt_pk_bf16(v1[0], v1[1]); w.w = cvt_pk_bf16(v1[2], v1[3]);
                        ST_NT(u32x4, rowp + bj * 128, w); } }
        } else {
            const int colg = (u.pn - 14) * 256 + wc * 32 + 8 * fq;
            bf16* O = (u.pn < 18) ? GA : GB;
            f32x4 bv[2][2];
#pragma unroll
            for (int bj = 0; bj < 2; ++bj)
#pragma unroll
                for (int n = 0; n < 2; ++n) bv[bj][n] = DBG_NOBIAS ? (f32x4){0.f, 0.f, 0.f, 0.f} : *(const f32x4*)(b_gate + colg + bj * 128 + 4 * n);
#pragma unroll
            for (int ai = 0; ai < 2; ++ai)
#pragma unroll
                for (int m = 0; m < 4; ++m) { unsigned char* rowp8 = (unsigned char*)O + (size_t)(row0 + ai * 128 + m * 16) * D + (colg & 1023);
#pragma unroll
                    for (int bj = 0; bj < 2; ++bj) { const f32x4 v0 = acc[ai][bj][m][0] + bv[bj][0], v1 = acc[ai][bj][m][1] + bv[bj][1]; u32x2 w;
                        w.x = pk4_u8(sigx(v0[0]), sigx(v0[1]), sigx(v0[2]), sigx(v0[3])); w.y = pk4_u8(sigx(v1[0]), sigx(v1[1]), sigx(v1[2]), sigx(v1[3]));
                        ST_NT(u32x2, rowp8 + bj * 128, w); } }
        }
    }
};
template <int MODE> struct EpiGateMul {
    static constexpr bool PERM = true, EPI2 = false, STAMP = false;
    bf16* O; const bf16* G;
    __device__ __forceinline__ int nst(const Unit&) const { return 0; }
    __device__ __forceinline__ void operator()(const f32x4 (&acc)[2][2][4][2], const Unit& u, int wr, int wc, int fr, int fq) const {
        const int row0 = u.pm * 256 + wr * 64 + fr, col0 = u.pn * 256 + wc * 32 + 8 * fq;
#pragma unroll
        for (int ai = 0; ai < 2; ++ai)
#pragma unroll
            for (int m = 0; m < 4; ++m) { const size_t off = (size_t)(row0 + ai * 128 + m * 16) * D + col0;
#pragma unroll
                for (int bj = 0; bj < 2; ++bj) { const u32x2 gw = __builtin_nontemporal_load((const u32x2*)((const unsigned char*)G + off + bj * 128)); const f32x4 v0 = acc[ai][bj][m][0] * (1.0f / 255.0f), v1 = acc[ai][bj][m][1] * (1.0f / 255.0f);
                    float r[8] = {(float)(gw.x & 0xffu) * v0[0], (float)((gw.x >> 8) & 0xffu) * v0[1], (float)((gw.x >> 16) & 0xffu) * v0[2], (float)(gw.x >> 24) * v0[3],
                                  (float)(gw.y & 0xffu) * v1[0], (float)((gw.y >> 8) & 0xffu) * v1[1], (float)((gw.y >> 16) & 0xffu) * v1[2], (float)(gw.y >> 24) * v1[3]};
                    if (MODE == 1) { const u32x4 ow = __builtin_nontemporal_load((const u32x4*)(O + off + bj * 128));
                        r[0] += bf_lo(ow.x); r[1] += bf_hi(ow.x); r[2] += bf_lo(ow.y); r[3] += bf_hi(ow.y); r[4] += bf_lo(ow.z); r[5] += bf_hi(ow.z); r[6] += bf_lo(ow.w); r[7] += bf_hi(ow.w); }
                    u32x4 w; w.x = cvt_pk_bf16(r[0], r[1]); w.y = cvt_pk_bf16(r[2], r[3]); w.z = cvt_pk_bf16(r[4], r[5]); w.w = cvt_pk_bf16(r[6], r[7]);
                    *(u32x4*)(O + off + bj * 128) = w; } }
    }
};
struct EpiGateBoth {
    static constexpr bool PERM = true, EPI2 = false, STAMP = false;
    bf16* O; const bf16* GAp; const bf16* GBp;
    __device__ __forceinline__ int nst(const Unit&) const { return 0; }
    __device__ __forceinline__ void operator()(const f32x4 (&acc)[2][2][4][2], const Unit& u, int wr, int wc, int fr, int fq) const {
        Unit v = u; const bool second = u.pn >= 4; v.pn = u.pn & 3;
        if (!second) { EpiGateMul<0> E{O, GAp}; E(acc, v, wr, wc, fr, fq); } else { EpiGateMul<1> E{O, GBp}; E(acc, v, wr, wc, fr, fq); }
    }
};
struct EpiResid {
    static constexpr bool PERM = true, EPI2 = (DBG_EPI2 == 5), STAMP = false;
    const float* x; bf16* X1B; const float* gate;
    __device__ __forceinline__ int nst(const Unit&) const { return 0; }
    __device__ __forceinline__ void operator()(const f32x4 (&acc)[2][2][4][2], const Unit& u, int wr, int wc, int fr, int fq) const {
        const int row0 = u.pm * 256 + wr * 64 + fr, col0 = u.pn * 256 + wc * 32 + 8 * fq, b = u.pm >> 5;
        f32x4 gv[2][2];
#pragma unroll
        for (int bj = 0; bj < 2; ++bj)
#pragma unroll
            for (int n = 0; n < 2; ++n) gv[bj][n] = *(const f32x4*)(gate + b * 6 * D + col0 + bj * 128 + 4 * n);
#pragma unroll
        for (int ai = 0; ai < 2; ++ai)
#pragma unroll
            for (int m = 0; m < 4; ++m) { const size_t off = (size_t)(row0 + ai * 128 + m * 16) * D + col0;
#pragma unroll
                for (int bj = 0; bj < 2; ++bj) { const f32x4 x0 = __builtin_nontemporal_load((const f32x4*)(x + off + bj * 128)), x1 = __builtin_nontemporal_load((const f32x4*)(x + off + bj * 128 + 4));
                    const f32x4 v0 = x0 + gv[bj][0] * acc[ai][bj][m][0], v1 = x1 + gv[bj][1] * acc[ai][bj][m][1];
                    u32x4 w; w.x = cvt_pk_bf16(v0[0], v0[1]); w.y = cvt_pk_bf16(v0[2], v0[3]); w.z = cvt_pk_bf16(v1[0], v1[1]); w.w = cvt_pk_bf16(v1[2], v1[3]);
                    *(u32x4*)(X1B + off + bj * 128) = w; }
                asm volatile("" ::: "memory"); }
    }
};
struct EpiSwiGLU {
    static constexpr bool PERM = true, EPI2 = (DBG_EPI2 == 9), STAMP = false;
    bf16* HM;
    __device__ __forceinline__ int nst(const Unit&) const { return 0; }
    __device__ __forceinline__ void operator()(const f32x4 (&acc)[2][2][4][2], const Unit& u, int wr, int wc, int fr, int fq) const {
        const int row0 = u.pm * 256 + wr * 64 + fr, col0 = u.pn * 128 + wc * 32 + 8 * fq;
#pragma unroll
        for (int ai = 0; ai < 2; ++ai)
#pragma unroll
            for (int m = 0; m < 4; ++m) { const f32x4 g0 = acc[ai][0][m][0], g1 = acc[ai][0][m][1], u0 = acc[ai][1][m][0], u1 = acc[ai][1][m][1]; u32x4 w;
                w.x = cvt_pk_bf16(silu(g0[0]) * u0[0], silu(g0[1]) * u0[1]); w.y = cvt_pk_bf16(silu(g0[2]) * u0[2], silu(g0[3]) * u0[3]);
                w.z = cvt_pk_bf16(silu(g1[0]) * u1[0], silu(g1[1]) * u1[1]); w.w = cvt_pk_bf16(silu(g1[2]) * u1[2], silu(g1[3]) * u1[3]);
                *(u32x4*)(HM + (size_t)(row0 + ai * 128 + m * 16) * DE + col0) = w; }
    }
};
typedef float f32x2v __attribute__((ext_vector_type(2)));
__device__ __forceinline__ f32x2v swiglu2(f32x2v g, f32x2v u) {
    const f32x2v e = g * (f32x2v){-1.44269504f, -1.44269504f}; f32x2v x; x.x = __builtin_amdgcn_exp2f(e.x); x.y = __builtin_amdgcn_exp2f(e.y);
    x = x + (f32x2v){1.0f, 1.0f}; f32x2v r; r.x = __builtin_amdgcn_rcpf(x.x); r.y = __builtin_amdgcn_rcpf(x.y);
    return (g * u) * r; }
__device__ __forceinline__ unsigned pk4_fp8(float a, float b2, float c, float d) { unsigned w = 0u; w = __builtin_amdgcn_cvt_pk_fp8_f32(a, b2, w, false); w = __builtin_amdgcn_cvt_pk_fp8_f32(c, d, w, true); return w; }
struct EpiSwiGLU8 {
    static constexpr bool PERM = true, EPI2 = false, STAMP = (PROBE_I >= 330 && PROBE_I < 340);
    unsigned char* HM8;
    __device__ __forceinline__ int nst(const Unit&) const { return ST_AHEAD ? 8 : 0; }
    __device__ __forceinline__ void operator()(const f32x4 (&acc)[2][2][4][2], const Unit& u, int wr, int wc, int fr, int fq) const {
        const int row0 = u.pm * 256 + wr * 64 + fr, col0 = u.pn * 128 + wc * 32 + 8 * fq;
#pragma unroll
        for (int ai = 0; ai < 2; ++ai)
#pragma unroll
            for (int m = 0; m < 4; ++m) { const f32x4 g0 = acc[ai][0][m][0], g1 = acc[ai][0][m][1], u0 = acc[ai][1][m][0], u1 = acc[ai][1][m][1]; u32x2 w;
                const f32x2v p0 = swiglu2(g0.lo, u0.lo), p1 = swiglu2(g0.hi, u0.hi), p2 = swiglu2(g1.lo, u1.lo), p3 = swiglu2(g1.hi, u1.hi);
                w.x = pk4_fp8(p0.x, p0.y, p1.x, p1.y); w.y = pk4_fp8(p2.x, p2.y, p3.x, p3.y);
                *(u32x2*)(HM8 + (size_t)(row0 + ai * 128 + m * 16) * DE + col0) = w; asm volatile("" ::: "memory"); }
    }
};
struct EpiRowScale {
    static constexpr bool PERM = true, EPI2 = (DBG_EPI2 == 10), STAMP = false;
    bf16* Y; const float* val;
    __device__ __forceinline__ int nst(const Unit&) const { return 0; }
    __device__ __forceinline__ void operator()(const f32x4 (&acc)[2][2][4][2], const Unit& u, int wr, int wc, int fr, int fq) const {
        const int row0 = u.pm * 256 + wr * 64 + fr, col0 = u.pn * 256 + wc * 32 + 8 * fq;
#pragma unroll
        for (int ai = 0; ai < 2; ++ai)
#pragma unroll
            for (int m = 0; m < 4; ++m) { const int row = row0 + ai * 128 + m * 16; const float sv = val[row];
#pragma unroll
                for (int bj = 0; bj < 2; ++bj) { const f32x4 v0 = acc[ai][bj][m][0] * sv, v1 = acc[ai][bj][m][1] * sv; u32x4 w; w.x = cvt_pk_bf16(v0[0], v0[1]); w.y = cvt_pk_bf16(v0[2], v0[3]); w.z = cvt_pk_bf16(v1[0], v1[1]); w.w = cvt_pk_bf16(v1[2], v1[3]);
                    *(u32x4*)(Y + (size_t)row * D + col0 + bj * 128) = w; } }
    }
};

struct EpiPlain {
    static constexpr bool PERM = true, EPI2 = false, STAMP = false;
    bf16* O; int ldc;
    __device__ __forceinline__ int nst(const Unit&) const { return 0; }
    __device__ __forceinline__ void operator()(const f32x4 (&acc)[2][2][4][2], const Unit& u, int wr, int wc, int fr, int fq) const {
        const int row0 = u.pm * 256 + wr * 64 + fr, col0 = u.pn * 256 + wc * 32 + 8 * fq;
#pragma unroll
        for (int ai = 0; ai < 2; ++ai)
#pragma unroll
            for (int m = 0; m < 4; ++m) { bf16* rowp = O + (size_t)(row0 + ai * 128 + m * 16) * ldc + col0;
#pragma unroll
                for (int bj = 0; bj < 2; ++bj) { const f32x4 v0 = acc[ai][bj][m][0], v1 = acc[ai][bj][m][1]; u32x4 w; w.x = cvt_pk_bf16(v0[0], v0[1]); w.y = cvt_pk_bf16(v0[2], v0[3]); w.z = cvt_pk_bf16(v1[0], v1[1]); w.w = cvt_pk_bf16(v1[2], v1[3]);
                    *(u32x4*)(rowp + bj * 128) = w; } }
    }
};
#ifndef NT_WLOAD
#define NT_WLOAD 1
#endif
__device__ __forceinline__ unsigned f2bf(float f) { unsigned u = __builtin_bit_cast(unsigned, f); return (u + 0x7fffu + ((u >> 16) & 1u)) >> 16; }
__device__ __forceinline__ unsigned pk2(float lo, float hi) { return f2bf(lo) | (f2bf(hi) << 16); }
__device__ __forceinline__ int rowmap_in(int n) {
    if (n < 512) return n;
    if (n < 1536) { const int j = n - 512; return 512 + 8 * (j >> 2) + (j & 3); }
    if (n < 2560) return 2560 + (n - 1536);
    if (n < 3584) { const int j = n - 2560; return 512 + 8 * (j >> 2) + 4 + (j & 3); }
    return n;
}
template <int MAP>
__device__ __forceinline__ void transpose_item(const float* W, int K, int N, bf16* WT, LAS float* scr, int item, int lane) {
    const int nblk = N / 32, kb = item / nblk, nb = item % nblk, k0 = 64 * kb, n0 = 32 * nb;
    { f32x4 t[8];
#pragma unroll
      for (int i = 0; i < 8; ++i) t[i] = NT_WLOAD ? __builtin_nontemporal_load((const GAS f32x4*)(W + (size_t)(k0 + 8 * i + (lane >> 3)) * N + n0 + 4 * (lane & 7))) : *(const GAS f32x4*)(W + (size_t)(k0 + 8 * i + (lane >> 3)) * N + n0 + 4 * (lane & 7));
#pragma unroll
      for (int i = 0; i < 8; ++i) { LAS float* d_ = scr + (8 * i + (lane >> 3)) * 33 + 4 * (lane & 7); d_[0] = t[i].x; d_[1] = t[i].y; d_[2] = t[i].z; d_[3] = t[i].w; } }
    LDS_WAIT(); asm volatile("" ::: "memory");
    const int c = lane & 7;
#pragma unroll
    for (int j = 0; j < 4; ++j) { const int n = (lane >> 3) + 8 * j; const LAS float* s = scr + (8 * c) * 33 + n;
        v4u o; o.x = pk2(s[0 * 33], s[1 * 33]); o.y = pk2(s[2 * 33], s[3 * 33]); o.z = pk2(s[4 * 33], s[5 * 33]); o.w = pk2(s[6 * 33], s[7 * 33]);
        const int ns = n0 + n; int row;
        if (MAP == 0) row = ns; else if (MAP == 1) row = rowmap_in(ns); else if (MAP == 2) row = 256 * (ns >> 7) + (ns & 127); else row = 256 * (ns >> 7) + 128 + (ns & 127);
        *(GAS v4u*)(WT + (size_t)row * K + k0 + 8 * c) = o; }
    LDS_WAIT(); asm volatile("" ::: "memory");
}
template <int MAP>
__device__ __forceinline__ void transpose_item8(const float* W, int K, int N, unsigned char* WT, LAS float* scr, int item, int lane) {
    const int nblk = N / 32, kb = item / nblk, nb = item % nblk, k0 = 64 * kb, n0 = 32 * nb;
    { f32x4 t[8];
#pragma unroll
      for (int i = 0; i < 8; ++i) t[i] = NT_WLOAD ? __builtin_nontemporal_load((const GAS f32x4*)(W + (size_t)(k0 + 8 * i + (lane >> 3)) * N + n0 + 4 * (lane & 7))) : *(const GAS f32x4*)(W + (size_t)(k0 + 8 * i + (lane >> 3)) * N + n0 + 4 * (lane & 7));
#pragma unroll
      for (int i = 0; i < 8; ++i) { LAS float* d_ = scr + (8 * i + (lane >> 3)) * 33 + 4 * (lane & 7); d_[0] = t[i].x; d_[1] = t[i].y; d_[2] = t[i].z; d_[3] = t[i].w; } }
    LDS_WAIT(); asm volatile("" ::: "memory");
    const int c = lane & 3;
#pragma unroll
    for (int j = 0; j < 2; ++j) { const int n = (lane >> 2) + 16 * j; const LAS float* s = scr + (16 * c) * 33 + n; unsigned o[4];
#pragma unroll
        for (int q = 0; q < 4; ++q) { unsigned w = 0u; w = __builtin_amdgcn_cvt_pk_fp8_f32(s[(4 * q) * 33] * 128.f, s[(4 * q + 1) * 33] * 128.f, w, false); w = __builtin_amdgcn_cvt_pk_fp8_f32(s[(4 * q + 2) * 33] * 128.f, s[(4 * q + 3) * 33] * 128.f, w, true); o[q] = w; }
        const int ns = n0 + n; int row;
        if (MAP == 0) row = ns; else if (MAP == 2) row = 256 * (ns >> 7) + (ns & 127); else row = 256 * (ns >> 7) + 128 + (ns & 127);
        v4u ov; ov.x = o[0]; ov.y = o[1]; ov.z = o[2]; ov.w = o[3];
        *(GAS v4u*)(WT + (size_t)row * K + k0 + 16 * c) = ov; }
    LDS_WAIT(); asm volatile("" ::: "memory");
}
#define EXPW_PARAMS const float* xw_g, const float* xw_u, const float* xw_d, unsigned char* xWGU8, unsigned char* xWD8
#define EXPW_ARGS xw_g, xw_u, xw_d, xWGU8, xWD8
__device__ __forceinline__ void exp_src(EXPW_PARAMS, int r, const float*& W, int& N, int& k0, int& n0) {
    const int e = r / 3072, q = r % 3072, t = q >> 10, it = q & 1023;
    if (t < 2) { W = (t == 0 ? xw_g : xw_u) + (size_t)e * D * DE; N = DE; } else { W = xw_d + (size_t)e * DE * D; N = D; }
    const int nblk = N / 32; k0 = 64 * (it / nblk); n0 = 32 * (it % nblk);
}
__device__ __forceinline__ void exp_load(EXPW_PARAMS, int r, int lane, f32x4 (&t)[8]) {
    const float* W; int N, k0, n0; exp_src(EXPW_ARGS, r, W, N, k0, n0);
#pragma unroll
    for (int i = 0; i < 8; ++i) t[i] = __builtin_nontemporal_load((const GAS f32x4*)(W + (size_t)(k0 + 8 * i + (lane >> 3)) * N + n0 + 4 * (lane & 7)));
}
__device__ __forceinline__ void exp_finish(EXPW_PARAMS, int r, int lane, const f32x4 (&t)[8], LAS float* scr) {
    const float* W; int N, k0, n0; exp_src(EXPW_ARGS, r, W, N, k0, n0);
    const int e = r / 3072, ty = (r % 3072) >> 10, K = (ty < 2) ? D : DE;
    unsigned char* WT = (ty < 2) ? xWGU8 + (size_t)e * 4096 * D : xWD8 + (size_t)e * D * DE;
#pragma unroll
    for (int i = 0; i < 8; ++i) { LAS float* d_ = scr + (8 * i + (lane >> 3)) * 33 + 4 * (lane & 7); d_[0] = t[i].x; d_[1] = t[i].y; d_[2] = t[i].z; d_[3] = t[i].w; }
    LDS_WAIT(); asm volatile("" ::: "memory");
    const int c = lane & 3;
#pragma unroll
    for (int j = 0; j < 2; ++j) { const int n = (lane >> 2) + 16 * j; const LAS float* s = scr + (16 * c) * 33 + n; unsigned o[4];
#pragma unroll
        for (int q = 0; q < 4; ++q) { unsigned w = 0u; w = __builtin_amdgcn_cvt_pk_fp8_f32(s[(4 * q) * 33] * 128.f, s[(4 * q + 1) * 33] * 128.f, w, false); w = __builtin_amdgcn_cvt_pk_fp8_f32(s[(4 * q + 2) * 33] * 128.f, s[(4 * q + 3) * 33] * 128.f, w, true); o[q] = w; }
        const int ns = n0 + n; const int row = (ty == 2) ? ns : 256 * (ns >> 7) + (ty == 1 ? 128 : 0) + (ns & 127);
        v4u ov; ov.x = o[0]; ov.y = o[1]; ov.z = o[2]; ov.w = o[3];
        *(GAS v4u*)(WT + (size_t)row * K + k0 + 16 * c) = ov; }
    LDS_WAIT(); asm volatile("" ::: "memory");
}
__device__ __forceinline__ void expert_range(EXPW_PARAMS, int first, int end, int stride, int lane, LAS float* scr) {
    if (first >= end) return;
    f32x4 t[8]; exp_load(EXPW_ARGS, first, lane, t);
    for (int r = first; r < end; r += stride) { f32x4 tn[8]; const int rn = r + stride; const bool more = rn < end;
        if (more) exp_load(EXPW_ARGS, rn, lane, tn);
        exp_finish(EXPW_ARGS, r, lane, t, scr);
        if (more) {
#pragma unroll
            for (int i = 0; i < 8; ++i) t[i] = tn[i]; } }
}
__device__ __forceinline__ void wf_item(const float* wf, bf16* WF_T, int item, int lane) {
    const int c = item >> 2, dblk = item & 3, g = c >> 7, j = c & 127, d0 = 256 * dblk + 4 * lane;
    f32x4 ac = {0.f, 0.f, 0.f, 0.f}, as = {0.f, 0.f, 0.f, 0.f};
    for (int m = 0; m < 128; ++m) { const f32x4 wv = *(const GAS f32x4*)(wf + (size_t)(g * 128 + m) * D + d0); const float fr = (float)((m * j) & 127) * (1.0f / 128.0f);
        const float cv = __builtin_amdgcn_cosf(fr), sv = __builtin_amdgcn_sinf(fr); ac += cv * wv; as += sv * wv; }
    const int kv = 8 * (c >> 2) + 2 * (c & 3);
#pragma unroll
    for (int i = 0; i < 4; ++i) *(GAS unsigned*)(WF_T + (size_t)(d0 + i) * D + kv) = pk2(ac[i] * (1.0f / 1024.0f), as[i] * (1.0f / 1024.0f));
}
__device__ __forceinline__ void fc_tables(bf16* Fc1, bf16* Fc2, int gtid, int gthreads) {
    for (int e = gtid; e < 8192 + 65536; e += gthreads) {
        if (e < 8192) { const int j = e & 7, ln = (e >> 3) & 63, kk = (e >> 9) & 1, mt = (e >> 10) & 3, hh = e >> 12, rho = ln & 15;
            const int s1 = 32 * kk + 8 * (ln >> 4) + j, k1 = 32 * hh + 16 * (mt & 1) + 4 * (rho & 3) + (rho >> 2);
            const float fr = (float)((k1 * s1) & 63) * (1.0f / 64.0f); Fc1[e] = (bf16)f2bf((mt >> 1) == 0 ? cospif(2.0f * fr) : -sinpif(2.0f * fr)); }
        else { const int q = e - 8192, j = q & 7, ln = (q >> 3) & 63, kk = (q >> 9) & 7, ro = (q >> 12) & 1, w = q >> 13;
            const int k2 = 16 * w + (ln & 15), kap = 32 * kk + 8 * (ln >> 4) + j, s2 = kap >> 1, ri = kap & 1;
            const float fr = (float)((k2 * s2) & 127) * (1.0f / 128.0f), cv = cospif(2.0f * fr), sv = sinpif(2.0f * fr);
            Fc2[q] = (bf16)f2bf(ro == 0 ? (ri == 0 ? cv : sv) : (ri == 0 ? -sv : cv)); }
    }
}
__device__ __forceinline__ void mod_item(const float* c, const float* w_ada, float* modp, LAS unsigned char* lds, int item, int tid, int wave, int lane) {
    const int cb = item % 24, kq = item / 24, col0 = 256 * cb + 4 * lane;
    f32x4 a0 = {0.f, 0.f, 0.f, 0.f}, a1 = {0.f, 0.f, 0.f, 0.f};
#pragma unroll
    for (int i0 = 0; i0 < 32; i0 += 16) { f32x4 wv[16];
#pragma unroll
        for (int i = 0; i < 16; ++i) wv[i] = __builtin_nontemporal_load((const GAS f32x4*)(w_ada + (size_t)(256 * kq + 32 * wave + i0 + i) * 6 * D + col0));
#pragma unroll
        for (int i = 0; i < 16; ++i) { const int d = 256 * kq + 32 * wave + i0 + i; a0 += silu(c[d]) * wv[i]; a1 += silu(c[D + d]) * wv[i]; } }
    LAS f32x4* red = (LAS f32x4*)lds;
    red[(wave * 2 + 0) * 64 + lane] = a0; red[(wave * 2 + 1) * 64 + lane] = a1;
    __syncthreads();
    { const int b = tid >> 8, cc = tid & 255; const LAS float* rf = (const LAS float*)lds; float s = 0.f;
#pragma unroll
      for (int w = 0; w < 8; ++w) s += rf[((w * 2 + b) * 64) * 4 + cc];
      modp[(size_t)(kq * 2 + b) * 6 * D + 256 * cb + cc] = s; }
    asm volatile("s_waitcnt vmcnt(0)" ::: "memory");
    __syncthreads();
}

__device__ __forceinline__ void phase_h(const float* x, const float* g_mix, const float* b_ada, const float* modp, float* mod, bf16* H1, LAS unsigned char* lds, int tid, int wave, int lane, int vcu, int G) {
    LAS float* ga = (LAS float*)lds;
    LAS float* sh = ga + 2 * D;
    { float v[8];
#pragma unroll
      for (int k = 0; k < 8; ++k) { const int i = tid + 512 * k, j = i & 2047; v[k] = b_ada[j]; }
#pragma unroll
      for (int q = 0; q < 4; ++q)
#pragma unroll
          for (int k = 0; k < 8; ++k) { const int i = tid + 512 * k, b = i >> 11, j = i & 2047; v[k] += modp[(size_t)(q * 2 + b) * 6 * D + j]; }
#pragma unroll
      for (int k = 0; k < 8; ++k) { const int i = tid + 512 * k, b = i >> 11, j = i & 2047; if (j < D) sh[b * D + j] = v[k]; else ga[b * D + j - D] = g_mix[j - D] * (1.f + v[k]); } }
    { const int i = vcu * NWAVES * 64 + tid;
      if (i < 2 * 6 * D) { const int b = i / (6 * D), j = i % (6 * D); float v = b_ada[j];
#pragma unroll
          for (int q = 0; q < 4; ++q) v += modp[(size_t)(q * 2 + b) * 6 * D + j];
          mod[i] = v; } }
    __syncthreads();
    const int gw = vcu * NWAVES + wave, NGW = G * NWAVES;
    for (int m0 = gw * 4; m0 < M; m0 += NGW * 4) { const int b = m0 >> 13;
        f32x4 v[4][4]; float s[4];
#pragma unroll
        for (int r = 0; r < 4; ++r) { const GAS f32x4* xr = (const GAS f32x4*)(x + (size_t)(m0 + r) * D) + lane;
#pragma unroll
            for (int j = 0; j < 4; ++j) v[r][j] = __builtin_nontemporal_load(xr + 64 * j); }
#pragma unroll
        for (int r = 0; r < 4; ++r) { s[r] = 0.f;
#pragma unroll
            for (int j = 0; j < 4; ++j) s[r] += (v[r][j].x * v[r][j].x + v[r][j].y * v[r][j].y) + (v[r][j].z * v[r][j].z + v[r][j].w * v[r][j].w); }
#pragma unroll
        for (int o = 1; o < 64; o <<= 1) {
#pragma unroll
            for (int r = 0; r < 4; ++r) s[r] += __shfl_xor(s[r], o); }
#pragma unroll
        for (int r = 0; r < 4; ++r) { const float rr = rsqrtf(s[r] * (1.f / D) + RMS_EPS); GAS v2u* o8 = (GAS v2u*)(H1 + (size_t)(m0 + r) * D) + lane;
#pragma unroll
            for (int j = 0; j < 4; ++j) { const f32x4 gg = *(const LAS f32x4*)(ga + b * D + 4 * lane + 256 * j), ss = *(const LAS f32x4*)(sh + b * D + 4 * lane + 256 * j); const f32x4 y = v[r][j] * rr * gg + ss;
                v2u w; w.x = cvt_pk_bf16(y.x, y.y); w.y = cvt_pk_bf16(y.z, y.w); o8[64 * j] = w; } } }
    __syncthreads();
}
__device__ __forceinline__ void phase_conv(const bf16* CV, const bf16* BG, const float* w_conv, bf16* AB, int wave, int lane, int vcu, int G) {
    const int gw = vcu * NWAVES + wave, NGW = G * NWAVES;
    for (int o = gw; o < M / 8; o += NGW) { const int r0 = 8 * o, s0 = r0 & (SEQ - 1);
#pragma unroll
        for (int hseg = 0; hseg < 2; ++hseg) { const int ch = hseg * 512 + 8 * lane; const size_t off = (size_t)r0 * D + ch;
            v4u cv[10], bg[8];
#pragma unroll
            for (int jj = 0; jj < 10; ++jj) { const bool ok = (jj == 0) ? (s0 > 0) : (jj == 9) ? (s0 + 8 < SEQ) : true; cv[jj] = (v4u){0u, 0u, 0u, 0u}; if (ok) cv[jj] = __builtin_nontemporal_load((const GAS v4u*)(CV + off + (size_t)(jj - 1) * D)); }
#pragma unroll
            for (int jj = 0; jj < 8; ++jj) bg[jj] = __builtin_nontemporal_load((const GAS v4u*)(BG + off + (size_t)jj * D));
            float w0[8], w1[8], w2[8];
#pragma unroll
            for (int q = 0; q < 2; ++q) { const f32x4 a = *(const GAS f32x4*)(w_conv + ch + 4 * q), b = *(const GAS f32x4*)(w_conv + D + ch + 4 * q), c2 = *(const GAS f32x4*)(w_conv + 2 * D + ch + 4 * q);
#pragma unroll
                for (int i2 = 0; i2 < 4; ++i2) { w0[4 * q + i2] = a[i2]; w1[4 * q + i2] = b[i2]; w2[4 * q + i2] = c2[i2]; } }
#pragma unroll
            for (int jj = 0; jj < 8; ++jj) { unsigned ow[4];
#pragma unroll
                for (int q = 0; q < 4; ++q) {
                    const float lo = bf_lo(bg[jj][q]) * (w0[2 * q] * bf_lo(cv[jj][q]) + w1[2 * q] * bf_lo(cv[jj + 1][q]) + w2[2 * q] * bf_lo(cv[jj + 2][q]));
                    const float hi = bf_hi(bg[jj][q]) * (w0[2 * q + 1] * bf_hi(cv[jj][q]) + w1[2 * q + 1] * bf_hi(cv[jj + 1][q]) + w2[2 * q + 1] * bf_hi(cv[jj + 2][q]));
                    ow[q] = cvt_pk_bf16(lo, hi); }
                v4u ov; ov.x = ow[0]; ov.y = ow[1]; ov.z = ow[2]; ov.w = ow[3];
                *(GAS v4u*)(AB + off + (size_t)jj * D) = ov; } } }
}
__device__ __forceinline__ void phase_h2(const bf16* X1B, const float* g_moe, const float* mod, const float* w_router, const float* b_router, bf16* H2, unsigned char* H2F8, float* probs,
                                         LAS unsigned char* lds, int tid, int wave, int lane, int vcu, int G) {
    LAS bf16* whi = (LAS bf16*)lds;
    LAS bf16* wlo = whi + 16384;
    LAS float* ga = (LAS float*)(lds + 65536);
    LAS float* sh = ga + 2 * D;
    for (int i = tid; i < 16384; i += NWAVES * 64) { const int j = i & 7, ln = (i >> 3) & 63, kk = i >> 9, k = 32 * kk + 8 * (ln >> 4) + j, e = ln & 15;
        const float w = w_router[k * NE + e]; const unsigned h = f2bf(w); const float wh = __uint_as_float(h << 16); whi[i] = (bf16)h; wlo[i] = (bf16)f2bf(w - wh); }
    { float a[4], b2[4], c2[4];
#pragma unroll
      for (int k = 0; k < 4; ++k) { const int i = tid + 512 * k, b = i >> 10, j = i & 1023; a[k] = mod[b * 6 * D + 3 * D + j]; b2[k] = mod[b * 6 * D + 4 * D + j]; c2[k] = g_moe[j]; }
#pragma unroll
      for (int k = 0; k < 4; ++k) { const int i = tid + 512 * k; sh[i] = a[k]; ga[i] = c2[k] * (1.f + b2[k]); } }
    __syncthreads();
    const int n = lane & 15, kq = lane >> 4;
    float br[4];
#pragma unroll
    for (int r = 0; r < 4; ++r) br[r] = b_router[4 * kq + r];
    for (int grp = wave * G + vcu; grp < M / 16; grp += NWAVES * G) { const int m0 = 16 * grp, b = m0 >> 13;
        const GAS v4u* xr = (const GAS v4u*)(X1B + (size_t)(m0 + n) * D + 8 * kq);
        v4u xf[32]; float ssq = 0.f;
#pragma unroll
        for (int kk = 0; kk < 32; ++kk) xf[kk] = __builtin_nontemporal_load(xr + 4 * kk);
#pragma unroll
        for (int kk = 0; kk < 32; ++kk) { const v4u w = xf[kk]; const float e0 = bf_lo(w.x), e1 = bf_hi(w.x), e2 = bf_lo(w.y), e3 = bf_hi(w.y), e4 = bf_lo(w.z), e5 = bf_hi(w.z), e6 = bf_lo(w.w), e7 = bf_hi(w.w);
            ssq += (e0 * e0 + e1 * e1) + (e2 * e2 + e3 * e3) + (e4 * e4 + e5 * e5) + (e6 * e6 + e7 * e7); }
#pragma unroll
        for (int kk = 0; kk < 32; ++kk) asm volatile("" : "+v"(xf[kk].x), "+v"(xf[kk].y), "+v"(xf[kk].z), "+v"(xf[kk].w));
        ssq += __shfl_xor(ssq, 16); ssq += __shfl_xor(ssq, 32);
        const float rstd = rsqrtf(ssq * (1.f / D) + RMS_EPS);
        f32x4 acc = {0.f, 0.f, 0.f, 0.f};
        GAS v4u* ho = (GAS v4u*)(H2 + (size_t)(m0 + n) * D + 8 * kq);
#pragma unroll
        for (int kk = 0; kk < 32; ++kk) { const v4u w = xf[kk]; const int col = 32 * kk + 8 * kq;
            const f32x4 g0 = *(const LAS f32x4*)(ga + b * D + col), g1 = *(const LAS f32x4*)(ga + b * D + col + 4), s0 = *(const LAS f32x4*)(sh + b * D + col), s1 = *(const LAS f32x4*)(sh + b * D + col + 4);
            float h[8] = {bf_lo(w.x) * rstd * g0.x + s0.x, bf_hi(w.x) * rstd * g0.y + s0.y, bf_lo(w.y) * rstd * g0.z + s0.z, bf_hi(w.y) * rstd * g0.w + s0.w,
                          bf_lo(w.z) * rstd * g1.x + s1.x, bf_hi(w.z) * rstd * g1.y + s1.y, bf_lo(w.w) * rstd * g1.z + s1.z, bf_hi(w.w) * rstd * g1.w + s1.w};
            v4u hh, hl;
            hh.x = cvt_pk_bf16(h[0], h[1]); hh.y = cvt_pk_bf16(h[2], h[3]); hh.z = cvt_pk_bf16(h[4], h[5]); hh.w = cvt_pk_bf16(h[6], h[7]);
            hl.x = cvt_pk_bf16(h[0] - bf_lo(hh.x), h[1] - bf_hi(hh.x)); hl.y = cvt_pk_bf16(h[2] - bf_lo(hh.y), h[3] - bf_hi(hh.y)); hl.z = cvt_pk_bf16(h[4] - bf_lo(hh.z), h[5] - bf_hi(hh.z)); hl.w = cvt_pk_bf16(h[6] - bf_lo(hh.w), h[7] - bf_hi(hh.w));
            if (MOE_FP8) { v2u q8; q8.x = pk4_fp8(h[0], h[1], h[2], h[3]); q8.y = pk4_fp8(h[4], h[5], h[6], h[7]); *(GAS v2u*)(H2F8 + (size_t)(m0 + n) * D + 32 * kk + 8 * kq) = q8; }
            else ho[4 * kk] = hh;
            const bf16x8 ah = *(const LAS bf16x8*)(whi + (kk * 64 + lane) * 8), al = *(const LAS bf16x8*)(wlo + (kk * 64 + lane) * 8);
            const bf16x8 bh = __builtin_bit_cast(bf16x8, hh), bl = __builtin_bit_cast(bf16x8, hl);
            acc = __builtin_amdgcn_mfma_f32_16x16x32_bf16(ah, bh, acc, 0, 0, 0); acc = __builtin_amdgcn_mfma_f32_16x16x32_bf16(al, bh, acc, 0, 0, 0); acc = __builtin_amdgcn_mfma_f32_16x16x32_bf16(ah, bl, acc, 0, 0, 0);
            asm volatile("" ::: "memory"); }
        float lg[4], mx = -3.0e38f;
#pragma unroll
        for (int r = 0; r < 4; ++r) { lg[r] = acc[r] + br[r]; mx = fmaxf(mx, lg[r]); }
        mx = fmaxf(mx, __shfl_xor(mx, 16)); mx = fmaxf(mx, __shfl_xor(mx, 32));
        float sum = 0.f;
#pragma unroll
        for (int r = 0; r < 4; ++r) { lg[r] = __expf(lg[r] - mx); sum += lg[r]; }
        sum += __shfl_xor(sum, 16); sum += __shfl_xor(sum, 32);
        const float inv = 1.0f / sum; const int s = (m0 + n) & (SEQ - 1);
#pragma unroll
        for (int r = 0; r < 4; ++r) probs[((size_t)(b * NE + 4 * kq + r)) * SEQ + s] = lg[r] * inv; }
}
__device__ __forceinline__ void topk_item(const float* probs, int* idx, float* val, int* slot, LAS unsigned char* lds, int item, int tid, int wave, int lane) {
    const int e = item >> 1, b = item & 1;
    LAS int* red = (LAS int*)lds;
    unsigned p[16];
#pragma unroll
    for (int q = 0; q < 4; ++q) { const v4u w = __builtin_nontemporal_load((const GAS v4u*)(probs + ((size_t)(b * NE + e)) * SEQ + 16 * tid + 4 * q)); p[4 * q] = w.x; p[4 * q + 1] = w.y; p[4 * q + 2] = w.z; p[4 * q + 3] = w.w; }
    unsigned prefix = 0u;
    for (int bit = 30; bit >= 0; --bit) { const unsigned cand = prefix | (1u << bit); int cnt = 0;
#pragma unroll
        for (int j = 0; j < 16; ++j) cnt += __popcll(__ballot(p[j] >= cand));
        const int par = bit & 1;
        if (lane == 0) red[par * 8 + wave] = cnt;
        __syncthreads();
        int tot = 0;
#pragma unroll
        for (int w = 0; w < 8; ++w) tot += red[par * 8 + w];
        if (tot >= CAP) prefix = cand; }
    const unsigned T = prefix;
    int cgt = 0, ceq = 0;
#pragma unroll
    for (int j = 0; j < 16; ++j) { cgt += (p[j] > T) ? 1 : 0; ceq += (p[j] == T) ? 1 : 0; }
    int sgt = cgt, seq = ceq;
#pragma unroll
    for (int o = 1; o < 64; o <<= 1) { const int a = __shfl_up(sgt, o), c = __shfl_up(seq, o); if (lane >= o) { sgt += a; seq += c; } }
    __syncthreads();
    if (lane == 63) { red[32 + wave] = sgt; red[48 + wave] = seq; }
    __syncthreads();
    int bgt = 0, beq = 0, totgt = 0;
#pragma unroll
    for (int w = 0; w < 8; ++w) { const int a = red[32 + w], c = red[48 + w]; if (w < wave) { bgt += a; beq += c; } totgt += a; }
    int rgt = bgt + sgt - cgt, req = beq + seq - ceq;
    const int need = CAP - totgt; const int rbase = (e * 2 + b) * CAP;
#pragma unroll
    for (int j = 0; j < 16; ++j) { const int tok = b * SEQ + 16 * tid + j; int sl = -1;
        if (p[j] > T) { sl = rgt; ++rgt; } else if (p[j] == T) { if (req < need) sl = totgt + req; ++req; }
        slot[(size_t)tok * NE + e] = sl;
        if (sl >= 0) { idx[rbase + sl] = tok; val[rbase + sl] = __uint_as_float(p[j]); } }
    __syncthreads();
}
__device__ __forceinline__ void phase_gather(const bf16* H2, const int* idx, bf16* XE, int wave, int lane, int vcu, int G) {
    const int gw = vcu * NWAVES + wave, NGW = G * NWAVES;
    for (int r = gw; r < MR; r += NGW) { const int tok = idx[r];
        const GAS v4u* src = (const GAS v4u*)(H2 + (size_t)tok * D) + lane; GAS v4u* dst = (GAS v4u*)(XE + (size_t)r * D) + lane;
        const v4u a = src[0], b2 = src[64]; dst[0] = a; dst[64] = b2; }
}
__device__ __forceinline__ void phase_final(float* out, const bf16* X1B, const bf16* Y, const int* slot, const float* mod, const float* g_fin, int wave, int lane, int vcu, int G, float pert) {
    const int gw = vcu * NWAVES + wave, NGW = G * NWAVES;
    int slv[2]; v2u xw[2][4];
#define PF_FETCH(mm) do { _Pragma("unroll") for (int r = 0; r < 2; ++r) { slv[r] = slot[(size_t)((mm) + r) * NE + (lane & 15)]; const GAS v2u* xr_ = (const GAS v2u*)(X1B + (size_t)((mm) + r) * D) + lane; \
        _Pragma("unroll") for (int j = 0; j < 4; ++j) xw[r][j] = __builtin_nontemporal_load(xr_ + 64 * j); } } while (0)
    int m0 = gw * 2;
    if (m0 < M) PF_FETCH(m0);
    for (; m0 < M; m0 += NGW * 2) { const int b = m0 >> 13;
        int cs[2]; f32x4 v[2][4], a[2][4];
#pragma unroll
        for (int r = 0; r < 2; ++r) { cs[r] = slv[r];
#pragma unroll
            for (int j = 0; j < 4; ++j) { const v2u w = xw[r][j]; v[r][j] = (f32x4){bf_lo(w.x), bf_hi(w.x), bf_lo(w.y), bf_hi(w.y)}; a[r][j] = (f32x4){0.f, 0.f, 0.f, 0.f}; } }
        const int mn = m0 + NGW * 2;
        if (mn < M) PF_FETCH(mn);
        unsigned long long mask[2]; bool more = false;
#pragma unroll
        for (int r = 0; r < 2; ++r) mask[r] = __ballot(cs[r] >= 0) & 0xFFFFull;
        do { const GAS v2u* yp[2][4]; bool ok[2][4]; v2u w[2][4][4];
#pragma unroll
            for (int r = 0; r < 2; ++r)
#pragma unroll
                for (int c = 0; c < 4; ++c) { ok[r][c] = (mask[r] != 0ull); const int e = ok[r][c] ? (int)__builtin_ctzll(mask[r]) : 0; mask[r] &= (mask[r] - 1ull);
                    const int sl = __builtin_amdgcn_readlane(cs[r], e); yp[r][c] = (const GAS v2u*)(Y + ((size_t)(e * 2 + b) * CAP + (ok[r][c] ? sl : 0)) * D) + lane; }
#pragma unroll
            for (int r = 0; r < 2; ++r)
#pragma unroll
                for (int c = 0; c < 4; ++c) if (ok[r][c]) {
#pragma unroll
                    for (int j = 0; j < 4; ++j) w[r][c][j] = __builtin_nontemporal_load(yp[r][c] + 64 * j); }
#pragma unroll
            for (int r = 0; r < 2; ++r)
#pragma unroll
                for (int c = 0; c < 4; ++c) if (ok[r][c]) {
#pragma unroll
                    for (int j = 0; j < 4; ++j) { a[r][j].x += bf_lo(w[r][c][j].x); a[r][j].y += bf_hi(w[r][c][j].x); a[r][j].z += bf_lo(w[r][c][j].y); a[r][j].w += bf_hi(w[r][c][j].y); } }
            more = (mask[0] | mask[1]) != 0ull;
        } while (more);
        float s[2];
#pragma unroll
        for (int r = 0; r < 2; ++r) { s[r] = 0.f;
#pragma unroll
            for (int j = 0; j < 4; ++j) { const f32x4 gf = *(const GAS f32x4*)(mod + b * 6 * D + 5 * D + 4 * lane + 256 * j); v[r][j] = v[r][j] + gf * a[r][j]; s[r] += (v[r][j].x * v[r][j].x + v[r][j].y * v[r][j].y) + (v[r][j].z * v[r][j].z + v[r][j].w * v[r][j].w); } }
#pragma unroll
        for (int o = 1; o < 64; o <<= 1) { s[0] += __shfl_xor(s[0], o); s[1] += __shfl_xor(s[1], o); }
#pragma unroll
        for (int r = 0; r < 2; ++r) { const float rr = rsqrtf(s[r] * (1.f / D) + RMS_EPS); GAS f32x4* xo = (GAS f32x4*)(out + (size_t)(m0 + r) * D) + lane;
#pragma unroll
            for (int j = 0; j < 4; ++j) { const f32x4 gg = *(const GAS f32x4*)(g_fin + 4 * lane + 256 * j); __builtin_nontemporal_store(v[r][j] * rr * gg + pert, xo + 64 * j); } } }
#undef PF_FETCH
}
__device__ __forceinline__ void fft_item(LAS unsigned char* lds, const bf16* UF, bf16* ZF, const bf16* Fc1, const bf16* Fc2, int item, int wave, int lane, unsigned long long* ts) {
#define FFT_STAMP(i_) do { if (ts && blockIdx.x == 0 && threadIdx.x == 0) ts[34 + (i_)] = __builtin_amdgcn_s_memrealtime(); } while (0)
    FFT_STAMP(0);
    const char* slab = (const char*)UF + (size_t)item * 65536;
    { v4u xv[8];
#pragma unroll
      for (int p = 0; p < 8; ++p) { const int s1 = 8 * p + wave; xv[p] = __builtin_nontemporal_load((const GAS v4u*)(slab + s1 * 1024 + ((16 * lane - 32 * ((s1 >> 3) & 3)) & 1023))); }
#pragma unroll
      for (int p = 0; p < 8; ++p) *(LAS v4u*)(lds + (8 * p + wave) * 1024 + 16 * lane) = xv[p]; }
    bf16x8 A2[2][8];
#pragma unroll
    for (int ro = 0; ro < 2; ++ro)
#pragma unroll
        for (int kk = 0; kk < 8; ++kk) A2[ro][kk] = *(const GAS bf16x8*)(Fc2 + ((size_t)(((wave * 2 + ro) * 8 + kk) * 64 + lane)) * 8);
    LDS_WAIT(); __syncthreads(); FFT_STAMP(1);
    const int fr = lane & 15, fq = lane >> 4, ch = lane & 3, s2l = (lane & 15) >> 2;
    char* zb = (char*)ZF + (size_t)item * 131072;
    for (int hh = 0; hh < 2; ++hh) {
        { bf16x8 A1[4][2];
#pragma unroll
          for (int mt = 0; mt < 4; ++mt)
#pragma unroll
              for (int kk = 0; kk < 2; ++kk) A1[mt][kk] = *(const GAS bf16x8*)(Fc1 + ((size_t)(((hh * 4 + mt) * 2 + kk) * 64 + lane)) * 8);
          for (int jn = 0; jn < 4; ++jn) { const int nt = wave + 8 * jn, s2 = 4 * nt + s2l;
            bf16x8 Bx[2];
#pragma unroll
            for (int kk = 0; kk < 2; ++kk)
#pragma unroll
                for (int j = 0; j < 8; ++j) { const int s1 = 32 * kk + 8 * fq + j; Bx[kk][j] = *(const LAS short*)(lds + s1 * 1024 + ((s2 * 8 + ch * 2 + 32 * fq) & 1023)); }
            f32x4 acc[4];
#pragma unroll
            for (int mt = 0; mt < 4; ++mt) { acc[mt] = (f32x4){0.f, 0.f, 0.f, 0.f};
#pragma unroll
                for (int kk = 0; kk < 2; ++kk) acc[mt] = __builtin_amdgcn_mfma_f32_16x16x32_bf16(A1[mt][kk], Bx[kk], acc[mt], 0, 0, 0); }
#pragma unroll
            for (int blk = 0; blk < 2; ++blk)
#pragma unroll
                for (int r = 0; r < 4; ++r) { const int k1l = 16 * blk + 4 * r + fq, k1 = 32 * hh + k1l; const float dr = acc[blk][r], di = acc[2 + blk][r];
                    const float frac = (float)((s2 * k1) & 8191) * (1.0f / 8192.0f), c = __builtin_amdgcn_cosf(frac), s = __builtin_amdgcn_sinf(frac);
                    *(LAS unsigned*)(lds + FFT_TOFF + (k1l * 4 + ch) * FFT_TPITCH + s2 * 4) = cvt_pk_bf16(dr * c + di * s, di * c - dr * s); } } }
        LDS_WAIT(); __syncthreads(); if (hh == 0) FFT_STAMP(2);
        for (int nt2 = 0; nt2 < 8; ++nt2) { f32x4 c0 = {0.f, 0.f, 0.f, 0.f}, c1 = {0.f, 0.f, 0.f, 0.f};
#pragma unroll
            for (int kk = 0; kk < 8; ++kk) { const bf16x8 Bt = *(const LAS bf16x8*)(lds + FFT_TOFF + (16 * nt2 + fr) * FFT_TPITCH + kk * 64 + fq * 16);
                c0 = __builtin_amdgcn_mfma_f32_16x16x32_bf16(A2[0][kk], Bt, c0, 0, 0, 0); c1 = __builtin_amdgcn_mfma_f32_16x16x32_bf16(A2[1][kk], Bt, c1, 0, 0, 0); }
            const int k1 = 32 * hh + 4 * nt2 + s2l;
#pragma unroll
            for (int r = 0; r < 4; ++r) { const int k = k1 + 64 * (16 * wave + 4 * fq + r); *(GAS unsigned*)(zb + (size_t)k * 16 + ch * 4) = cvt_pk_bf16(c0[r], c1[r]); } }
        LDS_WAIT(); __syncthreads(); if (hh == 0) FFT_STAMP(3);
    }
    FFT_STAMP(4);
#undef FFT_STAMP
}
#if MOE_FP8
#define EXPERT_ITEM(r_) do { const int e_ = (r_) / 3072, q_ = (r_) % 3072; \
    if (q_ < 1024) transpose_item8<2>(w_g + (size_t)e_ * D * DE, D, DE, WGU8 + (size_t)e_ * 4096 * D, scr, q_, lane); \
    else if (q_ < 2048) transpose_item8<3>(w_u + (size_t)e_ * D * DE, D, DE, WGU8 + (size_t)e_ * 4096 * D, scr, q_ - 1024, lane); \
    else transpose_item8<0>(w_d + (size_t)e_ * DE * D, DE, D, WD8 + (size_t)e_ * D * DE, scr, q_ - 2048, lane); } while (0)
#else
#define EXPERT_ITEM(r_) do { const int e_ = (r_) / 3072, q_ = (r_) % 3072; \
    if (q_ < 1024) transpose_item<2>(w_g + (size_t)e_ * D * DE, D, DE, WGU + (size_t)e_ * 4096 * D, scr, q_, lane); \
    else if (q_ < 2048) transpose_item<3>(w_u + (size_t)e_ * D * DE, D, DE, WGU + (size_t)e_ * 4096 * D, scr, q_ - 1024, lane); \
    else transpose_item<0>(w_d + (size_t)e_ * DE * D, DE, D, WD + (size_t)e_ * D * DE, scr, q_ - 2048, lane); } while (0)
#endif
#ifndef EXP_P2
#define EXP_P2 10240
#endif
#ifndef EXP_P7
#define EXP_P7 14336
#endif
#ifndef EXP_P6
#define EXP_P6 16384
#endif
constexpr int EXP_TOTAL = NE * 3072, EXP_P0 = EXP_TOTAL - EXP_P2 - EXP_P7 - EXP_P6;

constexpr int NPHASE = 12;
#ifndef P2_GEMM_CUS
#define P2_GEMM_CUS 235
#endif
constexpr int CW_MODCNT = 2048;
#ifndef P4_FUSED
#define P4_FUSED 0
#endif
#ifndef MOE_ALIGN
#define MOE_ALIGN true
#endif
#ifndef EXTRA_BARS
#define EXTRA_BARS 0
#endif
#ifndef STAGGER_US
#define STAGGER_US 0
#endif
#ifndef DOUBLE_PH
#define DOUBLE_PH -1
#endif
#define REP(k) for (int rep_ = 0; rep_ < ((DOUBLE_PH == (k)) ? 2 : 1); ++rep_)
#define REPBAR(k) do { if (DOUBLE_PH == (k) && rep_ == 0) xcd_barrier(bar); } while (0)
#ifndef PROBE_I
#define PROBE_I -1
#endif
#ifndef PROBE_J
#define PROBE_J -1
#endif
#ifndef DBG_PLAIN
#define DBG_PLAIN 0
#endif
#ifndef GALIGN
#define GALIGN true
#endif
#ifndef GSP2
#define GSP2 true
#endif
struct Args { const float* in[18]; float* out; unsigned char* ws; int ph_lo, ph_hi; };
__global__ void __launch_bounds__(NWAVES * 64, 2) fwd(Args args) {
    extern __shared__ __attribute__((aligned(16))) unsigned char lds_raw[];
    LAS unsigned char* lds = (LAS unsigned char*)lds_raw;
    volatile LAS unsigned* MISC = (volatile LAS unsigned*)(lds + MISC_OFF);
    const int tid = threadIdx.x, lane = tid & 63, wave = __builtin_amdgcn_readfirstlane(tid >> 6);
    const int G = gridDim.x; const int bx = blockIdx.x; const int vcu = (G % 8 == 0) ? (bx % 8) * (G / 8) + bx / 8 : bx;
    unsigned char* ws = args.ws;
    const float *x = args.in[0], *c = args.in[1], *w_ada = args.in[2], *b_ada = args.in[3], *g_mix = args.in[4], *w_in = args.in[5], *b_gate = args.in[6], *w_f = args.in[7], *w_conv = args.in[8],
                *w_co = args.in[9], *w_o = args.in[10], *g_moe = args.in[11], *w_r = args.in[12], *b_r = args.in[13], *w_g = args.in[14], *w_u = args.in[15], *w_d = args.in[16], *g_fin = args.in[17];
    float* out = args.out;
    float *modp = (float*)(ws + WS_MODP), *mod = (float*)(ws + WS_MOD), *probs = (float*)(ws + WS_PROBS), *val = (float*)(ws + WS_VAL);
    int *slot = (int*)(ws + WS_SLOT), *idx = (int*)(ws + WS_IDX);
    bf16 *Fc1 = (bf16*)(ws + WS_FC1), *Fc2 = (bf16*)(ws + WS_FC2), *WIN = (bf16*)(ws + WS_WIN), *WF = (bf16*)(ws + WS_WF), *WCO = (bf16*)(ws + WS_WCO), *WO = (bf16*)(ws + WS_WO), *WGU = (bf16*)(ws + WS_WGU), *WD = (bf16*)(ws + WS_WD);
    bf16 *H1 = (bf16*)(ws + WS_H1), *AB = (bf16*)(ws + WS_AB), *UF = (bf16*)(ws + WS_UF), *CV = (bf16*)(ws + WS_CV), *BG = (bf16*)(ws + WS_BG), *GA = (bf16*)(ws + WS_GA), *GB = (bf16*)(ws + WS_GB), *ZF = (bf16*)(ws + WS_ZF),
         *TZ = (bf16*)(ws + WS_TZ), *H2 = (bf16*)(ws + WS_H2), *HM = (bf16*)(ws + WS_HM), *Y = (bf16*)(ws + WS_Y), *X1B = (bf16*)(ws + WS_X1B);
    unsigned char *WGU8 = ws + WS_WGU, *WD8 = ws + WS_WD, *H2F8 = ws + WS_H2, *HM8 = ws + WS_HM;
    for (int u = tid; u < (LDS_BYTES - MISC_OFF) / 4; u += NWAVES * 64) ((LAS unsigned*)(lds + MISC_OFF))[u] = 0u;
    __syncthreads();
    const int lo = args.ph_lo, hi = args.ph_hi;
    XcdBarrier bar; bar.bar = (unsigned*)(ws + WS_CTL) + CW_BAR; bar.x = 0; bar.st = nullptr;
    if (hi - lo > 1) bar = xcd_barrier_post((unsigned*)(ws + WS_CTL) + CW_BAR, MISC + 8);
#define IN(k) (lo <= (k) && (k) < hi)
#if PROBE_I >= 0
    unsigned long long* tsb = (unsigned long long*)(ws + WS_CTL + 512 * 1024);
    if (bx == 0 && tid == 0) tsb[0] = __builtin_amdgcn_s_memrealtime();
#define GRID_BAR(k) do { if (IN(k) && IN((k) + 1)) xcd_barrier(bar); if (bx == 0 && tid == 0) tsb[(k) + 1] = __builtin_amdgcn_s_memrealtime(); } while (0)
#else
#define GRID_BAR(k) do { if (IN(k) && IN((k) + 1)) xcd_barrier(bar); } while (0)
#endif
    const int gw = vcu * NWAVES + wave, NGW = G * NWAVES;
    LAS float* scr = (LAS float*)(lds + wave * 16384);

    if (IN(0)) REP(0) {
        if (vcu < 96) { mod_item(c, w_ada, modp, lds, vcu, tid, wave, lane);
            if (tid == 0) { __builtin_amdgcn_fence(__ATOMIC_RELEASE, "agent"); asm volatile("s_waitcnt vmcnt(0)" ::: "memory");
                (void)xb_add((unsigned*)(ws + WS_CTL) + CW_MODCNT, 1u); } }
#if PROBE_I >= 0
        if (bx == 0 && tid == 0) tsb[22] = __builtin_amdgcn_s_memrealtime();
#endif
        fc_tables(Fc1, Fc2, vcu * NWAVES * 64 + tid, G * NWAVES * 64);
#if PROBE_I >= 0
        if (bx == 0 && tid == 0) tsb[23] = __builtin_amdgcn_s_memrealtime();
#endif
        constexpr int I_WF = 2048, I_IN = 16 * 176, I_SQ = 16 * 32, I_EX = 3072, NITEMS = I_WF + I_IN + 2 * I_SQ + NE * I_EX;
        if (vcu >= 96) { const int w0 = (vcu - 96) * NWAVES + wave, nw0 = (G - 96) * NWAVES;
            for (int r = w0; r < I_WF; r += nw0) wf_item(w_f, WF, r, lane); }
        for (int it = I_WF + gw; it < I_WF + I_IN + 2 * I_SQ; it += NGW) {
            int r = it - I_WF;
            if (r < I_IN) { transpose_item<1>(w_in, D, DIN, WIN, scr, r, lane); continue; } r -= I_IN;
            if (r < I_SQ) { transpose_item<0>(w_co, D, D, WCO, scr, r, lane); continue; } r -= I_SQ;
            if (r < I_SQ) { transpose_item<0>(w_o, D, D, WO, scr, r, lane); continue; } r -= I_SQ;
            break;
        }
        expert_range(w_g, w_u, w_d, WGU8, WD8, gw, EXP_P0, NGW, lane, scr);
#if PROBE_I >= 0
        asm volatile("s_waitcnt vmcnt(0)" ::: "memory"); __syncthreads(); if (bx == 0 && tid == 0) tsb[24] = __builtin_amdgcn_s_memrealtime();
#endif
        if (tid == 0) { unsigned* cnt = (unsigned*)(ws + WS_CTL) + CW_MODCNT; unsigned sp = 0u;
            while (xb_ld(cnt) < 96u) { __builtin_amdgcn_s_sleep(2); if (++sp > (1u << 22)) break; }
            __builtin_amdgcn_fence(__ATOMIC_ACQUIRE, "agent"); asm volatile("s_waitcnt vmcnt(0)" ::: "memory"); }
        __syncthreads();
        phase_h(x, g_mix, b_ada, modp, mod, H1, lds, tid, wave, lane, vcu, G);
        GRID_BAR(1);
    }
#if EXTRA_BARS > 0
    if (IN(1) && IN(2)) { for (int eb = 0; eb < EXTRA_BARS; ++eb) xcd_barrier(bar); }
#endif
    if (IN(2)) REP(2) {
#if STAGGER_US > 0
        if (bx >= 128) { const unsigned long long t0 = __builtin_amdgcn_s_memrealtime(); while (__builtin_amdgcn_s_memrealtime() - t0 < (unsigned long long)(STAGGER_US * 100)) __builtin_amdgcn_s_sleep(8); }
#endif
#if P2_GEMM_CUS > 0
        const int gcus = (G > P2_GEMM_CUS + 8) ? P2_GEMM_CUS : G - 1;
        if (bx >= gcus) {
            const int w2 = (bx - gcus) * NWAVES + wave, nw2 = (G - gcus) * NWAVES;
            expert_range(w_g, w_u, w_d, WGU8, WD8, EXP_P0 + EXP_P6 + w2, EXP_P0 + EXP_P6 + EXP_P2, nw2, lane, scr); }
        else {
        pg8::Gemm g{H1, WIN, M, DIN, D, 0, 0, nullptr, (unsigned long long*)(ws + WS_CTL + 512 * 1024), nullptr, 0}; pg8::StaticOrder S; S.init(M, DIN, gcus, bx);
        EpiInProj E{UF, CV, BG, GA, GB, b_gate};
        pg8::gemm_phase<EpiInProj, pg8::StaticOrder, 0, GALIGN, GSP2>(lds, g, S, E); }
#else
        pg8::Gemm g{H1, WIN, M, DIN, D, 0, 0, nullptr, (unsigned long long*)(ws + WS_CTL + 512 * 1024), nullptr, 0}; pg8::StaticOrder S; S.init(M, DIN, G, bx);
#if DBG_PLAIN
        EpiPlain E{UF, DIN};
        pg8::gemm_phase<EpiPlain, pg8::StaticOrder, 0, GALIGN, GSP2>(lds, g, S, E);
#else
        EpiInProj E{UF, CV, BG, GA, GB, b_gate};
        pg8::gemm_phase<EpiInProj, pg8::StaticOrder, 0, GALIGN, GSP2>(lds, g, S, E);
#endif
        if (bx >= G / 2) { const int w2 = (bx - G / 2) * NWAVES + wave, nw2 = (G - G / 2) * NWAVES;
            expert_range(w_g, w_u, w_d, WGU8, WD8, EXP_P0 + EXP_P6 + w2, EXP_P0 + EXP_P6 + EXP_P2, nw2, lane, scr); }
#endif
        GRID_BAR(2);
    }
    if (IN(3)) REP(3) {
        if (bx & 1) phase_conv(CV, BG, w_conv, AB, wave, lane, vcu, G);
        for (int it = vcu; it < BATCH * 128; it += G) fft_item(lds, UF, ZF, Fc1, Fc2, it, wave, lane, (PROBE_I >= 340 && PROBE_I < 350) ? (unsigned long long*)(ws + WS_CTL + 512 * 1024) : nullptr);
#if PROBE_I >= 0
        __syncthreads(); if (bx == 0 && tid == 0) tsb[20] = __builtin_amdgcn_s_memrealtime();
#endif
        if (!(bx & 1)) phase_conv(CV, BG, w_conv, AB, wave, lane, vcu, G);
#if PROBE_I >= 0
        asm volatile("s_waitcnt vmcnt(0)" ::: "memory"); __syncthreads(); if (bx == 0 && tid == 0) tsb[21] = __builtin_amdgcn_s_memrealtime();
#endif
        GRID_BAR(3);
    }
    if (IN(4)) REP(4) {
#if P4_FUSED
        { pg8::Gemm g{ZF, WF, M, 2 * D, D, 0, 0, nullptr, (unsigned long long*)(ws + WS_CTL + 512 * 1024), AB, 4}; pg8::StaticOrder S; S.init(M, 2 * D, G, bx); EpiGateBoth E{TZ, GA, GB};
          pg8::gemm_phase<EpiGateBoth, pg8::StaticOrder, 3, true, true>(lds, g, S, E); }
#else
        { pg8::Gemm g{ZF, WF, M, D, D, 0, 0, nullptr, (unsigned long long*)(ws + WS_CTL + 512 * 1024), nullptr, 0}; pg8::StaticOrder S; S.init(M, D, G, bx); EpiGateMul<0> E{TZ, GA};
          pg8::gemm_phase<EpiGateMul<0>, pg8::StaticOrder, 1, true, true>(lds, g, S, E); }
        { pg8::Gemm g{AB, WCO, M, D, D, 0, 0, nullptr, (unsigned long long*)(ws + WS_CTL + 512 * 1024), nullptr, 0}; pg8::StaticOrder S; S.init(M, D, G, bx); EpiGateMul<1> E{TZ, GB};
          pg8::gemm_phase<EpiGateMul<1>, pg8::StaticOrder, 0, true, true>(lds, g, S, E); }
#endif
        GRID_BAR(4);
    }
    if (IN(5)) REP(5) {
        pg8::Gemm g{TZ, WO, M, D, D, 0, 0, nullptr, (unsigned long long*)(ws + WS_CTL + 512 * 1024), nullptr, 0}; pg8::StaticOrder S; S.init(M, D, G, bx); EpiResid E{x, X1B, mod + 2 * D};
        pg8::gemm_phase<EpiResid, pg8::StaticOrder, 0, true, true>(lds, g, S, E);
        GRID_BAR(5);
    }
    if (IN(6)) REP(6) { phase_h2(X1B, g_moe, mod, w_r, b_r, H2, H2F8, probs, lds, tid, wave, lane, vcu, G);
        if (wave >= 4) { LAS float* scr6 = (LAS float*)(lds + 81920 + (wave - 4) * 8448);
            const int w6 = vcu * 4 + (wave - 4), nw6 = G * 4; LAS float* scr = scr6;
            expert_range(w_g, w_u, w_d, WGU8, WD8, EXP_P0 + w6, EXP_P0 + EXP_P6, nw6, lane, scr); }
        __syncthreads(); GRID_BAR(6); }
    if (IN(7)) REP(7) { for (int it = vcu; it < NE * BATCH; it += G) topk_item(probs, idx, val, slot, lds, it, tid, wave, lane);
        if (vcu >= NE * BATCH) { const int w7 = (vcu - NE * BATCH) * NWAVES + wave, nw7 = (G - NE * BATCH) * NWAVES;
            expert_range(w_g, w_u, w_d, WGU8, WD8, EXP_P0 + EXP_P6 + EXP_P2 + w7, EXP_TOTAL, nw7, lane, scr); }
        GRID_BAR(7); }
    if (IN(9)) REP(9) {
#if MOE_FP8
        pg8::Gemm g{(const bf16*)H2F8, (const bf16*)WGU8, MR, 2 * DE, D / 2, 8, (size_t)2 * DE * D / 2, idx, (unsigned long long*)(ws + WS_CTL + 512 * 1024), nullptr, 0}; pg8::StaticOrder S; S.init(MR, 2 * DE, G, bx); EpiSwiGLU8 E{HM8};
        pg8::gemm_phase<EpiSwiGLU8, pg8::StaticOrder, 2, MOE_ALIGN, true, true>(lds, g, S, E);
#else
        pg8::Gemm g{H2, WGU, MR, 2 * DE, D, 8, (size_t)2 * DE * D, idx, (unsigned long long*)(ws + WS_CTL + 512 * 1024), nullptr, 0}; pg8::StaticOrder S; S.init(MR, 2 * DE, G, bx); EpiSwiGLU E{HM};
        pg8::gemm_phase<EpiSwiGLU, pg8::StaticOrder, 2, true, true>(lds, g, S, E);
#endif
        GRID_BAR(9);
    }
    if (IN(10)) REP(10) {
#if MOE_FP8
        pg8::Gemm g{(const bf16*)HM8, (const bf16*)WD8, MR, D, DE / 2, 8, (size_t)D * DE / 2, nullptr, (unsigned long long*)(ws + WS_CTL + 512 * 1024), nullptr, 0}; pg8::StaticOrder S; S.init(MR, D, G, bx); EpiRowScale E{Y, val};
        pg8::gemm_phase<EpiRowScale, pg8::StaticOrder, 0, MOE_ALIGN, true, true>(lds, g, S, E);
#else
        pg8::Gemm g{HM, WD, MR, D, DE, 8, (size_t)D * DE, nullptr, (unsigned long long*)(ws + WS_CTL + 512 * 1024), nullptr, 0}; pg8::StaticOrder S; S.init(MR, D, G, bx); EpiRowScale E{Y, val};
        pg8::gemm_phase<EpiRowScale, pg8::StaticOrder, 0, true, true>(lds, g, S, E);
#endif
#if PROBE_I >= 0
        if (bx == 0 && tid == 0) tsb[12] = __builtin_amdgcn_s_memrealtime();
#endif
        GRID_BAR(10);
    }
#if PROBE_I >= 0
    float pert = 0.f;
    if (IN(11)) { const unsigned long long a0 = __hip_atomic_load(tsb + (PROBE_I == 100 ? 0 : PROBE_I == 9 ? 8 : PROBE_I), __ATOMIC_RELAXED, __HIP_MEMORY_SCOPE_AGENT), a1 = __hip_atomic_load(tsb + (PROBE_I == 100 ? 12 : PROBE_I == 10 ? 12 : PROBE_I + 1), __ATOMIC_RELAXED, __HIP_MEMORY_SCOPE_AGENT); pert = (float)(a1 - a0) * 0.01f * (PROBE_I == 100 ? (1.0f / 64000.0f) : (1.0f / 16000.0f)); }
    if (PROBE_I == 102) { pert = 0.f; if (bx == 0 && tid == 0) tsb[14] = __builtin_amdgcn_s_memrealtime(); __syncthreads(); }
    if (PROBE_I >= 340 && PROBE_I < 344) { pert = 0.f; if (bx == 0) { const int q_ = PROBE_I - 340; const unsigned long long a0 = __hip_atomic_load(tsb + 34 + q_, __ATOMIC_RELAXED, __HIP_MEMORY_SCOPE_AGENT), a1 = __hip_atomic_load(tsb + 35 + q_, __ATOMIC_RELAXED, __HIP_MEMORY_SCOPE_AGENT); pert = (float)(a1 - a0) * 0.01f * (1.0f / 250.0f); } }
    else if ((PROBE_I >= 320 && PROBE_I < 323) || (PROBE_I >= 330 && PROBE_I < 333)) { pert = 0.f; if (bx == 0) { const int q_ = PROBE_I % 10; const unsigned long long a0 = __hip_atomic_load(tsb + 30 + q_, __ATOMIC_RELAXED, __HIP_MEMORY_SCOPE_AGENT), a1 = __hip_atomic_load(tsb + 31 + q_, __ATOMIC_RELAXED, __HIP_MEMORY_SCOPE_AGENT); pert = (float)(a1 - a0) * 0.01f * (1.0f / 250.0f); } }
    else if (PROBE_I >= 310 && PROBE_I <= 313) { pert = 0.f; if (bx == 0) { const int ia = (PROBE_I == 310 ? 0 : PROBE_I == 311 ? 22 : PROBE_I == 312 ? 23 : 24), ib = (PROBE_I == 310 ? 22 : PROBE_I == 311 ? 23 : PROBE_I == 312 ? 24 : 1);
        const unsigned long long a0 = __hip_atomic_load(tsb + ia, __ATOMIC_RELAXED, __HIP_MEMORY_SCOPE_AGENT), a1 = __hip_atomic_load(tsb + ib, __ATOMIC_RELAXED, __HIP_MEMORY_SCOPE_AGENT); pert = (float)(a1 - a0) * 0.01f * (1.0f / 250.0f); } }
    else if (PROBE_I == 300 || PROBE_I == 301 || PROBE_I == 302) { pert = 0.f; if (bx == 0) { const unsigned long long a0 = __hip_atomic_load(tsb + (PROBE_I == 300 ? 3 : PROBE_I == 301 ? 20 : 21), __ATOMIC_RELAXED, __HIP_MEMORY_SCOPE_AGENT), a1 = __hip_atomic_load(tsb + (PROBE_I == 300 ? 20 : PROBE_I == 301 ? 21 : 4), __ATOMIC_RELAXED, __HIP_MEMORY_SCOPE_AGENT); pert = (float)(a1 - a0) * 0.01f * (1.0f / 250.0f); } }
    else if (PROBE_I >= 200) { pert = 0.f; if (bx == 0) { const int k_ = PROBE_I - 200; const unsigned long long a0 = __hip_atomic_load(tsb + (k_ == 9 ? 8 : k_), __ATOMIC_RELAXED, __HIP_MEMORY_SCOPE_AGENT), a1 = __hip_atomic_load(tsb + k_ + 1, __ATOMIC_RELAXED, __HIP_MEMORY_SCOPE_AGENT); pert = (float)(a1 - a0) * 0.01f * (1.0f / 250.0f); } }
    if (PROBE_I == 101) { pert = 0.f; if (bx == 0) { const unsigned long long a0 = __hip_atomic_load(tsb + 12, __ATOMIC_RELAXED, __HIP_MEMORY_SCOPE_AGENT); pert = (float)(__builtin_amdgcn_s_memrealtime() - a0) * 0.01f * (1.0f / 250.0f); } }
    if (IN(11)) phase_final(out, X1B, Y, slot, mod, g_fin, wave, lane, vcu, G, pert);
    if (PROBE_I == 102) {
        const unsigned long long t_a = tsb[14];
        xcd_barrier(bar);
        if (bx == 0) { const float pp = (float)(__builtin_amdgcn_s_memrealtime() - t_a) * 0.01f * (1.0f / 250.0f);
            for (int k = 0; k < 4; ++k) for (int r = 0; r < 2; ++r) { float* row = out + (size_t)(2 * (vcu * NWAVES + wave) + r + 4096 * k) * D; for (int cc = lane; cc < D; cc += 64) row[cc] += pp; } } }
#else
    if (IN(11)) REP(11) { phase_final(out, X1B, Y, slot, mod, g_fin, wave, lane, vcu, G, 0.f); if (DOUBLE_PH == 11 && rep_ == 0) xcd_barrier(bar); }
#endif

#undef IN
#undef GRID_BAR
}


struct DumpArgs { const unsigned short* p[8]; unsigned long long n[8]; int f32[8]; int nb; int pad; };
__global__ void k_dump(float* out, DumpArgs a) {
    const size_t i = (size_t)blockIdx.x * blockDim.x + threadIdx.x; float s = 0.f;
    for (int b = 0; b < a.nb; ++b) for (size_t j = i; j < a.n[b]; j += (size_t)M * D) s += (a.f32[b] ? ((const float*)a.p[b])[j] : __uint_as_float(((unsigned)a.p[b][j]) << 16)) * (float)(b + 1);
    out[i] = s;
}
#ifndef DUMP_WHICH
#define DUMP_WHICH -1
#endif
#ifndef STOP_AFTER
#define STOP_AFTER (NPHASE - 1)
#endif
#ifndef MK_PER_PHASE
#define MK_PER_PHASE 0
#endif
extern "C" void kernel_launch(void* const* d_in, const int* in_sizes, int n_in, void* d_out, int out_size, void* d_ws, size_t ws_size, hipStream_t stream) {
    static int grid = 0;
    if (grid == 0) {
        if (n_in != 18 || in_sizes[0] != M * D || out_size != M * D || ws_size < WS_END) { fprintf(stderr, "kernel_launch: unexpected shapes (n_in %d, in0 %d, out %d, ws %zu); nothing launched\n", n_in, n_in > 0 ? in_sizes[0] : -1, out_size, ws_size); grid = -1; return; }
        int dev = 0, cus = 0, per_cu = 0;
        if (hipGetDevice(&dev) != hipSuccess || hipDeviceGetAttribute(&cus, hipDeviceAttributeMultiprocessorCount, dev) != hipSuccess) { grid = -1; return; }
        if (hipFuncSetAttribute((const void*)fwd, hipFuncAttributeMaxDynamicSharedMemorySize, LDS_BYTES) != hipSuccess) { fprintf(stderr, "kernel_launch: hipFuncSetAttribute failed\n"); grid = -1; return; }
        if (hipOccupancyMaxActiveBlocksPerMultiprocessor(&per_cu, (const void*)fwd, NWAVES * 64, LDS_BYTES) != hipSuccess || per_cu < 1) { fprintf(stderr, "kernel_launch: occupancy query reports %d blocks per CU\n", per_cu); }
        (void)hipGetLastError();
        grid = cus;
    }
    if (grid < 0) return;
    (void)hipMemsetAsync((char*)d_ws + WS_CTL, 0, CTL_ZERO_BYTES, stream);
    Args a{};
    for (int i = 0; i < 18; ++i) a.in[i] = (const float*)d_in[i];
    a.out = (float*)d_out; a.ws = (unsigned char*)d_ws;
#if MK_PER_PHASE
    for (int p = 0; p < STOP_AFTER + 1; ++p) { a.ph_lo = p; a.ph_hi = p + 1; hipLaunchKernelGGL(fwd, dim3(grid), dim3(NWAVES * 64), LDS_BYTES, stream, a); }
#if DUMP_WHICH >= 0
    { DumpArgs da{}; unsigned char* w = (unsigned char*)d_ws; int nb = 0;
      auto add = [&](size_t off, size_t n, int isf = 0) { da.p[nb] = (const unsigned short*)(w + off); da.n[nb] = n; da.f32[nb] = isf; ++nb; };
      if (DUMP_WHICH == 0) { add(WS_WIN, (size_t)DIN * D); add(WS_WF, (size_t)D * D); add(WS_WCO, (size_t)D * D); add(WS_WO, (size_t)D * D); add(WS_WGU, (size_t)NE * 4096 * D); add(WS_WD, (size_t)NE * D * DE); add(WS_FC1, 8192 + 0); add(WS_MODP, 4 * 2 * 6 * D, 1); }
      if (DUMP_WHICH == 1) { add(WS_H1, (size_t)M * D); add(WS_MOD, 2 * 6 * D, 1); add(WS_FC2, 65536); }
      if (DUMP_WHICH == 2) { add(WS_UF, (size_t)M * DF); add(WS_CV, (size_t)M * D); add(WS_BG, (size_t)M * D); add(WS_GA, (size_t)M * D); add(WS_GB, (size_t)M * D); }
      if (DUMP_WHICH == 5) { add(WS_UF, (size_t)M * DIN); }
      if (DUMP_WHICH == 6) { add(WS_UF, (size_t)M * DF); add(WS_CV, (size_t)M * D); }
      if (DUMP_WHICH == 7) { add(WS_BG, (size_t)M * D); }
      if (DUMP_WHICH == 8) { add(WS_GA, (size_t)M * D); add(WS_GB, (size_t)M * D); }
      if (DUMP_WHICH == 9) { add(WS_GA, (size_t)M * D); }
      if (DUMP_WHICH == 10) { add(WS_GB, (size_t)M * D); }
      if (DUMP_WHICH == 3) { add(WS_ZF, (size_t)M * D); add(WS_AB, (size_t)M * D); }
      if (DUMP_WHICH == 4) { add(WS_TZ, (size_t)M * D); }
      da.nb = nb; hipLaunchKernelGGL(k_dump, dim3(M * D / 256), dim3(256), 0, stream, (float*)d_out, da); }
#endif
#else
    a.ph_lo = 0; a.ph_hi = NPHASE; hipLaunchKernelGGL(fwd, dim3(grid), dim3(NWAVES * 64), LDS_BYTES, stream, a);
#endif
}
```

```cpp
#include <hip/hip_runtime.h>
#include <cstdio>
#include <cstdint>
#define MK_PER_PHASE 0
#define STOP_AFTER 11
#define DUMP_WHICH -1
#define GALIGN true
#define GSP2 true
#define DBG_PLAIN 0
#define DBG_NOBIAS 0
#define DBG_NOSIG 0
#define PROBE_I -1
#define PROBE_J -1
#define DOUBLE_PH -1
#define STAGGER_US 0
#define EXTRA_BARS 0
#define DBG_EPI2 0
#ifndef PROBE_I
#define PROBE_I -1
#endif
#ifndef DBG_EPI2
#define DBG_EPI2 0
#endif
namespace pg8 {
#define PG8_LAS __attribute__((address_space(3)))
typedef unsigned short bf16_t;
typedef short bf16x8 __attribute__((ext_vector_type(8)));
typedef float f32x4 __attribute__((ext_vector_type(4)));
typedef unsigned u32x4 __attribute__((ext_vector_type(4)));
typedef unsigned u32x2 __attribute__((ext_vector_type(2)));
typedef int v8i __attribute__((ext_vector_type(8)));
typedef int v4i __attribute__((ext_vector_type(4)));
constexpr int BM = 256, BK = 64, HALF = 128, HTB = HALF * BK * 2  , STAGE_BYTES = 8 * HTB, NXCD = 8, WGM = 8;

__host__ __device__ __forceinline__ int lds_byte(int r, int c) { const int st = (r >> 4) * 2 + (c >> 5), rr = r & 15, cc = c & 31, ob = rr * 64 + cc * 2; return st * 1024 + (ob ^ (((ob >> 9) & 1) << 5)); }
__host__ __device__ __forceinline__ void stage_rc(int b, int& R, int& C) { const int st = b / 1024, sb = b % 1024, swz = sb ^ (((sb >> 9) & 1) << 5); R = (st >> 1) * 16 + swz / 64; C = (st & 1) * 32 + (swz % 64) / 2; }
__host__ __device__ __forceinline__ int perm32(int rho) { const int n = rho >> 4, i = rho & 15; return 8 * (i >> 2) + 4 * n + (i & 3); }

struct Unit { int pm, pn; };
struct Gemm { const bf16_t* A; const bf16_t* Bt; int M, N, K; int bgrp; size_t bstride; const int* gidx; unsigned long long* ts; const bf16_t* A2; int asplit; };

struct StaticOrder {
    int nM, nN, nwg, G, c;
    __host__ __device__ void init(int M, int N, int G_, int c_) { nM = M / BM; nN = N / BM; nwg = nM * nN; G = G_; c = c_; }
    __host__ __device__ bool next(int i, Unit& u) const {
        const long L = (long)i * G + c; if (L >= nwg) return false;
        int wgid = (int)L; { const int q = nwg / NXCD, r = nwg % NXCD, xcd = wgid % NXCD, off = wgid / NXCD; wgid = (xcd < r ? xcd * (q + 1) : r * (q + 1) + (xcd - r) * q) + off; }
        const int nig = WGM * nN, gid = wgid / nig, fm = gid * WGM, gsz = (nM - fm) < WGM ? (nM - fm) : WGM;
        u.pm = fm + ((wgid % nig) % gsz); u.pn = (wgid % nig) / gsz; return true;
    }
    __device__ __forceinline__ void a_ready(const Unit&) const {}
    __device__ __forceinline__ void done(const Unit&) const {}
};

typedef __bf16 bf16x2_t __attribute__((ext_vector_type(2)));
typedef float f32x2_t __attribute__((ext_vector_type(2)));
__device__ __forceinline__ unsigned cvt_pk_bf16(float lo, float hi) { const f32x2_t v = {lo, hi}; const bf16x2_t b = __builtin_convertvector(v, bf16x2_t); return __builtin_bit_cast(unsigned, b); }
__device__ __forceinline__ float bf_lo(unsigned w) { return __uint_as_float(w << 16); }
__device__ __forceinline__ float bf_hi(unsigned w) { return __uint_as_float(w & 0xffff0000u); }
__device__ __forceinline__ float sigm(float v) { return __builtin_amdgcn_rcpf(1.0f + __expf(-v)); }


template <class Epi, class Sched, int AMODE, bool ALIGN_EPI, bool SP2, bool F8 = false>
__device__ __forceinline__ void gemm_phase(PG8_LAS unsigned char* lds, const Gemm g, const Sched& S, const Epi& E) {
    const int tid = threadIdx.x, wid = __builtin_amdgcn_readfirstlane(tid >> 6), lane = tid & 63, wr = wid >> 2, wc = wid & 3, fr = lane & 15, fq = lane >> 4;
    const int K = g.K, nt = K / BK;
    unsigned voffA0[2], voffA1[2], voffB[2]; int gR[2], gC2[2];
#pragma unroll
    for (int i = 0; i < 2; ++i) { int R, C; stage_rc(tid * 16 + i * 8192, R, C); const int Rb = Epi::PERM ? ((R & ~31) + perm32(R & 31)) : R;
        voffB[i] = (unsigned)(Rb * K + C) * 2u; gR[i] = R; gC2[i] = C * 2;
        if (AMODE == 0) { voffA0[i] = (unsigned)(R * K + C) * 2u; voffA1[i] = (unsigned)((R + HALF) * K + C) * 2u; }
        else if (AMODE == 1) { voffA0[i] = (unsigned)((C >> 3) * 8192 + R) * 16u; voffA1[i] = voffA0[i] + (unsigned)HALF * 16u; }
        else if (AMODE == 3) { voffA0[i] = (unsigned)((C >> 3) * 8192 + R) * 16u; voffA1[i] = voffA0[i] + (unsigned)HALF * 16u; }
        else { voffA0[i] = 0u; voffA1[i] = 0u; } }
    const size_t kstepB = (size_t)(BK * 2);
    size_t kstepA = (AMODE == 1 || AMODE == 3) ? (size_t)8 * 8192 * 16 : (size_t)(BK * 2), kstepAN = kstepA;
    unsigned vrm0[2] = {0u, 0u}, vrm1[2] = {0u, 0u}, vbl0[2] = {0u, 0u}, vbl1[2] = {0u, 0u};
    if (AMODE == 3) {
#pragma unroll
        for (int i = 0; i < 2; ++i) { vbl0[i] = voffA0[i]; vbl1[i] = voffA1[i]; vrm0[i] = (unsigned)(gR[i] * K) * 2u + (unsigned)gC2[i]; vrm1[i] = (unsigned)((gR[i] + HALF) * K) * 2u + (unsigned)gC2[i]; } }
    int nidx0[2] = {0, 0}, nidx1[2] = {0, 0}; unsigned voffN0[2] = {0u, 0u}, voffN1[2] = {0u, 0u};
#define PG8_GIDX_LOAD(u) do { if (AMODE == 2) { _Pragma("unroll") for (int _i = 0; _i < 2; ++_i) { \
        const int* _p0 = g.gidx + (size_t)(u).pm * BM + gR[_i]; const int* _p1 = _p0 + HALF; \
        asm volatile("global_load_dword %0, %1, off" : "=v"(nidx0[_i]) : "v"(_p0) : "memory"); asm volatile("global_load_dword %0, %1, off" : "=v"(nidx1[_i]) : "v"(_p1) : "memory"); } } } while (0)
#define PG8_GIDX_USE() do { if (AMODE == 2) { _Pragma("unroll") for (int _i = 0; _i < 2; ++_i) { asm volatile("" : "+v"(nidx0[_i]), "+v"(nidx1[_i])); \
        voffN0[_i] = (unsigned)nidx0[_i] * (unsigned)(K * 2) + (unsigned)gC2[_i]; voffN1[_i] = (unsigned)nidx1[_i] * (unsigned)(K * 2) + (unsigned)gC2[_i]; } } } while (0)
    const size_t hstepB = (size_t)HALF * K * 2;
    const size_t tstepB = 2 * hstepB;
    const unsigned ldsw = (unsigned)wid * 1024u;
    const int aoff = lds_byte(wr * 64 + fr, fq * 8), boff = lds_byte(wc * 32 + fr, fq * 8);
    const int aoff8a = lds_byte(wr * 64 + fr, fq * 16), boff8a = lds_byte(wc * 32 + fr, fq * 16);
#define PG8_BLK3(u) ((u).pn < g.asplit)
#define PG8_ABASE(u) ((AMODE == 3) ? (PG8_BLK3(u) ? (const char*)g.A + (size_t)((u).pm >> 5) * ((size_t)(K >> 3) * 8192 * 16) + (size_t)((u).pm & 31) * (BM * 16) : (const char*)g.A2 + (size_t)(u).pm * (size_t)BM * K * 2) : (const char*)g.A + ((AMODE == 2) ? (size_t)0 : (AMODE == 0) ? (size_t)(u).pm * (size_t)BM * K * 2 : (size_t)((u).pm >> 5) * ((size_t)(K >> 3) * 8192 * 16) + (size_t)((u).pm & 31) * (BM * 16)))
#define PG8_BBASE(u) ((const char*)g.Bt + (g.bgrp ? (size_t)((u).pm / g.bgrp) * g.bstride * 2 : (size_t)0) + (size_t)(u).pn * tstepB)
#define PG8_SA(b, h) (((b) * 2 + (h)) * HTB)
#define PG8_SB(b, h) ((4 + (b) * 2 + (h)) * HTB)
#define PG8_STAGE(bufoff, gbase, voff) do { _Pragma("unroll") for (int _i = 0; _i < 2; ++_i) \
        __builtin_amdgcn_global_load_lds((const unsigned*)((const char*)(gbase) + (voff)[_i]), (PG8_LAS unsigned*)(lds + (bufoff) + ldsw + _i * 8192), 16, 0, 0); } while (0)
#define PG8_LDA16(dst, b, h) do { _Pragma("unroll") for (int m = 0; m < 4; ++m) _Pragma("unroll") for (int k = 0; k < 2; ++k) dst[m][k] = *(const PG8_LAS bf16x8*)(lds + PG8_SA(b, h) + aoff + m * 2048 + k * 1024); } while (0)
#define PG8_LDB16(dst, b, h) do { _Pragma("unroll") for (int n = 0; n < 2; ++n) _Pragma("unroll") for (int k = 0; k < 2; ++k) dst[n][k] = *(const PG8_LAS bf16x8*)(lds + PG8_SB(b, h) + boff + n * 2048 + k * 1024); } while (0)
#define PG8_MMA16(ai, bj, At, Bt) do { __builtin_amdgcn_s_setprio(1); _Pragma("unroll") for (int m = 0; m < 4; ++m) _Pragma("unroll") for (int n = 0; n < 2; ++n) _Pragma("unroll") for (int k = 0; k < 2; ++k) \
        acc[ai][bj][m][n] = __builtin_amdgcn_mfma_f32_16x16x32_bf16(Bt[n][k], At[m][k], acc[ai][bj][m][n], 0, 0, 0); __builtin_amdgcn_s_setprio(0); } while (0)
#define PG8_LDA8(dst, b, h) do { _Pragma("unroll") for (int m = 0; m < 4; ++m) { const v4i lo_ = *(const PG8_LAS v4i*)(lds + PG8_SA(b, h) + aoff8a + m * 2048), hi_ = *(const PG8_LAS v4i*)(lds + PG8_SA(b, h) + aoff8a + m * 2048 + 16); \
        dst[m] = (v8i){lo_.x, lo_.y, lo_.z, lo_.w, hi_.x, hi_.y, hi_.z, hi_.w}; } } while (0)
#define PG8_LDB8(dst, b, h) do { _Pragma("unroll") for (int n = 0; n < 2; ++n) { const v4i lo_ = *(const PG8_LAS v4i*)(lds + PG8_SB(b, h) + boff8a + n * 2048), hi_ = *(const PG8_LAS v4i*)(lds + PG8_SB(b, h) + boff8a + n * 2048 + 16); \
        dst[n] = (v8i){lo_.x, lo_.y, lo_.z, lo_.w, hi_.x, hi_.y, hi_.z, hi_.w}; } } while (0)
#define PG8_MMA8(ai, bj, At, Bt) do { __builtin_amdgcn_s_setprio(1); _Pragma("unroll") for (int m = 0; m < 4; ++m) _Pragma("unroll") for (int n = 0; n < 2; ++n) \
        asm volatile("v_mfma_scale_f32_16x16x128_f8f6f4 %0, %1, %2, %0, %3, %3 op_sel:[0,1,0] op_sel_hi:[0,0,0]" : "+v"(acc[ai][bj][m][n]) : "v"(Bt[n]), "v"(At[m]), "v"(f8scale)); __builtin_amdgcn_s_setprio(0); } while (0)
#define PG8_LDA(dst, b, h) do { if constexpr (F8) PG8_LDA8(dst##8, b, h); else PG8_LDA16(dst, b, h); } while (0)
#define PG8_LDB(dst, b, h) do { if constexpr (F8) PG8_LDB8(dst##8, b, h); else PG8_LDB16(dst, b, h); } while (0)
#define PG8_MMA(ai, bj, At, Bt) do { if constexpr (F8) PG8_MMA8(ai, bj, At##8, Bt##8); else PG8_MMA16(ai, bj, At, Bt); } while (0)
#define PG8_WAIT_V(n) asm volatile("s_waitcnt vmcnt(" #n ")" ::: "memory")
#define PG8_WAIT_VE() do { if (epi_st == 0) PG8_WAIT_V(8); else if (epi_st == 8) PG8_WAIT_V(16); else if (epi_st == 16) PG8_WAIT_V(24); else PG8_WAIT_V(40); } while (0)
#define PG8_WAIT_L(n) asm volatile("s_waitcnt lgkmcnt(" #n ")" ::: "memory")
#define PG8_BAR __builtin_amdgcn_s_barrier()
#define PG8_SCHED __builtin_amdgcn_sched_barrier(0)
    Unit cur, nxt; int ui = 0; int epi_st = 0;
    if (!S.next(0, cur)) return;
    f32x4 acc[2][2][4][2];
#pragma unroll
    for (int a = 0; a < 2; ++a)
#pragma unroll
        for (int b = 0; b < 2; ++b)
#pragma unroll
            for (int m = 0; m < 4; ++m)
#pragma unroll
                for (int n = 0; n < 2; ++n) acc[a][b][m][n] = (f32x4){0.f, 0.f, 0.f, 0.f};
    bf16x8 At[4][2], B0[2][2], B1[2][2]; v8i At8[4], B08[2], B18[2]; int f8scale = 0x7f7f7f78; asm volatile("" : "+v"(f8scale));
    const char* cA = PG8_ABASE(cur); const char* cB = PG8_BBASE(cur);
    S.a_ready(cur);
    if (AMODE == 3) { const bool blk = PG8_BLK3(cur); kstepA = blk ? (size_t)8 * 8192 * 16 : (size_t)(BK * 2);
#pragma unroll
        for (int i = 0; i < 2; ++i) { voffA0[i] = blk ? vbl0[i] : vrm0[i]; voffA1[i] = blk ? vbl1[i] : vrm1[i]; } }
    if (AMODE == 2) { PG8_GIDX_LOAD(cur); asm volatile("s_waitcnt vmcnt(0)" ::: "memory"); PG8_GIDX_USE();
#pragma unroll
        for (int i = 0; i < 2; ++i) { voffA0[i] = voffN0[i]; voffA1[i] = voffN1[i]; } }
    if constexpr (SP2) {
        PG8_STAGE(PG8_SB(0, 0), cB, voffB); PG8_STAGE(PG8_SB(0, 1), cB + hstepB, voffB); PG8_STAGE(PG8_SA(0, 0), cA, voffA0); PG8_STAGE(PG8_SA(0, 1), cA, voffA1);
        if (wr == 1) PG8_BAR;
        PG8_WAIT_V(2); PG8_BAR;
        PG8_STAGE(PG8_SB(1, 0), cB + kstepB, voffB); PG8_STAGE(PG8_SA(1, 0), cA + kstepA, voffA0); PG8_STAGE(PG8_SB(1, 1), cB + hstepB + kstepB, voffB);
        PG8_WAIT_V(6); PG8_BAR;
    } else {
        PG8_STAGE(PG8_SB(0, 0), cB, voffB); PG8_STAGE(PG8_SA(0, 0), cA, voffA0); PG8_STAGE(PG8_SB(0, 1), cB + hstepB, voffB); PG8_STAGE(PG8_SA(0, 1), cA, voffA1);
        if (wr == 1) PG8_BAR;
        PG8_WAIT_V(4); PG8_BAR;
        PG8_STAGE(PG8_SB(1, 0), cB + kstepB, voffB); PG8_STAGE(PG8_SA(1, 0), cA + kstepA, voffA0); PG8_STAGE(PG8_SB(1, 1), cB + hstepB + kstepB, voffB);
        PG8_WAIT_V(6); PG8_BAR;
    }
    for (;;) {
        const bool has_next = S.next(ui + 1, nxt);
        const char* nA = has_next ? PG8_ABASE(nxt) : cA; const char* nB = has_next ? PG8_BBASE(nxt) : cB;
        if (AMODE == 3) { const bool blkn = has_next ? PG8_BLK3(nxt) : PG8_BLK3(cur); kstepAN = blkn ? (size_t)8 * 8192 * 16 : (size_t)(BK * 2);
#pragma unroll
            for (int i = 0; i < 2; ++i) { voffN0[i] = blkn ? vbl0[i] : vrm0[i]; voffN1[i] = blkn ? vbl1[i] : vrm1[i]; } }
        if (AMODE == 2) { if (has_next) PG8_GIDX_LOAD(nxt); }
#if PROBE_I >= 0
        if (Epi::STAMP && ui == 1 && blockIdx.x == 0 && threadIdx.x == 0) g.ts[30] = __builtin_amdgcn_s_memrealtime();
#endif
#pragma unroll 1
        for (int t = 0; t < nt; t += 2) {
            const bool last = (t == nt - 2);
            unsigned vS0[2], vS1[2];
            if (AMODE == 2) { if (last) { if (has_next) PG8_GIDX_USE(); else { _Pragma("unroll") for (int i = 0; i < 2; ++i) { voffN0[i] = voffA0[i]; voffN1[i] = voffA1[i]; } } } }
#pragma unroll
            for (int i = 0; i < 2; ++i) { vS0[i] = ((AMODE == 2 || AMODE == 3) && last) ? voffN0[i] : voffA0[i]; vS1[i] = ((AMODE == 2 || AMODE == 3) && last) ? voffN1[i] : voffA1[i]; }
            const char* a1 = cA + (size_t)(t + 1) * kstepA;
            const char* a2 = last ? nA : cA + (size_t)(t + 2) * kstepA; const char* b2 = last ? nB : cB + (size_t)(t + 2) * kstepB;
            const char* a3 = a2 + ((AMODE == 3 && last) ? kstepAN : kstepA); const char* b3 = b2 + kstepB;
            if (last && has_next) S.a_ready(nxt);
            if constexpr (SP2) {
            PG8_LDB(B0, 0, 0); PG8_LDB(B1, 0, 1); PG8_SCHED; PG8_LDA(At, 0, 0); PG8_STAGE(PG8_SA(1, 1), a1, voffA1);
            PG8_WAIT_VE(); PG8_WAIT_L(0); PG8_BAR; PG8_MMA(0, 0, At, B0); PG8_MMA(0, 1, At, B1); PG8_BAR; PG8_SCHED;
            PG8_LDA(At, 0, 1); PG8_STAGE(PG8_SB(0, 0), b2, voffB); PG8_STAGE(PG8_SB(0, 1), b2 + hstepB, voffB); PG8_STAGE(PG8_SA(0, 0), a2, vS0);
            PG8_WAIT_VE(); epi_st = 0; PG8_WAIT_L(0); PG8_BAR; PG8_MMA(1, 0, At, B0); PG8_MMA(1, 1, At, B1); PG8_BAR; PG8_SCHED;
            PG8_LDB(B0, 1, 0); PG8_LDB(B1, 1, 1); PG8_SCHED; PG8_LDA(At, 1, 0); PG8_STAGE(PG8_SA(0, 1), a2, vS1);
            PG8_WAIT_V(8); PG8_WAIT_L(0); PG8_BAR; PG8_MMA(0, 0, At, B0); PG8_MMA(0, 1, At, B1); PG8_BAR; PG8_SCHED;
            PG8_LDA(At, 1, 1); PG8_STAGE(PG8_SB(1, 0), b3, voffB); PG8_STAGE(PG8_SB(1, 1), b3 + hstepB, voffB); PG8_STAGE(PG8_SA(1, 0), a3, vS0);
            PG8_WAIT_V(8); PG8_WAIT_L(0); PG8_BAR; PG8_MMA(1, 0, At, B0); PG8_MMA(1, 1, At, B1); PG8_BAR; PG8_SCHED;
            } else {
            PG8_LDB(B0, 0, 0); PG8_SCHED; PG8_LDA(At, 0, 0); PG8_STAGE(PG8_SA(1, 1), a1, voffA1);
            PG8_WAIT_L(8); PG8_BAR; PG8_WAIT_L(0); PG8_MMA(0, 0, At, B0); PG8_BAR; PG8_SCHED;
            PG8_LDB(B1, 0, 1); PG8_STAGE(PG8_SB(0, 0), b2, voffB);
            PG8_BAR; PG8_WAIT_L(0); PG8_MMA(0, 1, At, B1); PG8_BAR;
            PG8_LDA(At, 0, 1); PG8_STAGE(PG8_SA(0, 0), a2, vS0);
            PG8_BAR; PG8_WAIT_L(0); PG8_MMA(1, 0, At, B0); PG8_BAR; PG8_SCHED;
            PG8_STAGE(PG8_SB(0, 1), b2 + hstepB, voffB);
            PG8_WAIT_V(6); PG8_BAR; PG8_MMA(1, 1, At, B1); PG8_BAR;
            PG8_LDB(B0, 1, 0); PG8_SCHED; PG8_LDA(At, 1, 0); PG8_STAGE(PG8_SA(0, 1), a2, vS1);
            PG8_WAIT_L(8); PG8_BAR; PG8_WAIT_L(0); PG8_MMA(0, 0, At, B0); PG8_BAR; PG8_SCHED;
            PG8_LDB(B1, 1, 1); PG8_STAGE(PG8_SB(1, 0), b3, voffB);
            PG8_BAR; PG8_WAIT_L(0); PG8_MMA(0, 1, At, B1); PG8_BAR;
            PG8_LDA(At, 1, 1); PG8_STAGE(PG8_SA(1, 0), a3, vS0);
            PG8_BAR; PG8_WAIT_L(0); PG8_MMA(1, 0, At, B0); PG8_BAR; PG8_SCHED;
            PG8_STAGE(PG8_SB(1, 1), b3 + hstepB, voffB);
            PG8_WAIT_V(6); PG8_BAR; PG8_MMA(1, 1, At, B1); PG8_BAR;
            }
        }
#if PROBE_I >= 0
        if (Epi::STAMP && ui == 1 && blockIdx.x == 0 && threadIdx.x == 0) g.ts[31] = __builtin_amdgcn_s_memrealtime();
#endif
        if constexpr (ALIGN_EPI) { if (wr == 0) PG8_BAR; }
        if constexpr (F8) asm volatile("s_nop 15\n\ts_nop 15\n\ts_nop 7" ::: "memory");
        E(acc, cur, wr, wc, fr, fq); S.done(cur);
#if DBG_EPI2
        if (Epi::EPI2) { asm volatile("" ::: "memory"); E(acc, cur, wr, wc, fr, fq); }
#endif
#if PROBE_I >= 0
        if (Epi::STAMP && ui == 1 && blockIdx.x == 0 && threadIdx.x == 0) g.ts[32] = __builtin_amdgcn_s_memrealtime();
        if (Epi::STAMP && ui == 2 && blockIdx.x == 0 && threadIdx.x == 0) g.ts[33] = __builtin_amdgcn_s_memrealtime();
#endif
        if (!has_next) break;
        epi_st = E.nst(cur);
#pragma unroll
        for (int a = 0; a < 2; ++a)
#pragma unroll
            for (int b = 0; b < 2; ++b)
#pragma unroll
                for (int m = 0; m < 4; ++m)
#pragma unroll
                    for (int n = 0; n < 2; ++n) acc[a][b][m][n] = (f32x4){0.f, 0.f, 0.f, 0.f};
        cur = nxt; cA = nA; cB = nB; ++ui;
        if (AMODE == 2 || AMODE == 3) {
#pragma unroll
            for (int i = 0; i < 2; ++i) { voffA0[i] = voffN0[i]; voffA1[i] = voffN1[i]; } }
        if (AMODE == 3) kstepA = kstepAN;
        if constexpr (ALIGN_EPI) { if (wr == 1) PG8_BAR; }
    }
    PG8_WAIT_V(0);
    if constexpr (!ALIGN_EPI) { if (wr == 0) PG8_BAR; }
    PG8_BAR;
#undef PG8_GIDX_LOAD
#undef PG8_GIDX_USE
#undef PG8_BLK3
#undef PG8_ABASE
#undef PG8_BBASE
#undef PG8_SA
#undef PG8_SB
#undef PG8_STAGE
#undef PG8_LDA
#undef PG8_LDA16
#undef PG8_LDA8
#undef PG8_LDB16
#undef PG8_LDB8
#undef PG8_MMA16
#undef PG8_MMA8
#undef PG8_LDB
#undef PG8_MMA
#undef PG8_WAIT_V
#undef PG8_WAIT_VE
#undef PG8_WAIT_L
#undef PG8_BAR
#undef PG8_SCHED
}
}
constexpr int NWAVES = 8;
constexpr int BATCH = 2, SEQ = 8192, D = 1024, M = BATCH * SEQ, DF = 512, DIN = 5632, NE = 16, CAP = 1024, DE = 2048, MR = BATCH * NE * CAP  ;
constexpr float RMS_EPS = 1e-6f;
constexpr size_t MiB = 1u << 20;
constexpr size_t WS_CTL = 0, CTL_ZERO_BYTES = 32 * 1024;
constexpr size_t WS_MODP = 1 * MiB, WS_MOD = 1 * MiB + 256 * 1024, WS_FC1 = 1 * MiB + 512 * 1024, WS_FC2 = 1 * MiB + 576 * 1024;
constexpr size_t WS_PROBS = 2 * MiB, WS_SLOT = 3 * MiB, WS_IDX = 4 * MiB, WS_VAL = 4 * MiB + 128 * 1024;
constexpr size_t WS_WIN = 8 * MiB, WS_WF = 20 * MiB, WS_WCO = 22 * MiB, WS_WO = 24 * MiB, WS_WGU = 32 * MiB, WS_WD = 160 * MiB;
constexpr size_t WS_H1 = 224 * MiB, WS_AB = 224 * MiB, WS_UF = 256 * MiB, WS_CV = 272 * MiB, WS_BG = 304 * MiB, WS_GA = 336 * MiB, WS_GB = 368 * MiB, WS_ZF = 400 * MiB, WS_TZ = 432 * MiB, WS_H2 = 464 * MiB;
#ifndef MOE_FP8
#define MOE_FP8 1
#endif
constexpr size_t WS_HM = 224 * MiB, WS_Y = 432 * MiB, WS_X1B = 400 * MiB, WS_END = 496 * MiB;
constexpr int CW_BAR = 4096;
constexpr int RING_BYTES = 131072, MISC_OFF = 143360, LDS_BYTES = 147456;
constexpr int FFT_TOFF = 65536, FFT_TPITCH = 528;

#define GAS __attribute__((address_space(1)))
#define LAS __attribute__((address_space(3)))
typedef unsigned short bf16;
typedef unsigned v4u __attribute__((ext_vector_type(4)));
typedef unsigned v2u __attribute__((ext_vector_type(2)));
typedef float f32x4 __attribute__((ext_vector_type(4)));
typedef short bf16x8 __attribute__((ext_vector_type(8)));
#define LDS_WAIT() asm volatile("s_waitcnt lgkmcnt(0)" ::: "memory")
#define VM_WAIT() asm volatile("s_waitcnt vmcnt(0)" ::: "memory")
using pg8::cvt_pk_bf16; using pg8::bf_lo; using pg8::bf_hi; using pg8::sigm;
__device__ __forceinline__ float wave_sum(float v) {
#pragma unroll
    for (int o = 1; o < 64; o <<= 1) v += __shfl_xor(v, o);
    return v;
}
__device__ __forceinline__ float silu(float v) { return v * sigm(v); }
#ifndef DBG_NOBIAS
#define DBG_NOBIAS 0
#endif
#ifndef DBG_NOSIG
#define DBG_NOSIG 0
#endif
__device__ __forceinline__ float sigx(float v) { return DBG_NOSIG ? v : sigm(v); }

#define XB_TMO      128
#define XB_XCNT(j)  (256  + 64 * (j))
#define XB_XSUB(j)  (1280 + 64 * (j))
#define XB_XGEN(j)  (2304 + 64 * (j))
#define XB_TOP      3328
#define XB_TOPGEN   3392
#define XCD_BAR_WORDS 3456
#define XB_SPIN_CAP (1u << 18)
__device__ __forceinline__ unsigned xb_ld(unsigned* p)              { return __hip_atomic_load(p, __ATOMIC_RELAXED, __HIP_MEMORY_SCOPE_AGENT); }
__device__ __forceinline__ unsigned xb_add(unsigned* p, unsigned v) { return __hip_atomic_fetch_add(p, v, __ATOMIC_RELAXED, __HIP_MEMORY_SCOPE_AGENT); }
__device__ __forceinline__ unsigned xb_xcc_id() { return (unsigned)__builtin_amdgcn_s_getreg((3 << 11) | 20) & 0xFu; }
#define XB_SPIN(cond, bar) do { unsigned _sp = 0; while (cond) { __builtin_amdgcn_s_sleep(1); \
    if ((++_sp & 255u) == 0u) { if (xb_ld(&(bar)[XB_TMO])) break; if (_sp > XB_SPIN_CAP) { atomicAdd(&(bar)[XB_TMO], 1u); break; } } } } while (0)
struct XcdBarrier { unsigned* bar; unsigned x; volatile LAS unsigned* st; };
__device__ __forceinline__ XcdBarrier xcd_barrier_post(unsigned* bar, volatile LAS unsigned* st) {
    XcdBarrier b; b.bar = bar; b.x = xb_xcc_id(); b.st = st;
    if (threadIdx.x == 0) (void)xb_add(&bar[XB_XCNT(b.x)], 1u);
    return b;
}
__device__ __forceinline__ void xcd_barrier_complete(unsigned* bar, unsigned x, unsigned& nloc, unsigned& nx) {
    const unsigned G = gridDim.x * gridDim.y * gridDim.z;
    unsigned sum, cnt, mine, sp = 0u;
    for (;;) {
        sum = 0u; cnt = 0u; mine = 0u;
#pragma unroll
        for (unsigned j = 0; j < 16; ++j) { const unsigned c = xb_ld(&bar[XB_XCNT(j)]); sum += c; cnt += (c > 0u) ? 1u : 0u; mine = (j == x) ? c : mine; }
        if (sum == G) break;
        __builtin_amdgcn_s_sleep(1);
        if ((++sp & 255u) == 0u) { if (xb_ld(&bar[XB_TMO])) break; if (sp > XB_SPIN_CAP) { atomicAdd(&bar[XB_TMO], 1u); break; } }
    }
    nloc = mine > 0u ? mine : 1u; nx = cnt > 0u ? cnt : 1u;
}
__device__ __forceinline__ void xcd_barrier(const XcdBarrier& b) {
    asm volatile("s_waitcnt vmcnt(0)" ::: "memory");
    __syncthreads();
    if (threadIdx.x == 0) {
        unsigned* bar = b.bar;
        __builtin_amdgcn_s_waitcnt(0);
        unsigned nloc = b.st[0], nx = b.st[1];
        if (nloc == 0u) { xcd_barrier_complete(bar, b.x, nloc, nx); b.st[0] = nloc; b.st[1] = nx; }
        const unsigned old = xb_add(&bar[XB_XSUB(b.x)], 1u);
        const unsigned gen = old / nloc;
        if (old + 1u == (gen + 1u) * nloc) {
            __builtin_amdgcn_fence(__ATOMIC_RELEASE, "agent");
            asm volatile("s_waitcnt vmcnt(0)" ::: "memory");
            const unsigned og = xb_add(&bar[XB_TOP], 1u);
            const unsigned tg = og / nx;
            if (og + 1u == (tg + 1u) * nx) xb_add(&bar[XB_TOPGEN], 1u);
            else XB_SPIN(xb_ld(&bar[XB_TOPGEN]) == tg, bar);
            __builtin_amdgcn_fence(__ATOMIC_ACQUIRE, "agent");
            xb_add(&bar[XB_XGEN(b.x)], 1u);
            asm volatile("s_waitcnt vmcnt(0)" ::: "memory");
        } else {
            XB_SPIN(xb_ld(&bar[XB_XGEN(b.x)]) == gen, bar);
            __builtin_amdgcn_fence(__ATOMIC_ACQUIRE, "agent");
            asm volatile("s_waitcnt vmcnt(0)" ::: "memory");
        }
    }
    __syncthreads();
}

using pg8::Unit; using pg8::u32x4; using pg8::u32x2;
__device__ __forceinline__ unsigned pk4_u8(float a, float b2, float c, float d) { return (unsigned)__builtin_rintf(a * 255.f) | ((unsigned)__builtin_rintf(b2 * 255.f) << 8) | ((unsigned)__builtin_rintf(c * 255.f) << 16) | ((unsigned)__builtin_rintf(d * 255.f) << 24); }
#ifndef ST_AHEAD
#define ST_AHEAD 0
#endif
#ifndef NT_INPROJ
#define NT_INPROJ 0
#endif
#if NT_INPROJ == 2
__device__ __forceinline__ void st_sc1(u32x4* p, u32x4 v) { asm volatile("global_store_dwordx4 %0, %1, off sc1" :: "v"(p), "v"(v) : "memory"); }
__device__ __forceinline__ void st_sc1(u32x2* p, u32x2 v) { asm volatile("global_store_dwordx2 %0, %1, off sc1" :: "v"(p), "v"(v) : "memory"); }
#define ST_NT(T, p, v) st_sc1((T*)(p), (v))
#elif NT_INPROJ
#define ST_NT(T, p, v) __builtin_nontemporal_store((v), (T*)(p))
#else
#define ST_NT(T, p, v) (*(T*)(p) = (v))
#endif
struct EpiInProj {
    static constexpr bool PERM = true, EPI2 = (DBG_EPI2 == 2), STAMP = (PROBE_I >= 320 && PROBE_I < 330);
    bf16 *UF, *CV, *BG, *GA, *GB; const float* b_gate;
    __device__ __forceinline__ int nst(const Unit& u) const { return ST_AHEAD ? ((u.pn < 2) ? 32 : 16) : 0; }
    __device__ __forceinline__ void operator()(const f32x4 (&acc)[2][2][4][2], const Unit& u, int wr, int wc, int fr, int fq) const {
        const int row0 = u.pm * 256 + wr * 64 + fr;
        if (u.pn < 2) {
            const int b = u.pm >> 5, s0 = (u.pm & 31) * 256 + wr * 64 + fr;
#pragma unroll
            for (int ai = 0; ai < 2; ++ai)
#pragma unroll
                for (int m = 0; m < 4; ++m) { const int s = s0 + ai * 128 + m * 16;
#pragma unroll
                    for (int bj = 0; bj < 2; ++bj) { const int g4 = (u.pn * 256 + bj * 128 + wc * 32 + 8 * fq) >> 2;
#pragma unroll
                        for (int n = 0; n < 2; ++n) { const f32x4 v = acc[ai][bj][m][n]; u32x2 w; w.x = cvt_pk_bf16(v[0], v[1]); w.y = cvt_pk_bf16(v[2], v[3]);
                            ST_NT(u32x2, UF + ((size_t)(b * 128 + g4 + n) * 8192 + s) * 4, w); } } }
        } else if (u.pn < 10) {
#pragma unroll
            for (int ai = 0; ai < 2; ++ai)
#pragma unroll
                for (int m = 0; m < 4; ++m) { bf16* rowp = CV + (size_t)(row0 + ai * 128 + m * 16) * D + (u.pn - 2) * 128 + wc * 16 + 4 * fq;
#pragma unroll
                    for (int bj = 0; bj < 2; ++bj) { const f32x4 v = acc[ai][bj][m][0] * acc[ai][bj][m][1]; u32x2 w; w.x = cvt_pk_bf16(v[0], v[1]); w.y = cvt_pk_bf16(v[2], v[3]);
                        ST_NT(u32x2, rowp + bj * 64, w); } }
        } else if (u.pn < 14) {
#pragma unroll
            for (int ai = 0; ai < 2; ++ai)
#pragma unroll
                for (int m = 0; m < 4; ++m) { bf16* rowp = BG + (size_t)(row0 + ai * 128 + m * 16) * D + (u.pn - 10) * 256 + wc * 32 + 8 * fq;
#pragma unroll
                    for (int bj = 0; bj < 2; ++bj) { const f32x4 v0 = acc[ai][bj][m][0], v1 = acc[ai][bj][m][1]; u32x4 w; w.x = cvt_pk_bf16(v0[0], v0[1]); w.y = cvt_pk_bf16(v0[2], v0[3]); w.z = cvt_pk_bf16(v1[0], v1[1]); w.w = cvt_pk_bf16(v1[2], v1[3]);
                        ST_NT(u32x4, rowp + bj * 128, w); } }
        } else {
            const int colg = (u.pn - 14) * 256 + wc * 32 + 8 * fq;
            bf16* O = (u.pn < 18) ? GA : GB;
            f32x4 bv[2][2];
#pragma unroll
            for (int bj = 0; bj < 2; ++bj)
#pragma unroll
                for (int n = 0; n < 2; ++n) bv[bj][n] = DBG_NOBIAS ? (f32x4){0.f, 0.f, 0.f, 0.f} : *(const f32x4*)(b_gate + colg + bj * 128 + 4 * n);
#pragma unroll
            for (int ai = 0; ai < 2; ++ai)
#pragma unroll
                for (int m = 0; m < 4; ++m) { unsigned char* rowp8 = (unsigned char*)O + (size_t)(row0 + ai * 128 + m * 16) * D + (colg & 1023);
#pragma unroll
                    for (int bj = 0; bj < 2; ++bj) { const f32x4 v0 = acc[ai][bj][m][0] + bv[bj][0], v1 = acc[ai][bj][m][1] + bv[bj][1]; u32x2 w;
                        w.x = pk4_u8(sigx(v0[0]), sigx(v0[1]), sigx(v0[2]), sigx(v0[3])); w.y = pk4_u8(sigx(v1[0]), sigx(v1[1]), sigx(v1[2]), sigx(v1[3]));
                        ST_NT(u32x2, rowp8 + bj * 128, w); } }
        }
    }
};
template <int MODE> struct EpiGateMul {
    static constexpr bool PERM = true, EPI2 = false, STAMP = false;
    bf16* O; const bf16* G;
    __device__ __forceinline__ int nst(const Unit&) const { return 0; }
    __device__ __forceinline__ void operator()(const f32x4 (&acc)[2][2][4][2], const Unit& u, int wr, int wc, int fr, int fq) const {
        const int row0 = u.pm * 256 + wr * 64 + fr, col0 = u.pn * 256 + wc * 32 + 8 * fq;
#pragma unroll
        for (int ai = 0; ai < 2; ++ai)
#pragma unroll
            for (int m = 0; m < 4; ++m) { const size_t off = (size_t)(row0 + ai * 128 + m * 16) * D + col0;
#pragma unroll
                for (int bj = 0; bj < 2; ++bj) { const u32x2 gw = __builtin_nontemporal_load((const u32x2*)((const unsigned char*)G + off + bj * 128)); const f32x4 v0 = acc[ai][bj][m][0] * (1.0f / 255.0f), v1 = acc[ai][bj][m][1] * (1.0f / 255.0f);
                    float r[8] = {(float)(gw.x & 0xffu) * v0[0], (float)((gw.x >> 8) & 0xffu) * v0[1], (float)((gw.x >> 16) & 0xffu) * v0[2], (float)(gw.x >> 24) * v0[3],
                                  (float)(gw.y & 0xffu) * v1[0], (float)((gw.y >> 8) & 0xffu) * v1[1], (float)((gw.y >> 16) & 0xffu) * v1[2], (float)(gw.y >> 24) * v1[3]};
                    if (MODE == 1) { const u32x4 ow = __builtin_nontemporal_load((const u32x4*)(O + off + bj * 128));
                        r[0] += bf_lo(ow.x); r[1] += bf_hi(ow.x); r[2] += bf_lo(ow.y); r[3] += bf_hi(ow.y); r[4] += bf_lo(ow.z); r[5] += bf_hi(ow.z); r[6] += bf_lo(ow.w); r[7] += bf_hi(ow.w); }
                    u32x4 w; w.x = cvt_pk_bf16(r[0], r[1]); w.y = cvt_pk_bf16(r[2], r[3]); w.z = cvt_pk_bf16(r[4], r[5]); w.w = cvt_pk_bf16(r[6], r[7]);
                    *(u32x4*)(O + off + bj * 128) = w; } }
    }
};
struct EpiGateBoth {
    static constexpr bool PERM = true, EPI2 = false, STAMP = false;
    bf16* O; const bf16* GAp; const bf16* GBp;
    __device__ __forceinline__ int nst(const Unit&) const { return 0; }
    __device__ __forceinline__ void operator()(const f32x4 (&acc)[2][2][4][2], const Unit& u, int wr, int wc, int fr, int fq) const {
        Unit v = u; const bool second = u.pn >= 4; v.pn = u.pn & 3;
        if (!second) { EpiGateMul<0> E{O, GAp}; E(acc, v, wr, wc, fr, fq); } else { EpiGateMul<1> E{O, GBp}; E(acc, v, wr, wc, fr, fq); }
    }
};
struct EpiResid {
    static constexpr bool PERM = true, EPI2 = (DBG_EPI2 == 5), STAMP = false;
    const float* x; bf16* X1B; const float* gate;
    __device__ __forceinline__ int nst(const Unit&) const { return 0; }
    __device__ __forceinline__ void operator()(const f32x4 (&acc)[2][2][4][2], const Unit& u, int wr, int wc, int fr, int fq) const {
        const int row0 = u.pm * 256 + wr * 64 + fr, col0 = u.pn * 256 + wc * 32 + 8 * fq, b = u.pm >> 5;
        f32x4 gv[2][2];
#pragma unroll
        for (int bj = 0; bj < 2; ++bj)
#pragma unroll
            for (int n = 0; n < 2; ++n) gv[bj][n] = *(const f32x4*)(gate + b * 6 * D + col0 + bj * 128 + 4 * n);
#pragma unroll
        for (int ai = 0; ai < 2; ++ai)
#pragma unroll
            for (int m = 0; m < 4; ++m) { const size_t off = (size_t)(row0 + ai * 128 + m * 16) * D + col0;
#pragma unroll
                for (int bj = 0; bj < 2; ++bj) { const f32x4 x0 = __builtin_nontemporal_load((const f32x4*)(x + off + bj * 128)), x1 = __builtin_nontemporal_load((const f32x4*)(x + off + bj * 128 + 4));
                    const f32x4 v0 = x0 + gv[bj][0] * acc[ai][bj][m][0], v1 = x1 + gv[bj][1] * acc[ai][bj][m][1];
                    u32x4 w; w.x = cvt_pk_bf16(v0[0], v0[1]); w.y = cvt_pk_bf16(v0[2], v0[3]); w.z = cvt_pk_bf16(v1[0], v1[1]); w.w = cvt_pk_bf16(v1[2], v1[3]);
                    *(u32x4*)(X1B + off + bj * 128) = w; }
                asm volatile("" ::: "memory"); }
    }
};
struct EpiSwiGLU {
    static constexpr bool PERM = true, EPI2 = (DBG_EPI2 == 9), STAMP = false;
    bf16* HM;
    __device__ __forceinline__ int nst(const Unit&) const { return 0; }
    __device__ __forceinline__ void operator()(const f32x4 (&acc)[2][2][4][2], const Unit& u, int wr, int wc, int fr, int fq) const {
        const int row0 = u.pm * 256 + wr * 64 + fr, col0 = u.pn * 128 + wc * 32 + 8 * fq;
#pragma unroll
        for (int ai = 0; ai < 2; ++ai)
#pragma unroll
            for (int m = 0; m < 4; ++m) { const f32x4 g0 = acc[ai][0][m][0], g1 = acc[ai][0][m][1], u0 = acc[ai][1][m][0], u1 = acc[ai][1][m][1]; u32x4 w;
                w.x = cvt_pk_bf16(silu(g0[0]) * u0[0], silu(g0[1]) * u0[1]); w.y = cvt_pk_bf16(silu(g0[2]) * u0[2], silu(g0[3]) * u0[3]);
                w.z = cvt_pk_bf16(silu(g1[0]) * u1[0], silu(g1[1]) * u1[1]); w.w = cvt_pk_bf16(silu(g1[2]) * u1[2], silu(g1[3]) * u1[3]);
                *(u32x4*)(HM + (size_t)(row0 + ai * 128 + m * 16) * DE + col0) = w; }
    }
};
typedef float f32x2v __attribute__((ext_vector_type(2)));
__device__ __forceinline__ f32x2v swiglu2(f32x2v g, f32x2v u) {
    const f32x2v e = g * (f32x2v){-1.44269504f, -1.44269504f}; f32x2v x; x.x = __builtin_amdgcn_exp2f(e.x); x.y = __builtin_amdgcn_exp2f(e.y);
    x = x + (f32x2v){1.0f, 1.0f}; f32x2v r; r.x = __builtin_amdgcn_rcpf(x.x); r.y = __builtin_amdgcn_rcpf(x.y);
    return (g * u) * r; }
__device__ __forceinline__ unsigned pk4_fp8(float a, float b2, float c, float d) { unsigned w = 0u; w = __builtin_amdgcn_cvt_pk_fp8_f32(a, b2, w, false); w = __builtin_amdgcn_cvt_pk_fp8_f32(c, d, w, true); return w; }
struct EpiSwiGLU8 {
    static constexpr bool PERM = true, EPI2 = false, STAMP = (PROBE_I >= 330 && PROBE_I < 340);
    unsigned char* HM8;
    __device__ __forceinline__ int nst(const Unit&) const { return ST_AHEAD ? 8 : 0; }
    __device__ __forceinline__ void operator()(const f32x4 (&acc)[2][2][4][2], const Unit& u, int wr, int wc, int fr, int fq) const {
        const int row0 = u.pm * 256 + wr * 64 + fr, col0 = u.pn * 128 + wc * 32 + 8 * fq;
#pragma unroll
        for (int ai = 0; ai < 2; ++ai)
#pragma unroll
            for (int m = 0; m < 4; ++m) { const f32x4 g0 = acc[ai][0][m][0], g1 = acc[ai][0][m][1], u0 = acc[ai][1][m][0], u1 = acc[ai][1][m][1]; u32x2 w;
                const f32x2v p0 = swiglu2(g0.lo, u0.lo), p1 = swiglu2(g0.hi, u0.hi), p2 = swiglu2(g1.lo, u1.lo), p3 = swiglu2(g1.hi, u1.hi);
                w.x = pk4_fp8(p0.x, p0.y, p1.x, p1.y); w.y = pk4_fp8(p2.x, p2.y, p3.x, p3.y);
                *(u32x2*)(HM8 + (size_t)(row0 + ai * 128 + m * 16) * DE + col0) = w; asm volatile("" ::: "memory"); }
    }
};
struct EpiRowScale {
    static constexpr bool PERM = true, EPI2 = (DBG_EPI2 == 10), STAMP = false;
    bf16* Y; const float* val;
    __device__ __forceinline__ int nst(const Unit&) const { return 0; }
    __device__ __forceinline__ void operator()(const f32x4 (&acc)[2][2][4][2], const Unit& u, int wr, int wc, int fr, int fq) const {
        const int row0 = u.pm * 256 + wr * 64 + fr, col0 = u.pn * 256 + wc * 32 + 8 * fq;
#pragma unroll
        for (int ai = 0; ai < 2; ++ai)
#pragma unroll
            for (int m = 0; m < 4; ++m) { const int row = row0 + ai * 128 + m * 16; const float sv = val[row];
#pragma unroll
                for (int bj = 0; bj < 2; ++bj) { const f32x4 v0 = acc[ai][bj][m][0] * sv, v1 = acc[ai][bj][m][1] * sv; u32x4 w; w.x = cvt_pk_bf16(v0[0], v0[1]); w.y = cvt_pk_bf16(v0[2], v0[3]); w.z = cvt_pk_bf16(v1[0], v1[1]); w.w = cvt_pk_bf16(v1[2], v1[3]);
                    *(u32x4*)(Y + (size_t)row * D + col0 + bj * 128) = w; } }
    }
};

struct EpiPlain {
    static constexpr bool PERM = true, EPI2 = false, STAMP = false;
    bf16* O; int ldc;
    __device__ __forceinline__ int nst(const Unit&) const { return 0; }
    __device__ __forceinline__ void operator()(const f32x4 (&acc)[2][2][4][2], const Unit& u, int wr, int wc, int fr, int fq) const {
        const int row0 = u.pm * 256 + wr * 64 + fr, col0 = u.pn * 256 + wc * 32 + 8 * fq;
#pragma unroll
        for (int ai = 0; ai < 2; ++ai)
#pragma unroll
            for (int m = 0; m < 4; ++m) { bf16* rowp = O + (size_t)(row0 + ai * 128 + m * 16) * ldc + col0;
#pragma unroll
                for (int bj = 0; bj < 2; ++bj) { const f32x4 v0 = acc[ai][bj][m][0], v1 = acc[ai][bj][m][1]; u32x4 w; w.x = cvt_pk_bf16(v0[0], v0[1]); w.y = cvt_pk_bf16(v0[2], v0[3]); w.z = cvt_pk_bf16(v1[0], v1[1]); w.w = cvt_pk_bf16(v1[2], v1[3]);
                    *(u32x4*)(rowp + bj * 128) = w; } }
    }
};
#ifndef NT_WLOAD
#define NT_WLOAD 1
#endif
__device__ __forceinline__ unsigned f2bf(float f) { unsigned u = __builtin_bit_cast(unsigned, f); return (u + 0x7fffu + ((u >> 16) & 1u)) >> 16; }
__device__ __forceinline__ unsigned pk2(float lo, float hi) { return f2bf(lo) | (f2bf(hi) << 16); }
__device__ __forceinline__ int rowmap_in(int n) {
    if (n < 512) return n;
    if (n < 1536) { const int j = n - 512; return 512 + 8 * (j >> 2) + (j & 3); }
    if (n < 2560) return 2560 + (n - 1536);
    if (n < 3584) { const int j = n - 2560; return 512 + 8 * (j >> 2) + 4 + (j & 3); }
    return n;
}
template <int MAP>
__device__ __forceinline__ void transpose_item(const float* W, int K, int N, bf16* WT, LAS float* scr, int item, int lane) {
    const int nblk = N / 32, kb = item / nblk, nb = item % nblk, k0 = 64 * kb, n0 = 32 * nb;
    { f32x4 t[8];
#pragma unroll
      for (int i = 0; i < 8; ++i) t[i] = NT_WLOAD ? __builtin_nontemporal_load((const GAS f32x4*)(W + (size_t)(k0 + 8 * i + (lane >> 3)) * N + n0 + 4 * (lane & 7))) : *(const GAS f32x4*)(W + (size_t)(k0 + 8 * i + (lane >> 3)) * N + n0 + 4 * (lane & 7));
#pragma unroll
      for (int i = 0; i < 8; ++i) { LAS float* d_ = scr + (8 * i + (lane >> 3)) * 33 + 4 * (lane & 7); d_[0] = t[i].x; d_[1] = t[i].y; d_[2] = t[i].z; d_[3] = t[i].w; } }
    LDS_WAIT(); asm volatile("" ::: "memory");
    const int c = lane & 7;
#pragma unroll
    for (int j = 0; j < 4; ++j) { const int n = (lane >> 3) + 8 * j; const LAS float* s = scr + (8 * c) * 33 + n;
        v4u o; o.x = pk2(s[0 * 33], s[1 * 33]); o.y = pk2(s[2 * 33], s[3 * 33]); o.z = pk2(s[4 * 33], s[5 * 33]); o.w = pk2(s[6 * 33], s[7 * 33]);
        const int ns = n0 + n; int row;
        if (MAP == 0) row = ns; else if (MAP == 1) row = rowmap_in(ns); else if (MAP == 2) row = 256 * (ns >> 7) + (ns & 127); else row = 256 * (ns >> 7) + 128 + (ns & 127);
        *(GAS v4u*)(WT + (size_t)row * K + k0 + 8 * c) = o; }
    LDS_WAIT(); asm volatile("" ::: "memory");
}
template <int MAP>
__device__ __forceinline__ void transpose_item8(const float* W, int K, int N, unsigned char* WT, LAS float* scr, int item, int lane) {
    const int nblk = N / 32, kb = item / nblk, nb = item % nblk, k0 = 64 * kb, n0 = 32 * nb;
    { f32x4 t[8];
#pragma unroll
      for (int i = 0; i < 8; ++i) t[i] = NT_WLOAD ? __builtin_nontemporal_load((const GAS f32x4*)(W + (size_t)(k0 + 8 * i + (lane >> 3)) * N + n0 + 4 * (lane & 7))) : *(const GAS f32x4*)(W + (size_t)(k0 + 8 * i + (lane >> 3)) * N + n0 + 4 * (lane & 7));
#pragma unroll
      for (int i = 0; i < 8; ++i) { LAS float* d_ = scr + (8 * i + (lane >> 3)) * 33 + 4 * (lane & 7); d_[0] = t[i].x; d_[1] = t[i].y; d_[2] = t[i].z; d_[3] = t[i].w; } }
    LDS_WAIT(); asm volatile("" ::: "memory");
    const int c = lane & 3;
#pragma unroll
    for (int j = 0; j < 2; ++j) { const int n = (lane >> 2) + 16 * j; const LAS float* s = scr + (16 * c) * 33 + n; unsigned o[4];
#pragma unroll
        for (int q = 0; q < 4; ++q) { unsigned w = 0u; w = __builtin_amdgcn_cvt_pk_fp8_f32(s[(4 * q) * 33] * 128.f, s[(4 * q + 1) * 33] * 128.f, w, false); w = __builtin_amdgcn_cvt_pk_fp8_f32(s[(4 * q + 2) * 33] * 128.f, s[(4 * q + 3) * 33] * 128.f, w, true); o[q] = w; }
        const int ns = n0 + n; int row;
        if (MAP == 0) row = ns; else if (MAP == 2) row = 256 * (ns >> 7) + (ns & 127); else row = 256 * (ns >> 7) + 128 + (ns & 127);
        v4u ov; ov.x = o[0]; ov.y = o[1]; ov.z = o[2]; ov.w = o[3];
        *(GAS v4u*)(WT + (size_t)row * K + k0 + 16 * c) = ov; }
    LDS_WAIT(); asm volatile("" ::: "memory");
}
#ifndef EXP_SCAT
#define EXP_SCAT 1
#endif
#define EXPW_PARAMS const float* xw_g, const float* xw_u, const float* xw_d, unsigned char* xWGU8, unsigned char* xWD8
#define EXPW_ARGS xw_g, xw_u, xw_d, xWGU8, xWD8
__device__ __forceinline__ void exp_src(EXPW_PARAMS, int r, const float*& W, int& N, int& k0, int& n0) {
    const int e = r / 3072, q = r % 3072, t = q >> 10, it = ((q & 1023) * EXP_SCAT) & 1023;
    if (t < 2) { W = (t == 0 ? xw_g : xw_u) + (size_t)e * D * DE; N = DE; } else { W = xw_d + (size_t)e * DE * D; N = D; }
    const int nblk = N / 32; k0 = 64 * (it / nblk); n0 = 32 * (it % nblk);
}
__device__ __forceinline__ void exp_load(EXPW_PARAMS, int r, int lane, f32x4 (&t)[8]) {
    const float* W; int N, k0, n0; exp_src(EXPW_ARGS, r, W, N, k0, n0);
#pragma unroll
    for (int i = 0; i < 8; ++i) t[i] = __builtin_nontemporal_load((const GAS f32x4*)(W + (size_t)(k0 + 8 * i + (lane >> 3)) * N + n0 + 4 * (lane & 7)));
}
__device__ __forceinline__ void exp_finish(EXPW_PARAMS, int r, int lane, const f32x4 (&t)[8], LAS float* scr) {
    const float* W; int N, k0, n0; exp_src(EXPW_ARGS, r, W, N, k0, n0);
    const int e = r / 3072, ty = (r % 3072) >> 10, K = (ty < 2) ? D : DE;
    unsigned char* WT = (ty < 2) ? xWGU8 + (size_t)e * 4096 * D : xWD8 + (size_t)e * D * DE;
#pragma unroll
    for (int i = 0; i < 8; ++i) { LAS float* d_ = scr + (8 * i + (lane >> 3)) * 33 + 4 * (lane & 7); d_[0] = t[i].x; d_[1] = t[i].y; d_[2] = t[i].z; d_[3] = t[i].w; }
    LDS_WAIT(); asm volatile("" ::: "memory");
    const int c = lane & 3;
#pragma unroll
    for (int j = 0; j < 2; ++j) { const int n = (lane >> 2) + 16 * j; const LAS float* s = scr + (16 * c) * 33 + n; unsigned o[4];
#pragma unroll
        for (int q = 0; q < 4; ++q) { unsigned w = 0u; w = __builtin_amdgcn_cvt_pk_fp8_f32(s[(4 * q) * 33] * 128.f, s[(4 * q + 1) * 33] * 128.f, w, false); w = __builtin_amdgcn_cvt_pk_fp8_f32(s[(4 * q + 2) * 33] * 128.f, s[(4 * q + 3) * 33] * 128.f, w, true); o[q] = w; }
        const int ns = n0 + n; const int row = (ty == 2) ? ns : 256 * (ns >> 7) + (ty == 1 ? 128 : 0) + (ns & 127);
        v4u ov; ov.x = o[0]; ov.y = o[1]; ov.z = o[2]; ov.w = o[3];
        *(GAS v4u*)(WT + (size_t)row * K + k0 + 16 * c) = ov; }
    LDS_WAIT(); asm volatile("" ::: "memory");
}
__device__ __forceinline__ void expert_range(EXPW_PARAMS, int first, int end, int stride, int lane, LAS float* scr) {
    if (first >= end) return;
    const int lastr = first + ((end - 1 - first) / stride) * stride, s2 = 2 * stride;
    f32x4 t0[8], t1[8], t2[8]; exp_load(EXPW_ARGS, first, lane, t0); { const int r1 = first + stride; exp_load(EXPW_ARGS, r1 <= lastr ? r1 : 0, lane, t1); }
    int r = first;
    for (;;) {
        exp_load(EXPW_ARGS, (r + s2 <= lastr) ? r + s2 : 0, lane, t2); exp_finish(EXPW_ARGS, r, lane, t0, scr); r += stride; if (r >= end) break;
        exp_load(EXPW_ARGS, (r + s2 <= lastr) ? r + s2 : 0, lane, t0); exp_finish(EXPW_ARGS, r, lane, t1, scr); r += stride; if (r >= end) break;
        exp_load(EXPW_ARGS, (r + s2 <= lastr) ? r + s2 : 0, lane, t1); exp_finish(EXPW_ARGS, r, lane, t2, scr); r += stride; if (r >= end) break;
    }
}
__device__ __forceinline__ void wf_item(const float* wf, bf16* WF_T, int item, int lane) {
    const int c = item >> 2, dblk = item & 3, g = c >> 7, j = c & 127, d0 = 256 * dblk + 4 * lane;
    f32x4 ac = {0.f, 0.f, 0.f, 0.f}, as = {0.f, 0.f, 0.f, 0.f};
    for (int m = 0; m < 128; ++m) { const f32x4 wv = *(const GAS f32x4*)(wf + (size_t)(g * 128 + m) * D + d0); const float fr = (float)((m * j) & 127) * (1.0f / 128.0f);
        const float cv = __builtin_amdgcn_cosf(fr), sv = __builtin_amdgcn_sinf(fr); ac += cv * wv; as += sv * wv; }
    const int kv = 8 * (c >> 2) + 2 * (c & 3);
#pragma unroll
    for (int i = 0; i < 4; ++i) *(GAS unsigned*)(WF_T + (size_t)(d0 + i) * D + kv) = pk2(ac[i] * (1.0f / 1024.0f), as[i] * (1.0f / 1024.0f));
}
__device__ __forceinline__ void fc_tables(bf16* Fc1, bf16* Fc2, int gtid, int gthreads) {
    for (int e = gtid; e < 8192 + 65536; e += gthreads) {
        if (e < 8192) { const int j = e & 7, ln = (e >> 3) & 63, kk = (e >> 9) & 1, mt = (e >> 10) & 3, hh = e >> 12, rho = ln & 15;
            const int s1 = 32 * kk + 8 * (ln >> 4) + j, k1 = 32 * hh + 16 * (mt & 1) + 4 * (rho & 3) + (rho >> 2);
            const float fr = (float)((k1 * s1) & 63) * (1.0f / 64.0f); Fc1[e] = (bf16)f2bf((mt >> 1) == 0 ? cospif(2.0f * fr) : -sinpif(2.0f * fr)); }
        else { const int q = e - 8192, j = q & 7, ln = (q >> 3) & 63, kk = (q >> 9) & 7, ro = (q >> 12) & 1, w = q >> 13;
            const int k2 = 16 * w + (ln & 15), kap = 32 * kk + 8 * (ln >> 4) + j, s2 = kap >> 1, ri = kap & 1;
            const float fr = (float)((k2 * s2) & 127) * (1.0f / 128.0f), cv = cospif(2.0f * fr), sv = sinpif(2.0f * fr);
            Fc2[q] = (bf16)f2bf(ro == 0 ? (ri == 0 ? cv : sv) : (ri == 0 ? -sv : cv)); }
    }
}
__device__ __forceinline__ void mod_item(const float* c, const float* w_ada, float* modp, LAS unsigned char* lds, int item, int tid, int wave, int lane) {
    const int cb = item % 24, kq = item / 24, col0 = 256 * cb + 4 * lane;
    f32x4 a0 = {0.f, 0.f, 0.f, 0.f}, a1 = {0.f, 0.f, 0.f, 0.f};
#pragma unroll
    for (int i0 = 0; i0 < 32; i0 += 16) { f32x4 wv[16];
#pragma unroll
        for (int i = 0; i < 16; ++i) wv[i] = __builtin_nontemporal_load((const GAS f32x4*)(w_ada + (size_t)(256 * kq + 32 * wave + i0 + i) * 6 * D + col0));
#pragma unroll
        for (int i = 0; i < 16; ++i) { const int d = 256 * kq + 32 * wave + i0 + i; a0 += silu(c[d]) * wv[i]; a1 += silu(c[D + d]) * wv[i]; } }
    LAS f32x4* red = (LAS f32x4*)lds;
    red[(wave * 2 + 0) * 64 + lane] = a0; red[(wave * 2 + 1) * 64 + lane] = a1;
    __syncthreads();
    { const int b = tid >> 8, cc = tid & 255; const LAS float* rf = (const LAS float*)lds; float s = 0.f;
#pragma unroll
      for (int w = 0; w < 8; ++w) s += rf[((w * 2 + b) * 64) * 4 + cc];
      modp[(size_t)(kq * 2 + b) * 6 * D + 256 * cb + cc] = s; }
    asm volatile("s_waitcnt vmcnt(0)" ::: "memory");
    __syncthreads();
}

__device__ __forceinline__ void phase_h(const float* x, const float* g_mix, const float* b_ada, const float* modp, float* mod, bf16* H1, LAS unsigned char* lds, int tid, int wave, int lane, int vcu, int G) {
    LAS float* ga = (LAS float*)lds;
    LAS float* sh = ga + 2 * D;
    { float v[8];
#pragma unroll
      for (int k = 0; k < 8; ++k) { const int i = tid + 512 * k, j = i & 2047; v[k] = b_ada[j]; }
#pragma unroll
      for (int q = 0; q < 4; ++q)
#pragma unroll
          for (int k = 0; k < 8; ++k) { const int i = tid + 512 * k, b = i >> 11, j = i & 2047; v[k] += modp[(size_t)(q * 2 + b) * 6 * D + j]; }
#pragma unroll
      for (int k = 0; k < 8; ++k) { const int i = tid + 512 * k, b = i >> 11, j = i & 2047; if (j < D) sh[b * D + j] = v[k]; else ga[b * D + j - D] = g_mix[j - D] * (1.f + v[k]); } }
    { const int i = vcu * NWAVES * 64 + tid;
      if (i < 2 * 6 * D) { const int b = i / (6 * D), j = i % (6 * D); float v = b_ada[j];
#pragma unroll
          for (int q = 0; q < 4; ++q) v += modp[(size_t)(q * 2 + b) * 6 * D + j];
          mod[i] = v; } }
    __syncthreads();
    const int gw = vcu * NWAVES + wave, NGW = G * NWAVES;
    for (int m0 = gw * 4; m0 < M; m0 += NGW * 4) { const int b = m0 >> 13;
        f32x4 v[4][4]; float s[4];
#pragma unroll
        for (int r = 0; r < 4; ++r) { const GAS f32x4* xr = (const GAS f32x4*)(x + (size_t)(m0 + r) * D) + lane;
#pragma unroll
            for (int j = 0; j < 4; ++j) v[r][j] = __builtin_nontemporal_load(xr + 64 * j); }
#pragma unroll
        for (int r = 0; r < 4; ++r) { s[r] = 0.f;
#pragma unroll
            for (int j = 0; j < 4; ++j) s[r] += (v[r][j].x * v[r][j].x + v[r][j].y * v[r][j].y) + (v[r][j].z * v[r][j].z + v[r][j].w * v[r][j].w); }
#pragma unroll
        for (int o = 1; o < 64; o <<= 1) {
#pragma unroll
            for (int r = 0; r < 4; ++r) s[r] += __shfl_xor(s[r], o); }
#pragma unroll
        for (int r = 0; r < 4; ++r) { const float rr = rsqrtf(s[r] * (1.f / D) + RMS_EPS); GAS v2u* o8 = (GAS v2u*)(H1 + (size_t)(m0 + r) * D) + lane;
#pragma unroll
            for (int j = 0; j < 4; ++j) { const f32x4 gg = *(const LAS f32x4*)(ga + b * D + 4 * lane + 256 * j), ss = *(const LAS f32x4*)(sh + b * D + 4 * lane + 256 * j); const f32x4 y = v[r][j] * rr * gg + ss;
                v2u w; w.x = cvt_pk_bf16(y.x, y.y); w.y = cvt_pk_bf16(y.z, y.w); o8[64 * j] = w; } } }
    __syncthreads();
}
__device__ __forceinline__ void phase_conv(const bf16* CV, const bf16* BG, const float* w_conv, bf16* AB, int wave, int lane, int vcu, int G) {
    const int gw = vcu * NWAVES + wave, NGW = G * NWAVES;
    for (int o = gw; o < M / 8; o += NGW) { const int r0 = 8 * o, s0 = r0 & (SEQ - 1);
#pragma unroll
        for (int hseg = 0; hseg < 2; ++hseg) { const int ch = hseg * 512 + 8 * lane; const size_t off = (size_t)r0 * D + ch;
            v4u cv[10], bg[8];
#pragma unroll
            for (int jj = 0; jj < 10; ++jj) { const bool ok = (jj == 0) ? (s0 > 0) : (jj == 9) ? (s0 + 8 < SEQ) : true; cv[jj] = (v4u){0u, 0u, 0u, 0u}; if (ok) cv[jj] = __builtin_nontemporal_load((const GAS v4u*)(CV + off + (size_t)(jj - 1) * D)); }
#pragma unroll
            for (int jj = 0; jj < 8; ++jj) bg[jj] = __builtin_nontemporal_load((const GAS v4u*)(BG + off + (size_t)jj * D));
            float w0[8], w1[8], w2[8];
#pragma unroll
            for (int q = 0; q < 2; ++q) { const f32x4 a = *(const GAS f32x4*)(w_conv + ch + 4 * q), b = *(const GAS f32x4*)(w_conv + D + ch + 4 * q), c2 = *(const GAS f32x4*)(w_conv + 2 * D + ch + 4 * q);
#pragma unroll
                for (int i2 = 0; i2 < 4; ++i2) { w0[4 * q + i2] = a[i2]; w1[4 * q + i2] = b[i2]; w2[4 * q + i2] = c2[i2]; } }
#pragma unroll
            for (int jj = 0; jj < 8; ++jj) { unsigned ow[4];
#pragma unroll
                for (int q = 0; q < 4; ++q) {
                    const float lo = bf_lo(bg[jj][q]) * (w0[2 * q] * bf_lo(cv[jj][q]) + w1[2 * q] * bf_lo(cv[jj + 1][q]) + w2[2 * q] * bf_lo(cv[jj + 2][q]));
                    const float hi = bf_hi(bg[jj][q]) * (w0[2 * q + 1] * bf_hi(cv[jj][q]) + w1[2 * q + 1] * bf_hi(cv[jj + 1][q]) + w2[2 * q + 1] * bf_hi(cv[jj + 2][q]));
                    ow[q] = cvt_pk_bf16(lo, hi); }
                v4u ov; ov.x = ow[0]; ov.y = ow[1]; ov.z = ow[2]; ov.w = ow[3];
                *(GAS v4u*)(AB + off + (size_t)jj * D) = ov; } } }
}
__device__ __forceinline__ void phase_h2(const bf16* X1B, const float* g_moe, const float* mod, const float* w_router, const float* b_router, bf16* H2, unsigned char* H2F8, float* probs,
                                         LAS unsigned char* lds, int tid, int wave, int lane, int vcu, int G) {
    LAS bf16* whi = (LAS bf16*)lds;
    LAS bf16* wlo = whi + 16384;
    LAS float* ga = (LAS float*)(lds + 65536);
    LAS float* sh = ga + 2 * D;
    for (int i = tid; i < 16384; i += NWAVES * 64) { const int j = i & 7, ln = (i >> 3) & 63, kk = i >> 9, k = 32 * kk + 8 * (ln >> 4) + j, e = ln & 15;
        const float w = w_router[k * NE + e]; const unsigned h = f2bf(w); const float wh = __uint_as_float(h << 16); whi[i] = (bf16)h; wlo[i] = (bf16)f2bf(w - wh); }
    { float a[4], b2[4], c2[4];
#pragma unroll
      for (int k = 0; k < 4; ++k) { const int i = tid + 512 * k, b = i >> 10, j = i & 1023; a[k] = mod[b * 6 * D + 3 * D + j]; b2[k] = mod[b * 6 * D + 4 * D + j]; c2[k] = g_moe[j]; }
#pragma unroll
      for (int k = 0; k < 4; ++k) { const int i = tid + 512 * k; sh[i] = a[k]; ga[i] = c2[k] * (1.f + b2[k]); } }
    __syncthreads();
    const int n = lane & 15, kq = lane >> 4;
    float br[4];
#pragma unroll
    for (int r = 0; r < 4; ++r) br[r] = b_router[4 * kq + r];
    for (int grp = wave * G + vcu; grp < M / 16; grp += NWAVES * G) { const int m0 = 16 * grp, b = m0 >> 13;
        const GAS v4u* xr = (const GAS v4u*)(X1B + (size_t)(m0 + n) * D + 8 * kq);
        v4u xf[32]; float ssq = 0.f;
#pragma unroll
        for (int kk = 0; kk < 32; ++kk) xf[kk] = __builtin_nontemporal_load(xr + 4 * kk);
#pragma unroll
        for (int kk = 0; kk < 32; ++kk) { const v4u w = xf[kk]; const float e0 = bf_lo(w.x), e1 = bf_hi(w.x), e2 = bf_lo(w.y), e3 = bf_hi(w.y), e4 = bf_lo(w.z), e5 = bf_hi(w.z), e6 = bf_lo(w.w), e7 = bf_hi(w.w);
            ssq += (e0 * e0 + e1 * e1) + (e2 * e2 + e3 * e3) + (e4 * e4 + e5 * e5) + (e6 * e6 + e7 * e7); }
#pragma unroll
        for (int kk = 0; kk < 32; ++kk) asm volatile("" : "+v"(xf[kk].x), "+v"(xf[kk].y), "+v"(xf[kk].z), "+v"(xf[kk].w));
        ssq += __shfl_xor(ssq, 16); ssq += __shfl_xor(ssq, 32);
        const float rstd = rsqrtf(ssq * (1.f / D) + RMS_EPS);
        f32x4 acc = {0.f, 0.f, 0.f, 0.f};
        GAS v4u* ho = (GAS v4u*)(H2 + (size_t)(m0 + n) * D + 8 * kq);
#pragma unroll
        for (int kk = 0; kk < 32; ++kk) { const v4u w = xf[kk]; const int col = 32 * kk + 8 * kq;
            const f32x4 g0 = *(const LAS f32x4*)(ga + b * D + col), g1 = *(const LAS f32x4*)(ga + b * D + col + 4), s0 = *(const LAS f32x4*)(sh + b * D + col), s1 = *(const LAS f32x4*)(sh + b * D + col + 4);
            float h[8] = {bf_lo(w.x) * rstd * g0.x + s0.x, bf_hi(w.x) * rstd * g0.y + s0.y, bf_lo(w.y) * rstd * g0.z + s0.z, bf_hi(w.y) * rstd * g0.w + s0.w,
                          bf_lo(w.z) * rstd * g1.x + s1.x, bf_hi(w.z) * rstd * g1.y + s1.y, bf_lo(w.w) * rstd * g1.z + s1.z, bf_hi(w.w) * rstd * g1.w + s1.w};
            v4u hh, hl;
            hh.x = cvt_pk_bf16(h[0], h[1]); hh.y = cvt_pk_bf16(h[2], h[3]); hh.z = cvt_pk_bf16(h[4], h[5]); hh.w = cvt_pk_bf16(h[6], h[7]);
            hl.x = cvt_pk_bf16(h[0] - bf_lo(hh.x), h[1] - bf_hi(hh.x)); hl.y = cvt_pk_bf16(h[2] - bf_lo(hh.y), h[3] - bf_hi(hh.y)); hl.z = cvt_pk_bf16(h[4] - bf_lo(hh.z), h[5] - bf_hi(hh.z)); hl.w = cvt_pk_bf16(h[6] - bf_lo(hh.w), h[7] - bf_hi(hh.w));
            if (MOE_FP8) { v2u q8; q8.x = pk4_fp8(h[0], h[1], h[2], h[3]); q8.y = pk4_fp8(h[4], h[5], h[6], h[7]); *(GAS v2u*)(H2F8 + (size_t)(m0 + n) * D + 32 * kk + 8 * kq) = q8; }
            else ho[4 * kk] = hh;
            const bf16x8 ah = *(const LAS bf16x8*)(whi + (kk * 64 + lane) * 8), al = *(const LAS bf16x8*)(wlo + (kk * 64 + lane) * 8);
            const bf16x8 bh = __builtin_bit_cast(bf16x8, hh), bl = __builtin_bit_cast(bf16x8, hl);
            acc = __builtin_amdgcn_mfma_f32_16x16x32_bf16(ah, bh, acc, 0, 0, 0); acc = __builtin_amdgcn_mfma_f32_16x16x32_bf16(al, bh, acc, 0, 0, 0); acc = __builtin_amdgcn_mfma_f32_16x16x32_bf16(ah, bl, acc, 0, 0, 0);
            asm volatile("" ::: "memory"); }
        float lg[4], mx = -3.0e38f;
#pragma unroll
        for (int r = 0; r < 4; ++r) { lg[r] = acc[r] + br[r]; mx = fmaxf(mx, lg[r]); }
        mx = fmaxf(mx, __shfl_xor(mx, 16)); mx = fmaxf(mx, __shfl_xor(mx, 32));
        float sum = 0.f;
#pragma unroll
        for (int r = 0; r < 4; ++r) { lg[r] = __expf(lg[r] - mx); sum += lg[r]; }
        sum += __shfl_xor(sum, 16); sum += __shfl_xor(sum, 32);
        const float inv = 1.0f / sum; const int s = (m0 + n) & (SEQ - 1);
#pragma unroll
        for (int r = 0; r < 4; ++r) probs[((size_t)(b * NE + 4 * kq + r)) * SEQ + s] = lg[r] * inv; }
}
__device__ __forceinline__ void topk_item(const float* probs, int* idx, float* val, int* slot, LAS unsigned char* lds, int item, int tid, int wave, int lane) {
    const int e = item >> 1, b = item & 1;
    LAS int* red = (LAS int*)lds;
    unsigned p[16];
#pragma unroll
    for (int q = 0; q < 4; ++q) { const v4u w = __builtin_nontemporal_load((const GAS v4u*)(probs + ((size_t)(b * NE + e)) * SEQ + 16 * tid + 4 * q)); p[4 * q] = w.x; p[4 * q + 1] = w.y; p[4 * q + 2] = w.z; p[4 * q + 3] = w.w; }
    unsigned prefix = 0u;
    for (int bit = 30; bit >= 0; --bit) { const unsigned cand = prefix | (1u << bit); int cnt = 0;
#pragma unroll
        for (int j = 0; j < 16; ++j) cnt += __popcll(__ballot(p[j] >= cand));
        const int par = bit & 1;
        if (lane == 0) red[par * 8 + wave] = cnt;
        __syncthreads();
        int tot = 0;
#pragma unroll
        for (int w = 0; w < 8; ++w) tot += red[par * 8 + w];
        if (tot >= CAP) prefix = cand; }
    const unsigned T = prefix;
    int cgt = 0, ceq = 0;
#pragma unroll
    for (int j = 0; j < 16; ++j) { cgt += (p[j] > T) ? 1 : 0; ceq += (p[j] == T) ? 1 : 0; }
    int sgt = cgt, seq = ceq;
#pragma unroll
    for (int o = 1; o < 64; o <<= 1) { const int a = __shfl_up(sgt, o), c = __shfl_up(seq, o); if (lane >= o) { sgt += a; seq += c; } }
    __syncthreads();
    if (lane == 63) { red[32 + wave] = sgt; red[48 + wave] = seq; }
    __syncthreads();
    int bgt = 0, beq = 0, totgt = 0;
#pragma unroll
    for (int w = 0; w < 8; ++w) { const int a = red[32 + w], c = red[48 + w]; if (w < wave) { bgt += a; beq += c; } totgt += a; }
    int rgt = bgt + sgt - cgt, req = beq + seq - ceq;
    const int need = CAP - totgt; const int rbase = (e * 2 + b) * CAP;
#pragma unroll
    for (int j = 0; j < 16; ++j) { const int tok = b * SEQ + 16 * tid + j; int sl = -1;
        if (p[j] > T) { sl = rgt; ++rgt; } else if (p[j] == T) { if (req < need) sl = totgt + req; ++req; }
        slot[(size_t)tok * NE + e] = sl;
        if (sl >= 0) { idx[rbase + sl] = tok; val[rbase + sl] = __uint_as_float(p[j]); } }
    __syncthreads();
}
__device__ __forceinline__ void phase_gather(const bf16* H2, const int* idx, bf16* XE, int wave, int lane, int vcu, int G) {
    const int gw = vcu * NWAVES + wave, NGW = G * NWAVES;
    for (int r = gw; r < MR; r += NGW) { const int tok = idx[r];
        const GAS v4u* src = (const GAS v4u*)(H2 + (size_t)tok * D) + lane; GAS v4u* dst = (GAS v4u*)(XE + (size_t)r * D) + lane;
        const v4u a = src[0], b2 = src[64]; dst[0] = a; dst[64] = b2; }
}
__device__ __forceinline__ void phase_final(float* out, const bf16* X1B, const bf16* Y, const int* slot, const float* mod, const float* g_fin, int wave, int lane, int vcu, int G, float pert) {
    const int gw = vcu * NWAVES + wave, NGW = G * NWAVES;
    int slv[2]; v2u xw[2][4];
#define PF_FETCH(mm) do { _Pragma("unroll") for (int r = 0; r < 2; ++r) { slv[r] = slot[(size_t)((mm) + r) * NE + (lane & 15)]; const GAS v2u* xr_ = (const GAS v2u*)(X1B + (size_t)((mm) + r) * D) + lane; \
        _Pragma("unroll") for (int j = 0; j < 4; ++j) xw[r][j] = __builtin_nontemporal_load(xr_ + 64 * j); } } while (0)
    int m0 = gw * 2;
    if (m0 < M) PF_FETCH(m0);
    for (; m0 < M; m0 += NGW * 2) { const int b = m0 >> 13;
        int cs[2]; f32x4 v[2][4], a[2][4];
#pragma unroll
        for (int r = 0; r < 2; ++r) { cs[r] = slv[r];
#pragma unroll
            for (int j = 0; j < 4; ++j) { const v2u w = xw[r][j]; v[r][j] = (f32x4){bf_lo(w.x), bf_hi(w.x), bf_lo(w.y), bf_hi(w.y)}; a[r][j] = (f32x4){0.f, 0.f, 0.f, 0.f}; } }
        const int mn = m0 + NGW * 2;
        if (mn < M) PF_FETCH(mn);
        unsigned long long mask[2]; bool more = false;
#pragma unroll
        for (int r = 0; r < 2; ++r) mask[r] = __ballot(cs[r] >= 0) & 0xFFFFull;
        do { const GAS v2u* yp[2][4]; bool ok[2][4]; v2u w[2][4][4];
#pragma unroll
            for (int r = 0; r < 2; ++r)
#pragma unroll
                for (int c = 0; c < 4; ++c) { ok[r][c] = (mask[r] != 0ull); const int e = ok[r][c] ? (int)__builtin_ctzll(mask[r]) : 0; mask[r] &= (mask[r] - 1ull);
                    const int sl = __builtin_amdgcn_readlane(cs[r], e); yp[r][c] = (const GAS v2u*)(Y + ((size_t)(e * 2 + b) * CAP + (ok[r][c] ? sl : 0)) * D) + lane; }
#pragma unroll
            for (int r = 0; r < 2; ++r)
#pragma unroll
                for (int c = 0; c < 4; ++c) if (ok[r][c]) {
#pragma unroll
                    for (int j = 0; j < 4; ++j) w[r][c][j] = __builtin_nontemporal_load(yp[r][c] + 64 * j); }
#pragma unroll
            for (int r = 0; r < 2; ++r)
#pragma unroll
                for (int c = 0; c < 4; ++c) if (ok[r][c]) {
#pragma unroll
                    for (int j = 0; j < 4; ++j) { a[r][j].x += bf_lo(w[r][c][j].x); a[r][j].y += bf_hi(w[r][c][j].x); a[r][j].z += bf_lo(w[r][c][j].y); a[r][j].w += bf_hi(w[r][c][j].y); } }
            more = (mask[0] | mask[1]) != 0ull;
        } while (more);
        float s[2];
#pragma unroll
        for (int r = 0; r < 2; ++r) { s[r] = 0.f;
#pragma unroll
            for (int j = 0; j < 4; ++j) { const f32x4 gf = *(const GAS f32x4*)(mod + b * 6 * D + 5 * D + 4 * lane + 256 * j); v[r][j] = v[r][j] + gf * a[r][j]; s[r] += (v[r][j].x * v[r][j].x + v[r][j].y * v[r][j].y) + (v[r][j].z * v[r][j].z + v[r][j].w * v[r][j].w); } }
#pragma unroll
        for (int o = 1; o < 64; o <<= 1) { s[0] += __shfl_xor(s[0], o); s[1] += __shfl_xor(s[1], o); }
#pragma unroll
        for (int r = 0; r < 2; ++r) { const float rr = rsqrtf(s[r] * (1.f / D) + RMS_EPS); GAS f32x4* xo = (GAS f32x4*)(out + (size_t)(m0 + r) * D) + lane;
#pragma unroll
            for (int j = 0; j < 4; ++j) { const f32x4 gg = *(const GAS f32x4*)(g_fin + 4 * lane + 256 * j); __builtin_nontemporal_store(v[r][j] * rr * gg + pert, xo + 64 * j); } } }
#undef PF_FETCH
}
__device__ __forceinline__ void fft_item(LAS unsigned char* lds, const bf16* UF, bf16* ZF, const bf16* Fc1, const bf16* Fc2, int item, int wave, int lane, unsigned long long* ts) {
#define FFT_STAMP(i_) do { if (ts && blockIdx.x == 0 && threadIdx.x == 0) ts[34 + (i_)] = __builtin_amdgcn_s_memrealtime(); } while (0)
    FFT_STAMP(0);
    const char* slab = (const char*)UF + (size_t)item * 65536;
    { v4u xv[8];
#pragma unroll
      for (int p = 0; p < 8; ++p) { const int s1 = 8 * p + wave; xv[p] = __builtin_nontemporal_load((const GAS v4u*)(slab + s1 * 1024 + ((16 * lane - 32 * ((s1 >> 3) & 3)) & 1023))); }
#pragma unroll
      for (int p = 0; p < 8; ++p) *(LAS v4u*)(lds + (8 * p + wave) * 1024 + 16 * lane) = xv[p]; }
    bf16x8 A2[2][8];
#pragma unroll
    for (int ro = 0; ro < 2; ++ro)
#pragma unroll
        for (int kk = 0; kk < 8; ++kk) A2[ro][kk] = *(const GAS bf16x8*)(Fc2 + ((size_t)(((wave * 2 + ro) * 8 + kk) * 64 + lane)) * 8);
    LDS_WAIT(); __syncthreads(); FFT_STAMP(1);
    const int fr = lane & 15, fq = lane >> 4, ch = lane & 3, s2l = (lane & 15) >> 2;
    char* zb = (char*)ZF + (size_t)item * 131072;
    for (int hh = 0; hh < 2; ++hh) {
        { bf16x8 A1[4][2];
#pragma unroll
          for (int mt = 0; mt < 4; ++mt)
#pragma unroll
              for (int kk = 0; kk < 2; ++kk) A1[mt][kk] = *(const GAS bf16x8*)(Fc1 + ((size_t)(((hh * 4 + mt) * 2 + kk) * 64 + lane)) * 8);
          for (int jn = 0; jn < 4; ++jn) { const int nt = wave + 8 * jn, s2 = 4 * nt + s2l;
            bf16x8 Bx[2];
#pragma unroll
            for (int kk = 0; kk < 2; ++kk)
#pragma unroll
                for (int j = 0; j < 8; ++j) { const int s1 = 32 * kk + 8 * fq + j; Bx[kk][j] = *(const LAS short*)(lds + s1 * 1024 + ((s2 * 8 + ch * 2 + 32 * fq) & 1023)); }
            f32x4 acc[4];
#pragma unroll
            for (int mt = 0; mt < 4; ++mt) { acc[mt] = (f32x4){0.f, 0.f, 0.f, 0.f};
#pragma unroll
                for (int kk = 0; kk < 2; ++kk) acc[mt] = __builtin_amdgcn_mfma_f32_16x16x32_bf16(A1[mt][kk], Bx[kk], acc[mt], 0, 0, 0); }
#pragma unroll
            for (int blk = 0; blk < 2; ++blk)
#pragma unroll
                for (int r = 0; r < 4; ++r) { const int k1l = 16 * blk + 4 * r + fq, k1 = 32 * hh + k1l; const float dr = acc[blk][r], di = acc[2 + blk][r];
                    const float frac = (float)((s2 * k1) & 8191) * (1.0f / 8192.0f), c = __builtin_amdgcn_cosf(frac), s = __builtin_amdgcn_sinf(frac);
                    *(LAS unsigned*)(lds + FFT_TOFF + (k1l * 4 + ch) * FFT_TPITCH + s2 * 4) = cvt_pk_bf16(dr * c + di * s, di * c - dr * s); } } }
        LDS_WAIT(); __syncthreads(); if (hh == 0) FFT_STAMP(2);
        for (int nt2 = 0; nt2 < 8; ++nt2) { f32x4 c0 = {0.f, 0.f, 0.f, 0.f}, c1 = {0.f, 0.f, 0.f, 0.f};
#pragma unroll
            for (int kk = 0; kk < 8; ++kk) { const bf16x8 Bt = *(const LAS bf16x8*)(lds + FFT_TOFF + (16 * nt2 + fr) * FFT_TPITCH + kk * 64 + fq * 16);
                c0 = __builtin_amdgcn_mfma_f32_16x16x32_bf16(A2[0][kk], Bt, c0, 0, 0, 0); c1 = __builtin_amdgcn_mfma_f32_16x16x32_bf16(A2[1][kk], Bt, c1, 0, 0, 0); }
            const int k1 = 32 * hh + 4 * nt2 + s2l;
#pragma unroll
            for (int r = 0; r < 4; ++r) { const int k = k1 + 64 * (16 * wave + 4 * fq + r); *(GAS unsigned*)(zb + (size_t)k * 16 + ch * 4) = cvt_pk_bf16(c0[r], c1[r]); } }
        LDS_WAIT(); __syncthreads(); if (hh == 0) FFT_STAMP(3);
    }
    FFT_STAMP(4);
#undef FFT_STAMP
}
#if MOE_FP8
#define EXPERT_ITEM(r_) do { const int e_ = (r_) / 3072, q_ = (r_) % 3072; \
    if (q_ < 1024) transpose_item8<2>(w_g + (size_t)e_ * D * DE, D, DE, WGU8 + (size_t)e_ * 4096 * D, scr, q_, lane); \
    else if (q_ < 2048) transpose_item8<3>(w_u + (size_t)e_ * D * DE, D, DE, WGU8 + (size_t)e_ * 4096 * D, scr, q_ - 1024, lane); \
    else transpose_item8<0>(w_d + (size_t)e_ * DE * D, DE, D, WD8 + (size_t)e_ * D * DE, scr, q_ - 2048, lane); } while (0)
#else
#define EXPERT_ITEM(r_) do { const int e_ = (r_) / 3072, q_ = (r_) % 3072; \
    if (q_ < 1024) transpose_item<2>(w_g + (size_t)e_ * D * DE, D, DE, WGU + (size_t)e_ * 4096 * D, scr, q_, lane); \
    else if (q_ < 2048) transpose_item<3>(w_u + (size_t)e_ * D * DE, D, DE, WGU + (size_t)e_ * 4096 * D, scr, q_ - 1024, lane); \
    else transpose_item<0>(w_d + (size_t)e_ * DE * D, DE, D, WD + (size_t)e_ * D * DE, scr, q_ - 2048, lane); } while (0)
#endif
#ifndef EXP_P2
#define EXP_P2 28672
#endif
#ifndef EXP_P7
#define EXP_P7 14336
#endif
#ifndef EXP_P6
#define EXP_P6 4096
#endif
constexpr int EXP_TOTAL = NE * 3072, EXP_P0 = EXP_TOTAL - EXP_P2 - EXP_P7 - EXP_P6;

constexpr int NPHASE = 12;
#ifndef P2_GEMM_CUS
#define P2_GEMM_CUS 202
#endif
constexpr int CW_MODCNT = 2048;
#ifndef P4_FUSED
#define P4_FUSED 0
#endif
#ifndef MOE_ALIGN
#define MOE_ALIGN true
#endif
#ifndef EXTRA_BARS
#define EXTRA_BARS 0
#endif
#ifndef STAGGER_US
#define STAGGER_US 0
#endif
#ifndef DOUBLE_PH
#define DOUBLE_PH -1
#endif
#define REP(k) for (int rep_ = 0; rep_ < ((DOUBLE_PH == (k)) ? 2 : 1); ++rep_)
#define REPBAR(k) do { if (DOUBLE_PH == (k) && rep_ == 0) xcd_barrier(bar); } while (0)
#ifndef PROBE_I
#define PROBE_I -1
#endif
#ifndef PROBE_J
#define PROBE_J -1
#endif
#ifndef DBG_PLAIN
#define DBG_PLAIN 0
#endif
#ifndef GALIGN
#define GALIGN true
#endif
#ifndef GSP2
#define GSP2 true
#endif
struct Args { const float* in[18]; float* out; unsigned char* ws; int ph_lo, ph_hi; };
__global__ void __launch_bounds__(NWAVES * 64, 2) fwd(Args args) {
    extern __shared__ __attribute__((aligned(16))) unsigned char lds_raw[];
    LAS unsigned char* lds = (LAS unsigned char*)lds_raw;
    volatile LAS unsigned* MISC = (volatile LAS unsigned*)(lds + MISC_OFF);
    const int tid = threadIdx.x, lane = tid & 63, wave = __builtin_amdgcn_readfirstlane(tid >> 6);
    const int G = gridDim.x; const int bx = blockIdx.x; const int vcu = (G % 8 == 0) ? (bx % 8) * (G / 8) + bx / 8 : bx;
    unsigned char* ws = args.ws;
    const float *x = args.in[0], *c = args.in[1], *w_ada = args.in[2], *b_ada = args.in[3], *g_mix = args.in[4], *w_in = args.in[5], *b_gate = args.in[6], *w_f = args.in[7], *w_conv = args.in[8],
                *w_co = args.in[9], *w_o = args.in[10], *g_moe = args.in[11], *w_r = args.in[12], *b_r = args.in[13], *w_g = args.in[14], *w_u = args.in[15], *w_d = args.in[16], *g_fin = args.in[17];
    float* out = args.out;
    float *modp = (float*)(ws + WS_MODP), *mod = (float*)(ws + WS_MOD), *probs = (float*)(ws + WS_PROBS), *val = (float*)(ws + WS_VAL);
    int *slot = (int*)(ws + WS_SLOT), *idx = (int*)(ws + WS_IDX);
    bf16 *Fc1 = (bf16*)(ws + WS_FC1), *Fc2 = (bf16*)(ws + WS_FC2), *WIN = (bf16*)(ws + WS_WIN), *WF = (bf16*)(ws + WS_WF), *WCO = (bf16*)(ws + WS_WCO), *WO = (bf16*)(ws + WS_WO), *WGU = (bf16*)(ws + WS_WGU), *WD = (bf16*)(ws + WS_WD);
    bf16 *H1 = (bf16*)(ws + WS_H1), *AB = (bf16*)(ws + WS_AB), *UF = (bf16*)(ws + WS_UF), *CV = (bf16*)(ws + WS_CV), *BG = (bf16*)(ws + WS_BG), *GA = (bf16*)(ws + WS_GA), *GB = (bf16*)(ws + WS_GB), *ZF = (bf16*)(ws + WS_ZF),
         *TZ = (bf16*)(ws + WS_TZ), *H2 = (bf16*)(ws + WS_H2), *HM = (bf16*)(ws + WS_HM), *Y = (bf16*)(ws + WS_Y), *X1B = (bf16*)(ws + WS_X1B);
    unsigned char *WGU8 = ws + WS_WGU, *WD8 = ws + WS_WD, *H2F8 = ws + WS_H2, *HM8 = ws + WS_HM;
    for (int u = tid; u < (LDS_BYTES - MISC_OFF) / 4; u += NWAVES * 64) ((LAS unsigned*)(lds + MISC_OFF))[u] = 0u;
    __syncthreads();
    const int lo = args.ph_lo, hi = args.ph_hi;
    XcdBarrier bar; bar.bar = (unsigned*)(ws + WS_CTL) + CW_BAR; bar.x = 0; bar.st = nullptr;
    if (hi - lo > 1) bar = xcd_barrier_post((unsigned*)(ws + WS_CTL) + CW_BAR, MISC + 8);
#define IN(k) (lo <= (k) && (k) < hi)
#if PROBE_I >= 0
    unsigned long long* tsb = (unsigned long long*)(ws + WS_CTL + 512 * 1024);
    if (bx == 0 && tid == 0) tsb[0] = __builtin_amdgcn_s_memrealtime();
#define GRID_BAR(k) do { if (IN(k) && IN((k) + 1)) xcd_barrier(bar); if (bx == 0 && tid == 0) tsb[(k) + 1] = __builtin_amdgcn_s_memrealtime(); } while (0)
#else
#define GRID_BAR(k) do { if (IN(k) && IN((k) + 1)) xcd_barrier(bar); } while (0)
#endif
    const int gw = vcu * NWAVES + wave, NGW = G * NWAVES;
    LAS float* scr = (LAS float*)(lds + wave * 16384);

    if (IN(0)) REP(0) {
        if (vcu < 96) { mod_item(c, w_ada, modp, lds, vcu, tid, wave, lane);
            if (tid == 0) { __builtin_amdgcn_fence(__ATOMIC_RELEASE, "agent"); asm volatile("s_waitcnt vmcnt(0)" ::: "memory");
                (void)xb_add((unsigned*)(ws + WS_CTL) + CW_MODCNT, 1u); } }
#if PROBE_I >= 0
        if (bx == 0 && tid == 0) tsb[22] = __builtin_amdgcn_s_memrealtime();
#endif
        fc_tables(Fc1, Fc2, vcu * NWAVES * 64 + tid, G * NWAVES * 64);
#if PROBE_I >= 0
        if (bx == 0 && tid == 0) tsb[23] = __builtin_amdgcn_s_memrealtime();
#endif
        constexpr int I_WF = 2048, I_IN = 16 * 176, I_SQ = 16 * 32, I_EX = 3072, NITEMS = I_WF + I_IN + 2 * I_SQ + NE * I_EX;
        if (vcu >= 96) { const int w0 = (vcu - 96) * NWAVES + wave, nw0 = (G - 96) * NWAVES;
            for (int r = w0; r < I_WF; r += nw0) wf_item(w_f, WF, r, lane); }
        for (int it = I_WF + gw; it < I_WF + I_IN + 2 * I_SQ; it += NGW) {
            int r = it - I_WF;
            if (r < I_IN) { transpose_item<1>(w_in, D, DIN, WIN, scr, r, lane); continue; } r -= I_IN;
            if (r < I_SQ) { transpose_item<0>(w_co, D, D, WCO, scr, r, lane); continue; } r -= I_SQ;
            if (r < I_SQ) { transpose_item<0>(w_o, D, D, WO, scr, r, lane); continue; } r -= I_SQ;
            break;
        }
        expert_range(w_g, w_u, w_d, WGU8, WD8, gw, EXP_P0, NGW, lane, scr);
#if PROBE_I >= 0
        asm volatile("s_waitcnt vmcnt(0)" ::: "memory"); __syncthreads(); if (bx == 0 && tid == 0) tsb[24] = __builtin_amdgcn_s_memrealtime();
#endif
        if (tid == 0) { unsigned* cnt = (unsigned*)(ws + WS_CTL) + CW_MODCNT; unsigned sp = 0u;
            while (xb_ld(cnt) < 96u) { __builtin_amdgcn_s_sleep(2); if (++sp > (1u << 22)) break; }
            __builtin_amdgcn_fence(__ATOMIC_ACQUIRE, "agent"); asm volatile("s_waitcnt vmcnt(0)" ::: "memory"); }
        __syncthreads();
        phase_h(x, g_mix, b_ada, modp, mod, H1, lds, tid, wave, lane, vcu, G);
        GRID_BAR(1);
    }
#if EXTRA_BARS > 0
    if (IN(1) && IN(2)) { for (int eb = 0; eb < EXTRA_BARS; ++eb) xcd_barrier(bar); }
#endif
    if (IN(2)) REP(2) {
#if STAGGER_US > 0
        if (bx >= 128) { const unsigned long long t0 = __builtin_amdgcn_s_memrealtime(); while (__builtin_amdgcn_s_memrealtime() - t0 < (unsigned long long)(STAGGER_US * 100)) __builtin_amdgcn_s_sleep(8); }
#endif
#if P2_GEMM_CUS > 0
        const int gcus = (G > P2_GEMM_CUS + 8) ? P2_GEMM_CUS : G - 1;
        if (bx >= gcus) {
            const int w2 = (bx - gcus) * NWAVES + wave, nw2 = (G - gcus) * NWAVES;
            expert_range(w_g, w_u, w_d, WGU8, WD8, EXP_P0 + EXP_P6 + w2, EXP_P0 + EXP_P6 + EXP_P2, nw2, lane, scr); }
        else {
        pg8::Gemm g{H1, WIN, M, DIN, D, 0, 0, nullptr, (unsigned long long*)(ws + WS_CTL + 512 * 1024), nullptr, 0}; pg8::StaticOrder S; S.init(M, DIN, gcus, bx);
        EpiInProj E{UF, CV, BG, GA, GB, b_gate};
        pg8::gemm_phase<EpiInProj, pg8::StaticOrder, 0, GALIGN, GSP2>(lds, g, S, E); }
#else
        pg8::Gemm g{H1, WIN, M, DIN, D, 0, 0, nullptr, (unsigned long long*)(ws + WS_CTL + 512 * 1024), nullptr, 0}; pg8::StaticOrder S; S.init(M, DIN, G, bx);
#if DBG_PLAIN
        EpiPlain E{UF, DIN};
        pg8::gemm_phase<EpiPlain, pg8::StaticOrder, 0, GALIGN, GSP2>(lds, g, S, E);
#else
        EpiInProj E{UF, CV, BG, GA, GB, b_gate};
        pg8::gemm_phase<EpiInProj, pg8::StaticOrder, 0, GALIGN, GSP2>(lds, g, S, E);
#endif
        if (bx >= G / 2) { const int w2 = (bx - G / 2) * NWAVES + wave, nw2 = (G - G / 2) * NWAVES;
            expert_range(w_g, w_u, w_d, WGU8, WD8, EXP_P0 + EXP_P6 + w2, EXP_P0 + EXP_P6 + EXP_P2, nw2, lane, scr); }
#endif
        GRID_BAR(2);
    }
    if (IN(3)) REP(3) {
        if (bx & 1) phase_conv(CV, BG, w_conv, AB, wave, lane, vcu, G);
        for (int it = vcu; it < BATCH * 128; it += G) fft_item(lds, UF, ZF, Fc1, Fc2, it, wave, lane, (PROBE_I >= 340 && PROBE_I < 350) ? (unsigned long long*)(ws + WS_CTL + 512 * 1024) : nullptr);
#if PROBE_I >= 0
        __syncthreads(); if (bx == 0 && tid == 0) tsb[20] = __builtin_amdgcn_s_memrealtime();
#endif
        if (!(bx & 1)) phase_conv(CV, BG, w_conv, AB, wave, lane, vcu, G);
#if PROBE_I >= 0
        asm volatile("s_waitcnt vmcnt(0)" ::: "memory"); __syncthreads(); if (bx == 0 && tid == 0) tsb[21] = __builtin_amdgcn_s_memrealtime();
#endif
        GRID_BAR(3);
    }
    if (IN(4)) REP(4) {
#if P4_FUSED
        { pg8::Gemm g{ZF, WF, M, 2 * D, D, 0, 0, nullptr, (unsigned long long*)(ws + WS_CTL + 512 * 1024), AB, 4}; pg8::StaticOrder S; S.init(M, 2 * D, G, bx); EpiGateBoth E{TZ, GA, GB};
          pg8::gemm_phase<EpiGateBoth, pg8::StaticOrder, 3, true, true>(lds, g, S, E); }
#else
        { pg8::Gemm g{ZF, WF, M, D, D, 0, 0, nullptr, (unsigned long long*)(ws + WS_CTL + 512 * 1024), nullptr, 0}; pg8::StaticOrder S; S.init(M, D, G, bx); EpiGateMul<0> E{TZ, GA};
          pg8::gemm_phase<EpiGateMul<0>, pg8::StaticOrder, 1, true, true>(lds, g, S, E); }
        { pg8::Gemm g{AB, WCO, M, D, D, 0, 0, nullptr, (unsigned long long*)(ws + WS_CTL + 512 * 1024), nullptr, 0}; pg8::StaticOrder S; S.init(M, D, G, bx); EpiGateMul<1> E{TZ, GB};
          pg8::gemm_phase<EpiGateMul<1>, pg8::StaticOrder, 0, true, true>(lds, g, S, E); }
#endif
        GRID_BAR(4);
    }
    if (IN(5)) REP(5) {
        pg8::Gemm g{TZ, WO, M, D, D, 0, 0, nullptr, (unsigned long long*)(ws + WS_CTL + 512 * 1024), nullptr, 0}; pg8::StaticOrder S; S.init(M, D, G, bx); EpiResid E{x, X1B, mod + 2 * D};
        pg8::gemm_phase<EpiResid, pg8::StaticOrder, 0, true, true>(lds, g, S, E);
        GRID_BAR(5);
    }
    if (IN(6)) REP(6) { phase_h2(X1B, g_moe, mod, w_r, b_r, H2, H2F8, probs, lds, tid, wave, lane, vcu, G);
        if (wave >= 4) { LAS float* scr6 = (LAS float*)(lds + 81920 + (wave - 4) * 8448);
            const int w6 = vcu * 4 + (wave - 4), nw6 = G * 4; LAS float* scr = scr6;
            expert_range(w_g, w_u, w_d, WGU8, WD8, EXP_P0 + w6, EXP_P0 + EXP_P6, nw6, lane, scr); }
        __syncthreads(); GRID_BAR(6); }
    if (IN(7)) REP(7) { for (int it = vcu; it < NE * BATCH; it += G) topk_item(probs, idx, val, slot, lds, it, tid, wave, lane);
        if (vcu >= NE * BATCH) { const int w7 = (vcu - NE * BATCH) * NWAVES + wave, nw7 = (G - NE * BATCH) * NWAVES;
            expert_range(w_g, w_u, w_d, WGU8, WD8, EXP_P0 + EXP_P6 + EXP_P2 + w7, EXP_TOTAL, nw7, lane, scr); }
        GRID_BAR(7); }
    if (IN(9)) REP(9) {
#if MOE_FP8
        pg8::Gemm g{(const bf16*)H2F8, (const bf16*)WGU8, MR, 2 * DE, D / 2, 8, (size_t)2 * DE * D / 2, idx, (unsigned long long*)(ws + WS_CTL + 512 * 1024), nullptr, 0}; pg8::StaticOrder S; S.init(MR, 2 * DE, G, bx); EpiSwiGLU8 E{HM8};
        pg8::gemm_phase<EpiSwiGLU8, pg8::StaticOrder, 2, MOE_ALIGN, true, true>(lds, g, S, E);
#else
        pg8::Gemm g{H2, WGU, MR, 2 * DE, D, 8, (size_t)2 * DE * D, idx, (unsigned long long*)(ws + WS_CTL + 512 * 1024), nullptr, 0}; pg8::StaticOrder S; S.init(MR, 2 * DE, G, bx); EpiSwiGLU E{HM};
        pg8::gemm_phase<EpiSwiGLU, pg8::StaticOrder, 2, true, true>(lds, g, S, E);
#endif
        GRID_BAR(9);
    }
    if (IN(10)) REP(10) {
#if MOE_FP8
        pg8::Gemm g{(const bf16*)HM8, (const bf16*)WD8, MR, D, DE / 2, 8, (size_t)D * DE / 2, nullptr, (unsigned long long*)(ws + WS_CTL + 512 * 1024), nullptr, 0}; pg8::StaticOrder S; S.init(MR, D, G, bx); EpiRowScale E{Y, val};
        pg8::gemm_phase<EpiRowScale, pg8::StaticOrder, 0, MOE_ALIGN, true, true>(lds, g, S, E);
#else
        pg8::Gemm g{HM, WD, MR, D, DE, 8, (size_t)D * DE, nullptr, (unsigned long long*)(ws + WS_CTL + 512 * 1024), nullptr, 0}; pg8::StaticOrder S; S.init(MR, D, G, bx); EpiRowScale E{Y, val};
        pg8::gemm_phase<EpiRowScale, pg8::StaticOrder, 0, true, true>(lds, g, S, E);
#endif
#if PROBE_I >= 0
        if (bx == 0 && tid == 0) tsb[12] = __builtin_amdgcn_s_memrealtime();
#endif
        GRID_BAR(10);
    }
#if PROBE_I >= 0
    float pert = 0.f;
    if (IN(11)) { const unsigned long long a0 = __hip_atomic_load(tsb + (PROBE_I == 100 ? 0 : PROBE_I == 9 ? 8 : PROBE_I), __ATOMIC_RELAXED, __HIP_MEMORY_SCOPE_AGENT), a1 = __hip_atomic_load(tsb + (PROBE_I == 100 ? 12 : PROBE_I == 10 ? 12 : PROBE_I + 1), __ATOMIC_RELAXED, __HIP_MEMORY_SCOPE_AGENT); pert = (float)(a1 - a0) * 0.01f * (PROBE_I == 100 ? (1.0f / 64000.0f) : (1.0f / 16000.0f)); }
    if (PROBE_I == 102) { pert = 0.f; if (bx == 0 && tid == 0) tsb[14] = __builtin_amdgcn_s_memrealtime(); __syncthreads(); }
    if (PROBE_I >= 340 && PROBE_I < 344) { pert = 0.f; if (bx == 0) { const int q_ = PROBE_I - 340; const unsigned long long a0 = __hip_atomic_load(tsb + 34 + q_, __ATOMIC_RELAXED, __HIP_MEMORY_SCOPE_AGENT), a1 = __hip_atomic_load(tsb + 35 + q_, __ATOMIC_RELAXED, __HIP_MEMORY_SCOPE_AGENT); pert = (float)(a1 - a0) * 0.01f * (1.0f / 250.0f); } }
    else if ((PROBE_I >= 320 && PROBE_I < 323) || (PROBE_I >= 330 && PROBE_I < 333)) { pert = 0.f; if (bx == 0) { const int q_ = PROBE_I % 10; const unsigned long long a0 = __hip_atomic_load(tsb + 30 + q_, __ATOMIC_RELAXED, __HIP_MEMORY_SCOPE_AGENT), a1 = __hip_atomic_load(tsb + 31 + q_, __ATOMIC_RELAXED, __HIP_MEMORY_SCOPE_AGENT); pert = (float)(a1 - a0) * 0.01f * (1.0f / 250.0f); } }
    else if (PROBE_I >= 310 && PROBE_I <= 313) { pert = 0.f; if (bx == 0) { const int ia = (PROBE_I == 310 ? 0 : PROBE_I == 311 ? 22 : PROBE_I == 312 ? 23 : 24), ib = (PROBE_I == 310 ? 22 : PROBE_I == 311 ? 23 : PROBE_I == 312 ? 24 : 1);
        const unsigned long long a0 = __hip_atomic_load(tsb + ia, __ATOMIC_RELAXED, __HIP_MEMORY_SCOPE_AGENT), a1 = __hip_atomic_load(tsb + ib, __ATOMIC_RELAXED, __HIP_MEMORY_SCOPE_AGENT); pert = (float)(a1 - a0) * 0.01f * (1.0f / 250.0f); } }
    else if (PROBE_I == 300 || PROBE_I == 301 || PROBE_I == 302) { pert = 0.f; if (bx == 0) { const unsigned long long a0 = __hip_atomic_load(tsb + (PROBE_I == 300 ? 3 : PROBE_I == 301 ? 20 : 21), __ATOMIC_RELAXED, __HIP_MEMORY_SCOPE_AGENT), a1 = __hip_atomic_load(tsb + (PROBE_I == 300 ? 20 : PROBE_I == 301 ? 21 : 4), __ATOMIC_RELAXED, __HIP_MEMORY_SCOPE_AGENT); pert = (float)(a1 - a0) * 0.01f * (1.0f / 250.0f); } }
    else if (PROBE_I >= 200) { pert = 0.f; if (bx == 0) { const int k_ = PROBE_I - 200; const unsigned long long a0 = __hip_atomic_load(tsb + (k_ == 9 ? 8 : k_), __ATOMIC_RELAXED, __HIP_MEMORY_SCOPE_AGENT), a1 = __hip_atomic_load(tsb + k_ + 1, __ATOMIC_RELAXED, __HIP_MEMORY_SCOPE_AGENT); pert = (float)(a1 - a0) * 0.01f * (1.0f / 250.0f); } }
    if (PROBE_I == 101) { pert = 0.f; if (bx == 0) { const unsigned long long a0 = __hip_atomic_load(tsb + 12, __ATOMIC_RELAXED, __HIP_MEMORY_SCOPE_AGENT); pert = (float)(__builtin_amdgcn_s_memrealtime() - a0) * 0.01f * (1.0f / 250.0f); } }
    if (IN(11)) phase_final(out, X1B, Y, slot, mod, g_fin, wave, lane, vcu, G, pert);
    if (PROBE_I == 102) {
        const unsigned long long t_a = tsb[14];
        xcd_barrier(bar);
        if (bx == 0) { const float pp = (float)(__builtin_amdgcn_s_memrealtime() - t_a) * 0.01f * (1.0f / 250.0f);
            for (int k = 0; k < 4; ++k) for (int r = 0; r < 2; ++r) { float* row = out + (size_t)(2 * (vcu * NWAVES + wave) + r + 4096 * k) * D; for (int cc = lane; cc < D; cc += 64) row[cc] += pp; } } }
#else
    if (IN(11)) REP(11) { phase_final(out, X1B, Y, slot, mod, g_fin, wave, lane, vcu, G, 0.f); if (DOUBLE_PH == 11 && rep_ == 0) xcd_barrier(bar); }
#endif

#undef IN
#undef GRID_BAR
}


struct DumpArgs { const unsigned short* p[8]; unsigned long long n[8]; int f32[8]; int nb; int pad; };
__global__ void k_dump(float* out, DumpArgs a) {
    const size_t i = (size_t)blockIdx.x * blockDim.x + threadIdx.x; float s = 0.f;
    for (int b = 0; b < a.nb; ++b) for (size_t j = i; j < a.n[b]; j += (size_t)M * D) s += (a.f32[b] ? ((const float*)a.p[b])[j] : __uint_as_float(((unsigned)a.p[b][j]) << 16)) * (float)(b + 1);
    out[i] = s;
}
#ifndef DUMP_WHICH
#define DUMP_WHICH -1
#endif
#ifndef STOP_AFTER
#define STOP_AFTER (NPHASE - 1)
#endif
#ifndef MK_PER_PHASE
#define MK_PER_PHASE 0
#endif
extern "C" void kernel_launch(void* const* d_in, const int* in_sizes, int n_in, void* d_out, int out_size, void* d_ws, size_t ws_size, hipStream_t stream) {
    static int grid = 0;
    if (grid == 0) {
        if (n_in != 18 || in_sizes[0] != M * D || out_size != M * D || ws_size < WS_END) { fprintf(stderr, "kernel_launch: unexpected shapes (n_in %d, in0 %d, out %d, ws %zu); nothing launched\n", n_in, n_in > 0 ? in_sizes[0] : -1, out_size, ws_size); grid = -1; return; }
        int dev = 0, cus = 0, per_cu = 0;
        if (hipGetDevice(&dev) != hipSuccess || hipDeviceGetAttribute(&cus, hipDeviceAttributeMultiprocessorCount, dev) != hipSuccess) { grid = -1; return; }
        if (hipFuncSetAttribute((const void*)fwd, hipFuncAttributeMaxDynamicSharedMemorySize, LDS_BYTES) != hipSuccess) { fprintf(stderr, "kernel_launch: hipFuncSetAttribute failed\n"); grid = -1; return; }
        if (hipOccupancyMaxActiveBlocksPerMultiprocessor(&per_cu, (const void*)fwd, NWAVES * 64, LDS_BYTES) != hipSuccess || per_cu < 1) { fprintf(stderr, "kernel_launch: occupancy query reports %d blocks per CU\n", per_cu); }
        (void)hipGetLastError();
        grid = cus;
    }
    if (grid < 0) return;
    (void)hipMemsetAsync((char*)d_ws + WS_CTL, 0, CTL_ZERO_BYTES, stream);
    Args a{};
    for (int i = 0; i < 18; ++i) a.in[i] = (const float*)d_in[i];
    a.out = (float*)d_out; a.ws = (unsigned char*)d_ws;
#if MK_PER_PHASE
    for (int p = 0; p < STOP_AFTER + 1; ++p) { a.ph_lo = p; a.ph_hi = p + 1; hipLaunchKernelGGL(fwd, dim3(grid), dim3(NWAVES * 64), LDS_BYTES, stream, a); }
#if DUMP_WHICH >= 0
    { DumpArgs da{}; unsigned char* w = (unsigned char*)d_ws; int nb = 0;
      auto add = [&](size_t off, size_t n, int isf = 0) { da.p[nb] = (const unsigned short*)(w + off); da.n[nb] = n; da.f32[nb] = isf; ++nb; };
      if (DUMP_WHICH == 0) { add(WS_WIN, (size_t)DIN * D); add(WS_WF, (size_t)D * D); add(WS_WCO, (size_t)D * D); add(WS_WO, (size_t)D * D); add(WS_WGU, (size_t)NE * 4096 * D); add(WS_WD, (size_t)NE * D * DE); add(WS_FC1, 8192 + 0); add(WS_MODP, 4 * 2 * 6 * D, 1); }
      if (DUMP_WHICH == 1) { add(WS_H1, (size_t)M * D); add(WS_MOD, 2 * 6 * D, 1); add(WS_FC2, 65536); }
      if (DUMP_WHICH == 2) { add(WS_UF, (size_t)M * DF); add(WS_CV, (size_t)M * D); add(WS_BG, (size_t)M * D); add(WS_GA, (size_t)M * D); add(WS_GB, (size_t)M * D); }
      if (DUMP_WHICH == 5) { add(WS_UF, (size_t)M * DIN); }
      if (DUMP_WHICH == 6) { add(WS_UF, (size_t)M * DF); add(WS_CV, (size_t)M * D); }
      if (DUMP_WHICH == 7) { add(WS_BG, (size_t)M * D); }
      if (DUMP_WHICH == 8) { add(WS_GA, (size_t)M * D); add(WS_GB, (size_t)M * D); }
      if (DUMP_WHICH == 9) { add(WS_GA, (size_t)M * D); }
      if (DUMP_WHICH == 10) { add(WS_GB, (size_t)M * D); }
      if (DUMP_WHICH == 3) { add(WS_ZF, (size_t)M * D); add(WS_AB, (size_t)M * D); }
      if (DUMP_WHICH == 4) { add(WS_TZ, (size_t)M * D); }
      da.nb = nb; hipLaunchKernelGGL(k_dump, dim3(M * D / 256), dim3(256), 0, stream, (float*)d_out, da); }
#endif
#else
    a.ph_lo = 0; a.ph_hi = NPHASE; hipLaunchKernelGGL(fwd, dim3(grid), dim3(NWAVES * 64), LDS_BYTES, stream, a);
#endif
}
```
